# Optimizing an MI355X kernel written in HIP

```python
import math
import jax, jax.numpy as jnp
from jax import lax
import numpy as np

D_MODEL = 1024
BATCH = 4
SEQ = 4096
DEPTH = 2

CHUNK = 64
Q_BLOCK = 128
A_HEAD_DIM = 64
A_WIDTH = D_MODEL // 2
A_HEADS = A_WIDTH // A_HEAD_DIM
IDX_HEADS = 8
IDX_DIM = 64
TOPK_MAX = 256
N_BUCKETS = 32
MAX_DISTANCE = 128
B_HEAD_DIM = 64
B_WIDTH = D_MODEL - A_WIDTH
B_HEADS = B_WIDTH // B_HEAD_DIM
DECAY_LORA = 64
ICLR_LORA = 64
GATE_LORA = 128
A_SIZES = (A_WIDTH, A_WIDTH, A_WIDTH, IDX_HEADS * IDX_DIM, IDX_DIM, IDX_HEADS)
B_SIZES = (B_WIDTH, B_WIDTH, B_WIDTH, DECAY_LORA, ICLR_LORA, GATE_LORA)
A_COLS = sum(A_SIZES)
B_COLS = sum(B_SIZES)
IN_COLS = A_COLS + B_COLS
MIX_WIDTH = A_WIDTH + B_WIDTH
N_EXPERTS = 16
N_GROUPS = 4
EXPERTS_PER_GROUP = N_EXPERTS // N_GROUPS
TOP_K = 2
D_EXPERT = 256
PLE_DIM = 256
ALPHA = (2 * DEPTH) ** 0.25
BETA = (8 * DEPTH) ** -0.25
LN_EPS = 1e-5
GN_EPS = 64e-5
NEG = -1e30

kernel_name = 'hybrid_dsa_rwkv7_grouped_moe_deepnorm'


def split_cols(a, sizes):
    cuts = [int(c) for c in np.cumsum(sizes)[:-1]]
    return jnp.split(a, cuts, axis=-1)


def layer_norm(x, g, b):
    xf = x.astype(jnp.float32)
    mu = xf.mean(-1, keepdims=True)
    var = jnp.square(xf - mu).mean(-1, keepdims=True)
    return ((xf - mu) * lax.rsqrt(var + LN_EPS) * g + b).astype(x.dtype)


def t5_bucket(rel):
    nb = N_BUCKETS // 2
    max_exact = nb // 2
    ret = jnp.where(rel > 0, nb, 0)
    n = jnp.abs(rel)
    nf = jnp.maximum(n, 1).astype(jnp.float32)
    large = max_exact + (jnp.log(nf / max_exact) / math.log(MAX_DISTANCE / max_exact)
                         * (nb - max_exact)).astype(jnp.int32)
    large = jnp.minimum(large, nb - 1)
    return ret + jnp.where(n < max_exact, n, large)


def dsa_attention(q, k, v, qi, ki, wi, rel_bias):
    bsz, seq = q.shape[0], q.shape[1]
    n_sel = min(TOPK_MAX, seq // 4)
    n_blk = seq // Q_BLOCK
    key_chunk = jnp.arange(seq, dtype=jnp.int32) // CHUNK
    ki32 = ki.astype(jnp.float32)
    idx_scale = (IDX_HEADS ** -0.5) * (IDX_DIM ** -0.5)
    att_scale = A_HEAD_DIM ** -0.5
    gather = jax.vmap(lambda a, i: a[i])

    def to_blocks(a):
        a = a.reshape((bsz, n_blk, Q_BLOCK) + a.shape[2:])
        return jnp.moveaxis(a, 1, 0)

    def one_block(args):
        qb, qib, wib, start = args
        t = start + jnp.arange(Q_BLOCK, dtype=jnp.int32)
        q_chunk = t // CHUNK
        dots = jnp.einsum('bqhd,bsd->bqhs', qib.astype(jnp.float32), ki32)
        score = jnp.einsum('bqh,bqhs->bqs', wib.astype(jnp.float32) * idx_scale, jax.nn.relu(dots))
        admissible = key_chunk[None, :] <= q_chunk[:, None]
        score = jnp.where(admissible[None], score, NEG)
        _, sel = lax.top_k(score, n_sel)
        kg = gather(k, sel)
        vg = gather(v, sel)
        logits = jnp.einsum('bqhd,bqkhd->bqkh', qb, kg).astype(jnp.float32) * att_scale
        logits = logits + rel_bias[t5_bucket(sel - t[None, :, None])].astype(jnp.float32)
        valid = (sel // CHUNK) <= q_chunk[None, :, None]
        logits = jnp.where(valid[..., None], logits, NEG)
        probs = jax.nn.softmax(logits, axis=2).astype(vg.dtype)
        return jnp.einsum('bqkh,bqkhd->bqhd', probs, vg)

    starts = jnp.arange(n_blk, dtype=jnp.int32) * Q_BLOCK
    out = lax.map(one_block, (to_blocks(q), to_blocks(qi), to_blocks(wi), starts))
    return jnp.moveaxis(out, 0, 1).reshape(bsz, seq, A_WIDTH)


def rwkv7_time_mix(h, mu, w0, w_decay, a0, w_iclr, w_gate_up, k_k, k_a, r_k, gn_g, gn_b):
    bsz, seq = h.shape[0], h.shape[1]
    f32 = jnp.float32
    h_prev = jnp.pad(h, ((0, 0), (1, 0), (0, 0)))[:, :-1]
    hs = h + (h_prev - h) * mu
    r, k, v, wd, ad, gd = split_cols(hs, B_SIZES)
    w_log = -jax.nn.softplus(-(w0 + jnp.tanh(wd) @ w_decay)) - 0.5
    decay = jnp.exp(-jnp.exp(w_log.astype(f32)))
    a = jax.nn.sigmoid(a0 + ad @ w_iclr)
    g = jax.nn.sigmoid(gd) @ w_gate_up
    heads = lambda t: t.astype(f32).reshape(bsz, seq, B_HEADS, B_HEAD_DIM)
    kk = heads(k * k_k)
    kk = kk / jnp.maximum(jnp.sqrt(jnp.sum(kk * kk, -1, keepdims=True)), 1e-12)
    k = k * (1 + (a - 1) * k_a)
    rh, kh, vh, wh, ah = heads(r), heads(k), heads(v), heads(decay), heads(a)

    def step(state, inp):
        r_t, k_t, v_t, w_t, kk_t, a_t = inp
        sa = jnp.einsum('bhvk,bhk->bhv', state, -kk_t)
        state = (state * w_t[:, :, None, :] + sa[..., None] * (kk_t * a_t)[:, :, None, :]
                 + v_t[..., None] * k_t[:, :, None, :])
        return state, jnp.einsum('bhvk,bhk->bhv', state, r_t)

    tm = lambda t: jnp.moveaxis(t, 1, 0)
    s0 = jnp.zeros((bsz, B_HEADS, B_HEAD_DIM, B_HEAD_DIM), f32)
    _, y = lax.scan(step, s0, (tm(rh), tm(kh), tm(vh), tm(wh), tm(kk), tm(ah)))
    y = jnp.moveaxis(y, 0, 1)
    m = y.mean(-1, keepdims=True)
    var = jnp.square(y - m).mean(-1, keepdims=True)
    yn = ((y - m) * lax.rsqrt(var + GN_EPS)).reshape(bsz, seq, B_WIDTH) * gn_g + gn_b
    bonus = (jnp.sum(rh * kh * r_k.astype(f32), -1, keepdims=True) * vh).reshape(bsz, seq, B_WIDTH)
    return ((yn + bonus) * g).astype(h.dtype)


def grouped_moe(h, w_router, b_router, w_gate, w_up, w_down):
    f32 = jnp.float32
    scores = jax.nn.sigmoid(h.astype(f32) @ w_router.astype(f32))
    sel = scores + b_router.astype(f32)
    grouped = sel.reshape(sel.shape[:-1] + (N_GROUPS, EXPERTS_PER_GROUP))
    group_score = lax.top_k(grouped, TOP_K)[0].sum(-1)
    best = jnp.argmax(group_score, axis=-1)
    in_group = (jnp.arange(N_EXPERTS) // EXPERTS_PER_GROUP) == best[..., None]
    _, idx = lax.top_k(jnp.where(in_group, sel, NEG), TOP_K)
    w_sel = jnp.take_along_axis(scores, idx, axis=-1)
    w_sel = w_sel / jnp.sum(w_sel, -1, keepdims=True)
    gates = jnp.sum(jax.nn.one_hot(idx, N_EXPERTS, dtype=f32) * w_sel[..., None], axis=-2)
    hidden = (jax.nn.silu(jnp.einsum('bsd,edf->bsef', h, w_gate))
              * jnp.einsum('bsd,edf->bsef', h, w_up))
    hidden = hidden * gates[..., None].astype(hidden.dtype)
    return jnp.einsum('bsef,efd->bsd', hidden, w_down)


def setup_inputs(seed: int = 0) -> dict:
    key = jax.random.key(seed)
    ks = iter(jax.random.split(key, 40))
    nrm = lambda shape, s: jax.random.normal(next(ks), shape, jnp.float32) * s
    gain = lambda shape: 1.0 + nrm(shape, 0.02)
    L = DEPTH
    return {
        'x': nrm((BATCH, SEQ, D_MODEL), 1.0),
        'p': nrm((DEPTH, BATCH, SEQ, PLE_DIM), 1.0),
        'ln_in_g': gain((D_MODEL,)),
        'ln_in_b': nrm((D_MODEL,), 0.02),
        'w_in': nrm((L, D_MODEL, IN_COLS), D_MODEL ** -0.5),
        'w_out': nrm((L, MIX_WIDTH, D_MODEL), MIX_WIDTH ** -0.5 * BETA),
        'mu_shift': jax.random.uniform(next(ks), (L, B_COLS), jnp.float32),
        'w0': nrm((L, B_WIDTH), 1.0) - 2.0,
        'w_decay': nrm((L, DECAY_LORA, B_WIDTH), 0.1),
        'a0': nrm((L, B_WIDTH), 0.1),
        'w_iclr': nrm((L, ICLR_LORA, B_WIDTH), 0.1),
        'w_gate_up': nrm((L, GATE_LORA, B_WIDTH), GATE_LORA ** -0.5),
        'k_k': 0.85 + nrm((L, B_WIDTH), 0.02),
        'k_a': gain((L, B_WIDTH)),
        'r_k': nrm((L, B_HEADS, B_HEAD_DIM), 0.1),
        'gn_g': gain((L, B_WIDTH)),
        'gn_b': nrm((L, B_WIDTH), 0.02),
        'rel_bias': nrm((N_BUCKETS, A_HEADS), 0.5),
        'w_router': nrm((D_MODEL, N_EXPERTS), D_MODEL ** -0.5),
        'b_router': nrm((N_EXPERTS,), 0.01),
        'w_exp_gate': nrm((L, N_EXPERTS, D_MODEL, D_EXPERT), D_MODEL ** -0.5),
        'w_exp_up': nrm((L, N_EXPERTS, D_MODEL, D_EXPERT), D_MODEL ** -0.5),
        'w_exp_down': nrm((L, N_EXPERTS, D_EXPERT, D_MODEL), D_EXPERT ** -0.5 * BETA),
        'w_ple': nrm((L, PLE_DIM, D_MODEL), PLE_DIM ** -0.5 * BETA),
        'w_ple_gate': nrm((L, D_MODEL, D_MODEL), D_MODEL ** -0.5),
        'ln_mix_g': gain((L, D_MODEL)),
        'ln_mix_b': nrm((L, D_MODEL), 0.02),
        'ln_ffn_g': gain((L, D_MODEL)),
        'ln_ffn_b': nrm((L, D_MODEL), 0.02),
        'ln_ple_g': gain((L, D_MODEL)),
        'ln_ple_b': nrm((L, D_MODEL), 0.02),
    }


def reference(x, p, ln_in_g, ln_in_b, w_in, w_out, mu_shift, w0, w_decay, a0, w_iclr,
              w_gate_up, k_k, k_a, r_k, gn_g, gn_b, rel_bias, w_router, b_router,
              w_exp_gate, w_exp_up, w_exp_down, w_ple, w_ple_gate, ln_mix_g, ln_mix_b,
              ln_ffn_g, ln_ffn_b, ln_ple_g, ln_ple_b):
    bsz, seq = x.shape[0], x.shape[1]
    x = layer_norm(x, ln_in_g, ln_in_b)
    for i in range(DEPTH):
        proj = x @ w_in[i]
        h_a, h_b = proj[..., :A_COLS], proj[..., A_COLS:]
        q, k, v, qi, ki, wi = split_cols(h_a, A_SIZES)
        hsplit = lambda t: t.reshape(bsz, seq, A_HEADS, A_HEAD_DIM)
        a_out = dsa_attention(hsplit(q), hsplit(k), hsplit(v),
                              qi.reshape(bsz, seq, IDX_HEADS, IDX_DIM), ki, wi, rel_bias)
        b_out = rwkv7_time_mix(h_b, mu_shift[i], w0[i], w_decay[i], a0[i], w_iclr[i],
                               w_gate_up[i], k_k[i], k_a[i], r_k[i], gn_g[i], gn_b[i])
        mix = jnp.concatenate([a_out, b_out.astype(a_out.dtype)], axis=-1) @ w_out[i]
        x = layer_norm(ALPHA * x + mix, ln_mix_g[i], ln_mix_b[i])
        ffn = grouped_moe(x, w_router, b_router, w_exp_gate[i], w_exp_up[i], w_exp_down[i])
        x = layer_norm(ALPHA * x + ffn, ln_ffn_g[i], ln_ffn_b[i])
        ple = jax.nn.sigmoid(x @ w_ple_gate[i]) * (p[i] @ w_ple[i])
        x = layer_norm(ALPHA * x + ple, ln_ple_g[i], ln_ple_b[i])
    return x
```

```cpp
#include <hip/hip_runtime.h>
#include <hip/hip_cooperative_groups.h>
#include <cstdio>
#include <cstdint>
namespace cg = cooperative_groups;
namespace pg8 {
#define PG8_LAS __attribute__((address_space(3)))
typedef unsigned short bf16_t;
typedef short bf16x8 __attribute__((ext_vector_type(8)));
typedef float f32x4 __attribute__((ext_vector_type(4)));
typedef unsigned u32x4 __attribute__((ext_vector_type(4)));
constexpr int BM = 256, BK = 64, HALF = 128, HTB = HALF * BK * 2  , STAGE_BYTES = 8 * HTB, NXCD = 8, WGM = 8;

__host__ __device__ __forceinline__ int lds_byte(int r, int c) { const int st = (r >> 4) * 2 + (c >> 5), rr = r & 15, cc = c & 31, ob = rr * 64 + cc * 2; return st * 1024 + (ob ^ (((ob >> 9) & 1) << 5)); }
__host__ __device__ __forceinline__ void stage_rc(int b, int& R, int& C) { const int st = b / 1024, sb = b % 1024, swz = sb ^ (((sb >> 9) & 1) << 5); R = (st >> 1) * 16 + swz / 64; C = (st & 1) * 32 + (swz % 64) / 2; }
__host__ __device__ __forceinline__ int perm32(int rho) { const int n = rho >> 4, i = rho & 15; return 8 * (i >> 2) + 4 * n + (i & 3); }

struct Unit { int pm, pn; };
struct Gemm { const bf16_t* A; const bf16_t* Bt; int M, N, K; };

struct StaticOrder {
    int nM, nN, nwg, G, c;
    __host__ __device__ void init(int M, int N, int G_, int c_) { nM = M / BM; nN = N / BM; nwg = nM * nN; G = G_; c = c_; }
    __host__ __device__ bool next(int i, Unit& u) const {
        const long L = (long)i * G + c; if (L >= nwg) return false;
        int wgid = (int)L; { const int q = nwg / NXCD, r = nwg % NXCD, xcd = wgid % NXCD, off = wgid / NXCD; wgid = (xcd < r ? xcd * (q + 1) : r * (q + 1) + (xcd - r) * q) + off; }
        const int nig = WGM * nN, gid = wgid / nig, fm = gid * WGM, gsz = (nM - fm) < WGM ? (nM - fm) : WGM;
        u.pm = fm + ((wgid % nig) % gsz); u.pn = (wgid % nig) / gsz; return true;
    }
    __device__ __forceinline__ void a_ready(const Unit&) const {}
    __device__ __forceinline__ void done(const Unit&) const {}
};

__device__ __forceinline__ unsigned cvt_pk_bf16(float lo, float hi) { typedef float f2_t __attribute__((ext_vector_type(2))); typedef __bf16 b2_t __attribute__((ext_vector_type(2))); f2_t v = {lo, hi}; b2_t b = __builtin_convertvector(v, b2_t); return __builtin_bit_cast(unsigned, b); }
template <class Epi, class Sched, bool ALIGN_EPI = false, bool SP2 = false>
__device__ __forceinline__ void gemm_phase(PG8_LAS unsigned char* lds, const Gemm g, const Sched& S, const Epi& E) {
    int tid_ = threadIdx.x; asm volatile("" : "+v"(tid_));
    const int tid = tid_, wid = __builtin_amdgcn_readfirstlane(tid >> 6), lane = tid & 63, wr = wid >> 2, wc = wid & 3, fr = lane & 15, fq = lane >> 4;
    const int K = g.K, nt = K / BK;
    unsigned voffA[2], voffB[2];
#pragma unroll
    for (int i = 0; i < 2; ++i) { int R, C; stage_rc(tid * 16 + i * 8192, R, C); const int Rb = Epi::PERM ? ((R & ~31) + perm32(R & 31)) : R;
        voffA[i] = (unsigned)(R * K + C) * 2u; voffB[i] = (unsigned)(Rb * K + C) * 2u; }
    const size_t kstep = (size_t)(BK * 2);
    const size_t hstep = (size_t)HALF * K * 2;
    const size_t tstep = 2 * hstep;
    const unsigned ldsw = (unsigned)wid * 1024u;
    const int aoff = lds_byte(wr * 64 + fr, fq * 8), boff = lds_byte(wc * 32 + fr, fq * 8);
#define PG8_SA(b, h) (((b) * 2 + (h)) * HTB)
#define PG8_SB(b, h) ((4 + (b) * 2 + (h)) * HTB)
#define PG8_STAGE(bufoff, gbase, voff) do { _Pragma("unroll") for (int _i = 0; _i < 2; ++_i) \
        __builtin_amdgcn_global_load_lds((const unsigned*)((const char*)(gbase) + (voff)[_i]), (PG8_LAS unsigned*)(lds + (bufoff) + ldsw + _i * 8192), 16, 0, 0); } while (0)
#define PG8_LDA(dst, b, h) do { _Pragma("unroll") for (int m = 0; m < 4; ++m) _Pragma("unroll") for (int k = 0; k < 2; ++k) dst[m][k] = *(const PG8_LAS bf16x8*)(lds + PG8_SA(b, h) + aoff + m * 2048 + k * 1024); } while (0)
#define PG8_LDB(dst, b, h) do { _Pragma("unroll") for (int n = 0; n < 2; ++n) _Pragma("unroll") for (int k = 0; k < 2; ++k) dst[n][k] = *(const PG8_LAS bf16x8*)(lds + PG8_SB(b, h) + boff + n * 2048 + k * 1024); } while (0)
#define PG8_MMA(ai, bj, At, Bt) do { __builtin_amdgcn_s_setprio(1); _Pragma("unroll") for (int m = 0; m < 4; ++m) _Pragma("unroll") for (int n = 0; n < 2; ++n) _Pragma("unroll") for (int k = 0; k < 2; ++k) \
        acc[ai][bj][m][n] = __builtin_amdgcn_mfma_f32_16x16x32_bf16(Bt[n][k], At[m][k], acc[ai][bj][m][n], 0, 0, 0); __builtin_amdgcn_s_setprio(0); } while (0)
#define PG8_WAIT_V(n) asm volatile("s_waitcnt vmcnt(" #n ")" ::: "memory")
#define PG8_WAIT_L(n) asm volatile("s_waitcnt lgkmcnt(" #n ")" ::: "memory")
#define PG8_BAR __builtin_amdgcn_s_barrier()
#define PG8_SCHED __builtin_amdgcn_sched_barrier(0)
    Unit cur, nxt; int ui = 0;
    if (!S.next(0, cur)) return;
    f32x4 acc[2][2][4][2];
#pragma unroll
    for (int a = 0; a < 2; ++a)
#pragma unroll
        for (int b = 0; b < 2; ++b)
#pragma unroll
            for (int m = 0; m < 4; ++m)
#pragma unroll
                for (int n = 0; n < 2; ++n) acc[a][b][m][n] = (f32x4){0.f, 0.f, 0.f, 0.f};
    bf16x8 At[4][2], B0[2][2], B1[2][2];
    const char* cA = (const char*)g.A + (size_t)cur.pm * tstep; const char* cB = (const char*)g.Bt + (size_t)cur.pn * tstep;
    S.a_ready(cur);
    if constexpr (SP2) {
        PG8_STAGE(PG8_SB(0, 0), cB, voffB); PG8_STAGE(PG8_SB(0, 1), cB + hstep, voffB); PG8_STAGE(PG8_SA(0, 0), cA, voffA); PG8_STAGE(PG8_SA(0, 1), cA + hstep, voffA);
        if (wr == 1) PG8_BAR;
        PG8_WAIT_V(2); PG8_BAR;
        PG8_STAGE(PG8_SB(1, 0), cB + kstep, voffB); PG8_STAGE(PG8_SA(1, 0), cA + kstep, voffA); PG8_STAGE(PG8_SB(1, 1), cB + hstep + kstep, voffB);
        PG8_WAIT_V(6); PG8_BAR;
    } else {
        PG8_STAGE(PG8_SB(0, 0), cB, voffB); PG8_STAGE(PG8_SA(0, 0), cA, voffA); PG8_STAGE(PG8_SB(0, 1), cB + hstep, voffB); PG8_STAGE(PG8_SA(0, 1), cA + hstep, voffA);
        if (wr == 1) PG8_BAR;
        PG8_WAIT_V(4); PG8_BAR;
        PG8_STAGE(PG8_SB(1, 0), cB + kstep, voffB); PG8_STAGE(PG8_SA(1, 0), cA + kstep, voffA); PG8_STAGE(PG8_SB(1, 1), cB + hstep + kstep, voffB);
        PG8_WAIT_V(6); PG8_BAR;
    }
    for (;;) {
        const bool has_next = S.next(ui + 1, nxt);
        const char* nA = has_next ? (const char*)g.A + (size_t)nxt.pm * tstep : cA; const char* nB = has_next ? (const char*)g.Bt + (size_t)nxt.pn * tstep : cB;
        for (int t = 0; t < nt; t += 2) {
            const bool last = (t == nt - 2);
            const char* a1 = cA + (size_t)(t + 1) * kstep;
            const char* a2 = last ? nA : cA + (size_t)(t + 2) * kstep; const char* b2 = last ? nB : cB + (size_t)(t + 2) * kstep;
            const char* a3 = a2 + kstep; const char* b3 = b2 + kstep;
            if (last && has_next) S.a_ready(nxt);
            if constexpr (SP2) {
            PG8_LDB(B0, 0, 0); PG8_LDB(B1, 0, 1); PG8_SCHED; PG8_LDA(At, 0, 0); PG8_STAGE(PG8_SA(1, 1), a1 + hstep, voffA);
            PG8_WAIT_V(8); PG8_WAIT_L(0); PG8_BAR; PG8_MMA(0, 0, At, B0); PG8_MMA(0, 1, At, B1); PG8_BAR; PG8_SCHED;
            PG8_LDA(At, 0, 1); PG8_STAGE(PG8_SB(0, 0), b2, voffB); PG8_STAGE(PG8_SB(0, 1), b2 + hstep, voffB); PG8_STAGE(PG8_SA(0, 0), a2, voffA);
            PG8_WAIT_V(8); PG8_WAIT_L(0); PG8_BAR; PG8_MMA(1, 0, At, B0); PG8_MMA(1, 1, At, B1); PG8_BAR; PG8_SCHED;
            PG8_LDB(B0, 1, 0); PG8_LDB(B1, 1, 1); PG8_SCHED; PG8_LDA(At, 1, 0); PG8_STAGE(PG8_SA(0, 1), a2 + hstep, voffA);
            PG8_WAIT_V(8); PG8_WAIT_L(0); PG8_BAR; PG8_MMA(0, 0, At, B0); PG8_MMA(0, 1, At, B1); PG8_BAR; PG8_SCHED;
            PG8_LDA(At, 1, 1); PG8_STAGE(PG8_SB(1, 0), b3, voffB); PG8_STAGE(PG8_SB(1, 1), b3 + hstep, voffB); PG8_STAGE(PG8_SA(1, 0), a3, voffA);
            PG8_WAIT_V(8); PG8_WAIT_L(0); PG8_BAR; PG8_MMA(1, 0, At, B0); PG8_MMA(1, 1, At, B1); PG8_BAR; PG8_SCHED;
            } else {
            PG8_LDB(B0, 0, 0); PG8_SCHED; PG8_LDA(At, 0, 0); PG8_STAGE(PG8_SA(1, 1), a1 + hstep, voffA);
            PG8_WAIT_L(8); PG8_BAR; PG8_WAIT_L(0); PG8_MMA(0, 0, At, B0); PG8_BAR; PG8_SCHED;
            PG8_LDB(B1, 0, 1); PG8_STAGE(PG8_SB(0, 0), b2, voffB);
            PG8_BAR; PG8_WAIT_L(0); PG8_MMA(0, 1, At, B1); PG8_BAR;
            PG8_LDA(At, 0, 1); PG8_STAGE(PG8_SA(0, 0), a2, voffA);
            PG8_BAR; PG8_WAIT_L(0); PG8_MMA(1, 0, At, B0); PG8_BAR; PG8_SCHED;
            PG8_STAGE(PG8_SB(0, 1), b2 + hstep, voffB);
            PG8_WAIT_V(6); PG8_BAR; PG8_MMA(1, 1, At, B1); PG8_BAR;
            PG8_LDB(B0, 1, 0); PG8_SCHED; PG8_LDA(At, 1, 0); PG8_STAGE(PG8_SA(0, 1), a2 + hstep, voffA);
            PG8_WAIT_L(8); PG8_BAR; PG8_WAIT_L(0); PG8_MMA(0, 0, At, B0); PG8_BAR; PG8_SCHED;
            PG8_LDB(B1, 1, 1); PG8_STAGE(PG8_SB(1, 0), b3, voffB);
            PG8_BAR; PG8_WAIT_L(0); PG8_MMA(0, 1, At, B1); PG8_BAR;
            PG8_LDA(At, 1, 1); PG8_STAGE(PG8_SA(1, 0), a3, voffA);
            PG8_BAR; PG8_WAIT_L(0); PG8_MMA(1, 0, At, B0); PG8_BAR; PG8_SCHED;
            PG8_STAGE(PG8_SB(1, 1), b3 + hstep, voffB);
            PG8_WAIT_V(6); PG8_BAR; PG8_MMA(1, 1, At, B1); PG8_BAR;
            }
        }
        if constexpr (ALIGN_EPI) { if (wr == 0) PG8_BAR; }
        if constexpr (!Epi::AFTER_DRAIN) { E(acc, cur, wr, wc, fr, fq); S.done(cur); }
        if (!has_next) break;
#pragma unroll
        for (int a = 0; a < 2; ++a)
#pragma unroll
            for (int b = 0; b < 2; ++b)
#pragma unroll
                for (int m = 0; m < 4; ++m)
#pragma unroll
                    for (int n = 0; n < 2; ++n) acc[a][b][m][n] = (f32x4){0.f, 0.f, 0.f, 0.f};
        cur = nxt; cA = nA; cB = nB; ++ui;
        if constexpr (ALIGN_EPI) { if (wr == 1) PG8_BAR; }
    }
    PG8_WAIT_V(0);
    if constexpr (!ALIGN_EPI) { if (wr == 0) PG8_BAR; }
    PG8_BAR;
    if constexpr (Epi::AFTER_DRAIN) { E.fused(acc, cur, wr, wc, fr, fq, lds, wid, lane); S.done(cur); }
#undef PG8_SA
#undef PG8_SB
#undef PG8_STAGE
#undef PG8_LDA
#undef PG8_LDB
#undef PG8_MMA
#undef PG8_WAIT_V
#undef PG8_WAIT_L
#undef PG8_BAR
#undef PG8_SCHED
}
}

#define DI __device__ __forceinline__
#define LAS __attribute__((address_space(3)))
typedef unsigned short bf16_t;
typedef short bf16x8 __attribute__((ext_vector_type(8)));
typedef _Float16 f16x8 __attribute__((ext_vector_type(8)));
typedef float f32x4 __attribute__((ext_vector_type(4)));
typedef float f32x16 __attribute__((ext_vector_type(16)));
typedef unsigned u32x4 __attribute__((ext_vector_type(4)));
typedef unsigned u32x2 __attribute__((ext_vector_type(2)));

constexpr int NB = 4, SEQ = 4096, T = NB * SEQ, D = 1024, DEPTH = 2;
constexpr int PLD = 3912;
constexpr int PC_Q = 0, PC_K = 512, PC_V = 1024, PC_QI = 1536, PC_KI = 2048, PC_WI = 2112;
constexpr int PC_R = 2120, PC_BK = 2632, PC_BV = 3144, PC_WD = 3656;
constexpr int NPROJ_PAD = 4096;
constexpr int NEXP = 16, DEXP = 256, PLE = 256;
constexpr float ALPHA = 1.4142135623730951f;
constexpr float LN_EPS = 1e-5f, GN_EPS = 64e-5f;
constexpr int MAXROWS = 2 * T + NEXP * 256;
constexpr int NWAVES = 8, NTHR = 512;

constexpr size_t MiB = 1u << 20;
constexpr size_t WS_CTL = 0, CTL_BYTES = 1 * MiB;
constexpr size_t WS_WEXP = 1 * MiB;
constexpr size_t WS_WDOWN = 17 * MiB;
constexpr size_t WS_WOUT = 25 * MiB, WS_WPG = 27 * MiB, WS_WPLE = 29 * MiB;
constexpr size_t WS_BM = 30 * MiB;
constexpr size_t WS_ELL = 38 * MiB, WS_AA = 70 * MiB, WS_GG = 102 * MiB;
constexpr size_t WS_PROJ = 119 * MiB;
constexpr size_t WS_PBF = 242 * MiB;
constexpr size_t WS_V = 119 * MiB;
constexpr size_t WS_AG = 38 * MiB;
constexpr size_t WS_H = 183 * MiB;
constexpr size_t WS_Y = 119 * MiB;
constexpr size_t WS_PE = 201 * MiB;
constexpr size_t WS_V3 = 38 * MiB;
constexpr size_t WS_TOK = 233 * MiB;
constexpr size_t WS_ROW = 234 * MiB;
constexpr int CW_GCNT = 1024;

struct TokInfo { int e0, e1, p0, p1; float g0, g1; int pad0, pad1; };
struct RowInfo { int token, slot; float gate; int pad; };

#define LDS_WAIT() asm volatile("s_waitcnt lgkmcnt(0)" ::: "memory")
#define VM_WAIT() asm volatile("s_waitcnt vmcnt(0)" ::: "memory")
DI unsigned f2bf(float f) { unsigned u = __builtin_bit_cast(unsigned, f); return (u + 0x7fffu + ((u >> 16) & 1u)) >> 16; }
DI unsigned pk2(float lo, float hi) { return pg8::cvt_pk_bf16(lo, hi); }
DI float bf2f(unsigned short b) { return __builtin_bit_cast(float, (unsigned)b << 16); }
DI float bflo(unsigned w) { return __builtin_bit_cast(float, w << 16); }
DI float bfhi(unsigned w) { return __builtin_bit_cast(float, w & 0xffff0000u); }
DI unsigned pk2h(float lo, float hi) { typedef _Float16 h2_t __attribute__((ext_vector_type(2))); h2_t v = {(_Float16)lo, (_Float16)hi}; return __builtin_bit_cast(unsigned, v); }
DI float wave_sum(float v) {
#pragma unroll
    for (int o = 1; o < 64; o <<= 1) v += __shfl_xor(v, o);
    return v;
}
DI int opaque_i(int v) { asm volatile("" : "+s"(v)); return v; }
DI float sigmoidf_(float x) { return 1.f / (1.f + __expf(-x)); }

struct Args { const float* in[31]; float* out; unsigned char* ws; int ph_lo, ph_hi; };
struct Ctx {
    LAS unsigned char* lds;
    int tid, lane, wave, G, blk;
    const __attribute__((address_space(4))) Args* ap;
    float* out; unsigned char* ws;
    unsigned* ctl;
    bf16_t* xcur; bf16_t* mixcat;
    DI const float* in(int i) const { return ap->in[i]; }
};

DI void ln16(f32x4 (&v)[4], const float* g, const float* b, int lane) {
    float s = 0.f;
#pragma unroll
    for (int j = 0; j < 4; ++j) s += (v[j].x + v[j].y) + (v[j].z + v[j].w);
    const float mean = wave_sum(s) * (1.f / D);
    float s2 = 0.f;
#pragma unroll
    for (int j = 0; j < 4; ++j) { v[j] = v[j] - mean; s2 += (v[j].x * v[j].x + v[j].y * v[j].y) + (v[j].z * v[j].z + v[j].w * v[j].w); }
    const float rstd = 1.f / sqrtf(wave_sum(s2) * (1.f / D) + LN_EPS);
#pragma unroll
    for (int j = 0; j < 4; ++j) { const f32x4 gg = *(const f32x4*)(g + 256 * j + 4 * lane), bb = *(const f32x4*)(b + 256 * j + 4 * lane); v[j] = v[j] * rstd * gg + bb; }
}
DI void store_row_bf16(bf16_t* row, const f32x4 (&v)[4], int lane) {
#pragma unroll
    for (int j = 0; j < 4; ++j) { u32x2 o; o.x = pk2(v[j].x, v[j].y); o.y = pk2(v[j].z, v[j].w); *(u32x2*)(row + 256 * j + 4 * lane) = o; }
}
DI void load_row_bf16(const bf16_t* row, f32x4 (&v)[4], int lane) {
#pragma unroll
    for (int j = 0; j < 4; ++j) { const u32x2 o = *(const u32x2*)(row + 256 * j + 4 * lane); v[j] = (f32x4){bflo(o.x), bfhi(o.x), bflo(o.y), bfhi(o.y)}; }
}

template <class ColPtr>
DI void transpose_item(const ColPtr colptr, int ld, int K, bf16_t* WT, int n0, int k0, LAS float* scr, int lane) {
    const float* sp = colptr(n0 + (lane & 31));
#pragma unroll 8
    for (int i = 0; i < 32; ++i) { const int kk = 2 * i + (lane >> 5); scr[kk * 33 + (lane & 31)] = sp ? sp[(size_t)(k0 + kk) * ld] : 0.f; }
    LDS_WAIT(); asm volatile("" ::: "memory");
    const int c = lane & 7;
#pragma unroll
    for (int j = 0; j < 4; ++j) { const int n = (lane >> 3) + 8 * j; const LAS float* s = scr + (8 * c) * 33 + n;
        u32x4 o; o.x = pk2(s[0 * 33], s[1 * 33]); o.y = pk2(s[2 * 33], s[3 * 33]); o.z = pk2(s[4 * 33], s[5 * 33]); o.w = pk2(s[6 * 33], s[7 * 33]);
        *(u32x4*)(WT + (size_t)(n0 + n) * K + k0 + 8 * c) = o; }
    LDS_WAIT(); asm volatile("" ::: "memory");
}
template <class ColPtr>
DI void convert_matrix(Ctx& C, const ColPtr colptr, int ld, int K, int N, bf16_t* WT, int& first) {
    LAS float* scr = (LAS float*)(C.lds + C.wave * 16384);
    const int gw = C.blk * NWAVES + C.wave, NGW = C.G * NWAVES;
    const int nblk = N / 32, nitems = (K / 64) * nblk;
    int it = gw - (first % NGW); if (it < 0) it += NGW;
    for (; it < nitems; it += NGW) transpose_item(colptr, ld, K, WT, 32 * (it % nblk), 64 * (it / nblk), scr, C.lane);
    first += nitems;
}

struct ColWin { const float* w; DI const float* operator()(int j) const { if (j < 2120) return w + j; if (j >= 2176 && j < 3968) return w + (j - 56); return nullptr; } };
struct ColPlain { const float* w; DI const float* operator()(int j) const { return w + j; } };
struct ColGateUp { const float* wg; const float* wu; DI const float* operator()(int j) const {
        const int e = j >> 9, pn = (j >> 8) & 1, jj = j & 255; const int col = pn * 128 + (jj & 127); const uintptr_t pg = (uintptr_t)wg, pu = (uintptr_t)wu; const uintptr_t sel = pg + ((jj >= 128) ? (pu - pg) : (uintptr_t)0); return (const float*)sel + (size_t)e * D * DEXP + col; } };
struct ColDown { const float* wd; DI const float* operator()(int j) const { return wd + j; } };

DI void phase_ln_in(Ctx& C) {
    const int gw = C.blk * NWAVES + C.wave, NGW = C.G * NWAVES;
    for (int m = gw; m < T; m += NGW) {
        f32x4 v[4]; const float* xr = C.in(0) + (size_t)m * D;
#pragma unroll
        for (int j = 0; j < 4; ++j) v[j] = *(const f32x4*)(xr + 256 * j + 4 * C.lane);
        ln16(v, C.in(2), C.in(3), C.lane);
        store_row_bf16(C.xcur + (size_t)m * D, v, C.lane);
    }
}
DI void convert_win(Ctx& C, int l) { int first = 0; ColWin cw{C.in(4) + (size_t)l * D * 3912}; convert_matrix(C, cw, 3912, D, NPROJ_PAD, (bf16_t*)(C.ws + WS_WEXP), first); }
DI void convert_layer_weights(Ctx& C, int l) {
    int first = 0;
    { ColPlain c{C.in(5) + (size_t)l * D * D}; convert_matrix(C, c, D, D, D, (bf16_t*)(C.ws + WS_WOUT), first); }
    { ColGateUp c{C.in(20) + (size_t)l * NEXP * D * DEXP, C.in(21) + (size_t)l * NEXP * D * DEXP}; convert_matrix(C, c, DEXP, D, NEXP * 512, (bf16_t*)(C.ws + WS_WEXP), first); }
    for (int e = 0; e < NEXP; ++e) { ColDown c{C.in(22) + ((size_t)l * NEXP + e) * DEXP * D}; convert_matrix(C, c, D, DEXP, D, (bf16_t*)(C.ws + WS_WDOWN) + (size_t)e * D * DEXP, first); }
    { ColPlain c{C.in(24) + (size_t)l * D * D}; convert_matrix(C, c, D, D, D, (bf16_t*)(C.ws + WS_WPG), first); }
    { ColPlain c{C.in(23) + (size_t)l * PLE * D}; convert_matrix(C, c, D, PLE, D, (bf16_t*)(C.ws + WS_WPLE), first); }
    const float* p = C.in(1) + (size_t)l * T * PLE; bf16_t* pb = (bf16_t*)(C.ws + WS_PBF);
    for (size_t i = ((size_t)C.blk * NTHR + C.tid) * 8; i < (size_t)T * PLE; i += (size_t)C.G * NTHR * 8) {
        const f32x4 a = *(const f32x4*)(p + i), b = *(const f32x4*)(p + i + 4);
        u32x4 o; o.x = pk2(a.x, a.y); o.y = pk2(a.z, a.w); o.z = pk2(b.x, b.y); o.w = pk2(b.z, b.w); *(u32x4*)(pb + i) = o; }
}

struct EpiProj {
    static constexpr bool PERM = true, AFTER_DRAIN = false;
    bf16_t* P;
    DI void operator()(const f32x4 (&acc)[2][2][4][2], const pg8::Unit& u, int wr, int wc, int fr, int fq) const {
        const int row0 = u.pm * 256 + wr * 64 + fr;
#pragma unroll
        for (int bj = 0; bj < 2; ++bj) {
            const int j0 = u.pn * 256 + bj * 128 + wc * 32 + 8 * fq;
            int dst; bool half = false;
            if (j0 < 2120) { dst = j0; half = (j0 >= 1536); } else if (j0 >= 2176 && j0 < 3968) dst = j0 - 56; else dst = -1;
            if (dst >= 0) {
#pragma unroll
                for (int ai = 0; ai < 2; ++ai)
#pragma unroll
                    for (int m = 0; m < 4; ++m) {
                        const f32x4 v0 = acc[ai][bj][m][0], v1 = acc[ai][bj][m][1]; u32x4 w;
                        if (half) { w.x = pk2h(v0[0], v0[1]); w.y = pk2h(v0[2], v0[3]); w.z = pk2h(v1[0], v1[1]); w.w = pk2h(v1[2], v1[3]); }
                        else { w.x = pk2(v0[0], v0[1]); w.y = pk2(v0[2], v0[3]); w.z = pk2(v1[0], v1[1]); w.w = pk2(v1[2], v1[3]); }
                        *(u32x4*)(P + (size_t)(row0 + ai * 128 + m * 16) * PLD + dst) = w; }
            }
        }
    }
};
struct EpiBf16Plain {
    static constexpr bool PERM = true, AFTER_DRAIN = false;
    bf16_t* O; int ldc;
    DI void operator()(const f32x4 (&acc)[2][2][4][2], const pg8::Unit& u, int wr, int wc, int fr, int fq) const {
        const int row0 = u.pm * 256 + wr * 64 + fr, col0 = u.pn * 256 + wc * 32 + 8 * fq;
#pragma unroll
        for (int ai = 0; ai < 2; ++ai)
#pragma unroll
            for (int m = 0; m < 4; ++m)
#pragma unroll
                for (int bj = 0; bj < 2; ++bj) { const f32x4 v0 = acc[ai][bj][m][0], v1 = acc[ai][bj][m][1]; u32x4 w; w.x = pk2(v0[0], v0[1]); w.y = pk2(v0[2], v0[3]); w.z = pk2(v1[0], v1[1]); w.w = pk2(v1[2], v1[3]);
                    *(u32x4*)(O + (size_t)(row0 + ai * 128 + m * 16) * ldc + col0 + bj * 128) = w; }
    }
};
struct EpiResF32 {
    static constexpr bool PERM = false, AFTER_DRAIN = false;
    const bf16_t* X; float* V;
    DI void operator()(const f32x4 (&acc)[2][2][4][2], const pg8::Unit& u, int wr, int wc, int fr, int fq) const {
        const int row0 = u.pm * 256 + wr * 64 + fr, col0 = u.pn * 256 + wc * 32 + 4 * fq;
#pragma unroll
        for (int ai = 0; ai < 2; ++ai)
#pragma unroll
            for (int m = 0; m < 4; ++m)
#pragma unroll
                for (int bj = 0; bj < 2; ++bj)
#pragma unroll
                    for (int n = 0; n < 2; ++n) { const size_t off = (size_t)(row0 + ai * 128 + m * 16) * D + col0 + bj * 128 + n * 16;
                        const u32x2 xb = *(const u32x2*)(X + off); const f32x4 xv = {bflo(xb.x), bfhi(xb.x), bflo(xb.y), bfhi(xb.y)};
                        *(f32x4*)(V + off) = xv * ALPHA + acc[ai][bj][m][n]; }
    }
};
struct EpiPle {
    static constexpr bool PERM = false, AFTER_DRAIN = false;
    const bf16_t* X; const bf16_t* PE; float* V;
    DI void operator()(const f32x4 (&acc)[2][2][4][2], const pg8::Unit& u, int wr, int wc, int fr, int fq) const {
        const int row0 = u.pm * 256 + wr * 64 + fr, col0 = u.pn * 256 + wc * 32 + 4 * fq;
#pragma unroll
        for (int ai = 0; ai < 2; ++ai)
#pragma unroll
            for (int m = 0; m < 4; ++m)
#pragma unroll
                for (int bj = 0; bj < 2; ++bj)
#pragma unroll
                    for (int n = 0; n < 2; ++n) { const size_t off = (size_t)(row0 + ai * 128 + m * 16) * D + col0 + bj * 128 + n * 16;
                        const u32x2 xb = *(const u32x2*)(X + off); const f32x4 xv = {bflo(xb.x), bfhi(xb.x), bflo(xb.y), bfhi(xb.y)};
                        const u32x2 pb = *(const u32x2*)(PE + off); const f32x4 pv = {bflo(pb.x), bfhi(pb.x), bflo(pb.y), bfhi(pb.y)};
                        const f32x4 a = acc[ai][bj][m][n]; f32x4 s; s.x = sigmoidf_(a.x); s.y = sigmoidf_(a.y); s.z = sigmoidf_(a.z); s.w = sigmoidf_(a.w);
                        *(f32x4*)(V + off) = xv * ALPHA + s * pv; }
    }
};
struct EpiSwiGLU {
    static constexpr bool PERM = true, AFTER_DRAIN = false;
    bf16_t* H; const RowInfo* R;
    DI void operator()(const f32x4 (&acc)[2][2][4][2], const pg8::Unit& u, int wr, int wc, int fr, int fq) const {
        const int row0 = u.pm * 256 + wr * 64 + fr, col0 = (u.pn & 1) * 128 + wc * 32 + 8 * fq;
#pragma unroll
        for (int ai = 0; ai < 2; ++ai)
#pragma unroll
            for (int m = 0; m < 4; ++m) { const int row = row0 + ai * 128 + m * 16; const float gw = R[row].gate;
                float h[8];
#pragma unroll
                for (int n = 0; n < 2; ++n)
#pragma unroll
                    for (int i = 0; i < 4; ++i) { const float g = acc[ai][0][m][n][i], up = acc[ai][1][m][n][i]; h[4 * n + i] = g * sigmoidf_(g) * up * gw; }
                u32x4 w; w.x = pk2(h[0], h[1]); w.y = pk2(h[2], h[3]); w.z = pk2(h[4], h[5]); w.w = pk2(h[6], h[7]);
                *(u32x4*)(H + (size_t)row * DEXP + col0) = w; }
    }
};
struct EpiDown {
    static constexpr bool PERM = true, AFTER_DRAIN = false;
    bf16_t* Y; const RowInfo* R;
    DI void operator()(const f32x4 (&acc)[2][2][4][2], const pg8::Unit& u, int wr, int wc, int fr, int fq) const {
        const int row0 = u.pm * 256 + wr * 64 + fr, col0 = (u.pn & 3) * 256 + wc * 32 + 8 * fq;
#pragma unroll
        for (int ai = 0; ai < 2; ++ai)
#pragma unroll
            for (int m = 0; m < 4; ++m) { const int row = row0 + ai * 128 + m * 16; const RowInfo ri = R[row];
                if (ri.token >= 0) { bf16_t* dst = Y + ((size_t)ri.slot * T + ri.token) * D + col0;
#pragma unroll
                    for (int bj = 0; bj < 2; ++bj) { const f32x4 v0 = acc[ai][bj][m][0], v1 = acc[ai][bj][m][1]; u32x4 w; w.x = pk2(v0[0], v0[1]); w.y = pk2(v0[2], v0[3]); w.z = pk2(v1[0], v1[1]); w.w = pk2(v1[2], v1[3]);
                        *(u32x4*)(dst + bj * 128) = w; } } }
    }
};
template <int NPN> struct GroupedOrder {
    const LAS int* texp; int ntiles, G, c;
    DI bool next(int i, pg8::Unit& u) const { const int L = i * G + c; if (L >= ntiles * NPN) return false; u.pm = L / NPN; u.pn = texp[u.pm] * NPN + (L % NPN); return true; }
    DI void a_ready(const pg8::Unit&) const {}
    DI void done(const pg8::Unit&) const {}
};

constexpr int IDX_CAP = 512;
DI unsigned ordkey(float s) { const unsigned b = __builtin_bit_cast(unsigned, s); return (b & 0x80000000u) ? ~b : (b | 0x80000000u); }
DI float unordkey(unsigned k) { const unsigned b = (k & 0x80000000u) ? (k & 0x7fffffffu) : ~k; return __builtin_bit_cast(float, b); }

DI void idx_item(Ctx& C, int item, int l) {
    const int b = item & 3, qt = 511 - (item >> 2);
    const int t0 = qt * 8, chunk = t0 >> 6, NT32 = 2 * (chunk + 1);
    const size_t tok0 = (size_t)b * SEQ + t0;
    unsigned* bm = (unsigned*)(C.ws + WS_BM);
    const int lane = C.lane, wave = C.wave, tid = C.tid;
    if (chunk < 4) {
        if (tid < 8 * NT32) { const int q = tid / NT32, kt = tid % NT32; bm[(tok0 + q) * 128 + kt] = 0xffffffffu; }
        return;
    }
    const _Float16* ph = (const _Float16*)(C.ws + WS_PROJ);
    LAS unsigned* hist = (LAS unsigned*)(C.lds);
    LAS float* candS = (LAS float*)(C.lds + 8192);
    LAS int* candI = (LAS int*)(C.lds + 24576);
    LAS float* redmn = (LAS float*)(C.lds + 40960);
    LAS float* redmx = redmn + 64;
    LAS int* selB = (LAS int*)(C.lds + 41472);
    LAS unsigned* selAbove = (LAS unsigned*)(selB + 8);
    LAS unsigned* ccount = selAbove + 8;
    LAS float* thrS = (LAS float*)(ccount + 8);
    LAS int* thrI = (LAS int*)(thrS + 8);
    LAS unsigned* ovf = (LAS unsigned*)(thrI + 8);
    LAS unsigned* fbT = ovf + 8;
    LAS unsigned* fbCnt = fbT + 8;
    LAS unsigned* fbNeed = fbCnt + 8;
    const int r = lane & 31, hh = lane >> 5;
    float sc[2][16][2];
#pragma unroll
    for (int m = 0; m < 2; ++m) {
        f16x8 afr[4]; float wq[2][8];
        {
            const int gq = (r >> 2) & 1, i = r >> 3, jj = r & 3, query = 4 * m + 2 * gq + (i >> 1), head = 4 * (i & 1) + jj;
            const _Float16* qp = ph + (tok0 + query) * PLD + PC_QI + head * 64 + 8 * hh;
#pragma unroll
            for (int s = 0; s < 4; ++s) afr[s] = *(const f16x8*)(qp + 16 * s);
#pragma unroll
            for (int qq = 0; qq < 2; ++qq) { const int q2 = 4 * m + 2 * hh + qq; const f16x8 wv = *(const f16x8*)(ph + (tok0 + q2) * PLD + PC_WI);
#pragma unroll
                for (int e = 0; e < 8; ++e) wq[qq][e] = (float)wv[e] * 0.044194173824159216f; }
        }
#pragma unroll
        for (int it = 0; it < 16; ++it) {
            const int kt = wave + 8 * it;
            if (kt < NT32) {
                const _Float16* kp = ph + ((size_t)b * SEQ + 32 * kt + r) * PLD + PC_KI + 8 * hh;
                f32x16 c = {};
#pragma unroll
                for (int s = 0; s < 4; ++s) { const f16x8 bfr = *(const f16x8*)(kp + 16 * s); c = __builtin_amdgcn_mfma_f32_32x32x16_f16(afr[s], bfr, c, 0, 0, 0); }
#pragma unroll
                for (int qq = 0; qq < 2; ++qq) { float a = 0.f;
#pragma unroll
                    for (int e = 0; e < 8; ++e) a += wq[qq][e] * fmaxf(c[8 * qq + e], 0.f);
                    sc[m][it][qq] = a; }
            } else { sc[m][it][0] = 0.f; sc[m][it][1] = 0.f; }
            __builtin_amdgcn_sched_barrier(0);
        }
    }
    float mn[2][2], mx[2][2];
#pragma unroll
    for (int m = 0; m < 2; ++m)
#pragma unroll
        for (int qq = 0; qq < 2; ++qq) { float a = 3.0e38f, z = -3.0e38f;
#pragma unroll
            for (int it = 0; it < 16; ++it) if (wave + 8 * it < NT32) { a = fminf(a, sc[m][it][qq]); z = fmaxf(z, sc[m][it][qq]); }
#pragma unroll
            for (int o = 1; o < 32; o <<= 1) { a = fminf(a, __shfl_xor(a, o)); z = fmaxf(z, __shfl_xor(z, o)); }
            mn[m][qq] = a; mx[m][qq] = z; }
    __syncthreads();
    if (r == 0) {
#pragma unroll
        for (int m = 0; m < 2; ++m)
#pragma unroll
            for (int qq = 0; qq < 2; ++qq) { const int qid = 4 * m + 2 * hh + qq; redmn[wave * 8 + qid] = mn[m][qq]; redmx[wave * 8 + qid] = mx[m][qq]; }
    }
    for (int i = tid; i < 2048; i += NTHR) hist[i] = 0u;
    if (tid < 8) { ccount[tid] = 0u; ovf[tid] = 0u; }
    __syncthreads();
    float lo[2][2], scl[2][2];
#pragma unroll
    for (int m = 0; m < 2; ++m)
#pragma unroll
        for (int qq = 0; qq < 2; ++qq) { const int qid = 4 * m + 2 * hh + qq; float a = 3.0e38f, z = -3.0e38f;
#pragma unroll
            for (int w = 0; w < 8; ++w) { a = fminf(a, redmn[w * 8 + qid]); z = fmaxf(z, redmx[w * 8 + qid]); }
            lo[m][qq] = a; scl[m][qq] = (z > a) ? 256.f / (z - a) : 0.f; }
#define IDX_BIN(m, it, qq) min(255, (int)((sc[m][it][qq] - lo[m][qq]) * scl[m][qq]))
#define IDX_LAUNDER() do { _Pragma("unroll") for (int m_ = 0; m_ < 2; ++m_) _Pragma("unroll") for (int q_ = 0; q_ < 2; ++q_) { asm volatile("" : "+v"(lo[m_][q_]), "+v"(scl[m_][q_])); } } while (0)
#pragma unroll
    for (int m = 0; m < 2; ++m)
#pragma unroll
        for (int qq = 0; qq < 2; ++qq) { const int qid = 4 * m + 2 * hh + qq;
#pragma unroll
            for (int it = 0; it < 16; ++it) if (wave + 8 * it < NT32) __hip_atomic_fetch_add(hist + qid * 256 + IDX_BIN(m, it, qq), 1u, __ATOMIC_RELAXED, __HIP_MEMORY_SCOPE_WORKGROUP); }
    __syncthreads();
    {
        const u32x4 h4 = *(const LAS u32x4*)(hist + wave * 256 + 4 * lane);
        const unsigned tot = h4.x + h4.y + h4.z + h4.w; unsigned incl = tot;
#pragma unroll
        for (int o = 1; o < 64; o <<= 1) { const unsigned v = __shfl_down(incl, o); if (lane + o < 64) incl += v; }
        unsigned run = incl - tot; int Bf = -1; unsigned ab = 0;
#pragma unroll
        for (int j = 3; j >= 0; --j) { const unsigned h = h4[j]; if (run < 256u && run + h >= 256u) { Bf = 4 * lane + j; ab = run; } run += h; }
        if (Bf >= 0) { selB[wave] = Bf; selAbove[wave] = ab; }
    }
    __syncthreads();
    IDX_LAUNDER();
#pragma unroll
    for (int m = 0; m < 2; ++m)
#pragma unroll
        for (int qq = 0; qq < 2; ++qq) { const int qid = 4 * m + 2 * hh + qq; const int B = selB[qid];
#pragma unroll
            for (int it = 0; it < 16; ++it) if (wave + 8 * it < NT32) { if (IDX_BIN(m, it, qq) == B) { const unsigned pos = __hip_atomic_fetch_add(ccount + qid, 1u, __ATOMIC_RELAXED, __HIP_MEMORY_SCOPE_WORKGROUP);
                if (pos < (unsigned)IDX_CAP) { candS[qid * IDX_CAP + pos] = sc[m][it][qq]; candI[qid * IDX_CAP + pos] = 32 * (wave + 8 * it) + r; } } } }
    __syncthreads();
    {
        const int c = (int)ccount[wave]; const int need = 256 - (int)selAbove[wave];
        if (c <= IDX_CAP) {
            for (int i = lane; i < c; i += 64) { const float si = candS[wave * IDX_CAP + i]; const int ii = candI[wave * IDX_CAP + i]; int rank = 0;
                for (int j = 0; j < c; ++j) { const float sj = candS[wave * IDX_CAP + j]; const int ij = candI[wave * IDX_CAP + j]; rank += ((sj > si) || (sj == si && ij < ii)) ? 1 : 0; }
                if (rank == need - 1) { thrS[wave] = si; thrI[wave] = ii; } }
        } else if (lane == 0) { ovf[wave] = 1u; fbNeed[wave] = (unsigned)need; fbT[wave] = 0u; }
    }
    __syncthreads();
    unsigned anyovf = 0u;
#pragma unroll
    for (int q = 0; q < 8; ++q) anyovf |= ovf[q];
    if (anyovf) {
        for (int bit = 31; bit >= 0; --bit) {
            if (tid < 8) fbCnt[tid] = 0u;
            __syncthreads();
            IDX_LAUNDER();
#pragma unroll
            for (int m = 0; m < 2; ++m)
#pragma unroll
                for (int qq = 0; qq < 2; ++qq) { const int qid = 4 * m + 2 * hh + qq; if (ovf[qid]) { const unsigned cand = fbT[qid] | (1u << bit); const int B = selB[qid]; unsigned cnt = 0;
#pragma unroll
                    for (int it = 0; it < 16; ++it) if (wave + 8 * it < NT32) cnt += (IDX_BIN(m, it, qq) == B && ordkey(sc[m][it][qq]) >= cand) ? 1u : 0u;
                    if (cnt) __hip_atomic_fetch_add(fbCnt + qid, cnt, __ATOMIC_RELAXED, __HIP_MEMORY_SCOPE_WORKGROUP); } }
            __syncthreads();
            if (tid < 8 && ovf[tid] && fbCnt[tid] >= fbNeed[tid]) fbT[tid] |= (1u << bit);
            __syncthreads();
        }
        if (tid < 8) fbCnt[tid] = 0u;
        __syncthreads();
        IDX_LAUNDER();
#pragma unroll
        for (int m = 0; m < 2; ++m)
#pragma unroll
            for (int qq = 0; qq < 2; ++qq) { const int qid = 4 * m + 2 * hh + qq; if (ovf[qid]) { const unsigned Tk = fbT[qid]; const int B = selB[qid]; unsigned cnt = 0;
#pragma unroll
                for (int it = 0; it < 16; ++it) if (wave + 8 * it < NT32) cnt += (IDX_BIN(m, it, qq) == B && ordkey(sc[m][it][qq]) > Tk) ? 1u : 0u;
                if (cnt) __hip_atomic_fetch_add(fbCnt + qid, cnt, __ATOMIC_RELAXED, __HIP_MEMORY_SCOPE_WORKGROUP); } }
        __syncthreads();
        if (tid < 8 && ovf[tid]) { fbNeed[tid] -= fbCnt[tid]; thrS[tid] = unordkey(fbT[tid]); thrI[tid] = 0; }
        __syncthreads();
        for (int bit = 11; bit >= 0; --bit) {
            if (tid < 8) fbCnt[tid] = 0u;
            __syncthreads();
            IDX_LAUNDER();
#pragma unroll
            for (int m = 0; m < 2; ++m)
#pragma unroll
                for (int qq = 0; qq < 2; ++qq) { const int qid = 4 * m + 2 * hh + qq; if (ovf[qid]) { const unsigned Tk = fbT[qid]; const int B = selB[qid]; const int cand = thrI[qid] | (1 << bit); unsigned cnt = 0;
#pragma unroll
                    for (int it = 0; it < 16; ++it) if (wave + 8 * it < NT32) cnt += (IDX_BIN(m, it, qq) == B && ordkey(sc[m][it][qq]) == Tk && (32 * (wave + 8 * it) + r) < cand) ? 1u : 0u;
                    if (cnt) __hip_atomic_fetch_add(fbCnt + qid, cnt, __ATOMIC_RELAXED, __HIP_MEMORY_SCOPE_WORKGROUP); } }
            __syncthreads();
            if (tid < 8 && ovf[tid] && fbCnt[tid] < fbNeed[tid]) thrI[tid] |= (1 << bit);
            __syncthreads();
        }
    }
    IDX_LAUNDER();
#pragma unroll
    for (int m = 0; m < 2; ++m)
#pragma unroll
        for (int qq = 0; qq < 2; ++qq) { const int qid = 4 * m + 2 * hh + qq; const int B = selB[qid]; const float ts = thrS[qid]; const int ti = thrI[qid];
#pragma unroll
            for (int it = 0; it < 16; ++it) { const int kt = wave + 8 * it;
                if (kt < NT32) { const int bin = IDX_BIN(m, it, qq); const float s = sc[m][it][qq]; const int idx = 32 * kt + r;
                    const bool sel = (bin > B) || (bin == B && (s > ts || (s == ts && idx <= ti)));
                    const unsigned long long mk = __ballot(sel);
                    if (r == 0) bm[(tok0 + qid) * 128 + kt] = hh ? (unsigned)(mk >> 32) : (unsigned)mk; } } }
#undef IDX_BIN
#undef IDX_LAUNDER
}

DI float softplusf_(float z) { return fmaxf(z, 0.f) + log1pf(expf(-fabsf(z))); }
DI void rwkv_prep_item(Ctx& C, int item, int l) {
    const int b = item >> 6, ch = item & 63; const size_t tok0 = (size_t)b * SEQ + ch * 64;
    const bf16_t* proj = (const bf16_t*)(C.ws + WS_PROJ);
    LAS float* tl = (LAS float*)C.lds;
    const float* mu = C.in(6) + (size_t)l * 1792;
    __syncthreads();
    { const int col = C.tid & 255, th = C.tid >> 8; const float m_ = mu[1536 + col];
        for (int i = 0; i < 32; ++i) { const int tok = th * 32 + i; const int t = ch * 64 + tok;
            const float cur = bf2f(proj[(tok0 + tok) * PLD + PC_WD + col]); const float prev = t ? bf2f(proj[(tok0 + tok - 1) * PLD + PC_WD + col]) : 0.f;
            const float hs = cur + (prev - cur) * m_;
            tl[col * 64 + tok] = (col < 64) ? tanhf(hs) : (col < 128) ? hs : sigmoidf_(hs); } }
    __syncthreads();
    const int c = C.tid;
    float* ep = (float*)(C.ws + WS_ELL) + tok0 * 512 + c; float* apn = (float*)(C.ws + WS_AA) + tok0 * 512 + c; bf16_t* gp = (bf16_t*)(C.ws + WS_GG) + tok0 * 512 + c;
    float acc[64];
#pragma unroll
    for (int i = 0; i < 64; ++i) acc[i] = 0.f;
    { const float* W = C.in(8) + (size_t)l * 64 * 512 + c;
        for (int j = 0; j < 64; ++j) { const float w = W[(size_t)j * 512];
#pragma unroll
            for (int q = 0; q < 16; ++q) { const f32x4 t = *(const LAS f32x4*)(tl + j * 64 + 4 * q); acc[4 * q] += t.x * w; acc[4 * q + 1] += t.y * w; acc[4 * q + 2] += t.z * w; acc[4 * q + 3] += t.w * w; } }
        const float w0 = C.in(7)[l * 512 + c];
#pragma unroll
        for (int i = 0; i < 64; ++i) { const float lw = w0 + acc[i]; const float wl = -softplusf_(-lw) - 0.5f; *ep = -expf(wl); ep += 512; asm volatile("" : "+v"(ep)); acc[i] = 0.f; } }
    { const float* W = C.in(10) + (size_t)l * 64 * 512 + c;
        for (int j = 0; j < 64; ++j) { const float w = W[(size_t)j * 512];
#pragma unroll
            for (int q = 0; q < 16; ++q) { const f32x4 t = *(const LAS f32x4*)(tl + (64 + j) * 64 + 4 * q); acc[4 * q] += t.x * w; acc[4 * q + 1] += t.y * w; acc[4 * q + 2] += t.z * w; acc[4 * q + 3] += t.w * w; } }
        const float a0 = C.in(9)[l * 512 + c];
#pragma unroll
        for (int i = 0; i < 64; ++i) { *apn = sigmoidf_(a0 + acc[i]); apn += 512; asm volatile("" : "+v"(apn)); acc[i] = 0.f; } }
    { const float* W = C.in(11) + (size_t)l * 128 * 512 + c;
        for (int j = 0; j < 128; ++j) { const float w = W[(size_t)j * 512];
#pragma unroll
            for (int q = 0; q < 16; ++q) { const f32x4 t = *(const LAS f32x4*)(tl + (128 + j) * 64 + 4 * q); acc[4 * q] += t.x * w; acc[4 * q + 1] += t.y * w; acc[4 * q + 2] += t.z * w; acc[4 * q + 3] += t.w * w; } }
#pragma unroll
        for (int i = 0; i < 64; ++i) { *gp = (bf16_t)f2bf(acc[i]); gp += 512; asm volatile("" : "+v"(gp)); } }
}

DI void rwkv_scan_v1(Ctx& C, int bh, int l) {
    const int b = bh >> 3, h = bh & 7, lane = C.lane, c = h * 64 + lane;
    const bf16_t* proj = (const bf16_t*)(C.ws + WS_PROJ);
    const float* ELL = (const float*)(C.ws + WS_ELL); const float* AA = (const float*)(C.ws + WS_AA); const bf16_t* GG = (const bf16_t*)(C.ws + WS_GG);
    LAS float* LW = (LAS float*)C.lds; LAS float* LKK = LW + 4096; LAS float* LBB = LKK + 4096; LAS float* LKP = LBB + 4096; LAS float* LRR = LKP + 4096; LAS float* LVV = LRR + 4096; LAS float* RHO = LVV + 4096;
    const float* mu = C.in(6) + (size_t)l * 1792;
    const float mur = mu[c], muk = mu[512 + c], muv = mu[1024 + c];
    const float kk_c = C.in(12)[l * 512 + c], ka_c = C.in(13)[l * 512 + c], rk_c = C.in(14)[l * 512 + c], gng = C.in(15)[l * 512 + c], gnb = C.in(16)[l * 512 + c];
    float S[64];
#pragma unroll
    for (int k = 0; k < 64; ++k) S[k] = 0.f;
    for (int ch = 0; ch < 64; ++ch) {
        const size_t tok0 = (size_t)b * SEQ + ch * 64;
        for (int tok = 0; tok < 64; ++tok) {
            const size_t row = tok0 + tok; const bool first = (ch == 0 && tok == 0);
            const bf16_t* pr = proj + row * PLD; const bf16_t* pp = pr - PLD;
            const float rc = bf2f(pr[PC_R + c]), kc = bf2f(pr[PC_BK + c]), vc = bf2f(pr[PC_BV + c]);
            const float rp = first ? 0.f : bf2f(pp[PC_R + c]), kp_ = first ? 0.f : bf2f(pp[PC_BK + c]), vp = first ? 0.f : bf2f(pp[PC_BV + c]);
            const float r = rc + (rp - rc) * mur, k = kc + (kp_ - kc) * muk, v = vc + (vp - vc) * muv;
            const float ell = ELL[row * 512 + c], a = AA[row * 512 + c];
            const float kkv = k * kk_c; const float n2 = wave_sum(kkv * kkv); const float kk = kkv / fmaxf(sqrtf(n2), 1e-12f);
            const float kp = k * (1.f + (a - 1.f) * ka_c);
            const float rho = wave_sum(r * kp * rk_c);
            LW[tok * 64 + lane] = expf(ell); LKK[tok * 64 + lane] = kk; LBB[tok * 64 + lane] = kk * a; LKP[tok * 64 + lane] = kp; LRR[tok * 64 + lane] = r; LVV[tok * 64 + lane] = v;
            if (lane == 0) RHO[tok] = rho;
        }
        LDS_WAIT(); asm volatile("" ::: "memory");
        for (int tok = 0; tok < 64; ++tok) {
            const float vv = LVV[tok * 64 + lane];
            float s0 = 0.f, s1 = 0.f, s2 = 0.f, s3 = 0.f;
#pragma unroll
            for (int q = 0; q < 16; ++q) { const f32x4 kk4 = *(const LAS f32x4*)(LKK + tok * 64 + 4 * q); s0 += S[4 * q] * kk4.x; s1 += S[4 * q + 1] * kk4.y; s2 += S[4 * q + 2] * kk4.z; s3 += S[4 * q + 3] * kk4.w; }
            const float sa = -((s0 + s1) + (s2 + s3));
            float y0 = 0.f, y1 = 0.f, y2 = 0.f, y3 = 0.f;
#pragma unroll
            for (int q = 0; q < 16; ++q) {
                const f32x4 w4 = *(const LAS f32x4*)(LW + tok * 64 + 4 * q), b4 = *(const LAS f32x4*)(LBB + tok * 64 + 4 * q), k4 = *(const LAS f32x4*)(LKP + tok * 64 + 4 * q), r4 = *(const LAS f32x4*)(LRR + tok * 64 + 4 * q);
                S[4 * q] = S[4 * q] * w4.x + sa * b4.x + vv * k4.x; y0 += S[4 * q] * r4.x;
                S[4 * q + 1] = S[4 * q + 1] * w4.y + sa * b4.y + vv * k4.y; y1 += S[4 * q + 1] * r4.y;
                S[4 * q + 2] = S[4 * q + 2] * w4.z + sa * b4.z + vv * k4.z; y2 += S[4 * q + 2] * r4.z;
                S[4 * q + 3] = S[4 * q + 3] * w4.w + sa * b4.w + vv * k4.w; y3 += S[4 * q + 3] * r4.w; }
            const float y = (y0 + y1) + (y2 + y3);
            const float mean = wave_sum(y) * (1.f / 64.f); const float d = y - mean; const float var = wave_sum(d * d) * (1.f / 64.f);
            const float yn = d * (1.f / sqrtf(var + GN_EPS)) * gng + gnb;
            const size_t row = tok0 + tok;
            const float g = bf2f(GG[row * 512 + c]);
            C.mixcat[row * D + 512 + c] = (bf16_t)f2bf((yn + RHO[tok] * vv) * g);
        }
        LDS_WAIT(); asm volatile("" ::: "memory");
    }
}

DI void attn_unit(Ctx& C, int b, int h, int qb) {
    const int tid = C.tid, lane = C.lane, wave = C.wave, r32 = lane & 31, hi = lane >> 5;
    const bf16_t* proj = (const bf16_t*)(C.ws + WS_PROJ);
    const unsigned* bm = (const unsigned*)(C.ws + WS_BM);
    LAS unsigned char* Kl = C.lds; LAS unsigned char* Vl = C.lds + 16384; LAS float* tab = (LAS float*)(C.lds + 33792);
    const size_t rowbase = (size_t)b * SEQ; const int q0 = qb * 256, qw = q0 + 32 * wave, myq = qw + r32;
    const int NT = 4 * qb + 4, mylast = qw >> 6;
    constexpr float LOG2E = 1.4426950408889634f;
    __syncthreads();
    if (tid < 192) { const int rel = tid - 128; const int n = rel < 0 ? -rel : rel; int bk = rel > 0 ? 16 : 0;
        if (n < 8) bk += n; else bk += 8 + (n >= 12) + (n >= 16) + (n >= 23) + (n >= 32) + (n >= 46) + (n >= 64) + (n >= 91);
        tab[tid] = C.in(17)[bk * 8 + h] * LOG2E; }
    const float bias_far = C.in(17)[15 * 8 + h] * LOG2E;
    bf16x8 qr[4];
    { const bf16_t* qp = proj + (rowbase + myq) * PLD + PC_Q + h * 64 + 8 * hi;
#pragma unroll
        for (int s = 0; s < 4; ++s) qr[s] = *(const bf16x8*)(qp + 16 * s); }
    const unsigned* bmrow = bm + (rowbase + myq) * 128;
    const int skv = tid >> 3, sch = tid & 7;
    const bf16_t* ksrc = proj + (rowbase + skv) * PLD + PC_K + h * 64 + 8 * sch;
    const bf16_t* vsrc = proj + (rowbase + skv) * PLD + PC_V + h * 64 + 8 * sch;
    const int kdst = skv * 128 + ((sch ^ ((skv >> 1) & 7)) << 4);
    u32x4 kreg = *(const u32x4*)ksrc, vreg = *(const u32x4*)vsrc;
    unsigned mw0 = bmrow[0], mw1 = bmrow[1];
#define ATT_WRITE(buf) do { *(LAS u32x4*)(Kl + (buf) * 8192 + kdst) = kreg; LAS bf16_t* vt_ = (LAS bf16_t*)(Vl + (buf) * 8704); \
        vt_[(8 * sch + 0) * 68 + skv] = (bf16_t)(vreg.x & 0xffffu); vt_[(8 * sch + 1) * 68 + skv] = (bf16_t)(vreg.x >> 16); \
        vt_[(8 * sch + 2) * 68 + skv] = (bf16_t)(vreg.y & 0xffffu); vt_[(8 * sch + 3) * 68 + skv] = (bf16_t)(vreg.y >> 16); \
        vt_[(8 * sch + 4) * 68 + skv] = (bf16_t)(vreg.z & 0xffffu); vt_[(8 * sch + 5) * 68 + skv] = (bf16_t)(vreg.z >> 16); \
        vt_[(8 * sch + 6) * 68 + skv] = (bf16_t)(vreg.w & 0xffffu); vt_[(8 * sch + 7) * 68 + skv] = (bf16_t)(vreg.w >> 16); } while (0)
    ATT_WRITE(0);
    __syncthreads();
    float m_run = -1.0e30f, l_run = 0.f; f32x16 o0 = {}, o1 = {};
    for (int j = 0; j < NT; ++j) {
        const int buf = j & 1;
        unsigned cw0 = mw0, cw1 = mw1;
        if (j + 1 < NT) { kreg = *(const u32x4*)(ksrc + (size_t)(j + 1) * 64 * PLD); vreg = *(const u32x4*)(vsrc + (size_t)(j + 1) * 64 * PLD); mw0 = bmrow[2 * j + 2]; mw1 = bmrow[2 * j + 3]; }
        if (j <= mylast) {
            f32x16 p0 = {}, p1 = {};
            const LAS unsigned char* kb = Kl + buf * 8192;
#pragma unroll
            for (int s = 0; s < 4; ++s) { const int ch = 2 * s + hi;
                const bf16x8 ka0 = *(const LAS bf16x8*)(kb + r32 * 128 + ((ch ^ ((r32 >> 1) & 7)) << 4));
                const bf16x8 ka1 = *(const LAS bf16x8*)(kb + (32 + r32) * 128 + ((ch ^ (((32 + r32) >> 1) & 7)) << 4));
                p0 = __builtin_amdgcn_mfma_f32_32x32x16_bf16(ka0, qr[s], p0, 0, 0, 0);
                p1 = __builtin_amdgcn_mfma_f32_32x32x16_bf16(ka1, qr[s], p1, 0, 0, 0); }
            const bool far = (64 * j + 63 - qw) <= -128;
            if (far) {
#pragma unroll
                for (int g = 0; g < 16; ++g) { p0[g] = p0[g] * (0.125f * LOG2E) + bias_far; p1[g] = p1[g] * (0.125f * LOG2E) + bias_far; }
            } else {
#pragma unroll
                for (int g = 0; g < 16; ++g) { const int kv0 = 64 * j + (g & 3) + 8 * (g >> 2) + 4 * hi; int r0 = kv0 - myq, r1 = r0 + 32;
                    r0 = r0 < -128 ? -128 : r0; r1 = r1 < -128 ? -128 : r1;
                    p0[g] = p0[g] * (0.125f * LOG2E) + tab[r0 + 128]; p1[g] = p1[g] * (0.125f * LOG2E) + tab[r1 + 128]; }
            }
            float mx = p0[0];
#pragma unroll
            for (int g = 1; g < 16; ++g) mx = fmaxf(mx, p0[g]);
#pragma unroll
            for (int g = 0; g < 16; ++g) mx = fmaxf(mx, p1[g]);
            mx = fmaxf(mx, __shfl_xor(mx, 32));
            const float m_new = fmaxf(m_run, mx); const float alpha = __builtin_amdgcn_exp2f(m_run - m_new); m_run = m_new;
            const unsigned sw0 = cw0 >> (4 * hi), sw1 = cw1 >> (4 * hi);
            float ls = 0.f;
#pragma unroll
            for (int g = 0; g < 16; ++g) { const int bit = (g & 3) + 8 * (g >> 2);
                const float e0 = __builtin_amdgcn_exp2f(p0[g] - m_new), e1 = __builtin_amdgcn_exp2f(p1[g] - m_new);
                p0[g] = ((sw0 >> bit) & 1u) ? e0 : 0.f; p1[g] = ((sw1 >> bit) & 1u) ? e1 : 0.f; ls += p0[g] + p1[g]; }
            l_run = l_run * alpha + ls;
#pragma unroll
            for (int g = 0; g < 16; ++g) { o0[g] *= alpha; o1[g] *= alpha; }
            bf16x8 pb[4];
#pragma unroll
            for (int s = 0; s < 2; ++s) {
                u32x4 w; w.x = pk2(p0[8 * s], p0[8 * s + 1]); w.y = pk2(p0[8 * s + 2], p0[8 * s + 3]); w.z = pk2(p0[8 * s + 4], p0[8 * s + 5]); w.w = pk2(p0[8 * s + 6], p0[8 * s + 7]); pb[s] = __builtin_bit_cast(bf16x8, w);
                u32x4 x; x.x = pk2(p1[8 * s], p1[8 * s + 1]); x.y = pk2(p1[8 * s + 2], p1[8 * s + 3]); x.z = pk2(p1[8 * s + 4], p1[8 * s + 5]); x.w = pk2(p1[8 * s + 6], p1[8 * s + 7]); pb[2 + s] = __builtin_bit_cast(bf16x8, x); }
            const LAS unsigned char* vb = Vl + buf * 8704;
#pragma unroll
            for (int s = 0; s < 4; ++s) {
                const u32x2 a0l = *(const LAS u32x2*)(vb + (r32) * 136 + (16 * s + 4 * hi) * 2), a0h = *(const LAS u32x2*)(vb + (r32) * 136 + (16 * s + 8 + 4 * hi) * 2);
                const u32x2 a1l = *(const LAS u32x2*)(vb + (32 + r32) * 136 + (16 * s + 4 * hi) * 2), a1h = *(const LAS u32x2*)(vb + (32 + r32) * 136 + (16 * s + 8 + 4 * hi) * 2);
                const u32x4 A0 = {a0l.x, a0l.y, a0h.x, a0h.y}, A1 = {a1l.x, a1l.y, a1h.x, a1h.y};
                o0 = __builtin_amdgcn_mfma_f32_32x32x16_bf16(__builtin_bit_cast(bf16x8, A0), pb[s], o0, 0, 0, 0);
                o1 = __builtin_amdgcn_mfma_f32_32x32x16_bf16(__builtin_bit_cast(bf16x8, A1), pb[s], o1, 0, 0, 0); }
        }
        if (j + 1 < NT) ATT_WRITE(buf ^ 1);
        __syncthreads();
    }
#undef ATT_WRITE
    const float lt = l_run + __shfl_xor(l_run, 32); const float inv = 1.f / lt;
    bf16_t* orow = C.mixcat + (rowbase + myq) * D + h * 64;
#pragma unroll
    for (int i = 0; i < 4; ++i) { const int d = 8 * i + 4 * hi;
        u32x2 w0; w0.x = pk2(o0[4 * i] * inv, o0[4 * i + 1] * inv); w0.y = pk2(o0[4 * i + 2] * inv, o0[4 * i + 3] * inv); *(u32x2*)(orow + d) = w0;
        u32x2 w1; w1.x = pk2(o1[4 * i] * inv, o1[4 * i + 1] * inv); w1.y = pk2(o1[4 * i + 2] * inv, o1[4 * i + 3] * inv); *(u32x2*)(orow + 32 + d) = w1; }
}

DI void phase_ln_router(Ctx& C, int l) {
    const float* V = (const float*)(C.ws + WS_V);
    const float* g = C.in(25) + (size_t)l * D; const float* bta = C.in(26) + (size_t)l * D;
    const float* wr = C.in(18); const float* br = C.in(19);
    LAS unsigned* lcnt = (LAS unsigned*)C.lds; LAS unsigned* base = lcnt + 16; LAS int* rec = (LAS int*)(C.lds + 128);
    TokInfo* tok = (TokInfo*)(C.ws + WS_TOK); RowInfo* rowi = (RowInfo*)(C.ws + WS_ROW);
    unsigned* gcnt = C.ctl + CW_GCNT + 64 * l;
    for (int i = C.blk * NTHR + C.tid; i < MAXROWS; i += C.G * NTHR) { RowInfo ri; ri.token = -1; ri.slot = 0; ri.gate = 0.f; ri.pad = 0; rowi[i] = ri; }
    for (int rb = C.blk; rb < T / 64; rb += C.G) {
        __syncthreads();
        if (C.tid < 16) lcnt[C.tid] = 0u;
        __syncthreads();
        for (int i = 0; i < 8; ++i) {
            const int lr = C.wave * 8 + i; const size_t m = (size_t)rb * 64 + lr;
            f32x4 v[4];
#pragma unroll
            for (int j = 0; j < 4; ++j) v[j] = *(const f32x4*)(V + m * D + 256 * j + 4 * C.lane);
            ln16(v, g, bta, C.lane);
            store_row_bf16(C.xcur + m * D, v, C.lane);
            float lg[16];
#pragma unroll
            for (int e = 0; e < 16; ++e) lg[e] = 0.f;
#pragma unroll
            for (int j = 0; j < 4; ++j)
#pragma unroll
                for (int i2 = 0; i2 < 4; ++i2) { const float xv = v[j][i2]; const float* wrow = wr + (size_t)(256 * j + 4 * C.lane + i2) * 16;
                    const f32x4 w0 = *(const f32x4*)(wrow), w1 = *(const f32x4*)(wrow + 4), w2 = *(const f32x4*)(wrow + 8), w3 = *(const f32x4*)(wrow + 12);
                    lg[0] += xv * w0.x; lg[1] += xv * w0.y; lg[2] += xv * w0.z; lg[3] += xv * w0.w; lg[4] += xv * w1.x; lg[5] += xv * w1.y; lg[6] += xv * w1.z; lg[7] += xv * w1.w;
                    lg[8] += xv * w2.x; lg[9] += xv * w2.y; lg[10] += xv * w2.z; lg[11] += xv * w2.w; lg[12] += xv * w3.x; lg[13] += xv * w3.y; lg[14] += xv * w3.z; lg[15] += xv * w3.w; }
            float sc[16], sl[16];
#pragma unroll
            for (int e = 0; e < 16; ++e) { const float t = wave_sum(lg[e]); sc[e] = 1.f / (1.f + expf(-t)); sl[e] = sc[e] + br[e]; }
            int best = 0; float bestv = -3.0e38f;
#pragma unroll
            for (int gq = 0; gq < 4; ++gq) { const float a = sl[4 * gq], b2 = sl[4 * gq + 1], c2 = sl[4 * gq + 2], d2 = sl[4 * gq + 3];
                const float mx1 = fmaxf(fmaxf(a, b2), fmaxf(c2, d2)); const float tot = a + b2 + c2 + d2; const float mn1 = fminf(fminf(a, b2), fminf(c2, d2));
                const float lo1 = fminf(a, b2), hi1 = fmaxf(a, b2), lo2 = fminf(c2, d2), hi2 = fmaxf(c2, d2);
                const float second = fmaxf(fminf(hi1, hi2), fmaxf(lo1, lo2));
                (void)tot; (void)mn1;
                const float gs = mx1 + second; if (gs > bestv) { bestv = gs; best = gq; } }
            int i0 = 0, i1 = 0; float v0 = -3.0e38f, v1 = -3.0e38f, s0 = 0.f, s1 = 0.f;
#pragma unroll
            for (int gq = 0; gq < 4; ++gq) if (gq == best) {
#pragma unroll
                for (int k = 0; k < 4; ++k) { const float x = sl[4 * gq + k]; if (x > v0) { v1 = v0; i1 = i0; s1 = s0; v0 = x; i0 = 4 * gq + k; s0 = sc[4 * gq + k]; } else if (x > v1) { v1 = x; i1 = 4 * gq + k; s1 = sc[4 * gq + k]; } } }
            const float den = s0 + s1; const float g0 = s0 / den, g1 = s1 / den;
            if (C.lane == 0) {
                const unsigned r0 = __hip_atomic_fetch_add(lcnt + i0, 1u, __ATOMIC_RELAXED, __HIP_MEMORY_SCOPE_WORKGROUP);
                const unsigned r1 = __hip_atomic_fetch_add(lcnt + i1, 1u, __ATOMIC_RELAXED, __HIP_MEMORY_SCOPE_WORKGROUP);
                rec[lr * 8 + 0] = i0; rec[lr * 8 + 1] = i1; rec[lr * 8 + 2] = (int)r0; rec[lr * 8 + 3] = (int)r1;
                rec[lr * 8 + 4] = __builtin_bit_cast(int, g0); rec[lr * 8 + 5] = __builtin_bit_cast(int, g1); }
        }
        __syncthreads();
        if (C.tid < 16) base[C.tid] = __hip_atomic_fetch_add(gcnt + C.tid, lcnt[C.tid], __ATOMIC_RELAXED, __HIP_MEMORY_SCOPE_AGENT);
        __syncthreads();
        if (C.tid < 64) { TokInfo ti; ti.e0 = rec[C.tid * 8]; ti.e1 = rec[C.tid * 8 + 1]; ti.p0 = rec[C.tid * 8 + 2] + (int)base[ti.e0]; ti.p1 = rec[C.tid * 8 + 3] + (int)base[ti.e1];
            ti.g0 = __builtin_bit_cast(float, rec[C.tid * 8 + 4]); ti.g1 = __builtin_bit_cast(float, rec[C.tid * 8 + 5]); ti.pad0 = 0; ti.pad1 = 0; tok[(size_t)rb * 64 + C.tid] = ti; }
    }
}
DI int build_tile_table(Ctx& C, int l, LAS int* toff, LAS int* texp) {
    const unsigned* gcnt = C.ctl + CW_GCNT + 64 * l;
    __syncthreads();
    if (C.tid == 0) { int o = 0; for (int e = 0; e < 16; ++e) { toff[e] = o; const int c = (int)__hip_atomic_load(gcnt + e, __ATOMIC_RELAXED, __HIP_MEMORY_SCOPE_AGENT); const int nt = (c + 255) >> 8; for (int t = 0; t < nt; ++t) texp[(o >> 8) + t] = e; o += nt << 8; } toff[16] = o; }
    __syncthreads();
    return toff[16] >> 8;
}
DI void phase_gather(Ctx& C, int l) {
    LAS int* toff = (LAS int*)(C.lds + 1024); LAS int* texp = (LAS int*)(C.lds + 2048);
    (void)build_tile_table(C, l, toff, texp);
    const TokInfo* tok = (const TokInfo*)(C.ws + WS_TOK); RowInfo* rowi = (RowInfo*)(C.ws + WS_ROW); bf16_t* AG = (bf16_t*)(C.ws + WS_AG);
    const int gw = C.blk * NWAVES + C.wave, NGW = C.G * NWAVES;
    for (int m = gw; m < T; m += NGW) {
        const TokInfo ti = tok[m];
        const u32x4 a = *(const u32x4*)(C.xcur + (size_t)m * D + 8 * C.lane), b = *(const u32x4*)(C.xcur + (size_t)m * D + 512 + 8 * C.lane);
        const int r0 = toff[ti.e0] + ti.p0, r1 = toff[ti.e1] + ti.p1;
        *(u32x4*)(AG + (size_t)r0 * D + 8 * C.lane) = a; *(u32x4*)(AG + (size_t)r0 * D + 512 + 8 * C.lane) = b;
        *(u32x4*)(AG + (size_t)r1 * D + 8 * C.lane) = a; *(u32x4*)(AG + (size_t)r1 * D + 512 + 8 * C.lane) = b;
        if (C.lane == 0) { RowInfo x; x.token = m; x.slot = 0; x.gate = ti.g0; x.pad = 0; rowi[r0] = x; x.slot = 1; x.gate = ti.g1; rowi[r1] = x; }
    }
}
DI void phase_ln_ffn(Ctx& C, int l) {
    const bf16_t* Y = (const bf16_t*)(C.ws + WS_Y);
    const float* g = C.in(27) + (size_t)l * D; const float* bta = C.in(28) + (size_t)l * D;
    const int gw = C.blk * NWAVES + C.wave, NGW = C.G * NWAVES;
    for (int m = gw; m < T; m += NGW) {
        f32x4 x[4], y0[4], y1[4];
        load_row_bf16(C.xcur + (size_t)m * D, x, C.lane); load_row_bf16(Y + (size_t)m * D, y0, C.lane); load_row_bf16(Y + ((size_t)T + m) * D, y1, C.lane);
#pragma unroll
        for (int j = 0; j < 4; ++j) x[j] = x[j] * ALPHA + (y0[j] + y1[j]);
        ln16(x, g, bta, C.lane);
        store_row_bf16(C.xcur + (size_t)m * D, x, C.lane);
    }
}
DI void phase_ln_ple(Ctx& C, int l, bool last) {
    const float* V = (const float*)(C.ws + WS_V3);
    const float* g = C.in(29) + (size_t)l * D; const float* bta = C.in(30) + (size_t)l * D;
    const int gw = C.blk * NWAVES + C.wave, NGW = C.G * NWAVES;
    for (int m = gw; m < T; m += NGW) {
        f32x4 v[4];
#pragma unroll
        for (int j = 0; j < 4; ++j) v[j] = *(const f32x4*)(V + (size_t)m * D + 256 * j + 4 * C.lane);
        ln16(v, g, bta, C.lane);
        if (last) {
#pragma unroll
            for (int j = 0; j < 4; ++j) *(f32x4*)(C.out + (size_t)m * D + 256 * j + 4 * C.lane) = v[j];
        } else store_row_bf16(C.xcur + (size_t)m * D, v, C.lane);
    }
}

constexpr int LDS_BYTES = 147456;
constexpr int PH_PER_LAYER = 11, NPHASE = 1 + DEPTH * PH_PER_LAYER;

template <int SP> DI void run_sp(Ctx& C, const int l) {
    if constexpr (SP == 0) {
        pg8::Gemm g{C.xcur, (const bf16_t*)(C.ws + WS_WEXP), T, NPROJ_PAD, opaque_i(D)}; pg8::StaticOrder S; S.init(T, NPROJ_PAD, C.G, C.blk);
        EpiProj E{(bf16_t*)(C.ws + WS_PROJ)};
        pg8::gemm_phase<EpiProj, pg8::StaticOrder, true, true>(C.lds, g, S, E);
    } else if constexpr (SP == 1) {
        convert_layer_weights(C, l);
        for (int it = C.blk; it < 256; it += C.G) rwkv_prep_item(C, it, l);
        for (int it = C.blk; it < 2048; it += C.G) idx_item(C, it, l);
    } else if constexpr (SP == 2) {
        if (C.blk < 32) { if (C.wave == 0) rwkv_scan_v1(C, C.blk, l); }
        else { const int nb = C.G - 32; for (int u = C.blk - 32; u < 512; u += nb) { const int qb = 15 - (u >> 5), bh = u & 31; attn_unit(C, bh >> 3, bh & 7, qb); } }
    } else if constexpr (SP == 3) {
        pg8::Gemm g{C.mixcat, (const bf16_t*)(C.ws + WS_WOUT), T, D, opaque_i(D)}; pg8::StaticOrder S; S.init(T, D, C.G, C.blk);
        EpiResF32 E{C.xcur, (float*)(C.ws + WS_V)};
        pg8::gemm_phase<EpiResF32, pg8::StaticOrder, true, true>(C.lds, g, S, E);
    } else if constexpr (SP == 4) { phase_ln_router(C, l);
    } else if constexpr (SP == 5) { phase_gather(C, l);
    } else if constexpr (SP == 6) {
        LAS int* toff = (LAS int*)(C.lds + 135168); LAS int* texp = (LAS int*)(C.lds + 136192);
        const int nt = build_tile_table(C, l, toff, texp);
        pg8::Gemm g{(const bf16_t*)(C.ws + WS_AG), (const bf16_t*)(C.ws + WS_WEXP), MAXROWS, NEXP * 512, opaque_i(D)};
        GroupedOrder<2> S{texp, nt, C.G, C.blk};
        EpiSwiGLU E{(bf16_t*)(C.ws + WS_H), (const RowInfo*)(C.ws + WS_ROW)};
        pg8::gemm_phase<EpiSwiGLU, GroupedOrder<2>, true, true>(C.lds, g, S, E);
    } else if constexpr (SP == 7) {
        LAS int* toff = (LAS int*)(C.lds + 135168); LAS int* texp = (LAS int*)(C.lds + 136192);
        const int nt = build_tile_table(C, l, toff, texp);
        { pg8::Gemm g{(const bf16_t*)(C.ws + WS_H), (const bf16_t*)(C.ws + WS_WDOWN), MAXROWS, NEXP * D, opaque_i(DEXP)};
          GroupedOrder<4> S{texp, nt, C.G, C.blk};
          EpiDown E{(bf16_t*)(C.ws + WS_Y), (const RowInfo*)(C.ws + WS_ROW)};
          pg8::gemm_phase<EpiDown, GroupedOrder<4>, true, true>(C.lds, g, S, E); }
        { pg8::Gemm g{(const bf16_t*)(C.ws + WS_PBF), (const bf16_t*)(C.ws + WS_WPLE), T, D, opaque_i(PLE)}; pg8::StaticOrder S; S.init(T, D, C.G, C.blk);
          EpiBf16Plain E{(bf16_t*)(C.ws + WS_PE), D};
          pg8::gemm_phase<EpiBf16Plain, pg8::StaticOrder, true, true>(C.lds, g, S, E); }
    } else if constexpr (SP == 8) { phase_ln_ffn(C, l);
    } else if constexpr (SP == 9) {
        pg8::Gemm g{C.xcur, (const bf16_t*)(C.ws + WS_WPG), T, D, opaque_i(D)}; pg8::StaticOrder S; S.init(T, D, C.G, C.blk);
        EpiPle E{C.xcur, (const bf16_t*)(C.ws + WS_PE), (float*)(C.ws + WS_V3)};
        pg8::gemm_phase<EpiPle, pg8::StaticOrder, true, true>(C.lds, g, S, E);
    } else { phase_ln_ple(C, l, l == DEPTH - 1); if (l + 1 < DEPTH) convert_win(C, l + 1); }
}
typedef const __attribute__((address_space(4))) Args* KArgP;
DI void ctx_setup(Ctx& C) {
    int t_ = threadIdx.x; asm volatile("" : "+v"(t_)); C.tid = t_; C.lane = t_ & 63; C.wave = __builtin_amdgcn_readfirstlane(t_ >> 6);
    int b_ = blockIdx.x, g_ = gridDim.x; asm volatile("" : "+s"(b_), "+s"(g_)); C.blk = b_; C.G = g_;
    KArgP ap = (KArgP)__builtin_amdgcn_kernarg_segment_ptr(); asm volatile("" : "+s"(ap));
    C.ap = ap; C.out = ap->out; C.ws = ap->ws; C.ctl = (unsigned*)(ap->ws + WS_CTL); C.xcur = (bf16_t*)ap->out; C.mixcat = (bf16_t*)ap->out + (size_t)T * D;
}
__global__ void __launch_bounds__(NTHR, 2) mega_fwd(Args args) {
    extern __shared__ __attribute__((aligned(16))) unsigned char lds_raw[];
    Ctx C;
    C.lds = (LAS unsigned char*)lds_raw;
    cg::grid_group grid = cg::this_grid();
    const int lo = ((KArgP)__builtin_amdgcn_kernarg_segment_ptr())->ph_lo, hi = ((KArgP)__builtin_amdgcn_kernarg_segment_ptr())->ph_hi;
#define PHASE(k, body) do { if (lo <= (k) && (k) < hi) { if ((k) > lo) grid.sync(); ctx_setup(C); body; } } while (0)
    PHASE(0, { phase_ln_in(C); convert_win(C, 0); });
#define LAYER(l) PHASE(1 + 11 * (l) + 0, run_sp<0>(C, l)); PHASE(1 + 11 * (l) + 1, run_sp<1>(C, l)); PHASE(1 + 11 * (l) + 2, run_sp<2>(C, l)); PHASE(1 + 11 * (l) + 3, run_sp<3>(C, l)); \
    PHASE(1 + 11 * (l) + 4, run_sp<4>(C, l)); PHASE(1 + 11 * (l) + 5, run_sp<5>(C, l)); PHASE(1 + 11 * (l) + 6, run_sp<6>(C, l)); PHASE(1 + 11 * (l) + 7, run_sp<7>(C, l)); \
    PHASE(1 + 11 * (l) + 8, run_sp<8>(C, l)); PHASE(1 + 11 * (l) + 9, run_sp<9>(C, l)); PHASE(1 + 11 * (l) + 10, run_sp<10>(C, l))
    LAYER(0);
    LAYER(1);
#undef LAYER
#undef PHASE
}

#ifndef N_LAUNCH_MODE
#define N_LAUNCH_MODE 1
#endif
extern "C" void kernel_launch(void* const* d_in, const int* in_sizes, int n_in, void* d_out, int out_size, void* d_ws, size_t ws_size, hipStream_t stream) {
    static int grid = 0;
    if (grid == 0) {
        if (n_in != 31 || out_size != T * D) { fprintf(stderr, "kernel_launch: unexpected problem (n_in %d out %d)\n", n_in, out_size); grid = -1; return; }
        int dev = 0, cus = 0, per_cu = 0;
        hipGetDevice(&dev); hipDeviceGetAttribute(&cus, hipDeviceAttributeMultiprocessorCount, dev);
        if (hipFuncSetAttribute((const void*)mega_fwd, hipFuncAttributeMaxDynamicSharedMemorySize, LDS_BYTES) != hipSuccess) { fprintf(stderr, "kernel_launch: hipFuncSetAttribute failed\n"); grid = -1; return; }
        if (hipOccupancyMaxActiveBlocksPerMultiprocessor(&per_cu, (const void*)mega_fwd, NTHR, LDS_BYTES) != hipSuccess || per_cu < 1) { fprintf(stderr, "kernel_launch: occupancy query says %d\n", per_cu); per_cu = 1; }
        (void)hipGetLastError();
        grid = cus * 1;
        fprintf(stderr, "kernel_launch: grid %d (occupancy %d per CU)\n", grid, per_cu);
    }
    if (grid < 0) return;
    hipMemsetAsync((char*)d_ws + WS_CTL, 0, CTL_BYTES, stream);
    Args a{};
    for (int i = 0; i < 31; ++i) a.in[i] = (const float*)d_in[i];
    a.out = (float*)d_out; a.ws = (unsigned char*)d_ws;
#if N_LAUNCH_MODE == 0
    for (int ph = 0; ph < NPHASE; ++ph) { a.ph_lo = ph; a.ph_hi = ph + 1; hipLaunchKernelGGL(mega_fwd, dim3(grid), dim3(NTHR), LDS_BYTES, stream, a); }
#else
    a.ph_lo = 0; a.ph_hi = NPHASE;
    void* kargs[] = {&a};
    hipError_t e = hipLaunchCooperativeKernel((const void*)mega_fwd, dim3(grid), dim3(NTHR), kargs, LDS_BYTES, stream);
    if (e != hipSuccess) fprintf(stderr, "cooperative launch failed: %s (grid %d)\n", hipGetErrorString(e), grid);
#endif
}
```

```cpp
#include <hip/hip_runtime.h>
#include <hip/hip_cooperative_groups.h>
#include <cstdio>
#include <cstdint>
namespace cg = cooperative_groups;
namespace pg8 {
#define PG8_LAS __attribute__((address_space(3)))
typedef unsigned short bf16_t;
typedef short bf16x8 __attribute__((ext_vector_type(8)));
typedef float f32x4 __attribute__((ext_vector_type(4)));
typedef unsigned u32x4 __attribute__((ext_vector_type(4)));
constexpr int BM = 256, BK = 64, HALF = 128, HTB = HALF * BK * 2  , STAGE_BYTES = 8 * HTB, NXCD = 8, WGM = 8;

__host__ __device__ __forceinline__ int lds_byte(int r, int c) { const int st = (r >> 4) * 2 + (c >> 5), rr = r & 15, cc = c & 31, ob = rr * 64 + cc * 2; return st * 1024 + (ob ^ (((ob >> 9) & 1) << 5)); }
__host__ __device__ __forceinline__ void stage_rc(int b, int& R, int& C) { const int st = b / 1024, sb = b % 1024, swz = sb ^ (((sb >> 9) & 1) << 5); R = (st >> 1) * 16 + swz / 64; C = (st & 1) * 32 + (swz % 64) / 2; }
__host__ __device__ __forceinline__ int perm32(int rho) { const int n = rho >> 4, i = rho & 15; return 8 * (i >> 2) + 4 * n + (i & 3); }

struct Unit { int pm, pn; };
struct Gemm { const bf16_t* A; const bf16_t* Bt; int M, N, K; };

struct StaticOrder {
    int nM, nN, nwg, G, c;
    __host__ __device__ void init(int M, int N, int G_, int c_) { nM = M / BM; nN = N / BM; nwg = nM * nN; G = G_; c = c_; }
    __host__ __device__ bool next(int i, Unit& u) const {
        const long L = (long)i * G + c; if (L >= nwg) return false;
        int wgid = (int)L; { const int q = nwg / NXCD, r = nwg % NXCD, xcd = wgid % NXCD, off = wgid / NXCD; wgid = (xcd < r ? xcd * (q + 1) : r * (q + 1) + (xcd - r) * q) + off; }
        const int nig = WGM * nN, gid = wgid / nig, fm = gid * WGM, gsz = (nM - fm) < WGM ? (nM - fm) : WGM;
        u.pm = fm + ((wgid % nig) % gsz); u.pn = (wgid % nig) / gsz; return true;
    }
    __device__ __forceinline__ void a_ready(const Unit&) const {}
    __device__ __forceinline__ void done(const Unit&) const {}
};

__device__ __forceinline__ unsigned cvt_pk_bf16(float lo, float hi) { typedef float f2_t __attribute__((ext_vector_type(2))); typedef __bf16 b2_t __attribute__((ext_vector_type(2))); f2_t v = {lo, hi}; b2_t b = __builtin_convertvector(v, b2_t); return __builtin_bit_cast(unsigned, b); }
template <class Epi, class Sched, bool ALIGN_EPI = false, bool SP2 = false>
__device__ __forceinline__ void gemm_phase(PG8_LAS unsigned char* lds, const Gemm g, const Sched& S, const Epi& E) {
    int tid_ = threadIdx.x; asm volatile("" : "+v"(tid_));
    const int tid = tid_, wid = __builtin_amdgcn_readfirstlane(tid >> 6), lane = tid & 63, wr = wid >> 2, wc = wid & 3, fr = lane & 15, fq = lane >> 4;
    const int K = g.K, nt = K / BK;
    unsigned voffA[2], voffB[2];
#pragma unroll
    for (int i = 0; i < 2; ++i) { int R, C; stage_rc(tid * 16 + i * 8192, R, C); const int Rb = Epi::PERM ? ((R & ~31) + perm32(R & 31)) : R;
        voffA[i] = (unsigned)(R * K + C) * 2u; voffB[i] = (unsigned)(Rb * K + C) * 2u; }
    const size_t kstep = (size_t)(BK * 2);
    const size_t hstep = (size_t)HALF * K * 2;
    const size_t tstep = 2 * hstep;
    const unsigned ldsw = (unsigned)wid * 1024u;
    const int aoff = lds_byte(wr * 64 + fr, fq * 8), boff = lds_byte(wc * 32 + fr, fq * 8);
#define PG8_SA(b, h) (((b) * 2 + (h)) * HTB)
#define PG8_SB(b, h) ((4 + (b) * 2 + (h)) * HTB)
#define PG8_STAGE(bufoff, gbase, voff) do { _Pragma("unroll") for (int _i = 0; _i < 2; ++_i) \
        __builtin_amdgcn_global_load_lds((const unsigned*)((const char*)(gbase) + (voff)[_i]), (PG8_LAS unsigned*)(lds + (bufoff) + ldsw + _i * 8192), 16, 0, 0); } while (0)
#define PG8_LDA(dst, b, h) do { _Pragma("unroll") for (int m = 0; m < 4; ++m) _Pragma("unroll") for (int k = 0; k < 2; ++k) dst[m][k] = *(const PG8_LAS bf16x8*)(lds + PG8_SA(b, h) + aoff + m * 2048 + k * 1024); } while (0)
#define PG8_LDB(dst, b, h) do { _Pragma("unroll") for (int n = 0; n < 2; ++n) _Pragma("unroll") for (int k = 0; k < 2; ++k) dst[n][k] = *(const PG8_LAS bf16x8*)(lds + PG8_SB(b, h) + boff + n * 2048 + k * 1024); } while (0)
#define PG8_MMA(ai, bj, At, Bt) do { __builtin_amdgcn_s_setprio(1); _Pragma("unroll") for (int m = 0; m < 4; ++m) _Pragma("unroll") for (int n = 0; n < 2; ++n) _Pragma("unroll") for (int k = 0; k < 2; ++k) \
        acc[ai][bj][m][n] = __builtin_amdgcn_mfma_f32_16x16x32_bf16(Bt[n][k], At[m][k], acc[ai][bj][m][n], 0, 0, 0); __builtin_amdgcn_s_setprio(0); } while (0)
#define PG8_WAIT_V(n) asm volatile("s_waitcnt vmcnt(" #n ")" ::: "memory")
#define PG8_WAIT_L(n) asm volatile("s_waitcnt lgkmcnt(" #n ")" ::: "memory")
#define PG8_BAR __builtin_amdgcn_s_barrier()
#define PG8_SCHED __builtin_amdgcn_sched_barrier(0)
    Unit cur, nxt; int ui = 0;
    if (!S.next(0, cur)) return;
    f32x4 acc[2][2][4][2];
#pragma unroll
    for (int a = 0; a < 2; ++a)
#pragma unroll
        for (int b = 0; b < 2; ++b)
#pragma unroll
            for (int m = 0; m < 4; ++m)
#pragma unroll
                for (int n = 0; n < 2; ++n) acc[a][b][m][n] = (f32x4){0.f, 0.f, 0.f, 0.f};
    bf16x8 At[4][2], B0[2][2], B1[2][2];
    const char* cA = (const char*)g.A + (size_t)cur.pm * tstep; const char* cB = (const char*)g.Bt + (size_t)cur.pn * tstep;
    S.a_ready(cur);
    if constexpr (SP2) {
        PG8_STAGE(PG8_SB(0, 0), cB, voffB); PG8_STAGE(PG8_SB(0, 1), cB + hstep, voffB); PG8_STAGE(PG8_SA(0, 0), cA, voffA); PG8_STAGE(PG8_SA(0, 1), cA + hstep, voffA);
        if (wr == 1) PG8_BAR;
        PG8_WAIT_V(2); PG8_BAR;
        PG8_STAGE(PG8_SB(1, 0), cB + kstep, voffB); PG8_STAGE(PG8_SA(1, 0), cA + kstep, voffA); PG8_STAGE(PG8_SB(1, 1), cB + hstep + kstep, voffB);
        PG8_WAIT_V(6); PG8_BAR;
    } else {
        PG8_STAGE(PG8_SB(0, 0), cB, voffB); PG8_STAGE(PG8_SA(0, 0), cA, voffA); PG8_STAGE(PG8_SB(0, 1), cB + hstep, voffB); PG8_STAGE(PG8_SA(0, 1), cA + hstep, voffA);
        if (wr == 1) PG8_BAR;
        PG8_WAIT_V(4); PG8_BAR;
        PG8_STAGE(PG8_SB(1, 0), cB + kstep, voffB); PG8_STAGE(PG8_SA(1, 0), cA + kstep, voffA); PG8_STAGE(PG8_SB(1, 1), cB + hstep + kstep, voffB);
        PG8_WAIT_V(6); PG8_BAR;
    }
    for (;;) {
        const bool has_next = S.next(ui + 1, nxt);
        const char* nA = has_next ? (const char*)g.A + (size_t)nxt.pm * tstep : cA; const char* nB = has_next ? (const char*)g.Bt + (size_t)nxt.pn * tstep : cB;
        for (int t = 0; t < nt; t += 2) {
            const bool last = (t == nt - 2);
            const char* a1 = cA + (size_t)(t + 1) * kstep;
            const char* a2 = last ? nA : cA + (size_t)(t + 2) * kstep; const char* b2 = last ? nB : cB + (size_t)(t + 2) * kstep;
            const char* a3 = a2 + kstep; const char* b3 = b2 + kstep;
            if (last && has_next) S.a_ready(nxt);
            if constexpr (SP2) {
            PG8_LDB(B0, 0, 0); PG8_LDB(B1, 0, 1); PG8_SCHED; PG8_LDA(At, 0, 0); PG8_STAGE(PG8_SA(1, 1), a1 + hstep, voffA);
            PG8_WAIT_V(8); PG8_WAIT_L(0); PG8_BAR; PG8_MMA(0, 0, At, B0); PG8_MMA(0, 1, At, B1); PG8_BAR; PG8_SCHED;
            PG8_LDA(At, 0, 1); PG8_STAGE(PG8_SB(0, 0), b2, voffB); PG8_STAGE(PG8_SB(0, 1), b2 + hstep, voffB); PG8_STAGE(PG8_SA(0, 0), a2, voffA);
            PG8_WAIT_V(8); PG8_WAIT_L(0); PG8_BAR; PG8_MMA(1, 0, At, B0); PG8_MMA(1, 1, At, B1); PG8_BAR; PG8_SCHED;
            PG8_LDB(B0, 1, 0); PG8_LDB(B1, 1, 1); PG8_SCHED; PG8_LDA(At, 1, 0); PG8_STAGE(PG8_SA(0, 1), a2 + hstep, voffA);
            PG8_WAIT_V(8); PG8_WAIT_L(0); PG8_BAR; PG8_MMA(0, 0, At, B0); PG8_MMA(0, 1, At, B1); PG8_BAR; PG8_SCHED;
            PG8_LDA(At, 1, 1); PG8_STAGE(PG8_SB(1, 0), b3, voffB); PG8_STAGE(PG8_SB(1, 1), b3 + hstep, voffB); PG8_STAGE(PG8_SA(1, 0), a3, voffA);
            PG8_WAIT_V(8); PG8_WAIT_L(0); PG8_BAR; PG8_MMA(1, 0, At, B0); PG8_MMA(1, 1, At, B1); PG8_BAR; PG8_SCHED;
            } else {
            PG8_LDB(B0, 0, 0); PG8_SCHED; PG8_LDA(At, 0, 0); PG8_STAGE(PG8_SA(1, 1), a1 + hstep, voffA);
            PG8_WAIT_L(8); PG8_BAR; PG8_WAIT_L(0); PG8_MMA(0, 0, At, B0); PG8_BAR; PG8_SCHED;
            PG8_LDB(B1, 0, 1); PG8_STAGE(PG8_SB(0, 0), b2, voffB);
            PG8_BAR; PG8_WAIT_L(0); PG8_MMA(0, 1, At, B1); PG8_BAR;
            PG8_LDA(At, 0, 1); PG8_STAGE(PG8_SA(0, 0), a2, voffA);
            PG8_BAR; PG8_WAIT_L(0); PG8_MMA(1, 0, At, B0); PG8_BAR; PG8_SCHED;
            PG8_STAGE(PG8_SB(0, 1), b2 + hstep, voffB);
            PG8_WAIT_V(6); PG8_BAR; PG8_MMA(1, 1, At, B1); PG8_BAR;
            PG8_LDB(B0, 1, 0); PG8_SCHED; PG8_LDA(At, 1, 0); PG8_STAGE(PG8_SA(0, 1), a2 + hstep, voffA);
            PG8_WAIT_L(8); PG8_BAR; PG8_WAIT_L(0); PG8_MMA(0, 0, At, B0); PG8_BAR; PG8_SCHED;
            PG8_LDB(B1, 1, 1); PG8_STAGE(PG8_SB(1, 0), b3, voffB);
            PG8_BAR; PG8_WAIT_L(0); PG8_MMA(0, 1, At, B1); PG8_BAR;
            PG8_LDA(At, 1, 1); PG8_STAGE(PG8_SA(1, 0), a3, voffA);
            PG8_BAR; PG8_WAIT_L(0); PG8_MMA(1, 0, At, B0); PG8_BAR; PG8_SCHED;
            PG8_STAGE(PG8_SB(1, 1), b3 + hstep, voffB);
            PG8_WAIT_V(6); PG8_BAR; PG8_MMA(1, 1, At, B1); PG8_BAR;
            }
        }
        if constexpr (ALIGN_EPI) { if (wr == 0) PG8_BAR; }
        if constexpr (!Epi::AFTER_DRAIN) { E(acc, cur, wr, wc, fr, fq); S.done(cur); }
        if (!has_next) break;
#pragma unroll
        for (int a = 0; a < 2; ++a)
#pragma unroll
            for (int b = 0; b < 2; ++b)
#pragma unroll
                for (int m = 0; m < 4; ++m)
#pragma unroll
                    for (int n = 0; n < 2; ++n) acc[a][b][m][n] = (f32x4){0.f, 0.f, 0.f, 0.f};
        cur = nxt; cA = nA; cB = nB; ++ui;
        if constexpr (ALIGN_EPI) { if (wr == 1) PG8_BAR; }
    }
    PG8_WAIT_V(0);
    if constexpr (!ALIGN_EPI) { if (wr == 0) PG8_BAR; }
    PG8_BAR;
    if constexpr (Epi::AFTER_DRAIN) { E.fused(acc, cur, wr, wc, fr, fq, lds, wid, lane); S.done(cur); }
#undef PG8_SA
#undef PG8_SB
#undef PG8_STAGE
#undef PG8_LDA
#undef PG8_LDB
#undef PG8_MMA
#undef PG8_WAIT_V
#undef PG8_WAIT_L
#undef PG8_BAR
#undef PG8_SCHED
}
}

#define DI __device__ __forceinline__
#define LAS __attribute__((address_space(3)))
typedef unsigned short bf16_t;
typedef short bf16x8 __attribute__((ext_vector_type(8)));
typedef _Float16 f16x8 __attribute__((ext_vector_type(8)));
typedef float f32x4 __attribute__((ext_vector_type(4)));
typedef float f32x16 __attribute__((ext_vector_type(16)));
typedef unsigned u32x4 __attribute__((ext_vector_type(4)));
typedef unsigned u32x2 __attribute__((ext_vector_type(2)));

constexpr int NB = 4, SEQ = 4096, T = NB * SEQ, D = 1024, DEPTH = 2;
constexpr int PLD = 3912;
constexpr int PC_Q = 0, PC_K = 512, PC_V = 1024, PC_QI = 1536, PC_KI = 2048, PC_WI = 2112;
constexpr int PC_R = 2120, PC_BK = 2632, PC_BV = 3144, PC_WD = 3656;
constexpr int NPROJ_PAD = 4096;
constexpr int NEXP = 16, DEXP = 256, PLE = 256;
constexpr float ALPHA = 1.4142135623730951f;
constexpr float LN_EPS = 1e-5f, GN_EPS = 64e-5f;
constexpr int MAXROWS = 2 * T + NEXP * 256;
constexpr int NWAVES = 8, NTHR = 512;

constexpr size_t MiB = 1u << 20;
constexpr size_t WS_CTL = 0, CTL_BYTES = 1 * MiB;
constexpr size_t WS_WEXP = 1 * MiB;
constexpr size_t WS_WDOWN = 17 * MiB;
constexpr size_t WS_WOUT = 25 * MiB, WS_WPG = 27 * MiB, WS_WPLE = 29 * MiB;
constexpr size_t WS_BM = 30 * MiB;
constexpr size_t WS_ELL = 38 * MiB, WS_AA = 70 * MiB, WS_GG = 102 * MiB;
constexpr size_t WS_PROJ = 119 * MiB;
constexpr size_t WS_PBF = 242 * MiB;
constexpr size_t WS_V = 119 * MiB;
constexpr size_t WS_AG = 38 * MiB;
constexpr size_t WS_H = 183 * MiB;
constexpr size_t WS_Y = 119 * MiB;
constexpr size_t WS_PE = 201 * MiB;
constexpr size_t WS_V3 = 38 * MiB;
constexpr size_t WS_TOK = 233 * MiB;
constexpr size_t WS_ROW = 234 * MiB;
constexpr int CW_GCNT = 1024;

struct TokInfo { int e0, e1, p0, p1; float g0, g1; int pad0, pad1; };
struct RowInfo { int token, slot; float gate; int pad; };

#define LDS_WAIT() asm volatile("s_waitcnt lgkmcnt(0)" ::: "memory")
#define VM_WAIT() asm volatile("s_waitcnt vmcnt(0)" ::: "memory")
DI unsigned f2bf(float f) { unsigned u = __builtin_bit_cast(unsigned, f); return (u + 0x7fffu + ((u >> 16) & 1u)) >> 16; }
DI unsigned pk2(float lo, float hi) { return pg8::cvt_pk_bf16(lo, hi); }
DI float bf2f(unsigned short b) { return __builtin_bit_cast(float, (unsigned)b << 16); }
DI float bflo(unsigned w) { return __builtin_bit_cast(float, w << 16); }
DI float bfhi(unsigned w) { return __builtin_bit_cast(float, w & 0xffff0000u); }
DI unsigned pk2h(float lo, float hi) { typedef _Float16 h2_t __attribute__((ext_vector_type(2))); h2_t v = {(_Float16)lo, (_Float16)hi}; return __builtin_bit_cast(unsigned, v); }
DI float wave_sum(float v) {
#pragma unroll
    for (int o = 1; o < 64; o <<= 1) v += __shfl_xor(v, o);
    return v;
}
DI int opaque_i(int v) { asm volatile("" : "+s"(v)); return v; }
DI float sigmoidf_(float x) { return 1.f / (1.f + __expf(-x)); }

struct Args { const float* in[31]; float* out; unsigned char* ws; int ph_lo, ph_hi; };
struct Ctx {
    LAS unsigned char* lds;
    int tid, lane, wave, G, blk;
    const __attribute__((address_space(4))) Args* ap;
    float* out; unsigned char* ws;
    unsigned* ctl;
    bf16_t* xcur; bf16_t* mixcat;
    DI const float* in(int i) const { return ap->in[i]; }
};

DI void ln16(f32x4 (&v)[4], const float* g, const float* b, int lane) {
    float s = 0.f;
#pragma unroll
    for (int j = 0; j < 4; ++j) s += (v[j].x + v[j].y) + (v[j].z + v[j].w);
    const float mean = wave_sum(s) * (1.f / D);
    float s2 = 0.f;
#pragma unroll
    for (int j = 0; j < 4; ++j) { v[j] = v[j] - mean; s2 += (v[j].x * v[j].x + v[j].y * v[j].y) + (v[j].z * v[j].z + v[j].w * v[j].w); }
    const float rstd = 1.f / sqrtf(wave_sum(s2) * (1.f / D) + LN_EPS);
#pragma unroll
    for (int j = 0; j < 4; ++j) { const f32x4 gg = *(const f32x4*)(g + 256 * j + 4 * lane), bb = *(const f32x4*)(b + 256 * j + 4 * lane); v[j] = v[j] * rstd * gg + bb; }
}
DI void store_row_bf16(bf16_t* row, const f32x4 (&v)[4], int lane) {
#pragma unroll
    for (int j = 0; j < 4; ++j) { u32x2 o; o.x = pk2(v[j].x, v[j].y); o.y = pk2(v[j].z, v[j].w); *(u32x2*)(row + 256 * j + 4 * lane) = o; }
}
DI void load_row_bf16(const bf16_t* row, f32x4 (&v)[4], int lane) {
#pragma unroll
    for (int j = 0; j < 4; ++j) { const u32x2 o = *(const u32x2*)(row + 256 * j + 4 * lane); v[j] = (f32x4){bflo(o.x), bfhi(o.x), bflo(o.y), bfhi(o.y)}; }
}

template <class ColPtr>
DI void transpose_item(const ColPtr colptr, int ld, int K, bf16_t* WT, int n0, int k0, LAS float* scr, int lane) {
    const float* sp = colptr(n0 + (lane & 31));
#pragma unroll 8
    for (int i = 0; i < 32; ++i) { const int kk = 2 * i + (lane >> 5); scr[kk * 33 + (lane & 31)] = sp ? sp[(size_t)(k0 + kk) * ld] : 0.f; }
    LDS_WAIT(); asm volatile("" ::: "memory");
    const int c = lane & 7;
#pragma unroll
    for (int j = 0; j < 4; ++j) { const int n = (lane >> 3) + 8 * j; const LAS float* s = scr + (8 * c) * 33 + n;
        u32x4 o; o.x = pk2(s[0 * 33], s[1 * 33]); o.y = pk2(s[2 * 33], s[3 * 33]); o.z = pk2(s[4 * 33], s[5 * 33]); o.w = pk2(s[6 * 33], s[7 * 33]);
        *(u32x4*)(WT + (size_t)(n0 + n) * K + k0 + 8 * c) = o; }
    LDS_WAIT(); asm volatile("" ::: "memory");
}
template <class ColPtr>
DI void convert_matrix(Ctx& C, const ColPtr colptr, int ld, int K, int N, bf16_t* WT, int& first) {
    LAS float* scr = (LAS float*)(C.lds + C.wave * 16384);
    const int gw = C.blk * NWAVES + C.wave, NGW = C.G * NWAVES;
    const int nblk = N / 32, nitems = (K / 64) * nblk;
    int it = gw - (first % NGW); if (it < 0) it += NGW;
    for (; it < nitems; it += NGW) transpose_item(colptr, ld, K, WT, 32 * (it % nblk), 64 * (it / nblk), scr, C.lane);
    first += nitems;
}

struct ColWin { const float* w; DI const float* operator()(int j) const { if (j < 2120) return w + j; if (j >= 2176 && j < 3968) return w + (j - 56); return nullptr; } };
struct ColPlain { const float* w; DI const float* operator()(int j) const { return w + j; } };
struct ColGateUp { const float* wg; const float* wu; DI const float* operator()(int j) const {
        const int e = j >> 9, pn = (j >> 8) & 1, jj = j & 255; const int col = pn * 128 + (jj & 127); const uintptr_t pg = (uintptr_t)wg, pu = (uintptr_t)wu; const uintptr_t sel = pg + ((jj >= 128) ? (pu - pg) : (uintptr_t)0); return (const float*)sel + (size_t)e * D * DEXP + col; } };
struct ColDown { const float* wd; DI const float* operator()(int j) const { return wd + j; } };

DI void phase_ln_in(Ctx& C) {
    const int gw = C.blk * NWAVES + C.wave, NGW = C.G * NWAVES;
    for (int m = gw; m < T; m += NGW) {
        f32x4 v[4]; const float* xr = C.in(0) + (size_t)m * D;
#pragma unroll
        for (int j = 0; j < 4; ++j) v[j] = *(const f32x4*)(xr + 256 * j + 4 * C.lane);
        ln16(v, C.in(2), C.in(3), C.lane);
        store_row_bf16(C.xcur + (size_t)m * D, v, C.lane);
    }
}
DI void convert_win(Ctx& C, int l) { int first = 0; ColWin cw{C.in(4) + (size_t)l * D * 3912}; convert_matrix(C, cw, 3912, D, NPROJ_PAD, (bf16_t*)(C.ws + WS_WEXP), first); }
DI void convert_layer_weights(Ctx& C, int l) {
    int first = 0;
    { ColPlain c{C.in(5) + (size_t)l * D * D}; convert_matrix(C, c, D, D, D, (bf16_t*)(C.ws + WS_WOUT), first); }
    { ColGateUp c{C.in(20) + (size_t)l * NEXP * D * DEXP, C.in(21) + (size_t)l * NEXP * D * DEXP}; convert_matrix(C, c, DEXP, D, NEXP * 512, (bf16_t*)(C.ws + WS_WEXP), first); }
    for (int e = 0; e < NEXP; ++e) { ColDown c{C.in(22) + ((size_t)l * NEXP + e) * DEXP * D}; convert_matrix(C, c, D, DEXP, D, (bf16_t*)(C.ws + WS_WDOWN) + (size_t)e * D * DEXP, first); }
    { ColPlain c{C.in(24) + (size_t)l * D * D}; convert_matrix(C, c, D, D, D, (bf16_t*)(C.ws + WS_WPG), first); }
    { ColPlain c{C.in(23) + (size_t)l * PLE * D}; convert_matrix(C, c, D, PLE, D, (bf16_t*)(C.ws + WS_WPLE), first); }
    const float* p = C.in(1) + (size_t)l * T * PLE; bf16_t* pb = (bf16_t*)(C.ws + WS_PBF);
    for (size_t i = ((size_t)C.blk * NTHR + C.tid) * 8; i < (size_t)T * PLE; i += (size_t)C.G * NTHR * 8) {
        const f32x4 a = *(const f32x4*)(p + i), b = *(const f32x4*)(p + i + 4);
        u32x4 o; o.x = pk2(a.x, a.y); o.y = pk2(a.z, a.w); o.z = pk2(b.x, b.y); o.w = pk2(b.z, b.w); *(u32x4*)(pb + i) = o; }
}

struct EpiProj {
    static constexpr bool PERM = true, AFTER_DRAIN = false;
    bf16_t* P;
    DI void operator()(const f32x4 (&acc)[2][2][4][2], const pg8::Unit& u, int wr, int wc, int fr, int fq) const {
        const int row0 = u.pm * 256 + wr * 64 + fr;
#pragma unroll
        for (int bj = 0; bj < 2; ++bj) {
            const int j0 = u.pn * 256 + bj * 128 + wc * 32 + 8 * fq;
            int dst; bool half = false;
            if (j0 < 2120) { dst = j0; half = (j0 >= 1536); } else if (j0 >= 2176 && j0 < 3968) dst = j0 - 56; else dst = -1;
            if (dst >= 0) {
#pragma unroll
                for (int ai = 0; ai < 2; ++ai)
#pragma unroll
                    for (int m = 0; m < 4; ++m) {
                        const f32x4 v0 = acc[ai][bj][m][0], v1 = acc[ai][bj][m][1]; u32x4 w;
                        if (half) { w.x = pk2h(v0[0], v0[1]); w.y = pk2h(v0[2], v0[3]); w.z = pk2h(v1[0], v1[1]); w.w = pk2h(v1[2], v1[3]); }
                        else { w.x = pk2(v0[0], v0[1]); w.y = pk2(v0[2], v0[3]); w.z = pk2(v1[0], v1[1]); w.w = pk2(v1[2], v1[3]); }
                        *(u32x4*)(P + (size_t)(row0 + ai * 128 + m * 16) * PLD + dst) = w; }
            }
        }
    }
};
struct EpiBf16Plain {
    static constexpr bool PERM = true, AFTER_DRAIN = false;
    bf16_t* O; int ldc;
    DI void operator()(const f32x4 (&acc)[2][2][4][2], const pg8::Unit& u, int wr, int wc, int fr, int fq) const {
        const int row0 = u.pm * 256 + wr * 64 + fr, col0 = u.pn * 256 + wc * 32 + 8 * fq;
#pragma unroll
        for (int ai = 0; ai < 2; ++ai)
#pragma unroll
            for (int m = 0; m < 4; ++m)
#pragma unroll
                for (int bj = 0; bj < 2; ++bj) { const f32x4 v0 = acc[ai][bj][m][0], v1 = acc[ai][bj][m][1]; u32x4 w; w.x = pk2(v0[0], v0[1]); w.y = pk2(v0[2], v0[3]); w.z = pk2(v1[0], v1[1]); w.w = pk2(v1[2], v1[3]);
                    *(u32x4*)(O + (size_t)(row0 + ai * 128 + m * 16) * ldc + col0 + bj * 128) = w; }
    }
};
struct EpiResF32 {
    static constexpr bool PERM = false, AFTER_DRAIN = false;
    const bf16_t* X; float* V;
    DI void operator()(const f32x4 (&acc)[2][2][4][2], const pg8::Unit& u, int wr, int wc, int fr, int fq) const {
        const int row0 = u.pm * 256 + wr * 64 + fr, col0 = u.pn * 256 + wc * 32 + 4 * fq;
#pragma unroll
        for (int ai = 0; ai < 2; ++ai)
#pragma unroll
            for (int m = 0; m < 4; ++m)
#pragma unroll
                for (int bj = 0; bj < 2; ++bj)
#pragma unroll
                    for (int n = 0; n < 2; ++n) { const size_t off = (size_t)(row0 + ai * 128 + m * 16) * D + col0 + bj * 128 + n * 16;
                        const u32x2 xb = *(const u32x2*)(X + off); const f32x4 xv = {bflo(xb.x), bfhi(xb.x), bflo(xb.y), bfhi(xb.y)};
                        *(f32x4*)(V + off) = xv * ALPHA + acc[ai][bj][m][n]; }
    }
};
struct EpiPle {
    static constexpr bool PERM = false, AFTER_DRAIN = false;
    const bf16_t* X; const bf16_t* PE; float* V;
    DI void operator()(const f32x4 (&acc)[2][2][4][2], const pg8::Unit& u, int wr, int wc, int fr, int fq) const {
        const int row0 = u.pm * 256 + wr * 64 + fr, col0 = u.pn * 256 + wc * 32 + 4 * fq;
#pragma unroll
        for (int ai = 0; ai < 2; ++ai)
#pragma unroll
            for (int m = 0; m < 4; ++m)
#pragma unroll
                for (int bj = 0; bj < 2; ++bj)
#pragma unroll
                    for (int n = 0; n < 2; ++n) { const size_t off = (size_t)(row0 + ai * 128 + m * 16) * D + col0 + bj * 128 + n * 16;
                        const u32x2 xb = *(const u32x2*)(X + off); const f32x4 xv = {bflo(xb.x), bfhi(xb.x), bflo(xb.y), bfhi(xb.y)};
                        const u32x2 pb = *(const u32x2*)(PE + off); const f32x4 pv = {bflo(pb.x), bfhi(pb.x), bflo(pb.y), bfhi(pb.y)};
                        const f32x4 a = acc[ai][bj][m][n]; f32x4 s; s.x = sigmoidf_(a.x); s.y = sigmoidf_(a.y); s.z = sigmoidf_(a.z); s.w = sigmoidf_(a.w);
                        *(f32x4*)(V + off) = xv * ALPHA + s * pv; }
    }
};
struct EpiSwiGLU {
    static constexpr bool PERM = true, AFTER_DRAIN = false;
    bf16_t* H; const RowInfo* R;
    DI void operator()(const f32x4 (&acc)[2][2][4][2], const pg8::Unit& u, int wr, int wc, int fr, int fq) const {
        const int row0 = u.pm * 256 + wr * 64 + fr, col0 = (u.pn & 1) * 128 + wc * 32 + 8 * fq;
#pragma unroll
        for (int ai = 0; ai < 2; ++ai)
#pragma unroll
            for (int m = 0; m < 4; ++m) { const int row = row0 + ai * 128 + m * 16; const float gw = R[row].gate;
                float h[8];
#pragma unroll
                for (int n = 0; n < 2; ++n)
#pragma unroll
                    for (int i = 0; i < 4; ++i) { const float g = acc[ai][0][m][n][i], up = acc[ai][1][m][n][i]; h[4 * n + i] = g * sigmoidf_(g) * up * gw; }
                u32x4 w; w.x = pk2(h[0], h[1]); w.y = pk2(h[2], h[3]); w.z = pk2(h[4], h[5]); w.w = pk2(h[6], h[7]);
                *(u32x4*)(H + (size_t)row * DEXP + col0) = w; }
    }
};
struct EpiDown {
    static constexpr bool PERM = true, AFTER_DRAIN = false;
    bf16_t* Y; const RowInfo* R;
    DI void operator()(const f32x4 (&acc)[2][2][4][2], const pg8::Unit& u, int wr, int wc, int fr, int fq) const {
        const int row0 = u.pm * 256 + wr * 64 + fr, col0 = (u.pn & 3) * 256 + wc * 32 + 8 * fq;
#pragma unroll
        for (int ai = 0; ai < 2; ++ai)
#pragma unroll
            for (int m = 0; m < 4; ++m) { const int row = row0 + ai * 128 + m * 16; const RowInfo ri = R[row];
                if (ri.token >= 0) { bf16_t* dst = Y + ((size_t)ri.slot * T + ri.token) * D + col0;
#pragma unroll
                    for (int bj = 0; bj < 2; ++bj) { const f32x4 v0 = acc[ai][bj][m][0], v1 = acc[ai][bj][m][1]; u32x4 w; w.x = pk2(v0[0], v0[1]); w.y = pk2(v0[2], v0[3]); w.z = pk2(v1[0], v1[1]); w.w = pk2(v1[2], v1[3]);
                        *(u32x4*)(dst + bj * 128) = w; } } }
    }
};
template <int NPN> struct GroupedOrder {
    const LAS int* texp; int ntiles, G, c;
    DI bool next(int i, pg8::Unit& u) const { const int L = i * G + c; if (L >= ntiles * NPN) return false; u.pm = L / NPN; u.pn = texp[u.pm] * NPN + (L % NPN); return true; }
    DI void a_ready(const pg8::Unit&) const {}
    DI void done(const pg8::Unit&) const {}
};

constexpr int IDX_CAP = 512;
DI unsigned ordkey(float s) { const unsigned b = __builtin_bit_cast(unsigned, s); return (b & 0x80000000u) ? ~b : (b | 0x80000000u); }
DI float unordkey(unsigned k) { const unsigned b = (k & 0x80000000u) ? (k & 0x7fffffffu) : ~k; return __builtin_bit_cast(float, b); }

DI void idx_item(Ctx& C, int item, int l) {
    const int b = item & 3, qt = 511 - (item >> 2);
    const int t0 = qt * 8, chunk = t0 >> 6, NT32 = 2 * (chunk + 1);
    const size_t tok0 = (size_t)b * SEQ + t0;
    unsigned* bm = (unsigned*)(C.ws + WS_BM);
    const int lane = C.lane, wave = C.wave, tid = C.tid;
    if (chunk < 4) {
        if (tid < 8 * NT32) { const int q = tid / NT32, kt = tid % NT32; bm[(tok0 + q) * 128 + kt] = 0xffffffffu; }
        return;
    }
    const _Float16* ph = (const _Float16*)(C.ws + WS_PROJ);
    LAS unsigned* hist = (LAS unsigned*)(C.lds);
    LAS float* candS = (LAS float*)(C.lds + 8192);
    LAS int* candI = (LAS int*)(C.lds + 24576);
    LAS float* redmn = (LAS float*)(C.lds + 40960);
    LAS float* redmx = redmn + 64;
    LAS int* selB = (LAS int*)(C.lds + 41472);
    LAS unsigned* selAbove = (LAS unsigned*)(selB + 8);
    LAS unsigned* ccount = selAbove + 8;
    LAS float* thrS = (LAS float*)(ccount + 8);
    LAS int* thrI = (LAS int*)(thrS + 8);
    LAS unsigned* ovf = (LAS unsigned*)(thrI + 8);
    LAS unsigned* fbT = ovf + 8;
    LAS unsigned* fbCnt = fbT + 8;
    LAS unsigned* fbNeed = fbCnt + 8;
    const int r = lane & 31, hh = lane >> 5;
    float sc[2][16][2];
#pragma unroll
    for (int m = 0; m < 2; ++m) {
        f16x8 afr[4]; float wq[2][8];
        {
            const int gq = (r >> 2) & 1, i = r >> 3, jj = r & 3, query = 4 * m + 2 * gq + (i >> 1), head = 4 * (i & 1) + jj;
            const _Float16* qp = ph + (tok0 + query) * PLD + PC_QI + head * 64 + 8 * hh;
#pragma unroll
            for (int s = 0; s < 4; ++s) afr[s] = *(const f16x8*)(qp + 16 * s);
#pragma unroll
            for (int qq = 0; qq < 2; ++qq) { const int q2 = 4 * m + 2 * hh + qq; const f16x8 wv = *(const f16x8*)(ph + (tok0 + q2) * PLD + PC_WI);
#pragma unroll
                for (int e = 0; e < 8; ++e) wq[qq][e] = (float)wv[e] * 0.044194173824159216f; }
        }
#pragma unroll
        for (int it = 0; it < 16; ++it) {
            const int kt = wave + 8 * it;
            if (kt < NT32) {
                const _Float16* kp = ph + ((size_t)b * SEQ + 32 * kt + r) * PLD + PC_KI + 8 * hh;
                f32x16 c = {};
#pragma unroll
                for (int s = 0; s < 4; ++s) { const f16x8 bfr = *(const f16x8*)(kp + 16 * s); c = __builtin_amdgcn_mfma_f32_32x32x16_f16(afr[s], bfr, c, 0, 0, 0); }
#pragma unroll
                for (int qq = 0; qq < 2; ++qq) { float a = 0.f;
#pragma unroll
                    for (int e = 0; e < 8; ++e) a += wq[qq][e] * fmaxf(c[8 * qq + e], 0.f);
                    sc[m][it][qq] = a; }
            } else { sc[m][it][0] = 0.f; sc[m][it][1] = 0.f; }
            __builtin_amdgcn_sched_barrier(0);
        }
    }
    float mn[2][2], mx[2][2];
#pragma unroll
    for (int m = 0; m < 2; ++m)
#pragma unroll
        for (int qq = 0; qq < 2; ++qq) { float a = 3.0e38f, z = -3.0e38f;
#pragma unroll
            for (int it = 0; it < 16; ++it) if (wave + 8 * it < NT32) { a = fminf(a, sc[m][it][qq]); z = fmaxf(z, sc[m][it][qq]); }
#pragma unroll
            for (int o = 1; o < 32; o <<= 1) { a = fminf(a, __shfl_xor(a, o)); z = fmaxf(z, __shfl_xor(z, o)); }
            mn[m][qq] = a; mx[m][qq] = z; }
    __syncthreads();
    if (r == 0) {
#pragma unroll
        for (int m = 0; m < 2; ++m)
#pragma unroll
            for (int qq = 0; qq < 2; ++qq) { const int qid = 4 * m + 2 * hh + qq; redmn[wave * 8 + qid] = mn[m][qq]; redmx[wave * 8 + qid] = mx[m][qq]; }
    }
    for (int i = tid; i < 2048; i += NTHR) hist[i] = 0u;
    if (tid < 8) { ccount[tid] = 0u; ovf[tid] = 0u; }
    __syncthreads();
    float lo[2][2], scl[2][2];
#pragma unroll
    for (int m = 0; m < 2; ++m)
#pragma unroll
        for (int qq = 0; qq < 2; ++qq) { const int qid = 4 * m + 2 * hh + qq; float a = 3.0e38f, z = -3.0e38f;
#pragma unroll
            for (int w = 0; w < 8; ++w) { a = fminf(a, redmn[w * 8 + qid]); z = fmaxf(z, redmx[w * 8 + qid]); }
            lo[m][qq] = a; scl[m][qq] = (z > a) ? 256.f / (z - a) : 0.f; }
#define IDX_BIN(m, it, qq) min(255, (int)((sc[m][it][qq] - lo[m][qq]) * scl[m][qq]))
#define IDX_LAUNDER() do { _Pragma("unroll") for (int m_ = 0; m_ < 2; ++m_) _Pragma("unroll") for (int q_ = 0; q_ < 2; ++q_) { asm volatile("" : "+v"(lo[m_][q_]), "+v"(scl[m_][q_])); } } while (0)
#pragma unroll
    for (int m = 0; m < 2; ++m)
#pragma unroll
        for (int qq = 0; qq < 2; ++qq) { const int qid = 4 * m + 2 * hh + qq;
#pragma unroll
            for (int it = 0; it < 16; ++it) if (wave + 8 * it < NT32) __hip_atomic_fetch_add(hist + qid * 256 + IDX_BIN(m, it, qq), 1u, __ATOMIC_RELAXED, __HIP_MEMORY_SCOPE_WORKGROUP); }
    __syncthreads();
    {
        const u32x4 h4 = *(const LAS u32x4*)(hist + wave * 256 + 4 * lane);
        const unsigned tot = h4.x + h4.y + h4.z + h4.w; unsigned incl = tot;
#pragma unroll
        for (int o = 1; o < 64; o <<= 1) { const unsigned v = __shfl_down(incl, o); if (lane + o < 64) incl += v; }
        unsigned run = incl - tot; int Bf = -1; unsigned ab = 0;
#pragma unroll
        for (int j = 3; j >= 0; --j) { const unsigned h = h4[j]; if (run < 256u && run + h >= 256u) { Bf = 4 * lane + j; ab = run; } run += h; }
        if (Bf >= 0) { selB[wave] = Bf; selAbove[wave] = ab; }
    }
    __syncthreads();
    IDX_LAUNDER();
#pragma unroll
    for (int m = 0; m < 2; ++m)
#pragma unroll
        for (int qq = 0; qq < 2; ++qq) { const int qid = 4 * m + 2 * hh + qq; const int B = selB[qid];
#pragma unroll
            for (int it = 0; it < 16; ++it) if (wave + 8 * it < NT32) { if (IDX_BIN(m, it, qq) == B) { const unsigned pos = __hip_atomic_fetch_add(ccount + qid, 1u, __ATOMIC_RELAXED, __HIP_MEMORY_SCOPE_WORKGROUP);
                if (pos < (unsigned)IDX_CAP) { candS[qid * IDX_CAP + pos] = sc[m][it][qq]; candI[qid * IDX_CAP + pos] = 32 * (wave + 8 * it) + r; } } } }
    __syncthreads();
    {
        const int c = (int)ccount[wave]; const int need = 256 - (int)selAbove[wave];
        if (c <= IDX_CAP) {
            for (int i = lane; i < c; i += 64) { const float si = candS[wave * IDX_CAP + i]; const int ii = candI[wave * IDX_CAP + i]; int rank = 0;
                for (int j = 0; j < c; ++j) { const float sj = candS[wave * IDX_CAP + j]; const int ij = candI[wave * IDX_CAP + j]; rank += ((sj > si) || (sj == si && ij < ii)) ? 1 : 0; }
                if (rank == need - 1) { thrS[wave] = si; thrI[wave] = ii; } }
        } else if (lane == 0) { ovf[wave] = 1u; fbNeed[wave] = (unsigned)need; fbT[wave] = 0u; }
    }
    __syncthreads();
    unsigned anyovf = 0u;
#pragma unroll
    for (int q = 0; q < 8; ++q) anyovf |= ovf[q];
    if (anyovf) {
        for (int bit = 31; bit >= 0; --bit) {
            if (tid < 8) fbCnt[tid] = 0u;
            __syncthreads();
            IDX_LAUNDER();
#pragma unroll
            for (int m = 0; m < 2; ++m)
#pragma unroll
                for (int qq = 0; qq < 2; ++qq) { const int qid = 4 * m + 2 * hh + qq; if (ovf[qid]) { const unsigned cand = fbT[qid] | (1u << bit); const int B = selB[qid]; unsigned cnt = 0;
#pragma unroll
                    for (int it = 0; it < 16; ++it) if (wave + 8 * it < NT32) cnt += (IDX_BIN(m, it, qq) == B && ordkey(sc[m][it][qq]) >= cand) ? 1u : 0u;
                    if (cnt) __hip_atomic_fetch_add(fbCnt + qid, cnt, __ATOMIC_RELAXED, __HIP_MEMORY_SCOPE_WORKGROUP); } }
            __syncthreads();
            if (tid < 8 && ovf[tid] && fbCnt[tid] >= fbNeed[tid]) fbT[tid] |= (1u << bit);
            __syncthreads();
        }
        if (tid < 8) fbCnt[tid] = 0u;
        __syncthreads();
        IDX_LAUNDER();
#pragma unroll
        for (int m = 0; m < 2; ++m)
#pragma unroll
            for (int qq = 0; qq < 2; ++qq) { const int qid = 4 * m + 2 * hh + qq; if (ovf[qid]) { const unsigned Tk = fbT[qid]; const int B = selB[qid]; unsigned cnt = 0;
#pragma unroll
                for (int it = 0; it < 16; ++it) if (wave + 8 * it < NT32) cnt += (IDX_BIN(m, it, qq) == B && ordkey(sc[m][it][qq]) > Tk) ? 1u : 0u;
                if (cnt) __hip_atomic_fetch_add(fbCnt + qid, cnt, __ATOMIC_RELAXED, __HIP_MEMORY_SCOPE_WORKGROUP); } }
        __syncthreads();
        if (tid < 8 && ovf[tid]) { fbNeed[tid] -= fbCnt[tid]; thrS[tid] = unordkey(fbT[tid]); thrI[tid] = 0; }
        __syncthreads();
        for (int bit = 11; bit >= 0; --bit) {
            if (tid < 8) fbCnt[tid] = 0u;
            __syncthreads();
            IDX_LAUNDER();
#pragma unroll
            for (int m = 0; m < 2; ++m)
#pragma unroll
                for (int qq = 0; qq < 2; ++qq) { const int qid = 4 * m + 2 * hh + qq; if (ovf[qid]) { const unsigned Tk = fbT[qid]; const int B = selB[qid]; const int cand = thrI[qid] | (1 << bit); unsigned cnt = 0;
#pragma unroll
                    for (int it = 0; it < 16; ++it) if (wave + 8 * it < NT32) cnt += (IDX_BIN(m, it, qq) == B && ordkey(sc[m][it][qq]) == Tk && (32 * (wave + 8 * it) + r) < cand) ? 1u : 0u;
                    if (cnt) __hip_atomic_fetch_add(fbCnt + qid, cnt, __ATOMIC_RELAXED, __HIP_MEMORY_SCOPE_WORKGROUP); } }
            __syncthreads();
            if (tid < 8 && ovf[tid] && fbCnt[tid] < fbNeed[tid]) thrI[tid] |= (1 << bit);
            __syncthreads();
        }
    }
    IDX_LAUNDER();
#pragma unroll
    for (int m = 0; m < 2; ++m)
#pragma unroll
        for (int qq = 0; qq < 2; ++qq) { const int qid = 4 * m + 2 * hh + qq; const int B = selB[qid]; const float ts = thrS[qid]; const int ti = thrI[qid];
#pragma unroll
            for (int it = 0; it < 16; ++it) { const int kt = wave + 8 * it;
                if (kt < NT32) { const int bin = IDX_BIN(m, it, qq); const float s = sc[m][it][qq]; const int idx = 32 * kt + r;
                    const bool sel = (bin > B) || (bin == B && (s > ts || (s == ts && idx <= ti)));
                    const unsigned long long mk = __ballot(sel);
                    if (r == 0) bm[(tok0 + qid) * 128 + kt] = hh ? (unsigned)(mk >> 32) : (unsigned)mk; } } }
#undef IDX_BIN
#undef IDX_LAUNDER
}

DI float softplusf_(float z) { return fmaxf(z, 0.f) + log1pf(expf(-fabsf(z))); }
DI void attn_unit(Ctx& C, int b, int h, int qb) {
    const int tid = C.tid, lane = C.lane, wave = C.wave, r32 = lane & 31, hi = lane >> 5;
    const bf16_t* proj = (const bf16_t*)(C.ws + WS_PROJ);
    const unsigned* bm = (const unsigned*)(C.ws + WS_BM);
    LAS unsigned char* Kl = C.lds; LAS unsigned char* Vl = C.lds + 16384; LAS float* tab = (LAS float*)(C.lds + 33792);
    const size_t rowbase = (size_t)b * SEQ; const int q0 = qb * 256, qw = q0 + 32 * wave, myq = qw + r32;
    const int NT = 4 * qb + 4, mylast = qw >> 6;
    constexpr float LOG2E = 1.4426950408889634f;
    __syncthreads();
    if (tid < 192) { const int rel = tid - 128; const int n = rel < 0 ? -rel : rel; int bk = rel > 0 ? 16 : 0;
        if (n < 8) bk += n; else bk += 8 + (n >= 12) + (n >= 16) + (n >= 23) + (n >= 32) + (n >= 46) + (n >= 64) + (n >= 91);
        tab[tid] = C.in(17)[bk * 8 + h] * LOG2E; }
    const float bias_far = C.in(17)[15 * 8 + h] * LOG2E;
    bf16x8 qr[4];
    { const bf16_t* qp = proj + (rowbase + myq) * PLD + PC_Q + h * 64 + 8 * hi;
#pragma unroll
        for (int s = 0; s < 4; ++s) qr[s] = *(const bf16x8*)(qp + 16 * s); }
    const unsigned* bmrow = bm + (rowbase + myq) * 128;
    const int skv = tid >> 3, sch = tid & 7;
    const bf16_t* ksrc = proj + (rowbase + skv) * PLD + PC_K + h * 64 + 8 * sch;
    const bf16_t* vsrc = proj + (rowbase + skv) * PLD + PC_V + h * 64 + 8 * sch;
    const int kdst = skv * 128 + ((sch ^ ((skv >> 1) & 7)) << 4);
    u32x4 kreg = *(const u32x4*)ksrc, vreg = *(const u32x4*)vsrc;
    unsigned mw0 = bmrow[0], mw1 = bmrow[1];
#define ATT_WRITE(buf) do { *(LAS u32x4*)(Kl + (buf) * 8192 + kdst) = kreg; LAS bf16_t* vt_ = (LAS bf16_t*)(Vl + (buf) * 8704); \
        vt_[(8 * sch + 0) * 68 + skv] = (bf16_t)(vreg.x & 0xffffu); vt_[(8 * sch + 1) * 68 + skv] = (bf16_t)(vreg.x >> 16); \
        vt_[(8 * sch + 2) * 68 + skv] = (bf16_t)(vreg.y & 0xffffu); vt_[(8 * sch + 3) * 68 + skv] = (bf16_t)(vreg.y >> 16); \
        vt_[(8 * sch + 4) * 68 + skv] = (bf16_t)(vreg.z & 0xffffu); vt_[(8 * sch + 5) * 68 + skv] = (bf16_t)(vreg.z >> 16); \
        vt_[(8 * sch + 6) * 68 + skv] = (bf16_t)(vreg.w & 0xffffu); vt_[(8 * sch + 7) * 68 + skv] = (bf16_t)(vreg.w >> 16); } while (0)
    ATT_WRITE(0);
    __syncthreads();
    float m_run = -1.0e30f, l_run = 0.f; f32x16 o0 = {}, o1 = {};
    for (int j = 0; j < NT; ++j) {
        const int buf = j & 1;
        unsigned cw0 = mw0, cw1 = mw1;
        if (j + 1 < NT) { kreg = *(const u32x4*)(ksrc + (size_t)(j + 1) * 64 * PLD); vreg = *(const u32x4*)(vsrc + (size_t)(j + 1) * 64 * PLD); mw0 = bmrow[2 * j + 2]; mw1 = bmrow[2 * j + 3]; }
        if (j <= mylast) {
            f32x16 p0 = {}, p1 = {};
            const LAS unsigned char* kb = Kl + buf * 8192;
#pragma unroll
            for (int s = 0; s < 4; ++s) { const int ch = 2 * s + hi;
                const bf16x8 ka0 = *(const LAS bf16x8*)(kb + r32 * 128 + ((ch ^ ((r32 >> 1) & 7)) << 4));
                const bf16x8 ka1 = *(const LAS bf16x8*)(kb + (32 + r32) * 128 + ((ch ^ (((32 + r32) >> 1) & 7)) << 4));
                p0 = __builtin_amdgcn_mfma_f32_32x32x16_bf16(ka0, qr[s], p0, 0, 0, 0);
                p1 = __builtin_amdgcn_mfma_f32_32x32x16_bf16(ka1, qr[s], p1, 0, 0, 0); }
            const bool far = (64 * j + 63 - qw) <= -128;
            if (far) {
#pragma unroll
                for (int g = 0; g < 16; ++g) { p0[g] = p0[g] * (0.125f * LOG2E) + bias_far; p1[g] = p1[g] * (0.125f * LOG2E) + bias_far; }
            } else {
#pragma unroll
                for (int g = 0; g < 16; ++g) { const int kv0 = 64 * j + (g & 3) + 8 * (g >> 2) + 4 * hi; int r0 = kv0 - myq, r1 = r0 + 32;
                    r0 = r0 < -128 ? -128 : r0; r1 = r1 < -128 ? -128 : r1;
                    p0[g] = p0[g] * (0.125f * LOG2E) + tab[r0 + 128]; p1[g] = p1[g] * (0.125f * LOG2E) + tab[r1 + 128]; }
            }
            float mx = p0[0];
#pragma unroll
            for (int g = 1; g < 16; ++g) mx = fmaxf(mx, p0[g]);
#pragma unroll
            for (int g = 0; g < 16; ++g) mx = fmaxf(mx, p1[g]);
            mx = fmaxf(mx, __shfl_xor(mx, 32));
            const float m_new = fmaxf(m_run, mx); const float alpha = __builtin_amdgcn_exp2f(m_run - m_new); m_run = m_new;
            const unsigned sw0 = cw0 >> (4 * hi), sw1 = cw1 >> (4 * hi);
            float ls = 0.f;
#pragma unroll
            for (int g = 0; g < 16; ++g) { const int bit = (g & 3) + 8 * (g >> 2);
                const float e0 = __builtin_amdgcn_exp2f(p0[g] - m_new), e1 = __builtin_amdgcn_exp2f(p1[g] - m_new);
                p0[g] = ((sw0 >> bit) & 1u) ? e0 : 0.f; p1[g] = ((sw1 >> bit) & 1u) ? e1 : 0.f; ls += p0[g] + p1[g]; }
            l_run = l_run * alpha + ls;
#pragma unroll
            for (int g = 0; g < 16; ++g) { o0[g] *= alpha; o1[g] *= alpha; }
            bf16x8 pb[4];
#pragma unroll
            for (int s = 0; s < 2; ++s) {
                u32x4 w; w.x = pk2(p0[8 * s], p0[8 * s + 1]); w.y = pk2(p0[8 * s + 2], p0[8 * s + 3]); w.z = pk2(p0[8 * s + 4], p0[8 * s + 5]); w.w = pk2(p0[8 * s + 6], p0[8 * s + 7]); pb[s] = __builtin_bit_cast(bf16x8, w);
                u32x4 x; x.x = pk2(p1[8 * s], p1[8 * s + 1]); x.y = pk2(p1[8 * s + 2], p1[8 * s + 3]); x.z = pk2(p1[8 * s + 4], p1[8 * s + 5]); x.w = pk2(p1[8 * s + 6], p1[8 * s + 7]); pb[2 + s] = __builtin_bit_cast(bf16x8, x); }
            const LAS unsigned char* vb = Vl + buf * 8704;
#pragma unroll
            for (int s = 0; s < 4; ++s) {
                const u32x2 a0l = *(const LAS u32x2*)(vb + (r32) * 136 + (16 * s + 4 * hi) * 2), a0h = *(const LAS u32x2*)(vb + (r32) * 136 + (16 * s + 8 + 4 * hi) * 2);
                const u32x2 a1l = *(const LAS u32x2*)(vb + (32 + r32) * 136 + (16 * s + 4 * hi) * 2), a1h = *(const LAS u32x2*)(vb + (32 + r32) * 136 + (16 * s + 8 + 4 * hi) * 2);
                const u32x4 A0 = {a0l.x, a0l.y, a0h.x, a0h.y}, A1 = {a1l.x, a1l.y, a1h.x, a1h.y};
                o0 = __builtin_amdgcn_mfma_f32_32x32x16_bf16(__builtin_bit_cast(bf16x8, A0), pb[s], o0, 0, 0, 0);
                o1 = __builtin_amdgcn_mfma_f32_32x32x16_bf16(__builtin_bit_cast(bf16x8, A1), pb[s], o1, 0, 0, 0); }
        }
        if (j + 1 < NT) ATT_WRITE(buf ^ 1);
        __syncthreads();
    }
#undef ATT_WRITE
    const float lt = l_run + __shfl_xor(l_run, 32); const float inv = 1.f / lt;
    bf16_t* orow = C.mixcat + (rowbase + myq) * D + h * 64;
#pragma unroll
    for (int i = 0; i < 4; ++i) { const int d = 8 * i + 4 * hi;
        u32x2 w0; w0.x = pk2(o0[4 * i] * inv, o0[4 * i + 1] * inv); w0.y = pk2(o0[4 * i + 2] * inv, o0[4 * i + 3] * inv); *(u32x2*)(orow + d) = w0;
        u32x2 w1; w1.x = pk2(o1[4 * i] * inv, o1[4 * i + 1] * inv); w1.y = pk2(o1[4 * i + 2] * inv, o1[4 * i + 3] * inv); *(u32x2*)(orow + 32 + d) = w1; }
}

constexpr size_t WS_S0 = 1 * MiB;
constexpr size_t WS_PHI = 38 * MiB, WS_PSI = 54 * MiB, WS_GT = 70 * MiB, WS_Y0T = 86 * MiB, WS_GGT = 102 * MiB, WS_RHO = 118 * MiB;
constexpr size_t WS_LORA = 250 * MiB;
DI int crow(int g, int hi) { return (g & 3) + 8 * (g >> 2) + 4 * hi; }
DI f32x16 mfma32(bf16x8 a, bf16x8 b, f32x16 c) { return __builtin_amdgcn_mfma_f32_32x32x16_bf16(a, b, c, 0, 0, 0); }
struct FA { float v[16]; DI float& operator[](int i) { return v[i]; } DI const float& operator[](int i) const { return v[i]; } };
struct F8 { float v[8]; DI float& operator[](int i) { return v[i]; } DI const float& operator[](int i) const { return v[i]; } };
DI bf16x8 pack8(const F8& a) { u32x4 w; w.x = pk2(a[0], a[1]); w.y = pk2(a[2], a[3]); w.z = pk2(a[4], a[5]); w.w = pk2(a[6], a[7]); return __builtin_bit_cast(bf16x8, w); }
DI void pin(FA& a) { asm volatile("" : "+v"(a.v[0]), "+v"(a.v[1]), "+v"(a.v[2]), "+v"(a.v[3]), "+v"(a.v[4]), "+v"(a.v[5]), "+v"(a.v[6]), "+v"(a.v[7]), "+v"(a.v[8]), "+v"(a.v[9]), "+v"(a.v[10]), "+v"(a.v[11]), "+v"(a.v[12]), "+v"(a.v[13]), "+v"(a.v[14]), "+v"(a.v[15])); }
DI void pinf(bf16x8& a) { asm volatile("" : "+v"(a)); }
DI FA toFA(const f32x16& a) { FA r; _Pragma("unroll") for (int i = 0; i < 16; ++i) r.v[i] = a[i]; return r; }
DI f32x16 toV(const FA& a) { f32x16 r; _Pragma("unroll") for (int i = 0; i < 16; ++i) r[i] = a.v[i]; return r; }
DI bf16x8 packfrag(const FA& a, int s) { u32x4 w; w.x = pk2(a[8 * s], a[8 * s + 1]); w.y = pk2(a[8 * s + 2], a[8 * s + 3]); w.z = pk2(a[8 * s + 4], a[8 * s + 5]); w.w = pk2(a[8 * s + 6], a[8 * s + 7]); return __builtin_bit_cast(bf16x8, w); }
DI bf16x8 packfrag(const f32x16& a, int s) { u32x4 w; w.x = pk2(a[8 * s], a[8 * s + 1]); w.y = pk2(a[8 * s + 2], a[8 * s + 3]); w.z = pk2(a[8 * s + 4], a[8 * s + 5]); w.w = pk2(a[8 * s + 6], a[8 * s + 7]); return __builtin_bit_cast(bf16x8, w); }
DI unsigned opq(unsigned v) { asm volatile("" : "+v"(v)); return v; }
DI void st_frag(unsigned char* buf, int f, int lane, bf16x8 v) { *(bf16x8*)(buf + f * 1024 + opq(lane * 16)) = v; }
DI bf16x8 ld_frag(const unsigned char* buf, int f, int lane) { return *(const bf16x8*)(buf + f * 1024 + opq(lane * 16)); }
template <class TT> DI void st_tile_bf16(unsigned char* buf, int q, int lane, const TT& a) { const unsigned o = opq(lane * 32); *(bf16x8*)(buf + q * 2048 + o) = packfrag(a, 0); *(bf16x8*)(buf + q * 2048 + o + 16) = packfrag(a, 1); }
DI FA ld_tile_bf16(const unsigned char* buf, int q, int lane) { const unsigned o = opq(lane * 32); const u32x4 a = *(const u32x4*)(buf + q * 2048 + o), b = *(const u32x4*)(buf + q * 2048 + o + 16); FA r;
    r[0] = bflo(a.x); r[1] = bfhi(a.x); r[2] = bflo(a.y); r[3] = bfhi(a.y); r[4] = bflo(a.z); r[5] = bfhi(a.z); r[6] = bflo(a.w); r[7] = bfhi(a.w);
    r[8] = bflo(b.x); r[9] = bfhi(b.x); r[10] = bflo(b.y); r[11] = bfhi(b.y); r[12] = bflo(b.z); r[13] = bfhi(b.z); r[14] = bflo(b.w); r[15] = bfhi(b.w); return r; }
DI float fexp(float x) { return __builtin_amdgcn_exp2f(x * 1.4426950408889634f); }
DI float flog(float x) { return __builtin_amdgcn_logf(x) * 0.6931471805599453f; }
DI float ftanh(float x) { return 1.f - 2.f * __builtin_amdgcn_rcpf(1.f + fexp(2.f * x)); }
DI float fsigm(float x) { return __builtin_amdgcn_rcpf(1.f + fexp(-x)); }
DI float fsoftplus(float z) { return fmaxf(z, 0.f) + flog(1.f + fexp(-fabsf(z))); }
template <int ACT> DI bf16x8 act_frag(const bf16_t* proj, size_t row, bool first, int c0, const float* mu8) {
    const bf16_t* rp = proj + opq((unsigned)(row * PLD)); const u32x4 cu = *(const u32x4*)(rp + c0); u32x4 pv = {0u, 0u, 0u, 0u}; if (!first) pv = *(const u32x4*)(rp - PLD + c0);
    const float* mq = mu8 + opq(0u); const f32x4 m0 = *(const f32x4*)(mq), m1 = *(const f32x4*)(mq + 4);
    float x[8];
#pragma unroll
    for (int q = 0; q < 4; ++q) { const float c_lo = bflo(cu[q]), c_hi = bfhi(cu[q]), p_lo = bflo(pv[q]), p_hi = bfhi(pv[q]); const float ma = (q < 2) ? m0[2 * q] : m1[2 * q - 4], mb = (q < 2) ? m0[2 * q + 1] : m1[2 * q - 3];
        x[2 * q] = c_lo + (p_lo - c_lo) * ma; x[2 * q + 1] = c_hi + (p_hi - c_hi) * mb; }
#pragma unroll
    for (int e = 0; e < 8; ++e) { if (ACT == 1) x[e] = ftanh(x[e]); else if (ACT == 2) x[e] = fsigm(x[e]); }
    u32x4 w; w.x = pk2(x[0], x[1]); w.y = pk2(x[2], x[3]); w.z = pk2(x[4], x[5]); w.w = pk2(x[6], x[7]); return __builtin_bit_cast(bf16x8, w);
}
DI f32x4 shift4(const bf16_t* proj, size_t row, bool first, int c4, const float* mu4) {
    const bf16_t* rp = proj + opq((unsigned)(row * PLD)); const u32x2 cu = *(const u32x2*)(rp + c4); u32x2 pv = {0u, 0u}; if (!first) pv = *(const u32x2*)(rp - PLD + c4);
    const f32x4 m = *(const f32x4*)(mu4 + opq(0u)); const f32x4 c = {bflo(cu.x), bfhi(cu.x), bflo(cu.y), bfhi(cu.y)}, p = {bflo(pv.x), bfhi(pv.x), bflo(pv.y), bfhi(pv.y)};
    return c + (p - c) * m;
}
DI f32x4 shiftT4(const bf16_t* proj, size_t row, bool firstseq, int c1, float mu1) {
    const bf16_t* rp = proj + opq((unsigned)(row * PLD + c1));
    const float c0 = bf2f(rp[0]), c1_ = bf2f(rp[PLD]), c2 = bf2f(rp[2 * PLD]), c3 = bf2f(rp[3 * PLD]);
    const float pm = firstseq ? 0.f : bf2f(*(rp - PLD));
    f32x4 r; r.x = c0 + (pm - c0) * mu1; r.y = c1_ + (c0 - c1_) * mu1; r.z = c2 + (c1_ - c2) * mu1; r.w = c3 + (c2 - c3) * mu1; return r;
}
DI float scan32_incl(float x, int tl) {
#pragma unroll
    for (int d = 1; d < 32; d <<= 1) { const float y = __shfl_up(x, d, 32); if (tl >= d) x += y; }
    return x;
}

constexpr int RL_ACT = 0;
constexpr int RL_MAB = 0, RL_W1C = 17408, RL_W2C = 26624;
constexpr int RL_ELL = 35840;
constexpr int RL_AV = RL_ELL + 16640, RL_MAK = RL_ELL, RL_NRB = RL_ELL + 9216, RL_NRK = RL_ELL + 18432;
constexpr int RL_AT = 69120, RL_RT = RL_AT + 9216, RL_BT = RL_AT + 18432, RL_KT = RL_AT + 27648;
constexpr int RL_BHC = 105984, RL_KHC = RL_BHC + 9216, RL_VC = RL_BHC + 18432;
constexpr int RL_X = 133632;
constexpr int RL_SM = 150272;
constexpr int RL_END = RL_SM + 512;
template <int KS> DI f32x16 mm_ll(const LAS bf16_t* a, int pa, const LAS bf16_t* b, int pb, int lane, f32x16 acc) {
    const LAS bf16_t* ap = a + (lane & 31) * pa + 8 * (lane >> 5); const LAS bf16_t* bp = b + (lane & 31) * pb + 8 * (lane >> 5);
#pragma unroll
    for (int s = 0; s < KS; ++s) acc = mfma32(*(const LAS bf16x8*)(ap + 16 * s), *(const LAS bf16x8*)(bp + 16 * s), acc);
    return acc;
}
DI void rwkv_head_item(Ctx& C, int item, int l) {
    const int h = item & 7, chunk = (item >> 3) & 63, b = item >> 9, tid = C.tid, lane = C.lane, wave = C.wave, tl = lane & 31, hi = lane >> 5;
    const size_t tok0 = (size_t)b * SEQ + chunk * 64;
    const bf16_t* proj = (const bf16_t*)(C.ws + WS_PROJ);
    const size_t chid = ((size_t)(b * 8 + h) * 64 + chunk) * 8192;
    unsigned char* PHI = C.ws + WS_PHI + chid; unsigned char* PSI = C.ws + WS_PSI + chid; unsigned char* GT = C.ws + WS_GT + chid; unsigned char* Y0T = C.ws + WS_Y0T + chid; unsigned char* GGT = C.ws + WS_GGT + chid;
    const bf16_t* WDT = (const bf16_t*)(C.ws + WS_LORA); const bf16_t* WAT = WDT + 512 * 64; const bf16_t* WGT = WAT + 512 * 64;
    const float* mu = C.in(6) + (size_t)l * 1792;
    const float* w0p = C.in(7) + l * 512 + 64 * h; const float* a0p = C.in(9) + l * 512 + 64 * h;
    const float* kkp = C.in(12) + l * 512 + 64 * h; const float* kap = C.in(13) + l * 512 + 64 * h; const float* rkp = C.in(14) + l * 512 + 64 * h;
    LAS bf16_t* ACT = (LAS bf16_t*)(C.lds + RL_ACT); LAS float* MAB = (LAS float*)(C.lds + RL_MAB); LAS bf16_t* W1C = (LAS bf16_t*)(C.lds + RL_W1C); LAS bf16_t* W2C = (LAS bf16_t*)(C.lds + RL_W2C);
    LAS float* ELL = (LAS float*)(C.lds + RL_ELL); LAS float* AV = (LAS float*)(C.lds + RL_AV);
    LAS bf16_t* MAK = (LAS bf16_t*)(C.lds + RL_MAK); LAS bf16_t* NRB = (LAS bf16_t*)(C.lds + RL_NRB); LAS bf16_t* NRK = (LAS bf16_t*)(C.lds + RL_NRK);
    LAS bf16_t* AT = (LAS bf16_t*)(C.lds + RL_AT); LAS bf16_t* RT = (LAS bf16_t*)(C.lds + RL_RT); LAS bf16_t* BT = (LAS bf16_t*)(C.lds + RL_BT); LAS bf16_t* KT = (LAS bf16_t*)(C.lds + RL_KT);
    LAS bf16_t* BHC = (LAS bf16_t*)(C.lds + RL_BHC); LAS bf16_t* KHC = (LAS bf16_t*)(C.lds + RL_KHC); LAS bf16_t* VC = (LAS bf16_t*)(C.lds + RL_VC);
    LAS float* X = (LAS float*)(C.lds + RL_X); LAS float* INV = (LAS float*)(C.lds + RL_SM); LAS float* LCv = INV + 64;
    __syncthreads();
    { const int t = tid >> 3, cg = tid & 7; const size_t row = tok0 + t; const bool first = (chunk == 0 && t == 0);
#pragma unroll
        for (int q = 0; q < 4; ++q) { const int c8 = cg * 32 + 8 * q; bf16x8 v;
            if (c8 < 64) v = act_frag<1>(proj, row, first, PC_WD + c8, mu + 1536 + c8); else if (c8 < 128) v = act_frag<0>(proj, row, first, PC_WD + c8, mu + 1536 + c8); else v = act_frag<2>(proj, row, first, PC_WD + c8, mu + 1536 + c8);
            *(LAS bf16x8*)(ACT + t * 264 + c8) = v; } }
    __syncthreads();
    for (int job = wave; job < 12; job += 8) {
        const int kind = job >> 2, p = (job >> 1) & 1, q = job & 1;
        if (kind < 2) {
            const bf16_t* W = (kind == 0 ? WDT : WAT) + (size_t)(64 * h + 32 * q + tl) * 64 + 8 * hi; const LAS bf16_t* ap = ACT + (32 * p + tl) * 264 + kind * 64 + 8 * hi;
            f32x16 acc = {};
#pragma unroll
            for (int s = 0; s < 4; ++s) acc = mfma32(*(const LAS bf16x8*)(ap + 16 * s), *(const bf16x8*)(W + 16 * s), acc);
            const int ch = 32 * q + tl; const float c0 = (kind == 0 ? w0p : a0p)[ch];
#pragma unroll
            for (int g = 0; g < 16; ++g) { const int t = 32 * p + crow(g, hi); const float x = c0 + acc[g];
                if (kind == 0) ELL[t * 65 + ch] = -fexp(-fsoftplus(-x) - 0.5f); else AV[t * 65 + ch] = fsigm(x); }
        } else {
            const bf16_t* W = WGT + (size_t)(64 * h + 32 * p + tl) * 128 + 8 * hi; const LAS bf16_t* bp = ACT + (32 * q + tl) * 264 + 128 + 8 * hi;
            f32x16 acc = {};
#pragma unroll
            for (int s = 0; s < 8; ++s) acc = mfma32(*(const bf16x8*)(W + 16 * s), *(const LAS bf16x8*)(bp + 16 * s), acc);
            st_tile_bf16(GGT, p * 2 + q, lane, acc);
        }
    }
    __syncthreads();
    if (tid < 64) { float run = 0.f; for (int t = 0; t < 64; ++t) { run += ELL[t * 65 + tid]; ELL[t * 65 + tid] = run; } LCv[tid] = run; }
    else if (tid < 128) { const int t = tid - 64; const size_t row = tok0 + t; const bool first = (chunk == 0 && t == 0); float n2 = 0.f;
        for (int c = 0; c < 64; c += 4) { const f32x4 k = shift4(proj, row, first, PC_BK + 64 * h + c, mu + 512 + 64 * h + c) * *(const f32x4*)(kkp + c); n2 += (k.x * k.x + k.y * k.y) + (k.z * k.z + k.w * k.w); }
        INV[t] = 1.f / fmaxf(sqrtf(n2), 1e-12f); }
    __syncthreads();
    { const int t = tid >> 3, c0 = (tid & 7) * 8; const size_t row = tok0 + t; const bool first = (chunk == 0 && t == 0); const float inv = INV[t]; float rho = 0.f;
        F8 vA, vR, vB, vK;
#pragma unroll
        for (int q = 0; q < 2; ++q) { const int c = c0 + 4 * q;
            const f32x4 r4 = shift4(proj, row, first, PC_R + 64 * h + c, mu + 64 * h + c), k4 = shift4(proj, row, first, PC_BK + 64 * h + c, mu + 512 + 64 * h + c), v4 = shift4(proj, row, first, PC_BV + 64 * h + c, mu + 1024 + 64 * h + c);
            const f32x4 kk4 = *(const f32x4*)(kkp + c), ka4 = *(const f32x4*)(kap + c), rk4 = *(const f32x4*)(rkp + c);
#pragma unroll
            for (int jj = 0; jj < 4; ++jj) { const int ch = c + jj; const float a = AV[t * 65 + ch], L = ELL[t * 65 + ch], Lp = t ? ELL[(t - 1) * 65 + ch] : 0.f, LC = LCv[ch];
                const float kk = k4[jj] * kk4[jj] * inv, kp = k4[jj] * (1.f + (a - 1.f) * ka4[jj]), bb = kk * a;
                const float eL = fexp(L), eN = fexp(-L), eP = fexp(Lp), eD = fexp(LC - L);
                rho += r4[jj] * kp * rk4[jj];
                const float xa = -kk * eP; vA[4 * q + jj] = xa; vR[4 * q + jj] = r4[jj] * eL; vB[4 * q + jj] = bb * eN; vK[4 * q + jj] = kp * eN;
                X[t * 65 + ch] = xa; BHC[ch * 72 + t] = (bf16_t)f2bf(bb * eD); KHC[ch * 72 + t] = (bf16_t)f2bf(kp * eD); VC[ch * 72 + t] = (bf16_t)f2bf(v4[jj]); } }
        *(LAS bf16x8*)(AT + t * 72 + c0) = pack8(vA); *(LAS bf16x8*)(RT + t * 72 + c0) = pack8(vR); *(LAS bf16x8*)(BT + t * 72 + c0) = pack8(vB); *(LAS bf16x8*)(KT + t * 72 + c0) = pack8(vK);
        rho += __shfl_xor(rho, 1); rho += __shfl_xor(rho, 2); rho += __shfl_xor(rho, 4);
        if ((tid & 7) == 0) ((float*)(C.ws + WS_RHO))[row * 8 + h] = rho; }
    __syncthreads();
    for (int job = wave; job < 16; job += 8) {
        const int kind = job >> 2, ti = (job >> 1) & 1, tj = job & 1;
        const LAS bf16_t* a = (kind < 2 ? AT : RT) + 32 * ti * 72; const LAS bf16_t* bm = ((kind & 1) ? KT : BT) + 32 * tj * 72;
        f32x16 acc = {};
        if (!(ti == 0 && tj == 1)) acc = mm_ll<4>(a, 72, bm, 72, lane, acc);
#pragma unroll
        for (int g = 0; g < 16; ++g) { const int i = 32 * ti + crow(g, hi), j = 32 * tj + tl; const bool keep = (kind < 2) ? (j < i) : (j <= i); const float v = keep ? acc[g] : 0.f;
            if (kind == 0) MAB[i * 68 + j] = v; else (kind == 1 ? MAK : kind == 2 ? NRB : NRK)[i * 72 + j] = (bf16_t)f2bf(v); }
    }
    __syncthreads();
#define RW_SOLVE() do { if (tid < 64) { for (int i = 1; i < 64; ++i) { float a_ = X[i * 65 + tid]; const LAS float* mr = MAB + i * 68; int j = 0; \
        for (; j + 4 <= i; j += 4) { const f32x4 m4 = *(const LAS f32x4*)(mr + j); a_ += m4.x * X[j * 65 + tid] + m4.y * X[(j + 1) * 65 + tid] + m4.z * X[(j + 2) * 65 + tid] + m4.w * X[(j + 3) * 65 + tid]; } \
        for (; j < i; ++j) a_ += mr[j] * X[j * 65 + tid]; X[i * 65 + tid] = a_; } } } while (0)
    RW_SOLVE();
    __syncthreads();
    { const int k = tid >> 3, i0 = (tid & 7) * 8; F8 v;
#pragma unroll
        for (int e = 0; e < 8; ++e) v[e] = X[(i0 + e) * 65 + k];
        *(LAS bf16x8*)(W1C + k * 72 + i0) = pack8(v); }
    __syncthreads();
    if (wave < 4) { const int ti = wave >> 1, tv = wave & 1; f32x16 acc = {}; acc = mm_ll<4>(MAK + 32 * ti * 72, 72, VC + 32 * tv * 72, 72, lane, acc);
#pragma unroll
        for (int g = 0; g < 16; ++g) X[(32 * ti + crow(g, hi)) * 65 + 32 * tv + tl] = acc[g]; }
    __syncthreads();
    RW_SOLVE();
    __syncthreads();
#undef RW_SOLVE
    { const int v_ = tid >> 3, i0 = (tid & 7) * 8; F8 v;
#pragma unroll
        for (int e = 0; e < 8; ++e) v[e] = X[(i0 + e) * 65 + v_];
        *(LAS bf16x8*)(W2C + v_ * 72 + i0) = pack8(v); }
    __syncthreads();
    for (int job = wave; job < 16; job += 8) {
        const int kind = job >> 2, p = (job >> 1) & 1, q = job & 1; f32x16 acc = {};
        if (kind == 0) {
            acc = mm_ll<4>(W1C + 32 * p * 72, 72, NRB + 32 * q * 72, 72, lane, acc);
            FA fa;
#pragma unroll
            for (int g = 0; g < 16; ++g) fa[g] = acc[g] + bf2f(RT[(32 * q + tl) * 72 + 32 * p + crow(g, hi)]);
            st_frag(GT, (p * 2 + q) * 2 + 0, lane, packfrag(fa, 0)); st_frag(GT, (p * 2 + q) * 2 + 1, lane, packfrag(fa, 1));
        } else if (kind == 1) {
            acc = mm_ll<4>(W2C + 32 * p * 72, 72, NRB + 32 * q * 72, 72, lane, acc); acc = mm_ll<4>(VC + 32 * p * 72, 72, NRK + 32 * q * 72, 72, lane, acc);
            st_tile_bf16(Y0T, p * 2 + q, lane, acc);
        } else if (kind == 2) {
            acc = mm_ll<4>(W1C + 32 * p * 72, 72, BHC + 32 * q * 72, 72, lane, acc);
            FA fa = toFA(acc);
            if (p == q) { const float pc = fexp(LCv[32 * q + tl]);
#pragma unroll
                for (int g = 0; g < 16; ++g) if (crow(g, hi) == tl) fa[g] += pc; }
            st_frag(PHI, (p * 2 + q) * 2 + 0, lane, packfrag(fa, 0)); st_frag(PHI, (p * 2 + q) * 2 + 1, lane, packfrag(fa, 1));
        } else {
            acc = mm_ll<4>(BHC + 32 * p * 72, 72, W2C + 32 * q * 72, 72, lane, acc); acc = mm_ll<4>(KHC + 32 * p * 72, 72, VC + 32 * q * 72, 72, lane, acc);
            st_tile_bf16(PSI, p * 2 + q, lane, acc);
        }
    }
}

DI void rwkv_scan_wave(Ctx& C, int id) {
    const int vt = id & 1, bh = id >> 1, lane = C.lane;
    f32x16 S[2] = {{}, {}};
    for (int chunk = 0; chunk < 64; ++chunk) {
        const size_t chid = ((size_t)bh * 64 + chunk) * 8192;
        const unsigned char* PHI = C.ws + WS_PHI + chid; const unsigned char* PSI = C.ws + WS_PSI + chid; unsigned char* S0B = C.ws + WS_S0 + chid;
        bf16x8 sh[2][2], sl[2][2];
#pragma unroll
        for (int cp = 0; cp < 2; ++cp)
#pragma unroll
            for (int s = 0; s < 2; ++s) { sh[cp][s] = packfrag(S[cp], s); st_frag(S0B, (cp * 2 + vt) * 2 + s, lane, sh[cp][s]);
                const u32x4 hw = __builtin_bit_cast(u32x4, sh[cp][s]); u32x4 lw;
#pragma unroll
                for (int q = 0; q < 4; ++q) lw[q] = pk2(S[cp][8 * s + 2 * q] - bflo(hw[q]), S[cp][8 * s + 2 * q + 1] - bfhi(hw[q]));
                sl[cp][s] = __builtin_bit_cast(bf16x8, lw); }
        f32x16 N[2];
#pragma unroll
        for (int ct = 0; ct < 2; ++ct) { N[ct] = toV(ld_tile_bf16(PSI, ct * 2 + vt, lane));
#pragma unroll
            for (int cp = 0; cp < 2; ++cp)
#pragma unroll
                for (int s = 0; s < 2; ++s) { const bf16x8 ph = ld_frag(PHI, (cp * 2 + ct) * 2 + s, lane); N[ct] = mfma32(ph, sh[cp][s], N[ct]); N[ct] = mfma32(ph, sl[cp][s], N[ct]); } }
        S[0] = N[0]; S[1] = N[1];
    }
}

DI void rwkv_out_wave(Ctx& C, int id, int l) {
    const int chunk = id & 63, bh = id >> 6, b = bh >> 3, h = bh & 7, lane = C.lane, tl = lane & 31, hi = lane >> 5;
    const size_t chid = (size_t)id * 8192; const size_t tok0 = (size_t)b * SEQ + chunk * 64;
    const unsigned char* GT = C.ws + WS_GT + chid; const unsigned char* Y0T = C.ws + WS_Y0T + chid; const unsigned char* GGT = C.ws + WS_GGT + chid; const unsigned char* S0B = C.ws + WS_S0 + chid;
    const bf16_t* proj = (const bf16_t*)(C.ws + WS_PROJ);
    const float* mu = C.in(6) + (size_t)l * 1792; const float* gng = C.in(15) + l * 512 + 64 * h; const float* gnb = C.in(16) + l * 512 + 64 * h;
    const float* RHO = (const float*)(C.ws + WS_RHO);
    FA Y[2][2];
#pragma unroll
    for (int vt = 0; vt < 2; ++vt)
#pragma unroll
        for (int tt = 0; tt < 2; ++tt) { f32x16 acc = toV(ld_tile_bf16(Y0T, vt * 2 + tt, lane));
#pragma unroll
            for (int cp = 0; cp < 2; ++cp)
#pragma unroll
                for (int s = 0; s < 2; ++s) acc = mfma32(ld_frag(S0B, (cp * 2 + vt) * 2 + s, lane), ld_frag(GT, (cp * 2 + tt) * 2 + s, lane), acc);
            Y[vt][tt] = toFA(acc); }
#pragma unroll
    for (int tt = 0; tt < 2; ++tt) {
        float s1 = 0.f;
#pragma unroll
        for (int vt = 0; vt < 2; ++vt)
#pragma unroll
            for (int g = 0; g < 16; ++g) s1 += Y[vt][tt][g];
        s1 += __shfl_xor(s1, 32); const float mean = s1 * (1.f / 64.f);
        float s2 = 0.f;
#pragma unroll
        for (int vt = 0; vt < 2; ++vt)
#pragma unroll
            for (int g = 0; g < 16; ++g) { const float d = Y[vt][tt][g] - mean; s2 += d * d; }
        s2 += __shfl_xor(s2, 32); const float rstd = 1.f / sqrtf(s2 * (1.f / 64.f) + GN_EPS);
        const size_t row = tok0 + 32 * tt + tl; const bool first = (chunk == 0 && tt == 0 && tl == 0);
        const float rho = RHO[row * 8 + h];
#pragma unroll
        for (int vt = 0; vt < 2; ++vt) { const FA gt = ld_tile_bf16(GGT, vt * 2 + tt, lane);
#pragma unroll
            for (int i = 0; i < 4; ++i) { const int c = 32 * vt + 8 * i + 4 * hi;
                const f32x4 v4 = shift4(proj, row, first, PC_BV + 64 * h + c, mu + 1024 + 64 * h + c); const f32x4 gg = *(const f32x4*)(gng + c), gb = *(const f32x4*)(gnb + c);
                float o[4];
#pragma unroll
                for (int jj = 0; jj < 4; ++jj) { const int g = 4 * i + jj; o[jj] = ((Y[vt][tt][g] - mean) * rstd * gg[jj] + gb[jj] + rho * v4[jj]) * gt[g]; }
                u32x2 w; w.x = pk2(o[0], o[1]); w.y = pk2(o[2], o[3]); *(u32x2*)(C.mixcat + row * D + 512 + 64 * h + c) = w; } }
    }
}

DI void phase_ln_router(Ctx& C, int l) {
    const float* V = (const float*)(C.ws + WS_V);
    const float* g = C.in(25) + (size_t)l * D; const float* bta = C.in(26) + (size_t)l * D;
    const float* wr = C.in(18); const float* br = C.in(19);
    LAS unsigned* lcnt = (LAS unsigned*)C.lds; LAS unsigned* base = lcnt + 16; LAS int* rec = (LAS int*)(C.lds + 128);
    TokInfo* tok = (TokInfo*)(C.ws + WS_TOK); RowInfo* rowi = (RowInfo*)(C.ws + WS_ROW);
    unsigned* gcnt = C.ctl + CW_GCNT + 64 * l;
    for (int i = C.blk * NTHR + C.tid; i < MAXROWS; i += C.G * NTHR) { RowInfo ri; ri.token = -1; ri.slot = 0; ri.gate = 0.f; ri.pad = 0; rowi[i] = ri; }
    for (int rb = C.blk; rb < T / 64; rb += C.G) {
        __syncthreads();
        if (C.tid < 16) lcnt[C.tid] = 0u;
        __syncthreads();
        for (int i = 0; i < 8; ++i) {
            const int lr = C.wave * 8 + i; const size_t m = (size_t)rb * 64 + lr;
            f32x4 v[4];
#pragma unroll
            for (int j = 0; j < 4; ++j) v[j] = *(const f32x4*)(V + m * D + 256 * j + 4 * C.lane);
            ln16(v, g, bta, C.lane);
            store_row_bf16(C.xcur + m * D, v, C.lane);
            float lg[16];
#pragma unroll
            for (int e = 0; e < 16; ++e) lg[e] = 0.f;
#pragma unroll
            for (int j = 0; j < 4; ++j)
#pragma unroll
                for (int i2 = 0; i2 < 4; ++i2) { const float xv = v[j][i2]; const float* wrow = wr + (size_t)(256 * j + 4 * C.lane + i2) * 16;
                    const f32x4 w0 = *(const f32x4*)(wrow), w1 = *(const f32x4*)(wrow + 4), w2 = *(const f32x4*)(wrow + 8), w3 = *(const f32x4*)(wrow + 12);
                    lg[0] += xv * w0.x; lg[1] += xv * w0.y; lg[2] += xv * w0.z; lg[3] += xv * w0.w; lg[4] += xv * w1.x; lg[5] += xv * w1.y; lg[6] += xv * w1.z; lg[7] += xv * w1.w;
                    lg[8] += xv * w2.x; lg[9] += xv * w2.y; lg[10] += xv * w2.z; lg[11] += xv * w2.w; lg[12] += xv * w3.x; lg[13] += xv * w3.y; lg[14] += xv * w3.z; lg[15] += xv * w3.w; }
            float sc[16], sl[16];
#pragma unroll
            for (int e = 0; e < 16; ++e) { const float t = wave_sum(lg[e]); sc[e] = 1.f / (1.f + expf(-t)); sl[e] = sc[e] + br[e]; }
            int best = 0; float bestv = -3.0e38f;
#pragma unroll
            for (int gq = 0; gq < 4; ++gq) { const float a = sl[4 * gq], b2 = sl[4 * gq + 1], c2 = sl[4 * gq + 2], d2 = sl[4 * gq + 3];
                const float mx1 = fmaxf(fmaxf(a, b2), fmaxf(c2, d2)); const float tot = a + b2 + c2 + d2; const float mn1 = fminf(fminf(a, b2), fminf(c2, d2));
                const float lo1 = fminf(a, b2), hi1 = fmaxf(a, b2), lo2 = fminf(c2, d2), hi2 = fmaxf(c2, d2);
                const float second = fmaxf(fminf(hi1, hi2), fmaxf(lo1, lo2));
                (void)tot; (void)mn1;
                const float gs = mx1 + second; if (gs > bestv) { bestv = gs; best = gq; } }
            int i0 = 0, i1 = 0; float v0 = -3.0e38f, v1 = -3.0e38f, s0 = 0.f, s1 = 0.f;
#pragma unroll
            for (int gq = 0; gq < 4; ++gq) if (gq == best) {
#pragma unroll
                for (int k = 0; k < 4; ++k) { const float x = sl[4 * gq + k]; if (x > v0) { v1 = v0; i1 = i0; s1 = s0; v0 = x; i0 = 4 * gq + k; s0 = sc[4 * gq + k]; } else if (x > v1) { v1 = x; i1 = 4 * gq + k; s1 = sc[4 * gq + k]; } } }
            const float den = s0 + s1; const float g0 = s0 / den, g1 = s1 / den;
            if (C.lane == 0) {
                const unsigned r0 = __hip_atomic_fetch_add(lcnt + i0, 1u, __ATOMIC_RELAXED, __HIP_MEMORY_SCOPE_WORKGROUP);
                const unsigned r1 = __hip_atomic_fetch_add(lcnt + i1, 1u, __ATOMIC_RELAXED, __HIP_MEMORY_SCOPE_WORKGROUP);
                rec[lr * 8 + 0] = i0; rec[lr * 8 + 1] = i1; rec[lr * 8 + 2] = (int)r0; rec[lr * 8 + 3] = (int)r1;
                rec[lr * 8 + 4] = __builtin_bit_cast(int, g0); rec[lr * 8 + 5] = __builtin_bit_cast(int, g1); }
        }
        __syncthreads();
        if (C.tid < 16) base[C.tid] = __hip_atomic_fetch_add(gcnt + C.tid, lcnt[C.tid], __ATOMIC_RELAXED, __HIP_MEMORY_SCOPE_AGENT);
        __syncthreads();
        if (C.tid < 64) { TokInfo ti; ti.e0 = rec[C.tid * 8]; ti.e1 = rec[C.tid * 8 + 1]; ti.p0 = rec[C.tid * 8 + 2] + (int)base[ti.e0]; ti.p1 = rec[C.tid * 8 + 3] + (int)base[ti.e1];
            ti.g0 = __builtin_bit_cast(float, rec[C.tid * 8 + 4]); ti.g1 = __builtin_bit_cast(float, rec[C.tid * 8 + 5]); ti.pad0 = 0; ti.pad1 = 0; tok[(size_t)rb * 64 + C.tid] = ti; }
    }
}
DI int build_tile_table(Ctx& C, int l, LAS int* toff, LAS int* texp) {
    const unsigned* gcnt = C.ctl + CW_GCNT + 64 * l;
    __syncthreads();
    if (C.tid == 0) { int o = 0; for (int e = 0; e < 16; ++e) { toff[e] = o; const int c = (int)__hip_atomic_load(gcnt + e, __ATOMIC_RELAXED, __HIP_MEMORY_SCOPE_AGENT); const int nt = (c + 255) >> 8; for (int t = 0; t < nt; ++t) texp[(o >> 8) + t] = e; o += nt << 8; } toff[16] = o; }
    __syncthreads();
    return toff[16] >> 8;
}
DI void phase_gather(Ctx& C, int l) {
    LAS int* toff = (LAS int*)(C.lds + 1024); LAS int* texp = (LAS int*)(C.lds + 2048);
    (void)build_tile_table(C, l, toff, texp);
    const TokInfo* tok = (const TokInfo*)(C.ws + WS_TOK); RowInfo* rowi = (RowInfo*)(C.ws + WS_ROW); bf16_t* AG = (bf16_t*)(C.ws + WS_AG);
    const int gw = C.blk * NWAVES + C.wave, NGW = C.G * NWAVES;
    for (int m = gw; m < T; m += NGW) {
        const TokInfo ti = tok[m];
        const u32x4 a = *(const u32x4*)(C.xcur + (size_t)m * D + 8 * C.lane), b = *(const u32x4*)(C.xcur + (size_t)m * D + 512 + 8 * C.lane);
        const int r0 = toff[ti.e0] + ti.p0, r1 = toff[ti.e1] + ti.p1;
        *(u32x4*)(AG + (size_t)r0 * D + 8 * C.lane) = a; *(u32x4*)(AG + (size_t)r0 * D + 512 + 8 * C.lane) = b;
        *(u32x4*)(AG + (size_t)r1 * D + 8 * C.lane) = a; *(u32x4*)(AG + (size_t)r1 * D + 512 + 8 * C.lane) = b;
        if (C.lane == 0) { RowInfo x; x.token = m; x.slot = 0; x.gate = ti.g0; x.pad = 0; rowi[r0] = x; x.slot = 1; x.gate = ti.g1; rowi[r1] = x; }
    }
}
DI void phase_ln_ffn(Ctx& C, int l) {
    const bf16_t* Y = (const bf16_t*)(C.ws + WS_Y);
    const float* g = C.in(27) + (size_t)l * D; const float* bta = C.in(28) + (size_t)l * D;
    const int gw = C.blk * NWAVES + C.wave, NGW = C.G * NWAVES;
    for (int m = gw; m < T; m += NGW) {
        f32x4 x[4], y0[4], y1[4];
        load_row_bf16(C.xcur + (size_t)m * D, x, C.lane); load_row_bf16(Y + (size_t)m * D, y0, C.lane); load_row_bf16(Y + ((size_t)T + m) * D, y1, C.lane);
#pragma unroll
        for (int j = 0; j < 4; ++j) x[j] = x[j] * ALPHA + (y0[j] + y1[j]);
        ln16(x, g, bta, C.lane);
        store_row_bf16(C.xcur + (size_t)m * D, x, C.lane);
    }
}
DI void phase_ln_ple(Ctx& C, int l, bool last) {
    const float* V = (const float*)(C.ws + WS_V3);
    const float* g = C.in(29) + (size_t)l * D; const float* bta = C.in(30) + (size_t)l * D;
    const int gw = C.blk * NWAVES + C.wave, NGW = C.G * NWAVES;
    for (int m = gw; m < T; m += NGW) {
        f32x4 v[4];
#pragma unroll
        for (int j = 0; j < 4; ++j) v[j] = *(const f32x4*)(V + (size_t)m * D + 256 * j + 4 * C.lane);
        ln16(v, g, bta, C.lane);
        if (last) {
#pragma unroll
            for (int j = 0; j < 4; ++j) *(f32x4*)(C.out + (size_t)m * D + 256 * j + 4 * C.lane) = v[j];
        } else store_row_bf16(C.xcur + (size_t)m * D, v, C.lane);
    }
}

constexpr int LDS_BYTES = 155648;
constexpr int PH_PER_LAYER = 13, NPHASE = 1 + DEPTH * PH_PER_LAYER;

constexpr int CW_AQ = 2048;
DI void convert_mixer_weights(Ctx& C, int l) {
    int first = 0;
    { ColPlain c{C.in(5) + (size_t)l * D * D}; convert_matrix(C, c, D, D, D, (bf16_t*)(C.ws + WS_WOUT), first); }
    { ColPlain c{C.in(8) + (size_t)l * 64 * 512}; convert_matrix(C, c, 512, 64, 512, (bf16_t*)(C.ws + WS_LORA), first); }
    { ColPlain c{C.in(10) + (size_t)l * 64 * 512}; convert_matrix(C, c, 512, 64, 512, (bf16_t*)(C.ws + WS_LORA) + 512 * 64, first); }
    { ColPlain c{C.in(11) + (size_t)l * 128 * 512}; convert_matrix(C, c, 512, 128, 512, (bf16_t*)(C.ws + WS_LORA) + 2 * 512 * 64, first); }
}
DI void convert_ffn_weights(Ctx& C, int l) {
    int first = 0;
    { ColGateUp c{C.in(20) + (size_t)l * NEXP * D * DEXP, C.in(21) + (size_t)l * NEXP * D * DEXP}; convert_matrix(C, c, DEXP, D, NEXP * 512, (bf16_t*)(C.ws + WS_WEXP), first); }
    for (int e = 0; e < NEXP; ++e) { ColDown c{C.in(22) + ((size_t)l * NEXP + e) * DEXP * D}; convert_matrix(C, c, D, DEXP, D, (bf16_t*)(C.ws + WS_WDOWN) + (size_t)e * D * DEXP, first); }
    { ColPlain c{C.in(24) + (size_t)l * D * D}; convert_matrix(C, c, D, D, D, (bf16_t*)(C.ws + WS_WPG), first); }
    { ColPlain c{C.in(23) + (size_t)l * PLE * D}; convert_matrix(C, c, D, PLE, D, (bf16_t*)(C.ws + WS_WPLE), first); }
    const float* p = C.in(1) + (size_t)l * T * PLE; bf16_t* pb = (bf16_t*)(C.ws + WS_PBF);
    for (size_t i = ((size_t)C.blk * NTHR + C.tid) * 8; i < (size_t)T * PLE; i += (size_t)C.G * NTHR * 8) {
        const f32x4 a = *(const f32x4*)(p + i), b = *(const f32x4*)(p + i + 4);
        u32x4 o; o.x = pk2(a.x, a.y); o.y = pk2(a.z, a.w); o.z = pk2(b.x, b.y); o.w = pk2(b.z, b.w); *(u32x4*)(pb + i) = o; }
}
template <int SP> DI void run_sp(Ctx& C, const int l) {
    if constexpr (SP == 0) {
        pg8::Gemm g{C.xcur, (const bf16_t*)(C.ws + WS_WEXP), T, NPROJ_PAD, opaque_i(D)}; pg8::StaticOrder S; S.init(T, NPROJ_PAD, C.G, C.blk);
        EpiProj E{(bf16_t*)(C.ws + WS_PROJ)};
        pg8::gemm_phase<EpiProj, pg8::StaticOrder, true, true>(C.lds, g, S, E);
    } else if constexpr (SP == 1) {
        convert_mixer_weights(C, l);
    } else if constexpr (SP == 2) {
        for (int it = C.blk; it < 2048; it += C.G) rwkv_head_item(C, it, l);
        for (int it = C.blk; it < 2048; it += C.G) idx_item(C, it, l);
    } else if constexpr (SP == 3) {
        if (C.blk < 8) rwkv_scan_wave(C, C.blk * 8 + C.wave);
        LAS int* qs = (LAS int*)(C.lds + LDS_BYTES - 64);
        for (;;) {
            __syncthreads();
            if (C.tid == 0) qs[0] = (int)__hip_atomic_fetch_add(C.ctl + CW_AQ + 64 * l, 1u, __ATOMIC_RELAXED, __HIP_MEMORY_SCOPE_AGENT);
            __syncthreads();
            const int u = qs[0];
            if (u >= 512) break;
            const int qb = 15 - (u >> 5), bh = u & 31; attn_unit(C, bh >> 3, bh & 7, qb);
        }
    } else if constexpr (SP == 4) {
        const int gw = C.blk * NWAVES + C.wave, NGW = C.G * NWAVES;
        for (int id = gw; id < 2048; id += NGW) rwkv_out_wave(C, id, l);
    } else if constexpr (SP == 5) {
        pg8::Gemm g{C.mixcat, (const bf16_t*)(C.ws + WS_WOUT), T, D, opaque_i(D)}; pg8::StaticOrder S; S.init(T, D, C.G, C.blk);
        EpiResF32 E{C.xcur, (float*)(C.ws + WS_V)};
        pg8::gemm_phase<EpiResF32, pg8::StaticOrder, true, true>(C.lds, g, S, E);
    } else if constexpr (SP == 6) { phase_ln_router(C, l); convert_ffn_weights(C, l);
    } else if constexpr (SP == 7) { phase_gather(C, l);
    } else if constexpr (SP == 8) {
        LAS int* toff = (LAS int*)(C.lds + 135168); LAS int* texp = (LAS int*)(C.lds + 136192);
        const int nt = build_tile_table(C, l, toff, texp);
        pg8::Gemm g{(const bf16_t*)(C.ws + WS_AG), (const bf16_t*)(C.ws + WS_WEXP), MAXROWS, NEXP * 512, opaque_i(D)};
        GroupedOrder<2> S{texp, nt, C.G, C.blk};
        EpiSwiGLU E{(bf16_t*)(C.ws + WS_H), (const RowInfo*)(C.ws + WS_ROW)};
        pg8::gemm_phase<EpiSwiGLU, GroupedOrder<2>, true, true>(C.lds, g, S, E);
    } else if constexpr (SP == 9) {
        LAS int* toff = (LAS int*)(C.lds + 135168); LAS int* texp = (LAS int*)(C.lds + 136192);
        const int nt = build_tile_table(C, l, toff, texp);
        { pg8::Gemm g{(const bf16_t*)(C.ws + WS_H), (const bf16_t*)(C.ws + WS_WDOWN), MAXROWS, NEXP * D, opaque_i(DEXP)};
          GroupedOrder<4> S{texp, nt, C.G, C.blk};
          EpiDown E{(bf16_t*)(C.ws + WS_Y), (const RowInfo*)(C.ws + WS_ROW)};
          pg8::gemm_phase<EpiDown, GroupedOrder<4>, true, true>(C.lds, g, S, E); }
        { pg8::Gemm g{(const bf16_t*)(C.ws + WS_PBF), (const bf16_t*)(C.ws + WS_WPLE), T, D, opaque_i(PLE)}; pg8::StaticOrder S; S.init(T, D, C.G, C.blk);
          EpiBf16Plain E{(bf16_t*)(C.ws + WS_PE), D};
          pg8::gemm_phase<EpiBf16Plain, pg8::StaticOrder, true, true>(C.lds, g, S, E); }
    } else if constexpr (SP == 10) { phase_ln_ffn(C, l);
    } else if constexpr (SP == 11) {
        pg8::Gemm g{C.xcur, (const bf16_t*)(C.ws + WS_WPG), T, D, opaque_i(D)}; pg8::StaticOrder S; S.init(T, D, C.G, C.blk);
        EpiPle E{C.xcur, (const bf16_t*)(C.ws + WS_PE), (float*)(C.ws + WS_V3)};
        pg8::gemm_phase<EpiPle, pg8::StaticOrder, true, true>(C.lds, g, S, E);
    } else { phase_ln_ple(C, l, l == DEPTH - 1); if (l + 1 < DEPTH) convert_win(C, l + 1); }
}
typedef const __attribute__((address_space(4))) Args* KArgP;
DI void ctx_setup(Ctx& C) {
    int t_ = threadIdx.x; asm volatile("" : "+v"(t_)); C.tid = t_; C.lane = t_ & 63; C.wave = __builtin_amdgcn_readfirstlane(t_ >> 6);
    int b_ = blockIdx.x, g_ = gridDim.x; asm volatile("" : "+s"(b_), "+s"(g_)); C.blk = b_; C.G = g_;
    KArgP ap = (KArgP)__builtin_amdgcn_kernarg_segment_ptr(); asm volatile("" : "+s"(ap));
    C.ap = ap; C.out = ap->out; C.ws = ap->ws; C.ctl = (unsigned*)(ap->ws + WS_CTL); C.xcur = (bf16_t*)ap->out; C.mixcat = (bf16_t*)ap->out + (size_t)T * D;
}
__global__ void __launch_bounds__(NTHR, 2) mega_fwd(Args args) {
    extern __shared__ __attribute__((aligned(16))) unsigned char lds_raw[];
    Ctx C;
    C.lds = (LAS unsigned char*)lds_raw;
    cg::grid_group grid = cg::this_grid();
    const int lo = ((KArgP)__builtin_amdgcn_kernarg_segment_ptr())->ph_lo, hi = ((KArgP)__builtin_amdgcn_kernarg_segment_ptr())->ph_hi;
#define PHASE(k, body) do { if (lo <= (k) && (k) < hi) { if ((k) > lo) grid.sync(); ctx_setup(C); body; } } while (0)
    PHASE(0, { phase_ln_in(C); convert_win(C, 0); });
#define LAYER(l) PHASE(1 + 13 * (l) + 0, run_sp<0>(C, l)); PHASE(1 + 13 * (l) + 1, run_sp<1>(C, l)); PHASE(1 + 13 * (l) + 2, run_sp<2>(C, l)); PHASE(1 + 13 * (l) + 3, run_sp<3>(C, l)); \
    PHASE(1 + 13 * (l) + 4, run_sp<4>(C, l)); PHASE(1 + 13 * (l) + 5, run_sp<5>(C, l)); PHASE(1 + 13 * (l) + 6, run_sp<6>(C, l)); PHASE(1 + 13 * (l) + 7, run_sp<7>(C, l)); \
    PHASE(1 + 13 * (l) + 8, run_sp<8>(C, l)); PHASE(1 + 13 * (l) + 9, run_sp<9>(C, l)); PHASE(1 + 13 * (l) + 10, run_sp<10>(C, l)); PHASE(1 + 13 * (l) + 11, run_sp<11>(C, l)); \
    PHASE(1 + 13 * (l) + 12, run_sp<12>(C, l))
    LAYER(0);
    LAYER(1);
#undef LAYER
#undef PHASE
}

#ifndef N_LAUNCH_MODE
#define N_LAUNCH_MODE 1
#endif
extern "C" void kernel_launch(void* const* d_in, const int* in_sizes, int n_in, void* d_out, int out_size, void* d_ws, size_t ws_size, hipStream_t stream) {
    static int grid = 0;
    if (grid == 0) {
        if (n_in != 31 || out_size != T * D) { fprintf(stderr, "kernel_launch: unexpected problem (n_in %d out %d)\n", n_in, out_size); grid = -1; return; }
        int dev = 0, cus = 0, per_cu = 0;
        hipGetDevice(&dev); hipDeviceGetAttribute(&cus, hipDeviceAttributeMultiprocessorCount, dev);
        if (hipFuncSetAttribute((const void*)mega_fwd, hipFuncAttributeMaxDynamicSharedMemorySize, LDS_BYTES) != hipSuccess) { fprintf(stderr, "kernel_launch: hipFuncSetAttribute failed\n"); grid = -1; return; }
        if (hipOccupancyMaxActiveBlocksPerMultiprocessor(&per_cu, (const void*)mega_fwd, NTHR, LDS_BYTES) != hipSuccess || per_cu < 1) { fprintf(stderr, "kernel_launch: occupancy query says %d\n", per_cu); per_cu = 1; }
        (void)hipGetLastError();
        grid = cus * 1;
        fprintf(stderr, "kernel_launch: grid %d (occupancy %d per CU)\n", grid, per_cu);
    }
    if (grid < 0) return;
    hipMemsetAsync((char*)d_ws + WS_CTL, 0, CTL_BYTES, stream);
    Args a{};
    for (int i = 0; i < 31; ++i) a.in[i] = (const float*)d_in[i];
    a.out = (float*)d_out; a.ws = (unsigned char*)d_ws;
#if N_LAUNCH_MODE == 0
    for (int ph = 0; ph < NPHASE; ++ph) { a.ph_lo = ph; a.ph_hi = ph + 1; hipLaunchKernelGGL(mega_fwd, dim3(grid), dim3(NTHR), LDS_BYTES, stream, a); }
#else
    a.ph_lo = 0; a.ph_hi = NPHASE;
    void* kargs[] = {&a};
    hipError_t e = hipLaunchCooperativeKernel((const void*)mega_fwd, dim3(grid), dim3(NTHR), kargs, LDS_BYTES, stream);
    if (e != hipSuccess) fprintf(stderr, "cooperative launch failed: %s (grid %d)\n", hipGetErrorString(e), grid);
#endif
}
```

```cpp
#include <hip/hip_runtime.h>
#include <hip/hip_cooperative_groups.h>
#include <cstdio>
#include <cstdint>
namespace cg = cooperative_groups;
namespace pg8 {
#define PG8_LAS __attribute__((address_space(3)))
typedef unsigned short bf16_t;
typedef short bf16x8 __attribute__((ext_vector_type(8)));
typedef float f32x4 __attribute__((ext_vector_type(4)));
typedef unsigned u32x4 __attribute__((ext_vector_type(4)));
constexpr int BM = 256, BK = 64, HALF = 128, HTB = HALF * BK * 2  , STAGE_BYTES = 8 * HTB, NXCD = 8, WGM = 8;

__host__ __device__ __forceinline__ int lds_byte(int r, int c) { const int st = (r >> 4) * 2 + (c >> 5), rr = r & 15, cc = c & 31, ob = rr * 64 + cc * 2; return st * 1024 + (ob ^ (((ob >> 9) & 1) << 5)); }
__host__ __device__ __forceinline__ void stage_rc(int b, int& R, int& C) { const int st = b / 1024, sb = b % 1024, swz = sb ^ (((sb >> 9) & 1) << 5); R = (st >> 1) * 16 + swz / 64; C = (st & 1) * 32 + (swz % 64) / 2; }
__host__ __device__ __forceinline__ int perm32(int rho) { const int n = rho >> 4, i = rho & 15; return 8 * (i >> 2) + 4 * n + (i & 3); }

struct Unit { int pm, pn; };
struct Gemm { const bf16_t* A; const bf16_t* Bt; int M, N, K; };

struct StaticOrder {
    int nM, nN, nwg, G, c;
    __host__ __device__ void init(int M, int N, int G_, int c_) { nM = M / BM; nN = N / BM; nwg = nM * nN; G = G_; c = c_; }
    __host__ __device__ bool next(int i, Unit& u) const {
        const long L = (long)i * G + c; if (L >= nwg) return false;
        int wgid = (int)L; { const int q = nwg / NXCD, r = nwg % NXCD, xcd = wgid % NXCD, off = wgid / NXCD; wgid = (xcd < r ? xcd * (q + 1) : r * (q + 1) + (xcd - r) * q) + off; }
        const int nig = WGM * nN, gid = wgid / nig, fm = gid * WGM, gsz = (nM - fm) < WGM ? (nM - fm) : WGM;
        u.pm = fm + ((wgid % nig) % gsz); u.pn = (wgid % nig) / gsz; return true;
    }
    __device__ __forceinline__ void a_ready(const Unit&) const {}
    __device__ __forceinline__ void done(const Unit&) const {}
};

__device__ __forceinline__ unsigned cvt_pk_bf16(float lo, float hi) { typedef float f2_t __attribute__((ext_vector_type(2))); typedef __bf16 b2_t __attribute__((ext_vector_type(2))); f2_t v = {lo, hi}; b2_t b = __builtin_convertvector(v, b2_t); return __builtin_bit_cast(unsigned, b); }
template <class Epi, class Sched, bool ALIGN_EPI = false, bool SP2 = false>
__device__ __forceinline__ void gemm_phase(PG8_LAS unsigned char* lds, const Gemm g, const Sched& S, const Epi& E) {
    int tid_ = threadIdx.x; asm volatile("" : "+v"(tid_));
    const int tid = tid_, wid = __builtin_amdgcn_readfirstlane(tid >> 6), lane = tid & 63, wr = wid >> 2, wc = wid & 3, fr = lane & 15, fq = lane >> 4;
    const int K = g.K, nt = K / BK;
    unsigned voffA[2], voffB[2];
#pragma unroll
    for (int i = 0; i < 2; ++i) { int R, C; stage_rc(tid * 16 + i * 8192, R, C); const int Rb = Epi::PERM ? ((R & ~31) + perm32(R & 31)) : R;
        voffA[i] = (unsigned)(R * K + C) * 2u; voffB[i] = (unsigned)(Rb * K + C) * 2u; }
    const size_t kstep = (size_t)(BK * 2);
    const size_t hstep = (size_t)HALF * K * 2;
    const size_t tstep = 2 * hstep;
    const unsigned ldsw = (unsigned)wid * 1024u;
    const int aoff = lds_byte(wr * 64 + fr, fq * 8), boff = lds_byte(wc * 32 + fr, fq * 8);
#define PG8_SA(b, h) (((b) * 2 + (h)) * HTB)
#define PG8_SB(b, h) ((4 + (b) * 2 + (h)) * HTB)
#define PG8_STAGE(bufoff, gbase, voff) do { _Pragma("unroll") for (int _i = 0; _i < 2; ++_i) \
        __builtin_amdgcn_global_load_lds((const unsigned*)((const char*)(gbase) + (voff)[_i]), (PG8_LAS unsigned*)(lds + (bufoff) + ldsw + _i * 8192), 16, 0, 0); } while (0)
#define PG8_LDA(dst, b, h) do { _Pragma("unroll") for (int m = 0; m < 4; ++m) _Pragma("unroll") for (int k = 0; k < 2; ++k) dst[m][k] = *(const PG8_LAS bf16x8*)(lds + PG8_SA(b, h) + aoff + m * 2048 + k * 1024); } while (0)
#define PG8_LDB(dst, b, h) do { _Pragma("unroll") for (int n = 0; n < 2; ++n) _Pragma("unroll") for (int k = 0; k < 2; ++k) dst[n][k] = *(const PG8_LAS bf16x8*)(lds + PG8_SB(b, h) + boff + n * 2048 + k * 1024); } while (0)
#define PG8_MMA(ai, bj, At, Bt) do { __builtin_amdgcn_s_setprio(1); _Pragma("unroll") for (int m = 0; m < 4; ++m) _Pragma("unroll") for (int n = 0; n < 2; ++n) _Pragma("unroll") for (int k = 0; k < 2; ++k) \
        acc[ai][bj][m][n] = __builtin_amdgcn_mfma_f32_16x16x32_bf16(Bt[n][k], At[m][k], acc[ai][bj][m][n], 0, 0, 0); __builtin_amdgcn_s_setprio(0); } while (0)
#define PG8_WAIT_V(n) asm volatile("s_waitcnt vmcnt(" #n ")" ::: "memory")
#define PG8_WAIT_L(n) asm volatile("s_waitcnt lgkmcnt(" #n ")" ::: "memory")
#define PG8_BAR __builtin_amdgcn_s_barrier()
#define PG8_SCHED __builtin_amdgcn_sched_barrier(0)
    Unit cur, nxt; int ui = 0;
    if (!S.next(0, cur)) return;
    f32x4 acc[2][2][4][2];
#pragma unroll
    for (int a = 0; a < 2; ++a)
#pragma unroll
        for (int b = 0; b < 2; ++b)
#pragma unroll
            for (int m = 0; m < 4; ++m)
#pragma unroll
                for (int n = 0; n < 2; ++n) acc[a][b][m][n] = (f32x4){0.f, 0.f, 0.f, 0.f};
    bf16x8 At[4][2], B0[2][2], B1[2][2];
    const char* cA = (const char*)g.A + (size_t)cur.pm * tstep; const char* cB = (const char*)g.Bt + (size_t)cur.pn * tstep;
    S.a_ready(cur);
    if constexpr (SP2) {
        PG8_STAGE(PG8_SB(0, 0), cB, voffB); PG8_STAGE(PG8_SB(0, 1), cB + hstep, voffB); PG8_STAGE(PG8_SA(0, 0), cA, voffA); PG8_STAGE(PG8_SA(0, 1), cA + hstep, voffA);
        if (wr == 1) PG8_BAR;
        PG8_WAIT_V(2); PG8_BAR;
        PG8_STAGE(PG8_SB(1, 0), cB + kstep, voffB); PG8_STAGE(PG8_SA(1, 0), cA + kstep, voffA); PG8_STAGE(PG8_SB(1, 1), cB + hstep + kstep, voffB);
        PG8_WAIT_V(6); PG8_BAR;
    } else {
        PG8_STAGE(PG8_SB(0, 0), cB, voffB); PG8_STAGE(PG8_SA(0, 0), cA, voffA); PG8_STAGE(PG8_SB(0, 1), cB + hstep, voffB); PG8_STAGE(PG8_SA(0, 1), cA + hstep, voffA);
        if (wr == 1) PG8_BAR;
        PG8_WAIT_V(4); PG8_BAR;
        PG8_STAGE(PG8_SB(1, 0), cB + kstep, voffB); PG8_STAGE(PG8_SA(1, 0), cA + kstep, voffA); PG8_STAGE(PG8_SB(1, 1), cB + hstep + kstep, voffB);
        PG8_WAIT_V(6); PG8_BAR;
    }
    for (;;) {
        const bool has_next = S.next(ui + 1, nxt);
        const char* nA = has_next ? (const char*)g.A + (size_t)nxt.pm * tstep : cA; const char* nB = has_next ? (const char*)g.Bt + (size_t)nxt.pn * tstep : cB;
        for (int t = 0; t < nt; t += 2) {
            const bool last = (t == nt - 2);
            const char* a1 = cA + (size_t)(t + 1) * kstep;
            const char* a2 = last ? nA : cA + (size_t)(t + 2) * kstep; const char* b2 = last ? nB : cB + (size_t)(t + 2) * kstep;
            const char* a3 = a2 + kstep; const char* b3 = b2 + kstep;
            if (last && has_next) S.a_ready(nxt);
            if constexpr (SP2) {
            PG8_LDB(B0, 0, 0); PG8_LDB(B1, 0, 1); PG8_SCHED; PG8_LDA(At, 0, 0); PG8_STAGE(PG8_SA(1, 1), a1 + hstep, voffA);
            PG8_WAIT_V(8); PG8_WAIT_L(0); PG8_BAR; PG8_MMA(0, 0, At, B0); PG8_MMA(0, 1, At, B1); PG8_BAR; PG8_SCHED;
            PG8_LDA(At, 0, 1); PG8_STAGE(PG8_SB(0, 0), b2, voffB); PG8_STAGE(PG8_SB(0, 1), b2 + hstep, voffB); PG8_STAGE(PG8_SA(0, 0), a2, voffA);
            PG8_WAIT_V(8); PG8_WAIT_L(0); PG8_BAR; PG8_MMA(1, 0, At, B0); PG8_MMA(1, 1, At, B1); PG8_BAR; PG8_SCHED;
            PG8_LDB(B0, 1, 0); PG8_LDB(B1, 1, 1); PG8_SCHED; PG8_LDA(At, 1, 0); PG8_STAGE(PG8_SA(0, 1), a2 + hstep, voffA);
            PG8_WAIT_V(8); PG8_WAIT_L(0); PG8_BAR; PG8_MMA(0, 0, At, B0); PG8_MMA(0, 1, At, B1); PG8_BAR; PG8_SCHED;
            PG8_LDA(At, 1, 1); PG8_STAGE(PG8_SB(1, 0), b3, voffB); PG8_STAGE(PG8_SB(1, 1), b3 + hstep, voffB); PG8_STAGE(PG8_SA(1, 0), a3, voffA);
            PG8_WAIT_V(8); PG8_WAIT_L(0); PG8_BAR; PG8_MMA(1, 0, At, B0); PG8_MMA(1, 1, At, B1); PG8_BAR; PG8_SCHED;
            } else {
            PG8_LDB(B0, 0, 0); PG8_SCHED; PG8_LDA(At, 0, 0); PG8_STAGE(PG8_SA(1, 1), a1 + hstep, voffA);
            PG8_WAIT_L(8); PG8_BAR; PG8_WAIT_L(0); PG8_MMA(0, 0, At, B0); PG8_BAR; PG8_SCHED;
            PG8_LDB(B1, 0, 1); PG8_STAGE(PG8_SB(0, 0), b2, voffB);
            PG8_BAR; PG8_WAIT_L(0); PG8_MMA(0, 1, At, B1); PG8_BAR;
            PG8_LDA(At, 0, 1); PG8_STAGE(PG8_SA(0, 0), a2, voffA);
            PG8_BAR; PG8_WAIT_L(0); PG8_MMA(1, 0, At, B0); PG8_BAR; PG8_SCHED;
            PG8_STAGE(PG8_SB(0, 1), b2 + hstep, voffB);
            PG8_WAIT_V(6); PG8_BAR; PG8_MMA(1, 1, At, B1); PG8_BAR;
            PG8_LDB(B0, 1, 0); PG8_SCHED; PG8_LDA(At, 1, 0); PG8_STAGE(PG8_SA(0, 1), a2 + hstep, voffA);
            PG8_WAIT_L(8); PG8_BAR; PG8_WAIT_L(0); PG8_MMA(0, 0, At, B0); PG8_BAR; PG8_SCHED;
            PG8_LDB(B1, 1, 1); PG8_STAGE(PG8_SB(1, 0), b3, voffB);
            PG8_BAR; PG8_WAIT_L(0); PG8_MMA(0, 1, At, B1); PG8_BAR;
            PG8_LDA(At, 1, 1); PG8_STAGE(PG8_SA(1, 0), a3, voffA);
            PG8_BAR; PG8_WAIT_L(0); PG8_MMA(1, 0, At, B0); PG8_BAR; PG8_SCHED;
            PG8_STAGE(PG8_SB(1, 1), b3 + hstep, voffB);
            PG8_WAIT_V(6); PG8_BAR; PG8_MMA(1, 1, At, B1); PG8_BAR;
            }
        }
        if constexpr (ALIGN_EPI) { if (wr == 0) PG8_BAR; }
        if constexpr (!Epi::AFTER_DRAIN) { E(acc, cur, wr, wc, fr, fq); S.done(cur); }
        if (!has_next) break;
#pragma unroll
        for (int a = 0; a < 2; ++a)
#pragma unroll
            for (int b = 0; b < 2; ++b)
#pragma unroll
                for (int m = 0; m < 4; ++m)
#pragma unroll
                    for (int n = 0; n < 2; ++n) acc[a][b][m][n] = (f32x4){0.f, 0.f, 0.f, 0.f};
        cur = nxt; cA = nA; cB = nB; ++ui;
        if constexpr (ALIGN_EPI) { if (wr == 1) PG8_BAR; }
    }
    PG8_WAIT_V(0);
    if constexpr (!ALIGN_EPI) { if (wr == 0) PG8_BAR; }
    PG8_BAR;
    if constexpr (Epi::AFTER_DRAIN) { E.fused(acc, cur, wr, wc, fr, fq, lds, wid, lane); S.done(cur); }
#undef PG8_SA
#undef PG8_SB
#undef PG8_STAGE
#undef PG8_LDA
#undef PG8_LDB
#undef PG8_MMA
#undef PG8_WAIT_V
#undef PG8_WAIT_L
#undef PG8_BAR
#undef PG8_SCHED
}

template <class Epi, class Sched, bool ALIGN_EPI = false>
__device__ __forceinline__ void gemm_phase_gather(PG8_LAS unsigned char* lds, const Gemm g, const Sched& S, const Epi& E, const int* rowtok) {
    constexpr bool SP2 = true;
    int tid_ = threadIdx.x; asm volatile("" : "+v"(tid_));
    const int tid = tid_, wid = __builtin_amdgcn_readfirstlane(tid >> 6), lane = tid & 63, wr = wid >> 2, wc = wid & 3, fr = lane & 15, fq = lane >> 4;
    const int K = g.K, nt = K / BK;
    unsigned voffB[2]; unsigned vcur[2][2], vnxt[2][2]; int RA[2], CA[2]; const unsigned voffA[2] = {0u, 0u};
#pragma unroll
    for (int i = 0; i < 2; ++i) { int R, C; stage_rc(tid * 16 + i * 8192, R, C); const int Rb = Epi::PERM ? ((R & ~31) + perm32(R & 31)) : R;
        RA[i] = R; CA[i] = C; voffB[i] = (unsigned)(Rb * K + C) * 2u; }
#define PG8_GMAP(dst, pm_) do { _Pragma("unroll") for (int h_ = 0; h_ < 2; ++h_) _Pragma("unroll") for (int i_ = 0; i_ < 2; ++i_) { int tk_ = rowtok[4 * ((pm_) * BM + h_ * HALF + RA[i_])]; tk_ = tk_ < 0 ? 0 : tk_; dst[h_][i_] = (unsigned)(tk_ * K + CA[i_]) * 2u; } } while (0)
    const size_t kstep = (size_t)(BK * 2);
    const size_t hstep = (size_t)HALF * K * 2;
    const size_t tstep = 2 * hstep;
    const unsigned ldsw = (unsigned)wid * 1024u;
    const int aoff = lds_byte(wr * 64 + fr, fq * 8), boff = lds_byte(wc * 32 + fr, fq * 8);
#define PG8_SA(b, h) (((b) * 2 + (h)) * HTB)
#define PG8_SB(b, h) ((4 + (b) * 2 + (h)) * HTB)
#define PG8_STAGE(bufoff, gbase, voff) do { _Pragma("unroll") for (int _i = 0; _i < 2; ++_i) \
        __builtin_amdgcn_global_load_lds((const unsigned*)((const char*)(gbase) + (voff)[_i]), (PG8_LAS unsigned*)(lds + (bufoff) + ldsw + _i * 8192), 16, 0, 0); } while (0)
#define PG8_LDA(dst, b, h) do { _Pragma("unroll") for (int m = 0; m < 4; ++m) _Pragma("unroll") for (int k = 0; k < 2; ++k) dst[m][k] = *(const PG8_LAS bf16x8*)(lds + PG8_SA(b, h) + aoff + m * 2048 + k * 1024); } while (0)
#define PG8_LDB(dst, b, h) do { _Pragma("unroll") for (int n = 0; n < 2; ++n) _Pragma("unroll") for (int k = 0; k < 2; ++k) dst[n][k] = *(const PG8_LAS bf16x8*)(lds + PG8_SB(b, h) + boff + n * 2048 + k * 1024); } while (0)
#define PG8_MMA(ai, bj, At, Bt) do { __builtin_amdgcn_s_setprio(1); _Pragma("unroll") for (int m = 0; m < 4; ++m) _Pragma("unroll") for (int n = 0; n < 2; ++n) _Pragma("unroll") for (int k = 0; k < 2; ++k) \
        acc[ai][bj][m][n] = __builtin_amdgcn_mfma_f32_16x16x32_bf16(Bt[n][k], At[m][k], acc[ai][bj][m][n], 0, 0, 0); __builtin_amdgcn_s_setprio(0); } while (0)
#define PG8_WAIT_V(n) asm volatile("s_waitcnt vmcnt(" #n ")" ::: "memory")
#define PG8_WAIT_L(n) asm volatile("s_waitcnt lgkmcnt(" #n ")" ::: "memory")
#define PG8_BAR __builtin_amdgcn_s_barrier()
#define PG8_SCHED __builtin_amdgcn_sched_barrier(0)
    Unit cur, nxt; int ui = 0;
    if (!S.next(0, cur)) return;
    f32x4 acc[2][2][4][2];
#pragma unroll
    for (int a = 0; a < 2; ++a)
#pragma unroll
        for (int b = 0; b < 2; ++b)
#pragma unroll
            for (int m = 0; m < 4; ++m)
#pragma unroll
                for (int n = 0; n < 2; ++n) acc[a][b][m][n] = (f32x4){0.f, 0.f, 0.f, 0.f};
    bf16x8 At[4][2], B0[2][2], B1[2][2];
    const char* cA = (const char*)g.A; const char* cB = (const char*)g.Bt + (size_t)cur.pn * tstep;
    PG8_GMAP(vcur, cur.pm);
    S.a_ready(cur);
    if constexpr (SP2) {
        PG8_STAGE(PG8_SB(0, 0), cB, voffB); PG8_STAGE(PG8_SB(0, 1), cB + hstep, voffB); PG8_STAGE(PG8_SA(0, 0), cA, vcur[0]); PG8_STAGE(PG8_SA(0, 1), cA, vcur[1]);
        if (wr == 1) PG8_BAR;
        PG8_WAIT_V(2); PG8_BAR;
        PG8_STAGE(PG8_SB(1, 0), cB + kstep, voffB); PG8_STAGE(PG8_SA(1, 0), cA + kstep, vcur[0]); PG8_STAGE(PG8_SB(1, 1), cB + hstep + kstep, voffB);
        PG8_WAIT_V(6); PG8_BAR;
    } else {
        PG8_STAGE(PG8_SB(0, 0), cB, voffB); PG8_STAGE(PG8_SA(0, 0), cA, voffA); PG8_STAGE(PG8_SB(0, 1), cB + hstep, voffB); PG8_STAGE(PG8_SA(0, 1), cA + hstep, voffA);
        if (wr == 1) PG8_BAR;
        PG8_WAIT_V(4); PG8_BAR;
        PG8_STAGE(PG8_SB(1, 0), cB + kstep, voffB); PG8_STAGE(PG8_SA(1, 0), cA + kstep, voffA); PG8_STAGE(PG8_SB(1, 1), cB + hstep + kstep, voffB);
        PG8_WAIT_V(6); PG8_BAR;
    }
    for (;;) {
        const bool has_next = S.next(ui + 1, nxt);
        const char* nA = cA; const char* nB = has_next ? (const char*)g.Bt + (size_t)nxt.pn * tstep : cB;
        if (has_next) PG8_GMAP(vnxt, nxt.pm); else { vnxt[0][0] = vcur[0][0]; vnxt[0][1] = vcur[0][1]; vnxt[1][0] = vcur[1][0]; vnxt[1][1] = vcur[1][1]; }
        for (int t = 0; t < nt; t += 2) {
            const bool last = (t == nt - 2);
            const char* a1 = cA + (size_t)(t + 1) * kstep;
            const char* a2 = last ? nA : cA + (size_t)(t + 2) * kstep; unsigned v2[2][2]; v2[0][0] = last ? vnxt[0][0] : vcur[0][0]; v2[0][1] = last ? vnxt[0][1] : vcur[0][1]; v2[1][0] = last ? vnxt[1][0] : vcur[1][0]; v2[1][1] = last ? vnxt[1][1] : vcur[1][1]; const char* b2 = last ? nB : cB + (size_t)(t + 2) * kstep;
            const char* a3 = a2 + kstep; const char* b3 = b2 + kstep;
            if (last && has_next) S.a_ready(nxt);
            if constexpr (SP2) {
            PG8_LDB(B0, 0, 0); PG8_LDB(B1, 0, 1); PG8_SCHED; PG8_LDA(At, 0, 0); PG8_STAGE(PG8_SA(1, 1), a1, vcur[1]);
            PG8_WAIT_V(8); PG8_WAIT_L(0); PG8_BAR; PG8_MMA(0, 0, At, B0); PG8_MMA(0, 1, At, B1); PG8_BAR; PG8_SCHED;
            PG8_LDA(At, 0, 1); PG8_STAGE(PG8_SB(0, 0), b2, voffB); PG8_STAGE(PG8_SB(0, 1), b2 + hstep, voffB); PG8_STAGE(PG8_SA(0, 0), a2, v2[0]);
            PG8_WAIT_V(8); PG8_WAIT_L(0); PG8_BAR; PG8_MMA(1, 0, At, B0); PG8_MMA(1, 1, At, B1); PG8_BAR; PG8_SCHED;
            PG8_LDB(B0, 1, 0); PG8_LDB(B1, 1, 1); PG8_SCHED; PG8_LDA(At, 1, 0); PG8_STAGE(PG8_SA(0, 1), a2, v2[1]);
            PG8_WAIT_V(8); PG8_WAIT_L(0); PG8_BAR; PG8_MMA(0, 0, At, B0); PG8_MMA(0, 1, At, B1); PG8_BAR; PG8_SCHED;
            PG8_LDA(At, 1, 1); PG8_STAGE(PG8_SB(1, 0), b3, voffB); PG8_STAGE(PG8_SB(1, 1), b3 + hstep, voffB); PG8_STAGE(PG8_SA(1, 0), a3, v2[0]);
            PG8_WAIT_V(8); PG8_WAIT_L(0); PG8_BAR; PG8_MMA(1, 0, At, B0); PG8_MMA(1, 1, At, B1); PG8_BAR; PG8_SCHED;
            } else {
            PG8_LDB(B0, 0, 0); PG8_SCHED; PG8_LDA(At, 0, 0); PG8_STAGE(PG8_SA(1, 1), a1 + hstep, voffA);
            PG8_WAIT_L(8); PG8_BAR; PG8_WAIT_L(0); PG8_MMA(0, 0, At, B0); PG8_BAR; PG8_SCHED;
            PG8_LDB(B1, 0, 1); PG8_STAGE(PG8_SB(0, 0), b2, voffB);
            PG8_BAR; PG8_WAIT_L(0); PG8_MMA(0, 1, At, B1); PG8_BAR;
            PG8_LDA(At, 0, 1); PG8_STAGE(PG8_SA(0, 0), a2, voffA);
            PG8_BAR; PG8_WAIT_L(0); PG8_MMA(1, 0, At, B0); PG8_BAR; PG8_SCHED;
            PG8_STAGE(PG8_SB(0, 1), b2 + hstep, voffB);
            PG8_WAIT_V(6); PG8_BAR; PG8_MMA(1, 1, At, B1); PG8_BAR;
            PG8_LDB(B0, 1, 0); PG8_SCHED; PG8_LDA(At, 1, 0); PG8_STAGE(PG8_SA(0, 1), a2 + hstep, voffA);
            PG8_WAIT_L(8); PG8_BAR; PG8_WAIT_L(0); PG8_MMA(0, 0, At, B0); PG8_BAR; PG8_SCHED;
            PG8_LDB(B1, 1, 1); PG8_STAGE(PG8_SB(1, 0), b3, voffB);
            PG8_BAR; PG8_WAIT_L(0); PG8_MMA(0, 1, At, B1); PG8_BAR;
            PG8_LDA(At, 1, 1); PG8_STAGE(PG8_SA(1, 0), a3, voffA);
            PG8_BAR; PG8_WAIT_L(0); PG8_MMA(1, 0, At, B0); PG8_BAR; PG8_SCHED;
            PG8_STAGE(PG8_SB(1, 1), b3 + hstep, voffB);
            PG8_WAIT_V(6); PG8_BAR; PG8_MMA(1, 1, At, B1); PG8_BAR;
            }
        }
        if constexpr (ALIGN_EPI) { if (wr == 0) PG8_BAR; }
        if constexpr (!Epi::AFTER_DRAIN) { E(acc, cur, wr, wc, fr, fq); S.done(cur); }
        if (!has_next) break;
#pragma unroll
        for (int a = 0; a < 2; ++a)
#pragma unroll
            for (int b = 0; b < 2; ++b)
#pragma unroll
                for (int m = 0; m < 4; ++m)
#pragma unroll
                    for (int n = 0; n < 2; ++n) acc[a][b][m][n] = (f32x4){0.f, 0.f, 0.f, 0.f};
        cur = nxt; cA = nA; cB = nB; ++ui; vcur[0][0] = vnxt[0][0]; vcur[0][1] = vnxt[0][1]; vcur[1][0] = vnxt[1][0]; vcur[1][1] = vnxt[1][1];
        if constexpr (ALIGN_EPI) { if (wr == 1) PG8_BAR; }
    }
    PG8_WAIT_V(0);
    if constexpr (!ALIGN_EPI) { if (wr == 0) PG8_BAR; }
    PG8_BAR;
    if constexpr (Epi::AFTER_DRAIN) { E.fused(acc, cur, wr, wc, fr, fq, lds, wid, lane); S.done(cur); }
#undef PG8_GMAP
#undef PG8_SA
#undef PG8_SB
#undef PG8_STAGE
#undef PG8_LDA
#undef PG8_LDB
#undef PG8_MMA
#undef PG8_WAIT_V
#undef PG8_WAIT_L
#undef PG8_BAR
#undef PG8_SCHED
}

}

#define DI __device__ __forceinline__
#define LAS __attribute__((address_space(3)))
typedef unsigned short bf16_t;
typedef short bf16x8 __attribute__((ext_vector_type(8)));
typedef _Float16 f16x8 __attribute__((ext_vector_type(8)));
typedef float f32x4 __attribute__((ext_vector_type(4)));
typedef float f32x16 __attribute__((ext_vector_type(16)));
typedef unsigned u32x4 __attribute__((ext_vector_type(4)));
typedef unsigned u32x2 __attribute__((ext_vector_type(2)));

constexpr int NB = 4, SEQ = 4096, T = NB * SEQ, D = 1024, DEPTH = 2;
constexpr int PLD = 3912;
constexpr int PC_Q = 0, PC_K = 512, PC_V = 1024, PC_QI = 1536, PC_KI = 2048, PC_WI = 2112;
constexpr int PC_R = 2120, PC_BK = 2632, PC_BV = 3144, PC_WD = 3656;
constexpr int NPROJ_PAD = 4096;
constexpr int NEXP = 16, DEXP = 256, PLE = 256;
constexpr float ALPHA = 1.4142135623730951f;
constexpr float LN_EPS = 1e-5f, GN_EPS = 64e-5f;
constexpr int MAXROWS = 2 * T + NEXP * 256;
constexpr int NWAVES = 8, NTHR = 512;

constexpr size_t MiB = 1u << 20;
constexpr size_t WS_CTL = 0, CTL_BYTES = 1 * MiB;
constexpr size_t WS_WEXP = 1 * MiB;
constexpr size_t WS_WDOWN = 17 * MiB;
constexpr size_t WS_WOUT = 25 * MiB, WS_WPG = 27 * MiB, WS_WPLE = 29 * MiB;
constexpr size_t WS_BM = 30 * MiB;
constexpr size_t WS_ELL = 38 * MiB, WS_AA = 70 * MiB, WS_GG = 102 * MiB;
constexpr size_t WS_PROJ = 119 * MiB;
constexpr size_t WS_PBF = 242 * MiB;
constexpr size_t WS_V = 119 * MiB;
constexpr size_t WS_AG = 38 * MiB;
constexpr size_t WS_H = 183 * MiB;
constexpr size_t WS_Y = 119 * MiB;
constexpr size_t WS_PE = 201 * MiB;
constexpr size_t WS_V3 = 38 * MiB;
constexpr size_t WS_TOK = 233 * MiB;
constexpr size_t WS_ROW = 234 * MiB;
constexpr int CW_GCNT = 1024;

struct TokInfo { int e0, e1, p0, p1; float g0, g1; int pad0, pad1; };
struct RowInfo { int token, slot; float gate; int pad; };

#define LDS_WAIT() asm volatile("s_waitcnt lgkmcnt(0)" ::: "memory")
#define VM_WAIT() asm volatile("s_waitcnt vmcnt(0)" ::: "memory")
DI unsigned f2bf(float f) { unsigned u = __builtin_bit_cast(unsigned, f); return (u + 0x7fffu + ((u >> 16) & 1u)) >> 16; }
DI unsigned pk2(float lo, float hi) { return pg8::cvt_pk_bf16(lo, hi); }
DI float bf2f(unsigned short b) { return __builtin_bit_cast(float, (unsigned)b << 16); }
DI float bflo(unsigned w) { return __builtin_bit_cast(float, w << 16); }
DI float bfhi(unsigned w) { return __builtin_bit_cast(float, w & 0xffff0000u); }
DI unsigned pk2h(float lo, float hi) { typedef _Float16 h2_t __attribute__((ext_vector_type(2))); h2_t v = {(_Float16)lo, (_Float16)hi}; return __builtin_bit_cast(unsigned, v); }
DI float wave_sum(float v) {
#pragma unroll
    for (int o = 1; o < 64; o <<= 1) v += __shfl_xor(v, o);
    return v;
}
DI int opaque_i(int v) { asm volatile("" : "+s"(v)); return v; }
DI float sigmoidf_(float x) { return 1.f / (1.f + __expf(-x)); }

struct Args { const float* in[31]; float* out; unsigned char* ws; int ph_lo, ph_hi; };
struct Ctx {
    LAS unsigned char* lds;
    int tid, lane, wave, G, blk;
    const __attribute__((address_space(4))) Args* ap;
    float* out; unsigned char* ws;
    unsigned* ctl;
    bf16_t* xcur; bf16_t* mixcat;
    DI const float* in(int i) const { return ap->in[i]; }
};

DI void ln16(f32x4 (&v)[4], const float* g, const float* b, int lane) {
    float s = 0.f;
#pragma unroll
    for (int j = 0; j < 4; ++j) s += (v[j].x + v[j].y) + (v[j].z + v[j].w);
    const float mean = wave_sum(s) * (1.f / D);
    float s2 = 0.f;
#pragma unroll
    for (int j = 0; j < 4; ++j) { v[j] = v[j] - mean; s2 += (v[j].x * v[j].x + v[j].y * v[j].y) + (v[j].z * v[j].z + v[j].w * v[j].w); }
    const float rstd = 1.f / sqrtf(wave_sum(s2) * (1.f / D) + LN_EPS);
#pragma unroll
    for (int j = 0; j < 4; ++j) { const f32x4 gg = *(const f32x4*)(g + 256 * j + 4 * lane), bb = *(const f32x4*)(b + 256 * j + 4 * lane); v[j] = v[j] * rstd * gg + bb; }
}
DI void store_row_bf16(bf16_t* row, const f32x4 (&v)[4], int lane) {
#pragma unroll
    for (int j = 0; j < 4; ++j) { u32x2 o; o.x = pk2(v[j].x, v[j].y); o.y = pk2(v[j].z, v[j].w); *(u32x2*)(row + 256 * j + 4 * lane) = o; }
}
DI void load_row_bf16(const bf16_t* row, f32x4 (&v)[4], int lane) {
#pragma unroll
    for (int j = 0; j < 4; ++j) { const u32x2 o = *(const u32x2*)(row + 256 * j + 4 * lane); v[j] = (f32x4){bflo(o.x), bfhi(o.x), bflo(o.y), bfhi(o.y)}; }
}

template <class ColPtr>
DI void transpose_item(const ColPtr colptr, int ld, int K, bf16_t* WT, int n0, int k0, LAS float* scr, int lane) {
    const float* sp = colptr(n0 + (lane & 31));
    float tv[32];
#pragma unroll
    for (int i = 0; i < 32; ++i) { const int kk = 2 * i + (lane >> 5); tv[i] = sp ? sp[(size_t)(k0 + kk) * ld] : 0.f; }
#pragma unroll
    for (int i = 0; i < 32; ++i) { const int kk = 2 * i + (lane >> 5); scr[kk * 33 + (lane & 31)] = tv[i]; }
    LDS_WAIT(); asm volatile("" ::: "memory");
    const int c = lane & 7;
#pragma unroll
    for (int j = 0; j < 4; ++j) { const int n = (lane >> 3) + 8 * j; const LAS float* s = scr + (8 * c) * 33 + n;
        u32x4 o; o.x = pk2(s[0 * 33], s[1 * 33]); o.y = pk2(s[2 * 33], s[3 * 33]); o.z = pk2(s[4 * 33], s[5 * 33]); o.w = pk2(s[6 * 33], s[7 * 33]);
        *(u32x4*)(WT + (size_t)(n0 + n) * K + k0 + 8 * c) = o; }
    LDS_WAIT(); asm volatile("" ::: "memory");
}
template <class ColPtr>
DI void convert_matrix(Ctx& C, const ColPtr colptr, int ld, int K, int N, bf16_t* WT, int& first) {
    LAS float* scr = (LAS float*)(C.lds + C.wave * 16384);
    const int gw = C.blk * NWAVES + C.wave, NGW = C.G * NWAVES;
    const int nblk = N / 32, nitems = (K / 64) * nblk;
    int it = gw - (first % NGW); if (it < 0) it += NGW;
    for (; it < nitems; it += NGW) transpose_item(colptr, ld, K, WT, 32 * (it % nblk), 64 * (it / nblk), scr, C.lane);
    first += nitems;
}

struct ColWin { const float* w; DI const float* operator()(int j) const { if (j < 2120) return w + j; if (j >= 2176 && j < 3968) return w + (j - 56); return nullptr; } };
struct ColPlain { const float* w; DI const float* operator()(int j) const { return w + j; } };
struct ColGateUp { const float* wg; const float* wu; DI const float* operator()(int j) const {
        const int e = j >> 9, pn = (j >> 8) & 1, jj = j & 255; const int col = pn * 128 + (jj & 127); const uintptr_t pg = (uintptr_t)wg, pu = (uintptr_t)wu; const uintptr_t sel = pg + ((jj >= 128) ? (pu - pg) : (uintptr_t)0); return (const float*)sel + (size_t)e * D * DEXP + col; } };
struct ColDown { const float* wd; DI const float* operator()(int j) const { return wd + j; } };

DI void phase_ln_in(Ctx& C) {
    const int gw = C.blk * NWAVES + C.wave, NGW = C.G * NWAVES;
    for (int m = gw; m < T; m += NGW) {
        f32x4 v[4]; const float* xr = C.in(0) + (size_t)m * D;
#pragma unroll
        for (int j = 0; j < 4; ++j) v[j] = *(const f32x4*)(xr + 256 * j + 4 * C.lane);
        ln16(v, C.in(2), C.in(3), C.lane);
        store_row_bf16(C.xcur + (size_t)m * D, v, C.lane);
    }
}
DI void convert_win(Ctx& C, int l) { int first = 0; ColWin cw{C.in(4) + (size_t)l * D * 3912}; convert_matrix(C, cw, 3912, D, NPROJ_PAD, (bf16_t*)(C.ws + WS_WEXP), first); }
DI void convert_layer_weights(Ctx& C, int l) {
    int first = 0;
    { ColPlain c{C.in(5) + (size_t)l * D * D}; convert_matrix(C, c, D, D, D, (bf16_t*)(C.ws + WS_WOUT), first); }
    { ColGateUp c{C.in(20) + (size_t)l * NEXP * D * DEXP, C.in(21) + (size_t)l * NEXP * D * DEXP}; convert_matrix(C, c, DEXP, D, NEXP * 512, (bf16_t*)(C.ws + WS_WEXP), first); }
    for (int e = 0; e < NEXP; ++e) { ColDown c{C.in(22) + ((size_t)l * NEXP + e) * DEXP * D}; convert_matrix(C, c, D, DEXP, D, (bf16_t*)(C.ws + WS_WDOWN) + (size_t)e * D * DEXP, first); }
    { ColPlain c{C.in(24) + (size_t)l * D * D}; convert_matrix(C, c, D, D, D, (bf16_t*)(C.ws + WS_WPG), first); }
    { ColPlain c{C.in(23) + (size_t)l * PLE * D}; convert_matrix(C, c, D, PLE, D, (bf16_t*)(C.ws + WS_WPLE), first); }
    const float* p = C.in(1) + (size_t)l * T * PLE; bf16_t* pb = (bf16_t*)(C.ws + WS_PBF);
    for (size_t i = ((size_t)C.blk * NTHR + C.tid) * 8; i < (size_t)T * PLE; i += (size_t)C.G * NTHR * 8) {
        const f32x4 a = *(const f32x4*)(p + i), b = *(const f32x4*)(p + i + 4);
        u32x4 o; o.x = pk2(a.x, a.y); o.y = pk2(a.z, a.w); o.z = pk2(b.x, b.y); o.w = pk2(b.z, b.w); *(u32x4*)(pb + i) = o; }
}

struct EpiProj {
    static constexpr bool PERM = true, AFTER_DRAIN = false;
    bf16_t* P;
    DI void operator()(const f32x4 (&acc)[2][2][4][2], const pg8::Unit& u, int wr, int wc, int fr, int fq) const {
        const int row0 = u.pm * 256 + wr * 64 + fr;
#pragma unroll
        for (int bj = 0; bj < 2; ++bj) {
            const int j0 = u.pn * 256 + bj * 128 + wc * 32 + 8 * fq;
            int dst; bool half = false;
            if (j0 < 2120) { dst = j0; half = (j0 >= 1536); } else if (j0 >= 2176 && j0 < 3968) dst = j0 - 56; else dst = -1;
            if (dst >= 0) {
#pragma unroll
                for (int ai = 0; ai < 2; ++ai)
#pragma unroll
                    for (int m = 0; m < 4; ++m) {
                        const f32x4 v0 = acc[ai][bj][m][0], v1 = acc[ai][bj][m][1]; u32x4 w;
                        if (half) { w.x = pk2h(v0[0], v0[1]); w.y = pk2h(v0[2], v0[3]); w.z = pk2h(v1[0], v1[1]); w.w = pk2h(v1[2], v1[3]); }
                        else { w.x = pk2(v0[0], v0[1]); w.y = pk2(v0[2], v0[3]); w.z = pk2(v1[0], v1[1]); w.w = pk2(v1[2], v1[3]); }
                        *(u32x4*)(P + (size_t)(row0 + ai * 128 + m * 16) * PLD + dst) = w; }
            }
        }
    }
};
struct EpiBf16Plain {
    static constexpr bool PERM = true, AFTER_DRAIN = false;
    bf16_t* O; int ldc;
    DI void operator()(const f32x4 (&acc)[2][2][4][2], const pg8::Unit& u, int wr, int wc, int fr, int fq) const {
        const int row0 = u.pm * 256 + wr * 64 + fr, col0 = u.pn * 256 + wc * 32 + 8 * fq;
#pragma unroll
        for (int ai = 0; ai < 2; ++ai)
#pragma unroll
            for (int m = 0; m < 4; ++m)
#pragma unroll
                for (int bj = 0; bj < 2; ++bj) { const f32x4 v0 = acc[ai][bj][m][0], v1 = acc[ai][bj][m][1]; u32x4 w; w.x = pk2(v0[0], v0[1]); w.y = pk2(v0[2], v0[3]); w.z = pk2(v1[0], v1[1]); w.w = pk2(v1[2], v1[3]);
                    *(u32x4*)(O + (size_t)(row0 + ai * 128 + m * 16) * ldc + col0 + bj * 128) = w; }
    }
};
struct EpiResF32 {
    static constexpr bool PERM = false, AFTER_DRAIN = false;
    const bf16_t* X; bf16_t* V;
    DI void operator()(const f32x4 (&acc)[2][2][4][2], const pg8::Unit& u, int wr, int wc, int fr, int fq) const {
        const int row0 = u.pm * 256 + wr * 64 + fr, col0 = u.pn * 256 + wc * 32 + 4 * fq;
#pragma unroll
        for (int ai = 0; ai < 2; ++ai)
#pragma unroll
            for (int m = 0; m < 4; ++m)
#pragma unroll
                for (int bj = 0; bj < 2; ++bj)
#pragma unroll
                    for (int n = 0; n < 2; ++n) { const size_t off = (size_t)(row0 + ai * 128 + m * 16) * D + col0 + bj * 128 + n * 16;
                        const u32x2 xb = *(const u32x2*)(X + off); const f32x4 xv = {bflo(xb.x), bfhi(xb.x), bflo(xb.y), bfhi(xb.y)};
                        const f32x4 o = xv * ALPHA + acc[ai][bj][m][n]; u32x2 ob; ob.x = pk2(o.x, o.y); ob.y = pk2(o.z, o.w); *(u32x2*)(V + off) = ob; }
    }
};
struct EpiPle {
    static constexpr bool PERM = false, AFTER_DRAIN = false;
    const bf16_t* X; const bf16_t* PE; bf16_t* V;
    DI void operator()(const f32x4 (&acc)[2][2][4][2], const pg8::Unit& u, int wr, int wc, int fr, int fq) const {
        const int row0 = u.pm * 256 + wr * 64 + fr, col0 = u.pn * 256 + wc * 32 + 4 * fq;
#pragma unroll
        for (int ai = 0; ai < 2; ++ai) {
            u32x2 xb[16], pb[16];
#pragma unroll
            for (int q = 0; q < 16; ++q) { const int m = q >> 2, bj = (q >> 1) & 1, n = q & 1; const size_t off = (size_t)(row0 + ai * 128 + m * 16) * D + col0 + bj * 128 + n * 16;
                xb[q] = *(const u32x2*)(X + off); pb[q] = *(const u32x2*)(PE + off); }
#pragma unroll
            for (int q = 0; q < 16; ++q) { const int m = q >> 2, bj = (q >> 1) & 1, n = q & 1; const size_t off = (size_t)(row0 + ai * 128 + m * 16) * D + col0 + bj * 128 + n * 16;
                const f32x4 xv = {bflo(xb[q].x), bfhi(xb[q].x), bflo(xb[q].y), bfhi(xb[q].y)}; const f32x4 pv = {bflo(pb[q].x), bfhi(pb[q].x), bflo(pb[q].y), bfhi(pb[q].y)};
                const f32x4 a = acc[ai][bj][m][n]; f32x4 s; s.x = sigmoidf_(a.x); s.y = sigmoidf_(a.y); s.z = sigmoidf_(a.z); s.w = sigmoidf_(a.w);
                const f32x4 o = xv * ALPHA + s * pv; u32x2 ob; ob.x = pk2(o.x, o.y); ob.y = pk2(o.z, o.w); *(u32x2*)(V + off) = ob; }
        }
    }
};
struct EpiSwiGLU {
    static constexpr bool PERM = true, AFTER_DRAIN = false;
    bf16_t* H; const RowInfo* R;
    DI void operator()(const f32x4 (&acc)[2][2][4][2], const pg8::Unit& u, int wr, int wc, int fr, int fq) const {
        const int row0 = u.pm * 256 + wr * 64 + fr, col0 = (u.pn & 1) * 128 + wc * 32 + 8 * fq;
#pragma unroll
        for (int ai = 0; ai < 2; ++ai)
#pragma unroll
            for (int m = 0; m < 4; ++m) { const int row = row0 + ai * 128 + m * 16; const float gw = R[row].gate;
                float h[8];
#pragma unroll
                for (int n = 0; n < 2; ++n)
#pragma unroll
                    for (int i = 0; i < 4; ++i) { const float g = acc[ai][0][m][n][i], up = acc[ai][1][m][n][i]; h[4 * n + i] = g * sigmoidf_(g) * up * gw; }
                u32x4 w; w.x = pk2(h[0], h[1]); w.y = pk2(h[2], h[3]); w.z = pk2(h[4], h[5]); w.w = pk2(h[6], h[7]);
                *(u32x4*)(H + (size_t)row * DEXP + col0) = w; }
    }
};
struct EpiDown {
    static constexpr bool PERM = true, AFTER_DRAIN = false;
    bf16_t* Y; const RowInfo* R;
    DI void operator()(const f32x4 (&acc)[2][2][4][2], const pg8::Unit& u, int wr, int wc, int fr, int fq) const {
        const int row0 = u.pm * 256 + wr * 64 + fr, col0 = (u.pn & 3) * 256 + wc * 32 + 8 * fq;
#pragma unroll
        for (int ai = 0; ai < 2; ++ai)
#pragma unroll
            for (int m = 0; m < 4; ++m) { const int row = row0 + ai * 128 + m * 16; const RowInfo ri = R[row];
                if (ri.token >= 0) { bf16_t* dst = Y + ((size_t)ri.slot * T + ri.token) * D + col0;
#pragma unroll
                    for (int bj = 0; bj < 2; ++bj) { const f32x4 v0 = acc[ai][bj][m][0], v1 = acc[ai][bj][m][1]; u32x4 w; w.x = pk2(v0[0], v0[1]); w.y = pk2(v0[2], v0[3]); w.z = pk2(v1[0], v1[1]); w.w = pk2(v1[2], v1[3]);
                        *(u32x4*)(dst + bj * 128) = w; } } }
    }
};
template <int NPN> struct GroupedOrder {
    const LAS int* texp; int ntiles, G, c;
    DI bool next(int i, pg8::Unit& u) const { const int L = i * G + c; if (L >= ntiles * NPN) return false; u.pm = L / NPN; u.pn = texp[u.pm] * NPN + (L % NPN); return true; }
    DI void a_ready(const pg8::Unit&) const {}
    DI void done(const pg8::Unit&) const {}
};

constexpr int IDX_CAP = 512;
DI unsigned ordkey(float s) { const unsigned b = __builtin_bit_cast(unsigned, s); return (b & 0x80000000u) ? ~b : (b | 0x80000000u); }
DI float unordkey(unsigned k) { const unsigned b = (k & 0x80000000u) ? (k & 0x7fffffffu) : ~k; return __builtin_bit_cast(float, b); }

DI void idx_item(Ctx& C, int item, int l) {
    const int b = item & 3, qt = 511 - (item >> 2);
    const int t0 = qt * 8, chunk = t0 >> 6, NT32 = 2 * (chunk + 1);
    const size_t tok0 = (size_t)b * SEQ + t0;
    unsigned* bm = (unsigned*)(C.ws + WS_BM);
    const int lane = C.lane, wave = C.wave, tid = C.tid;
    if (chunk < 4) {
        if (tid < 8 * NT32) { const int q = tid / NT32, kt = tid % NT32; bm[(tok0 + q) * 128 + kt] = 0xffffffffu; }
        return;
    }
    const _Float16* ph = (const _Float16*)(C.ws + WS_PROJ);
    LAS unsigned* hist = (LAS unsigned*)(C.lds);
    LAS float* candS = (LAS float*)(C.lds + 8192);
    LAS int* candI = (LAS int*)(C.lds + 24576);
    LAS float* redmn = (LAS float*)(C.lds + 40960);
    LAS float* redmx = redmn + 64;
    LAS int* selB = (LAS int*)(C.lds + 41472);
    LAS unsigned* selAbove = (LAS unsigned*)(selB + 8);
    LAS unsigned* ccount = selAbove + 8;
    LAS float* thrS = (LAS float*)(ccount + 8);
    LAS int* thrI = (LAS int*)(thrS + 8);
    LAS unsigned* ovf = (LAS unsigned*)(thrI + 8);
    LAS unsigned* fbT = ovf + 8;
    LAS unsigned* fbCnt = fbT + 8;
    LAS unsigned* fbNeed = fbCnt + 8;
    const int r = lane & 31, hh = lane >> 5;
    float sc[2][16][2];
    f16x8 afr[2][4]; float wq[2][2][8];
#pragma unroll
    for (int m = 0; m < 2; ++m) {
        const int gq = (r >> 2) & 1, i = r >> 3, jj = r & 3, query = 4 * m + 2 * gq + (i >> 1), head = 4 * (i & 1) + jj;
        const _Float16* qp = ph + (tok0 + query) * PLD + PC_QI + head * 64 + 8 * hh;
#pragma unroll
        for (int s = 0; s < 4; ++s) afr[m][s] = *(const f16x8*)(qp + 16 * s);
#pragma unroll
        for (int qq = 0; qq < 2; ++qq) { const int q2 = 4 * m + 2 * hh + qq; const f16x8 wv = *(const f16x8*)(ph + (tok0 + q2) * PLD + PC_WI);
#pragma unroll
            for (int e = 0; e < 8; ++e) wq[m][qq][e] = (float)wv[e] * 0.044194173824159216f; }
    }
    const _Float16* kbase = ph + ((size_t)b * SEQ + r) * PLD + PC_KI + 8 * hh;
    f16x8 bnx[4];
#pragma unroll
    for (int s = 0; s < 4; ++s) bnx[s] = *(const f16x8*)(kbase + (size_t)(32 * wave) * PLD + 16 * s);
#pragma unroll
    for (int it = 0; it < 16; ++it) {
        const int kt = wave + 8 * it;
        if (kt < NT32) {
            f16x8 bfr[4];
#pragma unroll
            for (int s = 0; s < 4; ++s) bfr[s] = bnx[s];
            if (kt + 8 < NT32) {
#pragma unroll
                for (int s = 0; s < 4; ++s) bnx[s] = *(const f16x8*)(kbase + (size_t)(32 * (kt + 8)) * PLD + 16 * s); }
#pragma unroll
            for (int m = 0; m < 2; ++m) {
                f32x16 c = {};
#pragma unroll
                for (int s = 0; s < 4; ++s) c = __builtin_amdgcn_mfma_f32_32x32x16_f16(afr[m][s], bfr[s], c, 0, 0, 0);
#pragma unroll
                for (int qq = 0; qq < 2; ++qq) { float a = 0.f;
#pragma unroll
                    for (int e = 0; e < 8; ++e) a += wq[m][qq][e] * fmaxf(c[8 * qq + e], 0.f);
                    sc[m][it][qq] = a; }
            }
        } else { sc[0][it][0] = 0.f; sc[0][it][1] = 0.f; sc[1][it][0] = 0.f; sc[1][it][1] = 0.f; }
    }
    float mn[2][2], mx[2][2];
#pragma unroll
    for (int m = 0; m < 2; ++m)
#pragma unroll
        for (int qq = 0; qq < 2; ++qq) { float a = 3.0e38f, z = -3.0e38f;
#pragma unroll
            for (int it = 0; it < 16; ++it) if (wave + 8 * it < NT32) z = fmaxf(z, sc[m][it][qq]);
            a = z;
#pragma unroll
            for (int o = 1; o < 32; o <<= 1) { a = fminf(a, __shfl_xor(a, o)); z = fmaxf(z, __shfl_xor(z, o)); }
            mn[m][qq] = a; mx[m][qq] = z; }
    asm volatile("s_waitcnt lgkmcnt(0)\n\ts_barrier" ::: "memory");
    if (r == 0) {
#pragma unroll
        for (int m = 0; m < 2; ++m)
#pragma unroll
            for (int qq = 0; qq < 2; ++qq) { const int qid = 4 * m + 2 * hh + qq; redmn[wave * 8 + qid] = mn[m][qq]; redmx[wave * 8 + qid] = mx[m][qq]; }
    }
    for (int i = tid; i < 2048; i += NTHR) hist[i] = 0u;
    if (tid < 8) { ccount[tid] = 0u; ovf[tid] = 0u; }
    asm volatile("s_waitcnt lgkmcnt(0)\n\ts_barrier" ::: "memory");
    float lo[2][2], scl[2][2];
#pragma unroll
    for (int m = 0; m < 2; ++m)
#pragma unroll
        for (int qq = 0; qq < 2; ++qq) { const int qid = 4 * m + 2 * hh + qq; float a = 3.0e38f, z = -3.0e38f;
#pragma unroll
            for (int w = 0; w < 8; ++w) { a = fminf(a, redmn[w * 8 + qid]); z = fmaxf(z, redmx[w * 8 + qid]); }
            lo[m][qq] = a; scl[m][qq] = (z > a) ? 256.f / (z - a) : 0.f; }
#define IDX_BIN(m, it, qq) ((sc[m][it][qq] >= lo[m][qq]) ? min(255, (int)((sc[m][it][qq] - lo[m][qq]) * scl[m][qq])) : -1)
#define IDX_LAUNDER() do { _Pragma("unroll") for (int m_ = 0; m_ < 2; ++m_) _Pragma("unroll") for (int q_ = 0; q_ < 2; ++q_) { asm volatile("" : "+v"(lo[m_][q_]), "+v"(scl[m_][q_])); } } while (0)
#pragma unroll
    for (int m = 0; m < 2; ++m)
#pragma unroll
        for (int qq = 0; qq < 2; ++qq) { const int qid = 4 * m + 2 * hh + qq;
#pragma unroll
            for (int it = 0; it < 16; ++it) if (wave + 8 * it < NT32) { const int bin_ = IDX_BIN(m, it, qq); if (bin_ >= 0) __hip_atomic_fetch_add(hist + qid * 256 + bin_, 1u, __ATOMIC_RELAXED, __HIP_MEMORY_SCOPE_WORKGROUP); } }
    asm volatile("s_waitcnt lgkmcnt(0)\n\ts_barrier" ::: "memory");
    {
        const u32x4 h4 = *(const LAS u32x4*)(hist + wave * 256 + 4 * lane);
        const unsigned tot = h4.x + h4.y + h4.z + h4.w; unsigned incl = tot;
#pragma unroll
        for (int o = 1; o < 64; o <<= 1) { const unsigned v = __shfl_down(incl, o); if (lane + o < 64) incl += v; }
        unsigned run = incl - tot; int Bf = -1; unsigned ab = 0;
#pragma unroll
        for (int j = 3; j >= 0; --j) { const unsigned h = h4[j]; if (run < 256u && run + h >= 256u) { Bf = 4 * lane + j; ab = run; } run += h; }
        if (Bf >= 0) { selB[wave] = Bf; selAbove[wave] = ab; }
    }
    asm volatile("s_waitcnt lgkmcnt(0)\n\ts_barrier" ::: "memory");
    IDX_LAUNDER();
#pragma unroll
    for (int m = 0; m < 2; ++m)
#pragma unroll
        for (int qq = 0; qq < 2; ++qq) { const int qid = 4 * m + 2 * hh + qq; const int B = selB[qid];
#pragma unroll
            for (int it = 0; it < 16; ++it) if (wave + 8 * it < NT32) { const bool hit = (IDX_BIN(m, it, qq) == B); if (__any(hit)) { if (hit) { const unsigned pos = __hip_atomic_fetch_add(ccount + qid, 1u, __ATOMIC_RELAXED, __HIP_MEMORY_SCOPE_WORKGROUP);
                if (pos < (unsigned)IDX_CAP) { candS[qid * IDX_CAP + pos] = sc[m][it][qq]; candI[qid * IDX_CAP + pos] = 32 * (wave + 8 * it) + r; } } } } }
    asm volatile("s_waitcnt lgkmcnt(0)\n\ts_barrier" ::: "memory");
    {
        const int c = (int)ccount[wave]; const int need = 256 - (int)selAbove[wave];
        if (c <= IDX_CAP) {
            for (int i = lane; i < c; i += 64) { const float si = candS[wave * IDX_CAP + i]; const int ii = candI[wave * IDX_CAP + i]; int rank = 0;
                for (int j = 0; j < c; ++j) { const float sj = candS[wave * IDX_CAP + j]; const int ij = candI[wave * IDX_CAP + j]; rank += ((sj > si) || (sj == si && ij < ii)) ? 1 : 0; }
                if (rank == need - 1) { thrS[wave] = si; thrI[wave] = ii; } }
        } else if (lane == 0) { ovf[wave] = 1u; fbNeed[wave] = (unsigned)need; fbT[wave] = 0u; }
    }
    asm volatile("s_waitcnt lgkmcnt(0)\n\ts_barrier" ::: "memory");
    unsigned anyovf = 0u;
#pragma unroll
    for (int q = 0; q < 8; ++q) anyovf |= ovf[q];
    if (anyovf) {
        for (int bit = 31; bit >= 0; --bit) {
            if (tid < 8) fbCnt[tid] = 0u;
            asm volatile("s_waitcnt lgkmcnt(0)\n\ts_barrier" ::: "memory");
            IDX_LAUNDER();
#pragma unroll
            for (int m = 0; m < 2; ++m)
#pragma unroll
                for (int qq = 0; qq < 2; ++qq) { const int qid = 4 * m + 2 * hh + qq; if (ovf[qid]) { const unsigned cand = fbT[qid] | (1u << bit); const int B = selB[qid]; unsigned cnt = 0;
#pragma unroll
                    for (int it = 0; it < 16; ++it) if (wave + 8 * it < NT32) cnt += (IDX_BIN(m, it, qq) == B && ordkey(sc[m][it][qq]) >= cand) ? 1u : 0u;
                    if (cnt) __hip_atomic_fetch_add(fbCnt + qid, cnt, __ATOMIC_RELAXED, __HIP_MEMORY_SCOPE_WORKGROUP); } }
            asm volatile("s_waitcnt lgkmcnt(0)\n\ts_barrier" ::: "memory");
            if (tid < 8 && ovf[tid] && fbCnt[tid] >= fbNeed[tid]) fbT[tid] |= (1u << bit);
            asm volatile("s_waitcnt lgkmcnt(0)\n\ts_barrier" ::: "memory");
        }
        if (tid < 8) fbCnt[tid] = 0u;
        asm volatile("s_waitcnt lgkmcnt(0)\n\ts_barrier" ::: "memory");
        IDX_LAUNDER();
#pragma unroll
        for (int m = 0; m < 2; ++m)
#pragma unroll
            for (int qq = 0; qq < 2; ++qq) { const int qid = 4 * m + 2 * hh + qq; if (ovf[qid]) { const unsigned Tk = fbT[qid]; const int B = selB[qid]; unsigned cnt = 0;
#pragma unroll
                for (int it = 0; it < 16; ++it) if (wave + 8 * it < NT32) cnt += (IDX_BIN(m, it, qq) == B && ordkey(sc[m][it][qq]) > Tk) ? 1u : 0u;
                if (cnt) __hip_atomic_fetch_add(fbCnt + qid, cnt, __ATOMIC_RELAXED, __HIP_MEMORY_SCOPE_WORKGROUP); } }
        asm volatile("s_waitcnt lgkmcnt(0)\n\ts_barrier" ::: "memory");
        if (tid < 8 && ovf[tid]) { fbNeed[tid] -= fbCnt[tid]; thrS[tid] = unordkey(fbT[tid]); thrI[tid] = 0; }
        asm volatile("s_waitcnt lgkmcnt(0)\n\ts_barrier" ::: "memory");
        for (int bit = 11; bit >= 0; --bit) {
            if (tid < 8) fbCnt[tid] = 0u;
            asm volatile("s_waitcnt lgkmcnt(0)\n\ts_barrier" ::: "memory");
            IDX_LAUNDER();
#pragma unroll
            for (int m = 0; m < 2; ++m)
#pragma unroll
                for (int qq = 0; qq < 2; ++qq) { const int qid = 4 * m + 2 * hh + qq; if (ovf[qid]) { const unsigned Tk = fbT[qid]; const int B = selB[qid]; const int cand = thrI[qid] | (1 << bit); unsigned cnt = 0;
#pragma unroll
                    for (int it = 0; it < 16; ++it) if (wave + 8 * it < NT32) cnt += (IDX_BIN(m, it, qq) == B && ordkey(sc[m][it][qq]) == Tk && (32 * (wave + 8 * it) + r) < cand) ? 1u : 0u;
                    if (cnt) __hip_atomic_fetch_add(fbCnt + qid, cnt, __ATOMIC_RELAXED, __HIP_MEMORY_SCOPE_WORKGROUP); } }
            asm volatile("s_waitcnt lgkmcnt(0)\n\ts_barrier" ::: "memory");
            if (tid < 8 && ovf[tid] && fbCnt[tid] < fbNeed[tid]) thrI[tid] |= (1 << bit);
            asm volatile("s_waitcnt lgkmcnt(0)\n\ts_barrier" ::: "memory");
        }
    }
    IDX_LAUNDER();
#pragma unroll
    for (int m = 0; m < 2; ++m)
#pragma unroll
        for (int qq = 0; qq < 2; ++qq) { const int qid = 4 * m + 2 * hh + qq; const int B = selB[qid]; const float ts = thrS[qid]; const int ti = thrI[qid];
            unsigned myw = 0u;
#pragma unroll
            for (int it = 0; it < 16; ++it) { const int kt = wave + 8 * it;
                if (kt < NT32) { const int bin = IDX_BIN(m, it, qq); const float s = sc[m][it][qq]; const int idx = 32 * kt + r;
                    const bool sel = (bin > B) || (bin == B && (s > ts || (s == ts && idx <= ti)));
                    const unsigned long long mk = __ballot(sel);
                    const unsigned wv = hh ? (unsigned)(mk >> 32) : (unsigned)mk;
                    if (r == it) myw = wv; } }
            if (r < 16 && wave + 8 * r < NT32) bm[(tok0 + qid) * 128 + wave + 8 * r] = myw; }
#undef IDX_BIN
#undef IDX_LAUNDER
}

DI float softplusf_(float z) { return fmaxf(z, 0.f) + log1pf(expf(-fabsf(z))); }
DI void attn_tile(const LAS unsigned char* kb, const LAS unsigned char* vb, const LAS float* tab, const bf16x8 (&qr)[4], unsigned cw0, unsigned cw1, int j, int qw, int myq, int r32, int hi, float bias_far,
                  float& m_run, float& l_run, f32x16& o0, f32x16& o1, f32x16& negmb) {
    bf16x8 ka[8];
#pragma unroll
    for (int s = 0; s < 4; ++s) { const int ch = 2 * s + hi;
        ka[2 * s] = *(const LAS bf16x8*)(kb + r32 * 128 + ((ch ^ ((r32 >> 1) & 7)) << 4));
        ka[2 * s + 1] = *(const LAS bf16x8*)(kb + (32 + r32) * 128 + ((ch ^ (((32 + r32) >> 1) & 7)) << 4)); }
    f32x16 p0 = negmb, p1 = negmb;
#pragma unroll
    for (int s = 0; s < 4; ++s) { p0 = __builtin_amdgcn_mfma_f32_32x32x16_bf16(ka[2 * s], qr[s], p0, 0, 0, 0); p1 = __builtin_amdgcn_mfma_f32_32x32x16_bf16(ka[2 * s + 1], qr[s], p1, 0, 0, 0); }
    u32x4 va0[4], va1[4];
#pragma unroll
    for (int s = 0; s < 4; ++s) {
        const u32x2 a0l = *(const LAS u32x2*)(vb + (r32) * 136 + (16 * s + 4 * hi) * 2), a0h = *(const LAS u32x2*)(vb + (r32) * 136 + (16 * s + 8 + 4 * hi) * 2);
        const u32x2 a1l = *(const LAS u32x2*)(vb + (32 + r32) * 136 + (16 * s + 4 * hi) * 2), a1h = *(const LAS u32x2*)(vb + (32 + r32) * 136 + (16 * s + 8 + 4 * hi) * 2);
        va0[s] = (u32x4){a0l.x, a0l.y, a0h.x, a0h.y}; va1[s] = (u32x4){a1l.x, a1l.y, a1h.x, a1h.y}; }
    const bool far = (64 * j + 63 - qw) <= -128;
    if (!far) {
#pragma unroll
        for (int g = 0; g < 16; ++g) { const int kv0 = 64 * j + (g & 3) + 8 * (g >> 2) + 4 * hi; int r0 = kv0 - myq, r1 = r0 + 32;
            r0 = r0 < -128 ? -128 : r0; r1 = r1 < -128 ? -128 : r1;
            p0[g] += tab[r0 + 128]; p1[g] += tab[r1 + 128]; }
    }
    float mx = p0[0];
#pragma unroll
    for (int g = 1; g < 16; ++g) mx = fmaxf(mx, p0[g]);
#pragma unroll
    for (int g = 0; g < 16; ++g) mx = fmaxf(mx, p1[g]);
    mx = fmaxf(mx, __shfl_xor(mx, 32));
    if (j == 0 || __any(mx > 0.f)) {
        const float dl = (j == 0) ? mx : fmaxf(mx, 0.f);
        m_run += dl;
        const float al = __builtin_amdgcn_exp2f(-dl); l_run *= al;
#pragma unroll
        for (int g = 0; g < 16; ++g) { p0[g] -= dl; p1[g] -= dl; o0[g] *= al; o1[g] *= al; negmb[g] = bias_far - m_run; }
        asm volatile("" : "+v"(negmb));
    }
    const int sw0 = (int)(cw0 >> (4 * hi)), sw1 = (int)(cw1 >> (4 * hi));
    float ls = 0.f;
#pragma unroll
    for (int g = 0; g < 16; ++g) { const int bit = (g & 3) + 8 * (g >> 2);
        const float e0 = __builtin_amdgcn_exp2f(p0[g]), e1 = __builtin_amdgcn_exp2f(p1[g]);
        int m0_, m1_;
        asm("v_bfe_i32 %0, %1, %2, 1" : "=v"(m0_) : "v"(sw0), "n"(bit)); asm("v_bfe_i32 %0, %1, %2, 1" : "=v"(m1_) : "v"(sw1), "n"(bit));
        p0[g] = __builtin_bit_cast(float, __builtin_bit_cast(int, e0) & m0_); p1[g] = __builtin_bit_cast(float, __builtin_bit_cast(int, e1) & m1_); ls += p0[g] + p1[g]; }
    l_run += ls;
    bf16x8 pb[4];
#pragma unroll
    for (int s = 0; s < 2; ++s) {
        u32x4 w; w.x = pk2(p0[8 * s], p0[8 * s + 1]); w.y = pk2(p0[8 * s + 2], p0[8 * s + 3]); w.z = pk2(p0[8 * s + 4], p0[8 * s + 5]); w.w = pk2(p0[8 * s + 6], p0[8 * s + 7]); pb[s] = __builtin_bit_cast(bf16x8, w);
        u32x4 x; x.x = pk2(p1[8 * s], p1[8 * s + 1]); x.y = pk2(p1[8 * s + 2], p1[8 * s + 3]); x.z = pk2(p1[8 * s + 4], p1[8 * s + 5]); x.w = pk2(p1[8 * s + 6], p1[8 * s + 7]); pb[2 + s] = __builtin_bit_cast(bf16x8, x); }
#pragma unroll
    for (int s = 0; s < 4; ++s) {
        o0 = __builtin_amdgcn_mfma_f32_32x32x16_bf16(__builtin_bit_cast(bf16x8, va0[s]), pb[s], o0, 0, 0, 0);
        o1 = __builtin_amdgcn_mfma_f32_32x32x16_bf16(__builtin_bit_cast(bf16x8, va1[s]), pb[s], o1, 0, 0, 0); }
}
DI void attn_unit(Ctx& C, int b, int h, int qb) {
    const int tid = C.tid, lane = C.lane, wave = C.wave, r32 = lane & 31, hi = lane >> 5;
    const bf16_t* proj = (const bf16_t*)(C.ws + WS_PROJ);
    const unsigned* bm = (const unsigned*)(C.ws + WS_BM);
    LAS unsigned char* Kl = C.lds; LAS unsigned char* Vl = C.lds + 16384; LAS float* tab = (LAS float*)(C.lds + 33792);
    const size_t rowbase = (size_t)b * SEQ; const int q0 = qb * 256, qw = q0 + 32 * wave, myq = qw + r32;
    const int NT = 4 * qb + 4, mylast = qw >> 6;
    constexpr float LOG2E = 1.4426950408889634f;
    __syncthreads();
    if (tid < 192) { const int rel = tid - 128; const int n = rel < 0 ? -rel : rel; int bk = rel > 0 ? 16 : 0;
        if (n < 8) bk += n; else bk += 8 + (n >= 12) + (n >= 16) + (n >= 23) + (n >= 32) + (n >= 46) + (n >= 64) + (n >= 91);
        tab[tid] = (C.in(17)[bk * 8 + h] - C.in(17)[15 * 8 + h]) * LOG2E; }
    const float bias_far = C.in(17)[15 * 8 + h] * LOG2E;
    bf16x8 qr[4];
    { const bf16_t* qp = proj + (rowbase + myq) * PLD + PC_Q + h * 64 + 8 * hi;
#pragma unroll
        for (int s = 0; s < 4; ++s) { const u32x4 raw = *(const u32x4*)(qp + 16 * s); u32x4 sc_;
#pragma unroll
            for (int e = 0; e < 4; ++e) sc_[e] = pk2(bflo(raw[e]) * (0.125f * LOG2E), bfhi(raw[e]) * (0.125f * LOG2E));
            qr[s] = __builtin_bit_cast(bf16x8, sc_); } }
    const unsigned* bmrow = bm + (rowbase + myq) * 128;
    const int skv = tid >> 3, sch = tid & 7;
    const bf16_t* ksrc = proj + (rowbase + skv) * PLD + PC_K + h * 64 + 8 * sch;
    const bf16_t* vsrc = proj + (rowbase + skv) * PLD + PC_V + h * 64 + 8 * sch;
    const int kdst = skv * 128 + ((sch ^ ((skv >> 1) & 7)) << 4);
    const u32x4 m4i = *(const u32x4*)bmrow;
    u32x4 kregA = *(const u32x4*)ksrc, vregA = *(const u32x4*)vsrc; unsigned mA0 = m4i.x, mA1 = m4i.y;
    u32x4 kregB = kregA, vregB = vregA; unsigned mB0 = m4i.z, mB1 = m4i.w;
    if (NT > 1) { kregB = *(const u32x4*)(ksrc + (size_t)64 * PLD); vregB = *(const u32x4*)(vsrc + (size_t)64 * PLD); }
    const bool vodd = (skv & 1) != 0; const int vdst = ((8 * sch + (vodd ? 4 : 0)) * 68 + (skv & ~1)) * 2;
#define ATT_WRITE(buf, kreg, vreg) do { *(LAS u32x4*)(Kl + (buf) * 8192 + kdst) = kreg; LAS unsigned char* vt_ = Vl + (buf) * 8704 + vdst; \
        const unsigned r0_ = (unsigned)__builtin_amdgcn_ds_swizzle((int)(vodd ? vreg.x : vreg.z), 0x201F), r1_ = (unsigned)__builtin_amdgcn_ds_swizzle((int)(vodd ? vreg.y : vreg.w), 0x201F); \
        const unsigned lo0_ = vodd ? r0_ : vreg.x, hi0_ = vodd ? vreg.z : r0_, lo1_ = vodd ? r1_ : vreg.y, hi1_ = vodd ? vreg.w : r1_; \
        *(LAS unsigned*)(vt_ + 0 * 136) = (lo0_ & 0xffffu) | (hi0_ << 16); *(LAS unsigned*)(vt_ + 1 * 136) = (lo0_ >> 16) | (hi0_ & 0xffff0000u); \
        *(LAS unsigned*)(vt_ + 2 * 136) = (lo1_ & 0xffffu) | (hi1_ << 16); *(LAS unsigned*)(vt_ + 3 * 136) = (lo1_ >> 16) | (hi1_ & 0xffff0000u); } while (0)
    ATT_WRITE(0, kregA, vregA);
    __syncthreads();
    float m_run = 0.f, l_run = 0.f; f32x16 o0 = {}, o1 = {}, negmb;
#pragma unroll
    for (int g = 0; g < 16; ++g) negmb[g] = bias_far;
    asm volatile("" : "+v"(negmb));
#define ATT_STEP(J, CW0, CW1, KN, VN, KF, VF, MLOAD) do { const int js_ = (J); const int buf = js_ & 1; \
        if (js_ + 2 < NT) { KF = *(const u32x4*)(ksrc + (size_t)(js_ + 2) * 64 * PLD); VF = *(const u32x4*)(vsrc + (size_t)(js_ + 2) * 64 * PLD); MLOAD; } \
        if (js_ <= mylast) { attn_tile(Kl + buf * 8192, Vl + buf * 8704, tab, qr, (CW0), (CW1), js_, qw, myq, r32, hi, bias_far, m_run, l_run, o0, o1, negmb); } \
        if (js_ + 1 < NT) ATT_WRITE(buf ^ 1, KN, VN); \
        __syncthreads(); } while (0)
    {
        unsigned cA0 = mA0, cA1 = mA1;
        for (int j = 0; j < NT; j += 2) {
            u32x4 m4 = {0u, 0u, 0u, 0u};
            { const unsigned c0 = cA0, c1 = cA1; u32x4 kf = kregA, vf = vregA;
              ATT_STEP(j, c0, c1, kregB, vregB, kf, vf, m4 = *(const u32x4*)(bmrow + 2 * js_ + 4)); kregA = kf; vregA = vf; cA0 = m4.x; cA1 = m4.y; }
            if (j + 1 < NT) {
                const unsigned c0 = mB0, c1 = mB1; u32x4 kf = kregB, vf = vregB;
                ATT_STEP(j + 1, c0, c1, kregA, vregA, kf, vf, (void)0); kregB = kf; vregB = vf; mB0 = m4.z; mB1 = m4.w; }
        }
    }
#undef ATT_STEP
#undef ATT_WRITE
    const float lt = l_run + __shfl_xor(l_run, 32); const float inv = 1.f / lt;
    bf16_t* orow = C.mixcat + (rowbase + myq) * D + h * 64;
#pragma unroll
    for (int i = 0; i < 4; ++i) { const int d = 8 * i + 4 * hi;
        u32x2 w0; w0.x = pk2(o0[4 * i] * inv, o0[4 * i + 1] * inv); w0.y = pk2(o0[4 * i + 2] * inv, o0[4 * i + 3] * inv); *(u32x2*)(orow + d) = w0;
        u32x2 w1; w1.x = pk2(o1[4 * i] * inv, o1[4 * i + 1] * inv); w1.y = pk2(o1[4 * i + 2] * inv, o1[4 * i + 3] * inv); *(u32x2*)(orow + 32 + d) = w1; }
}

constexpr size_t WS_PHI = 38 * MiB, WS_PSI = 54 * MiB, WS_GT = 70 * MiB, WS_Y0T = 86 * MiB, WS_GGT = 102 * MiB, WS_RHO = 118 * MiB;
constexpr size_t WS_S0 = 1 * MiB;
constexpr size_t WS_LORA = 250 * MiB;
DI int crow(int g, int hi) { return (g & 3) + 8 * (g >> 2) + 4 * hi; }
DI f32x16 mfma32(bf16x8 a, bf16x8 b, f32x16 c) { return __builtin_amdgcn_mfma_f32_32x32x16_bf16(a, b, c, 0, 0, 0); }
struct FA { float v[16]; DI float& operator[](int i) { return v[i]; } DI const float& operator[](int i) const { return v[i]; } };
struct F8 { float v[8]; DI float& operator[](int i) { return v[i]; } DI const float& operator[](int i) const { return v[i]; } };
DI bf16x8 pack8(const F8& a) { u32x4 w; w.x = pk2(a[0], a[1]); w.y = pk2(a[2], a[3]); w.z = pk2(a[4], a[5]); w.w = pk2(a[6], a[7]); return __builtin_bit_cast(bf16x8, w); }
DI void pin(FA& a) { asm volatile("" : "+v"(a.v[0]), "+v"(a.v[1]), "+v"(a.v[2]), "+v"(a.v[3]), "+v"(a.v[4]), "+v"(a.v[5]), "+v"(a.v[6]), "+v"(a.v[7]), "+v"(a.v[8]), "+v"(a.v[9]), "+v"(a.v[10]), "+v"(a.v[11]), "+v"(a.v[12]), "+v"(a.v[13]), "+v"(a.v[14]), "+v"(a.v[15])); }
DI void pinf(bf16x8& a) { asm volatile("" : "+v"(a)); }
DI FA toFA(const f32x16& a) { FA r; _Pragma("unroll") for (int i = 0; i < 16; ++i) r.v[i] = a[i]; return r; }
DI f32x16 toV(const FA& a) { f32x16 r; _Pragma("unroll") for (int i = 0; i < 16; ++i) r[i] = a.v[i]; return r; }
DI bf16x8 packfrag(const FA& a, int s) { u32x4 w; w.x = pk2(a[8 * s], a[8 * s + 1]); w.y = pk2(a[8 * s + 2], a[8 * s + 3]); w.z = pk2(a[8 * s + 4], a[8 * s + 5]); w.w = pk2(a[8 * s + 6], a[8 * s + 7]); return __builtin_bit_cast(bf16x8, w); }
DI bf16x8 packfrag(const f32x16& a, int s) { u32x4 w; w.x = pk2(a[8 * s], a[8 * s + 1]); w.y = pk2(a[8 * s + 2], a[8 * s + 3]); w.z = pk2(a[8 * s + 4], a[8 * s + 5]); w.w = pk2(a[8 * s + 6], a[8 * s + 7]); return __builtin_bit_cast(bf16x8, w); }
DI unsigned opq(unsigned v) { asm volatile("" : "+v"(v)); return v; }
DI void st_frag(unsigned char* buf, int f, int lane, bf16x8 v) { *(bf16x8*)(buf + f * 1024 + opq(lane * 16)) = v; }
DI bf16x8 ld_frag(const unsigned char* buf, int f, int lane) { return *(const bf16x8*)(buf + f * 1024 + opq(lane * 16)); }
template <class TT> DI void st_tile_bf16(unsigned char* buf, int q, int lane, const TT& a) { const unsigned o = opq(lane * 32); *(bf16x8*)(buf + q * 2048 + o) = packfrag(a, 0); *(bf16x8*)(buf + q * 2048 + o + 16) = packfrag(a, 1); }
DI FA ld_tile_bf16(const unsigned char* buf, int q, int lane) { const unsigned o = opq(lane * 32); const u32x4 a = *(const u32x4*)(buf + q * 2048 + o), b = *(const u32x4*)(buf + q * 2048 + o + 16); FA r;
    r[0] = bflo(a.x); r[1] = bfhi(a.x); r[2] = bflo(a.y); r[3] = bfhi(a.y); r[4] = bflo(a.z); r[5] = bfhi(a.z); r[6] = bflo(a.w); r[7] = bfhi(a.w);
    r[8] = bflo(b.x); r[9] = bfhi(b.x); r[10] = bflo(b.y); r[11] = bfhi(b.y); r[12] = bflo(b.z); r[13] = bfhi(b.z); r[14] = bflo(b.w); r[15] = bfhi(b.w); return r; }
DI float fexp(float x) { return __builtin_amdgcn_exp2f(x * 1.4426950408889634f); }
DI float flog(float x) { return __builtin_amdgcn_logf(x) * 0.6931471805599453f; }
DI float ftanh(float x) { return 1.f - 2.f * __builtin_amdgcn_rcpf(1.f + fexp(2.f * x)); }
DI float fsigm(float x) { return __builtin_amdgcn_rcpf(1.f + fexp(-x)); }
DI float fsoftplus(float z) { return fmaxf(z, 0.f) + flog(1.f + fexp(-fabsf(z))); }
template <int ACT> DI bf16x8 act_frag(const bf16_t* proj, size_t row, bool first, int c0, const float* mu8) {
    const bf16_t* rp = proj + opq((unsigned)(row * PLD)); const u32x4 cu = *(const u32x4*)(rp + c0); u32x4 pv = {0u, 0u, 0u, 0u}; if (!first) pv = *(const u32x4*)(rp - PLD + c0);
    const float* mq = mu8 + opq(0u); const f32x4 m0 = *(const f32x4*)(mq), m1 = *(const f32x4*)(mq + 4);
    float x[8];
#pragma unroll
    for (int q = 0; q < 4; ++q) { const float c_lo = bflo(cu[q]), c_hi = bfhi(cu[q]), p_lo = bflo(pv[q]), p_hi = bfhi(pv[q]); const float ma = (q < 2) ? m0[2 * q] : m1[2 * q - 4], mb = (q < 2) ? m0[2 * q + 1] : m1[2 * q - 3];
        x[2 * q] = c_lo + (p_lo - c_lo) * ma; x[2 * q + 1] = c_hi + (p_hi - c_hi) * mb; }
#pragma unroll
    for (int e = 0; e < 8; ++e) { if (ACT == 1) x[e] = ftanh(x[e]); else if (ACT == 2) x[e] = fsigm(x[e]); }
    u32x4 w; w.x = pk2(x[0], x[1]); w.y = pk2(x[2], x[3]); w.z = pk2(x[4], x[5]); w.w = pk2(x[6], x[7]); return __builtin_bit_cast(bf16x8, w);
}
DI f32x4 shift4(const bf16_t* proj, size_t row, bool first, int c4, const float* mu4) {
    const bf16_t* rp = proj + opq((unsigned)(row * PLD)); const u32x2 cu = *(const u32x2*)(rp + c4); u32x2 pv = {0u, 0u}; if (!first) pv = *(const u32x2*)(rp - PLD + c4);
    const f32x4 m = *(const f32x4*)(mu4 + opq(0u)); const f32x4 c = {bflo(cu.x), bfhi(cu.x), bflo(cu.y), bfhi(cu.y)}, p = {bflo(pv.x), bfhi(pv.x), bflo(pv.y), bfhi(pv.y)};
    return c + (p - c) * m;
}
DI f32x4 shiftT4(const bf16_t* proj, size_t row, bool firstseq, int c1, float mu1) {
    const bf16_t* rp = proj + opq((unsigned)(row * PLD + c1));
    const float c0 = bf2f(rp[0]), c1_ = bf2f(rp[PLD]), c2 = bf2f(rp[2 * PLD]), c3 = bf2f(rp[3 * PLD]);
    const float pm = firstseq ? 0.f : bf2f(*(rp - PLD));
    f32x4 r; r.x = c0 + (pm - c0) * mu1; r.y = c1_ + (c0 - c1_) * mu1; r.z = c2 + (c1_ - c2) * mu1; r.w = c3 + (c2 - c3) * mu1; return r;
}
DI float scan32_incl(float x, int tl) {
#pragma unroll
    for (int d = 1; d < 32; d <<= 1) { const float y = __shfl_up(x, d, 32); if (tl >= d) x += y; }
    return x;
}

constexpr int RL_ACT = 0;
constexpr int RL_MAB = 0, RL_W1C = 17408, RL_W2C = 26624;
constexpr int RL_ELL = 35840;
constexpr int RL_AV = RL_ELL + 16640, RL_MAK = RL_ELL, RL_NRB = RL_ELL + 9216, RL_NRK = RL_ELL + 18432;
constexpr int RL_RT = 69120, RL_AT = RL_RT + 9216, RL_BT = RL_RT + 18432, RL_KT = RL_RT + 27648;
constexpr int RL_X2 = RL_AT;
constexpr int RL_BHC = 105984, RL_KHC = RL_BHC + 9216, RL_VC = RL_BHC + 18432;
constexpr int RL_X = 133632;
constexpr int RL_SM = 150272;
constexpr int RL_END = RL_SM + 512;
template <int KS> DI f32x16 mm_ll(const LAS bf16_t* a, int pa, const LAS bf16_t* b, int pb, int lane, f32x16 acc) {
    const LAS bf16_t* ap = a + (lane & 31) * pa + 8 * (lane >> 5); const LAS bf16_t* bp = b + (lane & 31) * pb + 8 * (lane >> 5);
#pragma unroll
    for (int s = 0; s < KS; ++s) acc = mfma32(*(const LAS bf16x8*)(ap + 16 * s), *(const LAS bf16x8*)(bp + 16 * s), acc);
    return acc;
}
DI void rwkv_chunk_acts(Ctx& C, int bc, int l, bf16x8 (&actv)[4]) {
    const int chunk = bc & 63, b = bc >> 6, t = C.tid >> 3, cg = C.tid & 7; const size_t row = (size_t)b * SEQ + chunk * 64 + t; const bool first = (chunk == 0 && t == 0);
    const bf16_t* proj = (const bf16_t*)(C.ws + WS_PROJ); const float* mu = C.in(6) + (size_t)l * 1792;
#pragma unroll
    for (int q = 0; q < 4; ++q) { const int c8 = cg * 32 + 8 * q;
        if (c8 < 64) actv[q] = act_frag<1>(proj, row, first, PC_WD + c8, mu + 1536 + c8); else if (c8 < 128) actv[q] = act_frag<0>(proj, row, first, PC_WD + c8, mu + 1536 + c8); else actv[q] = act_frag<2>(proj, row, first, PC_WD + c8, mu + 1536 + c8); }
}
#define LBAR() asm volatile("s_waitcnt lgkmcnt(0)\n\ts_barrier" ::: "memory")
DI void rwkv_head_item(Ctx& C, int item, int l, const bf16x8 (&actv)[4]) {
    const int h = item & 7, chunk = (item >> 3) & 63, b = item >> 9, tid = C.tid, lane = C.lane, wave = C.wave, tl = lane & 31, hi = lane >> 5;
    const size_t tok0 = (size_t)b * SEQ + chunk * 64;
    const bf16_t* proj = (const bf16_t*)(C.ws + WS_PROJ);
    const size_t chid = ((size_t)(b * 8 + h) * 64 + chunk) * 8192;
    unsigned char* PHI = C.ws + WS_PHI + chid; unsigned char* PSI = C.ws + WS_PSI + chid; unsigned char* GT = C.ws + WS_GT + chid; unsigned char* Y0T = C.ws + WS_Y0T + chid; unsigned char* GGT = C.ws + WS_GGT + chid;
    const bf16_t* WDT = (const bf16_t*)(C.ws + WS_LORA); const bf16_t* WAT = WDT + 512 * 64; const bf16_t* WGT = WAT + 512 * 64;
    const float* mu = C.in(6) + (size_t)l * 1792;
    const float* w0p = C.in(7) + l * 512 + 64 * h; const float* a0p = C.in(9) + l * 512 + 64 * h;
    const float* kkp = C.in(12) + l * 512 + 64 * h; const float* kap = C.in(13) + l * 512 + 64 * h; const float* rkp = C.in(14) + l * 512 + 64 * h;
    LAS bf16_t* ACT = (LAS bf16_t*)(C.lds + RL_ACT); LAS float* MAB = (LAS float*)(C.lds + RL_MAB); LAS bf16_t* W1C = (LAS bf16_t*)(C.lds + RL_W1C); LAS bf16_t* W2C = (LAS bf16_t*)(C.lds + RL_W2C);
    LAS float* ELL = (LAS float*)(C.lds + RL_ELL); LAS float* AV = (LAS float*)(C.lds + RL_AV);
    LAS bf16_t* MAK = (LAS bf16_t*)(C.lds + RL_MAK); LAS bf16_t* NRB = (LAS bf16_t*)(C.lds + RL_NRB); LAS bf16_t* NRK = (LAS bf16_t*)(C.lds + RL_NRK);
    LAS bf16_t* AT = (LAS bf16_t*)(C.lds + RL_AT); LAS bf16_t* RT = (LAS bf16_t*)(C.lds + RL_RT); LAS bf16_t* BT = (LAS bf16_t*)(C.lds + RL_BT); LAS bf16_t* KT = (LAS bf16_t*)(C.lds + RL_KT);
    LAS bf16_t* BHC = (LAS bf16_t*)(C.lds + RL_BHC); LAS bf16_t* KHC = (LAS bf16_t*)(C.lds + RL_KHC); LAS bf16_t* VC = (LAS bf16_t*)(C.lds + RL_VC);
    LAS float* X = (LAS float*)(C.lds + RL_X); LAS float* X2 = (LAS float*)(C.lds + RL_X2); LAS float* INV = (LAS float*)(C.lds + RL_SM); LAS float* LCv = INV + 64;
    LBAR();
#ifndef RWR12
#define RWR12 1
#define RWR4 1
#define RWR5 1
#define RWR11 1
#endif
    for (int rr_ = 0; rr_ < RWR12; ++rr_) {
    const int jp = (wave >> 1) & 1, jq = wave & 1;
    bf16x8 wfr[8];
    if (wave < 4) { const bf16_t* W = WGT + (size_t)(64 * h + 32 * jp + tl) * 128 + 8 * hi;
#pragma unroll
        for (int s = 0; s < 8; ++s) wfr[s] = *(const bf16x8*)(W + 16 * s);
    } else { const bf16_t* W0 = WDT + (size_t)(64 * h + 32 * jq + tl) * 64 + 8 * hi; const bf16_t* W1 = WAT + (size_t)(64 * h + 32 * jq + tl) * 64 + 8 * hi;
#pragma unroll
        for (int s = 0; s < 4; ++s) { wfr[s] = *(const bf16x8*)(W0 + 16 * s); wfr[4 + s] = *(const bf16x8*)(W1 + 16 * s); } }
    { const int t = tid >> 3, cg = tid & 7;
#pragma unroll
        for (int q = 0; q < 4; ++q) *(LAS bf16x8*)(ACT + t * 264 + cg * 32 + 8 * q) = actv[q]; }
    LBAR();
    if (wave < 4) {
        const LAS bf16_t* bp = ACT + (32 * jq + tl) * 264 + 128 + 8 * hi; f32x16 acc = {};
#pragma unroll
        for (int s = 0; s < 8; ++s) acc = mfma32(wfr[s], *(const LAS bf16x8*)(bp + 16 * s), acc);
        st_tile_bf16(GGT, jp * 2 + jq, lane, acc);
    } else {
        const LAS bf16_t* ap = ACT + (32 * jp + tl) * 264 + 8 * hi; f32x16 a0 = {}, a1 = {};
#pragma unroll
        for (int s = 0; s < 4; ++s) { a0 = mfma32(*(const LAS bf16x8*)(ap + 16 * s), wfr[s], a0); a1 = mfma32(*(const LAS bf16x8*)(ap + 64 + 16 * s), wfr[4 + s], a1); }
        const int ch = 32 * jq + tl; const float w0c = w0p[ch], a0c = a0p[ch];
#pragma unroll
        for (int g = 0; g < 16; ++g) { const int t = 32 * jp + crow(g, hi); ELL[t * 65 + ch] = -fexp(-fsoftplus(-(w0c + a0[g])) - 0.5f); AV[t * 65 + ch] = fsigm(a0c + a1[g]); }
    }
    LBAR();
    }
    { const int ch = tid & 63, seg = tid >> 6; float p[8]; float run = 0.f;
#pragma unroll
        for (int e = 0; e < 8; ++e) { run += ELL[(8 * seg + e) * 65 + ch]; p[e] = run; }
        X[seg * 65 + ch] = run;
        LBAR();
        float off = 0.f;
#pragma unroll
        for (int s2 = 0; s2 < 7; ++s2) off += (s2 < seg) ? X[s2 * 65 + ch] : 0.f;
#pragma unroll
        for (int e = 0; e < 8; ++e) ELL[(8 * seg + e) * 65 + ch] = off + p[e];
        if (seg == 7) LCv[ch] = off + p[7]; }
    LBAR();
    for (int rr_ = 0; rr_ < RWR4; ++rr_) {
    { const int t = tid >> 3, c0 = (tid & 7) * 8; const size_t row = tok0 + t; const bool first = (chunk == 0 && t == 0); float rho = 0.f, n2 = 0.f;
        f32x4 r4[2], k4[2], v4[2];
#pragma unroll
        for (int q = 0; q < 2; ++q) { const int c = c0 + 4 * q;
            r4[q] = shift4(proj, row, first, PC_R + 64 * h + c, mu + 64 * h + c); k4[q] = shift4(proj, row, first, PC_BK + 64 * h + c, mu + 512 + 64 * h + c); v4[q] = shift4(proj, row, first, PC_BV + 64 * h + c, mu + 1024 + 64 * h + c);
            const f32x4 kr = k4[q] * *(const f32x4*)(kkp + c); n2 += (kr.x * kr.x + kr.y * kr.y) + (kr.z * kr.z + kr.w * kr.w); }
        n2 += __shfl_xor(n2, 1); n2 += __shfl_xor(n2, 2); n2 += __shfl_xor(n2, 4);
        const float inv = 1.f / fmaxf(sqrtf(n2), 1e-12f);
        F8 vA, vR, vB, vK;
#pragma unroll
        for (int q = 0; q < 2; ++q) { const int c = c0 + 4 * q;
            const f32x4 kk4 = *(const f32x4*)(kkp + c), ka4 = *(const f32x4*)(kap + c), rk4 = *(const f32x4*)(rkp + c);
#pragma unroll
            for (int jj = 0; jj < 4; ++jj) { const int ch = c + jj; const float a = AV[t * 65 + ch], L = ELL[t * 65 + ch], Lp = t ? ELL[(t - 1) * 65 + ch] : 0.f, LC = LCv[ch];
                const float kk = k4[q][jj] * kk4[jj] * inv, kp = k4[q][jj] * (1.f + (a - 1.f) * ka4[jj]), bb = kk * a;
                const float eL = fexp(L), eN = fexp(-L), eP = fexp(Lp), eD = fexp(LC - L);
                rho += r4[q][jj] * kp * rk4[jj];
                const float xa = -kk * eP; vA[4 * q + jj] = xa; vR[4 * q + jj] = r4[q][jj] * eL; vB[4 * q + jj] = bb * eN; vK[4 * q + jj] = kp * eN;
                X[t * 65 + ch] = xa; BHC[ch * 72 + t] = (bf16_t)f2bf(bb * eD); KHC[ch * 72 + t] = (bf16_t)f2bf(kp * eD); VC[ch * 72 + t] = (bf16_t)f2bf(v4[q][jj]); } }
        *(LAS bf16x8*)(AT + t * 72 + c0) = pack8(vA); *(LAS bf16x8*)(RT + t * 72 + c0) = pack8(vR); *(LAS bf16x8*)(BT + t * 72 + c0) = pack8(vB); *(LAS bf16x8*)(KT + t * 72 + c0) = pack8(vK);
        rho += __shfl_xor(rho, 1); rho += __shfl_xor(rho, 2); rho += __shfl_xor(rho, 4);
        if ((tid & 7) == 0) ((float*)(C.ws + WS_RHO))[row * 8 + h] = rho; }
    LBAR();
    }
    for (int rr_ = 0; rr_ < RWR5; ++rr_) {
    for (int job = wave; job < 16; job += 8) {
        const int kind = job >> 2, ti = (job >> 1) & 1, tj = job & 1;
        const LAS bf16_t* a = (kind < 2 ? AT : RT) + 32 * ti * 72; const LAS bf16_t* bm = ((kind & 1) ? KT : BT) + 32 * tj * 72;
        f32x16 acc = {};
        if (!(ti == 0 && tj == 1)) acc = mm_ll<4>(a, 72, bm, 72, lane, acc);
#pragma unroll
        for (int g = 0; g < 16; ++g) { const int i = 32 * ti + crow(g, hi), j = 32 * tj + tl; const bool keep = (kind < 2) ? (j < i) : (j <= i); const float v = keep ? acc[g] : 0.f;
            if (kind == 0) MAB[i * 68 + j] = v; else (kind == 1 ? MAK : kind == 2 ? NRB : NRK)[i * 72 + j] = (bf16_t)f2bf(v); }
    }
    LBAR();
    }
    if (wave < 4) { const int ti = wave >> 1, tv = wave & 1; f32x16 acc = {}; acc = mm_ll<4>(MAK + 32 * ti * 72, 72, VC + 32 * tv * 72, 72, lane, acc);
#pragma unroll
        for (int g = 0; g < 16; ++g) X2[(32 * ti + crow(g, hi)) * 65 + 32 * tv + tl] = acc[g]; }
    LBAR();
    for (int bk = 0; bk < 4; ++bk) {
        const int r0 = 16 * bk;
        if (wave < 2) {
            LAS float* XX = wave ? X2 : X; float x[16];
#pragma unroll
            for (int i = 0; i < 16; ++i) x[i] = XX[(r0 + i) * 65 + lane];
#pragma unroll
            for (int i = 1; i < 16; ++i) { const LAS float* mr = MAB + (r0 + i) * 68 + r0; float a_ = x[i];
#pragma unroll
                for (int q = 0; q < (i + 3) / 4; ++q) { const f32x4 m4 = *(const LAS f32x4*)(mr + 4 * q);
#pragma unroll
                    for (int e = 0; e < 4; ++e) if (4 * q + e < i) a_ += m4[e] * x[4 * q + e]; }
                x[i] = a_; }
#pragma unroll
            for (int i = 1; i < 16; ++i) XX[(r0 + i) * 65 + lane] = x[i];
        }
        LBAR();
        if (bk < 3) {
            const int mat = wave >> 2, rt = (wave >> 1) & 1, ctl = wave & 1;
            if (32 * rt + 31 >= r0 + 16) {
                LAS float* XX = mat ? X2 : X;
                F8 av8, bv8;
#pragma unroll
                for (int e = 0; e < 8; ++e) { av8[e] = MAB[(32 * rt + tl) * 68 + r0 + 8 * hi + e]; bv8[e] = XX[(r0 + 8 * hi + e) * 65 + 32 * ctl + tl]; }
                f32x16 acc;
#pragma unroll
                for (int g = 0; g < 16; ++g) acc[g] = XX[(32 * rt + crow(g, hi)) * 65 + 32 * ctl + tl];
                acc = mfma32(pack8(av8), pack8(bv8), acc);
#pragma unroll
                for (int g = 0; g < 16; ++g) { const int i = 32 * rt + crow(g, hi); if (i >= r0 + 16) XX[i * 65 + 32 * ctl + tl] = acc[g]; }
            }
            LBAR();
        }
    }
    { const int k = tid >> 3, i0 = (tid & 7) * 8; F8 v, w;
#pragma unroll
        for (int e = 0; e < 8; ++e) { v[e] = X[(i0 + e) * 65 + k]; w[e] = X2[(i0 + e) * 65 + k]; }
        *(LAS bf16x8*)(W1C + k * 72 + i0) = pack8(v); *(LAS bf16x8*)(W2C + k * 72 + i0) = pack8(w); }
    LBAR();
    for (int rr_ = 0; rr_ < RWR11; ++rr_) {
    for (int job = wave; job < 16; job += 8) {
        const int kind = job >> 2, p = (job >> 1) & 1, q = job & 1; f32x16 acc = {};
        if (kind == 0) {
            acc = mm_ll<4>(W1C + 32 * p * 72, 72, NRB + 32 * q * 72, 72, lane, acc);
            FA fa;
#pragma unroll
            for (int g = 0; g < 16; ++g) fa[g] = acc[g] + bf2f(RT[(32 * q + tl) * 72 + 32 * p + crow(g, hi)]);
            st_frag(GT, (p * 2 + q) * 2 + 0, lane, packfrag(fa, 0)); st_frag(GT, (p * 2 + q) * 2 + 1, lane, packfrag(fa, 1));
        } else if (kind == 1) {
            acc = mm_ll<4>(W2C + 32 * p * 72, 72, NRB + 32 * q * 72, 72, lane, acc); acc = mm_ll<4>(VC + 32 * p * 72, 72, NRK + 32 * q * 72, 72, lane, acc);
            st_tile_bf16(Y0T, p * 2 + q, lane, acc);
        } else if (kind == 2) {
            acc = mm_ll<4>(W1C + 32 * p * 72, 72, BHC + 32 * q * 72, 72, lane, acc);
            FA fa = toFA(acc);
            if (p == q) { const float pc = fexp(LCv[32 * q + tl]);
#pragma unroll
                for (int g = 0; g < 16; ++g) if (crow(g, hi) == tl) fa[g] += pc; }
            st_frag(PHI, (p * 2 + q) * 2 + 0, lane, packfrag(fa, 0)); st_frag(PHI, (p * 2 + q) * 2 + 1, lane, packfrag(fa, 1));
        } else {
            acc = mm_ll<4>(BHC + 32 * p * 72, 72, W2C + 32 * q * 72, 72, lane, acc); acc = mm_ll<4>(KHC + 32 * p * 72, 72, VC + 32 * q * 72, 72, lane, acc);
            st_tile_bf16(PSI, p * 2 + q, lane, acc);
        }
    }
    LBAR();
    }
}

#undef LBAR
DI void rwkv_scan_wave(Ctx& C, int id) {
    const int vt = id & 1, bh = id >> 1, lane = C.lane;
    f32x16 S[2] = {{}, {}};
    for (int chunk = 0; chunk < 64; ++chunk) {
        const size_t chid = ((size_t)bh * 64 + chunk) * 8192;
        const unsigned char* PHI = C.ws + WS_PHI + chid; const unsigned char* PSI = C.ws + WS_PSI + chid; unsigned char* S0B = C.ws + WS_S0 + chid;
        bf16x8 sh[2][2], sl[2][2];
        f32x16 N[2];
#pragma unroll
        for (int ct = 0; ct < 2; ++ct) N[ct] = toV(ld_tile_bf16(PSI, ct * 2 + vt, lane));
        asm volatile("" ::: "memory");
#pragma unroll
        for (int cp = 0; cp < 2; ++cp)
#pragma unroll
            for (int s = 0; s < 2; ++s) { sh[cp][s] = packfrag(S[cp], s); st_frag(S0B, (cp * 2 + vt) * 2 + s, lane, sh[cp][s]);
                const u32x4 hw = __builtin_bit_cast(u32x4, sh[cp][s]); u32x4 lw;
#pragma unroll
                for (int q = 0; q < 4; ++q) lw[q] = pk2(S[cp][8 * s + 2 * q] - bflo(hw[q]), S[cp][8 * s + 2 * q + 1] - bfhi(hw[q]));
                sl[cp][s] = __builtin_bit_cast(bf16x8, lw); }
#pragma unroll
        for (int ct = 0; ct < 2; ++ct) {
#pragma unroll
            for (int cp = 0; cp < 2; ++cp)
#pragma unroll
                for (int s = 0; s < 2; ++s) { const bf16x8 ph = ld_frag(PHI, (cp * 2 + ct) * 2 + s, lane); N[ct] = mfma32(ph, sh[cp][s], N[ct]); N[ct] = mfma32(ph, sl[cp][s], N[ct]); } }
        S[0] = N[0]; S[1] = N[1];
    }
}

DI void rwkv_out_wave(Ctx& C, int id, int l) {
    const int chunk = id & 63, bh = id >> 6, b = bh >> 3, h = bh & 7, lane = C.lane, tl = lane & 31, hi = lane >> 5;
    const size_t chid = (size_t)id * 8192; const size_t tok0 = (size_t)b * SEQ + chunk * 64;
    const unsigned char* GT = C.ws + WS_GT + chid; const unsigned char* Y0T = C.ws + WS_Y0T + chid; const unsigned char* GGT = C.ws + WS_GGT + chid; const unsigned char* S0B = C.ws + WS_S0 + chid;
    const bf16_t* proj = (const bf16_t*)(C.ws + WS_PROJ);
    const float* mu = C.in(6) + (size_t)l * 1792; const float* gng = C.in(15) + l * 512 + 64 * h; const float* gnb = C.in(16) + l * 512 + 64 * h;
    const float* RHO = (const float*)(C.ws + WS_RHO);
    FA Y[2][2];
#pragma unroll
    for (int vt = 0; vt < 2; ++vt)
#pragma unroll
        for (int tt = 0; tt < 2; ++tt) { f32x16 acc = toV(ld_tile_bf16(Y0T, vt * 2 + tt, lane));
#pragma unroll
            for (int cp = 0; cp < 2; ++cp)
#pragma unroll
                for (int s = 0; s < 2; ++s) acc = mfma32(ld_frag(S0B, (cp * 2 + vt) * 2 + s, lane), ld_frag(GT, (cp * 2 + tt) * 2 + s, lane), acc);
            Y[vt][tt] = toFA(acc); }
#pragma unroll
    for (int tt = 0; tt < 2; ++tt) {
        float s1 = 0.f;
#pragma unroll
        for (int vt = 0; vt < 2; ++vt)
#pragma unroll
            for (int g = 0; g < 16; ++g) s1 += Y[vt][tt][g];
        s1 += __shfl_xor(s1, 32); const float mean = s1 * (1.f / 64.f);
        float s2 = 0.f;
#pragma unroll
        for (int vt = 0; vt < 2; ++vt)
#pragma unroll
            for (int g = 0; g < 16; ++g) { const float d = Y[vt][tt][g] - mean; s2 += d * d; }
        s2 += __shfl_xor(s2, 32); const float rstd = 1.f / sqrtf(s2 * (1.f / 64.f) + GN_EPS);
        const size_t row = tok0 + 32 * tt + tl; const bool first = (chunk == 0 && tt == 0 && tl == 0);
        const float rho = RHO[row * 8 + h];
#pragma unroll
        for (int vt = 0; vt < 2; ++vt) { const FA gt = ld_tile_bf16(GGT, vt * 2 + tt, lane);
#pragma unroll
            for (int i = 0; i < 4; ++i) { const int c = 32 * vt + 8 * i + 4 * hi;
                const f32x4 v4 = shift4(proj, row, first, PC_BV + 64 * h + c, mu + 1024 + 64 * h + c); const f32x4 gg = *(const f32x4*)(gng + c), gb = *(const f32x4*)(gnb + c);
                float o[4];
#pragma unroll
                for (int jj = 0; jj < 4; ++jj) { const int g = 4 * i + jj; o[jj] = ((Y[vt][tt][g] - mean) * rstd * gg[jj] + gb[jj] + rho * v4[jj]) * gt[g]; }
                u32x2 w; w.x = pk2(o[0], o[1]); w.y = pk2(o[2], o[3]); *(u32x2*)(C.mixcat + row * D + 512 + 64 * h + c) = w; } }
    }
}

constexpr int GB_OFF = 163840 - 256;
DI void gbar(LAS unsigned* cnt, unsigned& target, int lane) {
    asm volatile("s_waitcnt lgkmcnt(0)" ::: "memory");
    target += 4u;
    if (lane == 0) __hip_atomic_fetch_add(cnt, 1u, __ATOMIC_RELAXED, __HIP_MEMORY_SCOPE_WORKGROUP);
    while (__hip_atomic_load(cnt, __ATOMIC_RELAXED, __HIP_MEMORY_SCOPE_WORKGROUP) < target) __builtin_amdgcn_s_sleep(1);
    asm volatile("" ::: "memory");
}
DI void rwkv_chunk_acts4(Ctx& C, int bc, int l, bf16x8 (&actv)[8]) {
    const int chunk = bc & 63, b = bc >> 6, t = C.tid >> 2, cg = C.tid & 3; const size_t row = (size_t)b * SEQ + chunk * 64 + t; const bool first = (chunk == 0 && t == 0);
    const bf16_t* proj = (const bf16_t*)(C.ws + WS_PROJ); const float* mu = C.in(6) + (size_t)l * 1792;
#pragma unroll
    for (int q = 0; q < 8; ++q) { const int c8 = cg * 64 + 8 * q;
        if (c8 < 64) actv[q] = act_frag<1>(proj, row, first, PC_WD + c8, mu + 1536 + c8); else if (c8 < 128) actv[q] = act_frag<0>(proj, row, first, PC_WD + c8, mu + 1536 + c8); else actv[q] = act_frag<2>(proj, row, first, PC_WD + c8, mu + 1536 + c8); }
}
#ifndef RW4_12
#define RW4_12 1
#endif
#ifndef RW4_4
#define RW4_4 1
#endif
#ifndef RW4_5
#define RW4_5 1
#endif
#ifndef RW4_11
#define RW4_11 1
#endif
#define GBA() gbar(gcnt, gtarget, lane)
DI void rwkv_head_item4(Ctx& C, int item, int l, const bf16x8 (&actv)[8], LAS unsigned* gcnt, unsigned& gtarget) {
    const int h = item & 7, chunk = (item >> 3) & 63, b = item >> 9, tid = C.tid, lane = C.lane, wave = C.wave, tl = lane & 31, hi = lane >> 5;
    const size_t tok0 = (size_t)b * SEQ + chunk * 64;
    const bf16_t* proj = (const bf16_t*)(C.ws + WS_PROJ);
    const size_t chid = ((size_t)(b * 8 + h) * 64 + chunk) * 8192;
    unsigned char* PHI = C.ws + WS_PHI + chid; unsigned char* PSI = C.ws + WS_PSI + chid; unsigned char* GT = C.ws + WS_GT + chid; unsigned char* Y0T = C.ws + WS_Y0T + chid; unsigned char* GGT = C.ws + WS_GGT + chid;
    const bf16_t* WDT = (const bf16_t*)(C.ws + WS_LORA); const bf16_t* WAT = WDT + 512 * 64; const bf16_t* WGT = WAT + 512 * 64;
    const float* mu = C.in(6) + (size_t)l * 1792;
    const float* w0p = C.in(7) + l * 512 + 64 * h; const float* a0p = C.in(9) + l * 512 + 64 * h;
    const float* kkp = C.in(12) + l * 512 + 64 * h; const float* kap = C.in(13) + l * 512 + 64 * h; const float* rkp = C.in(14) + l * 512 + 64 * h;
    LAS bf16_t* ACT = (LAS bf16_t*)(C.lds + RL_ACT); LAS float* MAB = (LAS float*)(C.lds + RL_MAB); LAS bf16_t* W1C = (LAS bf16_t*)(C.lds + RL_W1C); LAS bf16_t* W2C = (LAS bf16_t*)(C.lds + RL_W2C);
    LAS float* ELL = (LAS float*)(C.lds + RL_ELL); LAS float* AV = (LAS float*)(C.lds + RL_AV);
    LAS bf16_t* MAK = (LAS bf16_t*)(C.lds + RL_MAK); LAS bf16_t* NRB = (LAS bf16_t*)(C.lds + RL_NRB); LAS bf16_t* NRK = (LAS bf16_t*)(C.lds + RL_NRK);
    LAS bf16_t* AT = (LAS bf16_t*)(C.lds + RL_AT); LAS bf16_t* RT = (LAS bf16_t*)(C.lds + RL_RT); LAS bf16_t* BT = (LAS bf16_t*)(C.lds + RL_BT); LAS bf16_t* KT = (LAS bf16_t*)(C.lds + RL_KT);
    LAS bf16_t* BHC = (LAS bf16_t*)(C.lds + RL_BHC); LAS bf16_t* KHC = (LAS bf16_t*)(C.lds + RL_KHC); LAS bf16_t* VC = (LAS bf16_t*)(C.lds + RL_VC);
    LAS float* X = (LAS float*)(C.lds + RL_X); LAS float* X2 = (LAS float*)(C.lds + RL_X2); LAS float* LCv = (LAS float*)(C.lds + RL_SM) + 64;
    GBA();
    for (int r_RW4_12 = 0; r_RW4_12 < RW4_12; ++r_RW4_12) { asm volatile("" ::: "memory");
    const int jp = (wave >> 1) & 1, jq = wave & 1;
    bf16x8 wg[8], wd[8];
    { const bf16_t* W = WGT + (size_t)(64 * h + 32 * jp + tl) * 128 + 8 * hi; const bf16_t* W0 = WDT + (size_t)(64 * h + 32 * jq + tl) * 64 + 8 * hi; const bf16_t* W1 = WAT + (size_t)(64 * h + 32 * jq + tl) * 64 + 8 * hi;
#pragma unroll
        for (int s = 0; s < 8; ++s) wg[s] = *(const bf16x8*)(W + 16 * s);
#pragma unroll
        for (int s = 0; s < 4; ++s) { wd[s] = *(const bf16x8*)(W0 + 16 * s); wd[4 + s] = *(const bf16x8*)(W1 + 16 * s); } }
    { const int t = tid >> 2, cg = tid & 3;
#pragma unroll
        for (int q = 0; q < 8; ++q) *(LAS bf16x8*)(ACT + t * 264 + cg * 64 + 8 * q) = actv[q]; }
    GBA();
    {
        const LAS bf16_t* bp = ACT + (32 * jq + tl) * 264 + 128 + 8 * hi; f32x16 acc = {};
#pragma unroll
        for (int s = 0; s < 8; ++s) acc = mfma32(wg[s], *(const LAS bf16x8*)(bp + 16 * s), acc);
        st_tile_bf16(GGT, jp * 2 + jq, lane, acc);
        const LAS bf16_t* ap = ACT + (32 * jp + tl) * 264 + 8 * hi; f32x16 a0 = {}, a1 = {};
#pragma unroll
        for (int s = 0; s < 4; ++s) { a0 = mfma32(*(const LAS bf16x8*)(ap + 16 * s), wd[s], a0); a1 = mfma32(*(const LAS bf16x8*)(ap + 64 + 16 * s), wd[4 + s], a1); }
        const int ch = 32 * jq + tl; const float w0c = w0p[ch], a0c = a0p[ch];
#pragma unroll
        for (int g = 0; g < 16; ++g) { const int t = 32 * jp + crow(g, hi); ELL[t * 65 + ch] = -fexp(-fsoftplus(-(w0c + a0[g])) - 0.5f); AV[t * 65 + ch] = fsigm(a0c + a1[g]); }
    }
    GBA();
    }
    { const int ch = tid & 63, seg = tid >> 6; float p[16]; float run = 0.f;
#pragma unroll
        for (int e = 0; e < 16; ++e) { run += ELL[(16 * seg + e) * 65 + ch]; p[e] = run; }
        X[seg * 65 + ch] = run;
        GBA();
        float off = 0.f;
#pragma unroll
        for (int s2 = 0; s2 < 3; ++s2) off += (s2 < seg) ? X[s2 * 65 + ch] : 0.f;
#pragma unroll
        for (int e = 0; e < 16; ++e) ELL[(16 * seg + e) * 65 + ch] = off + p[e];
        if (seg == 3) LCv[ch] = off + p[15]; }
    GBA();
    for (int r_RW4_4 = 0; r_RW4_4 < RW4_4; ++r_RW4_4) { asm volatile("" ::: "memory");
#pragma unroll 1
    for (int pass = 0; pass < 2; ++pass) { const int e_ = tid + 256 * pass; const int t = e_ >> 3, c0 = (e_ & 7) * 8; const size_t row = tok0 + t; const bool first = (chunk == 0 && t == 0); float rho = 0.f, n2 = 0.f;
        f32x4 r4[2], k4[2], v4[2];
#pragma unroll
        for (int q = 0; q < 2; ++q) { const int c = c0 + 4 * q;
            r4[q] = shift4(proj, row, first, PC_R + 64 * h + c, mu + 64 * h + c); k4[q] = shift4(proj, row, first, PC_BK + 64 * h + c, mu + 512 + 64 * h + c); v4[q] = shift4(proj, row, first, PC_BV + 64 * h + c, mu + 1024 + 64 * h + c);
            const f32x4 kr = k4[q] * *(const f32x4*)(kkp + c); n2 += (kr.x * kr.x + kr.y * kr.y) + (kr.z * kr.z + kr.w * kr.w); }
        n2 += __shfl_xor(n2, 1); n2 += __shfl_xor(n2, 2); n2 += __shfl_xor(n2, 4);
        const float inv = 1.f / fmaxf(sqrtf(n2), 1e-12f);
        F8 vA, vR, vB, vK;
#pragma unroll
        for (int q = 0; q < 2; ++q) { const int c = c0 + 4 * q;
            const f32x4 kk4 = *(const f32x4*)(kkp + c), ka4 = *(const f32x4*)(kap + c), rk4 = *(const f32x4*)(rkp + c);
#pragma unroll
            for (int jj = 0; jj < 4; ++jj) { const int ch = c + jj; const float a = AV[t * 65 + ch], L = ELL[t * 65 + ch], Lp = t ? ELL[(t - 1) * 65 + ch] : 0.f, LC = LCv[ch];
                const float kk = k4[q][jj] * kk4[jj] * inv, kp = k4[q][jj] * (1.f + (a - 1.f) * ka4[jj]), bb = kk * a;
                const float eL = fexp(L), eN = fexp(-L), eP = fexp(Lp), eD = fexp(LC - L);
                rho += r4[q][jj] * kp * rk4[jj];
                const float xa = -kk * eP; vA[4 * q + jj] = xa; vR[4 * q + jj] = r4[q][jj] * eL; vB[4 * q + jj] = bb * eN; vK[4 * q + jj] = kp * eN;
                X[t * 65 + ch] = xa; BHC[ch * 72 + t] = (bf16_t)f2bf(bb * eD); KHC[ch * 72 + t] = (bf16_t)f2bf(kp * eD); VC[ch * 72 + t] = (bf16_t)f2bf(v4[q][jj]); } }
        *(LAS bf16x8*)(AT + t * 72 + c0) = pack8(vA); *(LAS bf16x8*)(RT + t * 72 + c0) = pack8(vR); *(LAS bf16x8*)(BT + t * 72 + c0) = pack8(vB); *(LAS bf16x8*)(KT + t * 72 + c0) = pack8(vK);
        rho += __shfl_xor(rho, 1); rho += __shfl_xor(rho, 2); rho += __shfl_xor(rho, 4);
        if ((tid & 7) == 0) ((float*)(C.ws + WS_RHO))[row * 8 + h] = rho; }
    GBA();
    }
    for (int r_RW4_5 = 0; r_RW4_5 < RW4_5; ++r_RW4_5) { asm volatile("" ::: "memory");
    for (int job = wave; job < 16; job += 4) {
        const int kind = job >> 2, ti = (job >> 1) & 1, tj = job & 1;
        const LAS bf16_t* a = (kind < 2 ? AT : RT) + 32 * ti * 72; const LAS bf16_t* bm = ((kind & 1) ? KT : BT) + 32 * tj * 72;
        f32x16 acc = {};
        if (!(ti == 0 && tj == 1)) acc = mm_ll<4>(a, 72, bm, 72, lane, acc);
#pragma unroll
        for (int g = 0; g < 16; ++g) { const int i = 32 * ti + crow(g, hi), j = 32 * tj + tl; const bool keep = (kind < 2) ? (j < i) : (j <= i); const float v = keep ? acc[g] : 0.f;
            if (kind == 0) MAB[i * 68 + j] = v; else (kind == 1 ? MAK : kind == 2 ? NRB : NRK)[i * 72 + j] = (bf16_t)f2bf(v); }
    }
    GBA();
    }
    { const int ti = wave >> 1, tv = wave & 1; f32x16 acc = {}; acc = mm_ll<4>(MAK + 32 * ti * 72, 72, VC + 32 * tv * 72, 72, lane, acc);
#pragma unroll
        for (int g = 0; g < 16; ++g) X2[(32 * ti + crow(g, hi)) * 65 + 32 * tv + tl] = acc[g]; }
    GBA();
    for (int bk = 0; bk < 4; ++bk) {
        const int r0 = 16 * bk;
        if (wave < 2) {
            LAS float* XX = wave ? X2 : X; float x[16];
#pragma unroll
            for (int i = 0; i < 16; ++i) x[i] = XX[(r0 + i) * 65 + lane];
#pragma unroll
            for (int i = 1; i < 16; ++i) { const LAS float* mr = MAB + (r0 + i) * 68 + r0; float a_ = x[i];
#pragma unroll
                for (int q = 0; q < (i + 3) / 4; ++q) { const f32x4 m4 = *(const LAS f32x4*)(mr + 4 * q);
#pragma unroll
                    for (int e = 0; e < 4; ++e) if (4 * q + e < i) a_ += m4[e] * x[4 * q + e]; }
                x[i] = a_; }
#pragma unroll
            for (int i = 1; i < 16; ++i) XX[(r0 + i) * 65 + lane] = x[i];
        }
        GBA();
        if (bk < 3) {
            for (int tq = wave; tq < 8; tq += 4) { const int mat = tq >> 2, rt = (tq >> 1) & 1, ctl = tq & 1;
                if (32 * rt + 31 >= r0 + 16) {
                    LAS float* XX = mat ? X2 : X;
                    F8 av8, bv8;
#pragma unroll
                    for (int e = 0; e < 8; ++e) { av8[e] = MAB[(32 * rt + tl) * 68 + r0 + 8 * hi + e]; bv8[e] = XX[(r0 + 8 * hi + e) * 65 + 32 * ctl + tl]; }
                    f32x16 acc;
#pragma unroll
                    for (int g = 0; g < 16; ++g) acc[g] = XX[(32 * rt + crow(g, hi)) * 65 + 32 * ctl + tl];
                    acc = mfma32(pack8(av8), pack8(bv8), acc);
#pragma unroll
                    for (int g = 0; g < 16; ++g) { const int i = 32 * rt + crow(g, hi); if (i >= r0 + 16) XX[i * 65 + 32 * ctl + tl] = acc[g]; }
                } }
            GBA();
        }
    }
#pragma unroll 1
    for (int pass = 0; pass < 2; ++pass) { const int e_ = tid + 256 * pass; const int k = e_ >> 3, i0 = (e_ & 7) * 8; F8 v, w;
#pragma unroll
        for (int e = 0; e < 8; ++e) { v[e] = X[(i0 + e) * 65 + k]; w[e] = X2[(i0 + e) * 65 + k]; }
        *(LAS bf16x8*)(W1C + k * 72 + i0) = pack8(v); *(LAS bf16x8*)(W2C + k * 72 + i0) = pack8(w); }
    GBA();
    for (int r_11 = 0; r_11 < RW4_11; ++r_11) { asm volatile("" ::: "memory");
    for (int job = wave; job < 16; job += 4) {
        const int kind = job >> 2, p = (job >> 1) & 1, q = job & 1; f32x16 acc = {};
        if (kind == 0) {
            acc = mm_ll<4>(W1C + 32 * p * 72, 72, NRB + 32 * q * 72, 72, lane, acc);
            FA fa;
#pragma unroll
            for (int g = 0; g < 16; ++g) fa[g] = acc[g] + bf2f(RT[(32 * q + tl) * 72 + 32 * p + crow(g, hi)]);
            st_frag(GT, (p * 2 + q) * 2 + 0, lane, packfrag(fa, 0)); st_frag(GT, (p * 2 + q) * 2 + 1, lane, packfrag(fa, 1));
        } else if (kind == 1) {
            acc = mm_ll<4>(W2C + 32 * p * 72, 72, NRB + 32 * q * 72, 72, lane, acc); acc = mm_ll<4>(VC + 32 * p * 72, 72, NRK + 32 * q * 72, 72, lane, acc);
            st_tile_bf16(Y0T, p * 2 + q, lane, acc);
        } else if (kind == 2) {
            acc = mm_ll<4>(W1C + 32 * p * 72, 72, BHC + 32 * q * 72, 72, lane, acc);
            FA fa = toFA(acc);
            if (p == q) { const float pc = fexp(LCv[32 * q + tl]);
#pragma unroll
                for (int g = 0; g < 16; ++g) if (crow(g, hi) == tl) fa[g] += pc; }
            st_frag(PHI, (p * 2 + q) * 2 + 0, lane, packfrag(fa, 0)); st_frag(PHI, (p * 2 + q) * 2 + 1, lane, packfrag(fa, 1));
        } else {
            acc = mm_ll<4>(BHC + 32 * p * 72, 72, W2C + 32 * q * 72, 72, lane, acc); acc = mm_ll<4>(KHC + 32 * p * 72, 72, VC + 32 * q * 72, 72, lane, acc);
            st_tile_bf16(PSI, p * 2 + q, lane, acc);
        }
    }
    }
}
#undef GBA

typedef float f32x2 __attribute__((ext_vector_type(2)));
constexpr int IX4 = RL_END, IX4_CAP = 256;
#ifndef IX_PF
#define IX_PF 2
#endif
#ifndef IXR_SEL
#define IXR_SEL 1
#endif
#define GBB() gbar(gcnt, gtarget, lane)
DI void ld_ktile(const _Float16* kbase, int kt, int ktmax, f16x8 (&d)[4]) {
    const _Float16* p = kbase + (size_t)(32 * min(kt, ktmax)) * PLD;
#pragma unroll
    for (int s = 0; s < 4; ++s) d[s] = *(const f16x8*)(p + 16 * s);
}
DI void idx_item4(Ctx& C, int item, int l, const int ixb, LAS unsigned* gcnt, unsigned& gtarget) {
    const int b = item & 3, qt = 1023 - (item >> 2);
    const int t0 = qt * 4, chunk = t0 >> 6, NT32 = 2 * (chunk + 1);
    const size_t tok0 = (size_t)b * SEQ + t0;
    unsigned* bm = (unsigned*)(C.ws + WS_BM);
    int lane = C.lane, wave = C.wave & 3, tid = C.tid & 255;
    asm volatile("" : "+v"(lane), "+v"(tid), "+s"(wave));
    if (chunk < 4) {
        if (tid < 4 * NT32) { const int q = tid / NT32, kt = tid % NT32; bm[(tok0 + q) * 128 + kt] = 0xffffffffu; }
        return;
    }
    const _Float16* ph = (const _Float16*)(C.ws + WS_PROJ);
    LAS unsigned* hist = (LAS unsigned*)(C.lds + ixb);
    LAS float* cand = (LAS float*)(C.lds + ixb + 4096);
    LAS float* redmn = (LAS float*)(C.lds + ixb + 4096 + 8 * IX4_CAP * 4);
    LAS float* redmx = redmn + 16;
    LAS unsigned* ccount = (LAS unsigned*)(redmx + 16);
    LAS float* thrS = (LAS float*)(ccount + 4);
    LAS int* thrI = (LAS int*)(thrS + 4);
    LAS unsigned* ovf = (LAS unsigned*)(thrI + 4);
    LAS unsigned* fbT = ovf + 4;
    LAS unsigned* fbCnt = fbT + 4;
    LAS unsigned* fbNeed = fbCnt + 4;
    const int r = lane & 31, hh = lane >> 5;
    float sc[32][2];
    {
        f16x8 afr[4]; float wq[2][8];
        {
            const int gq = (r >> 2) & 1, i = r >> 3, jj = r & 3, query = 2 * gq + (i >> 1), head = 4 * (i & 1) + jj;
            const _Float16* qp = ph + (tok0 + query) * PLD + PC_QI + head * 64 + 8 * hh;
#pragma unroll
            for (int s = 0; s < 4; ++s) afr[s] = *(const f16x8*)(qp + 16 * s);
#pragma unroll
            for (int qq = 0; qq < 2; ++qq) { const int q2 = 2 * hh + qq; const f16x8 wv = *(const f16x8*)(ph + (tok0 + q2) * PLD + PC_WI);
#pragma unroll
                for (int e = 0; e < 8; ++e) wq[qq][e] = (float)wv[e] * 0.044194173824159216f; }
        }
        const _Float16* kbase = ph + ((size_t)b * SEQ + r) * PLD + PC_KI + 8 * hh;
        f16x8 bq[IX_PF][4];
#pragma unroll
        for (int d = 0; d < IX_PF - 1; ++d) ld_ktile(kbase, wave + 4 * d, NT32 - 1, bq[d]);
#pragma unroll
        for (int it = 0; it < 32; ++it) {
            const int kt = wave + 4 * it;
            if (kt < NT32) {
                if (kt + 4 * (IX_PF - 1) < NT32) ld_ktile(kbase, kt + 4 * (IX_PF - 1), NT32 - 1, bq[(it + IX_PF - 1) % IX_PF]);
                f32x16 c = {};
#pragma unroll
                for (int s = 0; s < 4; ++s) c = __builtin_amdgcn_mfma_f32_32x32x16_f16(afr[s], bq[it % IX_PF][s], c, 0, 0, 0);
#pragma unroll
                for (int qq = 0; qq < 2; ++qq) { float a = 0.f;
#pragma unroll
                    for (int e = 0; e < 8; ++e) a += wq[qq][e] * fmaxf(c[8 * qq + e], 0.f);
                    sc[it][qq] = a; }
            } else { sc[it][0] = -3.0e38f; sc[it][1] = -3.0e38f; }
        }
    }
    for (int rl_ = 0; rl_ < IXR_SEL; ++rl_) { asm volatile("" ::: "memory");
    float mn[2], mx[2];
#pragma unroll
    for (int qq = 0; qq < 2; ++qq) { float me = -3.0e38f, mo = -3.0e38f;
#pragma unroll
        for (int it = 0; it < 32; it += 2) { me = fmaxf(me, sc[it][qq]); mo = fmaxf(mo, sc[it + 1][qq]); }
        float a = fminf(me, mo), z = fmaxf(me, mo);
#pragma unroll
        for (int o = 1; o < 32; o <<= 1) { a = fminf(a, __shfl_xor(a, o)); z = fmaxf(z, __shfl_xor(z, o)); }
        mn[qq] = a; mx[qq] = z; }
    if (r == 0) {
#pragma unroll
        for (int qq = 0; qq < 2; ++qq) { const int qid = 2 * hh + qq; redmn[wave * 4 + qid] = mn[qq]; redmx[wave * 4 + qid] = mx[qq]; }
    }
    { u32x4 z4 = {0u, 0u, 0u, 0u}; *(LAS u32x4*)(hist + 4 * tid) = z4; }
    if (tid < 4) { ccount[tid] = 0u; ovf[tid] = 0u; }
    GBB();
    unsigned pk[2][8];
#pragma unroll
    for (int qq = 0; qq < 2; ++qq) { const int qid = 2 * hh + qq; float a = 3.0e38f, z = -3.0e38f;
#pragma unroll
        for (int w = 0; w < 4; ++w) { a = fminf(a, redmn[w * 4 + qid]); z = fmaxf(z, redmx[w * 4 + qid]); }
        const float scl = (z > a) ? fminf(253.f / (z - a), 1.0e30f) : 1.f; const float nlo = 1.5f - a * scl;
#pragma unroll
        for (int g8 = 0; g8 < 8; ++g8) { unsigned p = 0u;
            if (wave + 16 * g8 < NT32) {
#pragma unroll
                for (int e = 0; e < 4; ++e) p = __builtin_amdgcn_cvt_pk_u8_f32(__builtin_amdgcn_fmed3f(__builtin_fmaf(sc[4 * g8 + e][qq], scl, nlo), 0.f, 255.f), e, p);
#pragma unroll
                for (int e = 0; e < 4; ++e) { const unsigned pb = (p >> (8 * e)) & 255u; if (pb) __hip_atomic_fetch_add(hist + qid * 256 + pb, 1u, __ATOMIC_RELAXED, __HIP_MEMORY_SCOPE_WORKGROUP); }
            }
            pk[qq][g8] = p; } }
    GBB();
    int B[2]; unsigned above[2];
#pragma unroll
    for (int qq = 0; qq < 2; ++qq) { const int qid = 2 * hh + qq;
        const u32x4 h0 = *(const LAS u32x4*)(hist + qid * 256 + 8 * r), h1 = *(const LAS u32x4*)(hist + qid * 256 + 8 * r + 4);
        const unsigned tot = (h0.x + h0.y) + (h0.z + h0.w) + (h1.x + h1.y) + (h1.z + h1.w); unsigned incl = tot;
#pragma unroll
        for (int o = 1; o < 32; o <<= 1) { const unsigned v = __shfl_down(incl, o, 32); if (r + o < 32) incl += v; }
        unsigned run = incl - tot; int Bf = -1; unsigned ab = 0; const unsigned hv8[8] = {h0.x, h0.y, h0.z, h0.w, h1.x, h1.y, h1.z, h1.w};
#pragma unroll
        for (int j = 7; j >= 0; --j) { const unsigned hv = hv8[j]; if (run < 256u && run + hv >= 256u) { Bf = 8 * r + j; ab = run; } run += hv; }
        const unsigned long long mk = __ballot(Bf >= 0);
        const unsigned mh = hh ? (unsigned)(mk >> 32) : (unsigned)mk;
        const int src = 32 * hh + (mh ? __builtin_ctz(mh) : 0);
        B[qq] = __shfl(Bf, src); above[qq] = (unsigned)__shfl((int)ab, src); }
#define IX_PB(it, qq) ((int)((pk[qq][(it) >> 2] >> (8 * ((it) & 3))) & 255u))
#define IX_LAUNDER() do { _Pragma("unroll") for (int it_ = 0; it_ < 32; ++it_) { asm volatile("" : "+v"(sc[it_][0]), "+v"(sc[it_][1])); } asm volatile("" : "+v"(B[0]), "+v"(B[1])); } while (0)
#pragma unroll
    for (int qq = 0; qq < 2; ++qq) { const int qid = 2 * hh + qq;
#pragma unroll
        for (int g8 = 0; g8 < 8; ++g8) if (wave + 16 * g8 < NT32) {
#pragma unroll
            for (int e = 0; e < 4; ++e) { const int it = 4 * g8 + e; const bool hit = (IX_PB(it, qq) == B[qq]);
                if (__any(hit)) { if (hit) { const unsigned pos = __hip_atomic_fetch_add(ccount + qid, 1u, __ATOMIC_RELAXED, __HIP_MEMORY_SCOPE_WORKGROUP);
                    if (pos < (unsigned)IX4_CAP) { f32x2 cv; cv.x = sc[it][qq]; cv.y = __builtin_bit_cast(float, 32 * (wave + 4 * it) + r); *(LAS f32x2*)(cand + (qid * IX4_CAP + pos) * 2) = cv; } } } } } }
    GBB();
    {
        const int c = (int)ccount[wave];
        const unsigned abq = (wave & 1) ? above[1] : above[0];
        const int need = 256 - (int)__shfl((int)abq, 32 * (wave >> 1));
        if (c <= IX4_CAP) {
            LAS float* cw = cand + wave * IX4_CAP * 2;
            if ((c & 1) && lane == 0) { f32x2 cv; cv.x = -3.0e38f; cv.y = __builtin_bit_cast(float, 0x7fffffff); *(LAS f32x2*)(cw + 2 * c) = cv; }
            asm volatile("" ::: "memory");
            for (int i = lane; i < c; i += 64) { const f32x2 ci = *(const LAS f32x2*)(cw + 2 * i); const float si = ci.x; const int ii = __float_as_int(ci.y); int rank = 0;
                for (int j = 0; j < c; j += 2) { const f32x4 cj = *(const LAS f32x4*)(cw + 2 * j);
                    rank += ((cj.x > si) || (cj.x == si && __float_as_int(cj.y) < ii)) ? 1 : 0; rank += ((cj.z > si) || (cj.z == si && __float_as_int(cj.w) < ii)) ? 1 : 0; }
                if (rank == need - 1) { thrS[wave] = si; thrI[wave] = ii; } }
        } else if (lane == 0) { ovf[wave] = 1u; fbNeed[wave] = (unsigned)need; fbT[wave] = 0u; }
    }
    GBB();
    unsigned anyovf = 0u;
#pragma unroll
    for (int q = 0; q < 4; ++q) anyovf |= ovf[q];
#ifndef IX_NOFB
#define IX_NOFB 0
#endif
    if (anyovf && !IX_NOFB) {
        for (int bit = 31; bit >= 0; --bit) {
            if (tid < 4) fbCnt[tid] = 0u;
            GBB();
            IX_LAUNDER();
#pragma unroll
            for (int qq = 0; qq < 2; ++qq) { const int qid = 2 * hh + qq; if (ovf[qid]) { const unsigned cd = fbT[qid] | (1u << bit); unsigned cnt = 0;
#pragma unroll
                for (int it = 0; it < 32; ++it) cnt += (IX_PB(it, qq) == B[qq] && ordkey(sc[it][qq]) >= cd) ? 1u : 0u;
                if (cnt) __hip_atomic_fetch_add(fbCnt + qid, cnt, __ATOMIC_RELAXED, __HIP_MEMORY_SCOPE_WORKGROUP); } }
            GBB();
            if (tid < 4 && ovf[tid] && fbCnt[tid] >= fbNeed[tid]) fbT[tid] |= (1u << bit);
            GBB();
        }
        if (tid < 4) fbCnt[tid] = 0u;
        GBB();
        IX_LAUNDER();
#pragma unroll
        for (int qq = 0; qq < 2; ++qq) { const int qid = 2 * hh + qq; if (ovf[qid]) { const unsigned Tk = fbT[qid]; unsigned cnt = 0;
#pragma unroll
            for (int it = 0; it < 32; ++it) cnt += (IX_PB(it, qq) == B[qq] && ordkey(sc[it][qq]) > Tk) ? 1u : 0u;
            if (cnt) __hip_atomic_fetch_add(fbCnt + qid, cnt, __ATOMIC_RELAXED, __HIP_MEMORY_SCOPE_WORKGROUP); } }
        GBB();
        if (tid < 4 && ovf[tid]) { fbNeed[tid] -= fbCnt[tid]; thrS[tid] = unordkey(fbT[tid]); thrI[tid] = 0; }
        GBB();
        for (int bit = 11; bit >= 0; --bit) {
            if (tid < 4) fbCnt[tid] = 0u;
            GBB();
            IX_LAUNDER();
#pragma unroll
            for (int qq = 0; qq < 2; ++qq) { const int qid = 2 * hh + qq; if (ovf[qid]) { const unsigned Tk = fbT[qid]; const int cd = thrI[qid] | (1 << bit); unsigned cnt = 0;
#pragma unroll
                for (int it = 0; it < 32; ++it) cnt += (IX_PB(it, qq) == B[qq] && ordkey(sc[it][qq]) == Tk && (32 * (wave + 4 * it) + r) < cd) ? 1u : 0u;
                if (cnt) __hip_atomic_fetch_add(fbCnt + qid, cnt, __ATOMIC_RELAXED, __HIP_MEMORY_SCOPE_WORKGROUP); } }
            GBB();
            if (tid < 4 && ovf[tid] && fbCnt[tid] < fbNeed[tid]) thrI[tid] |= (1 << bit);
            GBB();
        }
    }
#pragma unroll
    for (int qq = 0; qq < 2; ++qq) { const int qid = 2 * hh + qq; const float ts = thrS[qid]; const int ti = thrI[qid] - 32 * wave - r;
        unsigned myw = 0u;
#pragma unroll
        for (int g8 = 0; g8 < 8; ++g8) if (wave + 16 * g8 < NT32) {
#pragma unroll
            for (int e = 0; e < 4; ++e) { const int it = 4 * g8 + e; const float s = sc[it][qq];
                const bool sel = (s > ts) | ((s == ts) & (128 * it <= ti));
                const unsigned long long mk = __builtin_amdgcn_ballot_w64(sel);
                const unsigned wv = hh ? (unsigned)(mk >> 32) : (unsigned)mk;
                if (r == it) myw = wv; } }
        if (wave + 4 * r < NT32) bm[(tok0 + qid) * 128 + wave + 4 * r] = myw; }
    }
#undef IX_PB
#undef IX_LAUNDER
}
#undef GBB

DI void phase_ln_router(Ctx& C, int l) {
    const bf16_t* V = (const bf16_t*)(C.ws + WS_V);
    const float* g = C.in(25) + (size_t)l * D; const float* bta = C.in(26) + (size_t)l * D;
    const float* wr = C.in(18); const float* br = C.in(19);
    LAS unsigned* lcnt = (LAS unsigned*)C.lds; LAS unsigned* base = lcnt + 16; LAS int* rec = (LAS int*)(C.lds + 128);
    TokInfo* tok = (TokInfo*)(C.ws + WS_TOK); RowInfo* rowi = (RowInfo*)(C.ws + WS_ROW);
    unsigned* gcnt = C.ctl + CW_GCNT + 64 * l;
    for (int i = C.blk * NTHR + C.tid; i < MAXROWS; i += C.G * NTHR) { RowInfo ri; ri.token = -1; ri.slot = 0; ri.gate = 0.f; ri.pad = 0; rowi[i] = ri; }
    LAS float* wT = (LAS float*)(C.lds + 4096);
    __syncthreads();
    for (int i = C.tid; i < D * 16; i += NTHR) { const int d = i >> 4, e = i & 15; wT[e * D + d] = wr[i]; }
    for (int rb = C.blk; rb < T / 64; rb += C.G) {
        __syncthreads();
        if (C.tid < 16) lcnt[C.tid] = 0u;
        __syncthreads();
        for (int i = 0; i < 8; ++i) {
            const int lr = C.wave * 8 + i; const size_t m = (size_t)rb * 64 + lr;
            f32x4 v[4];
            load_row_bf16(V + m * D, v, C.lane);
            ln16(v, g, bta, C.lane);
            store_row_bf16(C.xcur + m * D, v, C.lane);
            float lg[16];
#pragma unroll
            for (int e = 0; e < 16; ++e) lg[e] = 0.f;
#pragma unroll
            for (int e = 0; e < 16; ++e)
#pragma unroll
                for (int j = 0; j < 4; ++j) { const f32x4 w4 = *(const LAS f32x4*)(wT + e * D + 256 * j + 4 * C.lane); lg[e] += (v[j].x * w4.x + v[j].y * w4.y) + (v[j].z * w4.z + v[j].w * w4.w); }
            float sc[16], sl[16];
#pragma unroll
            for (int e = 0; e < 16; ++e) { const float t = wave_sum(lg[e]); sc[e] = 1.f / (1.f + expf(-t)); sl[e] = sc[e] + br[e]; }
            int best = 0; float bestv = -3.0e38f;
#pragma unroll
            for (int gq = 0; gq < 4; ++gq) { const float a = sl[4 * gq], b2 = sl[4 * gq + 1], c2 = sl[4 * gq + 2], d2 = sl[4 * gq + 3];
                const float mx1 = fmaxf(fmaxf(a, b2), fmaxf(c2, d2)); const float tot = a + b2 + c2 + d2; const float mn1 = fminf(fminf(a, b2), fminf(c2, d2));
                const float lo1 = fminf(a, b2), hi1 = fmaxf(a, b2), lo2 = fminf(c2, d2), hi2 = fmaxf(c2, d2);
                const float second = fmaxf(fminf(hi1, hi2), fmaxf(lo1, lo2));
                (void)tot; (void)mn1;
                const float gs = mx1 + second; if (gs > bestv) { bestv = gs; best = gq; } }
            int i0 = 0, i1 = 0; float v0 = -3.0e38f, v1 = -3.0e38f, s0 = 0.f, s1 = 0.f;
#pragma unroll
            for (int gq = 0; gq < 4; ++gq) if (gq == best) {
#pragma unroll
                for (int k = 0; k < 4; ++k) { const float x = sl[4 * gq + k]; if (x > v0) { v1 = v0; i1 = i0; s1 = s0; v0 = x; i0 = 4 * gq + k; s0 = sc[4 * gq + k]; } else if (x > v1) { v1 = x; i1 = 4 * gq + k; s1 = sc[4 * gq + k]; } } }
            const float den = s0 + s1; const float g0 = s0 / den, g1 = s1 / den;
            if (C.lane == 0) {
                const unsigned r0 = __hip_atomic_fetch_add(lcnt + i0, 1u, __ATOMIC_RELAXED, __HIP_MEMORY_SCOPE_WORKGROUP);
                const unsigned r1 = __hip_atomic_fetch_add(lcnt + i1, 1u, __ATOMIC_RELAXED, __HIP_MEMORY_SCOPE_WORKGROUP);
                rec[lr * 8 + 0] = i0; rec[lr * 8 + 1] = i1; rec[lr * 8 + 2] = (int)r0; rec[lr * 8 + 3] = (int)r1;
                rec[lr * 8 + 4] = __builtin_bit_cast(int, g0); rec[lr * 8 + 5] = __builtin_bit_cast(int, g1); }
        }
        __syncthreads();
        if (C.tid < 16) base[C.tid] = __hip_atomic_fetch_add(gcnt + C.tid, lcnt[C.tid], __ATOMIC_RELAXED, __HIP_MEMORY_SCOPE_AGENT);
        __syncthreads();
        if (C.tid < 64) { TokInfo ti; ti.e0 = rec[C.tid * 8]; ti.e1 = rec[C.tid * 8 + 1]; ti.p0 = rec[C.tid * 8 + 2] + (int)base[ti.e0]; ti.p1 = rec[C.tid * 8 + 3] + (int)base[ti.e1];
            ti.g0 = __builtin_bit_cast(float, rec[C.tid * 8 + 4]); ti.g1 = __builtin_bit_cast(float, rec[C.tid * 8 + 5]); ti.pad0 = 0; ti.pad1 = 0; tok[(size_t)rb * 64 + C.tid] = ti; }
    }
}
DI int build_tile_table(Ctx& C, int l, LAS int* toff, LAS int* texp) {
    const unsigned* gcnt = C.ctl + CW_GCNT + 64 * l;
    __syncthreads();
    if (C.tid < 64) {
        int c = 0; if (C.lane < 16) c = (int)__hip_atomic_load(gcnt + C.lane, __ATOMIC_RELAXED, __HIP_MEMORY_SCOPE_AGENT);
        const int nt = (c + 255) >> 8; int incl = nt;
#pragma unroll
        for (int o = 1; o < 16; o <<= 1) { const int v = __shfl_up(incl, o); if (C.lane >= o) incl += v; }
        const int start = incl - nt;
        if (C.lane < 16) { toff[C.lane] = start << 8; for (int t = 0; t < nt; ++t) texp[start + t] = C.lane; }
        if (C.lane == 15) toff[16] = incl << 8; }
    __syncthreads();
    return toff[16] >> 8;
}
DI void phase_gather(Ctx& C, int l) {
    LAS int* toff = (LAS int*)(C.lds + 1024); LAS int* texp = (LAS int*)(C.lds + 2048);
    (void)build_tile_table(C, l, toff, texp);
    const TokInfo* tok = (const TokInfo*)(C.ws + WS_TOK); RowInfo* rowi = (RowInfo*)(C.ws + WS_ROW); bf16_t* AG = (bf16_t*)(C.ws + WS_AG);
    for (int m = C.blk * NTHR + C.tid; m < T; m += C.G * NTHR) {
        const TokInfo ti = tok[m];
        const int r0 = toff[ti.e0] + ti.p0, r1 = toff[ti.e1] + ti.p1;
        { RowInfo x; x.token = m; x.slot = 0; x.gate = ti.g0; x.pad = 0; rowi[r0] = x; x.slot = 1; x.gate = ti.g1; rowi[r1] = x; }
    }
}
DI void phase_ln_ffn(Ctx& C, int l) {
    const bf16_t* Y = (const bf16_t*)(C.ws + WS_Y);
    const float* g = C.in(27) + (size_t)l * D; const float* bta = C.in(28) + (size_t)l * D;
    const int gw = C.blk * NWAVES + C.wave, NGW = C.G * NWAVES;
    for (int m = gw; m < T; m += NGW) {
        f32x4 x[4], y0[4], y1[4];
        load_row_bf16(C.xcur + (size_t)m * D, x, C.lane); load_row_bf16(Y + (size_t)m * D, y0, C.lane); load_row_bf16(Y + ((size_t)T + m) * D, y1, C.lane);
#pragma unroll
        for (int j = 0; j < 4; ++j) x[j] = x[j] * ALPHA + (y0[j] + y1[j]);
        ln16(x, g, bta, C.lane);
        store_row_bf16(C.xcur + (size_t)m * D, x, C.lane);
    }
}
DI void phase_ln_ple(Ctx& C, int l, bool last) {
    const bf16_t* V = (const bf16_t*)(C.ws + WS_V3);
    const float* g = C.in(29) + (size_t)l * D; const float* bta = C.in(30) + (size_t)l * D;
    const int gw = C.blk * NWAVES + C.wave, NGW = C.G * NWAVES;
    for (int m = gw; m < T; m += NGW) {
        f32x4 v[4];
        load_row_bf16(V + (size_t)m * D, v, C.lane);
        ln16(v, g, bta, C.lane);
        if (last) {
#ifdef PROBE_PHASE
            { const unsigned long long* pt = (const unsigned long long*)(C.ws + WS_CTL + 32768); const float sc = 1.f + (float)(pt[1] - pt[0]) * (float)(PROBE_SCALE);
#pragma unroll
              for (int j = 0; j < 4; ++j) v[j] = v[j] * sc; }
#endif
#pragma unroll
            for (int j = 0; j < 4; ++j) *(f32x4*)(C.out + (size_t)m * D + 256 * j + 4 * C.lane) = v[j];
        } else store_row_bf16(C.xcur + (size_t)m * D, v, C.lane);
    }
}

constexpr int LDS_BYTES = 163840;
constexpr int PH_PER_LAYER = 13, NPHASE = 1 + DEPTH * PH_PER_LAYER;

constexpr int CW_AQ = 2048;
DI void convert_mixer_weights(Ctx& C, int l) {
    int first = 0;
    { ColPlain c{C.in(5) + (size_t)l * D * D}; convert_matrix(C, c, D, D, D, (bf16_t*)(C.ws + WS_WOUT), first); }
    { ColPlain c{C.in(8) + (size_t)l * 64 * 512}; convert_matrix(C, c, 512, 64, 512, (bf16_t*)(C.ws + WS_LORA), first); }
    { ColPlain c{C.in(10) + (size_t)l * 64 * 512}; convert_matrix(C, c, 512, 64, 512, (bf16_t*)(C.ws + WS_LORA) + 512 * 64, first); }
    { ColPlain c{C.in(11) + (size_t)l * 128 * 512}; convert_matrix(C, c, 512, 128, 512, (bf16_t*)(C.ws + WS_LORA) + 2 * 512 * 64, first); }
}
DI void convert_ffn_weights(Ctx& C, int l) {
    int first = 0;
    { ColGateUp c{C.in(20) + (size_t)l * NEXP * D * DEXP, C.in(21) + (size_t)l * NEXP * D * DEXP}; convert_matrix(C, c, DEXP, D, NEXP * 512, (bf16_t*)(C.ws + WS_WEXP), first); }
    for (int e = 0; e < NEXP; ++e) { ColDown c{C.in(22) + ((size_t)l * NEXP + e) * DEXP * D}; convert_matrix(C, c, D, DEXP, D, (bf16_t*)(C.ws + WS_WDOWN) + (size_t)e * D * DEXP, first); }
    { ColPlain c{C.in(24) + (size_t)l * D * D}; convert_matrix(C, c, D, D, D, (bf16_t*)(C.ws + WS_WPG), first); }
    { ColPlain c{C.in(23) + (size_t)l * PLE * D}; convert_matrix(C, c, D, PLE, D, (bf16_t*)(C.ws + WS_WPLE), first); }
    const float* p = C.in(1) + (size_t)l * T * PLE; bf16_t* pb = (bf16_t*)(C.ws + WS_PBF);
    for (size_t i = ((size_t)C.blk * NTHR + C.tid) * 8; i < (size_t)T * PLE; i += (size_t)C.G * NTHR * 8) {
        const f32x4 a = *(const f32x4*)(p + i), b = *(const f32x4*)(p + i + 4);
        u32x4 o; o.x = pk2(a.x, a.y); o.y = pk2(a.z, a.w); o.z = pk2(b.x, b.y); o.w = pk2(b.z, b.w); *(u32x4*)(pb + i) = o; }
}
#ifndef RWREP
#define RWREP 1
#endif
#ifndef IQREP
#define IQREP 1
#endif
#ifndef REP_SUB
#define REP_SUB 0
#endif
#ifndef REP_SP
#define REP_SP -1
#define REP_N 1
#endif
template <int SP> DI void run_sp_(Ctx& C, const int l, const int rep);
template <int SP> DI void run_sp(Ctx& C, const int l) { run_sp_<SP>(C, l, 0); }
template <int SP> DI void run_sp_(Ctx& C, const int l, const int rep) {
    if constexpr (SP == 0) {
        pg8::Gemm g{C.xcur, (const bf16_t*)(C.ws + WS_WEXP), T, NPROJ_PAD, opaque_i(D)}; pg8::StaticOrder S; S.init(T, NPROJ_PAD, C.G, C.blk);
        EpiProj E{(bf16_t*)(C.ws + WS_PROJ)};
        pg8::gemm_phase<EpiProj, pg8::StaticOrder, true, true>(C.lds, g, S, E);
    } else if constexpr (SP == 1) {
    } else if constexpr (SP == 2) {
        LAS unsigned* gb = (LAS unsigned*)(C.lds + GB_OFF);
        if (C.tid < 8) gb[C.tid] = 0u;
        __syncthreads();
        const int half = C.wave >> 2, ltid = C.tid & 255;
        LAS unsigned* gcnt = gb + half; unsigned gtarget = 0u;
        LAS int* slot = (LAS int*)(gb + 2 + 2 * half);
        unsigned* iq = C.ctl + CW_AQ + 32 + 64 * l + 256 * rep;
        int nxt = 0, par = 0;
        if (half == 0) {
            for (int rw_ = 0; rw_ < RWREP; ++rw_)
            for (int bc = C.blk; bc < 256; bc += C.G) { bf16x8 actv[8]; rwkv_chunk_acts4(C, bc, l, actv); for (int h = 0; h < 8; ++h) rwkv_head_item4(C, bc * 8 + h, l, actv, gcnt, gtarget); }
        }
        const int ixb = half ? IX4 : 0;
        if (ltid == 0) nxt = (int)__hip_atomic_fetch_add(iq, 1u, __ATOMIC_RELAXED, __HIP_MEMORY_SCOPE_AGENT);
        for (;;) {
            if (ltid == 0) slot[par] = nxt;
            gbar(gcnt, gtarget, C.lane);
            const int u = __builtin_amdgcn_readfirstlane(slot[par]); par ^= 1;
            if (u >= 4096) break;
            if (ltid == 0) nxt = (int)__hip_atomic_fetch_add(iq, 1u, __ATOMIC_RELAXED, __HIP_MEMORY_SCOPE_AGENT);
            idx_item4(C, u, l, ixb, gcnt, gtarget);
        }
    } else if constexpr (SP == 3) {
        if (C.blk < 8 && (rep == 0 || REP_SUB != 2)) rwkv_scan_wave(C, C.blk * 8 + C.wave);
        LAS int* qs = (LAS int*)(C.lds + LDS_BYTES - 128);
        if (rep == 0 || REP_SUB != 1)
        for (;;) {
            __syncthreads();
            if (C.tid == 0) qs[0] = (int)__hip_atomic_fetch_add(C.ctl + CW_AQ + 64 * l + 256 * rep, 1u, __ATOMIC_RELAXED, __HIP_MEMORY_SCOPE_AGENT);
            __syncthreads();
            const int u = __builtin_amdgcn_readfirstlane(qs[0]);
            if (u >= 512) break;
            const int qb = 15 - (u >> 5), bh = u & 31; attn_unit(C, bh >> 3, bh & 7, qb);
        }
    } else if constexpr (SP == 4) {
        const int gw = C.blk * NWAVES + C.wave, NGW = C.G * NWAVES;
        for (int id = gw; id < 2048; id += NGW) rwkv_out_wave(C, id, l);
    } else if constexpr (SP == 5) {
        pg8::Gemm g{C.mixcat, (const bf16_t*)(C.ws + WS_WOUT), T, D, opaque_i(D)}; pg8::StaticOrder S; S.init(T, D, C.G, C.blk);
        EpiResF32 E{C.xcur, (bf16_t*)(C.ws + WS_V)};
        pg8::gemm_phase<EpiResF32, pg8::StaticOrder, true, true>(C.lds, g, S, E);
    } else if constexpr (SP == 6) { phase_ln_router(C, l); convert_ffn_weights(C, l);
    } else if constexpr (SP == 7) { phase_gather(C, l);
    } else if constexpr (SP == 8) {
        LAS int* toff = (LAS int*)(C.lds + 135168); LAS int* texp = (LAS int*)(C.lds + 136192);
        const int nt = build_tile_table(C, l, toff, texp);
        pg8::Gemm g{C.xcur, (const bf16_t*)(C.ws + WS_WEXP), MAXROWS, NEXP * 512, opaque_i(D)};
        GroupedOrder<2> S{texp, nt, C.G, C.blk};
        EpiSwiGLU E{(bf16_t*)(C.ws + WS_H), (const RowInfo*)(C.ws + WS_ROW)};
        pg8::gemm_phase_gather<EpiSwiGLU, GroupedOrder<2>, true>(C.lds, g, S, E, (const int*)(C.ws + WS_ROW));
        {
            const int extra = (2 * nt > C.G) ? (2 * nt - C.G) : 0; const int nb = C.G - extra;
            if (C.blk >= extra && nb > 0) { pg8::Gemm g2{(const bf16_t*)(C.ws + WS_PBF), (const bf16_t*)(C.ws + WS_WPLE), T, D, opaque_i(PLE)}; pg8::StaticOrder S2; S2.init(T, D, nb, C.blk - extra);
                EpiBf16Plain E2{(bf16_t*)(C.ws + WS_PE), D};
                pg8::gemm_phase<EpiBf16Plain, pg8::StaticOrder, true, true>(C.lds, g2, S2, E2); } }
    } else if constexpr (SP == 9) {
        LAS int* toff = (LAS int*)(C.lds + 135168); LAS int* texp = (LAS int*)(C.lds + 136192);
        const int nt = build_tile_table(C, l, toff, texp);
        { pg8::Gemm g{(const bf16_t*)(C.ws + WS_H), (const bf16_t*)(C.ws + WS_WDOWN), MAXROWS, NEXP * D, opaque_i(DEXP)};
          GroupedOrder<4> S{texp, nt, C.G, C.blk};
          EpiDown E{(bf16_t*)(C.ws + WS_Y), (const RowInfo*)(C.ws + WS_ROW)};
          pg8::gemm_phase<EpiDown, GroupedOrder<4>, true, true>(C.lds, g, S, E); }
    } else if constexpr (SP == 10) { phase_ln_ffn(C, l);
    } else if constexpr (SP == 11) {
        pg8::Gemm g{C.xcur, (const bf16_t*)(C.ws + WS_WPG), T, D, opaque_i(D)}; pg8::StaticOrder S; S.init(T, D, C.G, C.blk);
        EpiPle E{C.xcur, (const bf16_t*)(C.ws + WS_PE), (bf16_t*)(C.ws + WS_V3)};
        pg8::gemm_phase<EpiPle, pg8::StaticOrder, true, true>(C.lds, g, S, E);
    } else { phase_ln_ple(C, l, l == DEPTH - 1); if (l + 1 < DEPTH) { convert_win(C, l + 1); convert_mixer_weights(C, l + 1); } }
}
#define XB_TMO      128
#define XB_XCNT(j)  (256  + 64 * (j))
#define XB_XSUB(j)  (1280 + 64 * (j))
#define XB_XGEN(j)  (2304 + 64 * (j))
#define XB_TOP      3328
#define XB_TOPGEN   3392
#define XCD_BAR_WORDS 3456
#define XB_SPIN_CAP (1u << 18)

__device__ __forceinline__ unsigned xb_ld(unsigned* p)              { return __hip_atomic_load(p, __ATOMIC_RELAXED, __HIP_MEMORY_SCOPE_AGENT); }
__device__ __forceinline__ unsigned xb_add(unsigned* p, unsigned v) { return __hip_atomic_fetch_add(p, v, __ATOMIC_RELAXED, __HIP_MEMORY_SCOPE_AGENT); }
__device__ __forceinline__ unsigned xb_xcc_id() { return (unsigned)__builtin_amdgcn_s_getreg((3 << 11) | 20) & 0xFu; }
#define XB_SPIN(cond, bar) do { unsigned _sp = 0; while (cond) { __builtin_amdgcn_s_sleep(1); \
    if ((++_sp & 255u) == 0u) { if (xb_ld(&(bar)[XB_TMO])) break; if (_sp > XB_SPIN_CAP) { atomicAdd(&(bar)[XB_TMO], 1u); break; } } } } while (0)

struct XcdBarrier {
    unsigned* bar; unsigned x;
    volatile __attribute__((address_space(3))) unsigned* st;
};

__device__ __forceinline__ XcdBarrier xcd_barrier_post(unsigned* bar, volatile __attribute__((address_space(3))) unsigned* st) {
    XcdBarrier b; b.bar = bar; b.x = xb_xcc_id(); b.st = st;
    if (threadIdx.x == 0) (void)xb_add(&bar[XB_XCNT(b.x)], 1u);
    return b;
}
__device__ __forceinline__ void xcd_barrier_complete(unsigned* bar, unsigned x, unsigned& nloc, unsigned& nx) {
    const unsigned G = gridDim.x * gridDim.y * gridDim.z;
    unsigned sum, cnt, mine, sp = 0u;
    for (;;) {
        sum = 0u; cnt = 0u; mine = 0u;
#pragma unroll
        for (unsigned j = 0; j < 16; ++j) { const unsigned c = xb_ld(&bar[XB_XCNT(j)]); sum += c; cnt += (c > 0u) ? 1u : 0u; mine = (j == x) ? c : mine; }
        if (sum == G) break;
        __builtin_amdgcn_s_sleep(1);
        if ((++sp & 255u) == 0u) { if (xb_ld(&bar[XB_TMO])) break; if (sp > XB_SPIN_CAP) { atomicAdd(&bar[XB_TMO], 1u); break; } }
    }
    nloc = mine > 0u ? mine : 1u; nx = cnt > 0u ? cnt : 1u;
}

__device__ __forceinline__ void xcd_barrier(const XcdBarrier& b) {
    asm volatile("s_waitcnt vmcnt(0)" ::: "memory");
    __syncthreads();
    if (threadIdx.x == 0) {
        unsigned* bar = b.bar;
        __builtin_amdgcn_s_waitcnt(0);
        unsigned nloc = b.st[0], nx = b.st[1];
        if (nloc == 0u) { xcd_barrier_complete(bar, b.x, nloc, nx); b.st[0] = nloc; b.st[1] = nx; }
        const unsigned old = xb_add(&bar[XB_XSUB(b.x)], 1u);
        const unsigned gen = old / nloc;
        if (old + 1u == (gen + 1u) * nloc) {
            __builtin_amdgcn_fence(__ATOMIC_RELEASE, "agent");
            asm volatile("s_waitcnt vmcnt(0)" ::: "memory");
            const unsigned og = xb_add(&bar[XB_TOP], 1u);
            const unsigned tg = og / nx;
            if (og + 1u == (tg + 1u) * nx) xb_add(&bar[XB_TOPGEN], 1u);
            else XB_SPIN(xb_ld(&bar[XB_TOPGEN]) == tg, bar);
            __builtin_amdgcn_fence(__ATOMIC_ACQUIRE, "agent");
            xb_add(&bar[XB_XGEN(b.x)], 1u);
            asm volatile("s_waitcnt vmcnt(0)" ::: "memory");
        } else {
            XB_SPIN(xb_ld(&bar[XB_XGEN(b.x)]) == gen, bar);
            __builtin_amdgcn_fence(__ATOMIC_ACQUIRE, "agent");
            asm volatile("s_waitcnt vmcnt(0)" ::: "memory");
        }
    }
    __syncthreads();
}

constexpr int CW_XBAR = 65536;
typedef const __attribute__((address_space(4))) Args* KArgP;
DI void ctx_setup(Ctx& C) {
    int t_ = threadIdx.x; asm volatile("" : "+v"(t_)); C.tid = t_; C.lane = t_ & 63; C.wave = __builtin_amdgcn_readfirstlane(t_ >> 6);
    int b_ = blockIdx.x, g_ = gridDim.x; asm volatile("" : "+s"(b_), "+s"(g_)); C.blk = b_; C.G = g_;
    KArgP ap = (KArgP)__builtin_amdgcn_kernarg_segment_ptr(); asm volatile("" : "+s"(ap));
    C.ap = ap; C.out = ap->out; C.ws = ap->ws; C.ctl = (unsigned*)(ap->ws + WS_CTL); C.xcur = (bf16_t*)ap->out; C.mixcat = (bf16_t*)ap->out + (size_t)T * D;
}
__global__ void __launch_bounds__(NTHR, 2) mega_fwd(Args args) {
    extern __shared__ __attribute__((aligned(16))) unsigned char lds_raw[];
    Ctx C;
    C.lds = (LAS unsigned char*)lds_raw;
    cg::grid_group grid = cg::this_grid();
    volatile LAS unsigned* xbst = (volatile LAS unsigned*)(C.lds + LDS_BYTES - 32);
    if (threadIdx.x < 4) xbst[threadIdx.x] = 0u;
    __syncthreads();
    XcdBarrier xbar = xcd_barrier_post((unsigned*)(((KArgP)__builtin_amdgcn_kernarg_segment_ptr())->ws + WS_CTL) + CW_XBAR, xbst);
    const int lo = ((KArgP)__builtin_amdgcn_kernarg_segment_ptr())->ph_lo, hi = ((KArgP)__builtin_amdgcn_kernarg_segment_ptr())->ph_hi;
#ifdef PROBE_PHASE
#define PROBE_HOOK(k) do { if (blockIdx.x == 0 && threadIdx.x == 0) { unsigned long long* pt = (unsigned long long*)(C.ws + WS_CTL + 32768); if ((k) == PROBE_PHASE) pt[0] = __builtin_amdgcn_s_memrealtime(); if ((k) == PROBE_PHASE_END) pt[1] = __builtin_amdgcn_s_memrealtime(); } } while (0)
#else
#define PROBE_HOOK(k) do { } while (0)
#endif
#define GRID_BAR(k) do { if ((k) == lo + 1) grid.sync(); else xcd_barrier(xbar); } while (0)
#define PHASE(k, body) do { if (lo <= (k) && (k) < hi) { if ((k) > lo) GRID_BAR(k); ctx_setup(C); PROBE_HOOK(k); body; } } while (0)
    PHASE(0, { phase_ln_in(C); convert_win(C, 0); convert_mixer_weights(C, 0); });
#define LAYER(l) PHASE(1 + 13 * (l) + 0, run_sp<0>(C, l)); PHASE(1 + 13 * (l) + 2, run_sp<2>(C, l)); PHASE(1 + 13 * (l) + 3, run_sp<3>(C, l)); \
    PHASE(1 + 13 * (l) + 4, run_sp<4>(C, l)); PHASE(1 + 13 * (l) + 5, run_sp<5>(C, l)); PHASE(1 + 13 * (l) + 6, run_sp<6>(C, l)); PHASE(1 + 13 * (l) + 7, run_sp<7>(C, l)); \
    PHASE(1 + 13 * (l) + 8, run_sp<8>(C, l)); PHASE(1 + 13 * (l) + 9, run_sp<9>(C, l)); PHASE(1 + 13 * (l) + 10, run_sp<10>(C, l)); PHASE(1 + 13 * (l) + 11, run_sp<11>(C, l)); \
    PHASE(1 + 13 * (l) + 12, run_sp<12>(C, l))
#define PH0(sp) PHASE(1 + (sp), run_sp<sp>(C, 0)); if (REP_SP == (sp)) { if (REP_N > 1) { xcd_barrier(xbar); ctx_setup(C); run_sp_<sp>(C, 0, 1); } if (REP_N > 2) { xcd_barrier(xbar); ctx_setup(C); run_sp_<sp>(C, 0, 2); } }
    PH0(0); PH0(2); PH0(3); PH0(4); PH0(5); PH0(6); PH0(7); PH0(8); PH0(9); PH0(10); PH0(11); PH0(12);
#undef PH0
    LAYER(1);
#undef LAYER
#undef PHASE
}

#ifndef N_LAUNCH_MODE
#define N_LAUNCH_MODE 1
#endif
extern "C" void kernel_launch(void* const* d_in, const int* in_sizes, int n_in, void* d_out, int out_size, void* d_ws, size_t ws_size, hipStream_t stream) {
    static int grid = 0;
    if (grid == 0) {
        if (n_in != 31 || out_size != T * D) { fprintf(stderr, "kernel_launch: unexpected problem (n_in %d out %d)\n", n_in, out_size); grid = -1; return; }
        int dev = 0, cus = 0, per_cu = 0;
        hipGetDevice(&dev); hipDeviceGetAttribute(&cus, hipDeviceAttributeMultiprocessorCount, dev);
        if (hipFuncSetAttribute((const void*)mega_fwd, hipFuncAttributeMaxDynamicSharedMemorySize, LDS_BYTES) != hipSuccess) { fprintf(stderr, "kernel_launch: hipFuncSetAttribute failed\n"); grid = -1; return; }
        if (hipOccupancyMaxActiveBlocksPerMultiprocessor(&per_cu, (const void*)mega_fwd, NTHR, LDS_BYTES) != hipSuccess || per_cu < 1) { fprintf(stderr, "kernel_launch: occupancy query says %d\n", per_cu); per_cu = 1; }
        (void)hipGetLastError();
        grid = cus * 1;
        fprintf(stderr, "kernel_launch: grid %d (occupancy %d per CU)\n", grid, per_cu);
    }
    if (grid < 0) return;
    hipMemsetAsync((char*)d_ws + WS_CTL, 0, CTL_BYTES, stream);
    Args a{};
    for (int i = 0; i < 31; ++i) a.in[i] = (const float*)d_in[i];
    a.out = (float*)d_out; a.ws = (unsigned char*)d_ws;
#if N_LAUNCH_MODE == 0
    for (int ph = 0; ph < NPHASE; ++ph) { a.ph_lo = ph; a.ph_hi = ph + 1; hipLaunchKernelGGL(mega_fwd, dim3(grid), dim3(NTHR), LDS_BYTES, stream, a); }
#else
    a.ph_lo = 0; a.ph_hi = NPHASE;
    void* kargs[] = {&a};
    hipError_t e = hipLaunchCooperativeKernel((const void*)mega_fwd, dim3(grid), dim3(NTHR), kargs, LDS_BYTES, stream);
    if (e != hipSuccess) fprintf(stderr, "cooperative launch failed: %s (grid %d)\n", hipGetErrorString(e), grid);
#endif
}
```

```cpp
#include <hip/hip_runtime.h>
#include <hip/hip_cooperative_groups.h>
#include <cstdio>
#include <cstdint>
namespace cg = cooperative_groups;
namespace pg8 {
#define PG8_LAS __attribute__((address_space(3)))
typedef unsigned short bf16_t;
typedef short bf16x8 __attribute__((ext_vector_type(8)));
typedef float f32x4 __attribute__((ext_vector_type(4)));
typedef unsigned u32x4 __attribute__((ext_vector_type(4)));
constexpr int BM = 256, BK = 64, HALF = 128, HTB = HALF * BK * 2  , STAGE_BYTES = 8 * HTB, NXCD = 8, WGM = 8;

__host__ __device__ __forceinline__ int lds_byte(int r, int c) { const int st = (r >> 4) * 2 + (c >> 5), rr = r & 15, cc = c & 31, ob = rr * 64 + cc * 2; return st * 1024 + (ob ^ (((ob >> 9) & 1) << 5)); }
__host__ __device__ __forceinline__ void stage_rc(int b, int& R, int& C) { const int st = b / 1024, sb = b % 1024, swz = sb ^ (((sb >> 9) & 1) << 5); R = (st >> 1) * 16 + swz / 64; C = (st & 1) * 32 + (swz % 64) / 2; }
__host__ __device__ __forceinline__ int perm32(int rho) { const int n = rho >> 4, i = rho & 15; return 8 * (i >> 2) + 4 * n + (i & 3); }

struct Unit { int pm, pn; };
struct Gemm { const bf16_t* A; const bf16_t* Bt; int M, N, K; };

struct StaticOrder {
    int nM, nN, nwg, G, c;
    __host__ __device__ void init(int M, int N, int G_, int c_) { nM = M / BM; nN = N / BM; nwg = nM * nN; G = G_; c = c_; }
    __host__ __device__ bool next(int i, Unit& u) const {
        const long L = (long)i * G + c; if (L >= nwg) return false;
        int wgid = (int)L; { const int q = nwg / NXCD, r = nwg % NXCD, xcd = wgid % NXCD, off = wgid / NXCD; wgid = (xcd < r ? xcd * (q + 1) : r * (q + 1) + (xcd - r) * q) + off; }
        const int nig = WGM * nN, gid = wgid / nig, fm = gid * WGM, gsz = (nM - fm) < WGM ? (nM - fm) : WGM;
        u.pm = fm + ((wgid % nig) % gsz); u.pn = (wgid % nig) / gsz; return true;
    }
    __device__ __forceinline__ void a_ready(const Unit&) const {}
    __device__ __forceinline__ void done(const Unit&) const {}
};

__device__ __forceinline__ unsigned cvt_pk_bf16(float lo, float hi) { typedef float f2_t __attribute__((ext_vector_type(2))); typedef __bf16 b2_t __attribute__((ext_vector_type(2))); f2_t v = {lo, hi}; b2_t b = __builtin_convertvector(v, b2_t); return __builtin_bit_cast(unsigned, b); }
template <class Epi, class Sched, bool ALIGN_EPI = false, bool SP2 = false>
__device__ __forceinline__ void gemm_phase(PG8_LAS unsigned char* lds, const Gemm g, const Sched& S, const Epi& E) {
    int tid_ = threadIdx.x; asm volatile("" : "+v"(tid_));
    const int tid = tid_, wid = __builtin_amdgcn_readfirstlane(tid >> 6), lane = tid & 63, wr = wid >> 2, wc = wid & 3, fr = lane & 15, fq = lane >> 4;
    const int K = g.K, nt = K / BK;
    unsigned voffA[2], voffB[2];
#pragma unroll
    for (int i = 0; i < 2; ++i) { int R, C; stage_rc(tid * 16 + i * 8192, R, C); const int Rb = Epi::PERM ? ((R & ~31) + perm32(R & 31)) : R;
        voffA[i] = (unsigned)(R * K + C) * 2u; voffB[i] = (unsigned)(Rb * K + C) * 2u; }
    const size_t kstep = (size_t)(BK * 2);
    const size_t hstep = (size_t)HALF * K * 2;
    const size_t tstep = 2 * hstep;
    const unsigned ldsw = (unsigned)wid * 1024u;
    const int aoff = lds_byte(wr * 64 + fr, fq * 8), boff = lds_byte(wc * 32 + fr, fq * 8);
#define PG8_SA(b, h) (((b) * 2 + (h)) * HTB)
#define PG8_SB(b, h) ((4 + (b) * 2 + (h)) * HTB)
#define PG8_STAGE(bufoff, gbase, voff) do { _Pragma("unroll") for (int _i = 0; _i < 2; ++_i) \
        __builtin_amdgcn_global_load_lds((const unsigned*)((const char*)(gbase) + (voff)[_i]), (PG8_LAS unsigned*)(lds + (bufoff) + ldsw + _i * 8192), 16, 0, 0); } while (0)
#define PG8_LDA(dst, b, h) do { _Pragma("unroll") for (int m = 0; m < 4; ++m) _Pragma("unroll") for (int k = 0; k < 2; ++k) dst[m][k] = *(const PG8_LAS bf16x8*)(lds + PG8_SA(b, h) + aoff + m * 2048 + k * 1024); } while (0)
#define PG8_LDB(dst, b, h) do { _Pragma("unroll") for (int n = 0; n < 2; ++n) _Pragma("unroll") for (int k = 0; k < 2; ++k) dst[n][k] = *(const PG8_LAS bf16x8*)(lds + PG8_SB(b, h) + boff + n * 2048 + k * 1024); } while (0)
#define PG8_MMA(ai, bj, At, Bt) do { __builtin_amdgcn_s_setprio(1); _Pragma("unroll") for (int m = 0; m < 4; ++m) _Pragma("unroll") for (int n = 0; n < 2; ++n) _Pragma("unroll") for (int k = 0; k < 2; ++k) \
        acc[ai][bj][m][n] = __builtin_amdgcn_mfma_f32_16x16x32_bf16(Bt[n][k], At[m][k], acc[ai][bj][m][n], 0, 0, 0); __builtin_amdgcn_s_setprio(0); } while (0)
#define PG8_WAIT_V(n) asm volatile("s_waitcnt vmcnt(" #n ")" ::: "memory")
#define PG8_WAIT_L(n) asm volatile("s_waitcnt lgkmcnt(" #n ")" ::: "memory")
#define PG8_BAR __builtin_amdgcn_s_barrier()
#define PG8_SCHED __builtin_amdgcn_sched_barrier(0)
    Unit cur, nxt; int ui = 0;
    if (!S.next(0, cur)) return;
    f32x4 acc[2][2][4][2];
#pragma unroll
    for (int a = 0; a < 2; ++a)
#pragma unroll
        for (int b = 0; b < 2; ++b)
#pragma unroll
            for (int m = 0; m < 4; ++m)
#pragma unroll
                for (int n = 0; n < 2; ++n) acc[a][b][m][n] = (f32x4){0.f, 0.f, 0.f, 0.f};
    bf16x8 At[4][2], B0[2][2], B1[2][2];
    const char* cA = (const char*)g.A + (size_t)cur.pm * tstep; const char* cB = (const char*)g.Bt + (size_t)cur.pn * tstep;
    S.a_ready(cur);
    if constexpr (SP2) {
        PG8_STAGE(PG8_SB(0, 0), cB, voffB); PG8_STAGE(PG8_SB(0, 1), cB + hstep, voffB); PG8_STAGE(PG8_SA(0, 0), cA, voffA); PG8_STAGE(PG8_SA(0, 1), cA + hstep, voffA);
        if (wr == 1) PG8_BAR;
        PG8_WAIT_V(2); PG8_BAR;
        PG8_STAGE(PG8_SB(1, 0), cB + kstep, voffB); PG8_STAGE(PG8_SA(1, 0), cA + kstep, voffA); PG8_STAGE(PG8_SB(1, 1), cB + hstep + kstep, voffB);
        PG8_WAIT_V(6); PG8_BAR;
    } else {
        PG8_STAGE(PG8_SB(0, 0), cB, voffB); PG8_STAGE(PG8_SA(0, 0), cA, voffA); PG8_STAGE(PG8_SB(0, 1), cB + hstep, voffB); PG8_STAGE(PG8_SA(0, 1), cA + hstep, voffA);
        if (wr == 1) PG8_BAR;
        PG8_WAIT_V(4); PG8_BAR;
        PG8_STAGE(PG8_SB(1, 0), cB + kstep, voffB); PG8_STAGE(PG8_SA(1, 0), cA + kstep, voffA); PG8_STAGE(PG8_SB(1, 1), cB + hstep + kstep, voffB);
        PG8_WAIT_V(6); PG8_BAR;
    }
    for (;;) {
        const bool has_next = S.next(ui + 1, nxt);
        const char* nA = has_next ? (const char*)g.A + (size_t)nxt.pm * tstep : cA; const char* nB = has_next ? (const char*)g.Bt + (size_t)nxt.pn * tstep : cB;
        for (int t = 0; t < nt; t += 2) {
            const bool last = (t == nt - 2);
            const char* a1 = cA + (size_t)(t + 1) * kstep;
            const char* a2 = last ? nA : cA + (size_t)(t + 2) * kstep; const char* b2 = last ? nB : cB + (size_t)(t + 2) * kstep;
            const char* a3 = a2 + kstep; const char* b3 = b2 + kstep;
            if (last && has_next) S.a_ready(nxt);
            if constexpr (SP2) {
            PG8_LDB(B0, 0, 0); PG8_LDB(B1, 0, 1); PG8_SCHED; PG8_LDA(At, 0, 0); PG8_STAGE(PG8_SA(1, 1), a1 + hstep, voffA);
            PG8_WAIT_V(8); PG8_WAIT_L(0); PG8_BAR; PG8_MMA(0, 0, At, B0); PG8_MMA(0, 1, At, B1); PG8_BAR; PG8_SCHED;
            PG8_LDA(At, 0, 1); PG8_STAGE(PG8_SB(0, 0), b2, voffB); PG8_STAGE(PG8_SB(0, 1), b2 + hstep, voffB); PG8_STAGE(PG8_SA(0, 0), a2, voffA);
            PG8_WAIT_V(8); PG8_WAIT_L(0); PG8_BAR; PG8_MMA(1, 0, At, B0); PG8_MMA(1, 1, At, B1); PG8_BAR; PG8_SCHED;
            PG8_LDB(B0, 1, 0); PG8_LDB(B1, 1, 1); PG8_SCHED; PG8_LDA(At, 1, 0); PG8_STAGE(PG8_SA(0, 1), a2 + hstep, voffA);
            PG8_WAIT_V(8); PG8_WAIT_L(0); PG8_BAR; PG8_MMA(0, 0, At, B0); PG8_MMA(0, 1, At, B1); PG8_BAR; PG8_SCHED;
            PG8_LDA(At, 1, 1); PG8_STAGE(PG8_SB(1, 0), b3, voffB); PG8_STAGE(PG8_SB(1, 1), b3 + hstep, voffB); PG8_STAGE(PG8_SA(1, 0), a3, voffA);
            PG8_WAIT_V(8); PG8_WAIT_L(0); PG8_BAR; PG8_MMA(1, 0, At, B0); PG8_MMA(1, 1, At, B1); PG8_BAR; PG8_SCHED;
            } else {
            PG8_LDB(B0, 0, 0); PG8_SCHED; PG8_LDA(At, 0, 0); PG8_STAGE(PG8_SA(1, 1), a1 + hstep, voffA);
            PG8_WAIT_L(8); PG8_BAR; PG8_WAIT_L(0); PG8_MMA(0, 0, At, B0); PG8_BAR; PG8_SCHED;
            PG8_LDB(B1, 0, 1); PG8_STAGE(PG8_SB(0, 0), b2, voffB);
            PG8_BAR; PG8_WAIT_L(0); PG8_MMA(0, 1, At, B1); PG8_BAR;
            PG8_LDA(At, 0, 1); PG8_STAGE(PG8_SA(0, 0), a2, voffA);
            PG8_BAR; PG8_WAIT_L(0); PG8_MMA(1, 0, At, B0); PG8_BAR; PG8_SCHED;
            PG8_STAGE(PG8_SB(0, 1), b2 + hstep, voffB);
            PG8_WAIT_V(6); PG8_BAR; PG8_MMA(1, 1, At, B1); PG8_BAR;
            PG8_LDB(B0, 1, 0); PG8_SCHED; PG8_LDA(At, 1, 0); PG8_STAGE(PG8_SA(0, 1), a2 + hstep, voffA);
            PG8_WAIT_L(8); PG8_BAR; PG8_WAIT_L(0); PG8_MMA(0, 0, At, B0); PG8_BAR; PG8_SCHED;
            PG8_LDB(B1, 1, 1); PG8_STAGE(PG8_SB(1, 0), b3, voffB);
            PG8_BAR; PG8_WAIT_L(0); PG8_MMA(0, 1, At, B1); PG8_BAR;
            PG8_LDA(At, 1, 1); PG8_STAGE(PG8_SA(1, 0), a3, voffA);
            PG8_BAR; PG8_WAIT_L(0); PG8_MMA(1, 0, At, B0); PG8_BAR; PG8_SCHED;
            PG8_STAGE(PG8_SB(1, 1), b3 + hstep, voffB);
            PG8_WAIT_V(6); PG8_BAR; PG8_MMA(1, 1, At, B1); PG8_BAR;
            }
        }
        if constexpr (ALIGN_EPI) { if (wr == 0) PG8_BAR; }
        if constexpr (!Epi::AFTER_DRAIN) { E(acc, cur, wr, wc, fr, fq); S.done(cur); }
        if (!has_next) break;
#pragma unroll
        for (int a = 0; a < 2; ++a)
#pragma unroll
            for (int b = 0; b < 2; ++b)
#pragma unroll
                for (int m = 0; m < 4; ++m)
#pragma unroll
                    for (int n = 0; n < 2; ++n) acc[a][b][m][n] = (f32x4){0.f, 0.f, 0.f, 0.f};
        cur = nxt; cA = nA; cB = nB; ++ui;
        if constexpr (ALIGN_EPI) { if (wr == 1) PG8_BAR; }
    }
    PG8_WAIT_V(0);
    if constexpr (!ALIGN_EPI) { if (wr == 0) PG8_BAR; }
    PG8_BAR;
    if constexpr (Epi::AFTER_DRAIN) { E.fused(acc, cur, wr, wc, fr, fq, lds, wid, lane); S.done(cur); }
#undef PG8_SA
#undef PG8_SB
#undef PG8_STAGE
#undef PG8_LDA
#undef PG8_LDB
#undef PG8_MMA
#undef PG8_WAIT_V
#undef PG8_WAIT_L
#undef PG8_BAR
#undef PG8_SCHED
}

template <class Epi, class Sched, bool ALIGN_EPI = false>
__device__ __forceinline__ void gemm_phase_gather(PG8_LAS unsigned char* lds, const Gemm g, const Sched& S, const Epi& E, const int* rowtok) {
    constexpr bool SP2 = true;
    int tid_ = threadIdx.x; asm volatile("" : "+v"(tid_));
    const int tid = tid_, wid = __builtin_amdgcn_readfirstlane(tid >> 6), lane = tid & 63, wr = wid >> 2, wc = wid & 3, fr = lane & 15, fq = lane >> 4;
    const int K = g.K, nt = K / BK;
    unsigned voffB[2]; unsigned vcur[2][2], vnxt[2][2]; int RA[2], CA[2]; const unsigned voffA[2] = {0u, 0u};
#pragma unroll
    for (int i = 0; i < 2; ++i) { int R, C; stage_rc(tid * 16 + i * 8192, R, C); const int Rb = Epi::PERM ? ((R & ~31) + perm32(R & 31)) : R;
        RA[i] = R; CA[i] = C; voffB[i] = (unsigned)(Rb * K + C) * 2u; }
#define PG8_GMAP(dst, pm_) do { _Pragma("unroll") for (int h_ = 0; h_ < 2; ++h_) _Pragma("unroll") for (int i_ = 0; i_ < 2; ++i_) { int tk_ = rowtok[4 * ((pm_) * BM + h_ * HALF + RA[i_])]; tk_ = tk_ < 0 ? 0 : tk_; dst[h_][i_] = (unsigned)(tk_ * K + CA[i_]) * 2u; } } while (0)
    const size_t kstep = (size_t)(BK * 2);
    const size_t hstep = (size_t)HALF * K * 2;
    const size_t tstep = 2 * hstep;
    const unsigned ldsw = (unsigned)wid * 1024u;
    const int aoff = lds_byte(wr * 64 + fr, fq * 8), boff = lds_byte(wc * 32 + fr, fq * 8);
#define PG8_SA(b, h) (((b) * 2 + (h)) * HTB)
#define PG8_SB(b, h) ((4 + (b) * 2 + (h)) * HTB)
#define PG8_STAGE(bufoff, gbase, voff) do { _Pragma("unroll") for (int _i = 0; _i < 2; ++_i) \
        __builtin_amdgcn_global_load_lds((const unsigned*)((const char*)(gbase) + (voff)[_i]), (PG8_LAS unsigned*)(lds + (bufoff) + ldsw + _i * 8192), 16, 0, 0); } while (0)
#define PG8_LDA(dst, b, h) do { _Pragma("unroll") for (int m = 0; m < 4; ++m) _Pragma("unroll") for (int k = 0; k < 2; ++k) dst[m][k] = *(const PG8_LAS bf16x8*)(lds + PG8_SA(b, h) + aoff + m * 2048 + k * 1024); } while (0)
#define PG8_LDB(dst, b, h) do { _Pragma("unroll") for (int n = 0; n < 2; ++n) _Pragma("unroll") for (int k = 0; k < 2; ++k) dst[n][k] = *(const PG8_LAS bf16x8*)(lds + PG8_SB(b, h) + boff + n * 2048 + k * 1024); } while (0)
#define PG8_MMA(ai, bj, At, Bt) do { __builtin_amdgcn_s_setprio(1); _Pragma("unroll") for (int m = 0; m < 4; ++m) _Pragma("unroll") for (int n = 0; n < 2; ++n) _Pragma("unroll") for (int k = 0; k < 2; ++k) \
        acc[ai][bj][m][n] = __builtin_amdgcn_mfma_f32_16x16x32_bf16(Bt[n][k], At[m][k], acc[ai][bj][m][n], 0, 0, 0); __builtin_amdgcn_s_setprio(0); } while (0)
#define PG8_WAIT_V(n) asm volatile("s_waitcnt vmcnt(" #n ")" ::: "memory")
#define PG8_WAIT_L(n) asm volatile("s_waitcnt lgkmcnt(" #n ")" ::: "memory")
#define PG8_BAR __builtin_amdgcn_s_barrier()
#define PG8_SCHED __builtin_amdgcn_sched_barrier(0)
    Unit cur, nxt; int ui = 0;
    if (!S.next(0, cur)) return;
    f32x4 acc[2][2][4][2];
#pragma unroll
    for (int a = 0; a < 2; ++a)
#pragma unroll
        for (int b = 0; b < 2; ++b)
#pragma unroll
            for (int m = 0; m < 4; ++m)
#pragma unroll
                for (int n = 0; n < 2; ++n) acc[a][b][m][n] = (f32x4){0.f, 0.f, 0.f, 0.f};
    bf16x8 At[4][2], B0[2][2], B1[2][2];
    const char* cA = (const char*)g.A; const char* cB = (const char*)g.Bt + (size_t)cur.pn * tstep;
    PG8_GMAP(vcur, cur.pm);
    S.a_ready(cur);
    if constexpr (SP2) {
        PG8_STAGE(PG8_SB(0, 0), cB, voffB); PG8_STAGE(PG8_SB(0, 1), cB + hstep, voffB); PG8_STAGE(PG8_SA(0, 0), cA, vcur[0]); PG8_STAGE(PG8_SA(0, 1), cA, vcur[1]);
        if (wr == 1) PG8_BAR;
        PG8_WAIT_V(2); PG8_BAR;
        PG8_STAGE(PG8_SB(1, 0), cB + kstep, voffB); PG8_STAGE(PG8_SA(1, 0), cA + kstep, vcur[0]); PG8_STAGE(PG8_SB(1, 1), cB + hstep + kstep, voffB);
        PG8_WAIT_V(6); PG8_BAR;
    } else {
        PG8_STAGE(PG8_SB(0, 0), cB, voffB); PG8_STAGE(PG8_SA(0, 0), cA, voffA); PG8_STAGE(PG8_SB(0, 1), cB + hstep, voffB); PG8_STAGE(PG8_SA(0, 1), cA + hstep, voffA);
        if (wr == 1) PG8_BAR;
        PG8_WAIT_V(4); PG8_BAR;
        PG8_STAGE(PG8_SB(1, 0), cB + kstep, voffB); PG8_STAGE(PG8_SA(1, 0), cA + kstep, voffA); PG8_STAGE(PG8_SB(1, 1), cB + hstep + kstep, voffB);
        PG8_WAIT_V(6); PG8_BAR;
    }
    for (;;) {
        const bool has_next = S.next(ui + 1, nxt);
        const char* nA = cA; const char* nB = has_next ? (const char*)g.Bt + (size_t)nxt.pn * tstep : cB;
        if (has_next) PG8_GMAP(vnxt, nxt.pm); else { vnxt[0][0] = vcur[0][0]; vnxt[0][1] = vcur[0][1]; vnxt[1][0] = vcur[1][0]; vnxt[1][1] = vcur[1][1]; }
        for (int t = 0; t < nt; t += 2) {
            const bool last = (t == nt - 2);
            const char* a1 = cA + (size_t)(t + 1) * kstep;
            const char* a2 = last ? nA : cA + (size_t)(t + 2) * kstep; unsigned v2[2][2]; v2[0][0] = last ? vnxt[0][0] : vcur[0][0]; v2[0][1] = last ? vnxt[0][1] : vcur[0][1]; v2[1][0] = last ? vnxt[1][0] : vcur[1][0]; v2[1][1] = last ? vnxt[1][1] : vcur[1][1]; const char* b2 = last ? nB : cB + (size_t)(t + 2) * kstep;
            const char* a3 = a2 + kstep; const char* b3 = b2 + kstep;
            if (last && has_next) S.a_ready(nxt);
            if constexpr (SP2) {
            PG8_LDB(B0, 0, 0); PG8_LDB(B1, 0, 1); PG8_SCHED; PG8_LDA(At, 0, 0); PG8_STAGE(PG8_SA(1, 1), a1, vcur[1]);
            PG8_WAIT_V(8); PG8_WAIT_L(0); PG8_BAR; PG8_MMA(0, 0, At, B0); PG8_MMA(0, 1, At, B1); PG8_BAR; PG8_SCHED;
            PG8_LDA(At, 0, 1); PG8_STAGE(PG8_SB(0, 0), b2, voffB); PG8_STAGE(PG8_SB(0, 1), b2 + hstep, voffB); PG8_STAGE(PG8_SA(0, 0), a2, v2[0]);
            PG8_WAIT_V(8); PG8_WAIT_L(0); PG8_BAR; PG8_MMA(1, 0, At, B0); PG8_MMA(1, 1, At, B1); PG8_BAR; PG8_SCHED;
            PG8_LDB(B0, 1, 0); PG8_LDB(B1, 1, 1); PG8_SCHED; PG8_LDA(At, 1, 0); PG8_STAGE(PG8_SA(0, 1), a2, v2[1]);
            PG8_WAIT_V(8); PG8_WAIT_L(0); PG8_BAR; PG8_MMA(0, 0, At, B0); PG8_MMA(0, 1, At, B1); PG8_BAR; PG8_SCHED;
            PG8_LDA(At, 1, 1); PG8_STAGE(PG8_SB(1, 0), b3, voffB); PG8_STAGE(PG8_SB(1, 1), b3 + hstep, voffB); PG8_STAGE(PG8_SA(1, 0), a3, v2[0]);
            PG8_WAIT_V(8); PG8_WAIT_L(0); PG8_BAR; PG8_MMA(1, 0, At, B0); PG8_MMA(1, 1, At, B1); PG8_BAR; PG8_SCHED;
            } else {
            PG8_LDB(B0, 0, 0); PG8_SCHED; PG8_LDA(At, 0, 0); PG8_STAGE(PG8_SA(1, 1), a1 + hstep, voffA);
            PG8_WAIT_L(8); PG8_BAR; PG8_WAIT_L(0); PG8_MMA(0, 0, At, B0); PG8_BAR; PG8_SCHED;
            PG8_LDB(B1, 0, 1); PG8_STAGE(PG8_SB(0, 0), b2, voffB);
            PG8_BAR; PG8_WAIT_L(0); PG8_MMA(0, 1, At, B1); PG8_BAR;
            PG8_LDA(At, 0, 1); PG8_STAGE(PG8_SA(0, 0), a2, voffA);
            PG8_BAR; PG8_WAIT_L(0); PG8_MMA(1, 0, At, B0); PG8_BAR; PG8_SCHED;
            PG8_STAGE(PG8_SB(0, 1), b2 + hstep, voffB);
            PG8_WAIT_V(6); PG8_BAR; PG8_MMA(1, 1, At, B1); PG8_BAR;
            PG8_LDB(B0, 1, 0); PG8_SCHED; PG8_LDA(At, 1, 0); PG8_STAGE(PG8_SA(0, 1), a2 + hstep, voffA);
            PG8_WAIT_L(8); PG8_BAR; PG8_WAIT_L(0); PG8_MMA(0, 0, At, B0); PG8_BAR; PG8_SCHED;
            PG8_LDB(B1, 1, 1); PG8_STAGE(PG8_SB(1, 0), b3, voffB);
            PG8_BAR; PG8_WAIT_L(0); PG8_MMA(0, 1, At, B1); PG8_BAR;
            PG8_LDA(At, 1, 1); PG8_STAGE(PG8_SA(1, 0), a3, voffA);
            PG8_BAR; PG8_WAIT_L(0); PG8_MMA(1, 0, At, B0); PG8_BAR; PG8_SCHED;
            PG8_STAGE(PG8_SB(1, 1), b3 + hstep, voffB);
            PG8_WAIT_V(6); PG8_BAR; PG8_MMA(1, 1, At, B1); PG8_BAR;
            }
        }
        if constexpr (ALIGN_EPI) { if (wr == 0) PG8_BAR; }
        if constexpr (!Epi::AFTER_DRAIN) { E(acc, cur, wr, wc, fr, fq); S.done(cur); }
        if (!has_next) break;
#pragma unroll
        for (int a = 0; a < 2; ++a)
#pragma unroll
            for (int b = 0; b < 2; ++b)
#pragma unroll
                for (int m = 0; m < 4; ++m)
#pragma unroll
                    for (int n = 0; n < 2; ++n) acc[a][b][m][n] = (f32x4){0.f, 0.f, 0.f, 0.f};
        cur = nxt; cA = nA; cB = nB; ++ui; vcur[0][0] = vnxt[0][0]; vcur[0][1] = vnxt[0][1]; vcur[1][0] = vnxt[1][0]; vcur[1][1] = vnxt[1][1];
        if constexpr (ALIGN_EPI) { if (wr == 1) PG8_BAR; }
    }
    PG8_WAIT_V(0);
    if constexpr (!ALIGN_EPI) { if (wr == 0) PG8_BAR; }
    PG8_BAR;
    if constexpr (Epi::AFTER_DRAIN) { E.fused(acc, cur, wr, wc, fr, fq, lds, wid, lane); S.done(cur); }
#undef PG8_GMAP
#undef PG8_SA
#undef PG8_SB
#undef PG8_STAGE
#undef PG8_LDA
#undef PG8_LDB
#undef PG8_MMA
#undef PG8_WAIT_V
#undef PG8_WAIT_L
#undef PG8_BAR
#undef PG8_SCHED
}

}

#define DI __device__ __forceinline__
#define LAS __attribute__((address_space(3)))
typedef unsigned short bf16_t;
typedef short bf16x8 __attribute__((ext_vector_type(8)));
typedef _Float16 f16x8 __attribute__((ext_vector_type(8)));
typedef float f32x4 __attribute__((ext_vector_type(4)));
typedef float f32x16 __attribute__((ext_vector_type(16)));
typedef unsigned u32x4 __attribute__((ext_vector_type(4)));
typedef unsigned u32x2 __attribute__((ext_vector_type(2)));

constexpr int NB = 4, SEQ = 4096, T = NB * SEQ, D = 1024, DEPTH = 2;
constexpr int PLD = 3912;
constexpr int PC_Q = 0, PC_K = 512, PC_V = 1024, PC_QI = 1536, PC_KI = 2048, PC_WI = 2112;
constexpr int PC_R = 2120, PC_BK = 2632, PC_BV = 3144, PC_WD = 3656;
constexpr int NPROJ_PAD = 4096;
constexpr int NEXP = 16, DEXP = 256, PLE = 256;
constexpr float ALPHA = 1.4142135623730951f;
constexpr float LN_EPS = 1e-5f, GN_EPS = 64e-5f;
constexpr int MAXROWS = 2 * T + NEXP * 256;
constexpr int NWAVES = 8, NTHR = 512;

constexpr size_t MiB = 1u << 20;
constexpr size_t WS_CTL = 0, CTL_BYTES = 1 * MiB;
constexpr size_t WS_WEXP = 1 * MiB;
constexpr size_t WS_WDOWN = 17 * MiB;
constexpr size_t WS_WOUT = 25 * MiB, WS_WPG = 27 * MiB, WS_WPLE = 29 * MiB;
constexpr size_t WS_BM = 30 * MiB;
constexpr size_t WS_ELL = 38 * MiB, WS_AA = 70 * MiB, WS_GG = 102 * MiB;
constexpr size_t WS_PROJ = 119 * MiB;
constexpr size_t WS_PBF = 242 * MiB;
constexpr size_t WS_V = 119 * MiB;
constexpr size_t WS_AG = 38 * MiB;
constexpr size_t WS_H = 183 * MiB;
constexpr size_t WS_Y = 119 * MiB;
constexpr size_t WS_PE = 201 * MiB;
constexpr size_t WS_V3 = 38 * MiB;
constexpr size_t WS_TOK = 233 * MiB;
constexpr size_t WS_ROW = 234 * MiB;
constexpr int CW_GCNT = 1024;

struct TokInfo { int e0, e1, p0, p1; float g0, g1; int pad0, pad1; };
struct RowInfo { int token, slot; float gate; int pad; };

#define LDS_WAIT() asm volatile("s_waitcnt lgkmcnt(0)" ::: "memory")
#define VM_WAIT() asm volatile("s_waitcnt vmcnt(0)" ::: "memory")
DI unsigned f2bf(float f) { unsigned u = __builtin_bit_cast(unsigned, f); return (u + 0x7fffu + ((u >> 16) & 1u)) >> 16; }
DI unsigned pk2(float lo, float hi) { return pg8::cvt_pk_bf16(lo, hi); }
DI float bf2f(unsigned short b) { return __builtin_bit_cast(float, (unsigned)b << 16); }
DI float bflo(unsigned w) { return __builtin_bit_cast(float, w << 16); }
DI float bfhi(unsigned w) { return __builtin_bit_cast(float, w & 0xffff0000u); }
DI unsigned pk2h(float lo, float hi) { typedef _Float16 h2_t __attribute__((ext_vector_type(2))); h2_t v = {(_Float16)lo, (_Float16)hi}; return __builtin_bit_cast(unsigned, v); }
DI float wave_sum(float v) {
#pragma unroll
    for (int o = 1; o < 64; o <<= 1) v += __shfl_xor(v, o);
    return v;
}
DI int opaque_i(int v) { asm volatile("" : "+s"(v)); return v; }
DI float sigmoidf_(float x) { return 1.f / (1.f + __expf(-x)); }

struct Args { const float* in[31]; float* out; unsigned char* ws; int ph_lo, ph_hi; };
struct Ctx {
    LAS unsigned char* lds;
    int tid, lane, wave, G, blk;
    const __attribute__((address_space(4))) Args* ap;
    float* out; unsigned char* ws;
    unsigned* ctl;
    bf16_t* xcur; bf16_t* mixcat;
    DI const float* in(int i) const { return ap->in[i]; }
};

DI void ln16(f32x4 (&v)[4], const float* g, const float* b, int lane) {
    float s = 0.f;
#pragma unroll
    for (int j = 0; j < 4; ++j) s += (v[j].x + v[j].y) + (v[j].z + v[j].w);
    const float mean = wave_sum(s) * (1.f / D);
    float s2 = 0.f;
#pragma unroll
    for (int j = 0; j < 4; ++j) { v[j] = v[j] - mean; s2 += (v[j].x * v[j].x + v[j].y * v[j].y) + (v[j].z * v[j].z + v[j].w * v[j].w); }
    const float rstd = 1.f / sqrtf(wave_sum(s2) * (1.f / D) + LN_EPS);
#pragma unroll
    for (int j = 0; j < 4; ++j) { const f32x4 gg = *(const f32x4*)(g + 256 * j + 4 * lane), bb = *(const f32x4*)(b + 256 * j + 4 * lane); v[j] = v[j] * rstd * gg + bb; }
}
DI void store_row_bf16(bf16_t* row, const f32x4 (&v)[4], int lane) {
#pragma unroll
    for (int j = 0; j < 4; ++j) { u32x2 o; o.x = pk2(v[j].x, v[j].y); o.y = pk2(v[j].z, v[j].w); *(u32x2*)(row + 256 * j + 4 * lane) = o; }
}
DI void load_row_bf16(const bf16_t* row, f32x4 (&v)[4], int lane) {
#pragma unroll
    for (int j = 0; j < 4; ++j) { const u32x2 o = *(const u32x2*)(row + 256 * j + 4 * lane); v[j] = (f32x4){bflo(o.x), bfhi(o.x), bflo(o.y), bfhi(o.y)}; }
}

template <class ColPtr>
DI void transpose_item(const ColPtr colptr, int ld, int K, bf16_t* WT, int n0, int k0, LAS float* scr, int lane) {
    const float* sp = colptr(n0 + (lane & 31));
    float tv[32];
#pragma unroll
    for (int i = 0; i < 32; ++i) { const int kk = 2 * i + (lane >> 5); tv[i] = sp ? sp[(size_t)(k0 + kk) * ld] : 0.f; }
#pragma unroll
    for (int i = 0; i < 32; ++i) { const int kk = 2 * i + (lane >> 5); scr[kk * 33 + (lane & 31)] = tv[i]; }
    LDS_WAIT(); asm volatile("" ::: "memory");
    const int c = lane & 7;
#pragma unroll
    for (int j = 0; j < 4; ++j) { const int n = (lane >> 3) + 8 * j; const LAS float* s = scr + (8 * c) * 33 + n;
        u32x4 o; o.x = pk2(s[0 * 33], s[1 * 33]); o.y = pk2(s[2 * 33], s[3 * 33]); o.z = pk2(s[4 * 33], s[5 * 33]); o.w = pk2(s[6 * 33], s[7 * 33]);
        *(u32x4*)(WT + (size_t)(n0 + n) * K + k0 + 8 * c) = o; }
    LDS_WAIT(); asm volatile("" ::: "memory");
}
template <class ColPtr>
DI void convert_matrix(Ctx& C, const ColPtr colptr, int ld, int K, int N, bf16_t* WT, int& first) {
    LAS float* scr = (LAS float*)(C.lds + C.wave * 16384);
    const int gw = C.blk * NWAVES + C.wave, NGW = C.G * NWAVES;
    const int nblk = N / 32, nitems = (K / 64) * nblk;
    int it = gw - (first % NGW); if (it < 0) it += NGW;
    for (; it < nitems; it += NGW) transpose_item(colptr, ld, K, WT, 32 * (it % nblk), 64 * (it / nblk), scr, C.lane);
    first += nitems;
}

struct ColWin { const float* w; DI const float* operator()(int j) const { if (j < 2120) return w + j; if (j >= 2176 && j < 3968) return w + (j - 56); return nullptr; } };
struct ColPlain { const float* w; DI const float* operator()(int j) const { return w + j; } };
struct ColGateUp { const float* wg; const float* wu; DI const float* operator()(int j) const {
        const int e = j >> 9, pn = (j >> 8) & 1, jj = j & 255; const int col = pn * 128 + (jj & 127); const uintptr_t pg = (uintptr_t)wg, pu = (uintptr_t)wu; const uintptr_t sel = pg + ((jj >= 128) ? (pu - pg) : (uintptr_t)0); return (const float*)sel + (size_t)e * D * DEXP + col; } };
struct ColDown { const float* wd; DI const float* operator()(int j) const { return wd + j; } };

DI void phase_ln_in(Ctx& C) {
    const int gw = C.blk * NWAVES + C.wave, NGW = C.G * NWAVES;
    for (int m = gw; m < T; m += NGW) {
        f32x4 v[4]; const float* xr = C.in(0) + (size_t)m * D;
#pragma unroll
        for (int j = 0; j < 4; ++j) v[j] = *(const f32x4*)(xr + 256 * j + 4 * C.lane);
        ln16(v, C.in(2), C.in(3), C.lane);
        store_row_bf16(C.xcur + (size_t)m * D, v, C.lane);
    }
}
DI void convert_win(Ctx& C, int l) { int first = 0; ColWin cw{C.in(4) + (size_t)l * D * 3912}; convert_matrix(C, cw, 3912, D, NPROJ_PAD, (bf16_t*)(C.ws + WS_WEXP), first); }
DI void convert_layer_weights(Ctx& C, int l) {
    int first = 0;
    { ColPlain c{C.in(5) + (size_t)l * D * D}; convert_matrix(C, c, D, D, D, (bf16_t*)(C.ws + WS_WOUT), first); }
    { ColGateUp c{C.in(20) + (size_t)l * NEXP * D * DEXP, C.in(21) + (size_t)l * NEXP * D * DEXP}; convert_matrix(C, c, DEXP, D, NEXP * 512, (bf16_t*)(C.ws + WS_WEXP), first); }
    for (int e = 0; e < NEXP; ++e) { ColDown c{C.in(22) + ((size_t)l * NEXP + e) * DEXP * D}; convert_matrix(C, c, D, DEXP, D, (bf16_t*)(C.ws + WS_WDOWN) + (size_t)e * D * DEXP, first); }
    { ColPlain c{C.in(24) + (size_t)l * D * D}; convert_matrix(C, c, D, D, D, (bf16_t*)(C.ws + WS_WPG), first); }
    { ColPlain c{C.in(23) + (size_t)l * PLE * D}; convert_matrix(C, c, D, PLE, D, (bf16_t*)(C.ws + WS_WPLE), first); }
    const float* p = C.in(1) + (size_t)l * T * PLE; bf16_t* pb = (bf16_t*)(C.ws + WS_PBF);
    for (size_t i = ((size_t)C.blk * NTHR + C.tid) * 8; i < (size_t)T * PLE; i += (size_t)C.G * NTHR * 8) {
        const f32x4 a = *(const f32x4*)(p + i), b = *(const f32x4*)(p + i + 4);
        u32x4 o; o.x = pk2(a.x, a.y); o.y = pk2(a.z, a.w); o.z = pk2(b.x, b.y); o.w = pk2(b.z, b.w); *(u32x4*)(pb + i) = o; }
}

struct EpiProj {
    static constexpr bool PERM = true, AFTER_DRAIN = false;
    bf16_t* P;
    DI void operator()(const f32x4 (&acc)[2][2][4][2], const pg8::Unit& u, int wr, int wc, int fr, int fq) const {
        const int row0 = u.pm * 256 + wr * 64 + fr;
#pragma unroll
        for (int bj = 0; bj < 2; ++bj) {
            const int j0 = u.pn * 256 + bj * 128 + wc * 32 + 8 * fq;
            int dst; bool half = false;
            if (j0 < 2120) { dst = j0; half = (j0 >= 1536); } else if (j0 >= 2176 && j0 < 3968) dst = j0 - 56; else dst = -1;
            if (dst >= 0) {
#pragma unroll
                for (int ai = 0; ai < 2; ++ai)
#pragma unroll
                    for (int m = 0; m < 4; ++m) {
                        const f32x4 v0 = acc[ai][bj][m][0], v1 = acc[ai][bj][m][1]; u32x4 w;
                        if (half) { w.x = pk2h(v0[0], v0[1]); w.y = pk2h(v0[2], v0[3]); w.z = pk2h(v1[0], v1[1]); w.w = pk2h(v1[2], v1[3]); }
                        else { w.x = pk2(v0[0], v0[1]); w.y = pk2(v0[2], v0[3]); w.z = pk2(v1[0], v1[1]); w.w = pk2(v1[2], v1[3]); }
                        *(u32x4*)(P + (size_t)(row0 + ai * 128 + m * 16) * PLD + dst) = w; }
            }
        }
    }
};
struct EpiBf16Plain {
    static constexpr bool PERM = true, AFTER_DRAIN = false;
    bf16_t* O; int ldc;
    DI void operator()(const f32x4 (&acc)[2][2][4][2], const pg8::Unit& u, int wr, int wc, int fr, int fq) const {
        const int row0 = u.pm * 256 + wr * 64 + fr, col0 = u.pn * 256 + wc * 32 + 8 * fq;
#pragma unroll
        for (int ai = 0; ai < 2; ++ai)
#pragma unroll
            for (int m = 0; m < 4; ++m)
#pragma unroll
                for (int bj = 0; bj < 2; ++bj) { const f32x4 v0 = acc[ai][bj][m][0], v1 = acc[ai][bj][m][1]; u32x4 w; w.x = pk2(v0[0], v0[1]); w.y = pk2(v0[2], v0[3]); w.z = pk2(v1[0], v1[1]); w.w = pk2(v1[2], v1[3]);
                    *(u32x4*)(O + (size_t)(row0 + ai * 128 + m * 16) * ldc + col0 + bj * 128) = w; }
    }
};
struct EpiResF32 {
    static constexpr bool PERM = false, AFTER_DRAIN = false;
    const bf16_t* X; bf16_t* V;
    DI void operator()(const f32x4 (&acc)[2][2][4][2], const pg8::Unit& u, int wr, int wc, int fr, int fq) const {
        const int row0 = u.pm * 256 + wr * 64 + fr, col0 = u.pn * 256 + wc * 32 + 4 * fq;
#pragma unroll
        for (int ai = 0; ai < 2; ++ai)
#pragma unroll
            for (int m = 0; m < 4; ++m)
#pragma unroll
                for (int bj = 0; bj < 2; ++bj)
#pragma unroll
                    for (int n = 0; n < 2; ++n) { const size_t off = (size_t)(row0 + ai * 128 + m * 16) * D + col0 + bj * 128 + n * 16;
                        const u32x2 xb = *(const u32x2*)(X + off); const f32x4 xv = {bflo(xb.x), bfhi(xb.x), bflo(xb.y), bfhi(xb.y)};
                        const f32x4 o = xv * ALPHA + acc[ai][bj][m][n]; u32x2 ob; ob.x = pk2(o.x, o.y); ob.y = pk2(o.z, o.w); *(u32x2*)(V + off) = ob; }
    }
};
struct EpiPle {
    static constexpr bool PERM = false, AFTER_DRAIN = false;
    const bf16_t* X; const bf16_t* PE; bf16_t* V;
    DI void operator()(const f32x4 (&acc)[2][2][4][2], const pg8::Unit& u, int wr, int wc, int fr, int fq) const {
        const int row0 = u.pm * 256 + wr * 64 + fr, col0 = u.pn * 256 + wc * 32 + 4 * fq;
#pragma unroll
        for (int ai = 0; ai < 2; ++ai)
#pragma unroll
            for (int m = 0; m < 4; ++m)
#pragma unroll
                for (int bj = 0; bj < 2; ++bj)
#pragma unroll
                    for (int n = 0; n < 2; ++n) { const size_t off = (size_t)(row0 + ai * 128 + m * 16) * D + col0 + bj * 128 + n * 16;
                        const u32x2 xb = *(const u32x2*)(X + off); const f32x4 xv = {bflo(xb.x), bfhi(xb.x), bflo(xb.y), bfhi(xb.y)};
                        const u32x2 pb = *(const u32x2*)(PE + off); const f32x4 pv = {bflo(pb.x), bfhi(pb.x), bflo(pb.y), bfhi(pb.y)};
                        const f32x4 a = acc[ai][bj][m][n]; f32x4 s; s.x = sigmoidf_(a.x); s.y = sigmoidf_(a.y); s.z = sigmoidf_(a.z); s.w = sigmoidf_(a.w);
                        const f32x4 o = xv * ALPHA + s * pv; u32x2 ob; ob.x = pk2(o.x, o.y); ob.y = pk2(o.z, o.w); *(u32x2*)(V + off) = ob; }
    }
};
struct EpiSwiGLU {
    static constexpr bool PERM = true, AFTER_DRAIN = false;
    bf16_t* H; const RowInfo* R;
    DI void operator()(const f32x4 (&acc)[2][2][4][2], const pg8::Unit& u, int wr, int wc, int fr, int fq) const {
        const int row0 = u.pm * 256 + wr * 64 + fr, col0 = (u.pn & 1) * 128 + wc * 32 + 8 * fq;
#pragma unroll
        for (int ai = 0; ai < 2; ++ai)
#pragma unroll
            for (int m = 0; m < 4; ++m) { const int row = row0 + ai * 128 + m * 16; const float gw = R[row].gate;
                float h[8];
#pragma unroll
                for (int n = 0; n < 2; ++n)
#pragma unroll
                    for (int i = 0; i < 4; ++i) { const float g = acc[ai][0][m][n][i], up = acc[ai][1][m][n][i]; h[4 * n + i] = g * sigmoidf_(g) * up * gw; }
                u32x4 w; w.x = pk2(h[0], h[1]); w.y = pk2(h[2], h[3]); w.z = pk2(h[4], h[5]); w.w = pk2(h[6], h[7]);
                *(u32x4*)(H + (size_t)row * DEXP + col0) = w; }
    }
};
struct EpiDown {
    static constexpr bool PERM = true, AFTER_DRAIN = false;
    bf16_t* Y; const RowInfo* R;
    DI void operator()(const f32x4 (&acc)[2][2][4][2], const pg8::Unit& u, int wr, int wc, int fr, int fq) const {
        const int row0 = u.pm * 256 + wr * 64 + fr, col0 = (u.pn & 3) * 256 + wc * 32 + 8 * fq;
#pragma unroll
        for (int ai = 0; ai < 2; ++ai)
#pragma unroll
            for (int m = 0; m < 4; ++m) { const int row = row0 + ai * 128 + m * 16; const RowInfo ri = R[row];
                if (ri.token >= 0) { bf16_t* dst = Y + ((size_t)ri.slot * T + ri.token) * D + col0;
#pragma unroll
                    for (int bj = 0; bj < 2; ++bj) { const f32x4 v0 = acc[ai][bj][m][0], v1 = acc[ai][bj][m][1]; u32x4 w; w.x = pk2(v0[0], v0[1]); w.y = pk2(v0[2], v0[3]); w.z = pk2(v1[0], v1[1]); w.w = pk2(v1[2], v1[3]);
                        *(u32x4*)(dst + bj * 128) = w; } } }
    }
};
template <int NPN> struct GroupedOrder {
    const LAS int* texp; int ntiles, G, c;
    DI bool next(int i, pg8::Unit& u) const { const int L = i * G + c; if (L >= ntiles * NPN) return false; u.pm = L / NPN; u.pn = texp[u.pm] * NPN + (L % NPN); return true; }
    DI void a_ready(const pg8::Unit&) const {}
    DI void done(const pg8::Unit&) const {}
};

constexpr int IDX_CAP = 512;
DI unsigned ordkey(float s) { const unsigned b = __builtin_bit_cast(unsigned, s); return (b & 0x80000000u) ? ~b : (b | 0x80000000u); }
DI float unordkey(unsigned k) { const unsigned b = (k & 0x80000000u) ? (k & 0x7fffffffu) : ~k; return __builtin_bit_cast(float, b); }

DI void idx_item(Ctx& C, int item, int l) {
    const int b = item & 3, qt = 511 - (item >> 2);
    const int t0 = qt * 8, chunk = t0 >> 6, NT32 = 2 * (chunk + 1);
    const size_t tok0 = (size_t)b * SEQ + t0;
    unsigned* bm = (unsigned*)(C.ws + WS_BM);
    const int lane = C.lane, wave = C.wave, tid = C.tid;
    if (chunk < 4) {
        if (tid < 8 * NT32) { const int q = tid / NT32, kt = tid % NT32; bm[(tok0 + q) * 128 + kt] = 0xffffffffu; }
        return;
    }
    const _Float16* ph = (const _Float16*)(C.ws + WS_PROJ);
    LAS unsigned* hist = (LAS unsigned*)(C.lds);
    LAS float* candS = (LAS float*)(C.lds + 8192);
    LAS int* candI = (LAS int*)(C.lds + 24576);
    LAS float* redmn = (LAS float*)(C.lds + 40960);
    LAS float* redmx = redmn + 64;
    LAS int* selB = (LAS int*)(C.lds + 41472);
    LAS unsigned* selAbove = (LAS unsigned*)(selB + 8);
    LAS unsigned* ccount = selAbove + 8;
    LAS float* thrS = (LAS float*)(ccount + 8);
    LAS int* thrI = (LAS int*)(thrS + 8);
    LAS unsigned* ovf = (LAS unsigned*)(thrI + 8);
    LAS unsigned* fbT = ovf + 8;
    LAS unsigned* fbCnt = fbT + 8;
    LAS unsigned* fbNeed = fbCnt + 8;
    const int r = lane & 31, hh = lane >> 5;
    float sc[2][16][2];
    f16x8 afr[2][4]; float wq[2][2][8];
#pragma unroll
    for (int m = 0; m < 2; ++m) {
        const int gq = (r >> 2) & 1, i = r >> 3, jj = r & 3, query = 4 * m + 2 * gq + (i >> 1), head = 4 * (i & 1) + jj;
        const _Float16* qp = ph + (tok0 + query) * PLD + PC_QI + head * 64 + 8 * hh;
#pragma unroll
        for (int s = 0; s < 4; ++s) afr[m][s] = *(const f16x8*)(qp + 16 * s);
#pragma unroll
        for (int qq = 0; qq < 2; ++qq) { const int q2 = 4 * m + 2 * hh + qq; const f16x8 wv = *(const f16x8*)(ph + (tok0 + q2) * PLD + PC_WI);
#pragma unroll
            for (int e = 0; e < 8; ++e) wq[m][qq][e] = (float)wv[e] * 0.044194173824159216f; }
    }
    const _Float16* kbase = ph + ((size_t)b * SEQ + r) * PLD + PC_KI + 8 * hh;
    f16x8 bnx[4];
#pragma unroll
    for (int s = 0; s < 4; ++s) bnx[s] = *(const f16x8*)(kbase + (size_t)(32 * wave) * PLD + 16 * s);
#pragma unroll
    for (int it = 0; it < 16; ++it) {
        const int kt = wave + 8 * it;
        if (kt < NT32) {
            f16x8 bfr[4];
#pragma unroll
            for (int s = 0; s < 4; ++s) bfr[s] = bnx[s];
            if (kt + 8 < NT32) {
#pragma unroll
                for (int s = 0; s < 4; ++s) bnx[s] = *(const f16x8*)(kbase + (size_t)(32 * (kt + 8)) * PLD + 16 * s); }
#pragma unroll
            for (int m = 0; m < 2; ++m) {
                f32x16 c = {};
#pragma unroll
                for (int s = 0; s < 4; ++s) c = __builtin_amdgcn_mfma_f32_32x32x16_f16(afr[m][s], bfr[s], c, 0, 0, 0);
#pragma unroll
                for (int qq = 0; qq < 2; ++qq) { float a = 0.f;
#pragma unroll
                    for (int e = 0; e < 8; ++e) a += wq[m][qq][e] * fmaxf(c[8 * qq + e], 0.f);
                    sc[m][it][qq] = a; }
            }
        } else { sc[0][it][0] = 0.f; sc[0][it][1] = 0.f; sc[1][it][0] = 0.f; sc[1][it][1] = 0.f; }
    }
    float mn[2][2], mx[2][2];
#pragma unroll
    for (int m = 0; m < 2; ++m)
#pragma unroll
        for (int qq = 0; qq < 2; ++qq) { float a = 3.0e38f, z = -3.0e38f;
#pragma unroll
            for (int it = 0; it < 16; ++it) if (wave + 8 * it < NT32) z = fmaxf(z, sc[m][it][qq]);
            a = z;
#pragma unroll
            for (int o = 1; o < 32; o <<= 1) { a = fminf(a, __shfl_xor(a, o)); z = fmaxf(z, __shfl_xor(z, o)); }
            mn[m][qq] = a; mx[m][qq] = z; }
    asm volatile("s_waitcnt lgkmcnt(0)\n\ts_barrier" ::: "memory");
    if (r == 0) {
#pragma unroll
        for (int m = 0; m < 2; ++m)
#pragma unroll
            for (int qq = 0; qq < 2; ++qq) { const int qid = 4 * m + 2 * hh + qq; redmn[wave * 8 + qid] = mn[m][qq]; redmx[wave * 8 + qid] = mx[m][qq]; }
    }
    for (int i = tid; i < 2048; i += NTHR) hist[i] = 0u;
    if (tid < 8) { ccount[tid] = 0u; ovf[tid] = 0u; }
    asm volatile("s_waitcnt lgkmcnt(0)\n\ts_barrier" ::: "memory");
    float lo[2][2], scl[2][2];
#pragma unroll
    for (int m = 0; m < 2; ++m)
#pragma unroll
        for (int qq = 0; qq < 2; ++qq) { const int qid = 4 * m + 2 * hh + qq; float a = 3.0e38f, z = -3.0e38f;
#pragma unroll
            for (int w = 0; w < 8; ++w) { a = fminf(a, redmn[w * 8 + qid]); z = fmaxf(z, redmx[w * 8 + qid]); }
            lo[m][qq] = a; scl[m][qq] = (z > a) ? 256.f / (z - a) : 0.f; }
#define IDX_BIN(m, it, qq) ((sc[m][it][qq] >= lo[m][qq]) ? min(255, (int)((sc[m][it][qq] - lo[m][qq]) * scl[m][qq])) : -1)
#define IDX_LAUNDER() do { _Pragma("unroll") for (int m_ = 0; m_ < 2; ++m_) _Pragma("unroll") for (int q_ = 0; q_ < 2; ++q_) { asm volatile("" : "+v"(lo[m_][q_]), "+v"(scl[m_][q_])); } } while (0)
#pragma unroll
    for (int m = 0; m < 2; ++m)
#pragma unroll
        for (int qq = 0; qq < 2; ++qq) { const int qid = 4 * m + 2 * hh + qq;
#pragma unroll
            for (int it = 0; it < 16; ++it) if (wave + 8 * it < NT32) { const int bin_ = IDX_BIN(m, it, qq); if (bin_ >= 0) __hip_atomic_fetch_add(hist + qid * 256 + bin_, 1u, __ATOMIC_RELAXED, __HIP_MEMORY_SCOPE_WORKGROUP); } }
    asm volatile("s_waitcnt lgkmcnt(0)\n\ts_barrier" ::: "memory");
    {
        const u32x4 h4 = *(const LAS u32x4*)(hist + wave * 256 + 4 * lane);
        const unsigned tot = h4.x + h4.y + h4.z + h4.w; unsigned incl = tot;
#pragma unroll
        for (int o = 1; o < 64; o <<= 1) { const unsigned v = __shfl_down(incl, o); if (lane + o < 64) incl += v; }
        unsigned run = incl - tot; int Bf = -1; unsigned ab = 0;
#pragma unroll
        for (int j = 3; j >= 0; --j) { const unsigned h = h4[j]; if (run < 256u && run + h >= 256u) { Bf = 4 * lane + j; ab = run; } run += h; }
        if (Bf >= 0) { selB[wave] = Bf; selAbove[wave] = ab; }
    }
    asm volatile("s_waitcnt lgkmcnt(0)\n\ts_barrier" ::: "memory");
    IDX_LAUNDER();
#pragma unroll
    for (int m = 0; m < 2; ++m)
#pragma unroll
        for (int qq = 0; qq < 2; ++qq) { const int qid = 4 * m + 2 * hh + qq; const int B = selB[qid];
#pragma unroll
            for (int it = 0; it < 16; ++it) if (wave + 8 * it < NT32) { const bool hit = (IDX_BIN(m, it, qq) == B); if (__any(hit)) { if (hit) { const unsigned pos = __hip_atomic_fetch_add(ccount + qid, 1u, __ATOMIC_RELAXED, __HIP_MEMORY_SCOPE_WORKGROUP);
                if (pos < (unsigned)IDX_CAP) { candS[qid * IDX_CAP + pos] = sc[m][it][qq]; candI[qid * IDX_CAP + pos] = 32 * (wave + 8 * it) + r; } } } } }
    asm volatile("s_waitcnt lgkmcnt(0)\n\ts_barrier" ::: "memory");
    {
        const int c = (int)ccount[wave]; const int need = 256 - (int)selAbove[wave];
        if (c <= IDX_CAP) {
            for (int i = lane; i < c; i += 64) { const float si = candS[wave * IDX_CAP + i]; const int ii = candI[wave * IDX_CAP + i]; int rank = 0;
                for (int j = 0; j < c; ++j) { const float sj = candS[wave * IDX_CAP + j]; const int ij = candI[wave * IDX_CAP + j]; rank += ((sj > si) || (sj == si && ij < ii)) ? 1 : 0; }
                if (rank == need - 1) { thrS[wave] = si; thrI[wave] = ii; } }
        } else if (lane == 0) { ovf[wave] = 1u; fbNeed[wave] = (unsigned)need; fbT[wave] = 0u; }
    }
    asm volatile("s_waitcnt lgkmcnt(0)\n\ts_barrier" ::: "memory");
    unsigned anyovf = 0u;
#pragma unroll
    for (int q = 0; q < 8; ++q) anyovf |= ovf[q];
    if (anyovf) {
        for (int bit = 31; bit >= 0; --bit) {
            if (tid < 8) fbCnt[tid] = 0u;
            asm volatile("s_waitcnt lgkmcnt(0)\n\ts_barrier" ::: "memory");
            IDX_LAUNDER();
#pragma unroll
            for (int m = 0; m < 2; ++m)
#pragma unroll
                for (int qq = 0; qq < 2; ++qq) { const int qid = 4 * m + 2 * hh + qq; if (ovf[qid]) { const unsigned cand = fbT[qid] | (1u << bit); const int B = selB[qid]; unsigned cnt = 0;
#pragma unroll
                    for (int it = 0; it < 16; ++it) if (wave + 8 * it < NT32) cnt += (IDX_BIN(m, it, qq) == B && ordkey(sc[m][it][qq]) >= cand) ? 1u : 0u;
                    if (cnt) __hip_atomic_fetch_add(fbCnt + qid, cnt, __ATOMIC_RELAXED, __HIP_MEMORY_SCOPE_WORKGROUP); } }
            asm volatile("s_waitcnt lgkmcnt(0)\n\ts_barrier" ::: "memory");
            if (tid < 8 && ovf[tid] && fbCnt[tid] >= fbNeed[tid]) fbT[tid] |= (1u << bit);
            asm volatile("s_waitcnt lgkmcnt(0)\n\ts_barrier" ::: "memory");
        }
        if (tid < 8) fbCnt[tid] = 0u;
        asm volatile("s_waitcnt lgkmcnt(0)\n\ts_barrier" ::: "memory");
        IDX_LAUNDER();
#pragma unroll
        for (int m = 0; m < 2; ++m)
#pragma unroll
            for (int qq = 0; qq < 2; ++qq) { const int qid = 4 * m + 2 * hh + qq; if (ovf[qid]) { const unsigned Tk = fbT[qid]; const int B = selB[qid]; unsigned cnt = 0;
#pragma unroll
                for (int it = 0; it < 16; ++it) if (wave + 8 * it < NT32) cnt += (IDX_BIN(m, it, qq) == B && ordkey(sc[m][it][qq]) > Tk) ? 1u : 0u;
                if (cnt) __hip_atomic_fetch_add(fbCnt + qid, cnt, __ATOMIC_RELAXED, __HIP_MEMORY_SCOPE_WORKGROUP); } }
        asm volatile("s_waitcnt lgkmcnt(0)\n\ts_barrier" ::: "memory");
        if (tid < 8 && ovf[tid]) { fbNeed[tid] -= fbCnt[tid]; thrS[tid] = unordkey(fbT[tid]); thrI[tid] = 0; }
        asm volatile("s_waitcnt lgkmcnt(0)\n\ts_barrier" ::: "memory");
        for (int bit = 11; bit >= 0; --bit) {
            if (tid < 8) fbCnt[tid] = 0u;
            asm volatile("s_waitcnt lgkmcnt(0)\n\ts_barrier" ::: "memory");
            IDX_LAUNDER();
#pragma unroll
            for (int m = 0; m < 2; ++m)
#pragma unroll
                for (int qq = 0; qq < 2; ++qq) { const int qid = 4 * m + 2 * hh + qq; if (ovf[qid]) { const unsigned Tk = fbT[qid]; const int B = selB[qid]; const int cand = thrI[qid] | (1 << bit); unsigned cnt = 0;
#pragma unroll
                    for (int it = 0; it < 16; ++it) if (wave + 8 * it < NT32) cnt += (IDX_BIN(m, it, qq) == B && ordkey(sc[m][it][qq]) == Tk && (32 * (wave + 8 * it) + r) < cand) ? 1u : 0u;
                    if (cnt) __hip_atomic_fetch_add(fbCnt + qid, cnt, __ATOMIC_RELAXED, __HIP_MEMORY_SCOPE_WORKGROUP); } }
            asm volatile("s_waitcnt lgkmcnt(0)\n\ts_barrier" ::: "memory");
            if (tid < 8 && ovf[tid] && fbCnt[tid] < fbNeed[tid]) thrI[tid] |= (1 << bit);
            asm volatile("s_waitcnt lgkmcnt(0)\n\ts_barrier" ::: "memory");
        }
    }
    IDX_LAUNDER();
#pragma unroll
    for (int m = 0; m < 2; ++m)
#pragma unroll
        for (int qq = 0; qq < 2; ++qq) { const int qid = 4 * m + 2 * hh + qq; const int B = selB[qid]; const float ts = thrS[qid]; const int ti = thrI[qid];
            unsigned myw = 0u;
#pragma unroll
            for (int it = 0; it < 16; ++it) { const int kt = wave + 8 * it;
                if (kt < NT32) { const int bin = IDX_BIN(m, it, qq); const float s = sc[m][it][qq]; const int idx = 32 * kt + r;
                    const bool sel = (bin > B) || (bin == B && (s > ts || (s == ts && idx <= ti)));
                    const unsigned long long mk = __ballot(sel);
                    const unsigned wv = hh ? (unsigned)(mk >> 32) : (unsigned)mk;
                    if (r == it) myw = wv; } }
            if (r < 16 && wave + 8 * r < NT32) bm[(tok0 + qid) * 128 + wave + 8 * r] = myw; }
#undef IDX_BIN
#undef IDX_LAUNDER
}

DI float softplusf_(float z) { return fmaxf(z, 0.f) + log1pf(expf(-fabsf(z))); }
DI void attn_tile(const LAS unsigned char* kb, const LAS unsigned char* vb, const LAS float* tab, const bf16x8 (&qr)[4], unsigned cw0, unsigned cw1, int j, int qw, int myq, int r32, int hi, float bias_far,
                  float& m_run, float& l_run, f32x16& o0, f32x16& o1, f32x16& negmb) {
    bf16x8 ka[8];
#pragma unroll
    for (int s = 0; s < 4; ++s) { const int ch = 2 * s + hi;
        ka[2 * s] = *(const LAS bf16x8*)(kb + r32 * 128 + ((ch ^ ((r32 >> 1) & 7)) << 4));
        ka[2 * s + 1] = *(const LAS bf16x8*)(kb + (32 + r32) * 128 + ((ch ^ (((32 + r32) >> 1) & 7)) << 4)); }
    f32x16 p0 = negmb, p1 = negmb;
#pragma unroll
    for (int s = 0; s < 4; ++s) { p0 = __builtin_amdgcn_mfma_f32_32x32x16_bf16(ka[2 * s], qr[s], p0, 0, 0, 0); p1 = __builtin_amdgcn_mfma_f32_32x32x16_bf16(ka[2 * s + 1], qr[s], p1, 0, 0, 0); }
    u32x4 va0[4], va1[4];
#pragma unroll
    for (int s = 0; s < 4; ++s) {
        const u32x2 a0l = *(const LAS u32x2*)(vb + (r32) * 136 + (16 * s + 4 * hi) * 2), a0h = *(const LAS u32x2*)(vb + (r32) * 136 + (16 * s + 8 + 4 * hi) * 2);
        const u32x2 a1l = *(const LAS u32x2*)(vb + (32 + r32) * 136 + (16 * s + 4 * hi) * 2), a1h = *(const LAS u32x2*)(vb + (32 + r32) * 136 + (16 * s + 8 + 4 * hi) * 2);
        va0[s] = (u32x4){a0l.x, a0l.y, a0h.x, a0h.y}; va1[s] = (u32x4){a1l.x, a1l.y, a1h.x, a1h.y}; }
    const bool far = (64 * j + 63 - qw) <= -128;
    if (!far) {
#pragma unroll
        for (int g = 0; g < 16; ++g) { const int kv0 = 64 * j + (g & 3) + 8 * (g >> 2) + 4 * hi; int r0 = kv0 - myq, r1 = r0 + 32;
            r0 = r0 < -128 ? -128 : r0; r1 = r1 < -128 ? -128 : r1;
            p0[g] += tab[r0 + 128]; p1[g] += tab[r1 + 128]; }
    }
    float mx = p0[0];
#pragma unroll
    for (int g = 1; g < 16; ++g) mx = fmaxf(mx, p0[g]);
#pragma unroll
    for (int g = 0; g < 16; ++g) mx = fmaxf(mx, p1[g]);
    mx = fmaxf(mx, __shfl_xor(mx, 32));
    if (j == 0 || __any(mx > 0.f)) {
        const float dl = (j == 0) ? mx : fmaxf(mx, 0.f);
        m_run += dl;
        const float al = __builtin_amdgcn_exp2f(-dl); l_run *= al;
#pragma unroll
        for (int g = 0; g < 16; ++g) { p0[g] -= dl; p1[g] -= dl; o0[g] *= al; o1[g] *= al; negmb[g] = bias_far - m_run; }
        asm volatile("" : "+v"(negmb));
    }
    const int sw0 = (int)(cw0 >> (4 * hi)), sw1 = (int)(cw1 >> (4 * hi));
    float ls = 0.f;
#pragma unroll
    for (int g = 0; g < 16; ++g) { const int bit = (g & 3) + 8 * (g >> 2);
        const float e0 = __builtin_amdgcn_exp2f(p0[g]), e1 = __builtin_amdgcn_exp2f(p1[g]);
        int m0_, m1_;
        asm("v_bfe_i32 %0, %1, %2, 1" : "=v"(m0_) : "v"(sw0), "n"(bit)); asm("v_bfe_i32 %0, %1, %2, 1" : "=v"(m1_) : "v"(sw1), "n"(bit));
        p0[g] = __builtin_bit_cast(float, __builtin_bit_cast(int, e0) & m0_); p1[g] = __builtin_bit_cast(float, __builtin_bit_cast(int, e1) & m1_); ls += p0[g] + p1[g]; }
    l_run += ls;
    bf16x8 pb[4];
#pragma unroll
    for (int s = 0; s < 2; ++s) {
        u32x4 w; w.x = pk2(p0[8 * s], p0[8 * s + 1]); w.y = pk2(p0[8 * s + 2], p0[8 * s + 3]); w.z = pk2(p0[8 * s + 4], p0[8 * s + 5]); w.w = pk2(p0[8 * s + 6], p0[8 * s + 7]); pb[s] = __builtin_bit_cast(bf16x8, w);
        u32x4 x; x.x = pk2(p1[8 * s], p1[8 * s + 1]); x.y = pk2(p1[8 * s + 2], p1[8 * s + 3]); x.z = pk2(p1[8 * s + 4], p1[8 * s + 5]); x.w = pk2(p1[8 * s + 6], p1[8 * s + 7]); pb[2 + s] = __builtin_bit_cast(bf16x8, x); }
#pragma unroll
    for (int s = 0; s < 4; ++s) {
        o0 = __builtin_amdgcn_mfma_f32_32x32x16_bf16(__builtin_bit_cast(bf16x8, va0[s]), pb[s], o0, 0, 0, 0);
        o1 = __builtin_amdgcn_mfma_f32_32x32x16_bf16(__builtin_bit_cast(bf16x8, va1[s]), pb[s], o1, 0, 0, 0); }
}
DI void attn_unit(Ctx& C, int b, int h, int qb) {
    const int tid = C.tid, lane = C.lane, wave = C.wave, r32 = lane & 31, hi = lane >> 5;
    const bf16_t* proj = (const bf16_t*)(C.ws + WS_PROJ);
    const unsigned* bm = (const unsigned*)(C.ws + WS_BM);
    LAS unsigned char* Kl = C.lds; LAS unsigned char* Vl = C.lds + 16384; LAS float* tab = (LAS float*)(C.lds + 33792);
    const size_t rowbase = (size_t)b * SEQ; const int q0 = qb * 256, qw = q0 + 32 * wave, myq = qw + r32;
    const int NT = 4 * qb + 4, mylast = qw >> 6;
    constexpr float LOG2E = 1.4426950408889634f;
    __syncthreads();
    if (tid < 192) { const int rel = tid - 128; const int n = rel < 0 ? -rel : rel; int bk = rel > 0 ? 16 : 0;
        if (n < 8) bk += n; else bk += 8 + (n >= 12) + (n >= 16) + (n >= 23) + (n >= 32) + (n >= 46) + (n >= 64) + (n >= 91);
        tab[tid] = (C.in(17)[bk * 8 + h] - C.in(17)[15 * 8 + h]) * LOG2E; }
    const float bias_far = C.in(17)[15 * 8 + h] * LOG2E;
    bf16x8 qr[4];
    { const bf16_t* qp = proj + (rowbase + myq) * PLD + PC_Q + h * 64 + 8 * hi;
#pragma unroll
        for (int s = 0; s < 4; ++s) { const u32x4 raw = *(const u32x4*)(qp + 16 * s); u32x4 sc_;
#pragma unroll
            for (int e = 0; e < 4; ++e) sc_[e] = pk2(bflo(raw[e]) * (0.125f * LOG2E), bfhi(raw[e]) * (0.125f * LOG2E));
            qr[s] = __builtin_bit_cast(bf16x8, sc_); } }
    const unsigned* bmrow = bm + (rowbase + myq) * 128;
    const int skv = tid >> 3, sch = tid & 7;
    const bf16_t* ksrc = proj + (rowbase + skv) * PLD + PC_K + h * 64 + 8 * sch;
    const bf16_t* vsrc = proj + (rowbase + skv) * PLD + PC_V + h * 64 + 8 * sch;
    const int kdst = skv * 128 + ((sch ^ ((skv >> 1) & 7)) << 4);
    const u32x4 m4i = *(const u32x4*)bmrow;
    u32x4 kregA = *(const u32x4*)ksrc, vregA = *(const u32x4*)vsrc; unsigned mA0 = m4i.x, mA1 = m4i.y;
    u32x4 kregB = kregA, vregB = vregA; unsigned mB0 = m4i.z, mB1 = m4i.w;
    if (NT > 1) { kregB = *(const u32x4*)(ksrc + (size_t)64 * PLD); vregB = *(const u32x4*)(vsrc + (size_t)64 * PLD); }
    const bool vodd = (skv & 1) != 0; const int vdst = ((8 * sch + (vodd ? 4 : 0)) * 68 + (skv & ~1)) * 2;
#define ATT_WRITE(buf, kreg, vreg) do { *(LAS u32x4*)(Kl + (buf) * 8192 + kdst) = kreg; LAS unsigned char* vt_ = Vl + (buf) * 8704 + vdst; \
        const unsigned r0_ = (unsigned)__builtin_amdgcn_ds_swizzle((int)(vodd ? vreg.x : vreg.z), 0x201F), r1_ = (unsigned)__builtin_amdgcn_ds_swizzle((int)(vodd ? vreg.y : vreg.w), 0x201F); \
        const unsigned lo0_ = vodd ? r0_ : vreg.x, hi0_ = vodd ? vreg.z : r0_, lo1_ = vodd ? r1_ : vreg.y, hi1_ = vodd ? vreg.w : r1_; \
        *(LAS unsigned*)(vt_ + 0 * 136) = (lo0_ & 0xffffu) | (hi0_ << 16); *(LAS unsigned*)(vt_ + 1 * 136) = (lo0_ >> 16) | (hi0_ & 0xffff0000u); \
        *(LAS unsigned*)(vt_ + 2 * 136) = (lo1_ & 0xffffu) | (hi1_ << 16); *(LAS unsigned*)(vt_ + 3 * 136) = (lo1_ >> 16) | (hi1_ & 0xffff0000u); } while (0)
    ATT_WRITE(0, kregA, vregA);
    __syncthreads();
    float m_run = 0.f, l_run = 0.f; f32x16 o0 = {}, o1 = {}, negmb;
#pragma unroll
    for (int g = 0; g < 16; ++g) negmb[g] = bias_far;
    asm volatile("" : "+v"(negmb));
#define ATT_STEP(J, CW0, CW1, KN, VN, KF, VF, MLOAD) do { const int js_ = (J); const int buf = js_ & 1; \
        if (js_ + 2 < NT) { KF = *(const u32x4*)(ksrc + (size_t)(js_ + 2) * 64 * PLD); VF = *(const u32x4*)(vsrc + (size_t)(js_ + 2) * 64 * PLD); MLOAD; } \
        if (js_ <= mylast) { attn_tile(Kl + buf * 8192, Vl + buf * 8704, tab, qr, (CW0), (CW1), js_, qw, myq, r32, hi, bias_far, m_run, l_run, o0, o1, negmb); } \
        if (js_ + 1 < NT) ATT_WRITE(buf ^ 1, KN, VN); \
        __syncthreads(); } while (0)
    {
        unsigned cA0 = mA0, cA1 = mA1;
        for (int j = 0; j < NT; j += 2) {
            u32x4 m4 = {0u, 0u, 0u, 0u};
            { const unsigned c0 = cA0, c1 = cA1; u32x4 kf = kregA, vf = vregA;
              ATT_STEP(j, c0, c1, kregB, vregB, kf, vf, m4 = *(const u32x4*)(bmrow + 2 * js_ + 4)); kregA = kf; vregA = vf; cA0 = m4.x; cA1 = m4.y; }
            if (j + 1 < NT) {
                const unsigned c0 = mB0, c1 = mB1; u32x4 kf = kregB, vf = vregB;
                ATT_STEP(j + 1, c0, c1, kregA, vregA, kf, vf, (void)0); kregB = kf; vregB = vf; mB0 = m4.z; mB1 = m4.w; }
        }
    }
#undef ATT_STEP
#undef ATT_WRITE
    const float lt = l_run + __shfl_xor(l_run, 32); const float inv = 1.f / lt;
    bf16_t* orow = C.mixcat + (rowbase + myq) * D + h * 64;
#pragma unroll
    for (int i = 0; i < 4; ++i) { const int d = 8 * i + 4 * hi;
        u32x2 w0; w0.x = pk2(o0[4 * i] * inv, o0[4 * i + 1] * inv); w0.y = pk2(o0[4 * i + 2] * inv, o0[4 * i + 3] * inv); *(u32x2*)(orow + d) = w0;
        u32x2 w1; w1.x = pk2(o1[4 * i] * inv, o1[4 * i + 1] * inv); w1.y = pk2(o1[4 * i + 2] * inv, o1[4 * i + 3] * inv); *(u32x2*)(orow + 32 + d) = w1; }
}

constexpr size_t WS_PHI = 38 * MiB, WS_PSI = 54 * MiB, WS_GT = 70 * MiB, WS_Y0T = 86 * MiB, WS_GGT = 102 * MiB, WS_RHO = 118 * MiB;
constexpr size_t WS_S0 = 1 * MiB;
constexpr size_t WS_LORA = 250 * MiB;
DI int crow(int g, int hi) { return (g & 3) + 8 * (g >> 2) + 4 * hi; }
DI f32x16 mfma32(bf16x8 a, bf16x8 b, f32x16 c) { return __builtin_amdgcn_mfma_f32_32x32x16_bf16(a, b, c, 0, 0, 0); }
struct FA { float v[16]; DI float& operator[](int i) { return v[i]; } DI const float& operator[](int i) const { return v[i]; } };
struct F8 { float v[8]; DI float& operator[](int i) { return v[i]; } DI const float& operator[](int i) const { return v[i]; } };
DI bf16x8 pack8(const F8& a) { u32x4 w; w.x = pk2(a[0], a[1]); w.y = pk2(a[2], a[3]); w.z = pk2(a[4], a[5]); w.w = pk2(a[6], a[7]); return __builtin_bit_cast(bf16x8, w); }
DI void pin(FA& a) { asm volatile("" : "+v"(a.v[0]), "+v"(a.v[1]), "+v"(a.v[2]), "+v"(a.v[3]), "+v"(a.v[4]), "+v"(a.v[5]), "+v"(a.v[6]), "+v"(a.v[7]), "+v"(a.v[8]), "+v"(a.v[9]), "+v"(a.v[10]), "+v"(a.v[11]), "+v"(a.v[12]), "+v"(a.v[13]), "+v"(a.v[14]), "+v"(a.v[15])); }
DI void pinf(bf16x8& a) { asm volatile("" : "+v"(a)); }
DI FA toFA(const f32x16& a) { FA r; _Pragma("unroll") for (int i = 0; i < 16; ++i) r.v[i] = a[i]; return r; }
DI f32x16 toV(const FA& a) { f32x16 r; _Pragma("unroll") for (int i = 0; i < 16; ++i) r[i] = a.v[i]; return r; }
DI bf16x8 packfrag(const FA& a, int s) { u32x4 w; w.x = pk2(a[8 * s], a[8 * s + 1]); w.y = pk2(a[8 * s + 2], a[8 * s + 3]); w.z = pk2(a[8 * s + 4], a[8 * s + 5]); w.w = pk2(a[8 * s + 6], a[8 * s + 7]); return __builtin_bit_cast(bf16x8, w); }
DI bf16x8 packfrag(const f32x16& a, int s) { u32x4 w; w.x = pk2(a[8 * s], a[8 * s + 1]); w.y = pk2(a[8 * s + 2], a[8 * s + 3]); w.z = pk2(a[8 * s + 4], a[8 * s + 5]); w.w = pk2(a[8 * s + 6], a[8 * s + 7]); return __builtin_bit_cast(bf16x8, w); }
DI unsigned opq(unsigned v) { asm volatile("" : "+v"(v)); return v; }
DI void st_frag(unsigned char* buf, int f, int lane, bf16x8 v) { *(bf16x8*)(buf + f * 1024 + opq(lane * 16)) = v; }
DI bf16x8 ld_frag(const unsigned char* buf, int f, int lane) { return *(const bf16x8*)(buf + f * 1024 + opq(lane * 16)); }
template <class TT> DI void st_tile_bf16(unsigned char* buf, int q, int lane, const TT& a) { const unsigned o = opq(lane * 32); *(bf16x8*)(buf + q * 2048 + o) = packfrag(a, 0); *(bf16x8*)(buf + q * 2048 + o + 16) = packfrag(a, 1); }
DI FA ld_tile_bf16(const unsigned char* buf, int q, int lane) { const unsigned o = opq(lane * 32); const u32x4 a = *(const u32x4*)(buf + q * 2048 + o), b = *(const u32x4*)(buf + q * 2048 + o + 16); FA r;
    r[0] = bflo(a.x); r[1] = bfhi(a.x); r[2] = bflo(a.y); r[3] = bfhi(a.y); r[4] = bflo(a.z); r[5] = bfhi(a.z); r[6] = bflo(a.w); r[7] = bfhi(a.w);
    r[8] = bflo(b.x); r[9] = bfhi(b.x); r[10] = bflo(b.y); r[11] = bfhi(b.y); r[12] = bflo(b.z); r[13] = bfhi(b.z); r[14] = bflo(b.w); r[15] = bfhi(b.w); return r; }
DI float fexp(float x) { return __builtin_amdgcn_exp2f(x * 1.4426950408889634f); }
DI float flog(float x) { return __builtin_amdgcn_logf(x) * 0.6931471805599453f; }
DI float ftanh(float x) { return 1.f - 2.f * __builtin_amdgcn_rcpf(1.f + fexp(2.f * x)); }
DI float fsigm(float x) { return __builtin_amdgcn_rcpf(1.f + fexp(-x)); }
DI float fsoftplus(float z) { return fmaxf(z, 0.f) + flog(1.f + fexp(-fabsf(z))); }
template <int ACT> DI bf16x8 act_frag(const bf16_t* proj, size_t row, bool first, int c0, const float* mu8) {
    const bf16_t* rp = proj + opq((unsigned)(row * PLD)); const u32x4 cu = *(const u32x4*)(rp + c0); u32x4 pv = {0u, 0u, 0u, 0u}; if (!first) pv = *(const u32x4*)(rp - PLD + c0);
    const float* mq = mu8 + opq(0u); const f32x4 m0 = *(const f32x4*)(mq), m1 = *(const f32x4*)(mq + 4);
    float x[8];
#pragma unroll
    for (int q = 0; q < 4; ++q) { const float c_lo = bflo(cu[q]), c_hi = bfhi(cu[q]), p_lo = bflo(pv[q]), p_hi = bfhi(pv[q]); const float ma = (q < 2) ? m0[2 * q] : m1[2 * q - 4], mb = (q < 2) ? m0[2 * q + 1] : m1[2 * q - 3];
        x[2 * q] = c_lo + (p_lo - c_lo) * ma; x[2 * q + 1] = c_hi + (p_hi - c_hi) * mb; }
#pragma unroll
    for (int e = 0; e < 8; ++e) { if (ACT == 1) x[e] = ftanh(x[e]); else if (ACT == 2) x[e] = fsigm(x[e]); }
    u32x4 w; w.x = pk2(x[0], x[1]); w.y = pk2(x[2], x[3]); w.z = pk2(x[4], x[5]); w.w = pk2(x[6], x[7]); return __builtin_bit_cast(bf16x8, w);
}
DI f32x4 shift4(const bf16_t* proj, size_t row, bool first, int c4, const float* mu4) {
    const bf16_t* rp = proj + opq((unsigned)(row * PLD)); const u32x2 cu = *(const u32x2*)(rp + c4); u32x2 pv = {0u, 0u}; if (!first) pv = *(const u32x2*)(rp - PLD + c4);
    const f32x4 m = *(const f32x4*)(mu4 + opq(0u)); const f32x4 c = {bflo(cu.x), bfhi(cu.x), bflo(cu.y), bfhi(cu.y)}, p = {bflo(pv.x), bfhi(pv.x), bflo(pv.y), bfhi(pv.y)};
    return c + (p - c) * m;
}
DI f32x4 shiftT4(const bf16_t* proj, size_t row, bool firstseq, int c1, float mu1) {
    const bf16_t* rp = proj + opq((unsigned)(row * PLD + c1));
    const float c0 = bf2f(rp[0]), c1_ = bf2f(rp[PLD]), c2 = bf2f(rp[2 * PLD]), c3 = bf2f(rp[3 * PLD]);
    const float pm = firstseq ? 0.f : bf2f(*(rp - PLD));
    f32x4 r; r.x = c0 + (pm - c0) * mu1; r.y = c1_ + (c0 - c1_) * mu1; r.z = c2 + (c1_ - c2) * mu1; r.w = c3 + (c2 - c3) * mu1; return r;
}
DI float scan32_incl(float x, int tl) {
#pragma unroll
    for (int d = 1; d < 32; d <<= 1) { const float y = __shfl_up(x, d, 32); if (tl >= d) x += y; }
    return x;
}

constexpr int RL_ACT = 0;
constexpr int RL_MAB = 0, RL_W1C = 17408, RL_W2C = 26624;
constexpr int RL_ELL = 35840;
constexpr int RL_AV = RL_ELL + 16640, RL_MAK = RL_ELL, RL_NRB = RL_ELL + 9216, RL_NRK = RL_ELL + 18432;
constexpr int RL_RT = 69120, RL_AT = RL_RT + 9216, RL_BT = RL_RT + 18432, RL_KT = RL_RT + 27648;
constexpr int RL_X2 = RL_AT;
constexpr int RL_BHC = 105984, RL_KHC = RL_BHC + 9216, RL_VC = RL_BHC + 18432;
constexpr int RL_X = 133632;
constexpr int RL_SM = 150272;
constexpr int RL_END = RL_SM + 512;
template <int KS> DI f32x16 mm_ll(const LAS bf16_t* a, int pa, const LAS bf16_t* b, int pb, int lane, f32x16 acc) {
    const LAS bf16_t* ap = a + (lane & 31) * pa + 8 * (lane >> 5); const LAS bf16_t* bp = b + (lane & 31) * pb + 8 * (lane >> 5);
#pragma unroll
    for (int s = 0; s < KS; ++s) acc = mfma32(*(const LAS bf16x8*)(ap + 16 * s), *(const LAS bf16x8*)(bp + 16 * s), acc);
    return acc;
}
DI void rwkv_chunk_acts(Ctx& C, int bc, int l, bf16x8 (&actv)[4]) {
    const int chunk = bc & 63, b = bc >> 6, t = C.tid >> 3, cg = C.tid & 7; const size_t row = (size_t)b * SEQ + chunk * 64 + t; const bool first = (chunk == 0 && t == 0);
    const bf16_t* proj = (const bf16_t*)(C.ws + WS_PROJ); const float* mu = C.in(6) + (size_t)l * 1792;
#pragma unroll
    for (int q = 0; q < 4; ++q) { const int c8 = cg * 32 + 8 * q;
        if (c8 < 64) actv[q] = act_frag<1>(proj, row, first, PC_WD + c8, mu + 1536 + c8); else if (c8 < 128) actv[q] = act_frag<0>(proj, row, first, PC_WD + c8, mu + 1536 + c8); else actv[q] = act_frag<2>(proj, row, first, PC_WD + c8, mu + 1536 + c8); }
}
#define LBAR() asm volatile("s_waitcnt lgkmcnt(0)\n\ts_barrier" ::: "memory")
DI void rwkv_head_item(Ctx& C, int item, int l, const bf16x8 (&actv)[4]) {
    const int h = item & 7, chunk = (item >> 3) & 63, b = item >> 9, tid = C.tid, lane = C.lane, wave = C.wave, tl = lane & 31, hi = lane >> 5;
    const size_t tok0 = (size_t)b * SEQ + chunk * 64;
    const bf16_t* proj = (const bf16_t*)(C.ws + WS_PROJ);
    const size_t chid = ((size_t)(b * 8 + h) * 64 + chunk) * 8192;
    unsigned char* PHI = C.ws + WS_PHI + chid; unsigned char* PSI = C.ws + WS_PSI + chid; unsigned char* GT = C.ws + WS_GT + chid; unsigned char* Y0T = C.ws + WS_Y0T + chid; unsigned char* GGT = C.ws + WS_GGT + chid;
    const bf16_t* WDT = (const bf16_t*)(C.ws + WS_LORA); const bf16_t* WAT = WDT + 512 * 64; const bf16_t* WGT = WAT + 512 * 64;
    const float* mu = C.in(6) + (size_t)l * 1792;
    const float* w0p = C.in(7) + l * 512 + 64 * h; const float* a0p = C.in(9) + l * 512 + 64 * h;
    const float* kkp = C.in(12) + l * 512 + 64 * h; const float* kap = C.in(13) + l * 512 + 64 * h; const float* rkp = C.in(14) + l * 512 + 64 * h;
    LAS bf16_t* ACT = (LAS bf16_t*)(C.lds + RL_ACT); LAS float* MAB = (LAS float*)(C.lds + RL_MAB); LAS bf16_t* W1C = (LAS bf16_t*)(C.lds + RL_W1C); LAS bf16_t* W2C = (LAS bf16_t*)(C.lds + RL_W2C);
    LAS float* ELL = (LAS float*)(C.lds + RL_ELL); LAS float* AV = (LAS float*)(C.lds + RL_AV);
    LAS bf16_t* MAK = (LAS bf16_t*)(C.lds + RL_MAK); LAS bf16_t* NRB = (LAS bf16_t*)(C.lds + RL_NRB); LAS bf16_t* NRK = (LAS bf16_t*)(C.lds + RL_NRK);
    LAS bf16_t* AT = (LAS bf16_t*)(C.lds + RL_AT); LAS bf16_t* RT = (LAS bf16_t*)(C.lds + RL_RT); LAS bf16_t* BT = (LAS bf16_t*)(C.lds + RL_BT); LAS bf16_t* KT = (LAS bf16_t*)(C.lds + RL_KT);
    LAS bf16_t* BHC = (LAS bf16_t*)(C.lds + RL_BHC); LAS bf16_t* KHC = (LAS bf16_t*)(C.lds + RL_KHC); LAS bf16_t* VC = (LAS bf16_t*)(C.lds + RL_VC);
    LAS float* X = (LAS float*)(C.lds + RL_X); LAS float* X2 = (LAS float*)(C.lds + RL_X2); LAS float* INV = (LAS float*)(C.lds + RL_SM); LAS float* LCv = INV + 64;
    LBAR();
#ifndef RWR12
#define RWR12 1
#define RWR4 1
#define RWR5 1
#define RWR11 1
#endif
    for (int rr_ = 0; rr_ < RWR12; ++rr_) {
    const int jp = (wave >> 1) & 1, jq = wave & 1;
    bf16x8 wfr[8];
    if (wave < 4) { const bf16_t* W = WGT + (size_t)(64 * h + 32 * jp + tl) * 128 + 8 * hi;
#pragma unroll
        for (int s = 0; s < 8; ++s) wfr[s] = *(const bf16x8*)(W + 16 * s);
    } else { const bf16_t* W0 = WDT + (size_t)(64 * h + 32 * jq + tl) * 64 + 8 * hi; const bf16_t* W1 = WAT + (size_t)(64 * h + 32 * jq + tl) * 64 + 8 * hi;
#pragma unroll
        for (int s = 0; s < 4; ++s) { wfr[s] = *(const bf16x8*)(W0 + 16 * s); wfr[4 + s] = *(const bf16x8*)(W1 + 16 * s); } }
    { const int t = tid >> 3, cg = tid & 7;
#pragma unroll
        for (int q = 0; q < 4; ++q) *(LAS bf16x8*)(ACT + t * 264 + cg * 32 + 8 * q) = actv[q]; }
    LBAR();
    if (wave < 4) {
        const LAS bf16_t* bp = ACT + (32 * jq + tl) * 264 + 128 + 8 * hi; f32x16 acc = {};
#pragma unroll
        for (int s = 0; s < 8; ++s) acc = mfma32(wfr[s], *(const LAS bf16x8*)(bp + 16 * s), acc);
        st_tile_bf16(GGT, jp * 2 + jq, lane, acc);
    } else {
        const LAS bf16_t* ap = ACT + (32 * jp + tl) * 264 + 8 * hi; f32x16 a0 = {}, a1 = {};
#pragma unroll
        for (int s = 0; s < 4; ++s) { a0 = mfma32(*(const LAS bf16x8*)(ap + 16 * s), wfr[s], a0); a1 = mfma32(*(const LAS bf16x8*)(ap + 64 + 16 * s), wfr[4 + s], a1); }
        const int ch = 32 * jq + tl; const float w0c = w0p[ch], a0c = a0p[ch];
#pragma unroll
        for (int g = 0; g < 16; ++g) { const int t = 32 * jp + crow(g, hi); ELL[t * 65 + ch] = -fexp(-fsoftplus(-(w0c + a0[g])) - 0.5f); AV[t * 65 + ch] = fsigm(a0c + a1[g]); }
    }
    LBAR();
    }
    { const int ch = tid & 63, seg = tid >> 6; float p[8]; float run = 0.f;
#pragma unroll
        for (int e = 0; e < 8; ++e) { run += ELL[(8 * seg + e) * 65 + ch]; p[e] = run; }
        X[seg * 65 + ch] = run;
        LBAR();
        float off = 0.f;
#pragma unroll
        for (int s2 = 0; s2 < 7; ++s2) off += (s2 < seg) ? X[s2 * 65 + ch] : 0.f;
#pragma unroll
        for (int e = 0; e < 8; ++e) ELL[(8 * seg + e) * 65 + ch] = off + p[e];
        if (seg == 7) LCv[ch] = off + p[7]; }
    LBAR();
    for (int rr_ = 0; rr_ < RWR4; ++rr_) {
    { const int t = tid >> 3, c0 = (tid & 7) * 8; const size_t row = tok0 + t; const bool first = (chunk == 0 && t == 0); float rho = 0.f, n2 = 0.f;
        f32x4 r4[2], k4[2], v4[2];
#pragma unroll
        for (int q = 0; q < 2; ++q) { const int c = c0 + 4 * q;
            r4[q] = shift4(proj, row, first, PC_R + 64 * h + c, mu + 64 * h + c); k4[q] = shift4(proj, row, first, PC_BK + 64 * h + c, mu + 512 + 64 * h + c); v4[q] = shift4(proj, row, first, PC_BV + 64 * h + c, mu + 1024 + 64 * h + c);
            const f32x4 kr = k4[q] * *(const f32x4*)(kkp + c); n2 += (kr.x * kr.x + kr.y * kr.y) + (kr.z * kr.z + kr.w * kr.w); }
        n2 += __shfl_xor(n2, 1); n2 += __shfl_xor(n2, 2); n2 += __shfl_xor(n2, 4);
        const float inv = 1.f / fmaxf(sqrtf(n2), 1e-12f);
        F8 vA, vR, vB, vK;
#pragma unroll
        for (int q = 0; q < 2; ++q) { const int c = c0 + 4 * q;
            const f32x4 kk4 = *(const f32x4*)(kkp + c), ka4 = *(const f32x4*)(kap + c), rk4 = *(const f32x4*)(rkp + c);
#pragma unroll
            for (int jj = 0; jj < 4; ++jj) { const int ch = c + jj; const float a = AV[t * 65 + ch], L = ELL[t * 65 + ch], Lp = t ? ELL[(t - 1) * 65 + ch] : 0.f, LC = LCv[ch];
                const float kk = k4[q][jj] * kk4[jj] * inv, kp = k4[q][jj] * (1.f + (a - 1.f) * ka4[jj]), bb = kk * a;
                const float eL = fexp(L), eN = fexp(-L), eP = fexp(Lp), eD = fexp(LC - L);
                rho += r4[q][jj] * kp * rk4[jj];
                const float xa = -kk * eP; vA[4 * q + jj] = xa; vR[4 * q + jj] = r4[q][jj] * eL; vB[4 * q + jj] = bb * eN; vK[4 * q + jj] = kp * eN;
                X[t * 65 + ch] = xa; BHC[ch * 72 + t] = (bf16_t)f2bf(bb * eD); KHC[ch * 72 + t] = (bf16_t)f2bf(kp * eD); VC[ch * 72 + t] = (bf16_t)f2bf(v4[q][jj]); } }
        *(LAS bf16x8*)(AT + t * 72 + c0) = pack8(vA); *(LAS bf16x8*)(RT + t * 72 + c0) = pack8(vR); *(LAS bf16x8*)(BT + t * 72 + c0) = pack8(vB); *(LAS bf16x8*)(KT + t * 72 + c0) = pack8(vK);
        rho += __shfl_xor(rho, 1); rho += __shfl_xor(rho, 2); rho += __shfl_xor(rho, 4);
        if ((tid & 7) == 0) ((float*)(C.ws + WS_RHO))[row * 8 + h] = rho; }
    LBAR();
    }
    for (int rr_ = 0; rr_ < RWR5; ++rr_) {
    for (int job = wave; job < 16; job += 8) {
        const int kind = job >> 2, ti = (job >> 1) & 1, tj = job & 1;
        const LAS bf16_t* a = (kind < 2 ? AT : RT) + 32 * ti * 72; const LAS bf16_t* bm = ((kind & 1) ? KT : BT) + 32 * tj * 72;
        f32x16 acc = {};
        if (!(ti == 0 && tj == 1)) acc = mm_ll<4>(a, 72, bm, 72, lane, acc);
#pragma unroll
        for (int g = 0; g < 16; ++g) { const int i = 32 * ti + crow(g, hi), j = 32 * tj + tl; const bool keep = (kind < 2) ? (j < i) : (j <= i); const float v = keep ? acc[g] : 0.f;
            if (kind == 0) MAB[i * 68 + j] = v; else (kind == 1 ? MAK : kind == 2 ? NRB : NRK)[i * 72 + j] = (bf16_t)f2bf(v); }
    }
    LBAR();
    }
    if (wave < 4) { const int ti = wave >> 1, tv = wave & 1; f32x16 acc = {}; acc = mm_ll<4>(MAK + 32 * ti * 72, 72, VC + 32 * tv * 72, 72, lane, acc);
#pragma unroll
        for (int g = 0; g < 16; ++g) X2[(32 * ti + crow(g, hi)) * 65 + 32 * tv + tl] = acc[g]; }
    LBAR();
    for (int bk = 0; bk < 4; ++bk) {
        const int r0 = 16 * bk;
        if (wave < 2) {
            LAS float* XX = wave ? X2 : X; float x[16];
#pragma unroll
            for (int i = 0; i < 16; ++i) x[i] = XX[(r0 + i) * 65 + lane];
#pragma unroll
            for (int i = 1; i < 16; ++i) { const LAS float* mr = MAB + (r0 + i) * 68 + r0; float a_ = x[i];
#pragma unroll
                for (int q = 0; q < (i + 3) / 4; ++q) { const f32x4 m4 = *(const LAS f32x4*)(mr + 4 * q);
#pragma unroll
                    for (int e = 0; e < 4; ++e) if (4 * q + e < i) a_ += m4[e] * x[4 * q + e]; }
                x[i] = a_; }
#pragma unroll
            for (int i = 1; i < 16; ++i) XX[(r0 + i) * 65 + lane] = x[i];
        }
        LBAR();
        if (bk < 3) {
            const int mat = wave >> 2, rt = (wave >> 1) & 1, ctl = wave & 1;
            if (32 * rt + 31 >= r0 + 16) {
                LAS float* XX = mat ? X2 : X;
                F8 av8, bv8;
#pragma unroll
                for (int e = 0; e < 8; ++e) { av8[e] = MAB[(32 * rt + tl) * 68 + r0 + 8 * hi + e]; bv8[e] = XX[(r0 + 8 * hi + e) * 65 + 32 * ctl + tl]; }
                f32x16 acc;
#pragma unroll
                for (int g = 0; g < 16; ++g) acc[g] = XX[(32 * rt + crow(g, hi)) * 65 + 32 * ctl + tl];
                acc = mfma32(pack8(av8), pack8(bv8), acc);
#pragma unroll
                for (int g = 0; g < 16; ++g) { const int i = 32 * rt + crow(g, hi); if (i >= r0 + 16) XX[i * 65 + 32 * ctl + tl] = acc[g]; }
            }
            LBAR();
        }
    }
    { const int k = tid >> 3, i0 = (tid & 7) * 8; F8 v, w;
#pragma unroll
        for (int e = 0; e < 8; ++e) { v[e] = X[(i0 + e) * 65 + k]; w[e] = X2[(i0 + e) * 65 + k]; }
        *(LAS bf16x8*)(W1C + k * 72 + i0) = pack8(v); *(LAS bf16x8*)(W2C + k * 72 + i0) = pack8(w); }
    LBAR();
    for (int rr_ = 0; rr_ < RWR11; ++rr_) {
    for (int job = wave; job < 16; job += 8) {
        const int kind = job >> 2, p = (job >> 1) & 1, q = job & 1; f32x16 acc = {};
        if (kind == 0) {
            acc = mm_ll<4>(W1C + 32 * p * 72, 72, NRB + 32 * q * 72, 72, lane, acc);
            FA fa;
#pragma unroll
            for (int g = 0; g < 16; ++g) fa[g] = acc[g] + bf2f(RT[(32 * q + tl) * 72 + 32 * p + crow(g, hi)]);
            st_frag(GT, (p * 2 + q) * 2 + 0, lane, packfrag(fa, 0)); st_frag(GT, (p * 2 + q) * 2 + 1, lane, packfrag(fa, 1));
        } else if (kind == 1) {
            acc = mm_ll<4>(W2C + 32 * p * 72, 72, NRB + 32 * q * 72, 72, lane, acc); acc = mm_ll<4>(VC + 32 * p * 72, 72, NRK + 32 * q * 72, 72, lane, acc);
            st_tile_bf16(Y0T, p * 2 + q, lane, acc);
        } else if (kind == 2) {
            acc = mm_ll<4>(W1C + 32 * p * 72, 72, BHC + 32 * q * 72, 72, lane, acc);
            FA fa = toFA(acc);
            if (p == q) { const float pc = fexp(LCv[32 * q + tl]);
#pragma unroll
                for (int g = 0; g < 16; ++g) if (crow(g, hi) == tl) fa[g] += pc; }
            st_frag(PHI, (p * 2 + q) * 2 + 0, lane, packfrag(fa, 0)); st_frag(PHI, (p * 2 + q) * 2 + 1, lane, packfrag(fa, 1));
        } else {
            acc = mm_ll<4>(BHC + 32 * p * 72, 72, W2C + 32 * q * 72, 72, lane, acc); acc = mm_ll<4>(KHC + 32 * p * 72, 72, VC + 32 * q * 72, 72, lane, acc);
            st_tile_bf16(PSI, p * 2 + q, lane, acc);
        }
    }
    LBAR();
    }
}

#undef LBAR
DI void rwkv_scan_wave(Ctx& C, int id) {
    const int vt = id & 1, bh = id >> 1, lane = C.lane;
    f32x16 S[2] = {{}, {}};
    for (int chunk = 0; chunk < 64; ++chunk) {
        const size_t chid = ((size_t)bh * 64 + chunk) * 8192;
        const unsigned char* PHI = C.ws + WS_PHI + chid; const unsigned char* PSI = C.ws + WS_PSI + chid; unsigned char* S0B = C.ws + WS_S0 + chid;
        bf16x8 sh[2][2], sl[2][2];
        f32x16 N[2];
#pragma unroll
        for (int ct = 0; ct < 2; ++ct) N[ct] = toV(ld_tile_bf16(PSI, ct * 2 + vt, lane));
        asm volatile("" ::: "memory");
#pragma unroll
        for (int cp = 0; cp < 2; ++cp)
#pragma unroll
            for (int s = 0; s < 2; ++s) { sh[cp][s] = packfrag(S[cp], s); st_frag(S0B, (cp * 2 + vt) * 2 + s, lane, sh[cp][s]);
                const u32x4 hw = __builtin_bit_cast(u32x4, sh[cp][s]); u32x4 lw;
#pragma unroll
                for (int q = 0; q < 4; ++q) lw[q] = pk2(S[cp][8 * s + 2 * q] - bflo(hw[q]), S[cp][8 * s + 2 * q + 1] - bfhi(hw[q]));
                sl[cp][s] = __builtin_bit_cast(bf16x8, lw); }
#pragma unroll
        for (int ct = 0; ct < 2; ++ct) {
#pragma unroll
            for (int cp = 0; cp < 2; ++cp)
#pragma unroll
                for (int s = 0; s < 2; ++s) { const bf16x8 ph = ld_frag(PHI, (cp * 2 + ct) * 2 + s, lane); N[ct] = mfma32(ph, sh[cp][s], N[ct]); N[ct] = mfma32(ph, sl[cp][s], N[ct]); } }
        S[0] = N[0]; S[1] = N[1];
    }
}

DI void rwkv_out_wave(Ctx& C, int id, int l) {
    const int chunk = id & 63, bh = id >> 6, b = bh >> 3, h = bh & 7, lane = C.lane, tl = lane & 31, hi = lane >> 5;
    const size_t chid = (size_t)id * 8192; const size_t tok0 = (size_t)b * SEQ + chunk * 64;
    const unsigned char* GT = C.ws + WS_GT + chid; const unsigned char* Y0T = C.ws + WS_Y0T + chid; const unsigned char* GGT = C.ws + WS_GGT + chid; const unsigned char* S0B = C.ws + WS_S0 + chid;
    const bf16_t* proj = (const bf16_t*)(C.ws + WS_PROJ);
    const float* mu = C.in(6) + (size_t)l * 1792; const float* gng = C.in(15) + l * 512 + 64 * h; const float* gnb = C.in(16) + l * 512 + 64 * h;
    const float* RHO = (const float*)(C.ws + WS_RHO);
    FA Y[2][2];
#pragma unroll
    for (int vt = 0; vt < 2; ++vt)
#pragma unroll
        for (int tt = 0; tt < 2; ++tt) { f32x16 acc = toV(ld_tile_bf16(Y0T, vt * 2 + tt, lane));
#pragma unroll
            for (int cp = 0; cp < 2; ++cp)
#pragma unroll
                for (int s = 0; s < 2; ++s) acc = mfma32(ld_frag(S0B, (cp * 2 + vt) * 2 + s, lane), ld_frag(GT, (cp * 2 + tt) * 2 + s, lane), acc);
            Y[vt][tt] = toFA(acc); }
#pragma unroll
    for (int tt = 0; tt < 2; ++tt) {
        float s1 = 0.f;
#pragma unroll
        for (int vt = 0; vt < 2; ++vt)
#pragma unroll
            for (int g = 0; g < 16; ++g) s1 += Y[vt][tt][g];
        s1 += __shfl_xor(s1, 32); const float mean = s1 * (1.f / 64.f);
        float s2 = 0.f;
#pragma unroll
        for (int vt = 0; vt < 2; ++vt)
#pragma unroll
            for (int g = 0; g < 16; ++g) { const float d = Y[vt][tt][g] - mean; s2 += d * d; }
        s2 += __shfl_xor(s2, 32); const float rstd = 1.f / sqrtf(s2 * (1.f / 64.f) + GN_EPS);
        const size_t row = tok0 + 32 * tt + tl; const bool first = (chunk == 0 && tt == 0 && tl == 0);
        const float rho = RHO[row * 8 + h];
#pragma unroll
        for (int vt = 0; vt < 2; ++vt) { const FA gt = ld_tile_bf16(GGT, vt * 2 + tt, lane);
#pragma unroll
            for (int i = 0; i < 4; ++i) { const int c = 32 * vt + 8 * i + 4 * hi;
                const f32x4 v4 = shift4(proj, row, first, PC_BV + 64 * h + c, mu + 1024 + 64 * h + c); const f32x4 gg = *(const f32x4*)(gng + c), gb = *(const f32x4*)(gnb + c);
                float o[4];
#pragma unroll
                for (int jj = 0; jj < 4; ++jj) { const int g = 4 * i + jj; o[jj] = ((Y[vt][tt][g] - mean) * rstd * gg[jj] + gb[jj] + rho * v4[jj]) * gt[g]; }
                u32x2 w; w.x = pk2(o[0], o[1]); w.y = pk2(o[2], o[3]); *(u32x2*)(C.mixcat + row * D + 512 + 64 * h + c) = w; } }
    }
}

constexpr int GB_OFF = 163840 - 256;
DI void gbar(LAS unsigned* cnt, unsigned& target, int lane) {
    asm volatile("s_waitcnt lgkmcnt(0)" ::: "memory");
    target += 4u;
    if (lane == 0) __hip_atomic_fetch_add(cnt, 1u, __ATOMIC_RELAXED, __HIP_MEMORY_SCOPE_WORKGROUP);
    while (__hip_atomic_load(cnt, __ATOMIC_RELAXED, __HIP_MEMORY_SCOPE_WORKGROUP) < target) __builtin_amdgcn_s_sleep(1);
    asm volatile("" ::: "memory");
}
DI void rwkv_chunk_acts4(Ctx& C, int bc, int l, bf16x8 (&actv)[8]) {
    const int chunk = bc & 63, b = bc >> 6, t = C.tid >> 2, cg = C.tid & 3; const size_t row = (size_t)b * SEQ + chunk * 64 + t; const bool first = (chunk == 0 && t == 0);
    const bf16_t* proj = (const bf16_t*)(C.ws + WS_PROJ); const float* mu = C.in(6) + (size_t)l * 1792;
#pragma unroll
    for (int q = 0; q < 8; ++q) { const int c8 = cg * 64 + 8 * q;
        if (c8 < 64) actv[q] = act_frag<1>(proj, row, first, PC_WD + c8, mu + 1536 + c8); else if (c8 < 128) actv[q] = act_frag<0>(proj, row, first, PC_WD + c8, mu + 1536 + c8); else actv[q] = act_frag<2>(proj, row, first, PC_WD + c8, mu + 1536 + c8); }
}
#ifndef RW4_12
#define RW4_12 1
#endif
#ifndef RW4_4
#define RW4_4 1
#endif
#ifndef RW4_5
#define RW4_5 1
#endif
#ifndef RW4_11
#define RW4_11 1
#endif
#define GBA() gbar(gcnt, gtarget, lane)
DI void rwkv_head_item4(Ctx& C, int item, int l, const bf16x8 (&actv)[8], LAS unsigned* gcnt, unsigned& gtarget) {
    const int h = item & 7, chunk = (item >> 3) & 63, b = item >> 9, tid = C.tid, lane = C.lane, wave = C.wave, tl = lane & 31, hi = lane >> 5;
    const size_t tok0 = (size_t)b * SEQ + chunk * 64;
    const bf16_t* proj = (const bf16_t*)(C.ws + WS_PROJ);
    const size_t chid = ((size_t)(b * 8 + h) * 64 + chunk) * 8192;
    unsigned char* PHI = C.ws + WS_PHI + chid; unsigned char* PSI = C.ws + WS_PSI + chid; unsigned char* GT = C.ws + WS_GT + chid; unsigned char* Y0T = C.ws + WS_Y0T + chid; unsigned char* GGT = C.ws + WS_GGT + chid;
    const bf16_t* WDT = (const bf16_t*)(C.ws + WS_LORA); const bf16_t* WAT = WDT + 512 * 64; const bf16_t* WGT = WAT + 512 * 64;
    const float* mu = C.in(6) + (size_t)l * 1792;
    const float* w0p = C.in(7) + l * 512 + 64 * h; const float* a0p = C.in(9) + l * 512 + 64 * h;
    const float* kkp = C.in(12) + l * 512 + 64 * h; const float* kap = C.in(13) + l * 512 + 64 * h; const float* rkp = C.in(14) + l * 512 + 64 * h;
    LAS bf16_t* ACT = (LAS bf16_t*)(C.lds + RL_ACT); LAS float* MAB = (LAS float*)(C.lds + RL_MAB); LAS bf16_t* W1C = (LAS bf16_t*)(C.lds + RL_W1C); LAS bf16_t* W2C = (LAS bf16_t*)(C.lds + RL_W2C);
    LAS float* ELL = (LAS float*)(C.lds + RL_ELL); LAS float* AV = (LAS float*)(C.lds + RL_AV);
    LAS bf16_t* MAK = (LAS bf16_t*)(C.lds + RL_MAK); LAS bf16_t* NRB = (LAS bf16_t*)(C.lds + RL_NRB); LAS bf16_t* NRK = (LAS bf16_t*)(C.lds + RL_NRK);
    LAS bf16_t* AT = (LAS bf16_t*)(C.lds + RL_AT); LAS bf16_t* RT = (LAS bf16_t*)(C.lds + RL_RT); LAS bf16_t* BT = (LAS bf16_t*)(C.lds + RL_BT); LAS bf16_t* KT = (LAS bf16_t*)(C.lds + RL_KT);
    LAS bf16_t* BHC = (LAS bf16_t*)(C.lds + RL_BHC); LAS bf16_t* KHC = (LAS bf16_t*)(C.lds + RL_KHC); LAS bf16_t* VC = (LAS bf16_t*)(C.lds + RL_VC);
    LAS float* X = (LAS float*)(C.lds + RL_X); LAS float* X2 = (LAS float*)(C.lds + RL_X2); LAS float* LCv = (LAS float*)(C.lds + RL_SM) + 64;
    GBA();
    for (int r_RW4_12 = 0; r_RW4_12 < RW4_12; ++r_RW4_12) { asm volatile("" ::: "memory");
    const int jp = (wave >> 1) & 1, jq = wave & 1;
    bf16x8 wg[8], wd[8];
    { const bf16_t* W = WGT + (size_t)(64 * h + 32 * jp + tl) * 128 + 8 * hi; const bf16_t* W0 = WDT + (size_t)(64 * h + 32 * jq + tl) * 64 + 8 * hi; const bf16_t* W1 = WAT + (size_t)(64 * h + 32 * jq + tl) * 64 + 8 * hi;
#pragma unroll
        for (int s = 0; s < 8; ++s) wg[s] = *(const bf16x8*)(W + 16 * s);
#pragma unroll
        for (int s = 0; s < 4; ++s) { wd[s] = *(const bf16x8*)(W0 + 16 * s); wd[4 + s] = *(const bf16x8*)(W1 + 16 * s); } }
    { const int t = tid >> 2, cg = tid & 3;
#pragma unroll
        for (int q = 0; q < 8; ++q) *(LAS bf16x8*)(ACT + t * 264 + cg * 64 + 8 * q) = actv[q]; }
    GBA();
    {
        const LAS bf16_t* bp = ACT + (32 * jq + tl) * 264 + 128 + 8 * hi; f32x16 acc = {};
#pragma unroll
        for (int s = 0; s < 8; ++s) acc = mfma32(wg[s], *(const LAS bf16x8*)(bp + 16 * s), acc);
        st_tile_bf16(GGT, jp * 2 + jq, lane, acc);
        const LAS bf16_t* ap = ACT + (32 * jp + tl) * 264 + 8 * hi; f32x16 a0 = {}, a1 = {};
#pragma unroll
        for (int s = 0; s < 4; ++s) { a0 = mfma32(*(const LAS bf16x8*)(ap + 16 * s), wd[s], a0); a1 = mfma32(*(const LAS bf16x8*)(ap + 64 + 16 * s), wd[4 + s], a1); }
        const int ch = 32 * jq + tl; const float w0c = w0p[ch], a0c = a0p[ch];
#pragma unroll
        for (int g = 0; g < 16; ++g) { const int t = 32 * jp + crow(g, hi); ELL[t * 65 + ch] = -fexp(-fsoftplus(-(w0c + a0[g])) - 0.5f); AV[t * 65 + ch] = fsigm(a0c + a1[g]); }
    }
    GBA();
    }
    { const int ch = tid & 63, seg = tid >> 6; float p[16]; float run = 0.f;
#pragma unroll
        for (int e = 0; e < 16; ++e) { run += ELL[(16 * seg + e) * 65 + ch]; p[e] = run; }
        X[seg * 65 + ch] = run;
        GBA();
        float off = 0.f;
#pragma unroll
        for (int s2 = 0; s2 < 3; ++s2) off += (s2 < seg) ? X[s2 * 65 + ch] : 0.f;
#pragma unroll
        for (int e = 0; e < 16; ++e) ELL[(16 * seg + e) * 65 + ch] = off + p[e];
        if (seg == 3) LCv[ch] = off + p[15]; }
    GBA();
    for (int r_RW4_4 = 0; r_RW4_4 < RW4_4; ++r_RW4_4) { asm volatile("" ::: "memory");
#pragma unroll 1
    for (int pass = 0; pass < 2; ++pass) { const int e_ = tid + 256 * pass; const int t = e_ >> 3, c0 = (e_ & 7) * 8; const size_t row = tok0 + t; const bool first = (chunk == 0 && t == 0); float rho = 0.f, n2 = 0.f;
        f32x4 r4[2], k4[2], v4[2];
#pragma unroll
        for (int q = 0; q < 2; ++q) { const int c = c0 + 4 * q;
            r4[q] = shift4(proj, row, first, PC_R + 64 * h + c, mu + 64 * h + c); k4[q] = shift4(proj, row, first, PC_BK + 64 * h + c, mu + 512 + 64 * h + c); v4[q] = shift4(proj, row, first, PC_BV + 64 * h + c, mu + 1024 + 64 * h + c);
            const f32x4 kr = k4[q] * *(const f32x4*)(kkp + c); n2 += (kr.x * kr.x + kr.y * kr.y) + (kr.z * kr.z + kr.w * kr.w); }
        n2 += __shfl_xor(n2, 1); n2 += __shfl_xor(n2, 2); n2 += __shfl_xor(n2, 4);
        const float inv = 1.f / fmaxf(sqrtf(n2), 1e-12f);
        F8 vA, vR, vB, vK;
#pragma unroll
        for (int q = 0; q < 2; ++q) { const int c = c0 + 4 * q;
            const f32x4 kk4 = *(const f32x4*)(kkp + c), ka4 = *(const f32x4*)(kap + c), rk4 = *(const f32x4*)(rkp + c);
#pragma unroll
            for (int jj = 0; jj < 4; ++jj) { const int ch = c + jj; const float a = AV[t * 65 + ch], L = ELL[t * 65 + ch], Lp = t ? ELL[(t - 1) * 65 + ch] : 0.f, LC = LCv[ch];
                const float kk = k4[q][jj] * kk4[jj] * inv, kp = k4[q][jj] * (1.f + (a - 1.f) * ka4[jj]), bb = kk * a;
                const float eL = fexp(L), eN = fexp(-L), eP = fexp(Lp), eD = fexp(LC - L);
                rho += r4[q][jj] * kp * rk4[jj];
                const float xa = -kk * eP; vA[4 * q + jj] = xa; vR[4 * q + jj] = r4[q][jj] * eL; vB[4 * q + jj] = bb * eN; vK[4 * q + jj] = kp * eN;
                X[t * 65 + ch] = xa; BHC[ch * 72 + t] = (bf16_t)f2bf(bb * eD); KHC[ch * 72 + t] = (bf16_t)f2bf(kp * eD); VC[ch * 72 + t] = (bf16_t)f2bf(v4[q][jj]); } }
        *(LAS bf16x8*)(AT + t * 72 + c0) = pack8(vA); *(LAS bf16x8*)(RT + t * 72 + c0) = pack8(vR); *(LAS bf16x8*)(BT + t * 72 + c0) = pack8(vB); *(LAS bf16x8*)(KT + t * 72 + c0) = pack8(vK);
        rho += __shfl_xor(rho, 1); rho += __shfl_xor(rho, 2); rho += __shfl_xor(rho, 4);
        if ((tid & 7) == 0) ((float*)(C.ws + WS_RHO))[row * 8 + h] = rho; }
    GBA();
    }
    for (int r_RW4_5 = 0; r_RW4_5 < RW4_5; ++r_RW4_5) { asm volatile("" ::: "memory");
    for (int job = wave; job < 16; job += 4) {
        const int kind = job >> 2, ti = (job >> 1) & 1, tj = job & 1;
        const LAS bf16_t* a = (kind < 2 ? AT : RT) + 32 * ti * 72; const LAS bf16_t* bm = ((kind & 1) ? KT : BT) + 32 * tj * 72;
        f32x16 acc = {};
        if (!(ti == 0 && tj == 1)) acc = mm_ll<4>(a, 72, bm, 72, lane, acc);
#pragma unroll
        for (int g = 0; g < 16; ++g) { const int i = 32 * ti + crow(g, hi), j = 32 * tj + tl; const bool keep = (kind < 2) ? (j < i) : (j <= i); const float v = keep ? acc[g] : 0.f;
            if (kind == 0) MAB[i * 68 + j] = v; else (kind == 1 ? MAK : kind == 2 ? NRB : NRK)[i * 72 + j] = (bf16_t)f2bf(v); }
    }
    GBA();
    }
    { const int ti = wave >> 1, tv = wave & 1; f32x16 acc = {}; acc = mm_ll<4>(MAK + 32 * ti * 72, 72, VC + 32 * tv * 72, 72, lane, acc);
#pragma unroll
        for (int g = 0; g < 16; ++g) X2[(32 * ti + crow(g, hi)) * 65 + 32 * tv + tl] = acc[g]; }
    GBA();
    for (int bk = 0; bk < 4; ++bk) {
        const int r0 = 16 * bk;
        if (wave < 2) {
            LAS float* XX = wave ? X2 : X; float x[16];
#pragma unroll
            for (int i = 0; i < 16; ++i) x[i] = XX[(r0 + i) * 65 + lane];
#pragma unroll
            for (int i = 1; i < 16; ++i) { const LAS float* mr = MAB + (r0 + i) * 68 + r0; float a_ = x[i];
#pragma unroll
                for (int q = 0; q < (i + 3) / 4; ++q) { const f32x4 m4 = *(const LAS f32x4*)(mr + 4 * q);
#pragma unroll
                    for (int e = 0; e < 4; ++e) if (4 * q + e < i) a_ += m4[e] * x[4 * q + e]; }
                x[i] = a_; }
#pragma unroll
            for (int i = 1; i < 16; ++i) XX[(r0 + i) * 65 + lane] = x[i];
        }
        GBA();
        if (bk < 3) {
            for (int tq = wave; tq < 8; tq += 4) { const int mat = tq >> 2, rt = (tq >> 1) & 1, ctl = tq & 1;
                if (32 * rt + 31 >= r0 + 16) {
                    LAS float* XX = mat ? X2 : X;
                    F8 av8, bv8;
#pragma unroll
                    for (int e = 0; e < 8; ++e) { av8[e] = MAB[(32 * rt + tl) * 68 + r0 + 8 * hi + e]; bv8[e] = XX[(r0 + 8 * hi + e) * 65 + 32 * ctl + tl]; }
                    f32x16 acc;
#pragma unroll
                    for (int g = 0; g < 16; ++g) acc[g] = XX[(32 * rt + crow(g, hi)) * 65 + 32 * ctl + tl];
                    acc = mfma32(pack8(av8), pack8(bv8), acc);
#pragma unroll
                    for (int g = 0; g < 16; ++g) { const int i = 32 * rt + crow(g, hi); if (i >= r0 + 16) XX[i * 65 + 32 * ctl + tl] = acc[g]; }
                } }
            GBA();
        }
    }
#pragma unroll 1
    for (int pass = 0; pass < 2; ++pass) { const int e_ = tid + 256 * pass; const int k = e_ >> 3, i0 = (e_ & 7) * 8; F8 v, w;
#pragma unroll
        for (int e = 0; e < 8; ++e) { v[e] = X[(i0 + e) * 65 + k]; w[e] = X2[(i0 + e) * 65 + k]; }
        *(LAS bf16x8*)(W1C + k * 72 + i0) = pack8(v); *(LAS bf16x8*)(W2C + k * 72 + i0) = pack8(w); }
    GBA();
    for (int r_11 = 0; r_11 < RW4_11; ++r_11) { asm volatile("" ::: "memory");
    for (int job = wave; job < 16; job += 4) {
        const int kind = job >> 2, p = (job >> 1) & 1, q = job & 1; f32x16 acc = {};
        if (kind == 0) {
            acc = mm_ll<4>(W1C + 32 * p * 72, 72, NRB + 32 * q * 72, 72, lane, acc);
            FA fa;
#pragma unroll
            for (int g = 0; g < 16; ++g) fa[g] = acc[g] + bf2f(RT[(32 * q + tl) * 72 + 32 * p + crow(g, hi)]);
            st_frag(GT, (p * 2 + q) * 2 + 0, lane, packfrag(fa, 0)); st_frag(GT, (p * 2 + q) * 2 + 1, lane, packfrag(fa, 1));
        } else if (kind == 1) {
            acc = mm_ll<4>(W2C + 32 * p * 72, 72, NRB + 32 * q * 72, 72, lane, acc); acc = mm_ll<4>(VC + 32 * p * 72, 72, NRK + 32 * q * 72, 72, lane, acc);
            st_tile_bf16(Y0T, p * 2 + q, lane, acc);
        } else if (kind == 2) {
            acc = mm_ll<4>(W1C + 32 * p * 72, 72, BHC + 32 * q * 72, 72, lane, acc);
            FA fa = toFA(acc);
            if (p == q) { const float pc = fexp(LCv[32 * q + tl]);
#pragma unroll
                for (int g = 0; g < 16; ++g) if (crow(g, hi) == tl) fa[g] += pc; }
            st_frag(PHI, (p * 2 + q) * 2 + 0, lane, packfrag(fa, 0)); st_frag(PHI, (p * 2 + q) * 2 + 1, lane, packfrag(fa, 1));
        } else {
            acc = mm_ll<4>(BHC + 32 * p * 72, 72, W2C + 32 * q * 72, 72, lane, acc); acc = mm_ll<4>(KHC + 32 * p * 72, 72, VC + 32 * q * 72, 72, lane, acc);
            st_tile_bf16(PSI, p * 2 + q, lane, acc);
        }
    }
    }
}
#undef GBA

typedef float f32x2 __attribute__((ext_vector_type(2)));
constexpr int IX4 = RL_END, IX4_CAP = 256;
#ifndef IX_PF
#define IX_PF 2
#endif
#ifndef IXR_SEL
#define IXR_SEL 1
#endif
#define GBB() gbar(gcnt, gtarget, lane)
DI void ld_ktile(const _Float16* kbase, int kt, int ktmax, f16x8 (&d)[4]) {
    const _Float16* p = kbase + (size_t)(32 * min(kt, ktmax)) * PLD;
#pragma unroll
    for (int s = 0; s < 4; ++s) d[s] = *(const f16x8*)(p + 16 * s);
}
DI void idx_item4(Ctx& C, int item, int l, const int ixb, LAS unsigned* gcnt, unsigned& gtarget) {
    const int b = item & 3, qt = 1023 - (item >> 2);
    const int t0 = qt * 4, chunk = t0 >> 6, NT32 = 2 * (chunk + 1);
    const size_t tok0 = (size_t)b * SEQ + t0;
    unsigned* bm = (unsigned*)(C.ws + WS_BM);
    int lane = C.lane, wave = C.wave & 3, tid = C.tid & 255;
    asm volatile("" : "+v"(lane), "+v"(tid), "+s"(wave));
    if (chunk < 4) {
        if (tid < 4 * NT32) { const int q = tid / NT32, kt = tid % NT32; bm[(tok0 + q) * 128 + kt] = 0xffffffffu; }
        return;
    }
    const _Float16* ph = (const _Float16*)(C.ws + WS_PROJ);
    LAS unsigned* hist = (LAS unsigned*)(C.lds + ixb);
    LAS float* cand = (LAS float*)(C.lds + ixb + 4096);
    LAS float* redmn = (LAS float*)(C.lds + ixb + 4096 + 8 * IX4_CAP * 4);
    LAS float* redmx = redmn + 16;
    LAS unsigned* ccount = (LAS unsigned*)(redmx + 16);
    LAS float* thrS = (LAS float*)(ccount + 4);
    LAS int* thrI = (LAS int*)(thrS + 4);
    LAS unsigned* ovf = (LAS unsigned*)(thrI + 4);
    LAS unsigned* fbT = ovf + 4;
    LAS unsigned* fbCnt = fbT + 4;
    LAS unsigned* fbNeed = fbCnt + 4;
    const int r = lane & 31, hh = lane >> 5;
    float sc[32][2];
    {
        f16x8 afr[4]; float wq[2][8];
        {
            const int gq = (r >> 2) & 1, i = r >> 3, jj = r & 3, query = 2 * gq + (i >> 1), head = 4 * (i & 1) + jj;
            const _Float16* qp = ph + (tok0 + query) * PLD + PC_QI + head * 64 + 8 * hh;
#pragma unroll
            for (int s = 0; s < 4; ++s) afr[s] = *(const f16x8*)(qp + 16 * s);
#pragma unroll
            for (int qq = 0; qq < 2; ++qq) { const int q2 = 2 * hh + qq; const f16x8 wv = *(const f16x8*)(ph + (tok0 + q2) * PLD + PC_WI);
#pragma unroll
                for (int e = 0; e < 8; ++e) wq[qq][e] = (float)wv[e] * 0.044194173824159216f; }
        }
        const _Float16* kbase = ph + ((size_t)b * SEQ + r) * PLD + PC_KI + 8 * hh;
        f16x8 bq[IX_PF][4];
#pragma unroll
        for (int d = 0; d < IX_PF - 1; ++d) ld_ktile(kbase, wave + 4 * d, NT32 - 1, bq[d]);
#pragma unroll
        for (int it = 0; it < 32; ++it) {
            const int kt = wave + 4 * it;
            if (kt < NT32) {
                if (kt + 4 * (IX_PF - 1) < NT32) ld_ktile(kbase, kt + 4 * (IX_PF - 1), NT32 - 1, bq[(it + IX_PF - 1) % IX_PF]);
                f32x16 c = {};
#pragma unroll
                for (int s = 0; s < 4; ++s) c = __builtin_amdgcn_mfma_f32_32x32x16_f16(afr[s], bq[it % IX_PF][s], c, 0, 0, 0);
#pragma unroll
                for (int qq = 0; qq < 2; ++qq) { float a = 0.f;
#pragma unroll
                    for (int e = 0; e < 8; ++e) a += wq[qq][e] * fmaxf(c[8 * qq + e], 0.f);
                    sc[it][qq] = a; }
            } else { sc[it][0] = -3.0e38f; sc[it][1] = -3.0e38f; }
        }
    }
    for (int rl_ = 0; rl_ < IXR_SEL; ++rl_) { asm volatile("" ::: "memory");
    float mn[2], mx[2];
#pragma unroll
    for (int qq = 0; qq < 2; ++qq) { float me = -3.0e38f, mo = -3.0e38f;
#pragma unroll
        for (int it = 0; it < 32; it += 2) { me = fmaxf(me, sc[it][qq]); mo = fmaxf(mo, sc[it + 1][qq]); }
        float a = fminf(me, mo), z = fmaxf(me, mo);
#pragma unroll
        for (int o = 1; o < 32; o <<= 1) { a = fminf(a, __shfl_xor(a, o)); z = fmaxf(z, __shfl_xor(z, o)); }
        mn[qq] = a; mx[qq] = z; }
    if (r == 0) {
#pragma unroll
        for (int qq = 0; qq < 2; ++qq) { const int qid = 2 * hh + qq; redmn[wave * 4 + qid] = mn[qq]; redmx[wave * 4 + qid] = mx[qq]; }
    }
    { u32x4 z4 = {0u, 0u, 0u, 0u}; *(LAS u32x4*)(hist + 4 * tid) = z4; }
    if (tid < 4) { ccount[tid] = 0u; ovf[tid] = 0u; }
    GBB();
    unsigned pk[2][8];
#pragma unroll
    for (int qq = 0; qq < 2; ++qq) { const int qid = 2 * hh + qq; float a = 3.0e38f, z = -3.0e38f;
#pragma unroll
        for (int w = 0; w < 4; ++w) { a = fminf(a, redmn[w * 4 + qid]); z = fmaxf(z, redmx[w * 4 + qid]); }
        const float scl = (z > a) ? fminf(253.f / (z - a), 1.0e30f) : 1.f; const float nlo = 1.5f - a * scl;
#pragma unroll
        for (int g8 = 0; g8 < 8; ++g8) { unsigned p = 0u;
            if (wave + 16 * g8 < NT32) {
#pragma unroll
                for (int e = 0; e < 4; ++e) p = __builtin_amdgcn_cvt_pk_u8_f32(__builtin_amdgcn_fmed3f(__builtin_fmaf(sc[4 * g8 + e][qq], scl, nlo), 0.f, 255.f), e, p);
#pragma unroll
                for (int e = 0; e < 4; ++e) { const unsigned pb = (p >> (8 * e)) & 255u; if (pb) __hip_atomic_fetch_add(hist + qid * 256 + pb, 1u, __ATOMIC_RELAXED, __HIP_MEMORY_SCOPE_WORKGROUP); }
            }
            pk[qq][g8] = p; } }
    GBB();
    int B[2]; unsigned above[2];
#pragma unroll
    for (int qq = 0; qq < 2; ++qq) { const int qid = 2 * hh + qq;
        const u32x4 h0 = *(const LAS u32x4*)(hist + qid * 256 + 8 * r), h1 = *(const LAS u32x4*)(hist + qid * 256 + 8 * r + 4);
        const unsigned tot = (h0.x + h0.y) + (h0.z + h0.w) + (h1.x + h1.y) + (h1.z + h1.w); unsigned incl = tot;
#pragma unroll
        for (int o = 1; o < 32; o <<= 1) { const unsigned v = __shfl_down(incl, o, 32); if (r + o < 32) incl += v; }
        unsigned run = incl - tot; int Bf = -1; unsigned ab = 0; const unsigned hv8[8] = {h0.x, h0.y, h0.z, h0.w, h1.x, h1.y, h1.z, h1.w};
#pragma unroll
        for (int j = 7; j >= 0; --j) { const unsigned hv = hv8[j]; if (run < 256u && run + hv >= 256u) { Bf = 8 * r + j; ab = run; } run += hv; }
        const unsigned long long mk = __ballot(Bf >= 0);
        const unsigned mh = hh ? (unsigned)(mk >> 32) : (unsigned)mk;
        const int src = 32 * hh + (mh ? __builtin_ctz(mh) : 0);
        B[qq] = __shfl(Bf, src); above[qq] = (unsigned)__shfl((int)ab, src); }
#define IX_PB(it, qq) ((int)((pk[qq][(it) >> 2] >> (8 * ((it) & 3))) & 255u))
#define IX_LAUNDER() do { _Pragma("unroll") for (int it_ = 0; it_ < 32; ++it_) { asm volatile("" : "+v"(sc[it_][0]), "+v"(sc[it_][1])); } asm volatile("" : "+v"(B[0]), "+v"(B[1])); } while (0)
#pragma unroll
    for (int qq = 0; qq < 2; ++qq) { const int qid = 2 * hh + qq;
#pragma unroll
        for (int g8 = 0; g8 < 8; ++g8) if (wave + 16 * g8 < NT32) {
#pragma unroll
            for (int e = 0; e < 4; ++e) { const int it = 4 * g8 + e; const bool hit = (IX_PB(it, qq) == B[qq]);
                if (__any(hit)) { if (hit) { const unsigned pos = __hip_atomic_fetch_add(ccount + qid, 1u, __ATOMIC_RELAXED, __HIP_MEMORY_SCOPE_WORKGROUP);
                    if (pos < (unsigned)IX4_CAP) { f32x2 cv; cv.x = sc[it][qq]; cv.y = __builtin_bit_cast(float, 32 * (wave + 4 * it) + r); *(LAS f32x2*)(cand + (qid * IX4_CAP + pos) * 2) = cv; } } } } } }
    GBB();
    {
        const int c = (int)ccount[wave];
        const unsigned abq = (wave & 1) ? above[1] : above[0];
        const int need = 256 - (int)__shfl((int)abq, 32 * (wave >> 1));
        if (c <= IX4_CAP) {
            LAS float* cw = cand + wave * IX4_CAP * 2;
            if ((c & 1) && lane == 0) { f32x2 cv; cv.x = -3.0e38f; cv.y = __builtin_bit_cast(float, 0x7fffffff); *(LAS f32x2*)(cw + 2 * c) = cv; }
            asm volatile("" ::: "memory");
            for (int i = lane; i < c; i += 64) { const f32x2 ci = *(const LAS f32x2*)(cw + 2 * i); const float si = ci.x; const int ii = __float_as_int(ci.y); int rank = 0;
                for (int j = 0; j < c; j += 2) { const f32x4 cj = *(const LAS f32x4*)(cw + 2 * j);
                    rank += ((cj.x > si) || (cj.x == si && __float_as_int(cj.y) < ii)) ? 1 : 0; rank += ((cj.z > si) || (cj.z == si && __float_as_int(cj.w) < ii)) ? 1 : 0; }
                if (rank == need - 1) { thrS[wave] = si; thrI[wave] = ii; } }
        } else if (lane == 0) { ovf[wave] = 1u; fbNeed[wave] = (unsigned)need; fbT[wave] = 0u; }
    }
    GBB();
    unsigned anyovf = 0u;
#pragma unroll
    for (int q = 0; q < 4; ++q) anyovf |= ovf[q];
#ifndef IX_NOFB
#define IX_NOFB 0
#endif
    if (anyovf && !IX_NOFB) {
        for (int bit = 31; bit >= 0; --bit) {
            if (tid < 4) fbCnt[tid] = 0u;
            GBB();
            IX_LAUNDER();
#pragma unroll
            for (int qq = 0; qq < 2; ++qq) { const int qid = 2 * hh + qq; if (ovf[qid]) { const unsigned cd = fbT[qid] | (1u << bit); unsigned cnt = 0;
#pragma unroll
                for (int it = 0; it < 32; ++it) cnt += (IX_PB(it, qq) == B[qq] && ordkey(sc[it][qq]) >= cd) ? 1u : 0u;
                if (cnt) __hip_atomic_fetch_add(fbCnt + qid, cnt, __ATOMIC_RELAXED, __HIP_MEMORY_SCOPE_WORKGROUP); } }
            GBB();
            if (tid < 4 && ovf[tid] && fbCnt[tid] >= fbNeed[tid]) fbT[tid] |= (1u << bit);
            GBB();
        }
        if (tid < 4) fbCnt[tid] = 0u;
        GBB();
        IX_LAUNDER();
#pragma unroll
        for (int qq = 0; qq < 2; ++qq) { const int qid = 2 * hh + qq; if (ovf[qid]) { const unsigned Tk = fbT[qid]; unsigned cnt = 0;
#pragma unroll
            for (int it = 0; it < 32; ++it) cnt += (IX_PB(it, qq) == B[qq] && ordkey(sc[it][qq]) > Tk) ? 1u : 0u;
            if (cnt) __hip_atomic_fetch_add(fbCnt + qid, cnt, __ATOMIC_RELAXED, __HIP_MEMORY_SCOPE_WORKGROUP); } }
        GBB();
        if (tid < 4 && ovf[tid]) { fbNeed[tid] -= fbCnt[tid]; thrS[tid] = unordkey(fbT[tid]); thrI[tid] = 0; }
        GBB();
        for (int bit = 11; bit >= 0; --bit) {
            if (tid < 4) fbCnt[tid] = 0u;
            GBB();
            IX_LAUNDER();
#pragma unroll
            for (int qq = 0; qq < 2; ++qq) { const int qid = 2 * hh + qq; if (ovf[qid]) { const unsigned Tk = fbT[qid]; const int cd = thrI[qid] | (1 << bit); unsigned cnt = 0;
#pragma unroll
                for (int it = 0; it < 32; ++it) cnt += (IX_PB(it, qq) == B[qq] && ordkey(sc[it][qq]) == Tk && (32 * (wave + 4 * it) + r) < cd) ? 1u : 0u;
                if (cnt) __hip_atomic_fetch_add(fbCnt + qid, cnt, __ATOMIC_RELAXED, __HIP_MEMORY_SCOPE_WORKGROUP); } }
            GBB();
            if (tid < 4 && ovf[tid] && fbCnt[tid] < fbNeed[tid]) thrI[tid] |= (1 << bit);
            GBB();
        }
    }
#pragma unroll
    for (int qq = 0; qq < 2; ++qq) { const int qid = 2 * hh + qq; const float ts = thrS[qid]; const int ti = thrI[qid] - 32 * wave - r;
        unsigned myw = 0u;
#pragma unroll
        for (int g8 = 0; g8 < 8; ++g8) if (wave + 16 * g8 < NT32) {
#pragma unroll
            for (int e = 0; e < 4; ++e) { const int it = 4 * g8 + e; const float s = sc[it][qq];
                const bool sel = (s > ts) | ((s == ts) & (128 * it <= ti));
                const unsigned long long mk = __builtin_amdgcn_ballot_w64(sel);
                const unsigned wv = hh ? (unsigned)(mk >> 32) : (unsigned)mk;
                if (r == it) myw = wv; } }
        if (wave + 4 * r < NT32) bm[(tok0 + qid) * 128 + wave + 4 * r] = myw; }
    }
#undef IX_PB
#undef IX_LAUNDER
}
#undef GBB

DI void phase_ln_router(Ctx& C, int l) {
    const bf16_t* V = (const bf16_t*)(C.ws + WS_V);
    const float* g = C.in(25) + (size_t)l * D; const float* bta = C.in(26) + (size_t)l * D;
    const float* wr = C.in(18); const float* br = C.in(19);
    LAS unsigned* lcnt = (LAS unsigned*)C.lds; LAS unsigned* base = lcnt + 16; LAS int* rec = (LAS int*)(C.lds + 128);
    TokInfo* tok = (TokInfo*)(C.ws + WS_TOK); RowInfo* rowi = (RowInfo*)(C.ws + WS_ROW);
    unsigned* gcnt = C.ctl + CW_GCNT + 64 * l;
    for (int i = C.blk * NTHR + C.tid; i < MAXROWS; i += C.G * NTHR) { RowInfo ri; ri.token = -1; ri.slot = 0; ri.gate = 0.f; ri.pad = 0; rowi[i] = ri; }
    LAS float* wT = (LAS float*)(C.lds + 4096);
    __syncthreads();
    for (int i = C.tid; i < D * 16; i += NTHR) { const int d = i >> 4, e = i & 15; wT[e * D + d] = wr[i]; }
    for (int rb = C.blk; rb < T / 64; rb += C.G) {
        __syncthreads();
        if (C.tid < 16) lcnt[C.tid] = 0u;
        __syncthreads();
        for (int i4 = 0; i4 < 8; i4 += 2) {
          f32x4 vv[8]; float lgg[32];
          { u32x2 raw[8];
#pragma unroll
            for (int r = 0; r < 2; ++r)
#pragma unroll
                for (int j = 0; j < 4; ++j) raw[4 * r + j] = *(const u32x2*)(V + ((size_t)rb * 64 + C.wave * 8 + i4 + r) * D + 256 * j + 4 * C.lane);
#pragma unroll
            for (int r = 0; r < 2; ++r) { f32x4 t[4];
#pragma unroll
                for (int j = 0; j < 4; ++j) { const u32x2 o = raw[4 * r + j]; t[j] = (f32x4){bflo(o.x), bfhi(o.x), bflo(o.y), bfhi(o.y)}; }
                ln16(t, g, bta, C.lane);
                store_row_bf16(C.xcur + ((size_t)rb * 64 + C.wave * 8 + i4 + r) * D, t, C.lane);
#pragma unroll
                for (int j = 0; j < 4; ++j) vv[4 * r + j] = t[j]; } }
#pragma unroll
          for (int k = 0; k < 32; ++k) lgg[k] = 0.f;
#pragma unroll
          for (int e = 0; e < 16; ++e)
#pragma unroll
              for (int j = 0; j < 4; ++j) { const f32x4 w4 = *(const LAS f32x4*)(wT + e * D + 256 * j + 4 * C.lane);
#pragma unroll
                  for (int r = 0; r < 2; ++r) { const f32x4 x = vv[4 * r + j]; lgg[16 * r + e] += (x.x * w4.x + x.y * w4.y) + (x.z * w4.z + x.w * w4.w); } }
#pragma unroll
          for (int k = 0; k < 32; ++k) lgg[k] = wave_sum(lgg[k]);
#pragma unroll
          for (int r = 0; r < 2; ++r) {
            const int lr = C.wave * 8 + i4 + r;
            float sc[16], sl[16];
#pragma unroll
            for (int e = 0; e < 16; ++e) { const float t = lgg[16 * r + e]; sc[e] = 1.f / (1.f + expf(-t)); sl[e] = sc[e] + br[e]; }
            int best = 0; float bestv = -3.0e38f;
#pragma unroll
            for (int gq = 0; gq < 4; ++gq) { const float a = sl[4 * gq], b2 = sl[4 * gq + 1], c2 = sl[4 * gq + 2], d2 = sl[4 * gq + 3];
                const float mx1 = fmaxf(fmaxf(a, b2), fmaxf(c2, d2)); const float tot = a + b2 + c2 + d2; const float mn1 = fminf(fminf(a, b2), fminf(c2, d2));
                const float lo1 = fminf(a, b2), hi1 = fmaxf(a, b2), lo2 = fminf(c2, d2), hi2 = fmaxf(c2, d2);
                const float second = fmaxf(fminf(hi1, hi2), fmaxf(lo1, lo2));
                (void)tot; (void)mn1;
                const float gs = mx1 + second; if (gs > bestv) { bestv = gs; best = gq; } }
            int i0 = 0, i1 = 0; float v0 = -3.0e38f, v1 = -3.0e38f, s0 = 0.f, s1 = 0.f;
#pragma unroll
            for (int gq = 0; gq < 4; ++gq) if (gq == best) {
#pragma unroll
                for (int k = 0; k < 4; ++k) { const float x = sl[4 * gq + k]; if (x > v0) { v1 = v0; i1 = i0; s1 = s0; v0 = x; i0 = 4 * gq + k; s0 = sc[4 * gq + k]; } else if (x > v1) { v1 = x; i1 = 4 * gq + k; s1 = sc[4 * gq + k]; } } }
            const float den = s0 + s1; const float g0 = s0 / den, g1 = s1 / den;
            if (C.lane == 0) {
                const unsigned r0 = __hip_atomic_fetch_add(lcnt + i0, 1u, __ATOMIC_RELAXED, __HIP_MEMORY_SCOPE_WORKGROUP);
                const unsigned r1 = __hip_atomic_fetch_add(lcnt + i1, 1u, __ATOMIC_RELAXED, __HIP_MEMORY_SCOPE_WORKGROUP);
                rec[lr * 8 + 0] = i0; rec[lr * 8 + 1] = i1; rec[lr * 8 + 2] = (int)r0; rec[lr * 8 + 3] = (int)r1;
                rec[lr * 8 + 4] = __builtin_bit_cast(int, g0); rec[lr * 8 + 5] = __builtin_bit_cast(int, g1); }
          }
        }
        __syncthreads();
        if (C.tid < 16) base[C.tid] = __hip_atomic_fetch_add(gcnt + C.tid, lcnt[C.tid], __ATOMIC_RELAXED, __HIP_MEMORY_SCOPE_AGENT);
        __syncthreads();
        if (C.tid < 64) { TokInfo ti; ti.e0 = rec[C.tid * 8]; ti.e1 = rec[C.tid * 8 + 1]; ti.p0 = rec[C.tid * 8 + 2] + (int)base[ti.e0]; ti.p1 = rec[C.tid * 8 + 3] + (int)base[ti.e1];
            ti.g0 = __builtin_bit_cast(float, rec[C.tid * 8 + 4]); ti.g1 = __builtin_bit_cast(float, rec[C.tid * 8 + 5]); ti.pad0 = 0; ti.pad1 = 0; tok[(size_t)rb * 64 + C.tid] = ti; }
    }
}
DI int build_tile_table(Ctx& C, int l, LAS int* toff, LAS int* texp) {
    const unsigned* gcnt = C.ctl + CW_GCNT + 64 * l;
    __syncthreads();
    if (C.tid < 64) {
        int c = 0; if (C.lane < 16) c = (int)__hip_atomic_load(gcnt + C.lane, __ATOMIC_RELAXED, __HIP_MEMORY_SCOPE_AGENT);
        const int nt = (c + 255) >> 8; int incl = nt;
#pragma unroll
        for (int o = 1; o < 16; o <<= 1) { const int v = __shfl_up(incl, o); if (C.lane >= o) incl += v; }
        const int start = incl - nt;
        if (C.lane < 16) { toff[C.lane] = start << 8; for (int t = 0; t < nt; ++t) texp[start + t] = C.lane; }
        if (C.lane == 15) toff[16] = incl << 8; }
    __syncthreads();
    return toff[16] >> 8;
}
DI void phase_gather(Ctx& C, int l) {
    LAS int* toff = (LAS int*)(C.lds + 1024); LAS int* texp = (LAS int*)(C.lds + 2048);
    (void)build_tile_table(C, l, toff, texp);
    const TokInfo* tok = (const TokInfo*)(C.ws + WS_TOK); RowInfo* rowi = (RowInfo*)(C.ws + WS_ROW); bf16_t* AG = (bf16_t*)(C.ws + WS_AG);
    for (int m = C.blk * NTHR + C.tid; m < T; m += C.G * NTHR) {
        const TokInfo ti = tok[m];
        const int r0 = toff[ti.e0] + ti.p0, r1 = toff[ti.e1] + ti.p1;
        { RowInfo x; x.token = m; x.slot = 0; x.gate = ti.g0; x.pad = 0; rowi[r0] = x; x.slot = 1; x.gate = ti.g1; rowi[r1] = x; }
    }
}
DI void phase_ln_ffn(Ctx& C, int l) {
    const bf16_t* Y = (const bf16_t*)(C.ws + WS_Y);
    const float* g = C.in(27) + (size_t)l * D; const float* bta = C.in(28) + (size_t)l * D;
    const int gw = C.blk * NWAVES + C.wave, NGW = C.G * NWAVES;
    for (int m = gw; m < T; m += NGW) {
        f32x4 x[4], y0[4], y1[4];
        load_row_bf16(C.xcur + (size_t)m * D, x, C.lane); load_row_bf16(Y + (size_t)m * D, y0, C.lane); load_row_bf16(Y + ((size_t)T + m) * D, y1, C.lane);
#pragma unroll
        for (int j = 0; j < 4; ++j) x[j] = x[j] * ALPHA + (y0[j] + y1[j]);
        ln16(x, g, bta, C.lane);
        store_row_bf16(C.xcur + (size_t)m * D, x, C.lane);
    }
}
DI void phase_ln_ple(Ctx& C, int l, bool last) {
    const bf16_t* V = (const bf16_t*)(C.ws + WS_V3);
    const float* g = C.in(29) + (size_t)l * D; const float* bta = C.in(30) + (size_t)l * D;
    const int gw = C.blk * NWAVES + C.wave, NGW = C.G * NWAVES;
    for (int m = gw; m < T; m += NGW) {
        f32x4 v[4];
        load_row_bf16(V + (size_t)m * D, v, C.lane);
        ln16(v, g, bta, C.lane);
        if (last) {
#ifdef PROBE_PHASE
            { const unsigned long long* pt = (const unsigned long long*)(C.ws + WS_CTL + 32768); const float sc = 1.f + (float)(pt[1] - pt[0]) * (float)(PROBE_SCALE);
#pragma unroll
              for (int j = 0; j < 4; ++j) v[j] = v[j] * sc; }
#endif
#pragma unroll
            for (int j = 0; j < 4; ++j) *(f32x4*)(C.out + (size_t)m * D + 256 * j + 4 * C.lane) = v[j];
        } else store_row_bf16(C.xcur + (size_t)m * D, v, C.lane);
    }
}

constexpr int LDS_BYTES = 163840;
constexpr int PH_PER_LAYER = 13, NPHASE = 1 + DEPTH * PH_PER_LAYER;

constexpr int CW_AQ = 2048;
DI void convert_mixer_weights(Ctx& C, int l) {
    int first = 0;
    { ColPlain c{C.in(5) + (size_t)l * D * D}; convert_matrix(C, c, D, D, D, (bf16_t*)(C.ws + WS_WOUT), first); }
    { ColPlain c{C.in(8) + (size_t)l * 64 * 512}; convert_matrix(C, c, 512, 64, 512, (bf16_t*)(C.ws + WS_LORA), first); }
    { ColPlain c{C.in(10) + (size_t)l * 64 * 512}; convert_matrix(C, c, 512, 64, 512, (bf16_t*)(C.ws + WS_LORA) + 512 * 64, first); }
    { ColPlain c{C.in(11) + (size_t)l * 128 * 512}; convert_matrix(C, c, 512, 128, 512, (bf16_t*)(C.ws + WS_LORA) + 2 * 512 * 64, first); }
}
DI void convert_ffn_weights(Ctx& C, int l) {
    int first = 0;
    { ColGateUp c{C.in(20) + (size_t)l * NEXP * D * DEXP, C.in(21) + (size_t)l * NEXP * D * DEXP}; convert_matrix(C, c, DEXP, D, NEXP * 512, (bf16_t*)(C.ws + WS_WEXP), first); }
    for (int e = 0; e < NEXP; ++e) { ColDown c{C.in(22) + ((size_t)l * NEXP + e) * DEXP * D}; convert_matrix(C, c, D, DEXP, D, (bf16_t*)(C.ws + WS_WDOWN) + (size_t)e * D * DEXP, first); }
    { ColPlain c{C.in(24) + (size_t)l * D * D}; convert_matrix(C, c, D, D, D, (bf16_t*)(C.ws + WS_WPG), first); }
    { ColPlain c{C.in(23) + (size_t)l * PLE * D}; convert_matrix(C, c, D, PLE, D, (bf16_t*)(C.ws + WS_WPLE), first); }
    const float* p = C.in(1) + (size_t)l * T * PLE; bf16_t* pb = (bf16_t*)(C.ws + WS_PBF);
    for (size_t i = ((size_t)C.blk * NTHR + C.tid) * 8; i < (size_t)T * PLE; i += (size_t)C.G * NTHR * 8) {
        const f32x4 a = *(const f32x4*)(p + i), b = *(const f32x4*)(p + i + 4);
        u32x4 o; o.x = pk2(a.x, a.y); o.y = pk2(a.z, a.w); o.z = pk2(b.x, b.y); o.w = pk2(b.z, b.w); *(u32x4*)(pb + i) = o; }
}
#ifndef RWREP
#define RWREP 1
#endif
#ifndef IQREP
#define IQREP 1
#endif
#ifndef REP_SUB
#define REP_SUB 0
#endif
#ifndef REP_SP
#define REP_SP -1
#define REP_N 1
#endif
template <int SP> DI void run_sp_(Ctx& C, const int l, const int rep);
template <int SP> DI void run_sp(Ctx& C, const int l) { run_sp_<SP>(C, l, 0); }
template <int SP> DI void run_sp_(Ctx& C, const int l, const int rep) {
    if constexpr (SP == 0) {
        pg8::Gemm g{C.xcur, (const bf16_t*)(C.ws + WS_WEXP), T, NPROJ_PAD, opaque_i(D)}; pg8::StaticOrder S; S.init(T, NPROJ_PAD, C.G, C.blk);
        EpiProj E{(bf16_t*)(C.ws + WS_PROJ)};
        pg8::gemm_phase<EpiProj, pg8::StaticOrder, true, true>(C.lds, g, S, E);
    } else if constexpr (SP == 1) {
    } else if constexpr (SP == 2) {
        LAS unsigned* gb = (LAS unsigned*)(C.lds + GB_OFF);
        if (C.tid < 8) gb[C.tid] = 0u;
        __syncthreads();
        const int half = C.wave >> 2, ltid = C.tid & 255;
        LAS unsigned* gcnt = gb + half; unsigned gtarget = 0u;
        LAS int* slot = (LAS int*)(gb + 2 + 2 * half);
        unsigned* iq = C.ctl + CW_AQ + 32 + 64 * l + 256 * rep;
        int nxt = 0, par = 0;
        if (half == 0) {
            for (int rw_ = 0; rw_ < RWREP; ++rw_)
            for (int bc = C.blk; bc < 256; bc += C.G) { bf16x8 actv[8]; rwkv_chunk_acts4(C, bc, l, actv); for (int h = 0; h < 8; ++h) rwkv_head_item4(C, bc * 8 + h, l, actv, gcnt, gtarget); }
        }
        const int ixb = half ? IX4 : 0;
        if (ltid == 0) nxt = (int)__hip_atomic_fetch_add(iq, 1u, __ATOMIC_RELAXED, __HIP_MEMORY_SCOPE_AGENT);
        for (;;) {
            if (ltid == 0) slot[par] = nxt;
            gbar(gcnt, gtarget, C.lane);
            const int u = __builtin_amdgcn_readfirstlane(slot[par]); par ^= 1;
            if (u >= 4096) break;
            if (ltid == 0) nxt = (int)__hip_atomic_fetch_add(iq, 1u, __ATOMIC_RELAXED, __HIP_MEMORY_SCOPE_AGENT);
            idx_item4(C, u, l, ixb, gcnt, gtarget);
        }
    } else if constexpr (SP == 3) {
        if (C.blk < 8 && (rep == 0 || REP_SUB != 2)) rwkv_scan_wave(C, C.blk * 8 + C.wave);
        LAS int* qs = (LAS int*)(C.lds + LDS_BYTES - 128);
        if (rep == 0 || REP_SUB != 1)
        for (;;) {
            __syncthreads();
            if (C.tid == 0) qs[0] = (int)__hip_atomic_fetch_add(C.ctl + CW_AQ + 64 * l + 256 * rep, 1u, __ATOMIC_RELAXED, __HIP_MEMORY_SCOPE_AGENT);
            __syncthreads();
            const int u = __builtin_amdgcn_readfirstlane(qs[0]);
            if (u >= 512) break;
            const int qb = 15 - (u >> 5), bh = u & 31; attn_unit(C, bh >> 3, bh & 7, qb);
        }
    } else if constexpr (SP == 4) {
        const int gw = C.blk * NWAVES + C.wave, NGW = C.G * NWAVES;
        for (int id = gw; id < 2048; id += NGW) rwkv_out_wave(C, id, l);
    } else if constexpr (SP == 5) {
        pg8::Gemm g{C.mixcat, (const bf16_t*)(C.ws + WS_WOUT), T, D, opaque_i(D)}; pg8::StaticOrder S; S.init(T, D, C.G, C.blk);
        EpiResF32 E{C.xcur, (bf16_t*)(C.ws + WS_V)};
        pg8::gemm_phase<EpiResF32, pg8::StaticOrder, true, true>(C.lds, g, S, E);
    } else if constexpr (SP == 6) { phase_ln_router(C, l); convert_ffn_weights(C, l);
    } else if constexpr (SP == 7) { phase_gather(C, l);
    } else if constexpr (SP == 8) {
        LAS int* toff = (LAS int*)(C.lds + 135168); LAS int* texp = (LAS int*)(C.lds + 136192);
        const int nt = build_tile_table(C, l, toff, texp);
        pg8::Gemm g{C.xcur, (const bf16_t*)(C.ws + WS_WEXP), MAXROWS, NEXP * 512, opaque_i(D)};
        GroupedOrder<2> S{texp, nt, C.G, C.blk};
        EpiSwiGLU E{(bf16_t*)(C.ws + WS_H), (const RowInfo*)(C.ws + WS_ROW)};
        pg8::gemm_phase_gather<EpiSwiGLU, GroupedOrder<2>, true>(C.lds, g, S, E, (const int*)(C.ws + WS_ROW));
        {
            const int extra = (2 * nt > C.G) ? (2 * nt - C.G) : 0; const int nb = C.G - extra;
            if (C.blk >= extra && nb > 0) { pg8::Gemm g2{(const bf16_t*)(C.ws + WS_PBF), (const bf16_t*)(C.ws + WS_WPLE), T, D, opaque_i(PLE)}; pg8::StaticOrder S2; S2.init(T, D, nb, C.blk - extra);
                EpiBf16Plain E2{(bf16_t*)(C.ws + WS_PE), D};
                pg8::gemm_phase<EpiBf16Plain, pg8::StaticOrder, true, true>(C.lds, g2, S2, E2); } }
    } else if constexpr (SP == 9) {
        LAS int* toff = (LAS int*)(C.lds + 135168); LAS int* texp = (LAS int*)(C.lds + 136192);
        const int nt = build_tile_table(C, l, toff, texp);
        { pg8::Gemm g{(const bf16_t*)(C.ws + WS_H), (const bf16_t*)(C.ws + WS_WDOWN), MAXROWS, NEXP * D, opaque_i(DEXP)};
          GroupedOrder<4> S{texp, nt, C.G, C.blk};
          EpiDown E{(bf16_t*)(C.ws + WS_Y), (const RowInfo*)(C.ws + WS_ROW)};
          pg8::gemm_phase<EpiDown, GroupedOrder<4>, true, true>(C.lds, g, S, E); }
    } else if constexpr (SP == 10) { phase_ln_ffn(C, l);
    } else if constexpr (SP == 11) {
        pg8::Gemm g{C.xcur, (const bf16_t*)(C.ws + WS_WPG), T, D, opaque_i(D)}; pg8::StaticOrder S; S.init(T, D, C.G, C.blk);
        EpiPle E{C.xcur, (const bf16_t*)(C.ws + WS_PE), (bf16_t*)(C.ws + WS_V3)};
        pg8::gemm_phase<EpiPle, pg8::StaticOrder, true, true>(C.lds, g, S, E);
    } else { phase_ln_ple(C, l, l == DEPTH - 1); if (l + 1 < DEPTH) { convert_win(C, l + 1); convert_mixer_weights(C, l + 1); } }
}
#define XB_TMO      128
#define XB_XCNT(j)  (256  + 64 * (j))
#define XB_XSUB(j)  (1280 + 64 * (j))
#define XB_XGEN(j)  (2304 + 64 * (j))
#define XB_TOP      3328
#define XB_TOPGEN   3392
#define XCD_BAR_WORDS 3456
#define XB_SPIN_CAP (1u << 18)

__device__ __forceinline__ unsigned xb_ld(unsigned* p)              { return __hip_atomic_load(p, __ATOMIC_RELAXED, __HIP_MEMORY_SCOPE_AGENT); }
__device__ __forceinline__ unsigned xb_add(unsigned* p, unsigned v) { return __hip_atomic_fetch_add(p, v, __ATOMIC_RELAXED, __HIP_MEMORY_SCOPE_AGENT); }
__device__ __forceinline__ unsigned xb_xcc_id() { return (unsigned)__builtin_amdgcn_s_getreg((3 << 11) | 20) & 0xFu; }
#define XB_SPIN(cond, bar) do { unsigned _sp = 0; while (cond) { __builtin_amdgcn_s_sleep(1); \
    if ((++_sp & 255u) == 0u) { if (xb_ld(&(bar)[XB_TMO])) break; if (_sp > XB_SPIN_CAP) { atomicAdd(&(bar)[XB_TMO], 1u); break; } } } } while (0)

struct XcdBarrier {
    unsigned* bar; unsigned x;
    volatile __attribute__((address_space(3))) unsigned* st;
};

__device__ __forceinline__ XcdBarrier xcd_barrier_post(unsigned* bar, volatile __attribute__((address_space(3))) unsigned* st) {
    XcdBarrier b; b.bar = bar; b.x = xb_xcc_id(); b.st = st;
    if (threadIdx.x == 0) (void)xb_add(&bar[XB_XCNT(b.x)], 1u);
    return b;
}
__device__ __forceinline__ void xcd_barrier_complete(unsigned* bar, unsigned x, unsigned& nloc, unsigned& nx) {
    const unsigned G = gridDim.x * gridDim.y * gridDim.z;
    unsigned sum, cnt, mine, sp = 0u;
    for (;;) {
        sum = 0u; cnt = 0u; mine = 0u;
#pragma unroll
        for (unsigned j = 0; j < 16; ++j) { const unsigned c = xb_ld(&bar[XB_XCNT(j)]); sum += c; cnt += (c > 0u) ? 1u : 0u; mine = (j == x) ? c : mine; }
        if (sum == G) break;
        __builtin_amdgcn_s_sleep(1);
        if ((++sp & 255u) == 0u) { if (xb_ld(&bar[XB_TMO])) break; if (sp > XB_SPIN_CAP) { atomicAdd(&bar[XB_TMO], 1u); break; } }
    }
    nloc = mine > 0u ? mine : 1u; nx = cnt > 0u ? cnt : 1u;
}

__device__ __forceinline__ void xcd_barrier(const XcdBarrier& b) {
    asm volatile("s_waitcnt vmcnt(0)" ::: "memory");
    __syncthreads();
    if (threadIdx.x == 0) {
        unsigned* bar = b.bar;
        __builtin_amdgcn_s_waitcnt(0);
        unsigned nloc = b.st[0], nx = b.st[1];
        if (nloc == 0u) { xcd_barrier_complete(bar, b.x, nloc, nx); b.st[0] = nloc; b.st[1] = nx; }
        const unsigned old = xb_add(&bar[XB_XSUB(b.x)], 1u);
        const unsigned gen = old / nloc;
        if (old + 1u == (gen + 1u) * nloc) {
            __builtin_amdgcn_fence(__ATOMIC_RELEASE, "agent");
            asm volatile("s_waitcnt vmcnt(0)" ::: "memory");
            const unsigned og = xb_add(&bar[XB_TOP], 1u);
            const unsigned tg = og / nx;
            if (og + 1u == (tg + 1u) * nx) xb_add(&bar[XB_TOPGEN], 1u);
            else XB_SPIN(xb_ld(&bar[XB_TOPGEN]) == tg, bar);
            __builtin_amdgcn_fence(__ATOMIC_ACQUIRE, "agent");
            xb_add(&bar[XB_XGEN(b.x)], 1u);
            asm volatile("s_waitcnt vmcnt(0)" ::: "memory");
        } else {
            XB_SPIN(xb_ld(&bar[XB_XGEN(b.x)]) == gen, bar);
            __builtin_amdgcn_fence(__ATOMIC_ACQUIRE, "agent");
            asm volatile("s_waitcnt vmcnt(0)" ::: "memory");
        }
    }
    __syncthreads();
}

constexpr int CW_XBAR = 65536;
typedef const __attribute__((address_space(4))) Args* KArgP;
DI void ctx_setup(Ctx& C) {
    int t_ = threadIdx.x; asm volatile("" : "+v"(t_)); C.tid = t_; C.lane = t_ & 63; C.wave = __builtin_amdgcn_readfirstlane(t_ >> 6);
    int b_ = blockIdx.x, g_ = gridDim.x; asm volatile("" : "+s"(b_), "+s"(g_)); C.blk = b_; C.G = g_;
    KArgP ap = (KArgP)__builtin_amdgcn_kernarg_segment_ptr(); asm volatile("" : "+s"(ap));
    C.ap = ap; C.out = ap->out; C.ws = ap->ws; C.ctl = (unsigned*)(ap->ws + WS_CTL); C.xcur = (bf16_t*)ap->out; C.mixcat = (bf16_t*)ap->out + (size_t)T * D;
}
__global__ void __launch_bounds__(NTHR, 2) mega_fwd(Args args) {
    extern __shared__ __attribute__((aligned(16))) unsigned char lds_raw[];
    Ctx C;
    C.lds = (LAS unsigned char*)lds_raw;
    cg::grid_group grid = cg::this_grid();
    volatile LAS unsigned* xbst = (volatile LAS unsigned*)(C.lds + LDS_BYTES - 32);
    if (threadIdx.x < 4) xbst[threadIdx.x] = 0u;
    __syncthreads();
    XcdBarrier xbar = xcd_barrier_post((unsigned*)(((KArgP)__builtin_amdgcn_kernarg_segment_ptr())->ws + WS_CTL) + CW_XBAR, xbst);
    const int lo = ((KArgP)__builtin_amdgcn_kernarg_segment_ptr())->ph_lo, hi = ((KArgP)__builtin_amdgcn_kernarg_segment_ptr())->ph_hi;
#ifdef PROBE_PHASE
#define PROBE_HOOK(k) do { if (blockIdx.x == 0 && threadIdx.x == 0) { unsigned long long* pt = (unsigned long long*)(C.ws + WS_CTL + 32768); if ((k) == PROBE_PHASE) pt[0] = __builtin_amdgcn_s_memrealtime(); if ((k) == PROBE_PHASE_END) pt[1] = __builtin_amdgcn_s_memrealtime(); } } while (0)
#else
#define PROBE_HOOK(k) do { } while (0)
#endif
#define GRID_BAR(k) do { if ((k) == lo + 1) grid.sync(); else xcd_barrier(xbar); } while (0)
#define PHASE(k, body) do { if (lo <= (k) && (k) < hi) { if ((k) > lo) GRID_BAR(k); ctx_setup(C); PROBE_HOOK(k); body; } } while (0)
    PHASE(0, { phase_ln_in(C); convert_win(C, 0); convert_mixer_weights(C, 0); });
#define LAYER(l) PHASE(1 + 13 * (l) + 0, run_sp<0>(C, l)); PHASE(1 + 13 * (l) + 2, run_sp<2>(C, l)); PHASE(1 + 13 * (l) + 3, run_sp<3>(C, l)); \
    PHASE(1 + 13 * (l) + 4, run_sp<4>(C, l)); PHASE(1 + 13 * (l) + 5, run_sp<5>(C, l)); PHASE(1 + 13 * (l) + 6, run_sp<6>(C, l)); PHASE(1 + 13 * (l) + 7, run_sp<7>(C, l)); \
    PHASE(1 + 13 * (l) + 8, run_sp<8>(C, l)); PHASE(1 + 13 * (l) + 9, run_sp<9>(C, l)); PHASE(1 + 13 * (l) + 10, run_sp<10>(C, l)); PHASE(1 + 13 * (l) + 11, run_sp<11>(C, l)); \
    PHASE(1 + 13 * (l) + 12, run_sp<12>(C, l))
#define PH0(sp) PHASE(1 + (sp), run_sp<sp>(C, 0)); if (REP_SP == (sp)) { if (REP_N > 1) { xcd_barrier(xbar); ctx_setup(C); run_sp_<sp>(C, 0, 1); } if (REP_N > 2) { xcd_barrier(xbar); ctx_setup(C); run_sp_<sp>(C, 0, 2); } }
    PH0(0); PH0(2); PH0(3); PH0(4); PH0(5); PH0(6); PH0(7); PH0(8); PH0(9); PH0(10); PH0(11); PH0(12);
#undef PH0
    LAYER(1);
#undef LAYER
#undef PHASE
}

#ifndef N_LAUNCH_MODE
#define N_LAUNCH_MODE 1
#endif
extern "C" void kernel_launch(void* const* d_in, const int* in_sizes, int n_in, void* d_out, int out_size, void* d_ws, size_t ws_size, hipStream_t stream) {
    static int grid = 0;
    if (grid == 0) {
        if (n_in != 31 || out_size != T * D) { fprintf(stderr, "kernel_launch: unexpected problem (n_in %d out %d)\n", n_in, out_size); grid = -1; return; }
        int dev = 0, cus = 0, per_cu = 0;
        hipGetDevice(&dev); hipDeviceGetAttribute(&cus, hipDeviceAttributeMultiprocessorCount, dev);
        if (hipFuncSetAttribute((const void*)mega_fwd, hipFuncAttributeMaxDynamicSharedMemorySize, LDS_BYTES) != hipSuccess) { fprintf(stderr, "kernel_launch: hipFuncSetAttribute failed\n"); grid = -1; return; }
        if (hipOccupancyMaxActiveBlocksPerMultiprocessor(&per_cu, (const void*)mega_fwd, NTHR, LDS_BYTES) != hipSuccess || per_cu < 1) { fprintf(stderr, "kernel_launch: occupancy query says %d\n", per_cu); per_cu = 1; }
        (void)hipGetLastError();
        grid = cus * 1;
        fprintf(stderr, "kernel_launch: grid %d (occupancy %d per CU)\n", grid, per_cu);
    }
    if (grid < 0) return;
    hipMemsetAsync((char*)d_ws + WS_CTL, 0, CTL_BYTES, stream);
    Args a{};
    for (int i = 0; i < 31; ++i) a.in[i] = (const float*)d_in[i];
    a.out = (float*)d_out; a.ws = (unsigned char*)d_ws;
#if N_LAUNCH_MODE == 0
    for (int ph = 0; ph < NPHASE; ++ph) { a.ph_lo = ph; a.ph_hi = ph + 1; hipLaunchKernelGGL(mega_fwd, dim3(grid), dim3(NTHR), LDS_BYTES, stream, a); }
#else
    a.ph_lo = 0; a.ph_hi = NPHASE;
    void* kargs[] = {&a};
    hipError_t e = hipLaunchCooperativeKernel((const void*)mega_fwd, dim3(grid), dim3(NTHR), kargs, LDS_BYTES, stream);
    if (e != hipSuccess) fprintf(stderr, "cooperative launch failed: %s (grid %d)\n", hipGetErrorString(e), grid);
#endif
}
```

```cpp
#include <hip/hip_runtime.h>
#include <hip/hip_cooperative_groups.h>
#include <cstdio>
#include <cstdint>
namespace cg = cooperative_groups;
namespace pg8 {
#define PG8_LAS __attribute__((address_space(3)))
typedef unsigned short bf16_t;
typedef short bf16x8 __attribute__((ext_vector_type(8)));
typedef float f32x4 __attribute__((ext_vector_type(4)));
typedef unsigned u32x4 __attribute__((ext_vector_type(4)));
constexpr int BM = 256, BK = 64, HALF = 128, HTB = HALF * BK * 2  , STAGE_BYTES = 8 * HTB, NXCD = 8, WGM = 8;

__host__ __device__ __forceinline__ int lds_byte(int r, int c) { const int st = (r >> 4) * 2 + (c >> 5), rr = r & 15, cc = c & 31, ob = rr * 64 + cc * 2; return st * 1024 + (ob ^ (((ob >> 9) & 1) << 5)); }
__host__ __device__ __forceinline__ void stage_rc(int b, int& R, int& C) { const int st = b / 1024, sb = b % 1024, swz = sb ^ (((sb >> 9) & 1) << 5); R = (st >> 1) * 16 + swz / 64; C = (st & 1) * 32 + (swz % 64) / 2; }
__host__ __device__ __forceinline__ int perm32(int rho) { const int n = rho >> 4, i = rho & 15; return 8 * (i >> 2) + 4 * n + (i & 3); }

struct Unit { int pm, pn; };
struct Gemm { const bf16_t* A; const bf16_t* Bt; int M, N, K; };

struct StaticOrder {
    int nM, nN, nwg, G, c;
    __host__ __device__ void init(int M, int N, int G_, int c_) { nM = M / BM; nN = N / BM; nwg = nM * nN; G = G_; c = c_; }
    __host__ __device__ bool next(int i, Unit& u) const {
        const long L = (long)i * G + c; if (L >= nwg) return false;
        int wgid = (int)L; { const int q = nwg / NXCD, r = nwg % NXCD, xcd = wgid % NXCD, off = wgid / NXCD; wgid = (xcd < r ? xcd * (q + 1) : r * (q + 1) + (xcd - r) * q) + off; }
        const int nig = WGM * nN, gid = wgid / nig, fm = gid * WGM, gsz = (nM - fm) < WGM ? (nM - fm) : WGM;
        u.pm = fm + ((wgid % nig) % gsz); u.pn = (wgid % nig) / gsz; return true;
    }
    __device__ __forceinline__ void a_ready(const Unit&) const {}
    __device__ __forceinline__ void done(const Unit&) const {}
};

__device__ __forceinline__ unsigned cvt_pk_bf16(float lo, float hi) { typedef float f2_t __attribute__((ext_vector_type(2))); typedef __bf16 b2_t __attribute__((ext_vector_type(2))); f2_t v = {lo, hi}; b2_t b = __builtin_convertvector(v, b2_t); return __builtin_bit_cast(unsigned, b); }
template <class Epi, class Sched, bool ALIGN_EPI = false, bool SP2 = false>
__device__ __forceinline__ void gemm_phase(PG8_LAS unsigned char* lds, const Gemm g, const Sched& S, const Epi& E) {
    int tid_ = threadIdx.x; asm volatile("" : "+v"(tid_));
    const int tid = tid_, wid = __builtin_amdgcn_readfirstlane(tid >> 6), lane = tid & 63, wr = wid >> 2, wc = wid & 3, fr = lane & 15, fq = lane >> 4;
    const int K = g.K, nt = K / BK;
    unsigned voffA[2], voffB[2];
#pragma unroll
    for (int i = 0; i < 2; ++i) { int R, C; stage_rc(tid * 16 + i * 8192, R, C); const int Rb = Epi::PERM ? ((R & ~31) + perm32(R & 31)) : R;
        voffA[i] = (unsigned)(R * K + C) * 2u; voffB[i] = (unsigned)(Rb * K + C) * 2u; }
    const size_t kstep = (size_t)(BK * 2);
    const size_t hstep = (size_t)HALF * K * 2;
    const size_t tstep = 2 * hstep;
    const unsigned ldsw = (unsigned)wid * 1024u;
    const int aoff = lds_byte(wr * 64 + fr, fq * 8), boff = lds_byte(wc * 32 + fr, fq * 8);
#define PG8_SA(b, h) (((b) * 2 + (h)) * HTB)
#define PG8_SB(b, h) ((4 + (b) * 2 + (h)) * HTB)
#define PG8_STAGE(bufoff, gbase, voff) do { _Pragma("unroll") for (int _i = 0; _i < 2; ++_i) \
        __builtin_amdgcn_global_load_lds((const unsigned*)((const char*)(gbase) + (voff)[_i]), (PG8_LAS unsigned*)(lds + (bufoff) + ldsw + _i * 8192), 16, 0, 0); } while (0)
#define PG8_LDA(dst, b, h) do { _Pragma("unroll") for (int m = 0; m < 4; ++m) _Pragma("unroll") for (int k = 0; k < 2; ++k) dst[m][k] = *(const PG8_LAS bf16x8*)(lds + PG8_SA(b, h) + aoff + m * 2048 + k * 1024); } while (0)
#define PG8_LDB(dst, b, h) do { _Pragma("unroll") for (int n = 0; n < 2; ++n) _Pragma("unroll") for (int k = 0; k < 2; ++k) dst[n][k] = *(const PG8_LAS bf16x8*)(lds + PG8_SB(b, h) + boff + n * 2048 + k * 1024); } while (0)
#define PG8_MMA(ai, bj, At, Bt) do { __builtin_amdgcn_s_setprio(1); _Pragma("unroll") for (int m = 0; m < 4; ++m) _Pragma("unroll") for (int n = 0; n < 2; ++n) _Pragma("unroll") for (int k = 0; k < 2; ++k) \
        acc[ai][bj][m][n] = __builtin_amdgcn_mfma_f32_16x16x32_bf16(Bt[n][k], At[m][k], acc[ai][bj][m][n], 0, 0, 0); __builtin_amdgcn_s_setprio(0); } while (0)
#define PG8_WAIT_V(n) asm volatile("s_waitcnt vmcnt(" #n ")" ::: "memory")
#define PG8_WAIT_L(n) asm volatile("s_waitcnt lgkmcnt(" #n ")" ::: "memory")
#define PG8_BAR __builtin_amdgcn_s_barrier()
#define PG8_SCHED __builtin_amdgcn_sched_barrier(0)
    Unit cur, nxt; int ui = 0;
    if (!S.next(0, cur)) return;
    f32x4 acc[2][2][4][2];
#pragma unroll
    for (int a = 0; a < 2; ++a)
#pragma unroll
        for (int b = 0; b < 2; ++b)
#pragma unroll
            for (int m = 0; m < 4; ++m)
#pragma unroll
                for (int n = 0; n < 2; ++n) acc[a][b][m][n] = (f32x4){0.f, 0.f, 0.f, 0.f};
    bf16x8 At[4][2], B0[2][2], B1[2][2];
    const char* cA = (const char*)g.A + (size_t)cur.pm * tstep; const char* cB = (const char*)g.Bt + (size_t)cur.pn * tstep;
    S.a_ready(cur);
    if constexpr (SP2) {
        PG8_STAGE(PG8_SB(0, 0), cB, voffB); PG8_STAGE(PG8_SB(0, 1), cB + hstep, voffB); PG8_STAGE(PG8_SA(0, 0), cA, voffA); PG8_STAGE(PG8_SA(0, 1), cA + hstep, voffA);
        if (wr == 1) PG8_BAR;
        PG8_WAIT_V(2); PG8_BAR;
        PG8_STAGE(PG8_SB(1, 0), cB + kstep, voffB); PG8_STAGE(PG8_SA(1, 0), cA + kstep, voffA); PG8_STAGE(PG8_SB(1, 1), cB + hstep + kstep, voffB);
        PG8_WAIT_V(6); PG8_BAR;
    } else {
        PG8_STAGE(PG8_SB(0, 0), cB, voffB); PG8_STAGE(PG8_SA(0, 0), cA, voffA); PG8_STAGE(PG8_SB(0, 1), cB + hstep, voffB); PG8_STAGE(PG8_SA(0, 1), cA + hstep, voffA);
        if (wr == 1) PG8_BAR;
        PG8_WAIT_V(4); PG8_BAR;
        PG8_STAGE(PG8_SB(1, 0), cB + kstep, voffB); PG8_STAGE(PG8_SA(1, 0), cA + kstep, voffA); PG8_STAGE(PG8_SB(1, 1), cB + hstep + kstep, voffB);
        PG8_WAIT_V(6); PG8_BAR;
    }
    for (;;) {
        const bool has_next = S.next(ui + 1, nxt);
        const char* nA = has_next ? (const char*)g.A + (size_t)nxt.pm * tstep : cA; const char* nB = has_next ? (const char*)g.Bt + (size_t)nxt.pn * tstep : cB;
        for (int t = 0; t < nt; t += 2) {
            const bool last = (t == nt - 2);
            const char* a1 = cA + (size_t)(t + 1) * kstep;
            const char* a2 = last ? nA : cA + (size_t)(t + 2) * kstep; const char* b2 = last ? nB : cB + (size_t)(t + 2) * kstep;
            const char* a3 = a2 + kstep; const char* b3 = b2 + kstep;
            if (last && has_next) S.a_ready(nxt);
            if constexpr (SP2) {
            PG8_LDB(B0, 0, 0); PG8_LDB(B1, 0, 1); PG8_SCHED; PG8_LDA(At, 0, 0); PG8_STAGE(PG8_SA(1, 1), a1 + hstep, voffA);
            PG8_WAIT_V(8); PG8_WAIT_L(0); PG8_BAR; PG8_MMA(0, 0, At, B0); PG8_MMA(0, 1, At, B1); PG8_BAR; PG8_SCHED;
            PG8_LDA(At, 0, 1); PG8_STAGE(PG8_SB(0, 0), b2, voffB); PG8_STAGE(PG8_SB(0, 1), b2 + hstep, voffB); PG8_STAGE(PG8_SA(0, 0), a2, voffA);
            PG8_WAIT_V(8); PG8_WAIT_L(0); PG8_BAR; PG8_MMA(1, 0, At, B0); PG8_MMA(1, 1, At, B1); PG8_BAR; PG8_SCHED;
            PG8_LDB(B0, 1, 0); PG8_LDB(B1, 1, 1); PG8_SCHED; PG8_LDA(At, 1, 0); PG8_STAGE(PG8_SA(0, 1), a2 + hstep, voffA);
            PG8_WAIT_V(8); PG8_WAIT_L(0); PG8_BAR; PG8_MMA(0, 0, At, B0); PG8_MMA(0, 1, At, B1); PG8_BAR; PG8_SCHED;
            PG8_LDA(At, 1, 1); PG8_STAGE(PG8_SB(1, 0), b3, voffB); PG8_STAGE(PG8_SB(1, 1), b3 + hstep, voffB); PG8_STAGE(PG8_SA(1, 0), a3, voffA);
            PG8_WAIT_V(8); PG8_WAIT_L(0); PG8_BAR; PG8_MMA(1, 0, At, B0); PG8_MMA(1, 1, At, B1); PG8_BAR; PG8_SCHED;
            } else {
            PG8_LDB(B0, 0, 0); PG8_SCHED; PG8_LDA(At, 0, 0); PG8_STAGE(PG8_SA(1, 1), a1 + hstep, voffA);
            PG8_WAIT_L(8); PG8_BAR; PG8_WAIT_L(0); PG8_MMA(0, 0, At, B0); PG8_BAR; PG8_SCHED;
            PG8_LDB(B1, 0, 1); PG8_STAGE(PG8_SB(0, 0), b2, voffB);
            PG8_BAR; PG8_WAIT_L(0); PG8_MMA(0, 1, At, B1); PG8_BAR;
            PG8_LDA(At, 0, 1); PG8_STAGE(PG8_SA(0, 0), a2, voffA);
            PG8_BAR; PG8_WAIT_L(0); PG8_MMA(1, 0, At, B0); PG8_BAR; PG8_SCHED;
            PG8_STAGE(PG8_SB(0, 1), b2 + hstep, voffB);
            PG8_WAIT_V(6); PG8_BAR; PG8_MMA(1, 1, At, B1); PG8_BAR;
            PG8_LDB(B0, 1, 0); PG8_SCHED; PG8_LDA(At, 1, 0); PG8_STAGE(PG8_SA(0, 1), a2 + hstep, voffA);
            PG8_WAIT_L(8); PG8_BAR; PG8_WAIT_L(0); PG8_MMA(0, 0, At, B0); PG8_BAR; PG8_SCHED;
            PG8_LDB(B1, 1, 1); PG8_STAGE(PG8_SB(1, 0), b3, voffB);
            PG8_BAR; PG8_WAIT_L(0); PG8_MMA(0, 1, At, B1); PG8_BAR;
            PG8_LDA(At, 1, 1); PG8_STAGE(PG8_SA(1, 0), a3, voffA);
            PG8_BAR; PG8_WAIT_L(0); PG8_MMA(1, 0, At, B0); PG8_BAR; PG8_SCHED;
            PG8_STAGE(PG8_SB(1, 1), b3 + hstep, voffB);
            PG8_WAIT_V(6); PG8_BAR; PG8_MMA(1, 1, At, B1); PG8_BAR;
            }
        }
        if constexpr (ALIGN_EPI) { if (wr == 0) PG8_BAR; }
        if constexpr (!Epi::AFTER_DRAIN) { E(acc, cur, wr, wc, fr, fq); S.done(cur); }
        if (!has_next) break;
#pragma unroll
        for (int a = 0; a < 2; ++a)
#pragma unroll
            for (int b = 0; b < 2; ++b)
#pragma unroll
                for (int m = 0; m < 4; ++m)
#pragma unroll
                    for (int n = 0; n < 2; ++n) acc[a][b][m][n] = (f32x4){0.f, 0.f, 0.f, 0.f};
        cur = nxt; cA = nA; cB = nB; ++ui;
        if constexpr (ALIGN_EPI) { if (wr == 1) PG8_BAR; }
    }
    PG8_WAIT_V(0);
    if constexpr (!ALIGN_EPI) { if (wr == 0) PG8_BAR; }
    PG8_BAR;
    if constexpr (Epi::AFTER_DRAIN) { E.fused(acc, cur, wr, wc, fr, fq, lds, wid, lane); S.done(cur); }
#undef PG8_SA
#undef PG8_SB
#undef PG8_STAGE
#undef PG8_LDA
#undef PG8_LDB
#undef PG8_MMA
#undef PG8_WAIT_V
#undef PG8_WAIT_L
#undef PG8_BAR
#undef PG8_SCHED
}

template <class Epi, class Sched, bool ALIGN_EPI = false>
__device__ __forceinline__ void gemm_phase_gather(PG8_LAS unsigned char* lds, const Gemm g, const Sched& S, const Epi& E, const int* rowtok) {
    constexpr bool SP2 = true;
    int tid_ = threadIdx.x; asm volatile("" : "+v"(tid_));
    const int tid = tid_, wid = __builtin_amdgcn_readfirstlane(tid >> 6), lane = tid & 63, wr = wid >> 2, wc = wid & 3, fr = lane & 15, fq = lane >> 4;
    const int K = g.K, nt = K / BK;
    unsigned voffB[2]; unsigned vcur[2][2], vnxt[2][2]; int RA[2], CA[2]; const unsigned voffA[2] = {0u, 0u};
#pragma unroll
    for (int i = 0; i < 2; ++i) { int R, C; stage_rc(tid * 16 + i * 8192, R, C); const int Rb = Epi::PERM ? ((R & ~31) + perm32(R & 31)) : R;
        RA[i] = R; CA[i] = C; voffB[i] = (unsigned)(Rb * K + C) * 2u; }
#define PG8_GMAP(dst, pm_) do { _Pragma("unroll") for (int h_ = 0; h_ < 2; ++h_) _Pragma("unroll") for (int i_ = 0; i_ < 2; ++i_) { int tk_ = rowtok[4 * ((pm_) * BM + h_ * HALF + RA[i_])]; tk_ = tk_ < 0 ? 0 : tk_; dst[h_][i_] = (unsigned)(tk_ * K + CA[i_]) * 2u; } } while (0)
    const size_t kstep = (size_t)(BK * 2);
    const size_t hstep = (size_t)HALF * K * 2;
    const size_t tstep = 2 * hstep;
    const unsigned ldsw = (unsigned)wid * 1024u;
    const int aoff = lds_byte(wr * 64 + fr, fq * 8), boff = lds_byte(wc * 32 + fr, fq * 8);
#define PG8_SA(b, h) (((b) * 2 + (h)) * HTB)
#define PG8_SB(b, h) ((4 + (b) * 2 + (h)) * HTB)
#define PG8_STAGE(bufoff, gbase, voff) do { _Pragma("unroll") for (int _i = 0; _i < 2; ++_i) \
        __builtin_amdgcn_global_load_lds((const unsigned*)((const char*)(gbase) + (voff)[_i]), (PG8_LAS unsigned*)(lds + (bufoff) + ldsw + _i * 8192), 16, 0, 0); } while (0)
#define PG8_LDA(dst, b, h) do { _Pragma("unroll") for (int m = 0; m < 4; ++m) _Pragma("unroll") for (int k = 0; k < 2; ++k) dst[m][k] = *(const PG8_LAS bf16x8*)(lds + PG8_SA(b, h) + aoff + m * 2048 + k * 1024); } while (0)
#define PG8_LDB(dst, b, h) do { _Pragma("unroll") for (int n = 0; n < 2; ++n) _Pragma("unroll") for (int k = 0; k < 2; ++k) dst[n][k] = *(const PG8_LAS bf16x8*)(lds + PG8_SB(b, h) + boff + n * 2048 + k * 1024); } while (0)
#define PG8_MMA(ai, bj, At, Bt) do { __builtin_amdgcn_s_setprio(1); _Pragma("unroll") for (int m = 0; m < 4; ++m) _Pragma("unroll") for (int n = 0; n < 2; ++n) _Pragma("unroll") for (int k = 0; k < 2; ++k) \
        acc[ai][bj][m][n] = __builtin_amdgcn_mfma_f32_16x16x32_bf16(Bt[n][k], At[m][k], acc[ai][bj][m][n], 0, 0, 0); __builtin_amdgcn_s_setprio(0); } while (0)
#define PG8_WAIT_V(n) asm volatile("s_waitcnt vmcnt(" #n ")" ::: "memory")
#define PG8_WAIT_L(n) asm volatile("s_waitcnt lgkmcnt(" #n ")" ::: "memory")
#define PG8_BAR __builtin_amdgcn_s_barrier()
#define PG8_SCHED __builtin_amdgcn_sched_barrier(0)
    Unit cur, nxt; int ui = 0;
    if (!S.next(0, cur)) return;
    f32x4 acc[2][2][4][2];
#pragma unroll
    for (int a = 0; a < 2; ++a)
#pragma unroll
        for (int b = 0; b < 2; ++b)
#pragma unroll
            for (int m = 0; m < 4; ++m)
#pragma unroll
                for (int n = 0; n < 2; ++n) acc[a][b][m][n] = (f32x4){0.f, 0.f, 0.f, 0.f};
    bf16x8 At[4][2], B0[2][2], B1[2][2];
    const char* cA = (const char*)g.A; const char* cB = (const char*)g.Bt + (size_t)cur.pn * tstep;
    PG8_GMAP(vcur, cur.pm);
    S.a_ready(cur);
    if constexpr (SP2) {
        PG8_STAGE(PG8_SB(0, 0), cB, voffB); PG8_STAGE(PG8_SB(0, 1), cB + hstep, voffB); PG8_STAGE(PG8_SA(0, 0), cA, vcur[0]); PG8_STAGE(PG8_SA(0, 1), cA, vcur[1]);
        if (wr == 1) PG8_BAR;
        PG8_WAIT_V(2); PG8_BAR;
        PG8_STAGE(PG8_SB(1, 0), cB + kstep, voffB); PG8_STAGE(PG8_SA(1, 0), cA + kstep, vcur[0]); PG8_STAGE(PG8_SB(1, 1), cB + hstep + kstep, voffB);
        PG8_WAIT_V(6); PG8_BAR;
    } else {
        PG8_STAGE(PG8_SB(0, 0), cB, voffB); PG8_STAGE(PG8_SA(0, 0), cA, voffA); PG8_STAGE(PG8_SB(0, 1), cB + hstep, voffB); PG8_STAGE(PG8_SA(0, 1), cA + hstep, voffA);
        if (wr == 1) PG8_BAR;
        PG8_WAIT_V(4); PG8_BAR;
        PG8_STAGE(PG8_SB(1, 0), cB + kstep, voffB); PG8_STAGE(PG8_SA(1, 0), cA + kstep, voffA); PG8_STAGE(PG8_SB(1, 1), cB + hstep + kstep, voffB);
        PG8_WAIT_V(6); PG8_BAR;
    }
    for (;;) {
        const bool has_next = S.next(ui + 1, nxt);
        const char* nA = cA; const char* nB = has_next ? (const char*)g.Bt + (size_t)nxt.pn * tstep : cB;
        if (has_next) PG8_GMAP(vnxt, nxt.pm); else { vnxt[0][0] = vcur[0][0]; vnxt[0][1] = vcur[0][1]; vnxt[1][0] = vcur[1][0]; vnxt[1][1] = vcur[1][1]; }
        for (int t = 0; t < nt; t += 2) {
            const bool last = (t == nt - 2);
            const char* a1 = cA + (size_t)(t + 1) * kstep;
            const char* a2 = last ? nA : cA + (size_t)(t + 2) * kstep; unsigned v2[2][2]; v2[0][0] = last ? vnxt[0][0] : vcur[0][0]; v2[0][1] = last ? vnxt[0][1] : vcur[0][1]; v2[1][0] = last ? vnxt[1][0] : vcur[1][0]; v2[1][1] = last ? vnxt[1][1] : vcur[1][1]; const char* b2 = last ? nB : cB + (size_t)(t + 2) * kstep;
            const char* a3 = a2 + kstep; const char* b3 = b2 + kstep;
            if (last && has_next) S.a_ready(nxt);
            if constexpr (SP2) {
            PG8_LDB(B0, 0, 0); PG8_LDB(B1, 0, 1); PG8_SCHED; PG8_LDA(At, 0, 0); PG8_STAGE(PG8_SA(1, 1), a1, vcur[1]);
            PG8_WAIT_V(8); PG8_WAIT_L(0); PG8_BAR; PG8_MMA(0, 0, At, B0); PG8_MMA(0, 1, At, B1); PG8_BAR; PG8_SCHED;
            PG8_LDA(At, 0, 1); PG8_STAGE(PG8_SB(0, 0), b2, voffB); PG8_STAGE(PG8_SB(0, 1), b2 + hstep, voffB); PG8_STAGE(PG8_SA(0, 0), a2, v2[0]);
            PG8_WAIT_V(8); PG8_WAIT_L(0); PG8_BAR; PG8_MMA(1, 0, At, B0); PG8_MMA(1, 1, At, B1); PG8_BAR; PG8_SCHED;
            PG8_LDB(B0, 1, 0); PG8_LDB(B1, 1, 1); PG8_SCHED; PG8_LDA(At, 1, 0); PG8_STAGE(PG8_SA(0, 1), a2, v2[1]);
            PG8_WAIT_V(8); PG8_WAIT_L(0); PG8_BAR; PG8_MMA(0, 0, At, B0); PG8_MMA(0, 1, At, B1); PG8_BAR; PG8_SCHED;
            PG8_LDA(At, 1, 1); PG8_STAGE(PG8_SB(1, 0), b3, voffB); PG8_STAGE(PG8_SB(1, 1), b3 + hstep, voffB); PG8_STAGE(PG8_SA(1, 0), a3, v2[0]);
            PG8_WAIT_V(8); PG8_WAIT_L(0); PG8_BAR; PG8_MMA(1, 0, At, B0); PG8_MMA(1, 1, At, B1); PG8_BAR; PG8_SCHED;
            } else {
            PG8_LDB(B0, 0, 0); PG8_SCHED; PG8_LDA(At, 0, 0); PG8_STAGE(PG8_SA(1, 1), a1 + hstep, voffA);
            PG8_WAIT_L(8); PG8_BAR; PG8_WAIT_L(0); PG8_MMA(0, 0, At, B0); PG8_BAR; PG8_SCHED;
            PG8_LDB(B1, 0, 1); PG8_STAGE(PG8_SB(0, 0), b2, voffB);
            PG8_BAR; PG8_WAIT_L(0); PG8_MMA(0, 1, At, B1); PG8_BAR;
            PG8_LDA(At, 0, 1); PG8_STAGE(PG8_SA(0, 0), a2, voffA);
            PG8_BAR; PG8_WAIT_L(0); PG8_MMA(1, 0, At, B0); PG8_BAR; PG8_SCHED;
            PG8_STAGE(PG8_SB(0, 1), b2 + hstep, voffB);
            PG8_WAIT_V(6); PG8_BAR; PG8_MMA(1, 1, At, B1); PG8_BAR;
            PG8_LDB(B0, 1, 0); PG8_SCHED; PG8_LDA(At, 1, 0); PG8_STAGE(PG8_SA(0, 1), a2 + hstep, voffA);
            PG8_WAIT_L(8); PG8_BAR; PG8_WAIT_L(0); PG8_MMA(0, 0, At, B0); PG8_BAR; PG8_SCHED;
            PG8_LDB(B1, 1, 1); PG8_STAGE(PG8_SB(1, 0), b3, voffB);
            PG8_BAR; PG8_WAIT_L(0); PG8_MMA(0, 1, At, B1); PG8_BAR;
            PG8_LDA(At, 1, 1); PG8_STAGE(PG8_SA(1, 0), a3, voffA);
            PG8_BAR; PG8_WAIT_L(0); PG8_MMA(1, 0, At, B0); PG8_BAR; PG8_SCHED;
            PG8_STAGE(PG8_SB(1, 1), b3 + hstep, voffB);
            PG8_WAIT_V(6); PG8_BAR; PG8_MMA(1, 1, At, B1); PG8_BAR;
            }
        }
        if constexpr (ALIGN_EPI) { if (wr == 0) PG8_BAR; }
        if constexpr (!Epi::AFTER_DRAIN) { E(acc, cur, wr, wc, fr, fq); S.done(cur); }
        if (!has_next) break;
#pragma unroll
        for (int a = 0; a < 2; ++a)
#pragma unroll
            for (int b = 0; b < 2; ++b)
#pragma unroll
                for (int m = 0; m < 4; ++m)
#pragma unroll
                    for (int n = 0; n < 2; ++n) acc[a][b][m][n] = (f32x4){0.f, 0.f, 0.f, 0.f};
        cur = nxt; cA = nA; cB = nB; ++ui; vcur[0][0] = vnxt[0][0]; vcur[0][1] = vnxt[0][1]; vcur[1][0] = vnxt[1][0]; vcur[1][1] = vnxt[1][1];
        if constexpr (ALIGN_EPI) { if (wr == 1) PG8_BAR; }
    }
    PG8_WAIT_V(0);
    if constexpr (!ALIGN_EPI) { if (wr == 0) PG8_BAR; }
    PG8_BAR;
    if constexpr (Epi::AFTER_DRAIN) { E.fused(acc, cur, wr, wc, fr, fq, lds, wid, lane); S.done(cur); }
#undef PG8_GMAP
#undef PG8_SA
#undef PG8_SB
#undef PG8_STAGE
#undef PG8_LDA
#undef PG8_LDB
#undef PG8_MMA
#undef PG8_WAIT_V
#undef PG8_WAIT_L
#undef PG8_BAR
#undef PG8_SCHED
}

}

#define DI __device__ __forceinline__
#define LAS __attribute__((address_space(3)))
typedef unsigned short bf16_t;
typedef short bf16x8 __attribute__((ext_vector_type(8)));
typedef _Float16 f16x8 __attribute__((ext_vector_type(8)));
typedef float f32x4 __attribute__((ext_vector_type(4)));
typedef float f32x16 __attribute__((ext_vector_type(16)));
typedef unsigned u32x4 __attribute__((ext_vector_type(4)));
typedef unsigned u32x2 __attribute__((ext_vector_type(2)));

constexpr int NB = 4, SEQ = 4096, T = NB * SEQ, D = 1024, DEPTH = 2;
constexpr int PLD = 3912;
constexpr int PC_Q = 0, PC_K = 512, PC_V = 1024, PC_QI = 1536, PC_KI = 2048, PC_WI = 2112;
constexpr int PC_R = 2120, PC_BK = 2632, PC_BV = 3144, PC_WD = 3656;
constexpr int NPROJ_PAD = 4096;
constexpr int NEXP = 16, DEXP = 256, PLE = 256;
constexpr float ALPHA = 1.4142135623730951f;
constexpr float LN_EPS = 1e-5f, GN_EPS = 64e-5f;
constexpr int MAXROWS = 2 * T + NEXP * 256;
constexpr int NWAVES = 8, NTHR = 512;

constexpr size_t MiB = 1u << 20;
constexpr size_t WS_CTL = 0, CTL_BYTES = 1 * MiB;
constexpr size_t WS_WEXP = 1 * MiB;
constexpr size_t WS_WDOWN = 17 * MiB;
constexpr size_t WS_WOUT = 25 * MiB, WS_WPG = 27 * MiB, WS_WPLE = 29 * MiB;
constexpr size_t WS_BM = 30 * MiB;
constexpr size_t WS_ELL = 38 * MiB, WS_AA = 70 * MiB, WS_GG = 102 * MiB;
constexpr size_t WS_PROJ = 119 * MiB;
constexpr size_t WS_PBF = 242 * MiB;
constexpr size_t WS_V = 119 * MiB;
constexpr size_t WS_AG = 38 * MiB;
constexpr size_t WS_H = 183 * MiB;
constexpr size_t WS_Y = 119 * MiB;
constexpr size_t WS_PE = 201 * MiB;
constexpr size_t WS_V3 = 38 * MiB;
constexpr size_t WS_TOK = 233 * MiB;
constexpr size_t WS_ROW = 234 * MiB;
constexpr int CW_GCNT = 1024;

struct TokInfo { int e0, e1, p0, p1; float g0, g1; int pad0, pad1; };
struct RowInfo { int token, slot; float gate; int pad; };

#define LDS_WAIT() asm volatile("s_waitcnt lgkmcnt(0)" ::: "memory")
#define VM_WAIT() asm volatile("s_waitcnt vmcnt(0)" ::: "memory")
DI unsigned f2bf(float f) { unsigned u = __builtin_bit_cast(unsigned, f); return (u + 0x7fffu + ((u >> 16) & 1u)) >> 16; }
DI unsigned pk2(float lo, float hi) { return pg8::cvt_pk_bf16(lo, hi); }
DI float bf2f(unsigned short b) { return __builtin_bit_cast(float, (unsigned)b << 16); }
DI float bflo(unsigned w) { return __builtin_bit_cast(float, w << 16); }
DI float bfhi(unsigned w) { return __builtin_bit_cast(float, w & 0xffff0000u); }
DI unsigned pk2h(float lo, float hi) { typedef _Float16 h2_t __attribute__((ext_vector_type(2))); h2_t v = {(_Float16)lo, (_Float16)hi}; return __builtin_bit_cast(unsigned, v); }
DI float wave_sum(float v) {
#pragma unroll
    for (int o = 1; o < 64; o <<= 1) v += __shfl_xor(v, o);
    return v;
}
DI int opaque_i(int v) { asm volatile("" : "+s"(v)); return v; }
DI float sigmoidf_(float x) { return 1.f / (1.f + __expf(-x)); }

struct Args { const float* in[31]; float* out; unsigned char* ws; int ph_lo, ph_hi; };
struct Ctx {
    LAS unsigned char* lds;
    int tid, lane, wave, G, blk;
    const __attribute__((address_space(4))) Args* ap;
    float* out; unsigned char* ws;
    unsigned* ctl;
    bf16_t* xcur; bf16_t* mixcat;
    DI const float* in(int i) const { return ap->in[i]; }
};

DI void ln16(f32x4 (&v)[4], const float* g, const float* b, int lane) {
    float s = 0.f;
#pragma unroll
    for (int j = 0; j < 4; ++j) s += (v[j].x + v[j].y) + (v[j].z + v[j].w);
    const float mean = wave_sum(s) * (1.f / D);
    float s2 = 0.f;
#pragma unroll
    for (int j = 0; j < 4; ++j) { v[j] = v[j] - mean; s2 += (v[j].x * v[j].x + v[j].y * v[j].y) + (v[j].z * v[j].z + v[j].w * v[j].w); }
    const float rstd = 1.f / sqrtf(wave_sum(s2) * (1.f / D) + LN_EPS);
#pragma unroll
    for (int j = 0; j < 4; ++j) { const f32x4 gg = *(const f32x4*)(g + 256 * j + 4 * lane), bb = *(const f32x4*)(b + 256 * j + 4 * lane); v[j] = v[j] * rstd * gg + bb; }
}
DI void store_row_bf16(bf16_t* row, const f32x4 (&v)[4], int lane) {
#pragma unroll
    for (int j = 0; j < 4; ++j) { u32x2 o; o.x = pk2(v[j].x, v[j].y); o.y = pk2(v[j].z, v[j].w); *(u32x2*)(row + 256 * j + 4 * lane) = o; }
}
DI void load_row_bf16(const bf16_t* row, f32x4 (&v)[4], int lane) {
#pragma unroll
    for (int j = 0; j < 4; ++j) { const u32x2 o = *(const u32x2*)(row + 256 * j + 4 * lane); v[j] = (f32x4){bflo(o.x), bfhi(o.x), bflo(o.y), bfhi(o.y)}; }
}

template <class ColPtr>
DI void transpose_item(const ColPtr colptr, int ld, int K, bf16_t* WT, int n0, int k0, LAS float* scr, int lane) {
    const float* sp = colptr(n0 + (lane & 31));
    float tv[32];
#pragma unroll
    for (int i = 0; i < 32; ++i) { const int kk = 2 * i + (lane >> 5); tv[i] = sp ? sp[(size_t)(k0 + kk) * ld] : 0.f; }
#pragma unroll
    for (int i = 0; i < 32; ++i) { const int kk = 2 * i + (lane >> 5); scr[kk * 33 + (lane & 31)] = tv[i]; }
    LDS_WAIT(); asm volatile("" ::: "memory");
    const int c = lane & 7;
#pragma unroll
    for (int j = 0; j < 4; ++j) { const int n = (lane >> 3) + 8 * j; const LAS float* s = scr + (8 * c) * 33 + n;
        u32x4 o; o.x = pk2(s[0 * 33], s[1 * 33]); o.y = pk2(s[2 * 33], s[3 * 33]); o.z = pk2(s[4 * 33], s[5 * 33]); o.w = pk2(s[6 * 33], s[7 * 33]);
        *(u32x4*)(WT + (size_t)(n0 + n) * K + k0 + 8 * c) = o; }
    LDS_WAIT(); asm volatile("" ::: "memory");
}
template <class ColPtr>
DI void convert_matrix(Ctx& C, const ColPtr colptr, int ld, int K, int N, bf16_t* WT, int& first) {
    LAS float* scr = (LAS float*)(C.lds + C.wave * 16384);
    const int gw = C.blk * NWAVES + C.wave, NGW = C.G * NWAVES;
    const int nblk = N / 32, nitems = (K / 64) * nblk;
    int it = gw - (first % NGW); if (it < 0) it += NGW;
    for (; it < nitems; it += NGW) transpose_item(colptr, ld, K, WT, 32 * (it % nblk), 64 * (it / nblk), scr, C.lane);
    first += nitems;
}

struct ColWin { const float* w; DI const float* operator()(int j) const { if (j < 2120) return w + j; if (j >= 2176 && j < 3968) return w + (j - 56); return nullptr; } };
struct ColPlain { const float* w; DI const float* operator()(int j) const { return w + j; } };
struct ColGateUp { const float* wg; const float* wu; DI const float* operator()(int j) const {
        const int e = j >> 9, pn = (j >> 8) & 1, jj = j & 255; const int col = pn * 128 + (jj & 127); const uintptr_t pg = (uintptr_t)wg, pu = (uintptr_t)wu; const uintptr_t sel = pg + ((jj >= 128) ? (pu - pg) : (uintptr_t)0); return (const float*)sel + (size_t)e * D * DEXP + col; } };
struct ColDown { const float* wd; DI const float* operator()(int j) const { return wd + j; } };

DI void phase_ln_in(Ctx& C) {
    const int gw = C.blk * NWAVES + C.wave, NGW = C.G * NWAVES;
    for (int m = gw; m < T; m += NGW) {
        f32x4 v[4]; const float* xr = C.in(0) + (size_t)m * D;
#pragma unroll
        for (int j = 0; j < 4; ++j) v[j] = *(const f32x4*)(xr + 256 * j + 4 * C.lane);
        ln16(v, C.in(2), C.in(3), C.lane);
        store_row_bf16(C.xcur + (size_t)m * D, v, C.lane);
    }
}
DI void convert_win(Ctx& C, int l) { int first = 0; ColWin cw{C.in(4) + (size_t)l * D * 3912}; convert_matrix(C, cw, 3912, D, NPROJ_PAD, (bf16_t*)(C.ws + WS_WEXP), first); }
DI void convert_layer_weights(Ctx& C, int l) {
    int first = 0;
    { ColPlain c{C.in(5) + (size_t)l * D * D}; convert_matrix(C, c, D, D, D, (bf16_t*)(C.ws + WS_WOUT), first); }
    { ColGateUp c{C.in(20) + (size_t)l * NEXP * D * DEXP, C.in(21) + (size_t)l * NEXP * D * DEXP}; convert_matrix(C, c, DEXP, D, NEXP * 512, (bf16_t*)(C.ws + WS_WEXP), first); }
    for (int e = 0; e < NEXP; ++e) { ColDown c{C.in(22) + ((size_t)l * NEXP + e) * DEXP * D}; convert_matrix(C, c, D, DEXP, D, (bf16_t*)(C.ws + WS_WDOWN) + (size_t)e * D * DEXP, first); }
    { ColPlain c{C.in(24) + (size_t)l * D * D}; convert_matrix(C, c, D, D, D, (bf16_t*)(C.ws + WS_WPG), first); }
    { ColPlain c{C.in(23) + (size_t)l * PLE * D}; convert_matrix(C, c, D, PLE, D, (bf16_t*)(C.ws + WS_WPLE), first); }
    const float* p = C.in(1) + (size_t)l * T * PLE; bf16_t* pb = (bf16_t*)(C.ws + WS_PBF);
    for (size_t i = ((size_t)C.blk * NTHR + C.tid) * 8; i < (size_t)T * PLE; i += (size_t)C.G * NTHR * 8) {
        const f32x4 a = *(const f32x4*)(p + i), b = *(const f32x4*)(p + i + 4);
        u32x4 o; o.x = pk2(a.x, a.y); o.y = pk2(a.z, a.w); o.z = pk2(b.x, b.y); o.w = pk2(b.z, b.w); *(u32x4*)(pb + i) = o; }
}

struct EpiProj {
    static constexpr bool PERM = true, AFTER_DRAIN = false;
    bf16_t* P;
    DI void operator()(const f32x4 (&acc)[2][2][4][2], const pg8::Unit& u, int wr, int wc, int fr, int fq) const {
        const int row0 = u.pm * 256 + wr * 64 + fr;
#pragma unroll
        for (int bj = 0; bj < 2; ++bj) {
            const int j0 = u.pn * 256 + bj * 128 + wc * 32 + 8 * fq;
            int dst; bool half = false;
            if (j0 < 2120) { dst = j0; half = (j0 >= 1536); } else if (j0 >= 2176 && j0 < 3968) dst = j0 - 56; else dst = -1;
            if (dst >= 0) {
#pragma unroll
                for (int ai = 0; ai < 2; ++ai)
#pragma unroll
                    for (int m = 0; m < 4; ++m) {
                        const f32x4 v0 = acc[ai][bj][m][0], v1 = acc[ai][bj][m][1]; u32x4 w;
                        if (half) { w.x = pk2h(v0[0], v0[1]); w.y = pk2h(v0[2], v0[3]); w.z = pk2h(v1[0], v1[1]); w.w = pk2h(v1[2], v1[3]); }
                        else { w.x = pk2(v0[0], v0[1]); w.y = pk2(v0[2], v0[3]); w.z = pk2(v1[0], v1[1]); w.w = pk2(v1[2], v1[3]); }
                        *(u32x4*)(P + (size_t)(row0 + ai * 128 + m * 16) * PLD + dst) = w; }
            }
        }
    }
};
struct EpiBf16Plain {
    static constexpr bool PERM = true, AFTER_DRAIN = false;
    bf16_t* O; int ldc;
    DI void operator()(const f32x4 (&acc)[2][2][4][2], const pg8::Unit& u, int wr, int wc, int fr, int fq) const {
        const int row0 = u.pm * 256 + wr * 64 + fr, col0 = u.pn * 256 + wc * 32 + 8 * fq;
#pragma unroll
        for (int ai = 0; ai < 2; ++ai)
#pragma unroll
            for (int m = 0; m < 4; ++m)
#pragma unroll
                for (int bj = 0; bj < 2; ++bj) { const f32x4 v0 = acc[ai][bj][m][0], v1 = acc[ai][bj][m][1]; u32x4 w; w.x = pk2(v0[0], v0[1]); w.y = pk2(v0[2], v0[3]); w.z = pk2(v1[0], v1[1]); w.w = pk2(v1[2], v1[3]);
                    *(u32x4*)(O + (size_t)(row0 + ai * 128 + m * 16) * ldc + col0 + bj * 128) = w; }
    }
};
struct EpiResF32 {
    static constexpr bool PERM = false, AFTER_DRAIN = false;
    const bf16_t* X; bf16_t* V;
    DI void operator()(const f32x4 (&acc)[2][2][4][2], const pg8::Unit& u, int wr, int wc, int fr, int fq) const {
        const int row0 = u.pm * 256 + wr * 64 + fr, col0 = u.pn * 256 + wc * 32 + 4 * fq;
#pragma unroll
        for (int ai = 0; ai < 2; ++ai)
#pragma unroll
            for (int m = 0; m < 4; ++m)
#pragma unroll
                for (int bj = 0; bj < 2; ++bj)
#pragma unroll
                    for (int n = 0; n < 2; ++n) { const size_t off = (size_t)(row0 + ai * 128 + m * 16) * D + col0 + bj * 128 + n * 16;
                        const u32x2 xb = *(const u32x2*)(X + off); const f32x4 xv = {bflo(xb.x), bfhi(xb.x), bflo(xb.y), bfhi(xb.y)};
                        const f32x4 o = xv * ALPHA + acc[ai][bj][m][n]; u32x2 ob; ob.x = pk2(o.x, o.y); ob.y = pk2(o.z, o.w); *(u32x2*)(V + off) = ob; }
    }
};
struct EpiPle {
    static constexpr bool PERM = false, AFTER_DRAIN = false;
    const bf16_t* X; const bf16_t* PE; bf16_t* V;
    DI void operator()(const f32x4 (&acc)[2][2][4][2], const pg8::Unit& u, int wr, int wc, int fr, int fq) const {
        const int row0 = u.pm * 256 + wr * 64 + fr, col0 = u.pn * 256 + wc * 32 + 4 * fq;
#pragma unroll
        for (int ai = 0; ai < 2; ++ai)
#pragma unroll
            for (int m = 0; m < 4; ++m)
#pragma unroll
                for (int bj = 0; bj < 2; ++bj)
#pragma unroll
                    for (int n = 0; n < 2; ++n) { const size_t off = (size_t)(row0 + ai * 128 + m * 16) * D + col0 + bj * 128 + n * 16;
                        const u32x2 xb = *(const u32x2*)(X + off); const f32x4 xv = {bflo(xb.x), bfhi(xb.x), bflo(xb.y), bfhi(xb.y)};
                        const u32x2 pb = *(const u32x2*)(PE + off); const f32x4 pv = {bflo(pb.x), bfhi(pb.x), bflo(pb.y), bfhi(pb.y)};
                        const f32x4 a = acc[ai][bj][m][n]; f32x4 s; s.x = sigmoidf_(a.x); s.y = sigmoidf_(a.y); s.z = sigmoidf_(a.z); s.w = sigmoidf_(a.w);
                        const f32x4 o = xv * ALPHA + s * pv; u32x2 ob; ob.x = pk2(o.x, o.y); ob.y = pk2(o.z, o.w); *(u32x2*)(V + off) = ob; }
    }
};
struct EpiSwiGLU {
    static constexpr bool PERM = true, AFTER_DRAIN = false;
    bf16_t* H; const RowInfo* R;
    DI void operator()(const f32x4 (&acc)[2][2][4][2], const pg8::Unit& u, int wr, int wc, int fr, int fq) const {
        const int row0 = u.pm * 256 + wr * 64 + fr, col0 = (u.pn & 1) * 128 + wc * 32 + 8 * fq;
#pragma unroll
        for (int ai = 0; ai < 2; ++ai)
#pragma unroll
            for (int m = 0; m < 4; ++m) { const int row = row0 + ai * 128 + m * 16; const float gw = R[row].gate;
                float h[8];
#pragma unroll
                for (int n = 0; n < 2; ++n)
#pragma unroll
                    for (int i = 0; i < 4; ++i) { const float g = acc[ai][0][m][n][i], up = acc[ai][1][m][n][i]; h[4 * n + i] = g * sigmoidf_(g) * up * gw; }
                u32x4 w; w.x = pk2(h[0], h[1]); w.y = pk2(h[2], h[3]); w.z = pk2(h[4], h[5]); w.w = pk2(h[6], h[7]);
                *(u32x4*)(H + (size_t)row * DEXP + col0) = w; }
    }
};
struct EpiDown {
    static constexpr bool PERM = true, AFTER_DRAIN = false;
    bf16_t* Y; const RowInfo* R;
    DI void operator()(const f32x4 (&acc)[2][2][4][2], const pg8::Unit& u, int wr, int wc, int fr, int fq) const {
        const int row0 = u.pm * 256 + wr * 64 + fr, col0 = (u.pn & 3) * 256 + wc * 32 + 8 * fq;
#pragma unroll
        for (int ai = 0; ai < 2; ++ai)
#pragma unroll
            for (int m = 0; m < 4; ++m) { const int row = row0 + ai * 128 + m * 16; const RowInfo ri = R[row];
                if (ri.token >= 0) { bf16_t* dst = Y + ((size_t)ri.slot * T + ri.token) * D + col0;
#pragma unroll
                    for (int bj = 0; bj < 2; ++bj) { const f32x4 v0 = acc[ai][bj][m][0], v1 = acc[ai][bj][m][1]; u32x4 w; w.x = pk2(v0[0], v0[1]); w.y = pk2(v0[2], v0[3]); w.z = pk2(v1[0], v1[1]); w.w = pk2(v1[2], v1[3]);
                        *(u32x4*)(dst + bj * 128) = w; } } }
    }
};
template <int NPN> struct GroupedOrder {
    const LAS int* texp; int ntiles, G, c;
    DI bool next(int i, pg8::Unit& u) const { const int L = i * G + c; if (L >= ntiles * NPN) return false; u.pm = L / NPN; u.pn = texp[u.pm] * NPN + (L % NPN); return true; }
    DI void a_ready(const pg8::Unit&) const {}
    DI void done(const pg8::Unit&) const {}
};

constexpr int IDX_CAP = 512;
DI unsigned ordkey(float s) { const unsigned b = __builtin_bit_cast(unsigned, s); return (b & 0x80000000u) ? ~b : (b | 0x80000000u); }
DI float unordkey(unsigned k) { const unsigned b = (k & 0x80000000u) ? (k & 0x7fffffffu) : ~k; return __builtin_bit_cast(float, b); }

DI void idx_item(Ctx& C, int item, int l) {
    const int b = item & 3, qt = 511 - (item >> 2);
    const int t0 = qt * 8, chunk = t0 >> 6, NT32 = 2 * (chunk + 1);
    const size_t tok0 = (size_t)b * SEQ + t0;
    unsigned* bm = (unsigned*)(C.ws + WS_BM);
    const int lane = C.lane, wave = C.wave, tid = C.tid;
    if (chunk < 4) {
        if (tid < 8 * NT32) { const int q = tid / NT32, kt = tid % NT32; bm[(tok0 + q) * 128 + kt] = 0xffffffffu; }
        return;
    }
    const _Float16* ph = (const _Float16*)(C.ws + WS_PROJ);
    LAS unsigned* hist = (LAS unsigned*)(C.lds);
    LAS float* candS = (LAS float*)(C.lds + 8192);
    LAS int* candI = (LAS int*)(C.lds + 24576);
    LAS float* redmn = (LAS float*)(C.lds + 40960);
    LAS float* redmx = redmn + 64;
    LAS int* selB = (LAS int*)(C.lds + 41472);
    LAS unsigned* selAbove = (LAS unsigned*)(selB + 8);
    LAS unsigned* ccount = selAbove + 8;
    LAS float* thrS = (LAS float*)(ccount + 8);
    LAS int* thrI = (LAS int*)(thrS + 8);
    LAS unsigned* ovf = (LAS unsigned*)(thrI + 8);
    LAS unsigned* fbT = ovf + 8;
    LAS unsigned* fbCnt = fbT + 8;
    LAS unsigned* fbNeed = fbCnt + 8;
    const int r = lane & 31, hh = lane >> 5;
    float sc[2][16][2];
    f16x8 afr[2][4]; float wq[2][2][8];
#pragma unroll
    for (int m = 0; m < 2; ++m) {
        const int gq = (r >> 2) & 1, i = r >> 3, jj = r & 3, query = 4 * m + 2 * gq + (i >> 1), head = 4 * (i & 1) + jj;
        const _Float16* qp = ph + (tok0 + query) * PLD + PC_QI + head * 64 + 8 * hh;
#pragma unroll
        for (int s = 0; s < 4; ++s) afr[m][s] = *(const f16x8*)(qp + 16 * s);
#pragma unroll
        for (int qq = 0; qq < 2; ++qq) { const int q2 = 4 * m + 2 * hh + qq; const f16x8 wv = *(const f16x8*)(ph + (tok0 + q2) * PLD + PC_WI);
#pragma unroll
            for (int e = 0; e < 8; ++e) wq[m][qq][e] = (float)wv[e] * 0.044194173824159216f; }
    }
    const _Float16* kbase = ph + ((size_t)b * SEQ + r) * PLD + PC_KI + 8 * hh;
    f16x8 bnx[4];
#pragma unroll
    for (int s = 0; s < 4; ++s) bnx[s] = *(const f16x8*)(kbase + (size_t)(32 * wave) * PLD + 16 * s);
#pragma unroll
    for (int it = 0; it < 16; ++it) {
        const int kt = wave + 8 * it;
        if (kt < NT32) {
            f16x8 bfr[4];
#pragma unroll
            for (int s = 0; s < 4; ++s) bfr[s] = bnx[s];
            if (kt + 8 < NT32) {
#pragma unroll
                for (int s = 0; s < 4; ++s) bnx[s] = *(const f16x8*)(kbase + (size_t)(32 * (kt + 8)) * PLD + 16 * s); }
#pragma unroll
            for (int m = 0; m < 2; ++m) {
                f32x16 c = {};
#pragma unroll
                for (int s = 0; s < 4; ++s) c = __builtin_amdgcn_mfma_f32_32x32x16_f16(afr[m][s], bfr[s], c, 0, 0, 0);
#pragma unroll
                for (int qq = 0; qq < 2; ++qq) { float a = 0.f;
#pragma unroll
                    for (int e = 0; e < 8; ++e) a += wq[m][qq][e] * fmaxf(c[8 * qq + e], 0.f);
                    sc[m][it][qq] = a; }
            }
        } else { sc[0][it][0] = 0.f; sc[0][it][1] = 0.f; sc[1][it][0] = 0.f; sc[1][it][1] = 0.f; }
    }
    float mn[2][2], mx[2][2];
#pragma unroll
    for (int m = 0; m < 2; ++m)
#pragma unroll
        for (int qq = 0; qq < 2; ++qq) { float a = 3.0e38f, z = -3.0e38f;
#pragma unroll
            for (int it = 0; it < 16; ++it) if (wave + 8 * it < NT32) z = fmaxf(z, sc[m][it][qq]);
            a = z;
#pragma unroll
            for (int o = 1; o < 32; o <<= 1) { a = fminf(a, __shfl_xor(a, o)); z = fmaxf(z, __shfl_xor(z, o)); }
            mn[m][qq] = a; mx[m][qq] = z; }
    asm volatile("s_waitcnt lgkmcnt(0)\n\ts_barrier" ::: "memory");
    if (r == 0) {
#pragma unroll
        for (int m = 0; m < 2; ++m)
#pragma unroll
            for (int qq = 0; qq < 2; ++qq) { const int qid = 4 * m + 2 * hh + qq; redmn[wave * 8 + qid] = mn[m][qq]; redmx[wave * 8 + qid] = mx[m][qq]; }
    }
    for (int i = tid; i < 2048; i += NTHR) hist[i] = 0u;
    if (tid < 8) { ccount[tid] = 0u; ovf[tid] = 0u; }
    asm volatile("s_waitcnt lgkmcnt(0)\n\ts_barrier" ::: "memory");
    float lo[2][2], scl[2][2];
#pragma unroll
    for (int m = 0; m < 2; ++m)
#pragma unroll
        for (int qq = 0; qq < 2; ++qq) { const int qid = 4 * m + 2 * hh + qq; float a = 3.0e38f, z = -3.0e38f;
#pragma unroll
            for (int w = 0; w < 8; ++w) { a = fminf(a, redmn[w * 8 + qid]); z = fmaxf(z, redmx[w * 8 + qid]); }
            lo[m][qq] = a; scl[m][qq] = (z > a) ? 256.f / (z - a) : 0.f; }
#define IDX_BIN(m, it, qq) ((sc[m][it][qq] >= lo[m][qq]) ? min(255, (int)((sc[m][it][qq] - lo[m][qq]) * scl[m][qq])) : -1)
#define IDX_LAUNDER() do { _Pragma("unroll") for (int m_ = 0; m_ < 2; ++m_) _Pragma("unroll") for (int q_ = 0; q_ < 2; ++q_) { asm volatile("" : "+v"(lo[m_][q_]), "+v"(scl[m_][q_])); } } while (0)
#pragma unroll
    for (int m = 0; m < 2; ++m)
#pragma unroll
        for (int qq = 0; qq < 2; ++qq) { const int qid = 4 * m + 2 * hh + qq;
#pragma unroll
            for (int it = 0; it < 16; ++it) if (wave + 8 * it < NT32) { const int bin_ = IDX_BIN(m, it, qq); if (bin_ >= 0) __hip_atomic_fetch_add(hist + qid * 256 + bin_, 1u, __ATOMIC_RELAXED, __HIP_MEMORY_SCOPE_WORKGROUP); } }
    asm volatile("s_waitcnt lgkmcnt(0)\n\ts_barrier" ::: "memory");
    {
        const u32x4 h4 = *(const LAS u32x4*)(hist + wave * 256 + 4 * lane);
        const unsigned tot = h4.x + h4.y + h4.z + h4.w; unsigned incl = tot;
#pragma unroll
        for (int o = 1; o < 64; o <<= 1) { const unsigned v = __shfl_down(incl, o); if (lane + o < 64) incl += v; }
        unsigned run = incl - tot; int Bf = -1; unsigned ab = 0;
#pragma unroll
        for (int j = 3; j >= 0; --j) { const unsigned h = h4[j]; if (run < 256u && run + h >= 256u) { Bf = 4 * lane + j; ab = run; } run += h; }
        if (Bf >= 0) { selB[wave] = Bf; selAbove[wave] = ab; }
    }
    asm volatile("s_waitcnt lgkmcnt(0)\n\ts_barrier" ::: "memory");
    IDX_LAUNDER();
#pragma unroll
    for (int m = 0; m < 2; ++m)
#pragma unroll
        for (int qq = 0; qq < 2; ++qq) { const int qid = 4 * m + 2 * hh + qq; const int B = selB[qid];
#pragma unroll
            for (int it = 0; it < 16; ++it) if (wave + 8 * it < NT32) { const bool hit = (IDX_BIN(m, it, qq) == B); if (__any(hit)) { if (hit) { const unsigned pos = __hip_atomic_fetch_add(ccount + qid, 1u, __ATOMIC_RELAXED, __HIP_MEMORY_SCOPE_WORKGROUP);
                if (pos < (unsigned)IDX_CAP) { candS[qid * IDX_CAP + pos] = sc[m][it][qq]; candI[qid * IDX_CAP + pos] = 32 * (wave + 8 * it) + r; } } } } }
    asm volatile("s_waitcnt lgkmcnt(0)\n\ts_barrier" ::: "memory");
    {
        const int c = (int)ccount[wave]; const int need = 256 - (int)selAbove[wave];
        if (c <= IDX_CAP) {
            for (int i = lane; i < c; i += 64) { const float si = candS[wave * IDX_CAP + i]; const int ii = candI[wave * IDX_CAP + i]; int rank = 0;
                for (int j = 0; j < c; ++j) { const float sj = candS[wave * IDX_CAP + j]; const int ij = candI[wave * IDX_CAP + j]; rank += ((sj > si) || (sj == si && ij < ii)) ? 1 : 0; }
                if (rank == need - 1) { thrS[wave] = si; thrI[wave] = ii; } }
        } else if (lane == 0) { ovf[wave] = 1u; fbNeed[wave] = (unsigned)need; fbT[wave] = 0u; }
    }
    asm volatile("s_waitcnt lgkmcnt(0)\n\ts_barrier" ::: "memory");
    unsigned anyovf = 0u;
#pragma unroll
    for (int q = 0; q < 8; ++q) anyovf |= ovf[q];
    if (anyovf) {
        for (int bit = 31; bit >= 0; --bit) {
            if (tid < 8) fbCnt[tid] = 0u;
            asm volatile("s_waitcnt lgkmcnt(0)\n\ts_barrier" ::: "memory");
            IDX_LAUNDER();
#pragma unroll
            for (int m = 0; m < 2; ++m)
#pragma unroll
                for (int qq = 0; qq < 2; ++qq) { const int qid = 4 * m + 2 * hh + qq; if (ovf[qid]) { const unsigned cand = fbT[qid] | (1u << bit); const int B = selB[qid]; unsigned cnt = 0;
#pragma unroll
                    for (int it = 0; it < 16; ++it) if (wave + 8 * it < NT32) cnt += (IDX_BIN(m, it, qq) == B && ordkey(sc[m][it][qq]) >= cand) ? 1u : 0u;
                    if (cnt) __hip_atomic_fetch_add(fbCnt + qid, cnt, __ATOMIC_RELAXED, __HIP_MEMORY_SCOPE_WORKGROUP); } }
            asm volatile("s_waitcnt lgkmcnt(0)\n\ts_barrier" ::: "memory");
            if (tid < 8 && ovf[tid] && fbCnt[tid] >= fbNeed[tid]) fbT[tid] |= (1u << bit);
            asm volatile("s_waitcnt lgkmcnt(0)\n\ts_barrier" ::: "memory");
        }
        if (tid < 8) fbCnt[tid] = 0u;
        asm volatile("s_waitcnt lgkmcnt(0)\n\ts_barrier" ::: "memory");
        IDX_LAUNDER();
#pragma unroll
        for (int m = 0; m < 2; ++m)
#pragma unroll
            for (int qq = 0; qq < 2; ++qq) { const int qid = 4 * m + 2 * hh + qq; if (ovf[qid]) { const unsigned Tk = fbT[qid]; const int B = selB[qid]; unsigned cnt = 0;
#pragma unroll
                for (int it = 0; it < 16; ++it) if (wave + 8 * it < NT32) cnt += (IDX_BIN(m, it, qq) == B && ordkey(sc[m][it][qq]) > Tk) ? 1u : 0u;
                if (cnt) __hip_atomic_fetch_add(fbCnt + qid, cnt, __ATOMIC_RELAXED, __HIP_MEMORY_SCOPE_WORKGROUP); } }
        asm volatile("s_waitcnt lgkmcnt(0)\n\ts_barrier" ::: "memory");
        if (tid < 8 && ovf[tid]) { fbNeed[tid] -= fbCnt[tid]; thrS[tid] = unordkey(fbT[tid]); thrI[tid] = 0; }
        asm volatile("s_waitcnt lgkmcnt(0)\n\ts_barrier" ::: "memory");
        for (int bit = 11; bit >= 0; --bit) {
            if (tid < 8) fbCnt[tid] = 0u;
            asm volatile("s_waitcnt lgkmcnt(0)\n\ts_barrier" ::: "memory");
            IDX_LAUNDER();
#pragma unroll
            for (int m = 0; m < 2; ++m)
#pragma unroll
                for (int qq = 0; qq < 2; ++qq) { const int qid = 4 * m + 2 * hh + qq; if (ovf[qid]) { const unsigned Tk = fbT[qid]; const int B = selB[qid]; const int cand = thrI[qid] | (1 << bit); unsigned cnt = 0;
#pragma unroll
                    for (int it = 0; it < 16; ++it) if (wave + 8 * it < NT32) cnt += (IDX_BIN(m, it, qq) == B && ordkey(sc[m][it][qq]) == Tk && (32 * (wave + 8 * it) + r) < cand) ? 1u : 0u;
                    if (cnt) __hip_atomic_fetch_add(fbCnt + qid, cnt, __ATOMIC_RELAXED, __HIP_MEMORY_SCOPE_WORKGROUP); } }
            asm volatile("s_waitcnt lgkmcnt(0)\n\ts_barrier" ::: "memory");
            if (tid < 8 && ovf[tid] && fbCnt[tid] < fbNeed[tid]) thrI[tid] |= (1 << bit);
            asm volatile("s_waitcnt lgkmcnt(0)\n\ts_barrier" ::: "memory");
        }
    }
    IDX_LAUNDER();
#pragma unroll
    for (int m = 0; m < 2; ++m)
#pragma unroll
        for (int qq = 0; qq < 2; ++qq) { const int qid = 4 * m + 2 * hh + qq; const int B = selB[qid]; const float ts = thrS[qid]; const int ti = thrI[qid];
            unsigned myw = 0u;
#pragma unroll
            for (int it = 0; it < 16; ++it) { const int kt = wave + 8 * it;
                if (kt < NT32) { const int bin = IDX_BIN(m, it, qq); const float s = sc[m][it][qq]; const int idx = 32 * kt + r;
                    const bool sel = (bin > B) || (bin == B && (s > ts || (s == ts && idx <= ti)));
                    const unsigned long long mk = __ballot(sel);
                    const unsigned wv = hh ? (unsigned)(mk >> 32) : (unsigned)mk;
                    if (r == it) myw = wv; } }
            if (r < 16 && wave + 8 * r < NT32) bm[(tok0 + qid) * 128 + wave + 8 * r] = myw; }
#undef IDX_BIN
#undef IDX_LAUNDER
}

DI float softplusf_(float z) { return fmaxf(z, 0.f) + log1pf(expf(-fabsf(z))); }
DI void attn_tile(const LAS unsigned char* kb, const LAS unsigned char* vb, const LAS float* tab, const bf16x8 (&qr)[4], unsigned cw0, unsigned cw1, int j, int qw, int myq, int r32, int hi, float bias_far,
                  float& m_run, float& l_run, f32x16& o0, f32x16& o1, f32x16& negmb) {
    bf16x8 ka[8];
#pragma unroll
    for (int s = 0; s < 4; ++s) { const int ch = 2 * s + hi;
        ka[2 * s] = *(const LAS bf16x8*)(kb + r32 * 128 + ((ch ^ ((r32 >> 1) & 7)) << 4));
        ka[2 * s + 1] = *(const LAS bf16x8*)(kb + (32 + r32) * 128 + ((ch ^ (((32 + r32) >> 1) & 7)) << 4)); }
    f32x16 p0 = negmb, p1 = negmb;
#pragma unroll
    for (int s = 0; s < 4; ++s) { p0 = __builtin_amdgcn_mfma_f32_32x32x16_bf16(ka[2 * s], qr[s], p0, 0, 0, 0); p1 = __builtin_amdgcn_mfma_f32_32x32x16_bf16(ka[2 * s + 1], qr[s], p1, 0, 0, 0); }
    u32x4 va0[4], va1[4];
#pragma unroll
    for (int s = 0; s < 4; ++s) {
        const u32x2 a0l = *(const LAS u32x2*)(vb + (r32) * 136 + (16 * s + 4 * hi) * 2), a0h = *(const LAS u32x2*)(vb + (r32) * 136 + (16 * s + 8 + 4 * hi) * 2);
        const u32x2 a1l = *(const LAS u32x2*)(vb + (32 + r32) * 136 + (16 * s + 4 * hi) * 2), a1h = *(const LAS u32x2*)(vb + (32 + r32) * 136 + (16 * s + 8 + 4 * hi) * 2);
        va0[s] = (u32x4){a0l.x, a0l.y, a0h.x, a0h.y}; va1[s] = (u32x4){a1l.x, a1l.y, a1h.x, a1h.y}; }
    const bool far = (64 * j + 63 - qw) <= -128;
    if (!far) {
#pragma unroll
        for (int g = 0; g < 16; ++g) { const int kv0 = 64 * j + (g & 3) + 8 * (g >> 2) + 4 * hi; int r0 = kv0 - myq, r1 = r0 + 32;
            r0 = r0 < -128 ? -128 : r0; r1 = r1 < -128 ? -128 : r1;
            p0[g] += tab[r0 + 128]; p1[g] += tab[r1 + 128]; }
    }
    float mx = p0[0];
#pragma unroll
    for (int g = 1; g < 16; ++g) mx = fmaxf(mx, p0[g]);
#pragma unroll
    for (int g = 0; g < 16; ++g) mx = fmaxf(mx, p1[g]);
    mx = fmaxf(mx, __shfl_xor(mx, 32));
    if (j == 0 || __any(mx > 0.f)) {
        const float dl = (j == 0) ? mx : fmaxf(mx, 0.f);
        m_run += dl;
        const float al = __builtin_amdgcn_exp2f(-dl); l_run *= al;
#pragma unroll
        for (int g = 0; g < 16; ++g) { p0[g] -= dl; p1[g] -= dl; o0[g] *= al; o1[g] *= al; negmb[g] = bias_far - m_run; }
        asm volatile("" : "+v"(negmb));
    }
    const int sw0 = (int)(cw0 >> (4 * hi)), sw1 = (int)(cw1 >> (4 * hi));
    float ls = 0.f;
#pragma unroll
    for (int g = 0; g < 16; ++g) { const int bit = (g & 3) + 8 * (g >> 2);
        const float e0 = __builtin_amdgcn_exp2f(p0[g]), e1 = __builtin_amdgcn_exp2f(p1[g]);
        int m0_, m1_;
        asm("v_bfe_i32 %0, %1, %2, 1" : "=v"(m0_) : "v"(sw0), "n"(bit)); asm("v_bfe_i32 %0, %1, %2, 1" : "=v"(m1_) : "v"(sw1), "n"(bit));
        p0[g] = __builtin_bit_cast(float, __builtin_bit_cast(int, e0) & m0_); p1[g] = __builtin_bit_cast(float, __builtin_bit_cast(int, e1) & m1_); ls += p0[g] + p1[g]; }
    l_run += ls;
    bf16x8 pb[4];
#pragma unroll
    for (int s = 0; s < 2; ++s) {
        u32x4 w; w.x = pk2(p0[8 * s], p0[8 * s + 1]); w.y = pk2(p0[8 * s + 2], p0[8 * s + 3]); w.z = pk2(p0[8 * s + 4], p0[8 * s + 5]); w.w = pk2(p0[8 * s + 6], p0[8 * s + 7]); pb[s] = __builtin_bit_cast(bf16x8, w);
        u32x4 x; x.x = pk2(p1[8 * s], p1[8 * s + 1]); x.y = pk2(p1[8 * s + 2], p1[8 * s + 3]); x.z = pk2(p1[8 * s + 4], p1[8 * s + 5]); x.w = pk2(p1[8 * s + 6], p1[8 * s + 7]); pb[2 + s] = __builtin_bit_cast(bf16x8, x); }
#pragma unroll
    for (int s = 0; s < 4; ++s) {
        o0 = __builtin_amdgcn_mfma_f32_32x32x16_bf16(__builtin_bit_cast(bf16x8, va0[s]), pb[s], o0, 0, 0, 0);
        o1 = __builtin_amdgcn_mfma_f32_32x32x16_bf16(__builtin_bit_cast(bf16x8, va1[s]), pb[s], o1, 0, 0, 0); }
}
DI void attn_unit(Ctx& C, int b, int h, int qb) {
    const int tid = C.tid, lane = C.lane, wave = C.wave, r32 = lane & 31, hi = lane >> 5;
    const bf16_t* proj = (const bf16_t*)(C.ws + WS_PROJ);
    const unsigned* bm = (const unsigned*)(C.ws + WS_BM);
    LAS unsigned char* Kl = C.lds; LAS unsigned char* Vl = C.lds + 16384; LAS float* tab = (LAS float*)(C.lds + 33792);
    const size_t rowbase = (size_t)b * SEQ; const int q0 = qb * 256, qw = q0 + 32 * wave, myq = qw + r32;
    const int NT = 4 * qb + 4, mylast = qw >> 6;
    constexpr float LOG2E = 1.4426950408889634f;
    __syncthreads();
    if (tid < 192) { const int rel = tid - 128; const int n = rel < 0 ? -rel : rel; int bk = rel > 0 ? 16 : 0;
        if (n < 8) bk += n; else bk += 8 + (n >= 12) + (n >= 16) + (n >= 23) + (n >= 32) + (n >= 46) + (n >= 64) + (n >= 91);
        tab[tid] = (C.in(17)[bk * 8 + h] - C.in(17)[15 * 8 + h]) * LOG2E; }
    const float bias_far = C.in(17)[15 * 8 + h] * LOG2E;
    bf16x8 qr[4];
    { const bf16_t* qp = proj + (rowbase + myq) * PLD + PC_Q + h * 64 + 8 * hi;
#pragma unroll
        for (int s = 0; s < 4; ++s) { const u32x4 raw = *(const u32x4*)(qp + 16 * s); u32x4 sc_;
#pragma unroll
            for (int e = 0; e < 4; ++e) sc_[e] = pk2(bflo(raw[e]) * (0.125f * LOG2E), bfhi(raw[e]) * (0.125f * LOG2E));
            qr[s] = __builtin_bit_cast(bf16x8, sc_); } }
    const unsigned* bmrow = bm + (rowbase + myq) * 128;
    const int skv = tid >> 3, sch = tid & 7;
    const bf16_t* ksrc = proj + (rowbase + skv) * PLD + PC_K + h * 64 + 8 * sch;
    const bf16_t* vsrc = proj + (rowbase + skv) * PLD + PC_V + h * 64 + 8 * sch;
    const int kdst = skv * 128 + ((sch ^ ((skv >> 1) & 7)) << 4);
    const u32x4 m4i = *(const u32x4*)bmrow;
    u32x4 kregA = *(const u32x4*)ksrc, vregA = *(const u32x4*)vsrc; unsigned mA0 = m4i.x, mA1 = m4i.y;
    u32x4 kregB = kregA, vregB = vregA; unsigned mB0 = m4i.z, mB1 = m4i.w;
    if (NT > 1) { kregB = *(const u32x4*)(ksrc + (size_t)64 * PLD); vregB = *(const u32x4*)(vsrc + (size_t)64 * PLD); }
    const bool vodd = (skv & 1) != 0; const int vdst = ((8 * sch + (vodd ? 4 : 0)) * 68 + (skv & ~1)) * 2;
#define ATT_WRITE(buf, kreg, vreg) do { *(LAS u32x4*)(Kl + (buf) * 8192 + kdst) = kreg; LAS unsigned char* vt_ = Vl + (buf) * 8704 + vdst; \
        const unsigned r0_ = (unsigned)__builtin_amdgcn_ds_swizzle((int)(vodd ? vreg.x : vreg.z), 0x201F), r1_ = (unsigned)__builtin_amdgcn_ds_swizzle((int)(vodd ? vreg.y : vreg.w), 0x201F); \
        const unsigned lo0_ = vodd ? r0_ : vreg.x, hi0_ = vodd ? vreg.z : r0_, lo1_ = vodd ? r1_ : vreg.y, hi1_ = vodd ? vreg.w : r1_; \
        *(LAS unsigned*)(vt_ + 0 * 136) = (lo0_ & 0xffffu) | (hi0_ << 16); *(LAS unsigned*)(vt_ + 1 * 136) = (lo0_ >> 16) | (hi0_ & 0xffff0000u); \
        *(LAS unsigned*)(vt_ + 2 * 136) = (lo1_ & 0xffffu) | (hi1_ << 16); *(LAS unsigned*)(vt_ + 3 * 136) = (lo1_ >> 16) | (hi1_ & 0xffff0000u); } while (0)
    ATT_WRITE(0, kregA, vregA);
    __syncthreads();
    float m_run = 0.f, l_run = 0.f; f32x16 o0 = {}, o1 = {}, negmb;
#pragma unroll
    for (int g = 0; g < 16; ++g) negmb[g] = bias_far;
    asm volatile("" : "+v"(negmb));
#define ATT_STEP(J, CW0, CW1, KN, VN, KF, VF, MLOAD) do { const int js_ = (J); const int buf = js_ & 1; \
        if (js_ + 2 < NT) { KF = *(const u32x4*)(ksrc + (size_t)(js_ + 2) * 64 * PLD); VF = *(const u32x4*)(vsrc + (size_t)(js_ + 2) * 64 * PLD); MLOAD; } \
        if (js_ <= mylast) { attn_tile(Kl + buf * 8192, Vl + buf * 8704, tab, qr, (CW0), (CW1), js_, qw, myq, r32, hi, bias_far, m_run, l_run, o0, o1, negmb); } \
        if (js_ + 1 < NT) ATT_WRITE(buf ^ 1, KN, VN); \
        __syncthreads(); } while (0)
    {
        unsigned cA0 = mA0, cA1 = mA1;
        for (int j = 0; j < NT; j += 2) {
            u32x4 m4 = {0u, 0u, 0u, 0u};
            { const unsigned c0 = cA0, c1 = cA1; u32x4 kf = kregA, vf = vregA;
              ATT_STEP(j, c0, c1, kregB, vregB, kf, vf, m4 = *(const u32x4*)(bmrow + 2 * js_ + 4)); kregA = kf; vregA = vf; cA0 = m4.x; cA1 = m4.y; }
            if (j + 1 < NT) {
                const unsigned c0 = mB0, c1 = mB1; u32x4 kf = kregB, vf = vregB;
                ATT_STEP(j + 1, c0, c1, kregA, vregA, kf, vf, (void)0); kregB = kf; vregB = vf; mB0 = m4.z; mB1 = m4.w; }
        }
    }
#undef ATT_STEP
#undef ATT_WRITE
    const float lt = l_run + __shfl_xor(l_run, 32); const float inv = 1.f / lt;
    bf16_t* orow = C.mixcat + (rowbase + myq) * D + h * 64;
#pragma unroll
    for (int i = 0; i < 4; ++i) { const int d = 8 * i + 4 * hi;
        u32x2 w0; w0.x = pk2(o0[4 * i] * inv, o0[4 * i + 1] * inv); w0.y = pk2(o0[4 * i + 2] * inv, o0[4 * i + 3] * inv); *(u32x2*)(orow + d) = w0;
        u32x2 w1; w1.x = pk2(o1[4 * i] * inv, o1[4 * i + 1] * inv); w1.y = pk2(o1[4 * i + 2] * inv, o1[4 * i + 3] * inv); *(u32x2*)(orow + 32 + d) = w1; }
}

constexpr size_t WS_PHI = 38 * MiB, WS_PSI = 54 * MiB, WS_GT = 70 * MiB, WS_Y0T = 86 * MiB, WS_GGT = 102 * MiB, WS_RHO = 118 * MiB;
constexpr size_t WS_S0 = 1 * MiB;
constexpr size_t WS_LORA = 250 * MiB;
DI int crow(int g, int hi) { return (g & 3) + 8 * (g >> 2) + 4 * hi; }
DI f32x16 mfma32(bf16x8 a, bf16x8 b, f32x16 c) { return __builtin_amdgcn_mfma_f32_32x32x16_bf16(a, b, c, 0, 0, 0); }
struct FA { float v[16]; DI float& operator[](int i) { return v[i]; } DI const float& operator[](int i) const { return v[i]; } };
struct F8 { float v[8]; DI float& operator[](int i) { return v[i]; } DI const float& operator[](int i) const { return v[i]; } };
DI bf16x8 pack8(const F8& a) { u32x4 w; w.x = pk2(a[0], a[1]); w.y = pk2(a[2], a[3]); w.z = pk2(a[4], a[5]); w.w = pk2(a[6], a[7]); return __builtin_bit_cast(bf16x8, w); }
DI void pin(FA& a) { asm volatile("" : "+v"(a.v[0]), "+v"(a.v[1]), "+v"(a.v[2]), "+v"(a.v[3]), "+v"(a.v[4]), "+v"(a.v[5]), "+v"(a.v[6]), "+v"(a.v[7]), "+v"(a.v[8]), "+v"(a.v[9]), "+v"(a.v[10]), "+v"(a.v[11]), "+v"(a.v[12]), "+v"(a.v[13]), "+v"(a.v[14]), "+v"(a.v[15])); }
DI void pinf(bf16x8& a) { asm volatile("" : "+v"(a)); }
DI FA toFA(const f32x16& a) { FA r; _Pragma("unroll") for (int i = 0; i < 16; ++i) r.v[i] = a[i]; return r; }
DI f32x16 toV(const FA& a) { f32x16 r; _Pragma("unroll") for (int i = 0; i < 16; ++i) r[i] = a.v[i]; return r; }
DI bf16x8 packfrag(const FA& a, int s) { u32x4 w; w.x = pk2(a[8 * s], a[8 * s + 1]); w.y = pk2(a[8 * s + 2], a[8 * s + 3]); w.z = pk2(a[8 * s + 4], a[8 * s + 5]); w.w = pk2(a[8 * s + 6], a[8 * s + 7]); return __builtin_bit_cast(bf16x8, w); }
DI bf16x8 packfrag(const f32x16& a, int s) { u32x4 w; w.x = pk2(a[8 * s], a[8 * s + 1]); w.y = pk2(a[8 * s + 2], a[8 * s + 3]); w.z = pk2(a[8 * s + 4], a[8 * s + 5]); w.w = pk2(a[8 * s + 6], a[8 * s + 7]); return __builtin_bit_cast(bf16x8, w); }
DI unsigned opq(unsigned v) { asm volatile("" : "+v"(v)); return v; }
DI void st_frag(unsigned char* buf, int f, int lane, bf16x8 v) { *(bf16x8*)(buf + f * 1024 + opq(lane * 16)) = v; }
DI bf16x8 ld_frag(const unsigned char* buf, int f, int lane) { return *(const bf16x8*)(buf + f * 1024 + opq(lane * 16)); }
template <class TT> DI void st_tile_bf16(unsigned char* buf, int q, int lane, const TT& a) { const unsigned o = opq(lane * 32); *(bf16x8*)(buf + q * 2048 + o) = packfrag(a, 0); *(bf16x8*)(buf + q * 2048 + o + 16) = packfrag(a, 1); }
DI FA ld_tile_bf16(const unsigned char* buf, int q, int lane) { const unsigned o = opq(lane * 32); const u32x4 a = *(const u32x4*)(buf + q * 2048 + o), b = *(const u32x4*)(buf + q * 2048 + o + 16); FA r;
    r[0] = bflo(a.x); r[1] = bfhi(a.x); r[2] = bflo(a.y); r[3] = bfhi(a.y); r[4] = bflo(a.z); r[5] = bfhi(a.z); r[6] = bflo(a.w); r[7] = bfhi(a.w);
    r[8] = bflo(b.x); r[9] = bfhi(b.x); r[10] = bflo(b.y); r[11] = bfhi(b.y); r[12] = bflo(b.z); r[13] = bfhi(b.z); r[14] = bflo(b.w); r[15] = bfhi(b.w); return r; }
DI float fexp(float x) { return __builtin_amdgcn_exp2f(x * 1.4426950408889634f); }
DI float flog(float x) { return __builtin_amdgcn_logf(x) * 0.6931471805599453f; }
DI float ftanh(float x) { return 1.f - 2.f * __builtin_amdgcn_rcpf(1.f + fexp(2.f * x)); }
DI float fsigm(float x) { return __builtin_amdgcn_rcpf(1.f + fexp(-x)); }
DI float fsoftplus(float z) { return fmaxf(z, 0.f) + flog(1.f + fexp(-fabsf(z))); }
template <int ACT> DI bf16x8 act_frag(const bf16_t* proj, size_t row, bool first, int c0, const float* mu8) {
    const bf16_t* rp = proj + opq((unsigned)(row * PLD)); const u32x4 cu = *(const u32x4*)(rp + c0); u32x4 pv = {0u, 0u, 0u, 0u}; if (!first) pv = *(const u32x4*)(rp - PLD + c0);
    const float* mq = mu8 + opq(0u); const f32x4 m0 = *(const f32x4*)(mq), m1 = *(const f32x4*)(mq + 4);
    float x[8];
#pragma unroll
    for (int q = 0; q < 4; ++q) { const float c_lo = bflo(cu[q]), c_hi = bfhi(cu[q]), p_lo = bflo(pv[q]), p_hi = bfhi(pv[q]); const float ma = (q < 2) ? m0[2 * q] : m1[2 * q - 4], mb = (q < 2) ? m0[2 * q + 1] : m1[2 * q - 3];
        x[2 * q] = c_lo + (p_lo - c_lo) * ma; x[2 * q + 1] = c_hi + (p_hi - c_hi) * mb; }
#pragma unroll
    for (int e = 0; e < 8; ++e) { if (ACT == 1) x[e] = ftanh(x[e]); else if (ACT == 2) x[e] = fsigm(x[e]); }
    u32x4 w; w.x = pk2(x[0], x[1]); w.y = pk2(x[2], x[3]); w.z = pk2(x[4], x[5]); w.w = pk2(x[6], x[7]); return __builtin_bit_cast(bf16x8, w);
}
DI f32x4 shift4(const bf16_t* proj, size_t row, bool first, int c4, const float* mu4) {
    const bf16_t* rp = proj + opq((unsigned)(row * PLD)); const u32x2 cu = *(const u32x2*)(rp + c4); u32x2 pv = {0u, 0u}; if (!first) pv = *(const u32x2*)(rp - PLD + c4);
    const f32x4 m = *(const f32x4*)(mu4 + opq(0u)); const f32x4 c = {bflo(cu.x), bfhi(cu.x), bflo(cu.y), bfhi(cu.y)}, p = {bflo(pv.x), bfhi(pv.x), bflo(pv.y), bfhi(pv.y)};
    return c + (p - c) * m;
}
DI f32x4 shiftT4(const bf16_t* proj, size_t row, bool firstseq, int c1, float mu1) {
    const bf16_t* rp = proj + opq((unsigned)(row * PLD + c1));
    const float c0 = bf2f(rp[0]), c1_ = bf2f(rp[PLD]), c2 = bf2f(rp[2 * PLD]), c3 = bf2f(rp[3 * PLD]);
    const float pm = firstseq ? 0.f : bf2f(*(rp - PLD));
    f32x4 r; r.x = c0 + (pm - c0) * mu1; r.y = c1_ + (c0 - c1_) * mu1; r.z = c2 + (c1_ - c2) * mu1; r.w = c3 + (c2 - c3) * mu1; return r;
}
DI float scan32_incl(float x, int tl) {
#pragma unroll
    for (int d = 1; d < 32; d <<= 1) { const float y = __shfl_up(x, d, 32); if (tl >= d) x += y; }
    return x;
}

constexpr int RL_ACT = 0;
constexpr int RL_MAB = 0, RL_W1C = 17408, RL_W2C = 26624;
constexpr int RL_ELL = 35840;
constexpr int RL_AV = RL_ELL + 16640, RL_MAK = RL_ELL, RL_NRB = RL_ELL + 9216, RL_NRK = RL_ELL + 18432;
constexpr int RL_RT = 69120, RL_AT = RL_RT + 9216, RL_BT = RL_RT + 18432, RL_KT = RL_RT + 27648;
constexpr int RL_X2 = RL_AT;
constexpr int RL_BHC = 105984, RL_KHC = RL_BHC + 9216, RL_VC = RL_BHC + 18432;
constexpr int RL_X = 133632;
constexpr int RL_SM = 150272;
constexpr int RL_END = RL_SM + 512;
template <int KS> DI f32x16 mm_ll(const LAS bf16_t* a, int pa, const LAS bf16_t* b, int pb, int lane, f32x16 acc) {
    const LAS bf16_t* ap = a + (lane & 31) * pa + 8 * (lane >> 5); const LAS bf16_t* bp = b + (lane & 31) * pb + 8 * (lane >> 5);
#pragma unroll
    for (int s = 0; s < KS; ++s) acc = mfma32(*(const LAS bf16x8*)(ap + 16 * s), *(const LAS bf16x8*)(bp + 16 * s), acc);
    return acc;
}
DI void rwkv_chunk_acts(Ctx& C, int bc, int l, bf16x8 (&actv)[4]) {
    const int chunk = bc & 63, b = bc >> 6, t = C.tid >> 3, cg = C.tid & 7; const size_t row = (size_t)b * SEQ + chunk * 64 + t; const bool first = (chunk == 0 && t == 0);
    const bf16_t* proj = (const bf16_t*)(C.ws + WS_PROJ); const float* mu = C.in(6) + (size_t)l * 1792;
#pragma unroll
    for (int q = 0; q < 4; ++q) { const int c8 = cg * 32 + 8 * q;
        if (c8 < 64) actv[q] = act_frag<1>(proj, row, first, PC_WD + c8, mu + 1536 + c8); else if (c8 < 128) actv[q] = act_frag<0>(proj, row, first, PC_WD + c8, mu + 1536 + c8); else actv[q] = act_frag<2>(proj, row, first, PC_WD + c8, mu + 1536 + c8); }
}
#define LBAR() asm volatile("s_waitcnt lgkmcnt(0)\n\ts_barrier" ::: "memory")
DI void rwkv_head_item(Ctx& C, int item, int l, const bf16x8 (&actv)[4]) {
    const int h = item & 7, chunk = (item >> 3) & 63, b = item >> 9, tid = C.tid, lane = C.lane, wave = C.wave, tl = lane & 31, hi = lane >> 5;
    const size_t tok0 = (size_t)b * SEQ + chunk * 64;
    const bf16_t* proj = (const bf16_t*)(C.ws + WS_PROJ);
    const size_t chid = ((size_t)(b * 8 + h) * 64 + chunk) * 8192;
    unsigned char* PHI = C.ws + WS_PHI + chid; unsigned char* PSI = C.ws + WS_PSI + chid; unsigned char* GT = C.ws + WS_GT + chid; unsigned char* Y0T = C.ws + WS_Y0T + chid; unsigned char* GGT = C.ws + WS_GGT + chid;
    const bf16_t* WDT = (const bf16_t*)(C.ws + WS_LORA); const bf16_t* WAT = WDT + 512 * 64; const bf16_t* WGT = WAT + 512 * 64;
    const float* mu = C.in(6) + (size_t)l * 1792;
    const float* w0p = C.in(7) + l * 512 + 64 * h; const float* a0p = C.in(9) + l * 512 + 64 * h;
    const float* kkp = C.in(12) + l * 512 + 64 * h; const float* kap = C.in(13) + l * 512 + 64 * h; const float* rkp = C.in(14) + l * 512 + 64 * h;
    LAS bf16_t* ACT = (LAS bf16_t*)(C.lds + RL_ACT); LAS float* MAB = (LAS float*)(C.lds + RL_MAB); LAS bf16_t* W1C = (LAS bf16_t*)(C.lds + RL_W1C); LAS bf16_t* W2C = (LAS bf16_t*)(C.lds + RL_W2C);
    LAS float* ELL = (LAS float*)(C.lds + RL_ELL); LAS float* AV = (LAS float*)(C.lds + RL_AV);
    LAS bf16_t* MAK = (LAS bf16_t*)(C.lds + RL_MAK); LAS bf16_t* NRB = (LAS bf16_t*)(C.lds + RL_NRB); LAS bf16_t* NRK = (LAS bf16_t*)(C.lds + RL_NRK);
    LAS bf16_t* AT = (LAS bf16_t*)(C.lds + RL_AT); LAS bf16_t* RT = (LAS bf16_t*)(C.lds + RL_RT); LAS bf16_t* BT = (LAS bf16_t*)(C.lds + RL_BT); LAS bf16_t* KT = (LAS bf16_t*)(C.lds + RL_KT);
    LAS bf16_t* BHC = (LAS bf16_t*)(C.lds + RL_BHC); LAS bf16_t* KHC = (LAS bf16_t*)(C.lds + RL_KHC); LAS bf16_t* VC = (LAS bf16_t*)(C.lds + RL_VC);
    LAS float* X = (LAS float*)(C.lds + RL_X); LAS float* X2 = (LAS float*)(C.lds + RL_X2); LAS float* INV = (LAS float*)(C.lds + RL_SM); LAS float* LCv = INV + 64;
    LBAR();
#ifndef RWR12
#define RWR12 1
#define RWR4 1
#define RWR5 1
#define RWR11 1
#endif
    for (int rr_ = 0; rr_ < RWR12; ++rr_) {
    const int jp = (wave >> 1) & 1, jq = wave & 1;
    bf16x8 wfr[8];
    if (wave < 4) { const bf16_t* W = WGT + (size_t)(64 * h + 32 * jp + tl) * 128 + 8 * hi;
#pragma unroll
        for (int s = 0; s < 8; ++s) wfr[s] = *(const bf16x8*)(W + 16 * s);
    } else { const bf16_t* W0 = WDT + (size_t)(64 * h + 32 * jq + tl) * 64 + 8 * hi; const bf16_t* W1 = WAT + (size_t)(64 * h + 32 * jq + tl) * 64 + 8 * hi;
#pragma unroll
        for (int s = 0; s < 4; ++s) { wfr[s] = *(const bf16x8*)(W0 + 16 * s); wfr[4 + s] = *(const bf16x8*)(W1 + 16 * s); } }
    { const int t = tid >> 3, cg = tid & 7;
#pragma unroll
        for (int q = 0; q < 4; ++q) *(LAS bf16x8*)(ACT + t * 264 + cg * 32 + 8 * q) = actv[q]; }
    LBAR();
    if (wave < 4) {
        const LAS bf16_t* bp = ACT + (32 * jq + tl) * 264 + 128 + 8 * hi; f32x16 acc = {};
#pragma unroll
        for (int s = 0; s < 8; ++s) acc = mfma32(wfr[s], *(const LAS bf16x8*)(bp + 16 * s), acc);
        st_tile_bf16(GGT, jp * 2 + jq, lane, acc);
    } else {
        const LAS bf16_t* ap = ACT + (32 * jp + tl) * 264 + 8 * hi; f32x16 a0 = {}, a1 = {};
#pragma unroll
        for (int s = 0; s < 4; ++s) { a0 = mfma32(*(const LAS bf16x8*)(ap + 16 * s), wfr[s], a0); a1 = mfma32(*(const LAS bf16x8*)(ap + 64 + 16 * s), wfr[4 + s], a1); }
        const int ch = 32 * jq + tl; const float w0c = w0p[ch], a0c = a0p[ch];
#pragma unroll
        for (int g = 0; g < 16; ++g) { const int t = 32 * jp + crow(g, hi); ELL[t * 65 + ch] = -fexp(-fsoftplus(-(w0c + a0[g])) - 0.5f); AV[t * 65 + ch] = fsigm(a0c + a1[g]); }
    }
    LBAR();
    }
    { const int ch = tid & 63, seg = tid >> 6; float p[8]; float run = 0.f;
#pragma unroll
        for (int e = 0; e < 8; ++e) { run += ELL[(8 * seg + e) * 65 + ch]; p[e] = run; }
        X[seg * 65 + ch] = run;
        LBAR();
        float off = 0.f;
#pragma unroll
        for (int s2 = 0; s2 < 7; ++s2) off += (s2 < seg) ? X[s2 * 65 + ch] : 0.f;
#pragma unroll
        for (int e = 0; e < 8; ++e) ELL[(8 * seg + e) * 65 + ch] = off + p[e];
        if (seg == 7) LCv[ch] = off + p[7]; }
    LBAR();
    for (int rr_ = 0; rr_ < RWR4; ++rr_) {
    { const int t = tid >> 3, c0 = (tid & 7) * 8; const size_t row = tok0 + t; const bool first = (chunk == 0 && t == 0); float rho = 0.f, n2 = 0.f;
        f32x4 r4[2], k4[2], v4[2];
#pragma unroll
        for (int q = 0; q < 2; ++q) { const int c = c0 + 4 * q;
            r4[q] = shift4(proj, row, first, PC_R + 64 * h + c, mu + 64 * h + c); k4[q] = shift4(proj, row, first, PC_BK + 64 * h + c, mu + 512 + 64 * h + c); v4[q] = shift4(proj, row, first, PC_BV + 64 * h + c, mu + 1024 + 64 * h + c);
            const f32x4 kr = k4[q] * *(const f32x4*)(kkp + c); n2 += (kr.x * kr.x + kr.y * kr.y) + (kr.z * kr.z + kr.w * kr.w); }
        n2 += __shfl_xor(n2, 1); n2 += __shfl_xor(n2, 2); n2 += __shfl_xor(n2, 4);
        const float inv = 1.f / fmaxf(sqrtf(n2), 1e-12f);
        F8 vA, vR, vB, vK;
#pragma unroll
        for (int q = 0; q < 2; ++q) { const int c = c0 + 4 * q;
            const f32x4 kk4 = *(const f32x4*)(kkp + c), ka4 = *(const f32x4*)(kap + c), rk4 = *(const f32x4*)(rkp + c);
#pragma unroll
            for (int jj = 0; jj < 4; ++jj) { const int ch = c + jj; const float a = AV[t * 65 + ch], L = ELL[t * 65 + ch], Lp = t ? ELL[(t - 1) * 65 + ch] : 0.f, LC = LCv[ch];
                const float kk = k4[q][jj] * kk4[jj] * inv, kp = k4[q][jj] * (1.f + (a - 1.f) * ka4[jj]), bb = kk * a;
                const float eL = fexp(L), eN = fexp(-L), eP = fexp(Lp), eD = fexp(LC - L);
                rho += r4[q][jj] * kp * rk4[jj];
                const float xa = -kk * eP; vA[4 * q + jj] = xa; vR[4 * q + jj] = r4[q][jj] * eL; vB[4 * q + jj] = bb * eN; vK[4 * q + jj] = kp * eN;
                X[t * 65 + ch] = xa; BHC[ch * 72 + t] = (bf16_t)f2bf(bb * eD); KHC[ch * 72 + t] = (bf16_t)f2bf(kp * eD); VC[ch * 72 + t] = (bf16_t)f2bf(v4[q][jj]); } }
        *(LAS bf16x8*)(AT + t * 72 + c0) = pack8(vA); *(LAS bf16x8*)(RT + t * 72 + c0) = pack8(vR); *(LAS bf16x8*)(BT + t * 72 + c0) = pack8(vB); *(LAS bf16x8*)(KT + t * 72 + c0) = pack8(vK);
        rho += __shfl_xor(rho, 1); rho += __shfl_xor(rho, 2); rho += __shfl_xor(rho, 4);
        if ((tid & 7) == 0) ((float*)(C.ws + WS_RHO))[row * 8 + h] = rho; }
    LBAR();
    }
    for (int rr_ = 0; rr_ < RWR5; ++rr_) {
    for (int job = wave; job < 16; job += 8) {
        const int kind = job >> 2, ti = (job >> 1) & 1, tj = job & 1;
        const LAS bf16_t* a = (kind < 2 ? AT : RT) + 32 * ti * 72; const LAS bf16_t* bm = ((kind & 1) ? KT : BT) + 32 * tj * 72;
        f32x16 acc = {};
        if (!(ti == 0 && tj == 1)) acc = mm_ll<4>(a, 72, bm, 72, lane, acc);
#pragma unroll
        for (int g = 0; g < 16; ++g) { const int i = 32 * ti + crow(g, hi), j = 32 * tj + tl; const bool keep = (kind < 2) ? (j < i) : (j <= i); const float v = keep ? acc[g] : 0.f;
            if (kind == 0) MAB[i * 68 + j] = v; else (kind == 1 ? MAK : kind == 2 ? NRB : NRK)[i * 72 + j] = (bf16_t)f2bf(v); }
    }
    LBAR();
    }
    if (wave < 4) { const int ti = wave >> 1, tv = wave & 1; f32x16 acc = {}; acc = mm_ll<4>(MAK + 32 * ti * 72, 72, VC + 32 * tv * 72, 72, lane, acc);
#pragma unroll
        for (int g = 0; g < 16; ++g) X2[(32 * ti + crow(g, hi)) * 65 + 32 * tv + tl] = acc[g]; }
    LBAR();
    for (int bk = 0; bk < 4; ++bk) {
        const int r0 = 16 * bk;
        if (wave < 2) {
            LAS float* XX = wave ? X2 : X; float x[16];
#pragma unroll
            for (int i = 0; i < 16; ++i) x[i] = XX[(r0 + i) * 65 + lane];
#pragma unroll
            for (int i = 1; i < 16; ++i) { const LAS float* mr = MAB + (r0 + i) * 68 + r0; float a_ = x[i];
#pragma unroll
                for (int q = 0; q < (i + 3) / 4; ++q) { const f32x4 m4 = *(const LAS f32x4*)(mr + 4 * q);
#pragma unroll
                    for (int e = 0; e < 4; ++e) if (4 * q + e < i) a_ += m4[e] * x[4 * q + e]; }
                x[i] = a_; }
#pragma unroll
            for (int i = 1; i < 16; ++i) XX[(r0 + i) * 65 + lane] = x[i];
        }
        LBAR();
        if (bk < 3) {
            const int mat = wave >> 2, rt = (wave >> 1) & 1, ctl = wave & 1;
            if (32 * rt + 31 >= r0 + 16) {
                LAS float* XX = mat ? X2 : X;
                F8 av8, bv8;
#pragma unroll
                for (int e = 0; e < 8; ++e) { av8[e] = MAB[(32 * rt + tl) * 68 + r0 + 8 * hi + e]; bv8[e] = XX[(r0 + 8 * hi + e) * 65 + 32 * ctl + tl]; }
                f32x16 acc;
#pragma unroll
                for (int g = 0; g < 16; ++g) acc[g] = XX[(32 * rt + crow(g, hi)) * 65 + 32 * ctl + tl];
                acc = mfma32(pack8(av8), pack8(bv8), acc);
#pragma unroll
                for (int g = 0; g < 16; ++g) { const int i = 32 * rt + crow(g, hi); if (i >= r0 + 16) XX[i * 65 + 32 * ctl + tl] = acc[g]; }
            }
            LBAR();
        }
    }
    { const int k = tid >> 3, i0 = (tid & 7) * 8; F8 v, w;
#pragma unroll
        for (int e = 0; e < 8; ++e) { v[e] = X[(i0 + e) * 65 + k]; w[e] = X2[(i0 + e) * 65 + k]; }
        *(LAS bf16x8*)(W1C + k * 72 + i0) = pack8(v); *(LAS bf16x8*)(W2C + k * 72 + i0) = pack8(w); }
    LBAR();
    for (int rr_ = 0; rr_ < RWR11; ++rr_) {
    for (int job = wave; job < 16; job += 8) {
        const int kind = job >> 2, p = (job >> 1) & 1, q = job & 1; f32x16 acc = {};
        if (kind == 0) {
            acc = mm_ll<4>(W1C + 32 * p * 72, 72, NRB + 32 * q * 72, 72, lane, acc);
            FA fa;
#pragma unroll
            for (int g = 0; g < 16; ++g) fa[g] = acc[g] + bf2f(RT[(32 * q + tl) * 72 + 32 * p + crow(g, hi)]);
            st_frag(GT, (p * 2 + q) * 2 + 0, lane, packfrag(fa, 0)); st_frag(GT, (p * 2 + q) * 2 + 1, lane, packfrag(fa, 1));
        } else if (kind == 1) {
            acc = mm_ll<4>(W2C + 32 * p * 72, 72, NRB + 32 * q * 72, 72, lane, acc); acc = mm_ll<4>(VC + 32 * p * 72, 72, NRK + 32 * q * 72, 72, lane, acc);
            st_tile_bf16(Y0T, p * 2 + q, lane, acc);
        } else if (kind == 2) {
            acc = mm_ll<4>(W1C + 32 * p * 72, 72, BHC + 32 * q * 72, 72, lane, acc);
            FA fa = toFA(acc);
            if (p == q) { const float pc = fexp(LCv[32 * q + tl]);
#pragma unroll
                for (int g = 0; g < 16; ++g) if (crow(g, hi) == tl) fa[g] += pc; }
            st_frag(PHI, (p * 2 + q) * 2 + 0, lane, packfrag(fa, 0)); st_frag(PHI, (p * 2 + q) * 2 + 1, lane, packfrag(fa, 1));
        } else {
            acc = mm_ll<4>(BHC + 32 * p * 72, 72, W2C + 32 * q * 72, 72, lane, acc); acc = mm_ll<4>(KHC + 32 * p * 72, 72, VC + 32 * q * 72, 72, lane, acc);
            st_tile_bf16(PSI, p * 2 + q, lane, acc);
        }
    }
    LBAR();
    }
}

#undef LBAR
DI void rwkv_scan_wave(Ctx& C, int id) {
    const int vt = id & 1, bh = id >> 1, lane = C.lane;
    f32x16 S[2] = {{}, {}};
    for (int chunk = 0; chunk < 64; ++chunk) {
        const size_t chid = ((size_t)bh * 64 + chunk) * 8192;
        const unsigned char* PHI = C.ws + WS_PHI + chid; const unsigned char* PSI = C.ws + WS_PSI + chid; unsigned char* S0B = C.ws + WS_S0 + chid;
        bf16x8 sh[2][2], sl[2][2];
        f32x16 N[2];
#pragma unroll
        for (int ct = 0; ct < 2; ++ct) N[ct] = toV(ld_tile_bf16(PSI, ct * 2 + vt, lane));
        asm volatile("" ::: "memory");
#pragma unroll
        for (int cp = 0; cp < 2; ++cp)
#pragma unroll
            for (int s = 0; s < 2; ++s) { sh[cp][s] = packfrag(S[cp], s); st_frag(S0B, (cp * 2 + vt) * 2 + s, lane, sh[cp][s]);
                const u32x4 hw = __builtin_bit_cast(u32x4, sh[cp][s]); u32x4 lw;
#pragma unroll
                for (int q = 0; q < 4; ++q) lw[q] = pk2(S[cp][8 * s + 2 * q] - bflo(hw[q]), S[cp][8 * s + 2 * q + 1] - bfhi(hw[q]));
                sl[cp][s] = __builtin_bit_cast(bf16x8, lw); }
#pragma unroll
        for (int ct = 0; ct < 2; ++ct) {
#pragma unroll
            for (int cp = 0; cp < 2; ++cp)
#pragma unroll
                for (int s = 0; s < 2; ++s) { const bf16x8 ph = ld_frag(PHI, (cp * 2 + ct) * 2 + s, lane); N[ct] = mfma32(ph, sh[cp][s], N[ct]); N[ct] = mfma32(ph, sl[cp][s], N[ct]); } }
        S[0] = N[0]; S[1] = N[1];
    }
}

DI void rwkv_out_wave(Ctx& C, int id, int l) {
    const int chunk = id & 63, bh = id >> 6, b = bh >> 3, h = bh & 7, lane = C.lane, tl = lane & 31, hi = lane >> 5;
    const size_t chid = (size_t)id * 8192; const size_t tok0 = (size_t)b * SEQ + chunk * 64;
    const unsigned char* GT = C.ws + WS_GT + chid; const unsigned char* Y0T = C.ws + WS_Y0T + chid; const unsigned char* GGT = C.ws + WS_GGT + chid; const unsigned char* S0B = C.ws + WS_S0 + chid;
    const bf16_t* proj = (const bf16_t*)(C.ws + WS_PROJ);
    const float* mu = C.in(6) + (size_t)l * 1792; const float* gng = C.in(15) + l * 512 + 64 * h; const float* gnb = C.in(16) + l * 512 + 64 * h;
    const float* RHO = (const float*)(C.ws + WS_RHO);
    FA Y[2][2];
#pragma unroll
    for (int vt = 0; vt < 2; ++vt)
#pragma unroll
        for (int tt = 0; tt < 2; ++tt) { f32x16 acc = toV(ld_tile_bf16(Y0T, vt * 2 + tt, lane));
#pragma unroll
            for (int cp = 0; cp < 2; ++cp)
#pragma unroll
                for (int s = 0; s < 2; ++s) acc = mfma32(ld_frag(S0B, (cp * 2 + vt) * 2 + s, lane), ld_frag(GT, (cp * 2 + tt) * 2 + s, lane), acc);
            Y[vt][tt] = toFA(acc); }
#pragma unroll
    for (int tt = 0; tt < 2; ++tt) {
        float s1 = 0.f;
#pragma unroll
        for (int vt = 0; vt < 2; ++vt)
#pragma unroll
            for (int g = 0; g < 16; ++g) s1 += Y[vt][tt][g];
        s1 += __shfl_xor(s1, 32); const float mean = s1 * (1.f / 64.f);
        float s2 = 0.f;
#pragma unroll
        for (int vt = 0; vt < 2; ++vt)
#pragma unroll
            for (int g = 0; g < 16; ++g) { const float d = Y[vt][tt][g] - mean; s2 += d * d; }
        s2 += __shfl_xor(s2, 32); const float rstd = 1.f / sqrtf(s2 * (1.f / 64.f) + GN_EPS);
        const size_t row = tok0 + 32 * tt + tl; const bool first = (chunk == 0 && tt == 0 && tl == 0);
        const float rho = RHO[row * 8 + h];
#pragma unroll
        for (int vt = 0; vt < 2; ++vt) { const FA gt = ld_tile_bf16(GGT, vt * 2 + tt, lane);
#pragma unroll
            for (int i = 0; i < 4; ++i) { const int c = 32 * vt + 8 * i + 4 * hi;
                const f32x4 v4 = shift4(proj, row, first, PC_BV + 64 * h + c, mu + 1024 + 64 * h + c); const f32x4 gg = *(const f32x4*)(gng + c), gb = *(const f32x4*)(gnb + c);
                float o[4];
#pragma unroll
                for (int jj = 0; jj < 4; ++jj) { const int g = 4 * i + jj; o[jj] = ((Y[vt][tt][g] - mean) * rstd * gg[jj] + gb[jj] + rho * v4[jj]) * gt[g]; }
                u32x2 w; w.x = pk2(o[0], o[1]); w.y = pk2(o[2], o[3]); *(u32x2*)(C.mixcat + row * D + 512 + 64 * h + c) = w; } }
    }
}

constexpr int GB_OFF = 163840 - 256;
DI void gbar(LAS unsigned* cnt, unsigned& target, int lane) {
    asm volatile("s_waitcnt lgkmcnt(0)" ::: "memory");
    target += 4u;
    if (lane == 0) __hip_atomic_fetch_add(cnt, 1u, __ATOMIC_RELAXED, __HIP_MEMORY_SCOPE_WORKGROUP);
    while (__hip_atomic_load(cnt, __ATOMIC_RELAXED, __HIP_MEMORY_SCOPE_WORKGROUP) < target) __builtin_amdgcn_s_sleep(1);
    asm volatile("" ::: "memory");
}
DI void rwkv_chunk_acts4(Ctx& C, int bc, int l, bf16x8 (&actv)[8]) {
    const int chunk = bc & 63, b = bc >> 6, t = C.tid >> 2, cg = C.tid & 3; const size_t row = (size_t)b * SEQ + chunk * 64 + t; const bool first = (chunk == 0 && t == 0);
    const bf16_t* proj = (const bf16_t*)(C.ws + WS_PROJ); const float* mu = C.in(6) + (size_t)l * 1792;
#pragma unroll
    for (int q = 0; q < 8; ++q) { const int c8 = cg * 64 + 8 * q;
        if (c8 < 64) actv[q] = act_frag<1>(proj, row, first, PC_WD + c8, mu + 1536 + c8); else if (c8 < 128) actv[q] = act_frag<0>(proj, row, first, PC_WD + c8, mu + 1536 + c8); else actv[q] = act_frag<2>(proj, row, first, PC_WD + c8, mu + 1536 + c8); }
}
#ifndef RW4_12
#define RW4_12 1
#endif
#ifndef RW4_4
#define RW4_4 1
#endif
#ifndef RW4_5
#define RW4_5 1
#endif
#ifndef RW4_11
#define RW4_11 1
#endif
#define GBA() gbar(gcnt, gtarget, lane)
DI void rwkv_head_item4(Ctx& C, int item, int l, const bf16x8 (&actv)[8], LAS unsigned* gcnt, unsigned& gtarget) {
    const int h = item & 7, chunk = (item >> 3) & 63, b = item >> 9, tid = C.tid, lane = C.lane, wave = C.wave, tl = lane & 31, hi = lane >> 5;
    const size_t tok0 = (size_t)b * SEQ + chunk * 64;
    const bf16_t* proj = (const bf16_t*)(C.ws + WS_PROJ);
    const size_t chid = ((size_t)(b * 8 + h) * 64 + chunk) * 8192;
    unsigned char* PHI = C.ws + WS_PHI + chid; unsigned char* PSI = C.ws + WS_PSI + chid; unsigned char* GT = C.ws + WS_GT + chid; unsigned char* Y0T = C.ws + WS_Y0T + chid; unsigned char* GGT = C.ws + WS_GGT + chid;
    const bf16_t* WDT = (const bf16_t*)(C.ws + WS_LORA); const bf16_t* WAT = WDT + 512 * 64; const bf16_t* WGT = WAT + 512 * 64;
    const float* mu = C.in(6) + (size_t)l * 1792;
    const float* w0p = C.in(7) + l * 512 + 64 * h; const float* a0p = C.in(9) + l * 512 + 64 * h;
    const float* kkp = C.in(12) + l * 512 + 64 * h; const float* kap = C.in(13) + l * 512 + 64 * h; const float* rkp = C.in(14) + l * 512 + 64 * h;
    LAS bf16_t* ACT = (LAS bf16_t*)(C.lds + RL_ACT); LAS float* MAB = (LAS float*)(C.lds + RL_MAB); LAS bf16_t* W1C = (LAS bf16_t*)(C.lds + RL_W1C); LAS bf16_t* W2C = (LAS bf16_t*)(C.lds + RL_W2C);
    LAS float* ELL = (LAS float*)(C.lds + RL_ELL); LAS float* AV = (LAS float*)(C.lds + RL_AV);
    LAS bf16_t* MAK = (LAS bf16_t*)(C.lds + RL_MAK); LAS bf16_t* NRB = (LAS bf16_t*)(C.lds + RL_NRB); LAS bf16_t* NRK = (LAS bf16_t*)(C.lds + RL_NRK);
    LAS bf16_t* AT = (LAS bf16_t*)(C.lds + RL_AT); LAS bf16_t* RT = (LAS bf16_t*)(C.lds + RL_RT); LAS bf16_t* BT = (LAS bf16_t*)(C.lds + RL_BT); LAS bf16_t* KT = (LAS bf16_t*)(C.lds + RL_KT);
    LAS bf16_t* BHC = (LAS bf16_t*)(C.lds + RL_BHC); LAS bf16_t* KHC = (LAS bf16_t*)(C.lds + RL_KHC); LAS bf16_t* VC = (LAS bf16_t*)(C.lds + RL_VC);
    LAS float* X = (LAS float*)(C.lds + RL_X); LAS float* X2 = (LAS float*)(C.lds + RL_X2); LAS float* LCv = (LAS float*)(C.lds + RL_SM) + 64;
    GBA();
    for (int r_RW4_12 = 0; r_RW4_12 < RW4_12; ++r_RW4_12) { asm volatile("" ::: "memory");
    const int jp = (wave >> 1) & 1, jq = wave & 1;
    bf16x8 wg[8], wd[8];
    { const bf16_t* W = WGT + (size_t)(64 * h + 32 * jp + tl) * 128 + 8 * hi; const bf16_t* W0 = WDT + (size_t)(64 * h + 32 * jq + tl) * 64 + 8 * hi; const bf16_t* W1 = WAT + (size_t)(64 * h + 32 * jq + tl) * 64 + 8 * hi;
#pragma unroll
        for (int s = 0; s < 8; ++s) wg[s] = *(const bf16x8*)(W + 16 * s);
#pragma unroll
        for (int s = 0; s < 4; ++s) { wd[s] = *(const bf16x8*)(W0 + 16 * s); wd[4 + s] = *(const bf16x8*)(W1 + 16 * s); } }
    { const int t = tid >> 2, cg = tid & 3;
#pragma unroll
        for (int q = 0; q < 8; ++q) *(LAS bf16x8*)(ACT + t * 264 + cg * 64 + 8 * q) = actv[q]; }
    GBA();
    {
        const LAS bf16_t* bp = ACT + (32 * jq + tl) * 264 + 128 + 8 * hi; f32x16 acc = {};
#pragma unroll
        for (int s = 0; s < 8; ++s) acc = mfma32(wg[s], *(const LAS bf16x8*)(bp + 16 * s), acc);
        st_tile_bf16(GGT, jp * 2 + jq, lane, acc);
        const LAS bf16_t* ap = ACT + (32 * jp + tl) * 264 + 8 * hi; f32x16 a0 = {}, a1 = {};
#pragma unroll
        for (int s = 0; s < 4; ++s) { a0 = mfma32(*(const LAS bf16x8*)(ap + 16 * s), wd[s], a0); a1 = mfma32(*(const LAS bf16x8*)(ap + 64 + 16 * s), wd[4 + s], a1); }
        const int ch = 32 * jq + tl; const float w0c = w0p[ch], a0c = a0p[ch];
#pragma unroll
        for (int g = 0; g < 16; ++g) { const int t = 32 * jp + crow(g, hi); ELL[t * 65 + ch] = -fexp(-fsoftplus(-(w0c + a0[g])) - 0.5f); AV[t * 65 + ch] = fsigm(a0c + a1[g]); }
    }
    GBA();
    }
    { const int ch = tid & 63, seg = tid >> 6; float p[16]; float run = 0.f;
#pragma unroll
        for (int e = 0; e < 16; ++e) { run += ELL[(16 * seg + e) * 65 + ch]; p[e] = run; }
        X[seg * 65 + ch] = run;
        GBA();
        float off = 0.f;
#pragma unroll
        for (int s2 = 0; s2 < 3; ++s2) off += (s2 < seg) ? X[s2 * 65 + ch] : 0.f;
#pragma unroll
        for (int e = 0; e < 16; ++e) ELL[(16 * seg + e) * 65 + ch] = off + p[e];
        if (seg == 3) LCv[ch] = off + p[15]; }
    GBA();
    for (int r_RW4_4 = 0; r_RW4_4 < RW4_4; ++r_RW4_4) { asm volatile("" ::: "memory");
#pragma unroll 1
    for (int pass = 0; pass < 2; ++pass) { const int e_ = tid + 256 * pass; const int t = e_ >> 3, c0 = (e_ & 7) * 8; const size_t row = tok0 + t; const bool first = (chunk == 0 && t == 0); float rho = 0.f, n2 = 0.f;
        f32x4 r4[2], k4[2], v4[2];
#pragma unroll
        for (int q = 0; q < 2; ++q) { const int c = c0 + 4 * q;
            r4[q] = shift4(proj, row, first, PC_R + 64 * h + c, mu + 64 * h + c); k4[q] = shift4(proj, row, first, PC_BK + 64 * h + c, mu + 512 + 64 * h + c); v4[q] = shift4(proj, row, first, PC_BV + 64 * h + c, mu + 1024 + 64 * h + c);
            const f32x4 kr = k4[q] * *(const f32x4*)(kkp + c); n2 += (kr.x * kr.x + kr.y * kr.y) + (kr.z * kr.z + kr.w * kr.w); }
        n2 += __shfl_xor(n2, 1); n2 += __shfl_xor(n2, 2); n2 += __shfl_xor(n2, 4);
        const float inv = 1.f / fmaxf(sqrtf(n2), 1e-12f);
        F8 vA, vR, vB, vK;
#pragma unroll
        for (int q = 0; q < 2; ++q) { const int c = c0 + 4 * q;
            const f32x4 kk4 = *(const f32x4*)(kkp + c), ka4 = *(const f32x4*)(kap + c), rk4 = *(const f32x4*)(rkp + c);
#pragma unroll
            for (int jj = 0; jj < 4; ++jj) { const int ch = c + jj; const float a = AV[t * 65 + ch], L = ELL[t * 65 + ch], Lp = t ? ELL[(t - 1) * 65 + ch] : 0.f, LC = LCv[ch];
                const float kk = k4[q][jj] * kk4[jj] * inv, kp = k4[q][jj] * (1.f + (a - 1.f) * ka4[jj]), bb = kk * a;
                const float eL = fexp(L), eN = fexp(-L), eP = fexp(Lp), eD = fexp(LC - L);
                rho += r4[q][jj] * kp * rk4[jj];
                const float xa = -kk * eP; vA[4 * q + jj] = xa; vR[4 * q + jj] = r4[q][jj] * eL; vB[4 * q + jj] = bb * eN; vK[4 * q + jj] = kp * eN;
                X[t * 65 + ch] = xa; BHC[ch * 72 + t] = (bf16_t)f2bf(bb * eD); KHC[ch * 72 + t] = (bf16_t)f2bf(kp * eD); VC[ch * 72 + t] = (bf16_t)f2bf(v4[q][jj]); } }
        *(LAS bf16x8*)(AT + t * 72 + c0) = pack8(vA); *(LAS bf16x8*)(RT + t * 72 + c0) = pack8(vR); *(LAS bf16x8*)(BT + t * 72 + c0) = pack8(vB); *(LAS bf16x8*)(KT + t * 72 + c0) = pack8(vK);
        rho += __shfl_xor(rho, 1); rho += __shfl_xor(rho, 2); rho += __shfl_xor(rho, 4);
        if ((tid & 7) == 0) ((float*)(C.ws + WS_RHO))[row * 8 + h] = rho; }
    GBA();
    }
    for (int r_RW4_5 = 0; r_RW4_5 < RW4_5; ++r_RW4_5) { asm volatile("" ::: "memory");
    for (int job = wave; job < 16; job += 4) {
        const int kind = job >> 2, ti = (job >> 1) & 1, tj = job & 1;
        const LAS bf16_t* a = (kind < 2 ? AT : RT) + 32 * ti * 72; const LAS bf16_t* bm = ((kind & 1) ? KT : BT) + 32 * tj * 72;
        f32x16 acc = {};
        if (!(ti == 0 && tj == 1)) acc = mm_ll<4>(a, 72, bm, 72, lane, acc);
#pragma unroll
        for (int g = 0; g < 16; ++g) { const int i = 32 * ti + crow(g, hi), j = 32 * tj + tl; const bool keep = (kind < 2) ? (j < i) : (j <= i); const float v = keep ? acc[g] : 0.f;
            if (kind == 0) MAB[i * 68 + j] = v; else (kind == 1 ? MAK : kind == 2 ? NRB : NRK)[i * 72 + j] = (bf16_t)f2bf(v); }
    }
    GBA();
    }
    { const int ti = wave >> 1, tv = wave & 1; f32x16 acc = {}; acc = mm_ll<4>(MAK + 32 * ti * 72, 72, VC + 32 * tv * 72, 72, lane, acc);
#pragma unroll
        for (int g = 0; g < 16; ++g) X2[(32 * ti + crow(g, hi)) * 65 + 32 * tv + tl] = acc[g]; }
    GBA();
    for (int bk = 0; bk < 4; ++bk) {
        const int r0 = 16 * bk;
        if (wave < 2) {
            LAS float* XX = wave ? X2 : X; float x[16];
#pragma unroll
            for (int i = 0; i < 16; ++i) x[i] = XX[(r0 + i) * 65 + lane];
#pragma unroll
            for (int i = 1; i < 16; ++i) { const LAS float* mr = MAB + (r0 + i) * 68 + r0; float a_ = x[i];
#pragma unroll
                for (int q = 0; q < (i + 3) / 4; ++q) { const f32x4 m4 = *(const LAS f32x4*)(mr + 4 * q);
#pragma unroll
                    for (int e = 0; e < 4; ++e) if (4 * q + e < i) a_ += m4[e] * x[4 * q + e]; }
                x[i] = a_; }
#pragma unroll
            for (int i = 1; i < 16; ++i) XX[(r0 + i) * 65 + lane] = x[i];
        }
        GBA();
        if (bk < 3) {
            for (int tq = wave; tq < 8; tq += 4) { const int mat = tq >> 2, rt = (tq >> 1) & 1, ctl = tq & 1;
                if (32 * rt + 31 >= r0 + 16) {
                    LAS float* XX = mat ? X2 : X;
                    F8 av8, bv8;
#pragma unroll
                    for (int e = 0; e < 8; ++e) { av8[e] = MAB[(32 * rt + tl) * 68 + r0 + 8 * hi + e]; bv8[e] = XX[(r0 + 8 * hi + e) * 65 + 32 * ctl + tl]; }
                    f32x16 acc;
#pragma unroll
                    for (int g = 0; g < 16; ++g) acc[g] = XX[(32 * rt + crow(g, hi)) * 65 + 32 * ctl + tl];
                    acc = mfma32(pack8(av8), pack8(bv8), acc);
#pragma unroll
                    for (int g = 0; g < 16; ++g) { const int i = 32 * rt + crow(g, hi); if (i >= r0 + 16) XX[i * 65 + 32 * ctl + tl] = acc[g]; }
                } }
            GBA();
        }
    }
#pragma unroll 1
    for (int pass = 0; pass < 2; ++pass) { const int e_ = tid + 256 * pass; const int k = e_ >> 3, i0 = (e_ & 7) * 8; F8 v, w;
#pragma unroll
        for (int e = 0; e < 8; ++e) { v[e] = X[(i0 + e) * 65 + k]; w[e] = X2[(i0 + e) * 65 + k]; }
        *(LAS bf16x8*)(W1C + k * 72 + i0) = pack8(v); *(LAS bf16x8*)(W2C + k * 72 + i0) = pack8(w); }
    GBA();
    for (int r_11 = 0; r_11 < RW4_11; ++r_11) { asm volatile("" ::: "memory");
    for (int job = wave; job < 16; job += 4) {
        const int kind = job >> 2, p = (job >> 1) & 1, q = job & 1; f32x16 acc = {};
        if (kind == 0) {
            acc = mm_ll<4>(W1C + 32 * p * 72, 72, NRB + 32 * q * 72, 72, lane, acc);
            FA fa;
#pragma unroll
            for (int g = 0; g < 16; ++g) fa[g] = acc[g] + bf2f(RT[(32 * q + tl) * 72 + 32 * p + crow(g, hi)]);
            st_frag(GT, (p * 2 + q) * 2 + 0, lane, packfrag(fa, 0)); st_frag(GT, (p * 2 + q) * 2 + 1, lane, packfrag(fa, 1));
        } else if (kind == 1) {
            acc = mm_ll<4>(W2C + 32 * p * 72, 72, NRB + 32 * q * 72, 72, lane, acc); acc = mm_ll<4>(VC + 32 * p * 72, 72, NRK + 32 * q * 72, 72, lane, acc);
            st_tile_bf16(Y0T, p * 2 + q, lane, acc);
        } else if (kind == 2) {
            acc = mm_ll<4>(W1C + 32 * p * 72, 72, BHC + 32 * q * 72, 72, lane, acc);
            FA fa = toFA(acc);
            if (p == q) { const float pc = fexp(LCv[32 * q + tl]);
#pragma unroll
                for (int g = 0; g < 16; ++g) if (crow(g, hi) == tl) fa[g] += pc; }
            st_frag(PHI, (p * 2 + q) * 2 + 0, lane, packfrag(fa, 0)); st_frag(PHI, (p * 2 + q) * 2 + 1, lane, packfrag(fa, 1));
        } else {
            acc = mm_ll<4>(BHC + 32 * p * 72, 72, W2C + 32 * q * 72, 72, lane, acc); acc = mm_ll<4>(KHC + 32 * p * 72, 72, VC + 32 * q * 72, 72, lane, acc);
            st_tile_bf16(PSI, p * 2 + q, lane, acc);
        }
    }
    }
}
#undef GBA

typedef float f32x2 __attribute__((ext_vector_type(2)));
constexpr int IX4 = RL_END, IX4_CAP = 256;
#ifndef IX_PF
#define IX_PF 2
#endif
#ifndef IXR_SEL
#define IXR_SEL 1
#endif
#define GBB() gbar(gcnt, gtarget, lane)
DI void ld_ktile(const _Float16* kbase, int kt, int ktmax, f16x8 (&d)[4]) {
    const _Float16* p = kbase + (size_t)(32 * min(kt, ktmax)) * PLD;
#pragma unroll
    for (int s = 0; s < 4; ++s) d[s] = *(const f16x8*)(p + 16 * s);
}
DI void idx_item4(Ctx& C, int item, int l, const int ixb, LAS unsigned* gcnt, unsigned& gtarget) {
    const int b = item & 3, qt = 1023 - (item >> 2);
    const int t0 = qt * 4, chunk = t0 >> 6, NT32 = 2 * (chunk + 1);
    const size_t tok0 = (size_t)b * SEQ + t0;
    unsigned* bm = (unsigned*)(C.ws + WS_BM);
    int lane = C.lane, wave = C.wave & 3, tid = C.tid & 255;
    asm volatile("" : "+v"(lane), "+v"(tid), "+s"(wave));
    if (chunk < 4) {
        if (tid < 4 * NT32) { const int q = tid / NT32, kt = tid % NT32; bm[(tok0 + q) * 128 + kt] = 0xffffffffu; }
        return;
    }
    const _Float16* ph = (const _Float16*)(C.ws + WS_PROJ);
    LAS unsigned* hist = (LAS unsigned*)(C.lds + ixb);
    LAS float* cand = (LAS float*)(C.lds + ixb + 4096);
    LAS float* redmn = (LAS float*)(C.lds + ixb + 4096 + 8 * IX4_CAP * 4);
    LAS float* redmx = redmn + 16;
    LAS unsigned* ccount = (LAS unsigned*)(redmx + 16);
    LAS float* thrS = (LAS float*)(ccount + 4);
    LAS int* thrI = (LAS int*)(thrS + 4);
    LAS unsigned* ovf = (LAS unsigned*)(thrI + 4);
    LAS unsigned* fbT = ovf + 4;
    LAS unsigned* fbCnt = fbT + 4;
    LAS unsigned* fbNeed = fbCnt + 4;
    const int r = lane & 31, hh = lane >> 5;
    float sc[32][2];
    {
        f16x8 afr[4]; float wq[2][8];
        {
            const int gq = (r >> 2) & 1, i = r >> 3, jj = r & 3, query = 2 * gq + (i >> 1), head = 4 * (i & 1) + jj;
            const _Float16* qp = ph + (tok0 + query) * PLD + PC_QI + head * 64 + 8 * hh;
#pragma unroll
            for (int s = 0; s < 4; ++s) afr[s] = *(const f16x8*)(qp + 16 * s);
#pragma unroll
            for (int qq = 0; qq < 2; ++qq) { const int q2 = 2 * hh + qq; const f16x8 wv = *(const f16x8*)(ph + (tok0 + q2) * PLD + PC_WI);
#pragma unroll
                for (int e = 0; e < 8; ++e) wq[qq][e] = (float)wv[e] * 0.044194173824159216f; }
        }
        const _Float16* kbase = ph + ((size_t)b * SEQ + r) * PLD + PC_KI + 8 * hh;
        f16x8 bq[IX_PF][4];
#pragma unroll
        for (int d = 0; d < IX_PF - 1; ++d) ld_ktile(kbase, wave + 4 * d, NT32 - 1, bq[d]);
#pragma unroll
        for (int it = 0; it < 32; ++it) {
            const int kt = wave + 4 * it;
            if (kt < NT32) {
                if (kt + 4 * (IX_PF - 1) < NT32) ld_ktile(kbase, kt + 4 * (IX_PF - 1), NT32 - 1, bq[(it + IX_PF - 1) % IX_PF]);
                f32x16 c = {};
#pragma unroll
                for (int s = 0; s < 4; ++s) c = __builtin_amdgcn_mfma_f32_32x32x16_f16(afr[s], bq[it % IX_PF][s], c, 0, 0, 0);
#pragma unroll
                for (int qq = 0; qq < 2; ++qq) { float a = 0.f;
#pragma unroll
                    for (int e = 0; e < 8; ++e) a += wq[qq][e] * fmaxf(c[8 * qq + e], 0.f);
                    sc[it][qq] = a; }
            } else { sc[it][0] = -3.0e38f; sc[it][1] = -3.0e38f; }
        }
    }
    for (int rl_ = 0; rl_ < IXR_SEL; ++rl_) { asm volatile("" ::: "memory");
    float mn[2], mx[2];
#pragma unroll
    for (int qq = 0; qq < 2; ++qq) { float me = -3.0e38f, mo = -3.0e38f;
#pragma unroll
        for (int it = 0; it < 32; it += 2) { me = fmaxf(me, sc[it][qq]); mo = fmaxf(mo, sc[it + 1][qq]); }
        float a = fminf(me, mo), z = fmaxf(me, mo);
#pragma unroll
        for (int o = 1; o < 32; o <<= 1) { a = fminf(a, __shfl_xor(a, o)); z = fmaxf(z, __shfl_xor(z, o)); }
        mn[qq] = a; mx[qq] = z; }
    if (r == 0) {
#pragma unroll
        for (int qq = 0; qq < 2; ++qq) { const int qid = 2 * hh + qq; redmn[wave * 4 + qid] = mn[qq]; redmx[wave * 4 + qid] = mx[qq]; }
    }
    { u32x4 z4 = {0u, 0u, 0u, 0u}; *(LAS u32x4*)(hist + 4 * tid) = z4; }
    if (tid < 4) { ccount[tid] = 0u; ovf[tid] = 0u; }
    GBB();
    unsigned pk[2][8];
#pragma unroll
    for (int qq = 0; qq < 2; ++qq) { const int qid = 2 * hh + qq; float a = 3.0e38f, z = -3.0e38f;
#pragma unroll
        for (int w = 0; w < 4; ++w) { a = fminf(a, redmn[w * 4 + qid]); z = fmaxf(z, redmx[w * 4 + qid]); }
        const float scl = (z > a) ? fminf(253.f / (z - a), 1.0e30f) : 1.f; const float nlo = 1.5f - a * scl;
#pragma unroll
        for (int g8 = 0; g8 < 8; ++g8) { unsigned p = 0u;
            if (wave + 16 * g8 < NT32) {
#pragma unroll
                for (int e = 0; e < 4; ++e) p = __builtin_amdgcn_cvt_pk_u8_f32(__builtin_amdgcn_fmed3f(__builtin_fmaf(sc[4 * g8 + e][qq], scl, nlo), 0.f, 255.f), e, p);
#pragma unroll
                for (int e = 0; e < 4; ++e) { const unsigned pb = (p >> (8 * e)) & 255u; if (pb) __hip_atomic_fetch_add(hist + qid * 256 + pb, 1u, __ATOMIC_RELAXED, __HIP_MEMORY_SCOPE_WORKGROUP); }
            }
            pk[qq][g8] = p; } }
    GBB();
    int B[2]; unsigned above[2];
#pragma unroll
    for (int qq = 0; qq < 2; ++qq) { const int qid = 2 * hh + qq;
        const u32x4 h0 = *(const LAS u32x4*)(hist + qid * 256 + 8 * r), h1 = *(const LAS u32x4*)(hist + qid * 256 + 8 * r + 4);
        const unsigned tot = (h0.x + h0.y) + (h0.z + h0.w) + (h1.x + h1.y) + (h1.z + h1.w); unsigned incl = tot;
#pragma unroll
        for (int o = 1; o < 32; o <<= 1) { const unsigned v = __shfl_down(incl, o, 32); if (r + o < 32) incl += v; }
        unsigned run = incl - tot; int Bf = -1; unsigned ab = 0; const unsigned hv8[8] = {h0.x, h0.y, h0.z, h0.w, h1.x, h1.y, h1.z, h1.w};
#pragma unroll
        for (int j = 7; j >= 0; --j) { const unsigned hv = hv8[j]; if (run < 256u && run + hv >= 256u) { Bf = 8 * r + j; ab = run; } run += hv; }
        const unsigned long long mk = __ballot(Bf >= 0);
        const unsigned mh = hh ? (unsigned)(mk >> 32) : (unsigned)mk;
        const int src = 32 * hh + (mh ? __builtin_ctz(mh) : 0);
        B[qq] = __shfl(Bf, src); above[qq] = (unsigned)__shfl((int)ab, src); }
#define IX_PB(it, qq) ((int)((pk[qq][(it) >> 2] >> (8 * ((it) & 3))) & 255u))
#define IX_LAUNDER() do { _Pragma("unroll") for (int it_ = 0; it_ < 32; ++it_) { asm volatile("" : "+v"(sc[it_][0]), "+v"(sc[it_][1])); } asm volatile("" : "+v"(B[0]), "+v"(B[1])); } while (0)
#pragma unroll
    for (int qq = 0; qq < 2; ++qq) { const int qid = 2 * hh + qq;
#pragma unroll
        for (int g8 = 0; g8 < 8; ++g8) if (wave + 16 * g8 < NT32) {
#pragma unroll
            for (int e = 0; e < 4; ++e) { const int it = 4 * g8 + e; const bool hit = (IX_PB(it, qq) == B[qq]);
                if (__any(hit)) { if (hit) { const unsigned pos = __hip_atomic_fetch_add(ccount + qid, 1u, __ATOMIC_RELAXED, __HIP_MEMORY_SCOPE_WORKGROUP);
                    if (pos < (unsigned)IX4_CAP) { f32x2 cv; cv.x = sc[it][qq]; cv.y = __builtin_bit_cast(float, 32 * (wave + 4 * it) + r); *(LAS f32x2*)(cand + (qid * IX4_CAP + pos) * 2) = cv; } } } } } }
    GBB();
    {
        const int c = (int)ccount[wave];
        const unsigned abq = (wave & 1) ? above[1] : above[0];
        const int need = 256 - (int)__shfl((int)abq, 32 * (wave >> 1));
        if (c <= IX4_CAP) {
            LAS float* cw = cand + wave * IX4_CAP * 2;
            if ((c & 1) && lane == 0) { f32x2 cv; cv.x = -3.0e38f; cv.y = __builtin_bit_cast(float, 0x7fffffff); *(LAS f32x2*)(cw + 2 * c) = cv; }
            asm volatile("" ::: "memory");
            for (int i = lane; i < c; i += 64) { const f32x2 ci = *(const LAS f32x2*)(cw + 2 * i); const float si = ci.x; const int ii = __float_as_int(ci.y); int rank = 0;
                for (int j = 0; j < c; j += 2) { const f32x4 cj = *(const LAS f32x4*)(cw + 2 * j);
                    rank += ((cj.x > si) || (cj.x == si && __float_as_int(cj.y) < ii)) ? 1 : 0; rank += ((cj.z > si) || (cj.z == si && __float_as_int(cj.w) < ii)) ? 1 : 0; }
                if (rank == need - 1) { thrS[wave] = si; thrI[wave] = ii; } }
        } else if (lane == 0) { ovf[wave] = 1u; fbNeed[wave] = (unsigned)need; fbT[wave] = 0u; }
    }
    GBB();
    unsigned anyovf = 0u;
#pragma unroll
    for (int q = 0; q < 4; ++q) anyovf |= ovf[q];
#ifndef IX_NOFB
#define IX_NOFB 0
#endif
    if (anyovf && !IX_NOFB) {
        for (int bit = 31; bit >= 0; --bit) {
            if (tid < 4) fbCnt[tid] = 0u;
            GBB();
            IX_LAUNDER();
#pragma unroll
            for (int qq = 0; qq < 2; ++qq) { const int qid = 2 * hh + qq; if (ovf[qid]) { const unsigned cd = fbT[qid] | (1u << bit); unsigned cnt = 0;
#pragma unroll
                for (int it = 0; it < 32; ++it) cnt += (IX_PB(it, qq) == B[qq] && ordkey(sc[it][qq]) >= cd) ? 1u : 0u;
                if (cnt) __hip_atomic_fetch_add(fbCnt + qid, cnt, __ATOMIC_RELAXED, __HIP_MEMORY_SCOPE_WORKGROUP); } }
            GBB();
            if (tid < 4 && ovf[tid] && fbCnt[tid] >= fbNeed[tid]) fbT[tid] |= (1u << bit);
            GBB();
        }
        if (tid < 4) fbCnt[tid] = 0u;
        GBB();
        IX_LAUNDER();
#pragma unroll
        for (int qq = 0; qq < 2; ++qq) { const int qid = 2 * hh + qq; if (ovf[qid]) { const unsigned Tk = fbT[qid]; unsigned cnt = 0;
#pragma unroll
            for (int it = 0; it < 32; ++it) cnt += (IX_PB(it, qq) == B[qq] && ordkey(sc[it][qq]) > Tk) ? 1u : 0u;
            if (cnt) __hip_atomic_fetch_add(fbCnt + qid, cnt, __ATOMIC_RELAXED, __HIP_MEMORY_SCOPE_WORKGROUP); } }
        GBB();
        if (tid < 4 && ovf[tid]) { fbNeed[tid] -= fbCnt[tid]; thrS[tid] = unordkey(fbT[tid]); thrI[tid] = 0; }
        GBB();
        for (int bit = 11; bit >= 0; --bit) {
            if (tid < 4) fbCnt[tid] = 0u;
            GBB();
            IX_LAUNDER();
#pragma unroll
            for (int qq = 0; qq < 2; ++qq) { const int qid = 2 * hh + qq; if (ovf[qid]) { const unsigned Tk = fbT[qid]; const int cd = thrI[qid] | (1 << bit); unsigned cnt = 0;
#pragma unroll
                for (int it = 0; it < 32; ++it) cnt += (IX_PB(it, qq) == B[qq] && ordkey(sc[it][qq]) == Tk && (32 * (wave + 4 * it) + r) < cd) ? 1u : 0u;
                if (cnt) __hip_atomic_fetch_add(fbCnt + qid, cnt, __ATOMIC_RELAXED, __HIP_MEMORY_SCOPE_WORKGROUP); } }
            GBB();
            if (tid < 4 && ovf[tid] && fbCnt[tid] < fbNeed[tid]) thrI[tid] |= (1 << bit);
            GBB();
        }
    }
#pragma unroll
    for (int qq = 0; qq < 2; ++qq) { const int qid = 2 * hh + qq; const float ts = thrS[qid]; const int ti = thrI[qid] - 32 * wave - r;
        unsigned myw = 0u;
#pragma unroll
        for (int g8 = 0; g8 < 8; ++g8) if (wave + 16 * g8 < NT32) {
#pragma unroll
            for (int e = 0; e < 4; ++e) { const int it = 4 * g8 + e; const float s = sc[it][qq];
                const bool sel = (s > ts) | ((s == ts) & (128 * it <= ti));
                const unsigned long long mk = __builtin_amdgcn_ballot_w64(sel);
                const unsigned wv = hh ? (unsigned)(mk >> 32) : (unsigned)mk;
                if (r == it) myw = wv; } }
        if (wave + 4 * r < NT32) bm[(tok0 + qid) * 128 + wave + 4 * r] = myw; }
    }
#undef IX_PB
#undef IX_LAUNDER
}
#undef GBB

DI void phase_ln_router(Ctx& C, int l) {
    const bf16_t* V = (const bf16_t*)(C.ws + WS_V);
    const float* g = C.in(25) + (size_t)l * D; const float* bta = C.in(26) + (size_t)l * D;
    const float* wr = C.in(18); const float* br = C.in(19);
    LAS unsigned* lcnt = (LAS unsigned*)C.lds; LAS unsigned* base = lcnt + 16; LAS int* rec = (LAS int*)(C.lds + 128);
    TokInfo* tok = (TokInfo*)(C.ws + WS_TOK); RowInfo* rowi = (RowInfo*)(C.ws + WS_ROW);
    unsigned* gcnt = C.ctl + CW_GCNT + 64 * l;
    for (int i = C.blk * NTHR + C.tid; i < MAXROWS; i += C.G * NTHR) { RowInfo ri; ri.token = -1; ri.slot = 0; ri.gate = 0.f; ri.pad = 0; rowi[i] = ri; }
    LAS float* wT = (LAS float*)(C.lds + 4096);
    __syncthreads();
    for (int i = C.tid; i < D * 16; i += NTHR) { const int d = i >> 4, e = i & 15; wT[e * D + d] = wr[i]; }
    for (int rb = C.blk; rb < T / 64; rb += C.G) {
        __syncthreads();
        if (C.tid < 16) lcnt[C.tid] = 0u;
        __syncthreads();
        for (int i4 = 0; i4 < 8; i4 += 2) {
          f32x4 vv[8]; float lgg[32];
          { u32x2 raw[8];
#pragma unroll
            for (int r = 0; r < 2; ++r)
#pragma unroll
                for (int j = 0; j < 4; ++j) raw[4 * r + j] = *(const u32x2*)(V + ((size_t)rb * 64 + C.wave * 8 + i4 + r) * D + 256 * j + 4 * C.lane);
#pragma unroll
            for (int r = 0; r < 2; ++r) { f32x4 t[4];
#pragma unroll
                for (int j = 0; j < 4; ++j) { const u32x2 o = raw[4 * r + j]; t[j] = (f32x4){bflo(o.x), bfhi(o.x), bflo(o.y), bfhi(o.y)}; }
                ln16(t, g, bta, C.lane);
                store_row_bf16(C.xcur + ((size_t)rb * 64 + C.wave * 8 + i4 + r) * D, t, C.lane);
#pragma unroll
                for (int j = 0; j < 4; ++j) vv[4 * r + j] = t[j]; } }
#pragma unroll
          for (int k = 0; k < 32; ++k) lgg[k] = 0.f;
#pragma unroll
          for (int e = 0; e < 16; ++e)
#pragma unroll
              for (int j = 0; j < 4; ++j) { const f32x4 w4 = *(const LAS f32x4*)(wT + e * D + 256 * j + 4 * C.lane);
#pragma unroll
                  for (int r = 0; r < 2; ++r) { const f32x4 x = vv[4 * r + j]; lgg[16 * r + e] += (x.x * w4.x + x.y * w4.y) + (x.z * w4.z + x.w * w4.w); } }
#pragma unroll
          for (int k = 0; k < 32; ++k) lgg[k] = wave_sum(lgg[k]);
#pragma unroll
          for (int r = 0; r < 2; ++r) {
            const int lr = C.wave * 8 + i4 + r;
            float sc[16], sl[16];
#pragma unroll
            for (int e = 0; e < 16; ++e) { const float t = lgg[16 * r + e]; sc[e] = 1.f / (1.f + expf(-t)); sl[e] = sc[e] + br[e]; }
            int best = 0; float bestv = -3.0e38f;
#pragma unroll
            for (int gq = 0; gq < 4; ++gq) { const float a = sl[4 * gq], b2 = sl[4 * gq + 1], c2 = sl[4 * gq + 2], d2 = sl[4 * gq + 3];
                const float mx1 = fmaxf(fmaxf(a, b2), fmaxf(c2, d2)); const float tot = a + b2 + c2 + d2; const float mn1 = fminf(fminf(a, b2), fminf(c2, d2));
                const float lo1 = fminf(a, b2), hi1 = fmaxf(a, b2), lo2 = fminf(c2, d2), hi2 = fmaxf(c2, d2);
                const float second = fmaxf(fminf(hi1, hi2), fmaxf(lo1, lo2));
                (void)tot; (void)mn1;
                const float gs = mx1 + second; if (gs > bestv) { bestv = gs; best = gq; } }
            int i0 = 0, i1 = 0; float v0 = -3.0e38f, v1 = -3.0e38f, s0 = 0.f, s1 = 0.f;
#pragma unroll
            for (int gq = 0; gq < 4; ++gq) if (gq == best) {
#pragma unroll
                for (int k = 0; k < 4; ++k) { const float x = sl[4 * gq + k]; if (x > v0) { v1 = v0; i1 = i0; s1 = s0; v0 = x; i0 = 4 * gq + k; s0 = sc[4 * gq + k]; } else if (x > v1) { v1 = x; i1 = 4 * gq + k; s1 = sc[4 * gq + k]; } } }
            const float den = s0 + s1; const float g0 = s0 / den, g1 = s1 / den;
            if (C.lane == 0) {
                const unsigned r0 = __hip_atomic_fetch_add(lcnt + i0, 1u, __ATOMIC_RELAXED, __HIP_MEMORY_SCOPE_WORKGROUP);
                const unsigned r1 = __hip_atomic_fetch_add(lcnt + i1, 1u, __ATOMIC_RELAXED, __HIP_MEMORY_SCOPE_WORKGROUP);
                rec[lr * 8 + 0] = i0; rec[lr * 8 + 1] = i1; rec[lr * 8 + 2] = (int)r0; rec[lr * 8 + 3] = (int)r1;
                rec[lr * 8 + 4] = __builtin_bit_cast(int, g0); rec[lr * 8 + 5] = __builtin_bit_cast(int, g1); }
          }
        }
        __syncthreads();
        if (C.tid < 16) base[C.tid] = __hip_atomic_fetch_add(gcnt + C.tid, lcnt[C.tid], __ATOMIC_RELAXED, __HIP_MEMORY_SCOPE_AGENT);
        __syncthreads();
        if (C.tid < 64) { TokInfo ti; ti.e0 = rec[C.tid * 8]; ti.e1 = rec[C.tid * 8 + 1]; ti.p0 = rec[C.tid * 8 + 2] + (int)base[ti.e0]; ti.p1 = rec[C.tid * 8 + 3] + (int)base[ti.e1];
            ti.g0 = __builtin_bit_cast(float, rec[C.tid * 8 + 4]); ti.g1 = __builtin_bit_cast(float, rec[C.tid * 8 + 5]); ti.pad0 = 0; ti.pad1 = 0; tok[(size_t)rb * 64 + C.tid] = ti; }
    }
}
DI int build_tile_table(Ctx& C, int l, LAS int* toff, LAS int* texp) {
    const unsigned* gcnt = C.ctl + CW_GCNT + 64 * l;
    __syncthreads();
    if (C.tid < 64) {
        int c = 0; if (C.lane < 16) c = (int)__hip_atomic_load(gcnt + C.lane, __ATOMIC_RELAXED, __HIP_MEMORY_SCOPE_AGENT);
        const int nt = (c + 255) >> 8; int incl = nt;
#pragma unroll
        for (int o = 1; o < 16; o <<= 1) { const int v = __shfl_up(incl, o); if (C.lane >= o) incl += v; }
        const int start = incl - nt;
        if (C.lane < 16) { toff[C.lane] = start << 8; for (int t = 0; t < nt; ++t) texp[start + t] = C.lane; }
        if (C.lane == 15) toff[16] = incl << 8; }
    __syncthreads();
    return toff[16] >> 8;
}
DI void phase_gather(Ctx& C, int l) {
    LAS int* toff = (LAS int*)(C.lds + 1024); LAS int* texp = (LAS int*)(C.lds + 2048);
    (void)build_tile_table(C, l, toff, texp);
    const TokInfo* tok = (const TokInfo*)(C.ws + WS_TOK); RowInfo* rowi = (RowInfo*)(C.ws + WS_ROW); bf16_t* AG = (bf16_t*)(C.ws + WS_AG);
    for (int m = C.blk * NTHR + C.tid; m < T; m += C.G * NTHR) {
        const TokInfo ti = tok[m];
        const int r0 = toff[ti.e0] + ti.p0, r1 = toff[ti.e1] + ti.p1;
        { RowInfo x; x.token = m; x.slot = 0; x.gate = ti.g0; x.pad = 0; rowi[r0] = x; x.slot = 1; x.gate = ti.g1; rowi[r1] = x; }
    }
}
DI void phase_ln_ffn(Ctx& C, int l) {
    const bf16_t* Y = (const bf16_t*)(C.ws + WS_Y);
    const float* g = C.in(27) + (size_t)l * D; const float* bta = C.in(28) + (size_t)l * D;
    const int gw = C.blk * NWAVES + C.wave, NGW = C.G * NWAVES;
    for (int m = gw; m < T; m += NGW) {
        f32x4 x[4], y0[4], y1[4];
        load_row_bf16(C.xcur + (size_t)m * D, x, C.lane); load_row_bf16(Y + (size_t)m * D, y0, C.lane); load_row_bf16(Y + ((size_t)T + m) * D, y1, C.lane);
#pragma unroll
        for (int j = 0; j < 4; ++j) x[j] = x[j] * ALPHA + (y0[j] + y1[j]);
        ln16(x, g, bta, C.lane);
        store_row_bf16(C.xcur + (size_t)m * D, x, C.lane);
    }
}
DI void phase_ln_ple(Ctx& C, int l, bool last) {
    const bf16_t* V = (const bf16_t*)(C.ws + WS_V3);
    const float* g = C.in(29) + (size_t)l * D; const float* bta = C.in(30) + (size_t)l * D;
    const int gw = C.blk * NWAVES + C.wave, NGW = C.G * NWAVES;
    for (int m = gw; m < T; m += NGW) {
        f32x4 v[4];
        load_row_bf16(V + (size_t)m * D, v, C.lane);
        ln16(v, g, bta, C.lane);
        if (last) {
#ifdef PROBE_PHASE
            { const unsigned long long* pt = (const unsigned long long*)(C.ws + WS_CTL + 32768); const float sc = 1.f + (float)(pt[1] - pt[0]) * (float)(PROBE_SCALE);
#pragma unroll
              for (int j = 0; j < 4; ++j) v[j] = v[j] * sc; }
#endif
#pragma unroll
            for (int j = 0; j < 4; ++j) *(f32x4*)(C.out + (size_t)m * D + 256 * j + 4 * C.lane) = v[j];
        } else store_row_bf16(C.xcur + (size_t)m * D, v, C.lane);
    }
}

constexpr int LDS_BYTES = 163840;
constexpr int PH_PER_LAYER = 13, NPHASE = 1 + DEPTH * PH_PER_LAYER;

constexpr int CW_AQ = 2048;
DI void convert_mixer_weights(Ctx& C, int l) {
    int first = 0;
    { ColPlain c{C.in(5) + (size_t)l * D * D}; convert_matrix(C, c, D, D, D, (bf16_t*)(C.ws + WS_WOUT), first); }
    { ColPlain c{C.in(8) + (size_t)l * 64 * 512}; convert_matrix(C, c, 512, 64, 512, (bf16_t*)(C.ws + WS_LORA), first); }
    { ColPlain c{C.in(10) + (size_t)l * 64 * 512}; convert_matrix(C, c, 512, 64, 512, (bf16_t*)(C.ws + WS_LORA) + 512 * 64, first); }
    { ColPlain c{C.in(11) + (size_t)l * 128 * 512}; convert_matrix(C, c, 512, 128, 512, (bf16_t*)(C.ws + WS_LORA) + 2 * 512 * 64, first); }
}
DI void convert_ffn_weights(Ctx& C, int l) {
    int first = 0;
    { ColGateUp c{C.in(20) + (size_t)l * NEXP * D * DEXP, C.in(21) + (size_t)l * NEXP * D * DEXP}; convert_matrix(C, c, DEXP, D, NEXP * 512, (bf16_t*)(C.ws + WS_WEXP), first); }
    for (int e = 0; e < NEXP; ++e) { ColDown c{C.in(22) + ((size_t)l * NEXP + e) * DEXP * D}; convert_matrix(C, c, D, DEXP, D, (bf16_t*)(C.ws + WS_WDOWN) + (size_t)e * D * DEXP, first); }
    { ColPlain c{C.in(24) + (size_t)l * D * D}; convert_matrix(C, c, D, D, D, (bf16_t*)(C.ws + WS_WPG), first); }
    { ColPlain c{C.in(23) + (size_t)l * PLE * D}; convert_matrix(C, c, D, PLE, D, (bf16_t*)(C.ws + WS_WPLE), first); }
    const float* p = C.in(1) + (size_t)l * T * PLE; bf16_t* pb = (bf16_t*)(C.ws + WS_PBF);
    const size_t pstr = (size_t)C.G * NTHR * 8;
    for (size_t i0 = ((size_t)C.blk * NTHR + C.tid) * 8; i0 < (size_t)T * PLE; i0 += 4 * pstr) {
        f32x4 a[4], b[4];
#pragma unroll
        for (int k = 0; k < 4; ++k) { const size_t i = i0 + k * pstr; if (i < (size_t)T * PLE) { a[k] = *(const f32x4*)(p + i); b[k] = *(const f32x4*)(p + i + 4); } }
#pragma unroll
        for (int k = 0; k < 4; ++k) { const size_t i = i0 + k * pstr; if (i < (size_t)T * PLE) { u32x4 o; o.x = pk2(a[k].x, a[k].y); o.y = pk2(a[k].z, a[k].w); o.z = pk2(b[k].x, b[k].y); o.w = pk2(b[k].z, b[k].w); *(u32x4*)(pb + i) = o; } } }
}
#ifndef RWREP
#define RWREP 1
#endif
#ifndef IQREP
#define IQREP 1
#endif
#ifndef REP_SUB
#define REP_SUB 0
#endif
#ifndef REP_SP
#define REP_SP -1
#define REP_N 1
#endif
template <int SP> DI void run_sp_(Ctx& C, const int l, const int rep);
template <int SP> DI void run_sp(Ctx& C, const int l) { run_sp_<SP>(C, l, 0); }
template <int SP> DI void run_sp_(Ctx& C, const int l, const int rep) {
    if constexpr (SP == 0) {
        pg8::Gemm g{C.xcur, (const bf16_t*)(C.ws + WS_WEXP), T, NPROJ_PAD, opaque_i(D)}; pg8::StaticOrder S; S.init(T, NPROJ_PAD, C.G, C.blk);
        EpiProj E{(bf16_t*)(C.ws + WS_PROJ)};
        pg8::gemm_phase<EpiProj, pg8::StaticOrder, true, true>(C.lds, g, S, E);
    } else if constexpr (SP == 1) {
    } else if constexpr (SP == 2) {
        LAS unsigned* gb = (LAS unsigned*)(C.lds + GB_OFF);
        if (C.tid < 8) gb[C.tid] = 0u;
        __syncthreads();
        const int half = C.wave >> 2, ltid = C.tid & 255;
        LAS unsigned* gcnt = gb + half; unsigned gtarget = 0u;
        LAS int* slot = (LAS int*)(gb + 2 + 2 * half);
        unsigned* iq = C.ctl + CW_AQ + 32 + 64 * l + 256 * rep;
        int nxt = 0, par = 0;
        if (half == 0) {
            for (int rw_ = 0; rw_ < RWREP; ++rw_)
            for (int bc = C.blk; bc < 256; bc += C.G) { bf16x8 actv[8]; rwkv_chunk_acts4(C, bc, l, actv); for (int h = 0; h < 8; ++h) rwkv_head_item4(C, bc * 8 + h, l, actv, gcnt, gtarget); }
        }
        const int ixb = half ? IX4 : 0;
        if (ltid == 0) nxt = (int)__hip_atomic_fetch_add(iq, 1u, __ATOMIC_RELAXED, __HIP_MEMORY_SCOPE_AGENT);
        for (;;) {
            if (ltid == 0) slot[par] = nxt;
            gbar(gcnt, gtarget, C.lane);
            const int u = __builtin_amdgcn_readfirstlane(slot[par]); par ^= 1;
            if (u >= 4096) break;
            if (ltid == 0) nxt = (int)__hip_atomic_fetch_add(iq, 1u, __ATOMIC_RELAXED, __HIP_MEMORY_SCOPE_AGENT);
            idx_item4(C, u, l, ixb, gcnt, gtarget);
        }
    } else if constexpr (SP == 3) {
        if (C.blk < 8 && (rep == 0 || REP_SUB != 2)) rwkv_scan_wave(C, C.blk * 8 + C.wave);
        LAS int* qs = (LAS int*)(C.lds + LDS_BYTES - 128);
        if (rep == 0 || REP_SUB != 1)
        for (;;) {
            __syncthreads();
            if (C.tid == 0) qs[0] = (int)__hip_atomic_fetch_add(C.ctl + CW_AQ + 64 * l + 256 * rep, 1u, __ATOMIC_RELAXED, __HIP_MEMORY_SCOPE_AGENT);
            __syncthreads();
            const int u = __builtin_amdgcn_readfirstlane(qs[0]);
            if (u >= 512) break;
            const int qb = 15 - (u >> 5), bh = u & 31; attn_unit(C, bh >> 3, bh & 7, qb);
        }
    } else if constexpr (SP == 4) {
        const int gw = C.blk * NWAVES + C.wave, NGW = C.G * NWAVES;
        for (int id = gw; id < 2048; id += NGW) rwkv_out_wave(C, id, l);
    } else if constexpr (SP == 5) {
        pg8::Gemm g{C.mixcat, (const bf16_t*)(C.ws + WS_WOUT), T, D, opaque_i(D)}; pg8::StaticOrder S; S.init(T, D, C.G, C.blk);
        EpiResF32 E{C.xcur, (bf16_t*)(C.ws + WS_V)};
        pg8::gemm_phase<EpiResF32, pg8::StaticOrder, true, true>(C.lds, g, S, E);
    } else if constexpr (SP == 6) { phase_ln_router(C, l); convert_ffn_weights(C, l);
    } else if constexpr (SP == 7) { phase_gather(C, l);
    } else if constexpr (SP == 8) {
        LAS int* toff = (LAS int*)(C.lds + 135168); LAS int* texp = (LAS int*)(C.lds + 136192);
        const int nt = build_tile_table(C, l, toff, texp);
        pg8::Gemm g{C.xcur, (const bf16_t*)(C.ws + WS_WEXP), MAXROWS, NEXP * 512, opaque_i(D)};
        GroupedOrder<2> S{texp, nt, C.G, C.blk};
        EpiSwiGLU E{(bf16_t*)(C.ws + WS_H), (const RowInfo*)(C.ws + WS_ROW)};
        pg8::gemm_phase_gather<EpiSwiGLU, GroupedOrder<2>, true>(C.lds, g, S, E, (const int*)(C.ws + WS_ROW));
        {
            const int extra = (2 * nt > C.G) ? (2 * nt - C.G) : 0; const int nb = C.G - extra;
            if (C.blk >= extra && nb > 0) { pg8::Gemm g2{(const bf16_t*)(C.ws + WS_PBF), (const bf16_t*)(C.ws + WS_WPLE), T, D, opaque_i(PLE)}; pg8::StaticOrder S2; S2.init(T, D, nb, C.blk - extra);
                EpiBf16Plain E2{(bf16_t*)(C.ws + WS_PE), D};
                pg8::gemm_phase<EpiBf16Plain, pg8::StaticOrder, true, true>(C.lds, g2, S2, E2); } }
    } else if constexpr (SP == 9) {
        LAS int* toff = (LAS int*)(C.lds + 135168); LAS int* texp = (LAS int*)(C.lds + 136192);
        const int nt = build_tile_table(C, l, toff, texp);
        { pg8::Gemm g{(const bf16_t*)(C.ws + WS_H), (const bf16_t*)(C.ws + WS_WDOWN), MAXROWS, NEXP * D, opaque_i(DEXP)};
          GroupedOrder<4> S{texp, nt, C.G, C.blk};
          EpiDown E{(bf16_t*)(C.ws + WS_Y), (const RowInfo*)(C.ws + WS_ROW)};
          pg8::gemm_phase<EpiDown, GroupedOrder<4>, true, true>(C.lds, g, S, E); }
    } else if constexpr (SP == 10) { phase_ln_ffn(C, l);
    } else if constexpr (SP == 11) {
        pg8::Gemm g{C.xcur, (const bf16_t*)(C.ws + WS_WPG), T, D, opaque_i(D)}; pg8::StaticOrder S; S.init(T, D, C.G, C.blk);
        EpiPle E{C.xcur, (const bf16_t*)(C.ws + WS_PE), (bf16_t*)(C.ws + WS_V3)};
        pg8::gemm_phase<EpiPle, pg8::StaticOrder, true, true>(C.lds, g, S, E);
    } else { phase_ln_ple(C, l, l == DEPTH - 1); if (l + 1 < DEPTH) { convert_win(C, l + 1); convert_mixer_weights(C, l + 1); } }
}
#define XB_TMO      128
#define XB_XCNT(j)  (256  + 64 * (j))
#define XB_XSUB(j)  (1280 + 64 * (j))
#define XB_XGEN(j)  (2304 + 64 * (j))
#define XB_TOP      3328
#define XB_TOPGEN   3392
#define XCD_BAR_WORDS 3456
#define XB_SPIN_CAP (1u << 18)

__device__ __forceinline__ unsigned xb_ld(unsigned* p)              { return __hip_atomic_load(p, __ATOMIC_RELAXED, __HIP_MEMORY_SCOPE_AGENT); }
__device__ __forceinline__ unsigned xb_add(unsigned* p, unsigned v) { return __hip_atomic_fetch_add(p, v, __ATOMIC_RELAXED, __HIP_MEMORY_SCOPE_AGENT); }
__device__ __forceinline__ unsigned xb_xcc_id() { return (unsigned)__builtin_amdgcn_s_getreg((3 << 11) | 20) & 0xFu; }
#define XB_SPIN(cond, bar) do { unsigned _sp = 0; while (cond) { __builtin_amdgcn_s_sleep(1); \
    if ((++_sp & 255u) == 0u) { if (xb_ld(&(bar)[XB_TMO])) break; if (_sp > XB_SPIN_CAP) { atomicAdd(&(bar)[XB_TMO], 1u); break; } } } } while (0)

struct XcdBarrier {
    unsigned* bar; unsigned x;
    volatile __attribute__((address_space(3))) unsigned* st;
};

__device__ __forceinline__ XcdBarrier xcd_barrier_post(unsigned* bar, volatile __attribute__((address_space(3))) unsigned* st) {
    XcdBarrier b; b.bar = bar; b.x = xb_xcc_id(); b.st = st;
    if (threadIdx.x == 0) (void)xb_add(&bar[XB_XCNT(b.x)], 1u);
    return b;
}
__device__ __forceinline__ void xcd_barrier_complete(unsigned* bar, unsigned x, unsigned& nloc, unsigned& nx) {
    const unsigned G = gridDim.x * gridDim.y * gridDim.z;
    unsigned sum, cnt, mine, sp = 0u;
    for (;;) {
        sum = 0u; cnt = 0u; mine = 0u;
#pragma unroll
        for (unsigned j = 0; j < 16; ++j) { const unsigned c = xb_ld(&bar[XB_XCNT(j)]); sum += c; cnt += (c > 0u) ? 1u : 0u; mine = (j == x) ? c : mine; }
        if (sum == G) break;
        __builtin_amdgcn_s_sleep(1);
        if ((++sp & 255u) == 0u) { if (xb_ld(&bar[XB_TMO])) break; if (sp > XB_SPIN_CAP) { atomicAdd(&bar[XB_TMO], 1u); break; } }
    }
    nloc = mine > 0u ? mine : 1u; nx = cnt > 0u ? cnt : 1u;
}

__device__ __forceinline__ void xcd_barrier(const XcdBarrier& b) {
    asm volatile("s_waitcnt vmcnt(0)" ::: "memory");
    __syncthreads();
    if (threadIdx.x == 0) {
        unsigned* bar = b.bar;
        __builtin_amdgcn_s_waitcnt(0);
        unsigned nloc = b.st[0], nx = b.st[1];
        if (nloc == 0u) { xcd_barrier_complete(bar, b.x, nloc, nx); b.st[0] = nloc; b.st[1] = nx; }
        const unsigned old = xb_add(&bar[XB_XSUB(b.x)], 1u);
        const unsigned gen = old / nloc;
        if (old + 1u == (gen + 1u) * nloc) {
            __builtin_amdgcn_fence(__ATOMIC_RELEASE, "agent");
            asm volatile("s_waitcnt vmcnt(0)" ::: "memory");
            const unsigned og = xb_add(&bar[XB_TOP], 1u);
            const unsigned tg = og / nx;
            if (og + 1u == (tg + 1u) * nx) xb_add(&bar[XB_TOPGEN], 1u);
            else XB_SPIN(xb_ld(&bar[XB_TOPGEN]) == tg, bar);
            __builtin_amdgcn_fence(__ATOMIC_ACQUIRE, "agent");
            xb_add(&bar[XB_XGEN(b.x)], 1u);
            asm volatile("s_waitcnt vmcnt(0)" ::: "memory");
        } else {
            XB_SPIN(xb_ld(&bar[XB_XGEN(b.x)]) == gen, bar);
            __builtin_amdgcn_fence(__ATOMIC_ACQUIRE, "agent");
            asm volatile("s_waitcnt vmcnt(0)" ::: "memory");
        }
    }
    __syncthreads();
}

constexpr int CW_XBAR = 65536;
typedef const __attribute__((address_space(4))) Args* KArgP;
DI void ctx_setup(Ctx& C) {
    int t_ = threadIdx.x; asm volatile("" : "+v"(t_)); C.tid = t_; C.lane = t_ & 63; C.wave = __builtin_amdgcn_readfirstlane(t_ >> 6);
    int b_ = blockIdx.x, g_ = gridDim.x; asm volatile("" : "+s"(b_), "+s"(g_)); C.blk = b_; C.G = g_;
    KArgP ap = (KArgP)__builtin_amdgcn_kernarg_segment_ptr(); asm volatile("" : "+s"(ap));
    C.ap = ap; C.out = ap->out; C.ws = ap->ws; C.ctl = (unsigned*)(ap->ws + WS_CTL); C.xcur = (bf16_t*)ap->out; C.mixcat = (bf16_t*)ap->out + (size_t)T * D;
}
__global__ void __launch_bounds__(NTHR, 2) mega_fwd(Args args) {
    extern __shared__ __attribute__((aligned(16))) unsigned char lds_raw[];
    Ctx C;
    C.lds = (LAS unsigned char*)lds_raw;
    cg::grid_group grid = cg::this_grid();
    volatile LAS unsigned* xbst = (volatile LAS unsigned*)(C.lds + LDS_BYTES - 32);
    if (threadIdx.x < 4) xbst[threadIdx.x] = 0u;
    __syncthreads();
    XcdBarrier xbar = xcd_barrier_post((unsigned*)(((KArgP)__builtin_amdgcn_kernarg_segment_ptr())->ws + WS_CTL) + CW_XBAR, xbst);
    const int lo = ((KArgP)__builtin_amdgcn_kernarg_segment_ptr())->ph_lo, hi = ((KArgP)__builtin_amdgcn_kernarg_segment_ptr())->ph_hi;
#ifdef PROBE_PHASE
#define PROBE_HOOK(k) do { if (blockIdx.x == 0 && threadIdx.x == 0) { unsigned long long* pt = (unsigned long long*)(C.ws + WS_CTL + 32768); if ((k) == PROBE_PHASE) pt[0] = __builtin_amdgcn_s_memrealtime(); if ((k) == PROBE_PHASE_END) pt[1] = __builtin_amdgcn_s_memrealtime(); } } while (0)
#else
#define PROBE_HOOK(k) do { } while (0)
#endif
#define GRID_BAR(k) do { if ((k) == lo + 1) grid.sync(); else xcd_barrier(xbar); } while (0)
#define PHASE(k, body) do { if (lo <= (k) && (k) < hi) { if ((k) > lo) GRID_BAR(k); ctx_setup(C); PROBE_HOOK(k); body; } } while (0)
    PHASE(0, { phase_ln_in(C); convert_win(C, 0); convert_mixer_weights(C, 0); });
#define LAYER(l) PHASE(1 + 13 * (l) + 0, run_sp<0>(C, l)); PHASE(1 + 13 * (l) + 2, run_sp<2>(C, l)); PHASE(1 + 13 * (l) + 3, run_sp<3>(C, l)); \
    PHASE(1 + 13 * (l) + 4, run_sp<4>(C, l)); PHASE(1 + 13 * (l) + 5, run_sp<5>(C, l)); PHASE(1 + 13 * (l) + 6, run_sp<6>(C, l)); PHASE(1 + 13 * (l) + 7, run_sp<7>(C, l)); \
    PHASE(1 + 13 * (l) + 8, run_sp<8>(C, l)); PHASE(1 + 13 * (l) + 9, run_sp<9>(C, l)); PHASE(1 + 13 * (l) + 10, run_sp<10>(C, l)); PHASE(1 + 13 * (l) + 11, run_sp<11>(C, l)); \
    PHASE(1 + 13 * (l) + 12, run_sp<12>(C, l))
#define PH0(sp) PHASE(1 + (sp), run_sp<sp>(C, 0)); if (REP_SP == (sp)) { if (REP_N > 1) { xcd_barrier(xbar); ctx_setup(C); run_sp_<sp>(C, 0, 1); } if (REP_N > 2) { xcd_barrier(xbar); ctx_setup(C); run_sp_<sp>(C, 0, 2); } }
    PH0(0); PH0(2); PH0(3); PH0(4); PH0(5); PH0(6); PH0(7); PH0(8); PH0(9); PH0(10); PH0(11); PH0(12);
#undef PH0
    LAYER(1);
#undef LAYER
#undef PHASE
}

#ifndef N_LAUNCH_MODE
#define N_LAUNCH_MODE 1
#endif
extern "C" void kernel_launch(void* const* d_in, const int* in_sizes, int n_in, void* d_out, int out_size, void* d_ws, size_t ws_size, hipStream_t stream) {
    static int grid = 0;
    if (grid == 0) {
        if (n_in != 31 || out_size != T * D) { fprintf(stderr, "kernel_launch: unexpected problem (n_in %d out %d)\n", n_in, out_size); grid = -1; return; }
        int dev = 0, cus = 0, per_cu = 0;
        hipGetDevice(&dev); hipDeviceGetAttribute(&cus, hipDeviceAttributeMultiprocessorCount, dev);
        if (hipFuncSetAttribute((const void*)mega_fwd, hipFuncAttributeMaxDynamicSharedMemorySize, LDS_BYTES) != hipSuccess) { fprintf(stderr, "kernel_launch: hipFuncSetAttribute failed\n"); grid = -1; return; }
        if (hipOccupancyMaxActiveBlocksPerMultiprocessor(&per_cu, (const void*)mega_fwd, NTHR, LDS_BYTES) != hipSuccess || per_cu < 1) { fprintf(stderr, "kernel_launch: occupancy query says %d\n", per_cu); per_cu = 1; }
        (void)hipGetLastError();
        grid = cus * 1;
        fprintf(stderr, "kernel_launch: grid %d (occupancy %d per CU)\n", grid, per_cu);
    }
    if (grid < 0) return;
    hipMemsetAsync((char*)d_ws + WS_CTL, 0, CTL_BYTES, stream);
    Args a{};
    for (int i = 0; i < 31; ++i) a.in[i] = (const float*)d_in[i];
    a.out = (float*)d_out; a.ws = (unsigned char*)d_ws;
#if N_LAUNCH_MODE == 0
    for (int ph = 0; ph < NPHASE; ++ph) { a.ph_lo = ph; a.ph_hi = ph + 1; hipLaunchKernelGGL(mega_fwd, dim3(grid), dim3(NTHR), LDS_BYTES, stream, a); }
#else
    a.ph_lo = 0; a.ph_hi = NPHASE;
    void* kargs[] = {&a};
    hipError_t e = hipLaunchCooperativeKernel((const void*)mega_fwd, dim3(grid), dim3(NTHR), kargs, LDS_BYTES, stream);
    if (e != hipSuccess) fprintf(stderr, "cooperative launch failed: %s (grid %d)\n", hipGetErrorString(e), grid);
#endif
}
```

```cpp
#include <hip/hip_runtime.h>
#include <hip/hip_cooperative_groups.h>
#include <cstdio>
#include <cstdint>
namespace cg = cooperative_groups;
namespace pg8 {
#define PG8_LAS __attribute__((address_space(3)))
typedef unsigned short bf16_t;
typedef short bf16x8 __attribute__((ext_vector_type(8)));
typedef float f32x4 __attribute__((ext_vector_type(4)));
typedef unsigned u32x4 __attribute__((ext_vector_type(4)));
constexpr int BM = 256, BK = 64, HALF = 128, HTB = HALF * BK * 2  , STAGE_BYTES = 8 * HTB, NXCD = 8, WGM = 8;

__host__ __device__ __forceinline__ int lds_byte(int r, int c) { const int st = (r >> 4) * 2 + (c >> 5), rr = r & 15, cc = c & 31, ob = rr * 64 + cc * 2; return st * 1024 + (ob ^ (((ob >> 9) & 1) << 5)); }
__host__ __device__ __forceinline__ void stage_rc(int b, int& R, int& C) { const int st = b / 1024, sb = b % 1024, swz = sb ^ (((sb >> 9) & 1) << 5); R = (st >> 1) * 16 + swz / 64; C = (st & 1) * 32 + (swz % 64) / 2; }
__host__ __device__ __forceinline__ int perm32(int rho) { const int n = rho >> 4, i = rho & 15; return 8 * (i >> 2) + 4 * n + (i & 3); }

struct Unit { int pm, pn; };
struct Gemm { const bf16_t* A; const bf16_t* Bt; int M, N, K; };

struct StaticOrder {
    int nM, nN, nwg, G, c;
    __host__ __device__ void init(int M, int N, int G_, int c_) { nM = M / BM; nN = N / BM; nwg = nM * nN; G = G_; c = c_; }
    __host__ __device__ bool next(int i, Unit& u) const {
        const long L = (long)i * G + c; if (L >= nwg) return false;
        int wgid = (int)L; { const int q = nwg / NXCD, r = nwg % NXCD, xcd = wgid % NXCD, off = wgid / NXCD; wgid = (xcd < r ? xcd * (q + 1) : r * (q + 1) + (xcd - r) * q) + off; }
        const int nig = WGM * nN, gid = wgid / nig, fm = gid * WGM, gsz = (nM - fm) < WGM ? (nM - fm) : WGM;
        u.pm = fm + ((wgid % nig) % gsz); u.pn = (wgid % nig) / gsz; return true;
    }
    __device__ __forceinline__ void a_ready(const Unit&) const {}
    __device__ __forceinline__ void done(const Unit&) const {}
};

__device__ __forceinline__ unsigned cvt_pk_bf16(float lo, float hi) { typedef float f2_t __attribute__((ext_vector_type(2))); typedef __bf16 b2_t __attribute__((ext_vector_type(2))); f2_t v = {lo, hi}; b2_t b = __builtin_convertvector(v, b2_t); return __builtin_bit_cast(unsigned, b); }
template <class Epi, class Sched, bool ALIGN_EPI = false, bool SP2 = false>
__device__ __forceinline__ void gemm_phase(PG8_LAS unsigned char* lds, const Gemm g, const Sched& S, const Epi& E) {
    int tid_ = threadIdx.x; asm volatile("" : "+v"(tid_));
    const int tid = tid_, wid = __builtin_amdgcn_readfirstlane(tid >> 6), lane = tid & 63, wr = wid >> 2, wc = wid & 3, fr = lane & 15, fq = lane >> 4;
    const int K = g.K, nt = K / BK;
    unsigned voffA[2], voffB[2];
#pragma unroll
    for (int i = 0; i < 2; ++i) { int R, C; stage_rc(tid * 16 + i * 8192, R, C); const int Rb = Epi::PERM ? ((R & ~31) + perm32(R & 31)) : R;
        voffA[i] = (unsigned)(R * K + C) * 2u; voffB[i] = (unsigned)(Rb * K + C) * 2u; }
    const size_t kstep = (size_t)(BK * 2);
    const size_t hstep = (size_t)HALF * K * 2;
    const size_t tstep = 2 * hstep;
    const unsigned ldsw = (unsigned)wid * 1024u;
    const int aoff = lds_byte(wr * 64 + fr, fq * 8), boff = lds_byte(wc * 32 + fr, fq * 8);
#define PG8_SA(b, h) (((b) * 2 + (h)) * HTB)
#define PG8_SB(b, h) ((4 + (b) * 2 + (h)) * HTB)
#define PG8_STAGE(bufoff, gbase, voff) do { _Pragma("unroll") for (int _i = 0; _i < 2; ++_i) \
        __builtin_amdgcn_global_load_lds((const unsigned*)((const char*)(gbase) + (voff)[_i]), (PG8_LAS unsigned*)(lds + (bufoff) + ldsw + _i * 8192), 16, 0, 0); } while (0)
#define PG8_LDA(dst, b, h) do { _Pragma("unroll") for (int m = 0; m < 4; ++m) _Pragma("unroll") for (int k = 0; k < 2; ++k) dst[m][k] = *(const PG8_LAS bf16x8*)(lds + PG8_SA(b, h) + aoff + m * 2048 + k * 1024); } while (0)
#define PG8_LDB(dst, b, h) do { _Pragma("unroll") for (int n = 0; n < 2; ++n) _Pragma("unroll") for (int k = 0; k < 2; ++k) dst[n][k] = *(const PG8_LAS bf16x8*)(lds + PG8_SB(b, h) + boff + n * 2048 + k * 1024); } while (0)
#define PG8_MMA(ai, bj, At, Bt) do { __builtin_amdgcn_s_setprio(1); _Pragma("unroll") for (int m = 0; m < 4; ++m) _Pragma("unroll") for (int n = 0; n < 2; ++n) _Pragma("unroll") for (int k = 0; k < 2; ++k) \
        acc[ai][bj][m][n] = __builtin_amdgcn_mfma_f32_16x16x32_bf16(Bt[n][k], At[m][k], acc[ai][bj][m][n], 0, 0, 0); __builtin_amdgcn_s_setprio(0); } while (0)
#define PG8_WAIT_V(n) asm volatile("s_waitcnt vmcnt(" #n ")" ::: "memory")
#define PG8_WAIT_L(n) asm volatile("s_waitcnt lgkmcnt(" #n ")" ::: "memory")
#define PG8_BAR __builtin_amdgcn_s_barrier()
#define PG8_SCHED __builtin_amdgcn_sched_barrier(0)
    Unit cur, nxt; int ui = 0;
    if (!S.next(0, cur)) return;
    f32x4 acc[2][2][4][2];
#pragma unroll
    for (int a = 0; a < 2; ++a)
#pragma unroll
        for (int b = 0; b < 2; ++b)
#pragma unroll
            for (int m = 0; m < 4; ++m)
#pragma unroll
                for (int n = 0; n < 2; ++n) acc[a][b][m][n] = (f32x4){0.f, 0.f, 0.f, 0.f};
    bf16x8 At[4][2], B0[2][2], B1[2][2];
    const char* cA = (const char*)g.A + (size_t)cur.pm * tstep; const char* cB = (const char*)g.Bt + (size_t)cur.pn * tstep;
    S.a_ready(cur);
    if constexpr (SP2) {
        PG8_STAGE(PG8_SB(0, 0), cB, voffB); PG8_STAGE(PG8_SB(0, 1), cB + hstep, voffB); PG8_STAGE(PG8_SA(0, 0), cA, voffA); PG8_STAGE(PG8_SA(0, 1), cA + hstep, voffA);
        if (wr == 1) PG8_BAR;
        PG8_WAIT_V(2); PG8_BAR;
        PG8_STAGE(PG8_SB(1, 0), cB + kstep, voffB); PG8_STAGE(PG8_SA(1, 0), cA + kstep, voffA); PG8_STAGE(PG8_SB(1, 1), cB + hstep + kstep, voffB);
        PG8_WAIT_V(6); PG8_BAR;
    } else {
        PG8_STAGE(PG8_SB(0, 0), cB, voffB); PG8_STAGE(PG8_SA(0, 0), cA, voffA); PG8_STAGE(PG8_SB(0, 1), cB + hstep, voffB); PG8_STAGE(PG8_SA(0, 1), cA + hstep, voffA);
        if (wr == 1) PG8_BAR;
        PG8_WAIT_V(4); PG8_BAR;
        PG8_STAGE(PG8_SB(1, 0), cB + kstep, voffB); PG8_STAGE(PG8_SA(1, 0), cA + kstep, voffA); PG8_STAGE(PG8_SB(1, 1), cB + hstep + kstep, voffB);
        PG8_WAIT_V(6); PG8_BAR;
    }
    for (;;) {
        const bool has_next = S.next(ui + 1, nxt);
        const char* nA = has_next ? (const char*)g.A + (size_t)nxt.pm * tstep : cA; const char* nB = has_next ? (const char*)g.Bt + (size_t)nxt.pn * tstep : cB;
        for (int t = 0; t < nt; t += 2) {
            const bool last = (t == nt - 2);
            const char* a1 = cA + (size_t)(t + 1) * kstep;
            const char* a2 = last ? nA : cA + (size_t)(t + 2) * kstep; const char* b2 = last ? nB : cB + (size_t)(t + 2) * kstep;
            const char* a3 = a2 + kstep; const char* b3 = b2 + kstep;
            if (last && has_next) S.a_ready(nxt);
            if constexpr (SP2) {
            PG8_LDB(B0, 0, 0); PG8_LDB(B1, 0, 1); PG8_SCHED; PG8_LDA(At, 0, 0); PG8_STAGE(PG8_SA(1, 1), a1 + hstep, voffA);
            PG8_WAIT_V(8); PG8_WAIT_L(0); PG8_BAR; PG8_MMA(0, 0, At, B0); PG8_MMA(0, 1, At, B1); PG8_BAR; PG8_SCHED;
            PG8_LDA(At, 0, 1); PG8_STAGE(PG8_SB(0, 0), b2, voffB); PG8_STAGE(PG8_SB(0, 1), b2 + hstep, voffB); PG8_STAGE(PG8_SA(0, 0), a2, voffA);
            PG8_WAIT_V(8); PG8_WAIT_L(0); PG8_BAR; PG8_MMA(1, 0, At, B0); PG8_MMA(1, 1, At, B1); PG8_BAR; PG8_SCHED;
            PG8_LDB(B0, 1, 0); PG8_LDB(B1, 1, 1); PG8_SCHED; PG8_LDA(At, 1, 0); PG8_STAGE(PG8_SA(0, 1), a2 + hstep, voffA);
            PG8_WAIT_V(8); PG8_WAIT_L(0); PG8_BAR; PG8_MMA(0, 0, At, B0); PG8_MMA(0, 1, At, B1); PG8_BAR; PG8_SCHED;
            PG8_LDA(At, 1, 1); PG8_STAGE(PG8_SB(1, 0), b3, voffB); PG8_STAGE(PG8_SB(1, 1), b3 + hstep, voffB); PG8_STAGE(PG8_SA(1, 0), a3, voffA);
            PG8_WAIT_V(8); PG8_WAIT_L(0); PG8_BAR; PG8_MMA(1, 0, At, B0); PG8_MMA(1, 1, At, B1); PG8_BAR; PG8_SCHED;
            } else {
            PG8_LDB(B0, 0, 0); PG8_SCHED; PG8_LDA(At, 0, 0); PG8_STAGE(PG8_SA(1, 1), a1 + hstep, voffA);
            PG8_WAIT_L(8); PG8_BAR; PG8_WAIT_L(0); PG8_MMA(0, 0, At, B0); PG8_BAR; PG8_SCHED;
            PG8_LDB(B1, 0, 1); PG8_STAGE(PG8_SB(0, 0), b2, voffB);
            PG8_BAR; PG8_WAIT_L(0); PG8_MMA(0, 1, At, B1); PG8_BAR;
            PG8_LDA(At, 0, 1); PG8_STAGE(PG8_SA(0, 0), a2, voffA);
            PG8_BAR; PG8_WAIT_L(0); PG8_MMA(1, 0, At, B0); PG8_BAR; PG8_SCHED;
            PG8_STAGE(PG8_SB(0, 1), b2 + hstep, voffB);
            PG8_WAIT_V(6); PG8_BAR; PG8_MMA(1, 1, At, B1); PG8_BAR;
            PG8_LDB(B0, 1, 0); PG8_SCHED; PG8_LDA(At, 1, 0); PG8_STAGE(PG8_SA(0, 1), a2 + hstep, voffA);
            PG8_WAIT_L(8); PG8_BAR; PG8_WAIT_L(0); PG8_MMA(0, 0, At, B0); PG8_BAR; PG8_SCHED;
            PG8_LDB(B1, 1, 1); PG8_STAGE(PG8_SB(1, 0), b3, voffB);
            PG8_BAR; PG8_WAIT_L(0); PG8_MMA(0, 1, At, B1); PG8_BAR;
            PG8_LDA(At, 1, 1); PG8_STAGE(PG8_SA(1, 0), a3, voffA);
            PG8_BAR; PG8_WAIT_L(0); PG8_MMA(1, 0, At, B0); PG8_BAR; PG8_SCHED;
            PG8_STAGE(PG8_SB(1, 1), b3 + hstep, voffB);
            PG8_WAIT_V(6); PG8_BAR; PG8_MMA(1, 1, At, B1); PG8_BAR;
            }
        }
        if constexpr (ALIGN_EPI) { if (wr == 0) PG8_BAR; }
        if constexpr (!Epi::AFTER_DRAIN) { E(acc, cur, wr, wc, fr, fq); S.done(cur); }
        if (!has_next) break;
#pragma unroll
        for (int a = 0; a < 2; ++a)
#pragma unroll
            for (int b = 0; b < 2; ++b)
#pragma unroll
                for (int m = 0; m < 4; ++m)
#pragma unroll
                    for (int n = 0; n < 2; ++n) acc[a][b][m][n] = (f32x4){0.f, 0.f, 0.f, 0.f};
        cur = nxt; cA = nA; cB = nB; ++ui;
        if constexpr (ALIGN_EPI) { if (wr == 1) PG8_BAR; }
    }
    PG8_WAIT_V(0);
    if constexpr (!ALIGN_EPI) { if (wr == 0) PG8_BAR; }
    PG8_BAR;
    if constexpr (Epi::AFTER_DRAIN) { E.fused(acc, cur, wr, wc, fr, fq, lds, wid, lane); S.done(cur); }
#undef PG8_SA
#undef PG8_SB
#undef PG8_STAGE
#undef PG8_LDA
#undef PG8_LDB
#undef PG8_MMA
#undef PG8_WAIT_V
#undef PG8_WAIT_L
#undef PG8_BAR
#undef PG8_SCHED
}

template <class Epi, class Sched, bool ALIGN_EPI = false>
__device__ __forceinline__ void gemm_phase_gather(PG8_LAS unsigned char* lds, const Gemm g, const Sched& S, const Epi& E, const int* rowtok) {
    constexpr bool SP2 = true;
    int tid_ = threadIdx.x; asm volatile("" : "+v"(tid_));
    const int tid = tid_, wid = __builtin_amdgcn_readfirstlane(tid >> 6), lane = tid & 63, wr = wid >> 2, wc = wid & 3, fr = lane & 15, fq = lane >> 4;
    const int K = g.K, nt = K / BK;
    unsigned voffB[2]; unsigned vcur[2][2], vnxt[2][2]; int RA[2], CA[2]; const unsigned voffA[2] = {0u, 0u};
#pragma unroll
    for (int i = 0; i < 2; ++i) { int R, C; stage_rc(tid * 16 + i * 8192, R, C); const int Rb = Epi::PERM ? ((R & ~31) + perm32(R & 31)) : R;
        RA[i] = R; CA[i] = C; voffB[i] = (unsigned)(Rb * K + C) * 2u; }
#define PG8_GMAP(dst, pm_) do { _Pragma("unroll") for (int h_ = 0; h_ < 2; ++h_) _Pragma("unroll") for (int i_ = 0; i_ < 2; ++i_) { int tk_ = rowtok[4 * ((pm_) * BM + h_ * HALF + RA[i_])]; tk_ = tk_ < 0 ? 0 : tk_; dst[h_][i_] = (unsigned)(tk_ * K + CA[i_]) * 2u; } } while (0)
    const size_t kstep = (size_t)(BK * 2);
    const size_t hstep = (size_t)HALF * K * 2;
    const size_t tstep = 2 * hstep;
    const unsigned ldsw = (unsigned)wid * 1024u;
    const int aoff = lds_byte(wr * 64 + fr, fq * 8), boff = lds_byte(wc * 32 + fr, fq * 8);
#define PG8_SA(b, h) (((b) * 2 + (h)) * HTB)
#define PG8_SB(b, h) ((4 + (b) * 2 + (h)) * HTB)
#define PG8_STAGE(bufoff, gbase, voff) do { _Pragma("unroll") for (int _i = 0; _i < 2; ++_i) \
        __builtin_amdgcn_global_load_lds((const unsigned*)((const char*)(gbase) + (voff)[_i]), (PG8_LAS unsigned*)(lds + (bufoff) + ldsw + _i * 8192), 16, 0, 0); } while (0)
#define PG8_LDA(dst, b, h) do { _Pragma("unroll") for (int m = 0; m < 4; ++m) _Pragma("unroll") for (int k = 0; k < 2; ++k) dst[m][k] = *(const PG8_LAS bf16x8*)(lds + PG8_SA(b, h) + aoff + m * 2048 + k * 1024); } while (0)
#define PG8_LDB(dst, b, h) do { _Pragma("unroll") for (int n = 0; n < 2; ++n) _Pragma("unroll") for (int k = 0; k < 2; ++k) dst[n][k] = *(const PG8_LAS bf16x8*)(lds + PG8_SB(b, h) + boff + n * 2048 + k * 1024); } while (0)
#define PG8_MMA(ai, bj, At, Bt) do { __builtin_amdgcn_s_setprio(1); _Pragma("unroll") for (int m = 0; m < 4; ++m) _Pragma("unroll") for (int n = 0; n < 2; ++n) _Pragma("unroll") for (int k = 0; k < 2; ++k) \
        acc[ai][bj][m][n] = __builtin_amdgcn_mfma_f32_16x16x32_bf16(Bt[n][k], At[m][k], acc[ai][bj][m][n], 0, 0, 0); __builtin_amdgcn_s_setprio(0); } while (0)
#define PG8_WAIT_V(n) asm volatile("s_waitcnt vmcnt(" #n ")" ::: "memory")
#define PG8_WAIT_L(n) asm volatile("s_waitcnt lgkmcnt(" #n ")" ::: "memory")
#define PG8_BAR __builtin_amdgcn_s_barrier()
#define PG8_SCHED __builtin_amdgcn_sched_barrier(0)
    Unit cur, nxt; int ui = 0;
    if (!S.next(0, cur)) return;
    f32x4 acc[2][2][4][2];
#pragma unroll
    for (int a = 0; a < 2; ++a)
#pragma unroll
        for (int b = 0; b < 2; ++b)
#pragma unroll
            for (int m = 0; m < 4; ++m)
#pragma unroll
                for (int n = 0; n < 2; ++n) acc[a][b][m][n] = (f32x4){0.f, 0.f, 0.f, 0.f};
    bf16x8 At[4][2], B0[2][2], B1[2][2];
    const char* cA = (const char*)g.A; const char* cB = (const char*)g.Bt + (size_t)cur.pn * tstep;
    PG8_GMAP(vcur, cur.pm);
    S.a_ready(cur);
    if constexpr (SP2) {
        PG8_STAGE(PG8_SB(0, 0), cB, voffB); PG8_STAGE(PG8_SB(0, 1), cB + hstep, voffB); PG8_STAGE(PG8_SA(0, 0), cA, vcur[0]); PG8_STAGE(PG8_SA(0, 1), cA, vcur[1]);
        if (wr == 1) PG8_BAR;
        PG8_WAIT_V(2); PG8_BAR;
        PG8_STAGE(PG8_SB(1, 0), cB + kstep, voffB); PG8_STAGE(PG8_SA(1, 0), cA + kstep, vcur[0]); PG8_STAGE(PG8_SB(1, 1), cB + hstep + kstep, voffB);
        PG8_WAIT_V(6); PG8_BAR;
    } else {
        PG8_STAGE(PG8_SB(0, 0), cB, voffB); PG8_STAGE(PG8_SA(0, 0), cA, voffA); PG8_STAGE(PG8_SB(0, 1), cB + hstep, voffB); PG8_STAGE(PG8_SA(0, 1), cA + hstep, voffA);
        if (wr == 1) PG8_BAR;
        PG8_WAIT_V(4); PG8_BAR;
        PG8_STAGE(PG8_SB(1, 0), cB + kstep, voffB); PG8_STAGE(PG8_SA(1, 0), cA + kstep, voffA); PG8_STAGE(PG8_SB(1, 1), cB + hstep + kstep, voffB);
        PG8_WAIT_V(6); PG8_BAR;
    }
    for (;;) {
        const bool has_next = S.next(ui + 1, nxt);
        const char* nA = cA; const char* nB = has_next ? (const char*)g.Bt + (size_t)nxt.pn * tstep : cB;
        if (has_next) PG8_GMAP(vnxt, nxt.pm); else { vnxt[0][0] = vcur[0][0]; vnxt[0][1] = vcur[0][1]; vnxt[1][0] = vcur[1][0]; vnxt[1][1] = vcur[1][1]; }
        for (int t = 0; t < nt; t += 2) {
            const bool last = (t == nt - 2);
            const char* a1 = cA + (size_t)(t + 1) * kstep;
            const char* a2 = last ? nA : cA + (size_t)(t + 2) * kstep; unsigned v2[2][2]; v2[0][0] = last ? vnxt[0][0] : vcur[0][0]; v2[0][1] = last ? vnxt[0][1] : vcur[0][1]; v2[1][0] = last ? vnxt[1][0] : vcur[1][0]; v2[1][1] = last ? vnxt[1][1] : vcur[1][1]; const char* b2 = last ? nB : cB + (size_t)(t + 2) * kstep;
            const char* a3 = a2 + kstep; const char* b3 = b2 + kstep;
            if (last && has_next) S.a_ready(nxt);
            if constexpr (SP2) {
            PG8_LDB(B0, 0, 0); PG8_LDB(B1, 0, 1); PG8_SCHED; PG8_LDA(At, 0, 0); PG8_STAGE(PG8_SA(1, 1), a1, vcur[1]);
            PG8_WAIT_V(8); PG8_WAIT_L(0); PG8_BAR; PG8_MMA(0, 0, At, B0); PG8_MMA(0, 1, At, B1); PG8_BAR; PG8_SCHED;
            PG8_LDA(At, 0, 1); PG8_STAGE(PG8_SB(0, 0), b2, voffB); PG8_STAGE(PG8_SB(0, 1), b2 + hstep, voffB); PG8_STAGE(PG8_SA(0, 0), a2, v2[0]);
            PG8_WAIT_V(8); PG8_WAIT_L(0); PG8_BAR; PG8_MMA(1, 0, At, B0); PG8_MMA(1, 1, At, B1); PG8_BAR; PG8_SCHED;
            PG8_LDB(B0, 1, 0); PG8_LDB(B1, 1, 1); PG8_SCHED; PG8_LDA(At, 1, 0); PG8_STAGE(PG8_SA(0, 1), a2, v2[1]);
            PG8_WAIT_V(8); PG8_WAIT_L(0); PG8_BAR; PG8_MMA(0, 0, At, B0); PG8_MMA(0, 1, At, B1); PG8_BAR; PG8_SCHED;
            PG8_LDA(At, 1, 1); PG8_STAGE(PG8_SB(1, 0), b3, voffB); PG8_STAGE(PG8_SB(1, 1), b3 + hstep, voffB); PG8_STAGE(PG8_SA(1, 0), a3, v2[0]);
            PG8_WAIT_V(8); PG8_WAIT_L(0); PG8_BAR; PG8_MMA(1, 0, At, B0); PG8_MMA(1, 1, At, B1); PG8_BAR; PG8_SCHED;
            } else {
            PG8_LDB(B0, 0, 0); PG8_SCHED; PG8_LDA(At, 0, 0); PG8_STAGE(PG8_SA(1, 1), a1 + hstep, voffA);
            PG8_WAIT_L(8); PG8_BAR; PG8_WAIT_L(0); PG8_MMA(0, 0, At, B0); PG8_BAR; PG8_SCHED;
            PG8_LDB(B1, 0, 1); PG8_STAGE(PG8_SB(0, 0), b2, voffB);
            PG8_BAR; PG8_WAIT_L(0); PG8_MMA(0, 1, At, B1); PG8_BAR;
            PG8_LDA(At, 0, 1); PG8_STAGE(PG8_SA(0, 0), a2, voffA);
            PG8_BAR; PG8_WAIT_L(0); PG8_MMA(1, 0, At, B0); PG8_BAR; PG8_SCHED;
            PG8_STAGE(PG8_SB(0, 1), b2 + hstep, voffB);
            PG8_WAIT_V(6); PG8_BAR; PG8_MMA(1, 1, At, B1); PG8_BAR;
            PG8_LDB(B0, 1, 0); PG8_SCHED; PG8_LDA(At, 1, 0); PG8_STAGE(PG8_SA(0, 1), a2 + hstep, voffA);
            PG8_WAIT_L(8); PG8_BAR; PG8_WAIT_L(0); PG8_MMA(0, 0, At, B0); PG8_BAR; PG8_SCHED;
            PG8_LDB(B1, 1, 1); PG8_STAGE(PG8_SB(1, 0), b3, voffB);
            PG8_BAR; PG8_WAIT_L(0); PG8_MMA(0, 1, At, B1); PG8_BAR;
            PG8_LDA(At, 1, 1); PG8_STAGE(PG8_SA(1, 0), a3, voffA);
            PG8_BAR; PG8_WAIT_L(0); PG8_MMA(1, 0, At, B0); PG8_BAR; PG8_SCHED;
            PG8_STAGE(PG8_SB(1, 1), b3 + hstep, voffB);
            PG8_WAIT_V(6); PG8_BAR; PG8_MMA(1, 1, At, B1); PG8_BAR;
            }
        }
        if constexpr (ALIGN_EPI) { if (wr == 0) PG8_BAR; }
        if constexpr (!Epi::AFTER_DRAIN) { E(acc, cur, wr, wc, fr, fq); S.done(cur); }
        if (!has_next) break;
#pragma unroll
        for (int a = 0; a < 2; ++a)
#pragma unroll
            for (int b = 0; b < 2; ++b)
#pragma unroll
                for (int m = 0; m < 4; ++m)
#pragma unroll
                    for (int n = 0; n < 2; ++n) acc[a][b][m][n] = (f32x4){0.f, 0.f, 0.f, 0.f};
        cur = nxt; cA = nA; cB = nB; ++ui; vcur[0][0] = vnxt[0][0]; vcur[0][1] = vnxt[0][1]; vcur[1][0] = vnxt[1][0]; vcur[1][1] = vnxt[1][1];
        if constexpr (ALIGN_EPI) { if (wr == 1) PG8_BAR; }
    }
    PG8_WAIT_V(0);
    if constexpr (!ALIGN_EPI) { if (wr == 0) PG8_BAR; }
    PG8_BAR;
    if constexpr (Epi::AFTER_DRAIN) { E.fused(acc, cur, wr, wc, fr, fq, lds, wid, lane); S.done(cur); }
#undef PG8_GMAP
#undef PG8_SA
#undef PG8_SB
#undef PG8_STAGE
#undef PG8_LDA
#undef PG8_LDB
#undef PG8_MMA
#undef PG8_WAIT_V
#undef PG8_WAIT_L
#undef PG8_BAR
#undef PG8_SCHED
}

}

#define DI __device__ __forceinline__
#define LAS __attribute__((address_space(3)))
typedef unsigned short bf16_t;
typedef short bf16x8 __attribute__((ext_vector_type(8)));
typedef _Float16 f16x8 __attribute__((ext_vector_type(8)));
typedef float f32x4 __attribute__((ext_vector_type(4)));
typedef float f32x16 __attribute__((ext_vector_type(16)));
typedef unsigned u32x4 __attribute__((ext_vector_type(4)));
typedef unsigned u32x2 __attribute__((ext_vector_type(2)));

constexpr int NB = 4, SEQ = 4096, T = NB * SEQ, D = 1024, DEPTH = 2;
constexpr int PLD = 3912;
constexpr int PC_Q = 0, PC_K = 512, PC_V = 1024, PC_QI = 1536, PC_KI = 2048, PC_WI = 2112;
constexpr int PC_R = 2120, PC_BK = 2632, PC_BV = 3144, PC_WD = 3656;
constexpr int NPROJ_PAD = 4096;
constexpr int NEXP = 16, DEXP = 256, PLE = 256;
constexpr float ALPHA = 1.4142135623730951f;
constexpr float LN_EPS = 1e-5f, GN_EPS = 64e-5f;
constexpr int MAXROWS = 2 * T + NEXP * 256;
constexpr int NWAVES = 8, NTHR = 512;

constexpr size_t MiB = 1u << 20;
constexpr size_t WS_CTL = 0, CTL_BYTES = 1 * MiB;
constexpr size_t WS_WEXP = 1 * MiB;
constexpr size_t WS_WDOWN = 17 * MiB;
constexpr size_t WS_WOUT = 25 * MiB, WS_WPG = 27 * MiB, WS_WPLE = 29 * MiB;
constexpr size_t WS_BM = 30 * MiB;
constexpr size_t WS_ELL = 38 * MiB, WS_AA = 70 * MiB, WS_GG = 102 * MiB;
constexpr size_t WS_PROJ = 119 * MiB;
constexpr size_t WS_PBF = 242 * MiB;
constexpr size_t WS_V = 119 * MiB;
constexpr size_t WS_AG = 38 * MiB;
constexpr size_t WS_H = 183 * MiB;
constexpr size_t WS_Y = 119 * MiB;
constexpr size_t WS_PE = 201 * MiB;
constexpr size_t WS_V3 = 38 * MiB;
constexpr size_t WS_TOK = 233 * MiB;
constexpr size_t WS_ROW = 234 * MiB;
constexpr int CW_GCNT = 1024;

struct TokInfo { int e0, e1, p0, p1; float g0, g1; int pad0, pad1; };
struct RowInfo { int token, slot; float gate; int pad; };

#define LDS_WAIT() asm volatile("s_waitcnt lgkmcnt(0)" ::: "memory")
#define VM_WAIT() asm volatile("s_waitcnt vmcnt(0)" ::: "memory")
DI unsigned f2bf(float f) { unsigned u = __builtin_bit_cast(unsigned, f); return (u + 0x7fffu + ((u >> 16) & 1u)) >> 16; }
DI unsigned pk2(float lo, float hi) { return pg8::cvt_pk_bf16(lo, hi); }
DI float bf2f(unsigned short b) { return __builtin_bit_cast(float, (unsigned)b << 16); }
DI float bflo(unsigned w) { return __builtin_bit_cast(float, w << 16); }
DI float bfhi(unsigned w) { return __builtin_bit_cast(float, w & 0xffff0000u); }
DI unsigned pk2h(float lo, float hi) { typedef _Float16 h2_t __attribute__((ext_vector_type(2))); h2_t v = {(_Float16)lo, (_Float16)hi}; return __builtin_bit_cast(unsigned, v); }
DI float wave_sum(float v) {
#pragma unroll
    for (int o = 1; o < 64; o <<= 1) v += __shfl_xor(v, o);
    return v;
}
DI int opaque_i(int v) { asm volatile("" : "+s"(v)); return v; }
DI float sigmoidf_(float x) { return 1.f / (1.f + __expf(-x)); }

struct Args { const float* in[31]; float* out; unsigned char* ws; int ph_lo, ph_hi; };
struct Ctx {
    LAS unsigned char* lds;
    int tid, lane, wave, G, blk;
    const __attribute__((address_space(4))) Args* ap;
    float* out; unsigned char* ws;
    unsigned* ctl;
    bf16_t* xcur; bf16_t* mixcat;
    DI const float* in(int i) const { return ap->in[i]; }
};

DI void ln16(f32x4 (&v)[4], const float* g, const float* b, int lane) {
    float s = 0.f;
#pragma unroll
    for (int j = 0; j < 4; ++j) s += (v[j].x + v[j].y) + (v[j].z + v[j].w);
    const float mean = wave_sum(s) * (1.f / D);
    float s2 = 0.f;
#pragma unroll
    for (int j = 0; j < 4; ++j) { v[j] = v[j] - mean; s2 += (v[j].x * v[j].x + v[j].y * v[j].y) + (v[j].z * v[j].z + v[j].w * v[j].w); }
    const float rstd = 1.f / sqrtf(wave_sum(s2) * (1.f / D) + LN_EPS);
#pragma unroll
    for (int j = 0; j < 4; ++j) { const f32x4 gg = *(const f32x4*)(g + 256 * j + 4 * lane), bb = *(const f32x4*)(b + 256 * j + 4 * lane); v[j] = v[j] * rstd * gg + bb; }
}
DI void store_row_bf16(bf16_t* row, const f32x4 (&v)[4], int lane) {
#pragma unroll
    for (int j = 0; j < 4; ++j) { u32x2 o; o.x = pk2(v[j].x, v[j].y); o.y = pk2(v[j].z, v[j].w); *(u32x2*)(row + 256 * j + 4 * lane) = o; }
}
DI void load_row_bf16(const bf16_t* row, f32x4 (&v)[4], int lane) {
#pragma unroll
    for (int j = 0; j < 4; ++j) { const u32x2 o = *(const u32x2*)(row + 256 * j + 4 * lane); v[j] = (f32x4){bflo(o.x), bfhi(o.x), bflo(o.y), bfhi(o.y)}; }
}

template <class ColPtr>
DI void transpose_item(const ColPtr colptr, int ld, int K, bf16_t* WT, int n0, int k0, LAS float* scr, int lane) {
    const float* sp = colptr(n0 + (lane & 31));
    float tv[32];
#pragma unroll
    for (int i = 0; i < 32; ++i) { const int kk = 2 * i + (lane >> 5); tv[i] = sp ? sp[(size_t)(k0 + kk) * ld] : 0.f; }
#pragma unroll
    for (int i = 0; i < 32; ++i) { const int kk = 2 * i + (lane >> 5); scr[kk * 33 + (lane & 31)] = tv[i]; }
    LDS_WAIT(); asm volatile("" ::: "memory");
    const int c = lane & 7;
#pragma unroll
    for (int j = 0; j < 4; ++j) { const int n = (lane >> 3) + 8 * j; const LAS float* s = scr + (8 * c) * 33 + n;
        u32x4 o; o.x = pk2(s[0 * 33], s[1 * 33]); o.y = pk2(s[2 * 33], s[3 * 33]); o.z = pk2(s[4 * 33], s[5 * 33]); o.w = pk2(s[6 * 33], s[7 * 33]);
        *(u32x4*)(WT + (size_t)(n0 + n) * K + k0 + 8 * c) = o; }
    LDS_WAIT(); asm volatile("" ::: "memory");
}
template <class ColPtr>
DI void convert_matrix(Ctx& C, const ColPtr colptr, int ld, int K, int N, bf16_t* WT, int& first) {
    LAS float* scr = (LAS float*)(C.lds + C.wave * 16384);
    const int gw = C.blk * NWAVES + C.wave, NGW = C.G * NWAVES;
    const int nblk = N / 32, nitems = (K / 64) * nblk;
    int it = gw - (first % NGW); if (it < 0) it += NGW;
    for (; it < nitems; it += NGW) transpose_item(colptr, ld, K, WT, 32 * (it % nblk), 64 * (it / nblk), scr, C.lane);
    first += nitems;
}

struct ColWin { const float* w; DI const float* operator()(int j) const { if (j < 2120) return w + j; if (j >= 2176 && j < 3968) return w + (j - 56); return nullptr; } };
struct ColPlain { const float* w; DI const float* operator()(int j) const { return w + j; } };
struct ColGateUp { const float* wg; const float* wu; DI const float* operator()(int j) const {
        const int e = j >> 9, pn = (j >> 8) & 1, jj = j & 255; const int col = pn * 128 + (jj & 127); const uintptr_t pg = (uintptr_t)wg, pu = (uintptr_t)wu; const uintptr_t sel = pg + ((jj >= 128) ? (pu - pg) : (uintptr_t)0); return (const float*)sel + (size_t)e * D * DEXP + col; } };
struct ColDown { const float* wd; DI const float* operator()(int j) const { return wd + j; } };

DI void phase_ln_in(Ctx& C) {
    const int gw = C.blk * NWAVES + C.wave, NGW = C.G * NWAVES;
    for (int m = gw; m < T; m += NGW) {
        f32x4 v[4]; const float* xr = C.in(0) + (size_t)m * D;
#pragma unroll
        for (int j = 0; j < 4; ++j) v[j] = *(const f32x4*)(xr + 256 * j + 4 * C.lane);
        ln16(v, C.in(2), C.in(3), C.lane);
        store_row_bf16(C.xcur + (size_t)m * D, v, C.lane);
    }
}
DI void convert_win(Ctx& C, int l) { int first = 0; ColWin cw{C.in(4) + (size_t)l * D * 3912}; convert_matrix(C, cw, 3912, D, NPROJ_PAD, (bf16_t*)(C.ws + WS_WEXP), first); }
DI void convert_layer_weights(Ctx& C, int l) {
    int first = 0;
    { ColPlain c{C.in(5) + (size_t)l * D * D}; convert_matrix(C, c, D, D, D, (bf16_t*)(C.ws + WS_WOUT), first); }
    { ColGateUp c{C.in(20) + (size_t)l * NEXP * D * DEXP, C.in(21) + (size_t)l * NEXP * D * DEXP}; convert_matrix(C, c, DEXP, D, NEXP * 512, (bf16_t*)(C.ws + WS_WEXP), first); }
    for (int e = 0; e < NEXP; ++e) { ColDown c{C.in(22) + ((size_t)l * NEXP + e) * DEXP * D}; convert_matrix(C, c, D, DEXP, D, (bf16_t*)(C.ws + WS_WDOWN) + (size_t)e * D * DEXP, first); }
    { ColPlain c{C.in(24) + (size_t)l * D * D}; convert_matrix(C, c, D, D, D, (bf16_t*)(C.ws + WS_WPG), first); }
    { ColPlain c{C.in(23) + (size_t)l * PLE * D}; convert_matrix(C, c, D, PLE, D, (bf16_t*)(C.ws + WS_WPLE), first); }
    const float* p = C.in(1) + (size_t)l * T * PLE; bf16_t* pb = (bf16_t*)(C.ws + WS_PBF);
    for (size_t i = ((size_t)C.blk * NTHR + C.tid) * 8; i < (size_t)T * PLE; i += (size_t)C.G * NTHR * 8) {
        const f32x4 a = *(const f32x4*)(p + i), b = *(const f32x4*)(p + i + 4);
        u32x4 o; o.x = pk2(a.x, a.y); o.y = pk2(a.z, a.w); o.z = pk2(b.x, b.y); o.w = pk2(b.z, b.w); *(u32x4*)(pb + i) = o; }
}

struct EpiProj {
    static constexpr bool PERM = true, AFTER_DRAIN = false;
    bf16_t* P;
    DI void operator()(const f32x4 (&acc)[2][2][4][2], const pg8::Unit& u, int wr, int wc, int fr, int fq) const {
        const int row0 = u.pm * 256 + wr * 64 + fr;
#pragma unroll
        for (int bj = 0; bj < 2; ++bj) {
            const int j0 = u.pn * 256 + bj * 128 + wc * 32 + 8 * fq;
            int dst; bool half = false;
            if (j0 < 2120) { dst = j0; half = (j0 >= 1536); } else if (j0 >= 2176 && j0 < 3968) dst = j0 - 56; else dst = -1;
            if (dst >= 0) {
#pragma unroll
                for (int ai = 0; ai < 2; ++ai)
#pragma unroll
                    for (int m = 0; m < 4; ++m) {
                        const f32x4 v0 = acc[ai][bj][m][0], v1 = acc[ai][bj][m][1]; u32x4 w;
                        if (half) { w.x = pk2h(v0[0], v0[1]); w.y = pk2h(v0[2], v0[3]); w.z = pk2h(v1[0], v1[1]); w.w = pk2h(v1[2], v1[3]); }
                        else { w.x = pk2(v0[0], v0[1]); w.y = pk2(v0[2], v0[3]); w.z = pk2(v1[0], v1[1]); w.w = pk2(v1[2], v1[3]); }
                        *(u32x4*)(P + (size_t)(row0 + ai * 128 + m * 16) * PLD + dst) = w; }
            }
        }
    }
};
struct EpiBf16Plain {
    static constexpr bool PERM = true, AFTER_DRAIN = false;
    bf16_t* O; int ldc;
    DI void operator()(const f32x4 (&acc)[2][2][4][2], const pg8::Unit& u, int wr, int wc, int fr, int fq) const {
        const int row0 = u.pm * 256 + wr * 64 + fr, col0 = u.pn * 256 + wc * 32 + 8 * fq;
#pragma unroll
        for (int ai = 0; ai < 2; ++ai)
#pragma unroll
            for (int m = 0; m < 4; ++m)
#pragma unroll
                for (int bj = 0; bj < 2; ++bj) { const f32x4 v0 = acc[ai][bj][m][0], v1 = acc[ai][bj][m][1]; u32x4 w; w.x = pk2(v0[0], v0[1]); w.y = pk2(v0[2], v0[3]); w.z = pk2(v1[0], v1[1]); w.w = pk2(v1[2], v1[3]);
                    *(u32x4*)(O + (size_t)(row0 + ai * 128 + m * 16) * ldc + col0 + bj * 128) = w; }
    }
};
struct EpiResF32 {
    static constexpr bool PERM = false, AFTER_DRAIN = false;
    const bf16_t* X; bf16_t* V;
    DI void operator()(const f32x4 (&acc)[2][2][4][2], const pg8::Unit& u, int wr, int wc, int fr, int fq) const {
        const int row0 = u.pm * 256 + wr * 64 + fr, col0 = u.pn * 256 + wc * 32 + 4 * fq;
#pragma unroll
        for (int ai = 0; ai < 2; ++ai)
#pragma unroll
            for (int m = 0; m < 4; ++m)
#pragma unroll
                for (int bj = 0; bj < 2; ++bj)
#pragma unroll
                    for (int n = 0; n < 2; ++n) { const size_t off = (size_t)(row0 + ai * 128 + m * 16) * D + col0 + bj * 128 + n * 16;
                        const u32x2 xb = *(const u32x2*)(X + off); const f32x4 xv = {bflo(xb.x), bfhi(xb.x), bflo(xb.y), bfhi(xb.y)};
                        const f32x4 o = xv * ALPHA + acc[ai][bj][m][n]; u32x2 ob; ob.x = pk2(o.x, o.y); ob.y = pk2(o.z, o.w); *(u32x2*)(V + off) = ob; }
    }
};
struct EpiPle {
    static constexpr bool PERM = false, AFTER_DRAIN = false;
    const bf16_t* X; const bf16_t* PE; bf16_t* V;
    DI void operator()(const f32x4 (&acc)[2][2][4][2], const pg8::Unit& u, int wr, int wc, int fr, int fq) const {
        const int row0 = u.pm * 256 + wr * 64 + fr, col0 = u.pn * 256 + wc * 32 + 4 * fq;
#pragma unroll
        for (int ai = 0; ai < 2; ++ai)
#pragma unroll
            for (int m = 0; m < 4; ++m)
#pragma unroll
                for (int bj = 0; bj < 2; ++bj)
#pragma unroll
                    for (int n = 0; n < 2; ++n) { const size_t off = (size_t)(row0 + ai * 128 + m * 16) * D + col0 + bj * 128 + n * 16;
                        const u32x2 xb = *(const u32x2*)(X + off); const f32x4 xv = {bflo(xb.x), bfhi(xb.x), bflo(xb.y), bfhi(xb.y)};
                        const u32x2 pb = *(const u32x2*)(PE + off); const f32x4 pv = {bflo(pb.x), bfhi(pb.x), bflo(pb.y), bfhi(pb.y)};
                        const f32x4 a = acc[ai][bj][m][n]; f32x4 s; s.x = sigmoidf_(a.x); s.y = sigmoidf_(a.y); s.z = sigmoidf_(a.z); s.w = sigmoidf_(a.w);
                        const f32x4 o = xv * ALPHA + s * pv; u32x2 ob; ob.x = pk2(o.x, o.y); ob.y = pk2(o.z, o.w); *(u32x2*)(V + off) = ob; }
    }
};
struct EpiSwiGLU {
    static constexpr bool PERM = true, AFTER_DRAIN = false;
    bf16_t* H; const RowInfo* R;
    DI void operator()(const f32x4 (&acc)[2][2][4][2], const pg8::Unit& u, int wr, int wc, int fr, int fq) const {
        const int row0 = u.pm * 256 + wr * 64 + fr, col0 = (u.pn & 1) * 128 + wc * 32 + 8 * fq;
#pragma unroll
        for (int ai = 0; ai < 2; ++ai)
#pragma unroll
            for (int m = 0; m < 4; ++m) { const int row = row0 + ai * 128 + m * 16; const float gw = R[row].gate;
                float h[8];
#pragma unroll
                for (int n = 0; n < 2; ++n)
#pragma unroll
                    for (int i = 0; i < 4; ++i) { const float g = acc[ai][0][m][n][i], up = acc[ai][1][m][n][i]; h[4 * n + i] = g * sigmoidf_(g) * up * gw; }
                u32x4 w; w.x = pk2(h[0], h[1]); w.y = pk2(h[2], h[3]); w.z = pk2(h[4], h[5]); w.w = pk2(h[6], h[7]);
                *(u32x4*)(H + (size_t)row * DEXP + col0) = w; }
    }
};
struct EpiDown {
    static constexpr bool PERM = true, AFTER_DRAIN = false;
    bf16_t* Y; const RowInfo* R;
    DI void operator()(const f32x4 (&acc)[2][2][4][2], const pg8::Unit& u, int wr, int wc, int fr, int fq) const {
        const int row0 = u.pm * 256 + wr * 64 + fr, col0 = (u.pn & 3) * 256 + wc * 32 + 8 * fq;
#pragma unroll
        for (int ai = 0; ai < 2; ++ai)
#pragma unroll
            for (int m = 0; m < 4; ++m) { const int row = row0 + ai * 128 + m * 16; const RowInfo ri = R[row];
                if (ri.token >= 0) { bf16_t* dst = Y + ((size_t)ri.slot * T + ri.token) * D + col0;
#pragma unroll
                    for (int bj = 0; bj < 2; ++bj) { const f32x4 v0 = acc[ai][bj][m][0], v1 = acc[ai][bj][m][1]; u32x4 w; w.x = pk2(v0[0], v0[1]); w.y = pk2(v0[2], v0[3]); w.z = pk2(v1[0], v1[1]); w.w = pk2(v1[2], v1[3]);
                        *(u32x4*)(dst + bj * 128) = w; } } }
    }
};
template <int NPN> struct GroupedOrder {
    const LAS int* texp; int ntiles, G, c;
    DI bool next(int i, pg8::Unit& u) const { const int L = i * G + c; if (L >= ntiles * NPN) return false; u.pm = L / NPN; u.pn = texp[u.pm] * NPN + (L % NPN); return true; }
    DI void a_ready(const pg8::Unit&) const {}
    DI void done(const pg8::Unit&) const {}
};

constexpr int IDX_CAP = 512;
DI unsigned ordkey(float s) { const unsigned b = __builtin_bit_cast(unsigned, s); return (b & 0x80000000u) ? ~b : (b | 0x80000000u); }
DI float unordkey(unsigned k) { const unsigned b = (k & 0x80000000u) ? (k & 0x7fffffffu) : ~k; return __builtin_bit_cast(float, b); }

DI void idx_item(Ctx& C, int item, int l) {
    const int b = item & 3, qt = 511 - (item >> 2);
    const int t0 = qt * 8, chunk = t0 >> 6, NT32 = 2 * (chunk + 1);
    const size_t tok0 = (size_t)b * SEQ + t0;
    unsigned* bm = (unsigned*)(C.ws + WS_BM);
    const int lane = C.lane, wave = C.wave, tid = C.tid;
    if (chunk < 4) {
        if (tid < 8 * NT32) { const int q = tid / NT32, kt = tid % NT32; bm[(tok0 + q) * 128 + kt] = 0xffffffffu; }
        return;
    }
    const _Float16* ph = (const _Float16*)(C.ws + WS_PROJ);
    LAS unsigned* hist = (LAS unsigned*)(C.lds);
    LAS float* candS = (LAS float*)(C.lds + 8192);
    LAS int* candI = (LAS int*)(C.lds + 24576);
    LAS float* redmn = (LAS float*)(C.lds + 40960);
    LAS float* redmx = redmn + 64;
    LAS int* selB = (LAS int*)(C.lds + 41472);
    LAS unsigned* selAbove = (LAS unsigned*)(selB + 8);
    LAS unsigned* ccount = selAbove + 8;
    LAS float* thrS = (LAS float*)(ccount + 8);
    LAS int* thrI = (LAS int*)(thrS + 8);
    LAS unsigned* ovf = (LAS unsigned*)(thrI + 8);
    LAS unsigned* fbT = ovf + 8;
    LAS unsigned* fbCnt = fbT + 8;
    LAS unsigned* fbNeed = fbCnt + 8;
    const int r = lane & 31, hh = lane >> 5;
    float sc[2][16][2];
    f16x8 afr[2][4]; float wq[2][2][8];
#pragma unroll
    for (int m = 0; m < 2; ++m) {
        const int gq = (r >> 2) & 1, i = r >> 3, jj = r & 3, query = 4 * m + 2 * gq + (i >> 1), head = 4 * (i & 1) + jj;
        const _Float16* qp = ph + (tok0 + query) * PLD + PC_QI + head * 64 + 8 * hh;
#pragma unroll
        for (int s = 0; s < 4; ++s) afr[m][s] = *(const f16x8*)(qp + 16 * s);
#pragma unroll
        for (int qq = 0; qq < 2; ++qq) { const int q2 = 4 * m + 2 * hh + qq; const f16x8 wv = *(const f16x8*)(ph + (tok0 + q2) * PLD + PC_WI);
#pragma unroll
            for (int e = 0; e < 8; ++e) wq[m][qq][e] = (float)wv[e] * 0.044194173824159216f; }
    }
    const _Float16* kbase = ph + ((size_t)b * SEQ + r) * PLD + PC_KI + 8 * hh;
    f16x8 bnx[4];
#pragma unroll
    for (int s = 0; s < 4; ++s) bnx[s] = *(const f16x8*)(kbase + (size_t)(32 * wave) * PLD + 16 * s);
#pragma unroll
    for (int it = 0; it < 16; ++it) {
        const int kt = wave + 8 * it;
        if (kt < NT32) {
            f16x8 bfr[4];
#pragma unroll
            for (int s = 0; s < 4; ++s) bfr[s] = bnx[s];
            if (kt + 8 < NT32) {
#pragma unroll
                for (int s = 0; s < 4; ++s) bnx[s] = *(const f16x8*)(kbase + (size_t)(32 * (kt + 8)) * PLD + 16 * s); }
#pragma unroll
            for (int m = 0; m < 2; ++m) {
                f32x16 c = {};
#pragma unroll
                for (int s = 0; s < 4; ++s) c = __builtin_amdgcn_mfma_f32_32x32x16_f16(afr[m][s], bfr[s], c, 0, 0, 0);
#pragma unroll
                for (int qq = 0; qq < 2; ++qq) { float a = 0.f;
#pragma unroll
                    for (int e = 0; e < 8; ++e) a += wq[m][qq][e] * fmaxf(c[8 * qq + e], 0.f);
                    sc[m][it][qq] = a; }
            }
        } else { sc[0][it][0] = 0.f; sc[0][it][1] = 0.f; sc[1][it][0] = 0.f; sc[1][it][1] = 0.f; }
    }
    float mn[2][2], mx[2][2];
#pragma unroll
    for (int m = 0; m < 2; ++m)
#pragma unroll
        for (int qq = 0; qq < 2; ++qq) { float a = 3.0e38f, z = -3.0e38f;
#pragma unroll
            for (int it = 0; it < 16; ++it) if (wave + 8 * it < NT32) z = fmaxf(z, sc[m][it][qq]);
            a = z;
#pragma unroll
            for (int o = 1; o < 32; o <<= 1) { a = fminf(a, __shfl_xor(a, o)); z = fmaxf(z, __shfl_xor(z, o)); }
            mn[m][qq] = a; mx[m][qq] = z; }
    asm volatile("s_waitcnt lgkmcnt(0)\n\ts_barrier" ::: "memory");
    if (r == 0) {
#pragma unroll
        for (int m = 0; m < 2; ++m)
#pragma unroll
            for (int qq = 0; qq < 2; ++qq) { const int qid = 4 * m + 2 * hh + qq; redmn[wave * 8 + qid] = mn[m][qq]; redmx[wave * 8 + qid] = mx[m][qq]; }
    }
    for (int i = tid; i < 2048; i += NTHR) hist[i] = 0u;
    if (tid < 8) { ccount[tid] = 0u; ovf[tid] = 0u; }
    asm volatile("s_waitcnt lgkmcnt(0)\n\ts_barrier" ::: "memory");
    float lo[2][2], scl[2][2];
#pragma unroll
    for (int m = 0; m < 2; ++m)
#pragma unroll
        for (int qq = 0; qq < 2; ++qq) { const int qid = 4 * m + 2 * hh + qq; float a = 3.0e38f, z = -3.0e38f;
#pragma unroll
            for (int w = 0; w < 8; ++w) { a = fminf(a, redmn[w * 8 + qid]); z = fmaxf(z, redmx[w * 8 + qid]); }
            lo[m][qq] = a; scl[m][qq] = (z > a) ? 256.f / (z - a) : 0.f; }
#define IDX_BIN(m, it, qq) ((sc[m][it][qq] >= lo[m][qq]) ? min(255, (int)((sc[m][it][qq] - lo[m][qq]) * scl[m][qq])) : -1)
#define IDX_LAUNDER() do { _Pragma("unroll") for (int m_ = 0; m_ < 2; ++m_) _Pragma("unroll") for (int q_ = 0; q_ < 2; ++q_) { asm volatile("" : "+v"(lo[m_][q_]), "+v"(scl[m_][q_])); } } while (0)
#pragma unroll
    for (int m = 0; m < 2; ++m)
#pragma unroll
        for (int qq = 0; qq < 2; ++qq) { const int qid = 4 * m + 2 * hh + qq;
#pragma unroll
            for (int it = 0; it < 16; ++it) if (wave + 8 * it < NT32) { const int bin_ = IDX_BIN(m, it, qq); if (bin_ >= 0) __hip_atomic_fetch_add(hist + qid * 256 + bin_, 1u, __ATOMIC_RELAXED, __HIP_MEMORY_SCOPE_WORKGROUP); } }
    asm volatile("s_waitcnt lgkmcnt(0)\n\ts_barrier" ::: "memory");
    {
        const u32x4 h4 = *(const LAS u32x4*)(hist + wave * 256 + 4 * lane);
        const unsigned tot = h4.x + h4.y + h4.z + h4.w; unsigned incl = tot;
#pragma unroll
        for (int o = 1; o < 64; o <<= 1) { const unsigned v = __shfl_down(incl, o); if (lane + o < 64) incl += v; }
        unsigned run = incl - tot; int Bf = -1; unsigned ab = 0;
#pragma unroll
        for (int j = 3; j >= 0; --j) { const unsigned h = h4[j]; if (run < 256u && run + h >= 256u) { Bf = 4 * lane + j; ab = run; } run += h; }
        if (Bf >= 0) { selB[wave] = Bf; selAbove[wave] = ab; }
    }
    asm volatile("s_waitcnt lgkmcnt(0)\n\ts_barrier" ::: "memory");
    IDX_LAUNDER();
#pragma unroll
    for (int m = 0; m < 2; ++m)
#pragma unroll
        for (int qq = 0; qq < 2; ++qq) { const int qid = 4 * m + 2 * hh + qq; const int B = selB[qid];
#pragma unroll
            for (int it = 0; it < 16; ++it) if (wave + 8 * it < NT32) { const bool hit = (IDX_BIN(m, it, qq) == B); if (__any(hit)) { if (hit) { const unsigned pos = __hip_atomic_fetch_add(ccount + qid, 1u, __ATOMIC_RELAXED, __HIP_MEMORY_SCOPE_WORKGROUP);
                if (pos < (unsigned)IDX_CAP) { candS[qid * IDX_CAP + pos] = sc[m][it][qq]; candI[qid * IDX_CAP + pos] = 32 * (wave + 8 * it) + r; } } } } }
    asm volatile("s_waitcnt lgkmcnt(0)\n\ts_barrier" ::: "memory");
    {
        const int c = (int)ccount[wave]; const int need = 256 - (int)selAbove[wave];
        if (c <= IDX_CAP) {
            for (int i = lane; i < c; i += 64) { const float si = candS[wave * IDX_CAP + i]; const int ii = candI[wave * IDX_CAP + i]; int rank = 0;
                for (int j = 0; j < c; ++j) { const float sj = candS[wave * IDX_CAP + j]; const int ij = candI[wave * IDX_CAP + j]; rank += ((sj > si) || (sj == si && ij < ii)) ? 1 : 0; }
                if (rank == need - 1) { thrS[wave] = si; thrI[wave] = ii; } }
        } else if (lane == 0) { ovf[wave] = 1u; fbNeed[wave] = (unsigned)need; fbT[wave] = 0u; }
    }
    asm volatile("s_waitcnt lgkmcnt(0)\n\ts_barrier" ::: "memory");
    unsigned anyovf = 0u;
#pragma unroll
    for (int q = 0; q < 8; ++q) anyovf |= ovf[q];
    if (anyovf) {
        for (int bit = 31; bit >= 0; --bit) {
            if (tid < 8) fbCnt[tid] = 0u;
            asm volatile("s_waitcnt lgkmcnt(0)\n\ts_barrier" ::: "memory");
            IDX_LAUNDER();
#pragma unroll
            for (int m = 0; m < 2; ++m)
#pragma unroll
                for (int qq = 0; qq < 2; ++qq) { const int qid = 4 * m + 2 * hh + qq; if (ovf[qid]) { const unsigned cand = fbT[qid] | (1u << bit); const int B = selB[qid]; unsigned cnt = 0;
#pragma unroll
                    for (int it = 0; it < 16; ++it) if (wave + 8 * it < NT32) cnt += (IDX_BIN(m, it, qq) == B && ordkey(sc[m][it][qq]) >= cand) ? 1u : 0u;
                    if (cnt) __hip_atomic_fetch_add(fbCnt + qid, cnt, __ATOMIC_RELAXED, __HIP_MEMORY_SCOPE_WORKGROUP); } }
            asm volatile("s_waitcnt lgkmcnt(0)\n\ts_barrier" ::: "memory");
            if (tid < 8 && ovf[tid] && fbCnt[tid] >= fbNeed[tid]) fbT[tid] |= (1u << bit);
            asm volatile("s_waitcnt lgkmcnt(0)\n\ts_barrier" ::: "memory");
        }
        if (tid < 8) fbCnt[tid] = 0u;
        asm volatile("s_waitcnt lgkmcnt(0)\n\ts_barrier" ::: "memory");
        IDX_LAUNDER();
#pragma unroll
        for (int m = 0; m < 2; ++m)
#pragma unroll
            for (int qq = 0; qq < 2; ++qq) { const int qid = 4 * m + 2 * hh + qq; if (ovf[qid]) { const unsigned Tk = fbT[qid]; const int B = selB[qid]; unsigned cnt = 0;
#pragma unroll
                for (int it = 0; it < 16; ++it) if (wave + 8 * it < NT32) cnt += (IDX_BIN(m, it, qq) == B && ordkey(sc[m][it][qq]) > Tk) ? 1u : 0u;
                if (cnt) __hip_atomic_fetch_add(fbCnt + qid, cnt, __ATOMIC_RELAXED, __HIP_MEMORY_SCOPE_WORKGROUP); } }
        asm volatile("s_waitcnt lgkmcnt(0)\n\ts_barrier" ::: "memory");
        if (tid < 8 && ovf[tid]) { fbNeed[tid] -= fbCnt[tid]; thrS[tid] = unordkey(fbT[tid]); thrI[tid] = 0; }
        asm volatile("s_waitcnt lgkmcnt(0)\n\ts_barrier" ::: "memory");
        for (int bit = 11; bit >= 0; --bit) {
            if (tid < 8) fbCnt[tid] = 0u;
            asm volatile("s_waitcnt lgkmcnt(0)\n\ts_barrier" ::: "memory");
            IDX_LAUNDER();
#pragma unroll
            for (int m = 0; m < 2; ++m)
#pragma unroll
                for (int qq = 0; qq < 2; ++qq) { const int qid = 4 * m + 2 * hh + qq; if (ovf[qid]) { const unsigned Tk = fbT[qid]; const int B = selB[qid]; const int cand = thrI[qid] | (1 << bit); unsigned cnt = 0;
#pragma unroll
                    for (int it = 0; it < 16; ++it) if (wave + 8 * it < NT32) cnt += (IDX_BIN(m, it, qq) == B && ordkey(sc[m][it][qq]) == Tk && (32 * (wave + 8 * it) + r) < cand) ? 1u : 0u;
                    if (cnt) __hip_atomic_fetch_add(fbCnt + qid, cnt, __ATOMIC_RELAXED, __HIP_MEMORY_SCOPE_WORKGROUP); } }
            asm volatile("s_waitcnt lgkmcnt(0)\n\ts_barrier" ::: "memory");
            if (tid < 8 && ovf[tid] && fbCnt[tid] < fbNeed[tid]) thrI[tid] |= (1 << bit);
            asm volatile("s_waitcnt lgkmcnt(0)\n\ts_barrier" ::: "memory");
        }
    }
    IDX_LAUNDER();
#pragma unroll
    for (int m = 0; m < 2; ++m)
#pragma unroll
        for (int qq = 0; qq < 2; ++qq) { const int qid = 4 * m + 2 * hh + qq; const int B = selB[qid]; const float ts = thrS[qid]; const int ti = thrI[qid];
            unsigned myw = 0u;
#pragma unroll
            for (int it = 0; it < 16; ++it) { const int kt = wave + 8 * it;
                if (kt < NT32) { const int bin = IDX_BIN(m, it, qq); const float s = sc[m][it][qq]; const int idx = 32 * kt + r;
                    const bool sel = (bin > B) || (bin == B && (s > ts || (s == ts && idx <= ti)));
                    const unsigned long long mk = __ballot(sel);
                    const unsigned wv = hh ? (unsigned)(mk >> 32) : (unsigned)mk;
                    if (r == it) myw = wv; } }
            if (r < 16 && wave + 8 * r < NT32) bm[(tok0 + qid) * 128 + wave + 8 * r] = myw; }
#undef IDX_BIN
#undef IDX_LAUNDER
}

DI float softplusf_(float z) { return fmaxf(z, 0.f) + log1pf(expf(-fabsf(z))); }
DI void attn_tile(const LAS unsigned char* kb, const LAS unsigned char* vb, const LAS float* tab, const bf16x8 (&qr)[4], unsigned cw0, unsigned cw1, int j, int qw, int myq, int r32, int hi, float bias_far,
                  float& m_run, float& l_run, f32x16& o0, f32x16& o1, f32x16& negmb) {
    bf16x8 ka[8];
#pragma unroll
    for (int s = 0; s < 4; ++s) { const int ch = 2 * s + hi;
        ka[2 * s] = *(const LAS bf16x8*)(kb + r32 * 128 + ((ch ^ ((r32 >> 1) & 7)) << 4));
        ka[2 * s + 1] = *(const LAS bf16x8*)(kb + (32 + r32) * 128 + ((ch ^ (((32 + r32) >> 1) & 7)) << 4)); }
    f32x16 p0 = negmb, p1 = negmb;
#pragma unroll
    for (int s = 0; s < 4; ++s) { p0 = __builtin_amdgcn_mfma_f32_32x32x16_bf16(ka[2 * s], qr[s], p0, 0, 0, 0); p1 = __builtin_amdgcn_mfma_f32_32x32x16_bf16(ka[2 * s + 1], qr[s], p1, 0, 0, 0); }
    u32x4 va0[4], va1[4];
#pragma unroll
    for (int s = 0; s < 4; ++s) {
        const u32x2 a0l = *(const LAS u32x2*)(vb + (r32) * 136 + (16 * s + 4 * hi) * 2), a0h = *(const LAS u32x2*)(vb + (r32) * 136 + (16 * s + 8 + 4 * hi) * 2);
        const u32x2 a1l = *(const LAS u32x2*)(vb + (32 + r32) * 136 + (16 * s + 4 * hi) * 2), a1h = *(const LAS u32x2*)(vb + (32 + r32) * 136 + (16 * s + 8 + 4 * hi) * 2);
        va0[s] = (u32x4){a0l.x, a0l.y, a0h.x, a0h.y}; va1[s] = (u32x4){a1l.x, a1l.y, a1h.x, a1h.y}; }
    const bool far = (64 * j + 63 - qw) <= -128;
    if (!far) {
#pragma unroll
        for (int g = 0; g < 16; ++g) { const int kv0 = 64 * j + (g & 3) + 8 * (g >> 2) + 4 * hi; int r0 = kv0 - myq, r1 = r0 + 32;
            r0 = r0 < -128 ? -128 : r0; r1 = r1 < -128 ? -128 : r1;
            p0[g] += tab[r0 + 128]; p1[g] += tab[r1 + 128]; }
    }
    float mx = p0[0];
#pragma unroll
    for (int g = 1; g < 16; ++g) mx = fmaxf(mx, p0[g]);
#pragma unroll
    for (int g = 0; g < 16; ++g) mx = fmaxf(mx, p1[g]);
    mx = fmaxf(mx, __shfl_xor(mx, 32));
    if (j == 0 || __any(mx > 0.f)) {
        const float dl = (j == 0) ? mx : fmaxf(mx, 0.f);
        m_run += dl;
        const float al = __builtin_amdgcn_exp2f(-dl); l_run *= al;
#pragma unroll
        for (int g = 0; g < 16; ++g) { p0[g] -= dl; p1[g] -= dl; o0[g] *= al; o1[g] *= al; negmb[g] = bias_far - m_run; }
        asm volatile("" : "+v"(negmb));
    }
    const int sw0 = (int)(cw0 >> (4 * hi)), sw1 = (int)(cw1 >> (4 * hi));
    float ls = 0.f;
#pragma unroll
    for (int g = 0; g < 16; ++g) { const int bit = (g & 3) + 8 * (g >> 2);
        const float e0 = __builtin_amdgcn_exp2f(p0[g]), e1 = __builtin_amdgcn_exp2f(p1[g]);
        int m0_, m1_;
        asm("v_bfe_i32 %0, %1, %2, 1" : "=v"(m0_) : "v"(sw0), "n"(bit)); asm("v_bfe_i32 %0, %1, %2, 1" : "=v"(m1_) : "v"(sw1), "n"(bit));
        p0[g] = __builtin_bit_cast(float, __builtin_bit_cast(int, e0) & m0_); p1[g] = __builtin_bit_cast(float, __builtin_bit_cast(int, e1) & m1_); ls += p0[g] + p1[g]; }
    l_run += ls;
    bf16x8 pb[4];
#pragma unroll
    for (int s = 0; s < 2; ++s) {
        u32x4 w; w.x = pk2(p0[8 * s], p0[8 * s + 1]); w.y = pk2(p0[8 * s + 2], p0[8 * s + 3]); w.z = pk2(p0[8 * s + 4], p0[8 * s + 5]); w.w = pk2(p0[8 * s + 6], p0[8 * s + 7]); pb[s] = __builtin_bit_cast(bf16x8, w);
        u32x4 x; x.x = pk2(p1[8 * s], p1[8 * s + 1]); x.y = pk2(p1[8 * s + 2], p1[8 * s + 3]); x.z = pk2(p1[8 * s + 4], p1[8 * s + 5]); x.w = pk2(p1[8 * s + 6], p1[8 * s + 7]); pb[2 + s] = __builtin_bit_cast(bf16x8, x); }
#pragma unroll
    for (int s = 0; s < 4; ++s) {
        o0 = __builtin_amdgcn_mfma_f32_32x32x16_bf16(__builtin_bit_cast(bf16x8, va0[s]), pb[s], o0, 0, 0, 0);
        o1 = __builtin_amdgcn_mfma_f32_32x32x16_bf16(__builtin_bit_cast(bf16x8, va1[s]), pb[s], o1, 0, 0, 0); }
}
DI void attn_unit(Ctx& C, int b, int h, int qb) {
    const int tid = C.tid, lane = C.lane, wave = C.wave, r32 = lane & 31, hi = lane >> 5;
    const bf16_t* proj = (const bf16_t*)(C.ws + WS_PROJ);
    const unsigned* bm = (const unsigned*)(C.ws + WS_BM);
    LAS unsigned char* Kl = C.lds; LAS unsigned char* Vl = C.lds + 16384; LAS float* tab = (LAS float*)(C.lds + 33792);
    const size_t rowbase = (size_t)b * SEQ; const int q0 = qb * 256, qw = q0 + 32 * wave, myq = qw + r32;
    const int NT = 4 * qb + 4, mylast = qw >> 6;
    constexpr float LOG2E = 1.4426950408889634f;
    __syncthreads();
    if (tid < 192) { const int rel = tid - 128; const int n = rel < 0 ? -rel : rel; int bk = rel > 0 ? 16 : 0;
        if (n < 8) bk += n; else bk += 8 + (n >= 12) + (n >= 16) + (n >= 23) + (n >= 32) + (n >= 46) + (n >= 64) + (n >= 91);
        tab[tid] = (C.in(17)[bk * 8 + h] - C.in(17)[15 * 8 + h]) * LOG2E; }
    const float bias_far = C.in(17)[15 * 8 + h] * LOG2E;
    bf16x8 qr[4];
    { const bf16_t* qp = proj + (rowbase + myq) * PLD + PC_Q + h * 64 + 8 * hi;
#pragma unroll
        for (int s = 0; s < 4; ++s) { const u32x4 raw = *(const u32x4*)(qp + 16 * s); u32x4 sc_;
#pragma unroll
            for (int e = 0; e < 4; ++e) sc_[e] = pk2(bflo(raw[e]) * (0.125f * LOG2E), bfhi(raw[e]) * (0.125f * LOG2E));
            qr[s] = __builtin_bit_cast(bf16x8, sc_); } }
    const unsigned* bmrow = bm + (rowbase + myq) * 128;
    const int skv = tid >> 3, sch = tid & 7;
    const bf16_t* ksrc = proj + (rowbase + skv) * PLD + PC_K + h * 64 + 8 * sch;
    const bf16_t* vsrc = proj + (rowbase + skv) * PLD + PC_V + h * 64 + 8 * sch;
    const int kdst = skv * 128 + ((sch ^ ((skv >> 1) & 7)) << 4);
    const u32x4 m4i = *(const u32x4*)bmrow;
    u32x4 kregA = *(const u32x4*)ksrc, vregA = *(const u32x4*)vsrc; unsigned mA0 = m4i.x, mA1 = m4i.y;
    u32x4 kregB = kregA, vregB = vregA; unsigned mB0 = m4i.z, mB1 = m4i.w;
    if (NT > 1) { kregB = *(const u32x4*)(ksrc + (size_t)64 * PLD); vregB = *(const u32x4*)(vsrc + (size_t)64 * PLD); }
    const bool vodd = (skv & 1) != 0; const int vdst = ((8 * sch + (vodd ? 4 : 0)) * 68 + (skv & ~1)) * 2;
#define ATT_WRITE(buf, kreg, vreg) do { *(LAS u32x4*)(Kl + (buf) * 8192 + kdst) = kreg; LAS unsigned char* vt_ = Vl + (buf) * 8704 + vdst; \
        const unsigned r0_ = (unsigned)__builtin_amdgcn_ds_swizzle((int)(vodd ? vreg.x : vreg.z), 0x201F), r1_ = (unsigned)__builtin_amdgcn_ds_swizzle((int)(vodd ? vreg.y : vreg.w), 0x201F); \
        const unsigned lo0_ = vodd ? r0_ : vreg.x, hi0_ = vodd ? vreg.z : r0_, lo1_ = vodd ? r1_ : vreg.y, hi1_ = vodd ? vreg.w : r1_; \
        *(LAS unsigned*)(vt_ + 0 * 136) = (lo0_ & 0xffffu) | (hi0_ << 16); *(LAS unsigned*)(vt_ + 1 * 136) = (lo0_ >> 16) | (hi0_ & 0xffff0000u); \
        *(LAS unsigned*)(vt_ + 2 * 136) = (lo1_ & 0xffffu) | (hi1_ << 16); *(LAS unsigned*)(vt_ + 3 * 136) = (lo1_ >> 16) | (hi1_ & 0xffff0000u); } while (0)
    ATT_WRITE(0, kregA, vregA);
    __syncthreads();
    float m_run = 0.f, l_run = 0.f; f32x16 o0 = {}, o1 = {}, negmb;
#pragma unroll
    for (int g = 0; g < 16; ++g) negmb[g] = bias_far;
    asm volatile("" : "+v"(negmb));
#define ATT_STEP(J, CW0, CW1, KN, VN, KF, VF, MLOAD) do { const int js_ = (J); const int buf = js_ & 1; \
        if (js_ + 2 < NT) { KF = *(const u32x4*)(ksrc + (size_t)(js_ + 2) * 64 * PLD); VF = *(const u32x4*)(vsrc + (size_t)(js_ + 2) * 64 * PLD); MLOAD; } \
        if (js_ <= mylast) { attn_tile(Kl + buf * 8192, Vl + buf * 8704, tab, qr, (CW0), (CW1), js_, qw, myq, r32, hi, bias_far, m_run, l_run, o0, o1, negmb); } \
        if (js_ + 1 < NT) ATT_WRITE(buf ^ 1, KN, VN); \
        __syncthreads(); } while (0)
    {
        unsigned cA0 = mA0, cA1 = mA1;
        for (int j = 0; j < NT; j += 2) {
            u32x4 m4 = {0u, 0u, 0u, 0u};
            { const unsigned c0 = cA0, c1 = cA1; u32x4 kf = kregA, vf = vregA;
              ATT_STEP(j, c0, c1, kregB, vregB, kf, vf, m4 = *(const u32x4*)(bmrow + 2 * js_ + 4)); kregA = kf; vregA = vf; cA0 = m4.x; cA1 = m4.y; }
            if (j + 1 < NT) {
                const unsigned c0 = mB0, c1 = mB1; u32x4 kf = kregB, vf = vregB;
                ATT_STEP(j + 1, c0, c1, kregA, vregA, kf, vf, (void)0); kregB = kf; vregB = vf; mB0 = m4.z; mB1 = m4.w; }
        }
    }
#undef ATT_STEP
#undef ATT_WRITE
    const float lt = l_run + __shfl_xor(l_run, 32); const float inv = 1.f / lt;
    bf16_t* orow = C.mixcat + (rowbase + myq) * D + h * 64;
#pragma unroll
    for (int i = 0; i < 4; ++i) { const int d = 8 * i + 4 * hi;
        u32x2 w0; w0.x = pk2(o0[4 * i] * inv, o0[4 * i + 1] * inv); w0.y = pk2(o0[4 * i + 2] * inv, o0[4 * i + 3] * inv); *(u32x2*)(orow + d) = w0;
        u32x2 w1; w1.x = pk2(o1[4 * i] * inv, o1[4 * i + 1] * inv); w1.y = pk2(o1[4 * i + 2] * inv, o1[4 * i + 3] * inv); *(u32x2*)(orow + 32 + d) = w1; }
}

constexpr size_t WS_PHI = 38 * MiB, WS_PSI = 54 * MiB, WS_GT = 70 * MiB, WS_Y0T = 86 * MiB, WS_GGT = 102 * MiB, WS_RHO = 118 * MiB;
constexpr size_t WS_S0 = 1 * MiB;
constexpr size_t WS_LORA = 250 * MiB;
DI int crow(int g, int hi) { return (g & 3) + 8 * (g >> 2) + 4 * hi; }
DI f32x16 mfma32(bf16x8 a, bf16x8 b, f32x16 c) { return __builtin_amdgcn_mfma_f32_32x32x16_bf16(a, b, c, 0, 0, 0); }
struct FA { float v[16]; DI float& operator[](int i) { return v[i]; } DI const float& operator[](int i) const { return v[i]; } };
struct F8 { float v[8]; DI float& operator[](int i) { return v[i]; } DI const float& operator[](int i) const { return v[i]; } };
DI bf16x8 pack8(const F8& a) { u32x4 w; w.x = pk2(a[0], a[1]); w.y = pk2(a[2], a[3]); w.z = pk2(a[4], a[5]); w.w = pk2(a[6], a[7]); return __builtin_bit_cast(bf16x8, w); }
DI void pin(FA& a) { asm volatile("" : "+v"(a.v[0]), "+v"(a.v[1]), "+v"(a.v[2]), "+v"(a.v[3]), "+v"(a.v[4]), "+v"(a.v[5]), "+v"(a.v[6]), "+v"(a.v[7]), "+v"(a.v[8]), "+v"(a.v[9]), "+v"(a.v[10]), "+v"(a.v[11]), "+v"(a.v[12]), "+v"(a.v[13]), "+v"(a.v[14]), "+v"(a.v[15])); }
DI void pinf(bf16x8& a) { asm volatile("" : "+v"(a)); }
DI FA toFA(const f32x16& a) { FA r; _Pragma("unroll") for (int i = 0; i < 16; ++i) r.v[i] = a[i]; return r; }
DI f32x16 toV(const FA& a) { f32x16 r; _Pragma("unroll") for (int i = 0; i < 16; ++i) r[i] = a.v[i]; return r; }
DI bf16x8 packfrag(const FA& a, int s) { u32x4 w; w.x = pk2(a[8 * s], a[8 * s + 1]); w.y = pk2(a[8 * s + 2], a[8 * s + 3]); w.z = pk2(a[8 * s + 4], a[8 * s + 5]); w.w = pk2(a[8 * s + 6], a[8 * s + 7]); return __builtin_bit_cast(bf16x8, w); }
DI bf16x8 packfrag(const f32x16& a, int s) { u32x4 w; w.x = pk2(a[8 * s], a[8 * s + 1]); w.y = pk2(a[8 * s + 2], a[8 * s + 3]); w.z = pk2(a[8 * s + 4], a[8 * s + 5]); w.w = pk2(a[8 * s + 6], a[8 * s + 7]); return __builtin_bit_cast(bf16x8, w); }
DI unsigned opq(unsigned v) { asm volatile("" : "+v"(v)); return v; }
DI void st_frag(unsigned char* buf, int f, int lane, bf16x8 v) { *(bf16x8*)(buf + f * 1024 + opq(lane * 16)) = v; }
DI bf16x8 ld_frag(const unsigned char* buf, int f, int lane) { return *(const bf16x8*)(buf + f * 1024 + opq(lane * 16)); }
template <class TT> DI void st_tile_bf16(unsigned char* buf, int q, int lane, const TT& a) { const unsigned o = opq(lane * 32); *(bf16x8*)(buf + q * 2048 + o) = packfrag(a, 0); *(bf16x8*)(buf + q * 2048 + o + 16) = packfrag(a, 1); }
DI FA ld_tile_bf16(const unsigned char* buf, int q, int lane) { const unsigned o = opq(lane * 32); const u32x4 a = *(const u32x4*)(buf + q * 2048 + o), b = *(const u32x4*)(buf + q * 2048 + o + 16); FA r;
    r[0] = bflo(a.x); r[1] = bfhi(a.x); r[2] = bflo(a.y); r[3] = bfhi(a.y); r[4] = bflo(a.z); r[5] = bfhi(a.z); r[6] = bflo(a.w); r[7] = bfhi(a.w);
    r[8] = bflo(b.x); r[9] = bfhi(b.x); r[10] = bflo(b.y); r[11] = bfhi(b.y); r[12] = bflo(b.z); r[13] = bfhi(b.z); r[14] = bflo(b.w); r[15] = bfhi(b.w); return r; }
DI float fexp(float x) { return __builtin_amdgcn_exp2f(x * 1.4426950408889634f); }
DI float flog(float x) { return __builtin_amdgcn_logf(x) * 0.6931471805599453f; }
DI float ftanh(float x) { return 1.f - 2.f * __builtin_amdgcn_rcpf(1.f + fexp(2.f * x)); }
DI float fsigm(float x) { return __builtin_amdgcn_rcpf(1.f + fexp(-x)); }
DI float fsoftplus(float z) { return fmaxf(z, 0.f) + flog(1.f + fexp(-fabsf(z))); }
template <int ACT> DI bf16x8 act_frag(const bf16_t* proj, size_t row, bool first, int c0, const float* mu8) {
    const bf16_t* rp = proj + opq((unsigned)(row * PLD)); const u32x4 cu = *(const u32x4*)(rp + c0); u32x4 pv = {0u, 0u, 0u, 0u}; if (!first) pv = *(const u32x4*)(rp - PLD + c0);
    const float* mq = mu8 + opq(0u); const f32x4 m0 = *(const f32x4*)(mq), m1 = *(const f32x4*)(mq + 4);
    float x[8];
#pragma unroll
    for (int q = 0; q < 4; ++q) { const float c_lo = bflo(cu[q]), c_hi = bfhi(cu[q]), p_lo = bflo(pv[q]), p_hi = bfhi(pv[q]); const float ma = (q < 2) ? m0[2 * q] : m1[2 * q - 4], mb = (q < 2) ? m0[2 * q + 1] : m1[2 * q - 3];
        x[2 * q] = c_lo + (p_lo - c_lo) * ma; x[2 * q + 1] = c_hi + (p_hi - c_hi) * mb; }
#pragma unroll
    for (int e = 0; e < 8; ++e) { if (ACT == 1) x[e] = ftanh(x[e]); else if (ACT == 2) x[e] = fsigm(x[e]); }
    u32x4 w; w.x = pk2(x[0], x[1]); w.y = pk2(x[2], x[3]); w.z = pk2(x[4], x[5]); w.w = pk2(x[6], x[7]); return __builtin_bit_cast(bf16x8, w);
}
DI f32x4 shift4(const bf16_t* proj, size_t row, bool first, int c4, const float* mu4) {
    const bf16_t* rp = proj + opq((unsigned)(row * PLD)); const u32x2 cu = *(const u32x2*)(rp + c4); u32x2 pv = {0u, 0u}; if (!first) pv = *(const u32x2*)(rp - PLD + c4);
    const f32x4 m = *(const f32x4*)(mu4 + opq(0u)); const f32x4 c = {bflo(cu.x), bfhi(cu.x), bflo(cu.y), bfhi(cu.y)}, p = {bflo(pv.x), bfhi(pv.x), bflo(pv.y), bfhi(pv.y)};
    return c + (p - c) * m;
}
DI f32x4 shiftT4(const bf16_t* proj, size_t row, bool firstseq, int c1, float mu1) {
    const bf16_t* rp = proj + opq((unsigned)(row * PLD + c1));
    const float c0 = bf2f(rp[0]), c1_ = bf2f(rp[PLD]), c2 = bf2f(rp[2 * PLD]), c3 = bf2f(rp[3 * PLD]);
    const float pm = firstseq ? 0.f : bf2f(*(rp - PLD));
    f32x4 r; r.x = c0 + (pm - c0) * mu1; r.y = c1_ + (c0 - c1_) * mu1; r.z = c2 + (c1_ - c2) * mu1; r.w = c3 + (c2 - c3) * mu1; return r;
}
DI float scan32_incl(float x, int tl) {
#pragma unroll
    for (int d = 1; d < 32; d <<= 1) { const float y = __shfl_up(x, d, 32); if (tl >= d) x += y; }
    return x;
}

constexpr int RL_ACT = 0;
constexpr int RL_MAB = 0, RL_W1C = 17408, RL_W2C = 26624;
constexpr int RL_ELL = 35840;
constexpr int RL_AV = RL_ELL + 16640, RL_MAK = RL_ELL, RL_NRB = RL_ELL + 9216, RL_NRK = RL_ELL + 18432;
constexpr int RL_RT = 69120, RL_AT = RL_RT + 9216, RL_BT = RL_RT + 18432, RL_KT = RL_RT + 27648;
constexpr int RL_X2 = RL_AT;
constexpr int RL_BHC = 105984, RL_KHC = RL_BHC + 9216, RL_VC = RL_BHC + 18432;
constexpr int RL_X = 133632;
constexpr int RL_SM = 150272;
constexpr int RL_END = RL_SM + 512;
template <int KS> DI f32x16 mm_ll(const LAS bf16_t* a, int pa, const LAS bf16_t* b, int pb, int lane, f32x16 acc) {
    const LAS bf16_t* ap = a + (lane & 31) * pa + 8 * (lane >> 5); const LAS bf16_t* bp = b + (lane & 31) * pb + 8 * (lane >> 5);
#pragma unroll
    for (int s = 0; s < KS; ++s) acc = mfma32(*(const LAS bf16x8*)(ap + 16 * s), *(const LAS bf16x8*)(bp + 16 * s), acc);
    return acc;
}
DI void rwkv_chunk_acts(Ctx& C, int bc, int l, bf16x8 (&actv)[4]) {
    const int chunk = bc & 63, b = bc >> 6, t = C.tid >> 3, cg = C.tid & 7; const size_t row = (size_t)b * SEQ + chunk * 64 + t; const bool first = (chunk == 0 && t == 0);
    const bf16_t* proj = (const bf16_t*)(C.ws + WS_PROJ); const float* mu = C.in(6) + (size_t)l * 1792;
#pragma unroll
    for (int q = 0; q < 4; ++q) { const int c8 = cg * 32 + 8 * q;
        if (c8 < 64) actv[q] = act_frag<1>(proj, row, first, PC_WD + c8, mu + 1536 + c8); else if (c8 < 128) actv[q] = act_frag<0>(proj, row, first, PC_WD + c8, mu + 1536 + c8); else actv[q] = act_frag<2>(proj, row, first, PC_WD + c8, mu + 1536 + c8); }
}
#define LBAR() asm volatile("s_waitcnt lgkmcnt(0)\n\ts_barrier" ::: "memory")
DI void rwkv_head_item(Ctx& C, int item, int l, const bf16x8 (&actv)[4]) {
    const int h = item & 7, chunk = (item >> 3) & 63, b = item >> 9, tid = C.tid, lane = C.lane, wave = C.wave, tl = lane & 31, hi = lane >> 5;
    const size_t tok0 = (size_t)b * SEQ + chunk * 64;
    const bf16_t* proj = (const bf16_t*)(C.ws + WS_PROJ);
    const size_t chid = ((size_t)(b * 8 + h) * 64 + chunk) * 8192;
    unsigned char* PHI = C.ws + WS_PHI + chid; unsigned char* PSI = C.ws + WS_PSI + chid; unsigned char* GT = C.ws + WS_GT + chid; unsigned char* Y0T = C.ws + WS_Y0T + chid; unsigned char* GGT = C.ws + WS_GGT + chid;
    const bf16_t* WDT = (const bf16_t*)(C.ws + WS_LORA); const bf16_t* WAT = WDT + 512 * 64; const bf16_t* WGT = WAT + 512 * 64;
    const float* mu = C.in(6) + (size_t)l * 1792;
    const float* w0p = C.in(7) + l * 512 + 64 * h; const float* a0p = C.in(9) + l * 512 + 64 * h;
    const float* kkp = C.in(12) + l * 512 + 64 * h; const float* kap = C.in(13) + l * 512 + 64 * h; const float* rkp = C.in(14) + l * 512 + 64 * h;
    LAS bf16_t* ACT = (LAS bf16_t*)(C.lds + RL_ACT); LAS float* MAB = (LAS float*)(C.lds + RL_MAB); LAS bf16_t* W1C = (LAS bf16_t*)(C.lds + RL_W1C); LAS bf16_t* W2C = (LAS bf16_t*)(C.lds + RL_W2C);
    LAS float* ELL = (LAS float*)(C.lds + RL_ELL); LAS float* AV = (LAS float*)(C.lds + RL_AV);
    LAS bf16_t* MAK = (LAS bf16_t*)(C.lds + RL_MAK); LAS bf16_t* NRB = (LAS bf16_t*)(C.lds + RL_NRB); LAS bf16_t* NRK = (LAS bf16_t*)(C.lds + RL_NRK);
    LAS bf16_t* AT = (LAS bf16_t*)(C.lds + RL_AT); LAS bf16_t* RT = (LAS bf16_t*)(C.lds + RL_RT); LAS bf16_t* BT = (LAS bf16_t*)(C.lds + RL_BT); LAS bf16_t* KT = (LAS bf16_t*)(C.lds + RL_KT);
    LAS bf16_t* BHC = (LAS bf16_t*)(C.lds + RL_BHC); LAS bf16_t* KHC = (LAS bf16_t*)(C.lds + RL_KHC); LAS bf16_t* VC = (LAS bf16_t*)(C.lds + RL_VC);
    LAS float* X = (LAS float*)(C.lds + RL_X); LAS float* X2 = (LAS float*)(C.lds + RL_X2); LAS float* INV = (LAS float*)(C.lds + RL_SM); LAS float* LCv = INV + 64;
    LBAR();
#ifndef RWR12
#define RWR12 1
#define RWR4 1
#define RWR5 1
#define RWR11 1
#endif
    for (int rr_ = 0; rr_ < RWR12; ++rr_) {
    const int jp = (wave >> 1) & 1, jq = wave & 1;
    bf16x8 wfr[8];
    if (wave < 4) { const bf16_t* W = WGT + (size_t)(64 * h + 32 * jp + tl) * 128 + 8 * hi;
#pragma unroll
        for (int s = 0; s < 8; ++s) wfr[s] = *(const bf16x8*)(W + 16 * s);
    } else { const bf16_t* W0 = WDT + (size_t)(64 * h + 32 * jq + tl) * 64 + 8 * hi; const bf16_t* W1 = WAT + (size_t)(64 * h + 32 * jq + tl) * 64 + 8 * hi;
#pragma unroll
        for (int s = 0; s < 4; ++s) { wfr[s] = *(const bf16x8*)(W0 + 16 * s); wfr[4 + s] = *(const bf16x8*)(W1 + 16 * s); } }
    { const int t = tid >> 3, cg = tid & 7;
#pragma unroll
        for (int q = 0; q < 4; ++q) *(LAS bf16x8*)(ACT + t * 264 + cg * 32 + 8 * q) = actv[q]; }
    LBAR();
    if (wave < 4) {
        const LAS bf16_t* bp = ACT + (32 * jq + tl) * 264 + 128 + 8 * hi; f32x16 acc = {};
#pragma unroll
        for (int s = 0; s < 8; ++s) acc = mfma32(wfr[s], *(const LAS bf16x8*)(bp + 16 * s), acc);
        st_tile_bf16(GGT, jp * 2 + jq, lane, acc);
    } else {
        const LAS bf16_t* ap = ACT + (32 * jp + tl) * 264 + 8 * hi; f32x16 a0 = {}, a1 = {};
#pragma unroll
        for (int s = 0; s < 4; ++s) { a0 = mfma32(*(const LAS bf16x8*)(ap + 16 * s), wfr[s], a0); a1 = mfma32(*(const LAS bf16x8*)(ap + 64 + 16 * s), wfr[4 + s], a1); }
        const int ch = 32 * jq + tl; const float w0c = w0p[ch], a0c = a0p[ch];
#pragma unroll
        for (int g = 0; g < 16; ++g) { const int t = 32 * jp + crow(g, hi); ELL[t * 65 + ch] = -fexp(-fsoftplus(-(w0c + a0[g])) - 0.5f); AV[t * 65 + ch] = fsigm(a0c + a1[g]); }
    }
    LBAR();
    }
    { const int ch = tid & 63, seg = tid >> 6; float p[8]; float run = 0.f;
#pragma unroll
        for (int e = 0; e < 8; ++e) { run += ELL[(8 * seg + e) * 65 + ch]; p[e] = run; }
        X[seg * 65 + ch] = run;
        LBAR();
        float off = 0.f;
#pragma unroll
        for (int s2 = 0; s2 < 7; ++s2) off += (s2 < seg) ? X[s2 * 65 + ch] : 0.f;
#pragma unroll
        for (int e = 0; e < 8; ++e) ELL[(8 * seg + e) * 65 + ch] = off + p[e];
        if (seg == 7) LCv[ch] = off + p[7]; }
    LBAR();
    for (int rr_ = 0; rr_ < RWR4; ++rr_) {
    { const int t = tid >> 3, c0 = (tid & 7) * 8; const size_t row = tok0 + t; const bool first = (chunk == 0 && t == 0); float rho = 0.f, n2 = 0.f;
        f32x4 r4[2], k4[2], v4[2];
#pragma unroll
        for (int q = 0; q < 2; ++q) { const int c = c0 + 4 * q;
            r4[q] = shift4(proj, row, first, PC_R + 64 * h + c, mu + 64 * h + c); k4[q] = shift4(proj, row, first, PC_BK + 64 * h + c, mu + 512 + 64 * h + c); v4[q] = shift4(proj, row, first, PC_BV + 64 * h + c, mu + 1024 + 64 * h + c);
            const f32x4 kr = k4[q] * *(const f32x4*)(kkp + c); n2 += (kr.x * kr.x + kr.y * kr.y) + (kr.z * kr.z + kr.w * kr.w); }
        n2 += __shfl_xor(n2, 1); n2 += __shfl_xor(n2, 2); n2 += __shfl_xor(n2, 4);
        const float inv = 1.f / fmaxf(sqrtf(n2), 1e-12f);
        F8 vA, vR, vB, vK;
#pragma unroll
        for (int q = 0; q < 2; ++q) { const int c = c0 + 4 * q;
            const f32x4 kk4 = *(const f32x4*)(kkp + c), ka4 = *(const f32x4*)(kap + c), rk4 = *(const f32x4*)(rkp + c);
#pragma unroll
            for (int jj = 0; jj < 4; ++jj) { const int ch = c + jj; const float a = AV[t * 65 + ch], L = ELL[t * 65 + ch], Lp = t ? ELL[(t - 1) * 65 + ch] : 0.f, LC = LCv[ch];
                const float kk = k4[q][jj] * kk4[jj] * inv, kp = k4[q][jj] * (1.f + (a - 1.f) * ka4[jj]), bb = kk * a;
                const float eL = fexp(L), eN = fexp(-L), eP = fexp(Lp), eD = fexp(LC - L);
                rho += r4[q][jj] * kp * rk4[jj];
                const float xa = -kk * eP; vA[4 * q + jj] = xa; vR[4 * q + jj] = r4[q][jj] * eL; vB[4 * q + jj] = bb * eN; vK[4 * q + jj] = kp * eN;
                X[t * 65 + ch] = xa; BHC[ch * 72 + t] = (bf16_t)f2bf(bb * eD); KHC[ch * 72 + t] = (bf16_t)f2bf(kp * eD); VC[ch * 72 + t] = (bf16_t)f2bf(v4[q][jj]); } }
        *(LAS bf16x8*)(AT + t * 72 + c0) = pack8(vA); *(LAS bf16x8*)(RT + t * 72 + c0) = pack8(vR); *(LAS bf16x8*)(BT + t * 72 + c0) = pack8(vB); *(LAS bf16x8*)(KT + t * 72 + c0) = pack8(vK);
        rho += __shfl_xor(rho, 1); rho += __shfl_xor(rho, 2); rho += __shfl_xor(rho, 4);
        if ((tid & 7) == 0) ((float*)(C.ws + WS_RHO))[row * 8 + h] = rho; }
    LBAR();
    }
    for (int rr_ = 0; rr_ < RWR5; ++rr_) {
    for (int job = wave; job < 16; job += 8) {
        const int kind = job >> 2, ti = (job >> 1) & 1, tj = job & 1;
        const LAS bf16_t* a = (kind < 2 ? AT : RT) + 32 * ti * 72; const LAS bf16_t* bm = ((kind & 1) ? KT : BT) + 32 * tj * 72;
        f32x16 acc = {};
        if (!(ti == 0 && tj == 1)) acc = mm_ll<4>(a, 72, bm, 72, lane, acc);
#pragma unroll
        for (int g = 0; g < 16; ++g) { const int i = 32 * ti + crow(g, hi), j = 32 * tj + tl; const bool keep = (kind < 2) ? (j < i) : (j <= i); const float v = keep ? acc[g] : 0.f;
            if (kind == 0) MAB[i * 68 + j] = v; else (kind == 1 ? MAK : kind == 2 ? NRB : NRK)[i * 72 + j] = (bf16_t)f2bf(v); }
    }
    LBAR();
    }
    if (wave < 4) { const int ti = wave >> 1, tv = wave & 1; f32x16 acc = {}; acc = mm_ll<4>(MAK + 32 * ti * 72, 72, VC + 32 * tv * 72, 72, lane, acc);
#pragma unroll
        for (int g = 0; g < 16; ++g) X2[(32 * ti + crow(g, hi)) * 65 + 32 * tv + tl] = acc[g]; }
    LBAR();
    for (int bk = 0; bk < 4; ++bk) {
        const int r0 = 16 * bk;
        if (wave < 2) {
            LAS float* XX = wave ? X2 : X; float x[16];
#pragma unroll
            for (int i = 0; i < 16; ++i) x[i] = XX[(r0 + i) * 65 + lane];
#pragma unroll
            for (int i = 1; i < 16; ++i) { const LAS float* mr = MAB + (r0 + i) * 68 + r0; float a_ = x[i];
#pragma unroll
                for (int q = 0; q < (i + 3) / 4; ++q) { const f32x4 m4 = *(const LAS f32x4*)(mr + 4 * q);
#pragma unroll
                    for (int e = 0; e < 4; ++e) if (4 * q + e < i) a_ += m4[e] * x[4 * q + e]; }
                x[i] = a_; }
#pragma unroll
            for (int i = 1; i < 16; ++i) XX[(r0 + i) * 65 + lane] = x[i];
        }
        LBAR();
        if (bk < 3) {
            const int mat = wave >> 2, rt = (wave >> 1) & 1, ctl = wave & 1;
            if (32 * rt + 31 >= r0 + 16) {
                LAS float* XX = mat ? X2 : X;
                F8 av8, bv8;
#pragma unroll
                for (int e = 0; e < 8; ++e) { av8[e] = MAB[(32 * rt + tl) * 68 + r0 + 8 * hi + e]; bv8[e] = XX[(r0 + 8 * hi + e) * 65 + 32 * ctl + tl]; }
                f32x16 acc;
#pragma unroll
                for (int g = 0; g < 16; ++g) acc[g] = XX[(32 * rt + crow(g, hi)) * 65 + 32 * ctl + tl];
                acc = mfma32(pack8(av8), pack8(bv8), acc);
#pragma unroll
                for (int g = 0; g < 16; ++g) { const int i = 32 * rt + crow(g, hi); if (i >= r0 + 16) XX[i * 65 + 32 * ctl + tl] = acc[g]; }
            }
            LBAR();
        }
    }
    { const int k = tid >> 3, i0 = (tid & 7) * 8; F8 v, w;
#pragma unroll
        for (int e = 0; e < 8; ++e) { v[e] = X[(i0 + e) * 65 + k]; w[e] = X2[(i0 + e) * 65 + k]; }
        *(LAS bf16x8*)(W1C + k * 72 + i0) = pack8(v); *(LAS bf16x8*)(W2C + k * 72 + i0) = pack8(w); }
    LBAR();
    for (int rr_ = 0; rr_ < RWR11; ++rr_) {
    for (int job = wave; job < 16; job += 8) {
        const int kind = job >> 2, p = (job >> 1) & 1, q = job & 1; f32x16 acc = {};
        if (kind == 0) {
            acc = mm_ll<4>(W1C + 32 * p * 72, 72, NRB + 32 * q * 72, 72, lane, acc);
            FA fa;
#pragma unroll
            for (int g = 0; g < 16; ++g) fa[g] = acc[g] + bf2f(RT[(32 * q + tl) * 72 + 32 * p + crow(g, hi)]);
            st_frag(GT, (p * 2 + q) * 2 + 0, lane, packfrag(fa, 0)); st_frag(GT, (p * 2 + q) * 2 + 1, lane, packfrag(fa, 1));
        } else if (kind == 1) {
            acc = mm_ll<4>(W2C + 32 * p * 72, 72, NRB + 32 * q * 72, 72, lane, acc); acc = mm_ll<4>(VC + 32 * p * 72, 72, NRK + 32 * q * 72, 72, lane, acc);
            st_tile_bf16(Y0T, p * 2 + q, lane, acc);
        } else if (kind == 2) {
            acc = mm_ll<4>(W1C + 32 * p * 72, 72, BHC + 32 * q * 72, 72, lane, acc);
            FA fa = toFA(acc);
            if (p == q) { const float pc = fexp(LCv[32 * q + tl]);
#pragma unroll
                for (int g = 0; g < 16; ++g) if (crow(g, hi) == tl) fa[g] += pc; }
            st_frag(PHI, (p * 2 + q) * 2 + 0, lane, packfrag(fa, 0)); st_frag(PHI, (p * 2 + q) * 2 + 1, lane, packfrag(fa, 1));
        } else {
            acc = mm_ll<4>(BHC + 32 * p * 72, 72, W2C + 32 * q * 72, 72, lane, acc); acc = mm_ll<4>(KHC + 32 * p * 72, 72, VC + 32 * q * 72, 72, lane, acc);
            st_tile_bf16(PSI, p * 2 + q, lane, acc);
        }
    }
    LBAR();
    }
}

#undef LBAR
DI void rwkv_scan_wave(Ctx& C, int id) {
    const int vt = id & 1, bh = id >> 1, lane = C.lane;
    f32x16 S[2] = {{}, {}};
    for (int chunk = 0; chunk < 64; ++chunk) {
        const size_t chid = ((size_t)bh * 64 + chunk) * 8192;
        const unsigned char* PHI = C.ws + WS_PHI + chid; const unsigned char* PSI = C.ws + WS_PSI + chid; unsigned char* S0B = C.ws + WS_S0 + chid;
        bf16x8 sh[2][2], sl[2][2];
        f32x16 N[2];
#pragma unroll
        for (int ct = 0; ct < 2; ++ct) N[ct] = toV(ld_tile_bf16(PSI, ct * 2 + vt, lane));
        asm volatile("" ::: "memory");
#pragma unroll
        for (int cp = 0; cp < 2; ++cp)
#pragma unroll
            for (int s = 0; s < 2; ++s) { sh[cp][s] = packfrag(S[cp], s); st_frag(S0B, (cp * 2 + vt) * 2 + s, lane, sh[cp][s]);
                const u32x4 hw = __builtin_bit_cast(u32x4, sh[cp][s]); u32x4 lw;
#pragma unroll
                for (int q = 0; q < 4; ++q) lw[q] = pk2(S[cp][8 * s + 2 * q] - bflo(hw[q]), S[cp][8 * s + 2 * q + 1] - bfhi(hw[q]));
                sl[cp][s] = __builtin_bit_cast(bf16x8, lw); }
#pragma unroll
        for (int ct = 0; ct < 2; ++ct) {
#pragma unroll
            for (int cp = 0; cp < 2; ++cp)
#pragma unroll
                for (int s = 0; s < 2; ++s) { const bf16x8 ph = ld_frag(PHI, (cp * 2 + ct) * 2 + s, lane); N[ct] = mfma32(ph, sh[cp][s], N[ct]); N[ct] = mfma32(ph, sl[cp][s], N[ct]); } }
        S[0] = N[0]; S[1] = N[1];
    }
}

DI void rwkv_out_wave(Ctx& C, int id, int l) {
    const int chunk = id & 63, bh = id >> 6, b = bh >> 3, h = bh & 7, lane = C.lane, tl = lane & 31, hi = lane >> 5;
    const size_t chid = (size_t)id * 8192; const size_t tok0 = (size_t)b * SEQ + chunk * 64;
    const unsigned char* GT = C.ws + WS_GT + chid; const unsigned char* Y0T = C.ws + WS_Y0T + chid; const unsigned char* GGT = C.ws + WS_GGT + chid; const unsigned char* S0B = C.ws + WS_S0 + chid;
    const bf16_t* proj = (const bf16_t*)(C.ws + WS_PROJ);
    const float* mu = C.in(6) + (size_t)l * 1792; const float* gng = C.in(15) + l * 512 + 64 * h; const float* gnb = C.in(16) + l * 512 + 64 * h;
    const float* RHO = (const float*)(C.ws + WS_RHO);
    FA Y[2][2];
#pragma unroll
    for (int vt = 0; vt < 2; ++vt)
#pragma unroll
        for (int tt = 0; tt < 2; ++tt) { f32x16 acc = toV(ld_tile_bf16(Y0T, vt * 2 + tt, lane));
#pragma unroll
            for (int cp = 0; cp < 2; ++cp)
#pragma unroll
                for (int s = 0; s < 2; ++s) acc = mfma32(ld_frag(S0B, (cp * 2 + vt) * 2 + s, lane), ld_frag(GT, (cp * 2 + tt) * 2 + s, lane), acc);
            Y[vt][tt] = toFA(acc); }
#pragma unroll
    for (int tt = 0; tt < 2; ++tt) {
        float s1 = 0.f;
#pragma unroll
        for (int vt = 0; vt < 2; ++vt)
#pragma unroll
            for (int g = 0; g < 16; ++g) s1 += Y[vt][tt][g];
        s1 += __shfl_xor(s1, 32); const float mean = s1 * (1.f / 64.f);
        float s2 = 0.f;
#pragma unroll
        for (int vt = 0; vt < 2; ++vt)
#pragma unroll
            for (int g = 0; g < 16; ++g) { const float d = Y[vt][tt][g] - mean; s2 += d * d; }
        s2 += __shfl_xor(s2, 32); const float rstd = 1.f / sqrtf(s2 * (1.f / 64.f) + GN_EPS);
        const size_t row = tok0 + 32 * tt + tl; const bool first = (chunk == 0 && tt == 0 && tl == 0);
        const float rho = RHO[row * 8 + h];
#pragma unroll
        for (int vt = 0; vt < 2; ++vt) { const FA gt = ld_tile_bf16(GGT, vt * 2 + tt, lane);
#pragma unroll
            for (int i = 0; i < 4; ++i) { const int c = 32 * vt + 8 * i + 4 * hi;
                const f32x4 v4 = shift4(proj, row, first, PC_BV + 64 * h + c, mu + 1024 + 64 * h + c); const f32x4 gg = *(const f32x4*)(gng + c), gb = *(const f32x4*)(gnb + c);
                float o[4];
#pragma unroll
                for (int jj = 0; jj < 4; ++jj) { const int g = 4 * i + jj; o[jj] = ((Y[vt][tt][g] - mean) * rstd * gg[jj] + gb[jj] + rho * v4[jj]) * gt[g]; }
                u32x2 w; w.x = pk2(o[0], o[1]); w.y = pk2(o[2], o[3]); *(u32x2*)(C.mixcat + row * D + 512 + 64 * h + c) = w; } }
    }
}

constexpr int GB_OFF = 163840 - 256;
DI void gbar(LAS unsigned* cnt, unsigned& target, int lane) {
    asm volatile("s_waitcnt lgkmcnt(0)" ::: "memory");
    target += 4u;
    if (lane == 0) __hip_atomic_fetch_add(cnt, 1u, __ATOMIC_RELAXED, __HIP_MEMORY_SCOPE_WORKGROUP);
    while (__hip_atomic_load(cnt, __ATOMIC_RELAXED, __HIP_MEMORY_SCOPE_WORKGROUP) < target) __builtin_amdgcn_s_sleep(1);
    asm volatile("" ::: "memory");
}
DI void rwkv_chunk_acts4(Ctx& C, int bc, int l, bf16x8 (&actv)[8]) {
    const int chunk = bc & 63, b = bc >> 6, t = C.tid >> 2, cg = C.tid & 3; const size_t row = (size_t)b * SEQ + chunk * 64 + t; const bool first = (chunk == 0 && t == 0);
    const bf16_t* proj = (const bf16_t*)(C.ws + WS_PROJ); const float* mu = C.in(6) + (size_t)l * 1792;
#pragma unroll
    for (int q = 0; q < 8; ++q) { const int c8 = cg * 64 + 8 * q;
        if (c8 < 64) actv[q] = act_frag<1>(proj, row, first, PC_WD + c8, mu + 1536 + c8); else if (c8 < 128) actv[q] = act_frag<0>(proj, row, first, PC_WD + c8, mu + 1536 + c8); else actv[q] = act_frag<2>(proj, row, first, PC_WD + c8, mu + 1536 + c8); }
}
#ifndef RW4_12
#define RW4_12 1
#endif
#ifndef RW4_4
#define RW4_4 1
#endif
#ifndef RW4_5
#define RW4_5 1
#endif
#ifndef RW4_11
#define RW4_11 1
#endif
#define GBA() gbar(gcnt, gtarget, lane)
DI void rwkv_head_item4(Ctx& C, int item, int l, const bf16x8 (&actv)[8], LAS unsigned* gcnt, unsigned& gtarget) {
    const int h = item & 7, chunk = (item >> 3) & 63, b = item >> 9, tid = C.tid, lane = C.lane, wave = C.wave, tl = lane & 31, hi = lane >> 5;
    const size_t tok0 = (size_t)b * SEQ + chunk * 64;
    const bf16_t* proj = (const bf16_t*)(C.ws + WS_PROJ);
    const size_t chid = ((size_t)(b * 8 + h) * 64 + chunk) * 8192;
    unsigned char* PHI = C.ws + WS_PHI + chid; unsigned char* PSI = C.ws + WS_PSI + chid; unsigned char* GT = C.ws + WS_GT + chid; unsigned char* Y0T = C.ws + WS_Y0T + chid; unsigned char* GGT = C.ws + WS_GGT + chid;
    const bf16_t* WDT = (const bf16_t*)(C.ws + WS_LORA); const bf16_t* WAT = WDT + 512 * 64; const bf16_t* WGT = WAT + 512 * 64;
    const float* mu = C.in(6) + (size_t)l * 1792;
    const float* w0p = C.in(7) + l * 512 + 64 * h; const float* a0p = C.in(9) + l * 512 + 64 * h;
    const float* kkp = C.in(12) + l * 512 + 64 * h; const float* kap = C.in(13) + l * 512 + 64 * h; const float* rkp = C.in(14) + l * 512 + 64 * h;
    LAS bf16_t* ACT = (LAS bf16_t*)(C.lds + RL_ACT); LAS float* MAB = (LAS float*)(C.lds + RL_MAB); LAS bf16_t* W1C = (LAS bf16_t*)(C.lds + RL_W1C); LAS bf16_t* W2C = (LAS bf16_t*)(C.lds + RL_W2C);
    LAS float* ELL = (LAS float*)(C.lds + RL_ELL); LAS float* AV = (LAS float*)(C.lds + RL_AV);
    LAS bf16_t* MAK = (LAS bf16_t*)(C.lds + RL_MAK); LAS bf16_t* NRB = (LAS bf16_t*)(C.lds + RL_NRB); LAS bf16_t* NRK = (LAS bf16_t*)(C.lds + RL_NRK);
    LAS bf16_t* AT = (LAS bf16_t*)(C.lds + RL_AT); LAS bf16_t* RT = (LAS bf16_t*)(C.lds + RL_RT); LAS bf16_t* BT = (LAS bf16_t*)(C.lds + RL_BT); LAS bf16_t* KT = (LAS bf16_t*)(C.lds + RL_KT);
    LAS bf16_t* BHC = (LAS bf16_t*)(C.lds + RL_BHC); LAS bf16_t* KHC = (LAS bf16_t*)(C.lds + RL_KHC); LAS bf16_t* VC = (LAS bf16_t*)(C.lds + RL_VC);
    LAS float* X = (LAS float*)(C.lds + RL_X); LAS float* X2 = (LAS float*)(C.lds + RL_X2); LAS float* LCv = (LAS float*)(C.lds + RL_SM) + 64;
    GBA();
    for (int r_RW4_12 = 0; r_RW4_12 < RW4_12; ++r_RW4_12) { asm volatile("" ::: "memory");
    const int jp = (wave >> 1) & 1, jq = wave & 1;
    bf16x8 wg[8], wd[8];
    { const bf16_t* W = WGT + (size_t)(64 * h + 32 * jp + tl) * 128 + 8 * hi; const bf16_t* W0 = WDT + (size_t)(64 * h + 32 * jq + tl) * 64 + 8 * hi; const bf16_t* W1 = WAT + (size_t)(64 * h + 32 * jq + tl) * 64 + 8 * hi;
#pragma unroll
        for (int s = 0; s < 8; ++s) wg[s] = *(const bf16x8*)(W + 16 * s);
#pragma unroll
        for (int s = 0; s < 4; ++s) { wd[s] = *(const bf16x8*)(W0 + 16 * s); wd[4 + s] = *(const bf16x8*)(W1 + 16 * s); } }
    { const int t = tid >> 2, cg = tid & 3;
#pragma unroll
        for (int q = 0; q < 8; ++q) *(LAS bf16x8*)(ACT + t * 264 + cg * 64 + 8 * q) = actv[q]; }
    GBA();
    {
        const LAS bf16_t* bp = ACT + (32 * jq + tl) * 264 + 128 + 8 * hi; f32x16 acc = {};
#pragma unroll
        for (int s = 0; s < 8; ++s) acc = mfma32(wg[s], *(const LAS bf16x8*)(bp + 16 * s), acc);
        st_tile_bf16(GGT, jp * 2 + jq, lane, acc);
        const LAS bf16_t* ap = ACT + (32 * jp + tl) * 264 + 8 * hi; f32x16 a0 = {}, a1 = {};
#pragma unroll
        for (int s = 0; s < 4; ++s) { a0 = mfma32(*(const LAS bf16x8*)(ap + 16 * s), wd[s], a0); a1 = mfma32(*(const LAS bf16x8*)(ap + 64 + 16 * s), wd[4 + s], a1); }
        const int ch = 32 * jq + tl; const float w0c = w0p[ch], a0c = a0p[ch];
#pragma unroll
        for (int g = 0; g < 16; ++g) { const int t = 32 * jp + crow(g, hi); ELL[t * 65 + ch] = -fexp(-fsoftplus(-(w0c + a0[g])) - 0.5f); AV[t * 65 + ch] = fsigm(a0c + a1[g]); }
    }
    GBA();
    }
    { const int ch = tid & 63, seg = tid >> 6; float p[16]; float run = 0.f;
#pragma unroll
        for (int e = 0; e < 16; ++e) { run += ELL[(16 * seg + e) * 65 + ch]; p[e] = run; }
        X[seg * 65 + ch] = run;
        GBA();
        float off = 0.f;
#pragma unroll
        for (int s2 = 0; s2 < 3; ++s2) off += (s2 < seg) ? X[s2 * 65 + ch] : 0.f;
#pragma unroll
        for (int e = 0; e < 16; ++e) ELL[(16 * seg + e) * 65 + ch] = off + p[e];
        if (seg == 3) LCv[ch] = off + p[15]; }
    GBA();
    for (int r_RW4_4 = 0; r_RW4_4 < RW4_4; ++r_RW4_4) { asm volatile("" ::: "memory");
#pragma unroll 1
    for (int pass = 0; pass < 2; ++pass) { const int e_ = tid + 256 * pass; const int t = e_ >> 3, c0 = (e_ & 7) * 8; const size_t row = tok0 + t; const bool first = (chunk == 0 && t == 0); float rho = 0.f, n2 = 0.f;
        f32x4 r4[2], k4[2], v4[2];
#pragma unroll
        for (int q = 0; q < 2; ++q) { const int c = c0 + 4 * q;
            r4[q] = shift4(proj, row, first, PC_R + 64 * h + c, mu + 64 * h + c); k4[q] = shift4(proj, row, first, PC_BK + 64 * h + c, mu + 512 + 64 * h + c); v4[q] = shift4(proj, row, first, PC_BV + 64 * h + c, mu + 1024 + 64 * h + c);
            const f32x4 kr = k4[q] * *(const f32x4*)(kkp + c); n2 += (kr.x * kr.x + kr.y * kr.y) + (kr.z * kr.z + kr.w * kr.w); }
        n2 += __shfl_xor(n2, 1); n2 += __shfl_xor(n2, 2); n2 += __shfl_xor(n2, 4);
        const float inv = 1.f / fmaxf(sqrtf(n2), 1e-12f);
        F8 vA, vR, vB, vK;
#pragma unroll
        for (int q = 0; q < 2; ++q) { const int c = c0 + 4 * q;
            const f32x4 kk4 = *(const f32x4*)(kkp + c), ka4 = *(const f32x4*)(kap + c), rk4 = *(const f32x4*)(rkp + c);
#pragma unroll
            for (int jj = 0; jj < 4; ++jj) { const int ch = c + jj; const float a = AV[t * 65 + ch], L = ELL[t * 65 + ch], Lp = t ? ELL[(t - 1) * 65 + ch] : 0.f, LC = LCv[ch];
                const float kk = k4[q][jj] * kk4[jj] * inv, kp = k4[q][jj] * (1.f + (a - 1.f) * ka4[jj]), bb = kk * a;
                const float eL = fexp(L), eN = fexp(-L), eP = fexp(Lp), eD = fexp(LC - L);
                rho += r4[q][jj] * kp * rk4[jj];
                const float xa = -kk * eP; vA[4 * q + jj] = xa; vR[4 * q + jj] = r4[q][jj] * eL; vB[4 * q + jj] = bb * eN; vK[4 * q + jj] = kp * eN;
                X[t * 65 + ch] = xa; BHC[ch * 72 + t] = (bf16_t)f2bf(bb * eD); KHC[ch * 72 + t] = (bf16_t)f2bf(kp * eD); VC[ch * 72 + t] = (bf16_t)f2bf(v4[q][jj]); } }
        *(LAS bf16x8*)(AT + t * 72 + c0) = pack8(vA); *(LAS bf16x8*)(RT + t * 72 + c0) = pack8(vR); *(LAS bf16x8*)(BT + t * 72 + c0) = pack8(vB); *(LAS bf16x8*)(KT + t * 72 + c0) = pack8(vK);
        rho += __shfl_xor(rho, 1); rho += __shfl_xor(rho, 2); rho += __shfl_xor(rho, 4);
        if ((tid & 7) == 0) ((float*)(C.ws + WS_RHO))[row * 8 + h] = rho; }
    GBA();
    }
    for (int r_RW4_5 = 0; r_RW4_5 < RW4_5; ++r_RW4_5) { asm volatile("" ::: "memory");
    for (int job = wave; job < 16; job += 4) {
        const int kind = job >> 2, ti = (job >> 1) & 1, tj = job & 1;
        const LAS bf16_t* a = (kind < 2 ? AT : RT) + 32 * ti * 72; const LAS bf16_t* bm = ((kind & 1) ? KT : BT) + 32 * tj * 72;
        f32x16 acc = {};
        if (!(ti == 0 && tj == 1)) acc = mm_ll<4>(a, 72, bm, 72, lane, acc);
#pragma unroll
        for (int g = 0; g < 16; ++g) { const int i = 32 * ti + crow(g, hi), j = 32 * tj + tl; const bool keep = (kind < 2) ? (j < i) : (j <= i); const float v = keep ? acc[g] : 0.f;
            if (kind == 0) MAB[i * 68 + j] = v; else (kind == 1 ? MAK : kind == 2 ? NRB : NRK)[i * 72 + j] = (bf16_t)f2bf(v); }
    }
    GBA();
    }
    { const int ti = wave >> 1, tv = wave & 1; f32x16 acc = {}; acc = mm_ll<4>(MAK + 32 * ti * 72, 72, VC + 32 * tv * 72, 72, lane, acc);
#pragma unroll
        for (int g = 0; g < 16; ++g) X2[(32 * ti + crow(g, hi)) * 65 + 32 * tv + tl] = acc[g]; }
    GBA();
    for (int bk = 0; bk < 4; ++bk) {
        const int r0 = 16 * bk;
        if (wave < 2) {
            LAS float* XX = wave ? X2 : X; float x[16];
#pragma unroll
            for (int i = 0; i < 16; ++i) x[i] = XX[(r0 + i) * 65 + lane];
#pragma unroll
            for (int i = 1; i < 16; ++i) { const LAS float* mr = MAB + (r0 + i) * 68 + r0; float a_ = x[i];
#pragma unroll
                for (int q = 0; q < (i + 3) / 4; ++q) { const f32x4 m4 = *(const LAS f32x4*)(mr + 4 * q);
#pragma unroll
                    for (int e = 0; e < 4; ++e) if (4 * q + e < i) a_ += m4[e] * x[4 * q + e]; }
                x[i] = a_; }
#pragma unroll
            for (int i = 1; i < 16; ++i) XX[(r0 + i) * 65 + lane] = x[i];
        }
        GBA();
        if (bk < 3) {
            for (int tq = wave; tq < 8; tq += 4) { const int mat = tq >> 2, rt = (tq >> 1) & 1, ctl = tq & 1;
                if (32 * rt + 31 >= r0 + 16) {
                    LAS float* XX = mat ? X2 : X;
                    F8 av8, bv8;
#pragma unroll
                    for (int e = 0; e < 8; ++e) { av8[e] = MAB[(32 * rt + tl) * 68 + r0 + 8 * hi + e]; bv8[e] = XX[(r0 + 8 * hi + e) * 65 + 32 * ctl + tl]; }
                    f32x16 acc;
#pragma unroll
                    for (int g = 0; g < 16; ++g) acc[g] = XX[(32 * rt + crow(g, hi)) * 65 + 32 * ctl + tl];
                    acc = mfma32(pack8(av8), pack8(bv8), acc);
#pragma unroll
                    for (int g = 0; g < 16; ++g) { const int i = 32 * rt + crow(g, hi); if (i >= r0 + 16) XX[i * 65 + 32 * ctl + tl] = acc[g]; }
                } }
            GBA();
        }
    }
#pragma unroll 1
    for (int pass = 0; pass < 2; ++pass) { const int e_ = tid + 256 * pass; const int k = e_ >> 3, i0 = (e_ & 7) * 8; F8 v, w;
#pragma unroll
        for (int e = 0; e < 8; ++e) { v[e] = X[(i0 + e) * 65 + k]; w[e] = X2[(i0 + e) * 65 + k]; }
        *(LAS bf16x8*)(W1C + k * 72 + i0) = pack8(v); *(LAS bf16x8*)(W2C + k * 72 + i0) = pack8(w); }
    GBA();
    for (int r_11 = 0; r_11 < RW4_11; ++r_11) { asm volatile("" ::: "memory");
    for (int job = wave; job < 16; job += 4) {
        const int kind = job >> 2, p = (job >> 1) & 1, q = job & 1; f32x16 acc = {};
        if (kind == 0) {
            acc = mm_ll<4>(W1C + 32 * p * 72, 72, NRB + 32 * q * 72, 72, lane, acc);
            FA fa;
#pragma unroll
            for (int g = 0; g < 16; ++g) fa[g] = acc[g] + bf2f(RT[(32 * q + tl) * 72 + 32 * p + crow(g, hi)]);
            st_frag(GT, (p * 2 + q) * 2 + 0, lane, packfrag(fa, 0)); st_frag(GT, (p * 2 + q) * 2 + 1, lane, packfrag(fa, 1));
        } else if (kind == 1) {
            acc = mm_ll<4>(W2C + 32 * p * 72, 72, NRB + 32 * q * 72, 72, lane, acc); acc = mm_ll<4>(VC + 32 * p * 72, 72, NRK + 32 * q * 72, 72, lane, acc);
            st_tile_bf16(Y0T, p * 2 + q, lane, acc);
        } else if (kind == 2) {
            acc = mm_ll<4>(W1C + 32 * p * 72, 72, BHC + 32 * q * 72, 72, lane, acc);
            FA fa = toFA(acc);
            if (p == q) { const float pc = fexp(LCv[32 * q + tl]);
#pragma unroll
                for (int g = 0; g < 16; ++g) if (crow(g, hi) == tl) fa[g] += pc; }
            st_frag(PHI, (p * 2 + q) * 2 + 0, lane, packfrag(fa, 0)); st_frag(PHI, (p * 2 + q) * 2 + 1, lane, packfrag(fa, 1));
        } else {
            acc = mm_ll<4>(BHC + 32 * p * 72, 72, W2C + 32 * q * 72, 72, lane, acc); acc = mm_ll<4>(KHC + 32 * p * 72, 72, VC + 32 * q * 72, 72, lane, acc);
            st_tile_bf16(PSI, p * 2 + q, lane, acc);
        }
    }
    }
}
#undef GBA

typedef float f32x2 __attribute__((ext_vector_type(2)));
constexpr int IX4 = RL_END, IX4_CAP = 256;
#ifndef IX_PF
#define IX_PF 2
#endif
#ifndef IXR_SEL
#define IXR_SEL 1
#endif
#define GBB() gbar(gcnt, gtarget, lane)
DI void ld_ktile(const _Float16* kbase, int kt, int ktmax, f16x8 (&d)[4]) {
    const _Float16* p = kbase + (size_t)(32 * min(kt, ktmax)) * PLD;
#pragma unroll
    for (int s = 0; s < 4; ++s) d[s] = *(const f16x8*)(p + 16 * s);
}
DI void idx_item4(Ctx& C, int item, int l, const int ixb, LAS unsigned* gcnt, unsigned& gtarget) {
    const int b = item & 3, qt = 1023 - (item >> 2);
    const int t0 = qt * 4, chunk = t0 >> 6, NT32 = 2 * (chunk + 1);
    const size_t tok0 = (size_t)b * SEQ + t0;
    unsigned* bm = (unsigned*)(C.ws + WS_BM);
    int lane = C.lane, wave = C.wave & 3, tid = C.tid & 255;
    asm volatile("" : "+v"(lane), "+v"(tid), "+s"(wave));
    if (chunk < 4) {
        if (tid < 4 * NT32) { const int q = tid / NT32, kt = tid % NT32; bm[(tok0 + q) * 128 + kt] = 0xffffffffu; }
        return;
    }
    const _Float16* ph = (const _Float16*)(C.ws + WS_PROJ);
    LAS unsigned* hist = (LAS unsigned*)(C.lds + ixb);
    LAS float* cand = (LAS float*)(C.lds + ixb + 4096);
    LAS float* redmn = (LAS float*)(C.lds + ixb + 4096 + 8 * IX4_CAP * 4);
    LAS float* redmx = redmn + 16;
    LAS unsigned* ccount = (LAS unsigned*)(redmx + 16);
    LAS float* thrS = (LAS float*)(ccount + 4);
    LAS int* thrI = (LAS int*)(thrS + 4);
    LAS unsigned* ovf = (LAS unsigned*)(thrI + 4);
    LAS unsigned* fbT = ovf + 4;
    LAS unsigned* fbCnt = fbT + 4;
    LAS unsigned* fbNeed = fbCnt + 4;
    const int r = lane & 31, hh = lane >> 5;
    float sc[32][2];
    {
        f16x8 afr[4]; float wq[2][8];
        {
            const int gq = (r >> 2) & 1, i = r >> 3, jj = r & 3, query = 2 * gq + (i >> 1), head = 4 * (i & 1) + jj;
            const _Float16* qp = ph + (tok0 + query) * PLD + PC_QI + head * 64 + 8 * hh;
#pragma unroll
            for (int s = 0; s < 4; ++s) afr[s] = *(const f16x8*)(qp + 16 * s);
#pragma unroll
            for (int qq = 0; qq < 2; ++qq) { const int q2 = 2 * hh + qq; const f16x8 wv = *(const f16x8*)(ph + (tok0 + q2) * PLD + PC_WI);
#pragma unroll
                for (int e = 0; e < 8; ++e) wq[qq][e] = (float)wv[e] * 0.044194173824159216f; }
        }
        const _Float16* kbase = ph + ((size_t)b * SEQ + r) * PLD + PC_KI + 8 * hh;
        f16x8 bq[IX_PF][4];
#pragma unroll
        for (int d = 0; d < IX_PF - 1; ++d) ld_ktile(kbase, wave + 4 * d, NT32 - 1, bq[d]);
#pragma unroll
        for (int it = 0; it < 32; ++it) {
            const int kt = wave + 4 * it;
            if (kt < NT32) {
                if (kt + 4 * (IX_PF - 1) < NT32) ld_ktile(kbase, kt + 4 * (IX_PF - 1), NT32 - 1, bq[(it + IX_PF - 1) % IX_PF]);
                f32x16 c = {};
#pragma unroll
                for (int s = 0; s < 4; ++s) c = __builtin_amdgcn_mfma_f32_32x32x16_f16(afr[s], bq[it % IX_PF][s], c, 0, 0, 0);
#pragma unroll
                for (int qq = 0; qq < 2; ++qq) { float a = 0.f;
#pragma unroll
                    for (int e = 0; e < 8; ++e) a += wq[qq][e] * fmaxf(c[8 * qq + e], 0.f);
                    sc[it][qq] = a; }
            } else { sc[it][0] = -3.0e38f; sc[it][1] = -3.0e38f; }
        }
    }
    for (int rl_ = 0; rl_ < IXR_SEL; ++rl_) { asm volatile("" ::: "memory");
    float mn[2], mx[2];
#pragma unroll
    for (int qq = 0; qq < 2; ++qq) { float me = -3.0e38f, mo = -3.0e38f;
#pragma unroll
        for (int it = 0; it < 32; it += 2) { me = fmaxf(me, sc[it][qq]); mo = fmaxf(mo, sc[it + 1][qq]); }
        float a = fminf(me, mo), z = fmaxf(me, mo);
#pragma unroll
        for (int o = 1; o < 32; o <<= 1) { a = fminf(a, __shfl_xor(a, o)); z = fmaxf(z, __shfl_xor(z, o)); }
        mn[qq] = a; mx[qq] = z; }
    if (r == 0) {
#pragma unroll
        for (int qq = 0; qq < 2; ++qq) { const int qid = 2 * hh + qq; redmn[wave * 4 + qid] = mn[qq]; redmx[wave * 4 + qid] = mx[qq]; }
    }
    { u32x4 z4 = {0u, 0u, 0u, 0u}; *(LAS u32x4*)(hist + 4 * tid) = z4; }
    if (tid < 4) { ccount[tid] = 0u; ovf[tid] = 0u; }
    GBB();
    unsigned pk[2][8];
#pragma unroll
    for (int qq = 0; qq < 2; ++qq) { const int qid = 2 * hh + qq; float a = 3.0e38f, z = -3.0e38f;
#pragma unroll
        for (int w = 0; w < 4; ++w) { a = fminf(a, redmn[w * 4 + qid]); z = fmaxf(z, redmx[w * 4 + qid]); }
        const float scl = (z > a) ? fminf(253.f / (z - a), 1.0e30f) : 1.f; const float nlo = 1.5f - a * scl;
#pragma unroll
        for (int g8 = 0; g8 < 8; ++g8) { unsigned p = 0u;
            if (wave + 16 * g8 < NT32) {
#pragma unroll
                for (int e = 0; e < 4; ++e) p = __builtin_amdgcn_cvt_pk_u8_f32(__builtin_amdgcn_fmed3f(__builtin_fmaf(sc[4 * g8 + e][qq], scl, nlo), 0.f, 255.f), e, p);
#pragma unroll
                for (int e = 0; e < 4; ++e) { const unsigned pb = (p >> (8 * e)) & 255u; if (pb) __hip_atomic_fetch_add(hist + qid * 256 + pb, 1u, __ATOMIC_RELAXED, __HIP_MEMORY_SCOPE_WORKGROUP); }
            }
            pk[qq][g8] = p; } }
    GBB();
    int B[2]; unsigned above[2];
#pragma unroll
    for (int qq = 0; qq < 2; ++qq) { const int qid = 2 * hh + qq;
        const u32x4 h0 = *(const LAS u32x4*)(hist + qid * 256 + 8 * r), h1 = *(const LAS u32x4*)(hist + qid * 256 + 8 * r + 4);
        const unsigned tot = (h0.x + h0.y) + (h0.z + h0.w) + (h1.x + h1.y) + (h1.z + h1.w); unsigned incl = tot;
#pragma unroll
        for (int o = 1; o < 32; o <<= 1) { const unsigned v = __shfl_down(incl, o, 32); if (r + o < 32) incl += v; }
        unsigned run = incl - tot; int Bf = -1; unsigned ab = 0; const unsigned hv8[8] = {h0.x, h0.y, h0.z, h0.w, h1.x, h1.y, h1.z, h1.w};
#pragma unroll
        for (int j = 7; j >= 0; --j) { const unsigned hv = hv8[j]; if (run < 256u && run + hv >= 256u) { Bf = 8 * r + j; ab = run; } run += hv; }
        const unsigned long long mk = __ballot(Bf >= 0);
        const unsigned mh = hh ? (unsigned)(mk >> 32) : (unsigned)mk;
        const int src = 32 * hh + (mh ? __builtin_ctz(mh) : 0);
        B[qq] = __shfl(Bf, src); above[qq] = (unsigned)__shfl((int)ab, src); }
#define IX_PB(it, qq) ((int)((pk[qq][(it) >> 2] >> (8 * ((it) & 3))) & 255u))
#define IX_LAUNDER() do { _Pragma("unroll") for (int it_ = 0; it_ < 32; ++it_) { asm volatile("" : "+v"(sc[it_][0]), "+v"(sc[it_][1])); } asm volatile("" : "+v"(B[0]), "+v"(B[1])); } while (0)
#pragma unroll
    for (int qq = 0; qq < 2; ++qq) { const int qid = 2 * hh + qq;
#pragma unroll
        for (int g8 = 0; g8 < 8; ++g8) if (wave + 16 * g8 < NT32) {
#pragma unroll
            for (int e = 0; e < 4; ++e) { const int it = 4 * g8 + e; const bool hit = (IX_PB(it, qq) == B[qq]);
                if (__any(hit)) { if (hit) { const unsigned pos = __hip_atomic_fetch_add(ccount + qid, 1u, __ATOMIC_RELAXED, __HIP_MEMORY_SCOPE_WORKGROUP);
                    if (pos < (unsigned)IX4_CAP) { f32x2 cv; cv.x = sc[it][qq]; cv.y = __builtin_bit_cast(float, 32 * (wave + 4 * it) + r); *(LAS f32x2*)(cand + (qid * IX4_CAP + pos) * 2) = cv; } } } } } }
    GBB();
    {
        const int c = (int)ccount[wave];
        const unsigned abq = (wave & 1) ? above[1] : above[0];
        const int need = 256 - (int)__shfl((int)abq, 32 * (wave >> 1));
        if (c <= IX4_CAP) {
            LAS float* cw = cand + wave * IX4_CAP * 2;
            if ((c & 1) && lane == 0) { f32x2 cv; cv.x = -3.0e38f; cv.y = __builtin_bit_cast(float, 0x7fffffff); *(LAS f32x2*)(cw + 2 * c) = cv; }
            asm volatile("" ::: "memory");
            for (int i = lane; i < c; i += 64) { const f32x2 ci = *(const LAS f32x2*)(cw + 2 * i); const float si = ci.x; const int ii = __float_as_int(ci.y); int rank = 0;
                for (int j = 0; j < c; j += 2) { const f32x4 cj = *(const LAS f32x4*)(cw + 2 * j);
                    rank += ((cj.x > si) || (cj.x == si && __float_as_int(cj.y) < ii)) ? 1 : 0; rank += ((cj.z > si) || (cj.z == si && __float_as_int(cj.w) < ii)) ? 1 : 0; }
                if (rank == need - 1) { thrS[wave] = si; thrI[wave] = ii; } }
        } else if (lane == 0) { ovf[wave] = 1u; fbNeed[wave] = (unsigned)need; fbT[wave] = 0u; }
    }
    GBB();
    unsigned anyovf = 0u;
#pragma unroll
    for (int q = 0; q < 4; ++q) anyovf |= ovf[q];
#ifndef IX_NOFB
#define IX_NOFB 0
#endif
    if (anyovf && !IX_NOFB) {
        for (int bit = 31; bit >= 0; --bit) {
            if (tid < 4) fbCnt[tid] = 0u;
            GBB();
            IX_LAUNDER();
#pragma unroll
            for (int qq = 0; qq < 2; ++qq) { const int qid = 2 * hh + qq; if (ovf[qid]) { const unsigned cd = fbT[qid] | (1u << bit); unsigned cnt = 0;
#pragma unroll
                for (int it = 0; it < 32; ++it) cnt += (IX_PB(it, qq) == B[qq] && ordkey(sc[it][qq]) >= cd) ? 1u : 0u;
                if (cnt) __hip_atomic_fetch_add(fbCnt + qid, cnt, __ATOMIC_RELAXED, __HIP_MEMORY_SCOPE_WORKGROUP); } }
            GBB();
            if (tid < 4 && ovf[tid] && fbCnt[tid] >= fbNeed[tid]) fbT[tid] |= (1u << bit);
            GBB();
        }
        if (tid < 4) fbCnt[tid] = 0u;
        GBB();
        IX_LAUNDER();
#pragma unroll
        for (int qq = 0; qq < 2; ++qq) { const int qid = 2 * hh + qq; if (ovf[qid]) { const unsigned Tk = fbT[qid]; unsigned cnt = 0;
#pragma unroll
            for (int it = 0; it < 32; ++it) cnt += (IX_PB(it, qq) == B[qq] && ordkey(sc[it][qq]) > Tk) ? 1u : 0u;
            if (cnt) __hip_atomic_fetch_add(fbCnt + qid, cnt, __ATOMIC_RELAXED, __HIP_MEMORY_SCOPE_WORKGROUP); } }
        GBB();
        if (tid < 4 && ovf[tid]) { fbNeed[tid] -= fbCnt[tid]; thrS[tid] = unordkey(fbT[tid]); thrI[tid] = 0; }
        GBB();
        for (int bit = 11; bit >= 0; --bit) {
            if (tid < 4) fbCnt[tid] = 0u;
            GBB();
            IX_LAUNDER();
#pragma unroll
            for (int qq = 0; qq < 2; ++qq) { const int qid = 2 * hh + qq; if (ovf[qid]) { const unsigned Tk = fbT[qid]; const int cd = thrI[qid] | (1 << bit); unsigned cnt = 0;
#pragma unroll
                for (int it = 0; it < 32; ++it) cnt += (IX_PB(it, qq) == B[qq] && ordkey(sc[it][qq]) == Tk && (32 * (wave + 4 * it) + r) < cd) ? 1u : 0u;
                if (cnt) __hip_atomic_fetch_add(fbCnt + qid, cnt, __ATOMIC_RELAXED, __HIP_MEMORY_SCOPE_WORKGROUP); } }
            GBB();
            if (tid < 4 && ovf[tid] && fbCnt[tid] < fbNeed[tid]) thrI[tid] |= (1 << bit);
            GBB();
        }
    }
#pragma unroll
    for (int qq = 0; qq < 2; ++qq) { const int qid = 2 * hh + qq; const float ts = thrS[qid]; const int ti = thrI[qid] - 32 * wave - r;
        unsigned myw = 0u;
#pragma unroll
        for (int g8 = 0; g8 < 8; ++g8) if (wave + 16 * g8 < NT32) {
#pragma unroll
            for (int e = 0; e < 4; ++e) { const int it = 4 * g8 + e; const float s = sc[it][qq];
                const bool sel = (s > ts) | ((s == ts) & (128 * it <= ti));
                const unsigned long long mk = __builtin_amdgcn_ballot_w64(sel);
                const unsigned wv = hh ? (unsigned)(mk >> 32) : (unsigned)mk;
                if (r == it) myw = wv; } }
        if (wave + 4 * r < NT32) bm[(tok0 + qid) * 128 + wave + 4 * r] = myw; }
    }
#undef IX_PB
#undef IX_LAUNDER
}
#undef GBB

constexpr int NCV_GU = 4096, NCV_DN = 2048, NCV_PG = 512, NCV_PL = 128, NCV = NCV_GU + NCV_DN + NCV_PG + NCV_PL;
DI void conv_flat_item(Ctx& C, int l, int w, LAS float* scr) {
    if (w < NCV_GU) { ColGateUp c{C.in(20) + (size_t)l * NEXP * D * DEXP, C.in(21) + (size_t)l * NEXP * D * DEXP}; transpose_item(c, DEXP, D, (bf16_t*)(C.ws + WS_WEXP), 32 * (w & 255), 64 * (w >> 8), scr, C.lane); return; }
    w -= NCV_GU;
    if (w < NCV_DN) { const int e = w >> 7, r = w & 127; ColDown c{C.in(22) + ((size_t)l * NEXP + e) * DEXP * D}; transpose_item(c, D, DEXP, (bf16_t*)(C.ws + WS_WDOWN) + (size_t)e * D * DEXP, 32 * (r & 31), 64 * (r >> 5), scr, C.lane); return; }
    w -= NCV_DN;
    if (w < NCV_PG) { ColPlain c{C.in(24) + (size_t)l * D * D}; transpose_item(c, D, D, (bf16_t*)(C.ws + WS_WPG), 32 * (w & 31), 64 * (w >> 5), scr, C.lane); return; }
    w -= NCV_PG;
    { ColPlain c{C.in(23) + (size_t)l * PLE * D}; transpose_item(c, D, PLE, (bf16_t*)(C.ws + WS_WPLE), 32 * (w & 31), 64 * (w >> 5), scr, C.lane); }
}
DI void phase_ln_router(Ctx& C, int l) {
    const bf16_t* V = (const bf16_t*)(C.ws + WS_V);
    const float* g = C.in(25) + (size_t)l * D; const float* bta = C.in(26) + (size_t)l * D;
    const float* wr = C.in(18); const float* br = C.in(19);
    LAS unsigned* lcnt = (LAS unsigned*)C.lds; LAS unsigned* base = lcnt + 16; LAS int* rec = (LAS int*)(C.lds + 128);
    TokInfo* tok = (TokInfo*)(C.ws + WS_TOK); RowInfo* rowi = (RowInfo*)(C.ws + WS_ROW);
    unsigned* gcnt = C.ctl + CW_GCNT + 64 * l;
    for (int i = C.blk * NTHR + C.tid; i < MAXROWS; i += C.G * NTHR) { RowInfo ri; ri.token = -1; ri.slot = 0; ri.gate = 0.f; ri.pad = 0; rowi[i] = ri; }
    LAS float* wT = (LAS float*)(C.lds + 4096);
    __syncthreads();
    for (int i = C.tid; i < D * 16; i += NTHR) { const int d = i >> 4, e = i & 15; wT[e * D + d] = wr[i]; }
    const int cgw = C.blk * NWAVES + C.wave, cNGW = C.G * NWAVES; LAS float* cscr = (LAS float*)(C.lds + 70656 + C.wave * 8448);
    for (int rb = C.blk; rb < T / 64; rb += C.G) {
        __syncthreads();
        if (C.tid < 16) lcnt[C.tid] = 0u;
        __syncthreads();
#pragma unroll 1
        for (int i4 = 0; i4 < 8; i4 += 2) {
          const int cw_ = cgw + (i4 >> 1) * cNGW; const bool cdo_ = (rb == C.blk) && cw_ < NCV;
          if (cdo_ && C.wave >= 4) conv_flat_item(C, l, cw_, cscr);
          f32x4 vv[8]; float lgg[32];
          { u32x2 raw[8];
#pragma unroll
            for (int r = 0; r < 2; ++r)
#pragma unroll
                for (int j = 0; j < 4; ++j) raw[4 * r + j] = *(const u32x2*)(V + ((size_t)rb * 64 + C.wave * 8 + i4 + r) * D + 256 * j + 4 * C.lane);
#pragma unroll
            for (int r = 0; r < 2; ++r) { f32x4 t[4];
#pragma unroll
                for (int j = 0; j < 4; ++j) { const u32x2 o = raw[4 * r + j]; t[j] = (f32x4){bflo(o.x), bfhi(o.x), bflo(o.y), bfhi(o.y)}; }
                ln16(t, g, bta, C.lane);
                store_row_bf16(C.xcur + ((size_t)rb * 64 + C.wave * 8 + i4 + r) * D, t, C.lane);
#pragma unroll
                for (int j = 0; j < 4; ++j) vv[4 * r + j] = t[j]; } }
#pragma unroll
          for (int k = 0; k < 32; ++k) lgg[k] = 0.f;
#pragma unroll
          for (int e = 0; e < 16; ++e)
#pragma unroll
              for (int j = 0; j < 4; ++j) { const f32x4 w4 = *(const LAS f32x4*)(wT + e * D + 256 * j + 4 * C.lane);
#pragma unroll
                  for (int r = 0; r < 2; ++r) { const f32x4 x = vv[4 * r + j]; lgg[16 * r + e] += (x.x * w4.x + x.y * w4.y) + (x.z * w4.z + x.w * w4.w); } }
#pragma unroll
          for (int k = 0; k < 32; ++k) lgg[k] = wave_sum(lgg[k]);
#pragma unroll
          for (int r = 0; r < 2; ++r) {
            const int lr = C.wave * 8 + i4 + r;
            float sc[16], sl[16];
#pragma unroll
            for (int e = 0; e < 16; ++e) { const float t = lgg[16 * r + e]; sc[e] = 1.f / (1.f + expf(-t)); sl[e] = sc[e] + br[e]; }
            int best = 0; float bestv = -3.0e38f;
#pragma unroll
            for (int gq = 0; gq < 4; ++gq) { const float a = sl[4 * gq], b2 = sl[4 * gq + 1], c2 = sl[4 * gq + 2], d2 = sl[4 * gq + 3];
                const float mx1 = fmaxf(fmaxf(a, b2), fmaxf(c2, d2)); const float tot = a + b2 + c2 + d2; const float mn1 = fminf(fminf(a, b2), fminf(c2, d2));
                const float lo1 = fminf(a, b2), hi1 = fmaxf(a, b2), lo2 = fminf(c2, d2), hi2 = fmaxf(c2, d2);
                const float second = fmaxf(fminf(hi1, hi2), fmaxf(lo1, lo2));
                (void)tot; (void)mn1;
                const float gs = mx1 + second; if (gs > bestv) { bestv = gs; best = gq; } }
            int i0 = 0, i1 = 0; float v0 = -3.0e38f, v1 = -3.0e38f, s0 = 0.f, s1 = 0.f;
#pragma unroll
            for (int gq = 0; gq < 4; ++gq) if (gq == best) {
#pragma unroll
                for (int k = 0; k < 4; ++k) { const float x = sl[4 * gq + k]; if (x > v0) { v1 = v0; i1 = i0; s1 = s0; v0 = x; i0 = 4 * gq + k; s0 = sc[4 * gq + k]; } else if (x > v1) { v1 = x; i1 = 4 * gq + k; s1 = sc[4 * gq + k]; } } }
            const float den = s0 + s1; const float g0 = s0 / den, g1 = s1 / den;
            if (C.lane == 0) {
                const unsigned r0 = __hip_atomic_fetch_add(lcnt + i0, 1u, __ATOMIC_RELAXED, __HIP_MEMORY_SCOPE_WORKGROUP);
                const unsigned r1 = __hip_atomic_fetch_add(lcnt + i1, 1u, __ATOMIC_RELAXED, __HIP_MEMORY_SCOPE_WORKGROUP);
                rec[lr * 8 + 0] = i0; rec[lr * 8 + 1] = i1; rec[lr * 8 + 2] = (int)r0; rec[lr * 8 + 3] = (int)r1;
                rec[lr * 8 + 4] = __builtin_bit_cast(int, g0); rec[lr * 8 + 5] = __builtin_bit_cast(int, g1); }
          }
          if (cdo_ && C.wave < 4) conv_flat_item(C, l, cw_, cscr);
        }
        __syncthreads();
        if (C.tid < 16) base[C.tid] = __hip_atomic_fetch_add(gcnt + C.tid, lcnt[C.tid], __ATOMIC_RELAXED, __HIP_MEMORY_SCOPE_AGENT);
        __syncthreads();
        if (C.tid < 64) { TokInfo ti; ti.e0 = rec[C.tid * 8]; ti.e1 = rec[C.tid * 8 + 1]; ti.p0 = rec[C.tid * 8 + 2] + (int)base[ti.e0]; ti.p1 = rec[C.tid * 8 + 3] + (int)base[ti.e1];
            ti.g0 = __builtin_bit_cast(float, rec[C.tid * 8 + 4]); ti.g1 = __builtin_bit_cast(float, rec[C.tid * 8 + 5]); ti.pad0 = 0; ti.pad1 = 0; tok[(size_t)rb * 64 + C.tid] = ti; }
    }
    for (int w = cgw + 4 * cNGW; w < NCV; w += cNGW) conv_flat_item(C, l, w, cscr);
}
DI int build_tile_table(Ctx& C, int l, LAS int* toff, LAS int* texp) {
    const unsigned* gcnt = C.ctl + CW_GCNT + 64 * l;
    __syncthreads();
    if (C.tid < 64) {
        int c = 0; if (C.lane < 16) c = (int)__hip_atomic_load(gcnt + C.lane, __ATOMIC_RELAXED, __HIP_MEMORY_SCOPE_AGENT);
        const int nt = (c + 255) >> 8; int incl = nt;
#pragma unroll
        for (int o = 1; o < 16; o <<= 1) { const int v = __shfl_up(incl, o); if (C.lane >= o) incl += v; }
        const int start = incl - nt;
        if (C.lane < 16) { toff[C.lane] = start << 8; for (int t = 0; t < nt; ++t) texp[start + t] = C.lane; }
        if (C.lane == 15) toff[16] = incl << 8; }
    __syncthreads();
    return toff[16] >> 8;
}
DI void phase_gather(Ctx& C, int l) {
    LAS int* toff = (LAS int*)(C.lds + 1024); LAS int* texp = (LAS int*)(C.lds + 2048);
    (void)build_tile_table(C, l, toff, texp);
    const TokInfo* tok = (const TokInfo*)(C.ws + WS_TOK); RowInfo* rowi = (RowInfo*)(C.ws + WS_ROW); bf16_t* AG = (bf16_t*)(C.ws + WS_AG);
    for (int m = C.blk * NTHR + C.tid; m < T; m += C.G * NTHR) {
        const TokInfo ti = tok[m];
        const int r0 = toff[ti.e0] + ti.p0, r1 = toff[ti.e1] + ti.p1;
        { RowInfo x; x.token = m; x.slot = 0; x.gate = ti.g0; x.pad = 0; rowi[r0] = x; x.slot = 1; x.gate = ti.g1; rowi[r1] = x; }
    }
}
DI void phase_ln_ffn(Ctx& C, int l) {
    const bf16_t* Y = (const bf16_t*)(C.ws + WS_Y);
    const float* g = C.in(27) + (size_t)l * D; const float* bta = C.in(28) + (size_t)l * D;
    const int gw = C.blk * NWAVES + C.wave, NGW = C.G * NWAVES;
    for (int m = gw; m < T; m += NGW) {
        f32x4 x[4], y0[4], y1[4];
        load_row_bf16(C.xcur + (size_t)m * D, x, C.lane); load_row_bf16(Y + (size_t)m * D, y0, C.lane); load_row_bf16(Y + ((size_t)T + m) * D, y1, C.lane);
#pragma unroll
        for (int j = 0; j < 4; ++j) x[j] = x[j] * ALPHA + (y0[j] + y1[j]);
        ln16(x, g, bta, C.lane);
        store_row_bf16(C.xcur + (size_t)m * D, x, C.lane);
    }
}
DI void phase_ln_ple(Ctx& C, int l, bool last) {
    const bf16_t* V = (const bf16_t*)(C.ws + WS_V3);
    const float* g = C.in(29) + (size_t)l * D; const float* bta = C.in(30) + (size_t)l * D;
    const int gw = C.blk * NWAVES + C.wave, NGW = C.G * NWAVES;
    for (int m = gw; m < T; m += NGW) {
        f32x4 v[4];
        load_row_bf16(V + (size_t)m * D, v, C.lane);
        ln16(v, g, bta, C.lane);
        if (last) {
#ifdef PROBE_PHASE
            { const unsigned long long* pt = (const unsigned long long*)(C.ws + WS_CTL + 32768); const float sc = 1.f + (float)(pt[1] - pt[0]) * (float)(PROBE_SCALE);
#pragma unroll
              for (int j = 0; j < 4; ++j) v[j] = v[j] * sc; }
#endif
#pragma unroll
            for (int j = 0; j < 4; ++j) *(f32x4*)(C.out + (size_t)m * D + 256 * j + 4 * C.lane) = v[j];
        } else store_row_bf16(C.xcur + (size_t)m * D, v, C.lane);
    }
}

constexpr int LDS_BYTES = 163840;
constexpr int PH_PER_LAYER = 13, NPHASE = 1 + DEPTH * PH_PER_LAYER;

constexpr int CW_AQ = 2048;
DI void convert_mixer_weights(Ctx& C, int l) {
    int first = 0;
    { ColPlain c{C.in(5) + (size_t)l * D * D}; convert_matrix(C, c, D, D, D, (bf16_t*)(C.ws + WS_WOUT), first); }
    { ColPlain c{C.in(8) + (size_t)l * 64 * 512}; convert_matrix(C, c, 512, 64, 512, (bf16_t*)(C.ws + WS_LORA), first); }
    { ColPlain c{C.in(10) + (size_t)l * 64 * 512}; convert_matrix(C, c, 512, 64, 512, (bf16_t*)(C.ws + WS_LORA) + 512 * 64, first); }
    { ColPlain c{C.in(11) + (size_t)l * 128 * 512}; convert_matrix(C, c, 512, 128, 512, (bf16_t*)(C.ws + WS_LORA) + 2 * 512 * 64, first); }
}
DI void convert_ffn_weights(Ctx& C, int l) {
    const float* p = C.in(1) + (size_t)l * T * PLE; bf16_t* pb = (bf16_t*)(C.ws + WS_PBF);
    const size_t pstr = (size_t)C.G * NTHR * 8;
    for (size_t i0 = ((size_t)C.blk * NTHR + C.tid) * 8; i0 < (size_t)T * PLE; i0 += 4 * pstr) {
        f32x4 a[4], b[4];
#pragma unroll
        for (int k = 0; k < 4; ++k) { const size_t i = i0 + k * pstr; if (i < (size_t)T * PLE) { a[k] = *(const f32x4*)(p + i); b[k] = *(const f32x4*)(p + i + 4); } }
#pragma unroll
        for (int k = 0; k < 4; ++k) { const size_t i = i0 + k * pstr; if (i < (size_t)T * PLE) { u32x4 o; o.x = pk2(a[k].x, a[k].y); o.y = pk2(a[k].z, a[k].w); o.z = pk2(b[k].x, b[k].y); o.w = pk2(b[k].z, b[k].w); *(u32x4*)(pb + i) = o; } } }
}
#ifndef RWREP
#define RWREP 1
#endif
#ifndef IQREP
#define IQREP 1
#endif
#ifndef REP_SUB
#define REP_SUB 0
#endif
#ifndef REP_SP
#define REP_SP -1
#define REP_N 1
#endif
template <int SP> DI void run_sp_(Ctx& C, const int l, const int rep);
template <int SP> DI void run_sp(Ctx& C, const int l) { run_sp_<SP>(C, l, 0); }
template <int SP> DI void run_sp_(Ctx& C, const int l, const int rep) {
    if constexpr (SP == 0) {
        pg8::Gemm g{C.xcur, (const bf16_t*)(C.ws + WS_WEXP), T, NPROJ_PAD, opaque_i(D)}; pg8::StaticOrder S; S.init(T, NPROJ_PAD, C.G, C.blk);
        EpiProj E{(bf16_t*)(C.ws + WS_PROJ)};
        pg8::gemm_phase<EpiProj, pg8::StaticOrder, true, true>(C.lds, g, S, E);
    } else if constexpr (SP == 1) {
    } else if constexpr (SP == 2) {
        LAS unsigned* gb = (LAS unsigned*)(C.lds + GB_OFF);
        if (C.tid < 8) gb[C.tid] = 0u;
        __syncthreads();
        const int half = C.wave >> 2, ltid = C.tid & 255;
        LAS unsigned* gcnt = gb + half; unsigned gtarget = 0u;
        LAS int* slot = (LAS int*)(gb + 2 + 2 * half);
        unsigned* iq = C.ctl + CW_AQ + 32 + 64 * l + 256 * rep;
        int nxt = 0, par = 0;
        if (half == 0) {
            for (int rw_ = 0; rw_ < RWREP; ++rw_)
            for (int bc = C.blk; bc < 256; bc += C.G) { bf16x8 actv[8]; rwkv_chunk_acts4(C, bc, l, actv); for (int h = 0; h < 8; ++h) rwkv_head_item4(C, bc * 8 + h, l, actv, gcnt, gtarget); }
        }
        const int ixb = half ? IX4 : 0;
        if (ltid == 0) nxt = (int)__hip_atomic_fetch_add(iq, 1u, __ATOMIC_RELAXED, __HIP_MEMORY_SCOPE_AGENT);
        for (;;) {
            if (ltid == 0) slot[par] = nxt;
            gbar(gcnt, gtarget, C.lane);
            const int u = __builtin_amdgcn_readfirstlane(slot[par]); par ^= 1;
            if (u >= 4096) break;
            if (ltid == 0) nxt = (int)__hip_atomic_fetch_add(iq, 1u, __ATOMIC_RELAXED, __HIP_MEMORY_SCOPE_AGENT);
            idx_item4(C, u, l, ixb, gcnt, gtarget);
        }
    } else if constexpr (SP == 3) {
        if (C.blk < 8 && (rep == 0 || REP_SUB != 2)) rwkv_scan_wave(C, C.blk * 8 + C.wave);
        LAS int* qs = (LAS int*)(C.lds + LDS_BYTES - 128);
        if (rep == 0 || REP_SUB != 1)
        for (;;) {
            __syncthreads();
            if (C.tid == 0) qs[0] = (int)__hip_atomic_fetch_add(C.ctl + CW_AQ + 64 * l + 256 * rep, 1u, __ATOMIC_RELAXED, __HIP_MEMORY_SCOPE_AGENT);
            __syncthreads();
            const int u = __builtin_amdgcn_readfirstlane(qs[0]);
            if (u >= 512) break;
            const int qb = 15 - (u >> 5), bh = u & 31; attn_unit(C, bh >> 3, bh & 7, qb);
        }
    } else if constexpr (SP == 4) {
        const int gw = C.blk * NWAVES + C.wave, NGW = C.G * NWAVES;
        for (int id = gw; id < 2048; id += NGW) rwkv_out_wave(C, id, l);
    } else if constexpr (SP == 5) {
        pg8::Gemm g{C.mixcat, (const bf16_t*)(C.ws + WS_WOUT), T, D, opaque_i(D)}; pg8::StaticOrder S; S.init(T, D, C.G, C.blk);
        EpiResF32 E{C.xcur, (bf16_t*)(C.ws + WS_V)};
        pg8::gemm_phase<EpiResF32, pg8::StaticOrder, true, true>(C.lds, g, S, E);
    } else if constexpr (SP == 6) { phase_ln_router(C, l); convert_ffn_weights(C, l);
    } else if constexpr (SP == 7) { phase_gather(C, l);
    } else if constexpr (SP == 8) {
        LAS int* toff = (LAS int*)(C.lds + 135168); LAS int* texp = (LAS int*)(C.lds + 136192);
        const int nt = build_tile_table(C, l, toff, texp);
        pg8::Gemm g{C.xcur, (const bf16_t*)(C.ws + WS_WEXP), MAXROWS, NEXP * 512, opaque_i(D)};
        GroupedOrder<2> S{texp, nt, C.G, C.blk};
        EpiSwiGLU E{(bf16_t*)(C.ws + WS_H), (const RowInfo*)(C.ws + WS_ROW)};
        pg8::gemm_phase_gather<EpiSwiGLU, GroupedOrder<2>, true>(C.lds, g, S, E, (const int*)(C.ws + WS_ROW));
        {
            const int extra = (2 * nt > C.G) ? (2 * nt - C.G) : 0; const int nb = C.G - extra;
            if (C.blk >= extra && nb > 0) { pg8::Gemm g2{(const bf16_t*)(C.ws + WS_PBF), (const bf16_t*)(C.ws + WS_WPLE), T, D, opaque_i(PLE)}; pg8::StaticOrder S2; S2.init(T, D, nb, C.blk - extra);
                EpiBf16Plain E2{(bf16_t*)(C.ws + WS_PE), D};
                pg8::gemm_phase<EpiBf16Plain, pg8::StaticOrder, true, true>(C.lds, g2, S2, E2); } }
    } else if constexpr (SP == 9) {
        LAS int* toff = (LAS int*)(C.lds + 135168); LAS int* texp = (LAS int*)(C.lds + 136192);
        const int nt = build_tile_table(C, l, toff, texp);
        { pg8::Gemm g{(const bf16_t*)(C.ws + WS_H), (const bf16_t*)(C.ws + WS_WDOWN), MAXROWS, NEXP * D, opaque_i(DEXP)};
          GroupedOrder<4> S{texp, nt, C.G, C.blk};
          EpiDown E{(bf16_t*)(C.ws + WS_Y), (const RowInfo*)(C.ws + WS_ROW)};
          pg8::gemm_phase<EpiDown, GroupedOrder<4>, true, true>(C.lds, g, S, E); }
    } else if constexpr (SP == 10) { phase_ln_ffn(C, l);
    } else if constexpr (SP == 11) {
        pg8::Gemm g{C.xcur, (const bf16_t*)(C.ws + WS_WPG), T, D, opaque_i(D)}; pg8::StaticOrder S; S.init(T, D, C.G, C.blk);
        EpiPle E{C.xcur, (const bf16_t*)(C.ws + WS_PE), (bf16_t*)(C.ws + WS_V3)};
        pg8::gemm_phase<EpiPle, pg8::StaticOrder, true, true>(C.lds, g, S, E);
    } else { phase_ln_ple(C, l, l == DEPTH - 1); if (l + 1 < DEPTH) { convert_win(C, l + 1); convert_mixer_weights(C, l + 1); } }
}
#define XB_TMO      128
#define XB_XCNT(j)  (256  + 64 * (j))
#define XB_XSUB(j)  (1280 + 64 * (j))
#define XB_XGEN(j)  (2304 + 64 * (j))
#define XB_TOP      3328
#define XB_TOPGEN   3392
#define XCD_BAR_WORDS 3456
#define XB_SPIN_CAP (1u << 18)

__device__ __forceinline__ unsigned xb_ld(unsigned* p)              { return __hip_atomic_load(p, __ATOMIC_RELAXED, __HIP_MEMORY_SCOPE_AGENT); }
__device__ __forceinline__ unsigned xb_add(unsigned* p, unsigned v) { return __hip_atomic_fetch_add(p, v, __ATOMIC_RELAXED, __HIP_MEMORY_SCOPE_AGENT); }
__device__ __forceinline__ unsigned xb_xcc_id() { return (unsigned)__builtin_amdgcn_s_getreg((3 << 11) | 20) & 0xFu; }
#define XB_SPIN(cond, bar) do { unsigned _sp = 0; while (cond) { __builtin_amdgcn_s_sleep(1); \
    if ((++_sp & 255u) == 0u) { if (xb_ld(&(bar)[XB_TMO])) break; if (_sp > XB_SPIN_CAP) { atomicAdd(&(bar)[XB_TMO], 1u); break; } } } } while (0)

struct XcdBarrier {
    unsigned* bar; unsigned x;
    volatile __attribute__((address_space(3))) unsigned* st;
};

__device__ __forceinline__ XcdBarrier xcd_barrier_post(unsigned* bar, volatile __attribute__((address_space(3))) unsigned* st) {
    XcdBarrier b; b.bar = bar; b.x = xb_xcc_id(); b.st = st;
    if (threadIdx.x == 0) (void)xb_add(&bar[XB_XCNT(b.x)], 1u);
    return b;
}
__device__ __forceinline__ void xcd_barrier_complete(unsigned* bar, unsigned x, unsigned& nloc, unsigned& nx) {
    const unsigned G = gridDim.x * gridDim.y * gridDim.z;
    unsigned sum, cnt, mine, sp = 0u;
    for (;;) {
        sum = 0u; cnt = 0u; mine = 0u;
#pragma unroll
        for (unsigned j = 0; j < 16; ++j) { const unsigned c = xb_ld(&bar[XB_XCNT(j)]); sum += c; cnt += (c > 0u) ? 1u : 0u; mine = (j == x) ? c : mine; }
        if (sum == G) break;
        __builtin_amdgcn_s_sleep(1);
        if ((++sp & 255u) == 0u) { if (xb_ld(&bar[XB_TMO])) break; if (sp > XB_SPIN_CAP) { atomicAdd(&bar[XB_TMO], 1u); break; } }
    }
    nloc = mine > 0u ? mine : 1u; nx = cnt > 0u ? cnt : 1u;
}

__device__ __forceinline__ void xcd_barrier(const XcdBarrier& b) {
    asm volatile("s_waitcnt vmcnt(0)" ::: "memory");
    __syncthreads();
    if (threadIdx.x == 0) {
        unsigned* bar = b.bar;
        __builtin_amdgcn_s_waitcnt(0);
        unsigned nloc = b.st[0], nx = b.st[1];
        if (nloc == 0u) { xcd_barrier_complete(bar, b.x, nloc, nx); b.st[0] = nloc; b.st[1] = nx; }
        const unsigned old = xb_add(&bar[XB_XSUB(b.x)], 1u);
        const unsigned gen = old / nloc;
        if (old + 1u == (gen + 1u) * nloc) {
            __builtin_amdgcn_fence(__ATOMIC_RELEASE, "agent");
            asm volatile("s_waitcnt vmcnt(0)" ::: "memory");
            const unsigned og = xb_add(&bar[XB_TOP], 1u);
            const unsigned tg = og / nx;
            if (og + 1u == (tg + 1u) * nx) xb_add(&bar[XB_TOPGEN], 1u);
            else XB_SPIN(xb_ld(&bar[XB_TOPGEN]) == tg, bar);
            __builtin_amdgcn_fence(__ATOMIC_ACQUIRE, "agent");
            xb_add(&bar[XB_XGEN(b.x)], 1u);
            asm volatile("s_waitcnt vmcnt(0)" ::: "memory");
        } else {
            XB_SPIN(xb_ld(&bar[XB_XGEN(b.x)]) == gen, bar);
            __builtin_amdgcn_fence(__ATOMIC_ACQUIRE, "agent");
            asm volatile("s_waitcnt vmcnt(0)" ::: "memory");
        }
    }
    __syncthreads();
}

constexpr int CW_XBAR = 65536;
typedef const __attribute__((address_space(4))) Args* KArgP;
DI void ctx_setup(Ctx& C) {
    int t_ = threadIdx.x; asm volatile("" : "+v"(t_)); C.tid = t_; C.lane = t_ & 63; C.wave = __builtin_amdgcn_readfirstlane(t_ >> 6);
    int b_ = blockIdx.x, g_ = gridDim.x; asm volatile("" : "+s"(b_), "+s"(g_)); C.blk = b_; C.G = g_;
    KArgP ap = (KArgP)__builtin_amdgcn_kernarg_segment_ptr(); asm volatile("" : "+s"(ap));
    C.ap = ap; C.out = ap->out; C.ws = ap->ws; C.ctl = (unsigned*)(ap->ws + WS_CTL); C.xcur = (bf16_t*)ap->out; C.mixcat = (bf16_t*)ap->out + (size_t)T * D;
}
__global__ void __launch_bounds__(NTHR, 2) mega_fwd(Args args) {
    extern __shared__ __attribute__((aligned(16))) unsigned char lds_raw[];
    Ctx C;
    C.lds = (LAS unsigned char*)lds_raw;
    cg::grid_group grid = cg::this_grid();
    volatile LAS unsigned* xbst = (volatile LAS unsigned*)(C.lds + LDS_BYTES - 32);
    if (threadIdx.x < 4) xbst[threadIdx.x] = 0u;
    __syncthreads();
    XcdBarrier xbar = xcd_barrier_post((unsigned*)(((KArgP)__builtin_amdgcn_kernarg_segment_ptr())->ws + WS_CTL) + CW_XBAR, xbst);
    const int lo = ((KArgP)__builtin_amdgcn_kernarg_segment_ptr())->ph_lo, hi = ((KArgP)__builtin_amdgcn_kernarg_segment_ptr())->ph_hi;
#ifdef PROBE_PHASE
#define PROBE_HOOK(k) do { if (blockIdx.x == 0 && threadIdx.x == 0) { unsigned long long* pt = (unsigned long long*)(C.ws + WS_CTL + 32768); if ((k) == PROBE_PHASE) pt[0] = __builtin_amdgcn_s_memrealtime(); if ((k) == PROBE_PHASE_END) pt[1] = __builtin_amdgcn_s_memrealtime(); } } while (0)
#else
#define PROBE_HOOK(k) do { } while (0)
#endif
#define GRID_BAR(k) do { if ((k) == lo + 1) grid.sync(); else xcd_barrier(xbar); } while (0)
#define PHASE(k, body) do { if (lo <= (k) && (k) < hi) { if ((k) > lo) GRID_BAR(k); ctx_setup(C); PROBE_HOOK(k); body; } } while (0)
    PHASE(0, { phase_ln_in(C); convert_win(C, 0); convert_mixer_weights(C, 0); });
#define LAYER(l) PHASE(1 + 13 * (l) + 0, run_sp<0>(C, l)); PHASE(1 + 13 * (l) + 2, run_sp<2>(C, l)); PHASE(1 + 13 * (l) + 3, run_sp<3>(C, l)); \
    PHASE(1 + 13 * (l) + 4, run_sp<4>(C, l)); PHASE(1 + 13 * (l) + 5, run_sp<5>(C, l)); PHASE(1 + 13 * (l) + 6, run_sp<6>(C, l)); PHASE(1 + 13 * (l) + 7, run_sp<7>(C, l)); \
    PHASE(1 + 13 * (l) + 8, run_sp<8>(C, l)); PHASE(1 + 13 * (l) + 9, run_sp<9>(C, l)); PHASE(1 + 13 * (l) + 10, run_sp<10>(C, l)); PHASE(1 + 13 * (l) + 11, run_sp<11>(C, l)); \
    PHASE(1 + 13 * (l) + 12, run_sp<12>(C, l))
#define PH0(sp) PHASE(1 + (sp), run_sp<sp>(C, 0)); if (REP_SP == (sp)) { if (REP_N > 1) { xcd_barrier(xbar); ctx_setup(C); run_sp_<sp>(C, 0, 1); } if (REP_N > 2) { xcd_barrier(xbar); ctx_setup(C); run_sp_<sp>(C, 0, 2); } }
    PH0(0); PH0(2); PH0(3); PH0(4); PH0(5); PH0(6); PH0(7); PH0(8); PH0(9); PH0(10); PH0(11); PH0(12);
#undef PH0
    LAYER(1);
#undef LAYER
#undef PHASE
}

#ifndef N_LAUNCH_MODE
#define N_LAUNCH_MODE 1
#endif
extern "C" void kernel_launch(void* const* d_in, const int* in_sizes, int n_in, void* d_out, int out_size, void* d_ws, size_t ws_size, hipStream_t stream) {
    static int grid = 0;
    if (grid == 0) {
        if (n_in != 31 || out_size != T * D) { fprintf(stderr, "kernel_launch: unexpected problem (n_in %d out %d)\n", n_in, out_size); grid = -1; return; }
        int dev = 0, cus = 0, per_cu = 0;
        hipGetDevice(&dev); hipDeviceGetAttribute(&cus, hipDeviceAttributeMultiprocessorCount, dev);
        if (hipFuncSetAttribute((const void*)mega_fwd, hipFuncAttributeMaxDynamicSharedMemorySize, LDS_BYTES) != hipSuccess) { fprintf(stderr, "kernel_launch: hipFuncSetAttribute failed\n"); grid = -1; return; }
        if (hipOccupancyMaxActiveBlocksPerMultiprocessor(&per_cu, (const void*)mega_fwd, NTHR, LDS_BYTES) != hipSuccess || per_cu < 1) { fprintf(stderr, "kernel_launch: occupancy query says %d\n", per_cu); per_cu = 1; }
        (void)hipGetLastError();
        grid = cus * 1;
        fprintf(stderr, "kernel_launch: grid %d (occupancy %d per CU)\n", grid, per_cu);
    }
    if (grid < 0) return;
    hipMemsetAsync((char*)d_ws + WS_CTL, 0, CTL_BYTES, stream);
    Args a{};
    for (int i = 0; i < 31; ++i) a.in[i] = (const float*)d_in[i];
    a.out = (float*)d_out; a.ws = (unsigned char*)d_ws;
#if N_LAUNCH_MODE == 0
    for (int ph = 0; ph < NPHASE; ++ph) { a.ph_lo = ph; a.ph_hi = ph + 1; hipLaunchKernelGGL(mega_fwd, dim3(grid), dim3(NTHR), LDS_BYTES, stream, a); }
#else
    a.ph_lo = 0; a.ph_hi = NPHASE;
    void* kargs[] = {&a};
    hipError_t e = hipLaunchCooperativeKernel((const void*)mega_fwd, dim3(grid), dim3(NTHR), kargs, LDS_BYTES, stream);
    if (e != hipSuccess) fprintf(stderr, "cooperative launch failed: %s (grid %d)\n", hipGetErrorString(e), grid);
#endif
}
```

```cpp
#include <hip/hip_runtime.h>
#include <hip/hip_cooperative_groups.h>
#include <cstdio>
#include <cstdint>
namespace cg = cooperative_groups;
namespace pg8 {
#define PG8_LAS __attribute__((address_space(3)))
typedef unsigned short bf16_t;
typedef short bf16x8 __attribute__((ext_vector_type(8)));
typedef float f32x4 __attribute__((ext_vector_type(4)));
typedef unsigned u32x4 __attribute__((ext_vector_type(4)));
constexpr int BM = 256, BK = 64, HALF = 128, HTB = HALF * BK * 2  , STAGE_BYTES = 8 * HTB, NXCD = 8, WGM = 8;

__host__ __device__ __forceinline__ int lds_byte(int r, int c) { const int st = (r >> 4) * 2 + (c >> 5), rr = r & 15, cc = c & 31, ob = rr * 64 + cc * 2; return st * 1024 + (ob ^ (((ob >> 9) & 1) << 5)); }
__host__ __device__ __forceinline__ void stage_rc(int b, int& R, int& C) { const int st = b / 1024, sb = b % 1024, swz = sb ^ (((sb >> 9) & 1) << 5); R = (st >> 1) * 16 + swz / 64; C = (st & 1) * 32 + (swz % 64) / 2; }
__host__ __device__ __forceinline__ int perm32(int rho) { const int n = rho >> 4, i = rho & 15; return 8 * (i >> 2) + 4 * n + (i & 3); }

struct Unit { int pm, pn; };
struct Gemm { const bf16_t* A; const bf16_t* Bt; int M, N, K; };

struct StaticOrder {
    int nM, nN, nwg, G, c;
    __host__ __device__ void init(int M, int N, int G_, int c_) { nM = M / BM; nN = N / BM; nwg = nM * nN; G = G_; c = c_; }
    __host__ __device__ bool next(int i, Unit& u) const {
        const long L = (long)i * G + c; if (L >= nwg) return false;
        int wgid = (int)L; { const int q = nwg / NXCD, r = nwg % NXCD, xcd = wgid % NXCD, off = wgid / NXCD; wgid = (xcd < r ? xcd * (q + 1) : r * (q + 1) + (xcd - r) * q) + off; }
        const int nig = WGM * nN, gid = wgid / nig, fm = gid * WGM, gsz = (nM - fm) < WGM ? (nM - fm) : WGM;
        u.pm = fm + ((wgid % nig) % gsz); u.pn = (wgid % nig) / gsz; return true;
    }
    __device__ __forceinline__ void a_ready(const Unit&) const {}
    __device__ __forceinline__ void done(const Unit&) const {}
};

__device__ __forceinline__ unsigned cvt_pk_bf16(float lo, float hi) { typedef float f2_t __attribute__((ext_vector_type(2))); typedef __bf16 b2_t __attribute__((ext_vector_type(2))); f2_t v = {lo, hi}; b2_t b = __builtin_convertvector(v, b2_t); return __builtin_bit_cast(unsigned, b); }
template <class Epi, class Sched, bool ALIGN_EPI = false, bool SP2 = false>
__device__ __forceinline__ void gemm_phase(PG8_LAS unsigned char* lds, const Gemm g, const Sched& S, const Epi& E) {
    int tid_ = threadIdx.x; asm volatile("" : "+v"(tid_));
    const int tid = tid_, wid = __builtin_amdgcn_readfirstlane(tid >> 6), lane = tid & 63, wr = wid >> 2, wc = wid & 3, fr = lane & 15, fq = lane >> 4;
    const int K = g.K, nt = K / BK;
    unsigned voffA[2], voffB[2];
#pragma unroll
    for (int i = 0; i < 2; ++i) { int R, C; stage_rc(tid * 16 + i * 8192, R, C); const int Rb = Epi::PERM ? ((R & ~31) + perm32(R & 31)) : R;
        voffA[i] = (unsigned)(R * K + C) * 2u; voffB[i] = (unsigned)(Rb * K + C) * 2u; }
    const size_t kstep = (size_t)(BK * 2);
    const size_t hstep = (size_t)HALF * K * 2;
    const size_t tstep = 2 * hstep;
    const unsigned ldsw = (unsigned)wid * 1024u;
    const int aoff = lds_byte(wr * 64 + fr, fq * 8), boff = lds_byte(wc * 32 + fr, fq * 8);
#define PG8_SA(b, h) (((b) * 2 + (h)) * HTB)
#define PG8_SB(b, h) ((4 + (b) * 2 + (h)) * HTB)
#define PG8_STAGE(bufoff, gbase, voff) do { _Pragma("unroll") for (int _i = 0; _i < 2; ++_i) \
        __builtin_amdgcn_global_load_lds((const unsigned*)((const char*)(gbase) + (voff)[_i]), (PG8_LAS unsigned*)(lds + (bufoff) + ldsw + _i * 8192), 16, 0, 0); } while (0)
#define PG8_LDA(dst, b, h) do { _Pragma("unroll") for (int m = 0; m < 4; ++m) _Pragma("unroll") for (int k = 0; k < 2; ++k) dst[m][k] = *(const PG8_LAS bf16x8*)(lds + PG8_SA(b, h) + aoff + m * 2048 + k * 1024); } while (0)
#define PG8_LDB(dst, b, h) do { _Pragma("unroll") for (int n = 0; n < 2; ++n) _Pragma("unroll") for (int k = 0; k < 2; ++k) dst[n][k] = *(const PG8_LAS bf16x8*)(lds + PG8_SB(b, h) + boff + n * 2048 + k * 1024); } while (0)
#define PG8_MMA(ai, bj, At, Bt) do { __builtin_amdgcn_s_setprio(1); _Pragma("unroll") for (int m = 0; m < 4; ++m) _Pragma("unroll") for (int n = 0; n < 2; ++n) _Pragma("unroll") for (int k = 0; k < 2; ++k) \
        acc[ai][bj][m][n] = __builtin_amdgcn_mfma_f32_16x16x32_bf16(Bt[n][k], At[m][k], acc[ai][bj][m][n], 0, 0, 0); __builtin_amdgcn_s_setprio(0); } while (0)
#define PG8_WAIT_V(n) asm volatile("s_waitcnt vmcnt(" #n ")" ::: "memory")
#define PG8_WAIT_L(n) asm volatile("s_waitcnt lgkmcnt(" #n ")" ::: "memory")
#define PG8_BAR __builtin_amdgcn_s_barrier()
#define PG8_SCHED __builtin_amdgcn_sched_barrier(0)
    Unit cur, nxt; int ui = 0;
    if (!S.next(0, cur)) return;
    f32x4 acc[2][2][4][2];
#pragma unroll
    for (int a = 0; a < 2; ++a)
#pragma unroll
        for (int b = 0; b < 2; ++b)
#pragma unroll
            for (int m = 0; m < 4; ++m)
#pragma unroll
                for (int n = 0; n < 2; ++n) acc[a][b][m][n] = (f32x4){0.f, 0.f, 0.f, 0.f};
    bf16x8 At[4][2], B0[2][2], B1[2][2];
    const char* cA = (const char*)g.A + (size_t)cur.pm * tstep; const char* cB = (const char*)g.Bt + (size_t)cur.pn * tstep;
    S.a_ready(cur);
    if constexpr (SP2) {
        PG8_STAGE(PG8_SB(0, 0), cB, voffB); PG8_STAGE(PG8_SB(0, 1), cB + hstep, voffB); PG8_STAGE(PG8_SA(0, 0), cA, voffA); PG8_STAGE(PG8_SA(0, 1), cA + hstep, voffA);
        if (wr == 1) PG8_BAR;
        PG8_WAIT_V(2); PG8_BAR;
        PG8_STAGE(PG8_SB(1, 0), cB + kstep, voffB); PG8_STAGE(PG8_SA(1, 0), cA + kstep, voffA); PG8_STAGE(PG8_SB(1, 1), cB + hstep + kstep, voffB);
        PG8_WAIT_V(6); PG8_BAR;
    } else {
        PG8_STAGE(PG8_SB(0, 0), cB, voffB); PG8_STAGE(PG8_SA(0, 0), cA, voffA); PG8_STAGE(PG8_SB(0, 1), cB + hstep, voffB); PG8_STAGE(PG8_SA(0, 1), cA + hstep, voffA);
        if (wr == 1) PG8_BAR;
        PG8_WAIT_V(4); PG8_BAR;
        PG8_STAGE(PG8_SB(1, 0), cB + kstep, voffB); PG8_STAGE(PG8_SA(1, 0), cA + kstep, voffA); PG8_STAGE(PG8_SB(1, 1), cB + hstep + kstep, voffB);
        PG8_WAIT_V(6); PG8_BAR;
    }
    for (;;) {
        const bool has_next = S.next(ui + 1, nxt);
        const char* nA = has_next ? (const char*)g.A + (size_t)nxt.pm * tstep : cA; const char* nB = has_next ? (const char*)g.Bt + (size_t)nxt.pn * tstep : cB;
        for (int t = 0; t < nt; t += 2) {
            const bool last = (t == nt - 2);
            const char* a1 = cA + (size_t)(t + 1) * kstep;
            const char* a2 = last ? nA : cA + (size_t)(t + 2) * kstep; const char* b2 = last ? nB : cB + (size_t)(t + 2) * kstep;
            const char* a3 = a2 + kstep; const char* b3 = b2 + kstep;
            if (last && has_next) S.a_ready(nxt);
            if constexpr (SP2) {
            PG8_LDB(B0, 0, 0); PG8_LDB(B1, 0, 1); PG8_SCHED; PG8_LDA(At, 0, 0); PG8_STAGE(PG8_SA(1, 1), a1 + hstep, voffA);
            PG8_WAIT_V(8); PG8_WAIT_L(0); PG8_BAR; PG8_MMA(0, 0, At, B0); PG8_MMA(0, 1, At, B1); PG8_BAR; PG8_SCHED;
            PG8_LDA(At, 0, 1); PG8_STAGE(PG8_SB(0, 0), b2, voffB); PG8_STAGE(PG8_SB(0, 1), b2 + hstep, voffB); PG8_STAGE(PG8_SA(0, 0), a2, voffA);
            PG8_WAIT_V(8); PG8_WAIT_L(0); PG8_BAR; PG8_MMA(1, 0, At, B0); PG8_MMA(1, 1, At, B1); PG8_BAR; PG8_SCHED;
            PG8_LDB(B0, 1, 0); PG8_LDB(B1, 1, 1); PG8_SCHED; PG8_LDA(At, 1, 0); PG8_STAGE(PG8_SA(0, 1), a2 + hstep, voffA);
            PG8_WAIT_V(8); PG8_WAIT_L(0); PG8_BAR; PG8_MMA(0, 0, At, B0); PG8_MMA(0, 1, At, B1); PG8_BAR; PG8_SCHED;
            PG8_LDA(At, 1, 1); PG8_STAGE(PG8_SB(1, 0), b3, voffB); PG8_STAGE(PG8_SB(1, 1), b3 + hstep, voffB); PG8_STAGE(PG8_SA(1, 0), a3, voffA);
            PG8_WAIT_V(8); PG8_WAIT_L(0); PG8_BAR; PG8_MMA(1, 0, At, B0); PG8_MMA(1, 1, At, B1); PG8_BAR; PG8_SCHED;
            } else {
            PG8_LDB(B0, 0, 0); PG8_SCHED; PG8_LDA(At, 0, 0); PG8_STAGE(PG8_SA(1, 1), a1 + hstep, voffA);
            PG8_WAIT_L(8); PG8_BAR; PG8_WAIT_L(0); PG8_MMA(0, 0, At, B0); PG8_BAR; PG8_SCHED;
            PG8_LDB(B1, 0, 1); PG8_STAGE(PG8_SB(0, 0), b2, voffB);
            PG8_BAR; PG8_WAIT_L(0); PG8_MMA(0, 1, At, B1); PG8_BAR;
            PG8_LDA(At, 0, 1); PG8_STAGE(PG8_SA(0, 0), a2, voffA);
            PG8_BAR; PG8_WAIT_L(0); PG8_MMA(1, 0, At, B0); PG8_BAR; PG8_SCHED;
            PG8_STAGE(PG8_SB(0, 1), b2 + hstep, voffB);
            PG8_WAIT_V(6); PG8_BAR; PG8_MMA(1, 1, At, B1); PG8_BAR;
            PG8_LDB(B0, 1, 0); PG8_SCHED; PG8_LDA(At, 1, 0); PG8_STAGE(PG8_SA(0, 1), a2 + hstep, voffA);
            PG8_WAIT_L(8); PG8_BAR; PG8_WAIT_L(0); PG8_MMA(0, 0, At, B0); PG8_BAR; PG8_SCHED;
            PG8_LDB(B1, 1, 1); PG8_STAGE(PG8_SB(1, 0), b3, voffB);
            PG8_BAR; PG8_WAIT_L(0); PG8_MMA(0, 1, At, B1); PG8_BAR;
            PG8_LDA(At, 1, 1); PG8_STAGE(PG8_SA(1, 0), a3, voffA);
            PG8_BAR; PG8_WAIT_L(0); PG8_MMA(1, 0, At, B0); PG8_BAR; PG8_SCHED;
            PG8_STAGE(PG8_SB(1, 1), b3 + hstep, voffB);
            PG8_WAIT_V(6); PG8_BAR; PG8_MMA(1, 1, At, B1); PG8_BAR;
            }
        }
        if constexpr (ALIGN_EPI) { if (wr == 0) PG8_BAR; }
        if constexpr (!Epi::AFTER_DRAIN) { E(acc, cur, wr, wc, fr, fq); S.done(cur); }
        if (!has_next) break;
#pragma unroll
        for (int a = 0; a < 2; ++a)
#pragma unroll
            for (int b = 0; b < 2; ++b)
#pragma unroll
                for (int m = 0; m < 4; ++m)
#pragma unroll
                    for (int n = 0; n < 2; ++n) acc[a][b][m][n] = (f32x4){0.f, 0.f, 0.f, 0.f};
        cur = nxt; cA = nA; cB = nB; ++ui;
        if constexpr (ALIGN_EPI) { if (wr == 1) PG8_BAR; }
    }
    PG8_WAIT_V(0);
    if constexpr (!ALIGN_EPI) { if (wr == 0) PG8_BAR; }
    PG8_BAR;
    if constexpr (Epi::AFTER_DRAIN) { E.fused(acc, cur, wr, wc, fr, fq, lds, wid, lane); S.done(cur); }
#undef PG8_SA
#undef PG8_SB
#undef PG8_STAGE
#undef PG8_LDA
#undef PG8_LDB
#undef PG8_MMA
#undef PG8_WAIT_V
#undef PG8_WAIT_L
#undef PG8_BAR
#undef PG8_SCHED
}

template <class Epi, class Sched, bool ALIGN_EPI = false>
__device__ __forceinline__ void gemm_phase_gather(PG8_LAS unsigned char* lds, const Gemm g, const Sched& S, const Epi& E, const int* rowtok) {
    constexpr bool SP2 = true;
    int tid_ = threadIdx.x; asm volatile("" : "+v"(tid_));
    const int tid = tid_, wid = __builtin_amdgcn_readfirstlane(tid >> 6), lane = tid & 63, wr = wid >> 2, wc = wid & 3, fr = lane & 15, fq = lane >> 4;
    const int K = g.K, nt = K / BK;
    unsigned voffB[2]; unsigned vcur[2][2], vnxt[2][2]; int RA[2], CA[2]; const unsigned voffA[2] = {0u, 0u};
#pragma unroll
    for (int i = 0; i < 2; ++i) { int R, C; stage_rc(tid * 16 + i * 8192, R, C); const int Rb = Epi::PERM ? ((R & ~31) + perm32(R & 31)) : R;
        RA[i] = R; CA[i] = C; voffB[i] = (unsigned)(Rb * K + C) * 2u; }
#define PG8_GMAP(dst, pm_) do { _Pragma("unroll") for (int h_ = 0; h_ < 2; ++h_) _Pragma("unroll") for (int i_ = 0; i_ < 2; ++i_) { int tk_ = rowtok[4 * ((pm_) * BM + h_ * HALF + RA[i_])]; tk_ = tk_ < 0 ? 0 : tk_; dst[h_][i_] = (unsigned)(tk_ * K + CA[i_]) * 2u; } } while (0)
    const size_t kstep = (size_t)(BK * 2);
    const size_t hstep = (size_t)HALF * K * 2;
    const size_t tstep = 2 * hstep;
    const unsigned ldsw = (unsigned)wid * 1024u;
    const int aoff = lds_byte(wr * 64 + fr, fq * 8), boff = lds_byte(wc * 32 + fr, fq * 8);
#define PG8_SA(b, h) (((b) * 2 + (h)) * HTB)
#define PG8_SB(b, h) ((4 + (b) * 2 + (h)) * HTB)
#define PG8_STAGE(bufoff, gbase, voff) do { _Pragma("unroll") for (int _i = 0; _i < 2; ++_i) \
        __builtin_amdgcn_global_load_lds((const unsigned*)((const char*)(gbase) + (voff)[_i]), (PG8_LAS unsigned*)(lds + (bufoff) + ldsw + _i * 8192), 16, 0, 0); } while (0)
#define PG8_LDA(dst, b, h) do { _Pragma("unroll") for (int m = 0; m < 4; ++m) _Pragma("unroll") for (int k = 0; k < 2; ++k) dst[m][k] = *(const PG8_LAS bf16x8*)(lds + PG8_SA(b, h) + aoff + m * 2048 + k * 1024); } while (0)
#define PG8_LDB(dst, b, h) do { _Pragma("unroll") for (int n = 0; n < 2; ++n) _Pragma("unroll") for (int k = 0; k < 2; ++k) dst[n][k] = *(const PG8_LAS bf16x8*)(lds + PG8_SB(b, h) + boff + n * 2048 + k * 1024); } while (0)
#define PG8_MMA(ai, bj, At, Bt) do { __builtin_amdgcn_s_setprio(1); _Pragma("unroll") for (int m = 0; m < 4; ++m) _Pragma("unroll") for (int n = 0; n < 2; ++n) _Pragma("unroll") for (int k = 0; k < 2; ++k) \
        acc[ai][bj][m][n] = __builtin_amdgcn_mfma_f32_16x16x32_bf16(Bt[n][k], At[m][k], acc[ai][bj][m][n], 0, 0, 0); __builtin_amdgcn_s_setprio(0); } while (0)
#define PG8_WAIT_V(n) asm volatile("s_waitcnt vmcnt(" #n ")" ::: "memory")
#define PG8_WAIT_L(n) asm volatile("s_waitcnt lgkmcnt(" #n ")" ::: "memory")
#define PG8_BAR __builtin_amdgcn_s_barrier()
#define PG8_SCHED __builtin_amdgcn_sched_barrier(0)
    Unit cur, nxt; int ui = 0;
    if (!S.next(0, cur)) return;
    f32x4 acc[2][2][4][2];
#pragma unroll
    for (int a = 0; a < 2; ++a)
#pragma unroll
        for (int b = 0; b < 2; ++b)
#pragma unroll
            for (int m = 0; m < 4; ++m)
#pragma unroll
                for (int n = 0; n < 2; ++n) acc[a][b][m][n] = (f32x4){0.f, 0.f, 0.f, 0.f};
    bf16x8 At[4][2], B0[2][2], B1[2][2];
    const char* cA = (const char*)g.A; const char* cB = (const char*)g.Bt + (size_t)cur.pn * tstep;
    PG8_GMAP(vcur, cur.pm);
    S.a_ready(cur);
    if constexpr (SP2) {
        PG8_STAGE(PG8_SB(0, 0), cB, voffB); PG8_STAGE(PG8_SB(0, 1), cB + hstep, voffB); PG8_STAGE(PG8_SA(0, 0), cA, vcur[0]); PG8_STAGE(PG8_SA(0, 1), cA, vcur[1]);
        if (wr == 1) PG8_BAR;
        PG8_WAIT_V(2); PG8_BAR;
        PG8_STAGE(PG8_SB(1, 0), cB + kstep, voffB); PG8_STAGE(PG8_SA(1, 0), cA + kstep, vcur[0]); PG8_STAGE(PG8_SB(1, 1), cB + hstep + kstep, voffB);
        PG8_WAIT_V(6); PG8_BAR;
    } else {
        PG8_STAGE(PG8_SB(0, 0), cB, voffB); PG8_STAGE(PG8_SA(0, 0), cA, voffA); PG8_STAGE(PG8_SB(0, 1), cB + hstep, voffB); PG8_STAGE(PG8_SA(0, 1), cA + hstep, voffA);
        if (wr == 1) PG8_BAR;
        PG8_WAIT_V(4); PG8_BAR;
        PG8_STAGE(PG8_SB(1, 0), cB + kstep, voffB); PG8_STAGE(PG8_SA(1, 0), cA + kstep, voffA); PG8_STAGE(PG8_SB(1, 1), cB + hstep + kstep, voffB);
        PG8_WAIT_V(6); PG8_BAR;
    }
    for (;;) {
        const bool has_next = S.next(ui + 1, nxt);
        const char* nA = cA; const char* nB = has_next ? (const char*)g.Bt + (size_t)nxt.pn * tstep : cB;
        if (has_next) PG8_GMAP(vnxt, nxt.pm); else { vnxt[0][0] = vcur[0][0]; vnxt[0][1] = vcur[0][1]; vnxt[1][0] = vcur[1][0]; vnxt[1][1] = vcur[1][1]; }
        for (int t = 0; t < nt; t += 2) {
            const bool last = (t == nt - 2);
            const char* a1 = cA + (size_t)(t + 1) * kstep;
            const char* a2 = last ? nA : cA + (size_t)(t + 2) * kstep; unsigned v2[2][2]; v2[0][0] = last ? vnxt[0][0] : vcur[0][0]; v2[0][1] = last ? vnxt[0][1] : vcur[0][1]; v2[1][0] = last ? vnxt[1][0] : vcur[1][0]; v2[1][1] = last ? vnxt[1][1] : vcur[1][1]; const char* b2 = last ? nB : cB + (size_t)(t + 2) * kstep;
            const char* a3 = a2 + kstep; const char* b3 = b2 + kstep;
            if (last && has_next) S.a_ready(nxt);
            if constexpr (SP2) {
            PG8_LDB(B0, 0, 0); PG8_LDB(B1, 0, 1); PG8_SCHED; PG8_LDA(At, 0, 0); PG8_STAGE(PG8_SA(1, 1), a1, vcur[1]);
            PG8_WAIT_V(8); PG8_WAIT_L(0); PG8_BAR; PG8_MMA(0, 0, At, B0); PG8_MMA(0, 1, At, B1); PG8_BAR; PG8_SCHED;
            PG8_LDA(At, 0, 1); PG8_STAGE(PG8_SB(0, 0), b2, voffB); PG8_STAGE(PG8_SB(0, 1), b2 + hstep, voffB); PG8_STAGE(PG8_SA(0, 0), a2, v2[0]);
            PG8_WAIT_V(8); PG8_WAIT_L(0); PG8_BAR; PG8_MMA(1, 0, At, B0); PG8_MMA(1, 1, At, B1); PG8_BAR; PG8_SCHED;
            PG8_LDB(B0, 1, 0); PG8_LDB(B1, 1, 1); PG8_SCHED; PG8_LDA(At, 1, 0); PG8_STAGE(PG8_SA(0, 1), a2, v2[1]);
            PG8_WAIT_V(8); PG8_WAIT_L(0); PG8_BAR; PG8_MMA(0, 0, At, B0); PG8_MMA(0, 1, At, B1); PG8_BAR; PG8_SCHED;
            PG8_LDA(At, 1, 1); PG8_STAGE(PG8_SB(1, 0), b3, voffB); PG8_STAGE(PG8_SB(1, 1), b3 + hstep, voffB); PG8_STAGE(PG8_SA(1, 0), a3, v2[0]);
            PG8_WAIT_V(8); PG8_WAIT_L(0); PG8_BAR; PG8_MMA(1, 0, At, B0); PG8_MMA(1, 1, At, B1); PG8_BAR; PG8_SCHED;
            } else {
            PG8_LDB(B0, 0, 0); PG8_SCHED; PG8_LDA(At, 0, 0); PG8_STAGE(PG8_SA(1, 1), a1 + hstep, voffA);
            PG8_WAIT_L(8); PG8_BAR; PG8_WAIT_L(0); PG8_MMA(0, 0, At, B0); PG8_BAR; PG8_SCHED;
            PG8_LDB(B1, 0, 1); PG8_STAGE(PG8_SB(0, 0), b2, voffB);
            PG8_BAR; PG8_WAIT_L(0); PG8_MMA(0, 1, At, B1); PG8_BAR;
            PG8_LDA(At, 0, 1); PG8_STAGE(PG8_SA(0, 0), a2, voffA);
            PG8_BAR; PG8_WAIT_L(0); PG8_MMA(1, 0, At, B0); PG8_BAR; PG8_SCHED;
            PG8_STAGE(PG8_SB(0, 1), b2 + hstep, voffB);
            PG8_WAIT_V(6); PG8_BAR; PG8_MMA(1, 1, At, B1); PG8_BAR;
            PG8_LDB(B0, 1, 0); PG8_SCHED; PG8_LDA(At, 1, 0); PG8_STAGE(PG8_SA(0, 1), a2 + hstep, voffA);
            PG8_WAIT_L(8); PG8_BAR; PG8_WAIT_L(0); PG8_MMA(0, 0, At, B0); PG8_BAR; PG8_SCHED;
            PG8_LDB(B1, 1, 1); PG8_STAGE(PG8_SB(1, 0), b3, voffB);
            PG8_BAR; PG8_WAIT_L(0); PG8_MMA(0, 1, At, B1); PG8_BAR;
            PG8_LDA(At, 1, 1); PG8_STAGE(PG8_SA(1, 0), a3, voffA);
            PG8_BAR; PG8_WAIT_L(0); PG8_MMA(1, 0, At, B0); PG8_BAR; PG8_SCHED;
            PG8_STAGE(PG8_SB(1, 1), b3 + hstep, voffB);
            PG8_WAIT_V(6); PG8_BAR; PG8_MMA(1, 1, At, B1); PG8_BAR;
            }
        }
        if constexpr (ALIGN_EPI) { if (wr == 0) PG8_BAR; }
        if constexpr (!Epi::AFTER_DRAIN) { E(acc, cur, wr, wc, fr, fq); S.done(cur); }
        if (!has_next) break;
#pragma unroll
        for (int a = 0; a < 2; ++a)
#pragma unroll
            for (int b = 0; b < 2; ++b)
#pragma unroll
                for (int m = 0; m < 4; ++m)
#pragma unroll
                    for (int n = 0; n < 2; ++n) acc[a][b][m][n] = (f32x4){0.f, 0.f, 0.f, 0.f};
        cur = nxt; cA = nA; cB = nB; ++ui; vcur[0][0] = vnxt[0][0]; vcur[0][1] = vnxt[0][1]; vcur[1][0] = vnxt[1][0]; vcur[1][1] = vnxt[1][1];
        if constexpr (ALIGN_EPI) { if (wr == 1) PG8_BAR; }
    }
    PG8_WAIT_V(0);
    if constexpr (!ALIGN_EPI) { if (wr == 0) PG8_BAR; }
    PG8_BAR;
    if constexpr (Epi::AFTER_DRAIN) { E.fused(acc, cur, wr, wc, fr, fq, lds, wid, lane); S.done(cur); }
#undef PG8_GMAP
#undef PG8_SA
#undef PG8_SB
#undef PG8_STAGE
#undef PG8_LDA
#undef PG8_LDB
#undef PG8_MMA
#undef PG8_WAIT_V
#undef PG8_WAIT_L
#undef PG8_BAR
#undef PG8_SCHED
}

}

#define DI __device__ __forceinline__
#define LAS __attribute__((address_space(3)))
typedef unsigned short bf16_t;
typedef short bf16x8 __attribute__((ext_vector_type(8)));
typedef _Float16 f16x8 __attribute__((ext_vector_type(8)));
typedef float f32x4 __attribute__((ext_vector_type(4)));
typedef float f32x16 __attribute__((ext_vector_type(16)));
typedef unsigned u32x4 __attribute__((ext_vector_type(4)));
typedef unsigned u32x2 __attribute__((ext_vector_type(2)));

constexpr int NB = 4, SEQ = 4096, T = NB * SEQ, D = 1024, DEPTH = 2;
constexpr int PLD = 3912;
constexpr int PC_Q = 0, PC_K = 512, PC_V = 1024, PC_QI = 1536, PC_KI = 2048, PC_WI = 2112;
constexpr int PC_R = 2120, PC_BK = 2632, PC_BV = 3144, PC_WD = 3656;
constexpr int NPROJ_PAD = 4096;
constexpr int NEXP = 16, DEXP = 256, PLE = 256;
constexpr float ALPHA = 1.4142135623730951f;
constexpr float LN_EPS = 1e-5f, GN_EPS = 64e-5f;
constexpr int MAXROWS = 2 * T + NEXP * 256;
constexpr int NWAVES = 8, NTHR = 512;

constexpr size_t MiB = 1u << 20;
constexpr size_t WS_CTL = 0, CTL_BYTES = 1 * MiB;
constexpr size_t WS_WEXP = 1 * MiB;
constexpr size_t WS_WDOWN = 17 * MiB;
constexpr size_t WS_WOUT = 25 * MiB, WS_WPG = 27 * MiB, WS_WPLE = 29 * MiB;
constexpr size_t WS_BM = 30 * MiB;
constexpr size_t WS_ELL = 38 * MiB, WS_AA = 70 * MiB, WS_GG = 102 * MiB;
constexpr size_t WS_PROJ = 119 * MiB;
constexpr size_t WS_PBF = 242 * MiB;
constexpr size_t WS_V = 119 * MiB;
constexpr size_t WS_AG = 38 * MiB;
constexpr size_t WS_H = 183 * MiB;
constexpr size_t WS_Y = 119 * MiB;
constexpr size_t WS_PE = 201 * MiB;
constexpr size_t WS_V3 = 38 * MiB;
constexpr size_t WS_TOK = 233 * MiB;
constexpr size_t WS_ROW = 234 * MiB;
constexpr int CW_GCNT = 1024;

struct TokInfo { int e0, e1, p0, p1; float g0, g1; int pad0, pad1; };
struct RowInfo { int token, slot; float gate; int pad; };

#define LDS_WAIT() asm volatile("s_waitcnt lgkmcnt(0)" ::: "memory")
#define VM_WAIT() asm volatile("s_waitcnt vmcnt(0)" ::: "memory")
DI unsigned f2bf(float f) { unsigned u = __builtin_bit_cast(unsigned, f); return (u + 0x7fffu + ((u >> 16) & 1u)) >> 16; }
DI unsigned pk2(float lo, float hi) { return pg8::cvt_pk_bf16(lo, hi); }
DI float bf2f(unsigned short b) { return __builtin_bit_cast(float, (unsigned)b << 16); }
DI float bflo(unsigned w) { return __builtin_bit_cast(float, w << 16); }
DI float bfhi(unsigned w) { return __builtin_bit_cast(float, w & 0xffff0000u); }
DI unsigned pk2h(float lo, float hi) { typedef _Float16 h2_t __attribute__((ext_vector_type(2))); h2_t v = {(_Float16)lo, (_Float16)hi}; return __builtin_bit_cast(unsigned, v); }
DI float wave_sum(float v) {
#pragma unroll
    for (int o = 1; o < 64; o <<= 1) v += __shfl_xor(v, o);
    return v;
}
DI int opaque_i(int v) { asm volatile("" : "+s"(v)); return v; }
DI float sigmoidf_(float x) { return 1.f / (1.f + __expf(-x)); }

struct Args { const float* in[31]; float* out; unsigned char* ws; int ph_lo, ph_hi; };
struct Ctx {
    LAS unsigned char* lds;
    int tid, lane, wave, G, blk;
    const __attribute__((address_space(4))) Args* ap;
    float* out; unsigned char* ws;
    unsigned* ctl;
    bf16_t* xcur; bf16_t* mixcat;
    DI const float* in(int i) const { return ap->in[i]; }
};

DI void ln16(f32x4 (&v)[4], const float* g, const float* b, int lane) {
    float s = 0.f;
#pragma unroll
    for (int j = 0; j < 4; ++j) s += (v[j].x + v[j].y) + (v[j].z + v[j].w);
    const float mean = wave_sum(s) * (1.f / D);
    float s2 = 0.f;
#pragma unroll
    for (int j = 0; j < 4; ++j) { v[j] = v[j] - mean; s2 += (v[j].x * v[j].x + v[j].y * v[j].y) + (v[j].z * v[j].z + v[j].w * v[j].w); }
    const float rstd = 1.f / sqrtf(wave_sum(s2) * (1.f / D) + LN_EPS);
#pragma unroll
    for (int j = 0; j < 4; ++j) { const f32x4 gg = *(const f32x4*)(g + 256 * j + 4 * lane), bb = *(const f32x4*)(b + 256 * j + 4 * lane); v[j] = v[j] * rstd * gg + bb; }
}
DI void store_row_bf16(bf16_t* row, const f32x4 (&v)[4], int lane) {
#pragma unroll
    for (int j = 0; j < 4; ++j) { u32x2 o; o.x = pk2(v[j].x, v[j].y); o.y = pk2(v[j].z, v[j].w); *(u32x2*)(row + 256 * j + 4 * lane) = o; }
}
DI void load_row_bf16(const bf16_t* row, f32x4 (&v)[4], int lane) {
#pragma unroll
    for (int j = 0; j < 4; ++j) { const u32x2 o = *(const u32x2*)(row + 256 * j + 4 * lane); v[j] = (f32x4){bflo(o.x), bfhi(o.x), bflo(o.y), bfhi(o.y)}; }
}

template <class ColPtr>
DI void transpose_item(const ColPtr colptr, int ld, int K, bf16_t* WT, int n0, int k0, LAS float* scr, int lane) {
    const float* sp = colptr(n0 + (lane & 31));
    float tv[32];
#pragma unroll
    for (int i = 0; i < 32; ++i) { const int kk = 2 * i + (lane >> 5); tv[i] = sp ? sp[(size_t)(k0 + kk) * ld] : 0.f; }
#pragma unroll
    for (int i = 0; i < 32; ++i) { const int kk = 2 * i + (lane >> 5); scr[kk * 33 + (lane & 31)] = tv[i]; }
    LDS_WAIT(); asm volatile("" ::: "memory");
    const int c = lane & 7;
#pragma unroll
    for (int j = 0; j < 4; ++j) { const int n = (lane >> 3) + 8 * j; const LAS float* s = scr + (8 * c) * 33 + n;
        u32x4 o; o.x = pk2(s[0 * 33], s[1 * 33]); o.y = pk2(s[2 * 33], s[3 * 33]); o.z = pk2(s[4 * 33], s[5 * 33]); o.w = pk2(s[6 * 33], s[7 * 33]);
        *(u32x4*)(WT + (size_t)(n0 + n) * K + k0 + 8 * c) = o; }
    LDS_WAIT(); asm volatile("" ::: "memory");
}
template <class ColPtr>
DI void convert_matrix(Ctx& C, const ColPtr colptr, int ld, int K, int N, bf16_t* WT, int& first) {
    LAS float* scr = (LAS float*)(C.lds + C.wave * 16384);
    const int gw = C.blk * NWAVES + C.wave, NGW = C.G * NWAVES;
    const int nblk = N / 32, nitems = (K / 64) * nblk;
    int it = gw - (first % NGW); if (it < 0) it += NGW;
    for (; it < nitems; it += NGW) transpose_item(colptr, ld, K, WT, 32 * (it % nblk), 64 * (it / nblk), scr, C.lane);
    first += nitems;
}

struct ColWin { const float* w; DI const float* operator()(int j) const { if (j < 2120) return w + j; if (j >= 2176 && j < 3968) return w + (j - 56); return nullptr; } };
struct ColPlain { const float* w; DI const float* operator()(int j) const { return w + j; } };
struct ColGateUp { const float* wg; const float* wu; DI const float* operator()(int j) const {
        const int e = j >> 9, pn = (j >> 8) & 1, jj = j & 255; const int col = pn * 128 + (jj & 127); const uintptr_t pg = (uintptr_t)wg, pu = (uintptr_t)wu; const uintptr_t sel = pg + ((jj >= 128) ? (pu - pg) : (uintptr_t)0); return (const float*)sel + (size_t)e * D * DEXP + col; } };
struct ColDown { const float* wd; DI const float* operator()(int j) const { return wd + j; } };

DI void phase_ln_in(Ctx& C) {
    const int gw = C.blk * NWAVES + C.wave, NGW = C.G * NWAVES;
    for (int m = gw; m < T; m += NGW) {
        f32x4 v[4]; const float* xr = C.in(0) + (size_t)m * D;
#pragma unroll
        for (int j = 0; j < 4; ++j) v[j] = *(const f32x4*)(xr + 256 * j + 4 * C.lane);
        ln16(v, C.in(2), C.in(3), C.lane);
        store_row_bf16(C.xcur + (size_t)m * D, v, C.lane);
    }
}
DI void convert_win(Ctx& C, int l) { int first = 0; ColWin cw{C.in(4) + (size_t)l * D * 3912}; convert_matrix(C, cw, 3912, D, NPROJ_PAD, (bf16_t*)(C.ws + WS_WEXP), first); }
DI void convert_layer_weights(Ctx& C, int l) {
    int first = 0;
    { ColPlain c{C.in(5) + (size_t)l * D * D}; convert_matrix(C, c, D, D, D, (bf16_t*)(C.ws + WS_WOUT), first); }
    { ColGateUp c{C.in(20) + (size_t)l * NEXP * D * DEXP, C.in(21) + (size_t)l * NEXP * D * DEXP}; convert_matrix(C, c, DEXP, D, NEXP * 512, (bf16_t*)(C.ws + WS_WEXP), first); }
    for (int e = 0; e < NEXP; ++e) { ColDown c{C.in(22) + ((size_t)l * NEXP + e) * DEXP * D}; convert_matrix(C, c, D, DEXP, D, (bf16_t*)(C.ws + WS_WDOWN) + (size_t)e * D * DEXP, first); }
    { ColPlain c{C.in(24) + (size_t)l * D * D}; convert_matrix(C, c, D, D, D, (bf16_t*)(C.ws + WS_WPG), first); }
    { ColPlain c{C.in(23) + (size_t)l * PLE * D}; convert_matrix(C, c, D, PLE, D, (bf16_t*)(C.ws + WS_WPLE), first); }
    const float* p = C.in(1) + (size_t)l * T * PLE; bf16_t* pb = (bf16_t*)(C.ws + WS_PBF);
    for (size_t i = ((size_t)C.blk * NTHR + C.tid) * 8; i < (size_t)T * PLE; i += (size_t)C.G * NTHR * 8) {
        const f32x4 a = *(const f32x4*)(p + i), b = *(const f32x4*)(p + i + 4);
        u32x4 o; o.x = pk2(a.x, a.y); o.y = pk2(a.z, a.w); o.z = pk2(b.x, b.y); o.w = pk2(b.z, b.w); *(u32x4*)(pb + i) = o; }
}

struct EpiProj {
    static constexpr bool PERM = true, AFTER_DRAIN = false;
    bf16_t* P;
    DI void operator()(const f32x4 (&acc)[2][2][4][2], const pg8::Unit& u, int wr, int wc, int fr, int fq) const {
        const int row0 = u.pm * 256 + wr * 64 + fr;
#pragma unroll
        for (int bj = 0; bj < 2; ++bj) {
            const int j0 = u.pn * 256 + bj * 128 + wc * 32 + 8 * fq;
            int dst; bool half = false;
            if (j0 < 2120) { dst = j0; half = (j0 >= 1536); } else if (j0 >= 2176 && j0 < 3968) dst = j0 - 56; else dst = -1;
            if (dst >= 0) {
#pragma unroll
                for (int ai = 0; ai < 2; ++ai)
#pragma unroll
                    for (int m = 0; m < 4; ++m) {
                        const f32x4 v0 = acc[ai][bj][m][0], v1 = acc[ai][bj][m][1]; u32x4 w;
                        if (half) { w.x = pk2h(v0[0], v0[1]); w.y = pk2h(v0[2], v0[3]); w.z = pk2h(v1[0], v1[1]); w.w = pk2h(v1[2], v1[3]); }
                        else { w.x = pk2(v0[0], v0[1]); w.y = pk2(v0[2], v0[3]); w.z = pk2(v1[0], v1[1]); w.w = pk2(v1[2], v1[3]); }
                        *(u32x4*)(P + (size_t)(row0 + ai * 128 + m * 16) * PLD + dst) = w; }
            }
        }
    }
};
struct EpiBf16Plain {
    static constexpr bool PERM = true, AFTER_DRAIN = false;
    bf16_t* O; int ldc;
    DI void operator()(const f32x4 (&acc)[2][2][4][2], const pg8::Unit& u, int wr, int wc, int fr, int fq) const {
        const int row0 = u.pm * 256 + wr * 64 + fr, col0 = u.pn * 256 + wc * 32 + 8 * fq;
#pragma unroll
        for (int ai = 0; ai < 2; ++ai)
#pragma unroll
            for (int m = 0; m < 4; ++m)
#pragma unroll
                for (int bj = 0; bj < 2; ++bj) { const f32x4 v0 = acc[ai][bj][m][0], v1 = acc[ai][bj][m][1]; u32x4 w; w.x = pk2(v0[0], v0[1]); w.y = pk2(v0[2], v0[3]); w.z = pk2(v1[0], v1[1]); w.w = pk2(v1[2], v1[3]);
                    *(u32x4*)(O + (size_t)(row0 + ai * 128 + m * 16) * ldc + col0 + bj * 128) = w; }
    }
};
struct EpiResF32 {
    static constexpr bool PERM = false, AFTER_DRAIN = false;
    const bf16_t* X; bf16_t* V;
    DI void operator()(const f32x4 (&acc)[2][2][4][2], const pg8::Unit& u, int wr, int wc, int fr, int fq) const {
        const int row0 = u.pm * 256 + wr * 64 + fr, col0 = u.pn * 256 + wc * 32 + 4 * fq;
#pragma unroll
        for (int ai = 0; ai < 2; ++ai)
#pragma unroll
            for (int m = 0; m < 4; ++m)
#pragma unroll
                for (int bj = 0; bj < 2; ++bj)
#pragma unroll
                    for (int n = 0; n < 2; ++n) { const size_t off = (size_t)(row0 + ai * 128 + m * 16) * D + col0 + bj * 128 + n * 16;
                        const u32x2 xb = *(const u32x2*)(X + off); const f32x4 xv = {bflo(xb.x), bfhi(xb.x), bflo(xb.y), bfhi(xb.y)};
                        const f32x4 o = xv * ALPHA + acc[ai][bj][m][n]; u32x2 ob; ob.x = pk2(o.x, o.y); ob.y = pk2(o.z, o.w); *(u32x2*)(V + off) = ob; }
    }
};
struct EpiPle {
    static constexpr bool PERM = false, AFTER_DRAIN = false;
    const bf16_t* X; const bf16_t* PE; bf16_t* V;
    DI void operator()(const f32x4 (&acc)[2][2][4][2], const pg8::Unit& u, int wr, int wc, int fr, int fq) const {
        const int row0 = u.pm * 256 + wr * 64 + fr, col0 = u.pn * 256 + wc * 32 + 4 * fq;
#pragma unroll
        for (int ai = 0; ai < 2; ++ai)
#pragma unroll
            for (int m = 0; m < 4; ++m)
#pragma unroll
                for (int bj = 0; bj < 2; ++bj)
#pragma unroll
                    for (int n = 0; n < 2; ++n) { const size_t off = (size_t)(row0 + ai * 128 + m * 16) * D + col0 + bj * 128 + n * 16;
                        const u32x2 xb = *(const u32x2*)(X + off); const f32x4 xv = {bflo(xb.x), bfhi(xb.x), bflo(xb.y), bfhi(xb.y)};
                        const u32x2 pb = *(const u32x2*)(PE + off); const f32x4 pv = {bflo(pb.x), bfhi(pb.x), bflo(pb.y), bfhi(pb.y)};
                        const f32x4 a = acc[ai][bj][m][n]; f32x4 s; s.x = sigmoidf_(a.x); s.y = sigmoidf_(a.y); s.z = sigmoidf_(a.z); s.w = sigmoidf_(a.w);
                        const f32x4 o = xv * ALPHA + s * pv; u32x2 ob; ob.x = pk2(o.x, o.y); ob.y = pk2(o.z, o.w); *(u32x2*)(V + off) = ob; }
    }
};
struct EpiSwiGLU {
    static constexpr bool PERM = true, AFTER_DRAIN = false;
    bf16_t* H; const RowInfo* R;
    DI void operator()(const f32x4 (&acc)[2][2][4][2], const pg8::Unit& u, int wr, int wc, int fr, int fq) const {
        const int row0 = u.pm * 256 + wr * 64 + fr, col0 = (u.pn & 1) * 128 + wc * 32 + 8 * fq;
#pragma unroll
        for (int ai = 0; ai < 2; ++ai)
#pragma unroll
            for (int m = 0; m < 4; ++m) { const int row = row0 + ai * 128 + m * 16; const float gw = R[row].gate;
                float h[8];
#pragma unroll
                for (int n = 0; n < 2; ++n)
#pragma unroll
                    for (int i = 0; i < 4; ++i) { const float g = acc[ai][0][m][n][i], up = acc[ai][1][m][n][i]; h[4 * n + i] = g * sigmoidf_(g) * up * gw; }
                u32x4 w; w.x = pk2(h[0], h[1]); w.y = pk2(h[2], h[3]); w.z = pk2(h[4], h[5]); w.w = pk2(h[6], h[7]);
                *(u32x4*)(H + (size_t)row * DEXP + col0) = w; }
    }
};
struct EpiDown {
    static constexpr bool PERM = true, AFTER_DRAIN = false;
    bf16_t* Y; const RowInfo* R;
    DI void operator()(const f32x4 (&acc)[2][2][4][2], const pg8::Unit& u, int wr, int wc, int fr, int fq) const {
        const int row0 = u.pm * 256 + wr * 64 + fr, col0 = (u.pn & 3) * 256 + wc * 32 + 8 * fq;
#pragma unroll
        for (int ai = 0; ai < 2; ++ai)
#pragma unroll
            for (int m = 0; m < 4; ++m) { const int row = row0 + ai * 128 + m * 16; const RowInfo ri = R[row];
                if (ri.token >= 0) { bf16_t* dst = Y + ((size_t)ri.slot * T + ri.token) * D + col0;
#pragma unroll
                    for (int bj = 0; bj < 2; ++bj) { const f32x4 v0 = acc[ai][bj][m][0], v1 = acc[ai][bj][m][1]; u32x4 w; w.x = pk2(v0[0], v0[1]); w.y = pk2(v0[2], v0[3]); w.z = pk2(v1[0], v1[1]); w.w = pk2(v1[2], v1[3]);
                        *(u32x4*)(dst + bj * 128) = w; } } }
    }
};
template <int NPN> struct GroupedOrder {
    const LAS int* texp; int ntiles, G, c;
    DI bool next(int i, pg8::Unit& u) const { const int L = i * G + c; if (L >= ntiles * NPN) return false; u.pm = L / NPN; u.pn = texp[u.pm] * NPN + (L % NPN); return true; }
    DI void a_ready(const pg8::Unit&) const {}
    DI void done(const pg8::Unit&) const {}
};

constexpr int IDX_CAP = 512;
DI unsigned ordkey(float s) { const unsigned b = __builtin_bit_cast(unsigned, s); return (b & 0x80000000u) ? ~b : (b | 0x80000000u); }
DI float unordkey(unsigned k) { const unsigned b = (k & 0x80000000u) ? (k & 0x7fffffffu) : ~k; return __builtin_bit_cast(float, b); }

DI void idx_item(Ctx& C, int item, int l) {
    const int b = item & 3, qt = 511 - (item >> 2);
    const int t0 = qt * 8, chunk = t0 >> 6, NT32 = 2 * (chunk + 1);
    const size_t tok0 = (size_t)b * SEQ + t0;
    unsigned* bm = (unsigned*)(C.ws + WS_BM);
    const int lane = C.lane, wave = C.wave, tid = C.tid;
    if (chunk < 4) {
        if (tid < 8 * NT32) { const int q = tid / NT32, kt = tid % NT32; bm[(tok0 + q) * 128 + kt] = 0xffffffffu; }
        return;
    }
    const _Float16* ph = (const _Float16*)(C.ws + WS_PROJ);
    LAS unsigned* hist = (LAS unsigned*)(C.lds);
    LAS float* candS = (LAS float*)(C.lds + 8192);
    LAS int* candI = (LAS int*)(C.lds + 24576);
    LAS float* redmn = (LAS float*)(C.lds + 40960);
    LAS float* redmx = redmn + 64;
    LAS int* selB = (LAS int*)(C.lds + 41472);
    LAS unsigned* selAbove = (LAS unsigned*)(selB + 8);
    LAS unsigned* ccount = selAbove + 8;
    LAS float* thrS = (LAS float*)(ccount + 8);
    LAS int* thrI = (LAS int*)(thrS + 8);
    LAS unsigned* ovf = (LAS unsigned*)(thrI + 8);
    LAS unsigned* fbT = ovf + 8;
    LAS unsigned* fbCnt = fbT + 8;
    LAS unsigned* fbNeed = fbCnt + 8;
    const int r = lane & 31, hh = lane >> 5;
    float sc[2][16][2];
    f16x8 afr[2][4]; float wq[2][2][8];
#pragma unroll
    for (int m = 0; m < 2; ++m) {
        const int gq = (r >> 2) & 1, i = r >> 3, jj = r & 3, query = 4 * m + 2 * gq + (i >> 1), head = 4 * (i & 1) + jj;
        const _Float16* qp = ph + (tok0 + query) * PLD + PC_QI + head * 64 + 8 * hh;
#pragma unroll
        for (int s = 0; s < 4; ++s) afr[m][s] = *(const f16x8*)(qp + 16 * s);
#pragma unroll
        for (int qq = 0; qq < 2; ++qq) { const int q2 = 4 * m + 2 * hh + qq; const f16x8 wv = *(const f16x8*)(ph + (tok0 + q2) * PLD + PC_WI);
#pragma unroll
            for (int e = 0; e < 8; ++e) wq[m][qq][e] = (float)wv[e] * 0.044194173824159216f; }
    }
    const _Float16* kbase = ph + ((size_t)b * SEQ + r) * PLD + PC_KI + 8 * hh;
    f16x8 bnx[4];
#pragma unroll
    for (int s = 0; s < 4; ++s) bnx[s] = *(const f16x8*)(kbase + (size_t)(32 * wave) * PLD + 16 * s);
#pragma unroll
    for (int it = 0; it < 16; ++it) {
        const int kt = wave + 8 * it;
        if (kt < NT32) {
            f16x8 bfr[4];
#pragma unroll
            for (int s = 0; s < 4; ++s) bfr[s] = bnx[s];
            if (kt + 8 < NT32) {
#pragma unroll
                for (int s = 0; s < 4; ++s) bnx[s] = *(const f16x8*)(kbase + (size_t)(32 * (kt + 8)) * PLD + 16 * s); }
#pragma unroll
            for (int m = 0; m < 2; ++m) {
                f32x16 c = {};
#pragma unroll
                for (int s = 0; s < 4; ++s) c = __builtin_amdgcn_mfma_f32_32x32x16_f16(afr[m][s], bfr[s], c, 0, 0, 0);
#pragma unroll
                for (int qq = 0; qq < 2; ++qq) { float a = 0.f;
#pragma unroll
                    for (int e = 0; e < 8; ++e) a += wq[m][qq][e] * fmaxf(c[8 * qq + e], 0.f);
                    sc[m][it][qq] = a; }
            }
        } else { sc[0][it][0] = 0.f; sc[0][it][1] = 0.f; sc[1][it][0] = 0.f; sc[1][it][1] = 0.f; }
    }
    float mn[2][2], mx[2][2];
#pragma unroll
    for (int m = 0; m < 2; ++m)
#pragma unroll
        for (int qq = 0; qq < 2; ++qq) { float a = 3.0e38f, z = -3.0e38f;
#pragma unroll
            for (int it = 0; it < 16; ++it) if (wave + 8 * it < NT32) z = fmaxf(z, sc[m][it][qq]);
            a = z;
#pragma unroll
            for (int o = 1; o < 32; o <<= 1) { a = fminf(a, __shfl_xor(a, o)); z = fmaxf(z, __shfl_xor(z, o)); }
            mn[m][qq] = a; mx[m][qq] = z; }
    asm volatile("s_waitcnt lgkmcnt(0)\n\ts_barrier" ::: "memory");
    if (r == 0) {
#pragma unroll
        for (int m = 0; m < 2; ++m)
#pragma unroll
            for (int qq = 0; qq < 2; ++qq) { const int qid = 4 * m + 2 * hh + qq; redmn[wave * 8 + qid] = mn[m][qq]; redmx[wave * 8 + qid] = mx[m][qq]; }
    }
    for (int i = tid; i < 2048; i += NTHR) hist[i] = 0u;
    if (tid < 8) { ccount[tid] = 0u; ovf[tid] = 0u; }
    asm volatile("s_waitcnt lgkmcnt(0)\n\ts_barrier" ::: "memory");
    float lo[2][2], scl[2][2];
#pragma unroll
    for (int m = 0; m < 2; ++m)
#pragma unroll
        for (int qq = 0; qq < 2; ++qq) { const int qid = 4 * m + 2 * hh + qq; float a = 3.0e38f, z = -3.0e38f;
#pragma unroll
            for (int w = 0; w < 8; ++w) { a = fminf(a, redmn[w * 8 + qid]); z = fmaxf(z, redmx[w * 8 + qid]); }
            lo[m][qq] = a; scl[m][qq] = (z > a) ? 256.f / (z - a) : 0.f; }
#define IDX_BIN(m, it, qq) ((sc[m][it][qq] >= lo[m][qq]) ? min(255, (int)((sc[m][it][qq] - lo[m][qq]) * scl[m][qq])) : -1)
#define IDX_LAUNDER() do { _Pragma("unroll") for (int m_ = 0; m_ < 2; ++m_) _Pragma("unroll") for (int q_ = 0; q_ < 2; ++q_) { asm volatile("" : "+v"(lo[m_][q_]), "+v"(scl[m_][q_])); } } while (0)
#pragma unroll
    for (int m = 0; m < 2; ++m)
#pragma unroll
        for (int qq = 0; qq < 2; ++qq) { const int qid = 4 * m + 2 * hh + qq;
#pragma unroll
            for (int it = 0; it < 16; ++it) if (wave + 8 * it < NT32) { const int bin_ = IDX_BIN(m, it, qq); if (bin_ >= 0) __hip_atomic_fetch_add(hist + qid * 256 + bin_, 1u, __ATOMIC_RELAXED, __HIP_MEMORY_SCOPE_WORKGROUP); } }
    asm volatile("s_waitcnt lgkmcnt(0)\n\ts_barrier" ::: "memory");
    {
        const u32x4 h4 = *(const LAS u32x4*)(hist + wave * 256 + 4 * lane);
        const unsigned tot = h4.x + h4.y + h4.z + h4.w; unsigned incl = tot;
#pragma unroll
        for (int o = 1; o < 64; o <<= 1) { const unsigned v = __shfl_down(incl, o); if (lane + o < 64) incl += v; }
        unsigned run = incl - tot; int Bf = -1; unsigned ab = 0;
#pragma unroll
        for (int j = 3; j >= 0; --j) { const unsigned h = h4[j]; if (run < 256u && run + h >= 256u) { Bf = 4 * lane + j; ab = run; } run += h; }
        if (Bf >= 0) { selB[wave] = Bf; selAbove[wave] = ab; }
    }
    asm volatile("s_waitcnt lgkmcnt(0)\n\ts_barrier" ::: "memory");
    IDX_LAUNDER();
#pragma unroll
    for (int m = 0; m < 2; ++m)
#pragma unroll
        for (int qq = 0; qq < 2; ++qq) { const int qid = 4 * m + 2 * hh + qq; const int B = selB[qid];
#pragma unroll
            for (int it = 0; it < 16; ++it) if (wave + 8 * it < NT32) { const bool hit = (IDX_BIN(m, it, qq) == B); if (__any(hit)) { if (hit) { const unsigned pos = __hip_atomic_fetch_add(ccount + qid, 1u, __ATOMIC_RELAXED, __HIP_MEMORY_SCOPE_WORKGROUP);
                if (pos < (unsigned)IDX_CAP) { candS[qid * IDX_CAP + pos] = sc[m][it][qq]; candI[qid * IDX_CAP + pos] = 32 * (wave + 8 * it) + r; } } } } }
    asm volatile("s_waitcnt lgkmcnt(0)\n\ts_barrier" ::: "memory");
    {
        const int c = (int)ccount[wave]; const int need = 256 - (int)selAbove[wave];
        if (c <= IDX_CAP) {
            for (int i = lane; i < c; i += 64) { const float si = candS[wave * IDX_CAP + i]; const int ii = candI[wave * IDX_CAP + i]; int rank = 0;
                for (int j = 0; j < c; ++j) { const float sj = candS[wave * IDX_CAP + j]; const int ij = candI[wave * IDX_CAP + j]; rank += ((sj > si) || (sj == si && ij < ii)) ? 1 : 0; }
                if (rank == need - 1) { thrS[wave] = si; thrI[wave] = ii; } }
        } else if (lane == 0) { ovf[wave] = 1u; fbNeed[wave] = (unsigned)need; fbT[wave] = 0u; }
    }
    asm volatile("s_waitcnt lgkmcnt(0)\n\ts_barrier" ::: "memory");
    unsigned anyovf = 0u;
#pragma unroll
    for (int q = 0; q < 8; ++q) anyovf |= ovf[q];
    if (anyovf) {
        for (int bit = 31; bit >= 0; --bit) {
            if (tid < 8) fbCnt[tid] = 0u;
            asm volatile("s_waitcnt lgkmcnt(0)\n\ts_barrier" ::: "memory");
            IDX_LAUNDER();
#pragma unroll
            for (int m = 0; m < 2; ++m)
#pragma unroll
                for (int qq = 0; qq < 2; ++qq) { const int qid = 4 * m + 2 * hh + qq; if (ovf[qid]) { const unsigned cand = fbT[qid] | (1u << bit); const int B = selB[qid]; unsigned cnt = 0;
#pragma unroll
                    for (int it = 0; it < 16; ++it) if (wave + 8 * it < NT32) cnt += (IDX_BIN(m, it, qq) == B && ordkey(sc[m][it][qq]) >= cand) ? 1u : 0u;
                    if (cnt) __hip_atomic_fetch_add(fbCnt + qid, cnt, __ATOMIC_RELAXED, __HIP_MEMORY_SCOPE_WORKGROUP); } }
            asm volatile("s_waitcnt lgkmcnt(0)\n\ts_barrier" ::: "memory");
            if (tid < 8 && ovf[tid] && fbCnt[tid] >= fbNeed[tid]) fbT[tid] |= (1u << bit);
            asm volatile("s_waitcnt lgkmcnt(0)\n\ts_barrier" ::: "memory");
        }
        if (tid < 8) fbCnt[tid] = 0u;
        asm volatile("s_waitcnt lgkmcnt(0)\n\ts_barrier" ::: "memory");
        IDX_LAUNDER();
#pragma unroll
        for (int m = 0; m < 2; ++m)
#pragma unroll
            for (int qq = 0; qq < 2; ++qq) { const int qid = 4 * m + 2 * hh + qq; if (ovf[qid]) { const unsigned Tk = fbT[qid]; const int B = selB[qid]; unsigned cnt = 0;
#pragma unroll
                for (int it = 0; it < 16; ++it) if (wave + 8 * it < NT32) cnt += (IDX_BIN(m, it, qq) == B && ordkey(sc[m][it][qq]) > Tk) ? 1u : 0u;
                if (cnt) __hip_atomic_fetch_add(fbCnt + qid, cnt, __ATOMIC_RELAXED, __HIP_MEMORY_SCOPE_WORKGROUP); } }
        asm volatile("s_waitcnt lgkmcnt(0)\n\ts_barrier" ::: "memory");
        if (tid < 8 && ovf[tid]) { fbNeed[tid] -= fbCnt[tid]; thrS[tid] = unordkey(fbT[tid]); thrI[tid] = 0; }
        asm volatile("s_waitcnt lgkmcnt(0)\n\ts_barrier" ::: "memory");
        for (int bit = 11; bit >= 0; --bit) {
            if (tid < 8) fbCnt[tid] = 0u;
            asm volatile("s_waitcnt lgkmcnt(0)\n\ts_barrier" ::: "memory");
            IDX_LAUNDER();
#pragma unroll
            for (int m = 0; m < 2; ++m)
#pragma unroll
                for (int qq = 0; qq < 2; ++qq) { const int qid = 4 * m + 2 * hh + qq; if (ovf[qid]) { const unsigned Tk = fbT[qid]; const int B = selB[qid]; const int cand = thrI[qid] | (1 << bit); unsigned cnt = 0;
#pragma unroll
                    for (int it = 0; it < 16; ++it) if (wave + 8 * it < NT32) cnt += (IDX_BIN(m, it, qq) == B && ordkey(sc[m][it][qq]) == Tk && (32 * (wave + 8 * it) + r) < cand) ? 1u : 0u;
                    if (cnt) __hip_atomic_fetch_add(fbCnt + qid, cnt, __ATOMIC_RELAXED, __HIP_MEMORY_SCOPE_WORKGROUP); } }
            asm volatile("s_waitcnt lgkmcnt(0)\n\ts_barrier" ::: "memory");
            if (tid < 8 && ovf[tid] && fbCnt[tid] < fbNeed[tid]) thrI[tid] |= (1 << bit);
            asm volatile("s_waitcnt lgkmcnt(0)\n\ts_barrier" ::: "memory");
        }
    }
    IDX_LAUNDER();
#pragma unroll
    for (int m = 0; m < 2; ++m)
#pragma unroll
        for (int qq = 0; qq < 2; ++qq) { const int qid = 4 * m + 2 * hh + qq; const int B = selB[qid]; const float ts = thrS[qid]; const int ti = thrI[qid];
            unsigned myw = 0u;
#pragma unroll
            for (int it = 0; it < 16; ++it) { const int kt = wave + 8 * it;
                if (kt < NT32) { const int bin = IDX_BIN(m, it, qq); const float s = sc[m][it][qq]; const int idx = 32 * kt + r;
                    const bool sel = (bin > B) || (bin == B && (s > ts || (s == ts && idx <= ti)));
                    const unsigned long long mk = __ballot(sel);
                    const unsigned wv = hh ? (unsigned)(mk >> 32) : (unsigned)mk;
                    if (r == it) myw = wv; } }
            if (r < 16 && wave + 8 * r < NT32) bm[(tok0 + qid) * 128 + wave + 8 * r] = myw; }
#undef IDX_BIN
#undef IDX_LAUNDER
}

DI float softplusf_(float z) { return fmaxf(z, 0.f) + log1pf(expf(-fabsf(z))); }
DI void attn_tile(const LAS unsigned char* kb, const LAS unsigned char* vb, const LAS float* tab, const bf16x8 (&qr)[4], unsigned cw0, unsigned cw1, int j, int qw, int myq, int r32, int hi, float bias_far,
                  float& m_run, float& l_run, f32x16& o0, f32x16& o1, f32x16& negmb) {
    bf16x8 ka[8];
#pragma unroll
    for (int s = 0; s < 4; ++s) { const int ch = 2 * s + hi;
        ka[2 * s] = *(const LAS bf16x8*)(kb + r32 * 128 + ((ch ^ ((r32 >> 1) & 7)) << 4));
        ka[2 * s + 1] = *(const LAS bf16x8*)(kb + (32 + r32) * 128 + ((ch ^ (((32 + r32) >> 1) & 7)) << 4)); }
    f32x16 p0 = negmb, p1 = negmb;
#pragma unroll
    for (int s = 0; s < 4; ++s) { p0 = __builtin_amdgcn_mfma_f32_32x32x16_bf16(ka[2 * s], qr[s], p0, 0, 0, 0); p1 = __builtin_amdgcn_mfma_f32_32x32x16_bf16(ka[2 * s + 1], qr[s], p1, 0, 0, 0); }
    u32x4 va0[4], va1[4];
#pragma unroll
    for (int s = 0; s < 4; ++s) {
        const u32x2 a0l = *(const LAS u32x2*)(vb + (r32) * 136 + (16 * s + 4 * hi) * 2), a0h = *(const LAS u32x2*)(vb + (r32) * 136 + (16 * s + 8 + 4 * hi) * 2);
        const u32x2 a1l = *(const LAS u32x2*)(vb + (32 + r32) * 136 + (16 * s + 4 * hi) * 2), a1h = *(const LAS u32x2*)(vb + (32 + r32) * 136 + (16 * s + 8 + 4 * hi) * 2);
        va0[s] = (u32x4){a0l.x, a0l.y, a0h.x, a0h.y}; va1[s] = (u32x4){a1l.x, a1l.y, a1h.x, a1h.y}; }
    const bool far = (64 * j + 63 - qw) <= -128;
    if (!far) {
#pragma unroll
        for (int g = 0; g < 16; ++g) { const int kv0 = 64 * j + (g & 3) + 8 * (g >> 2) + 4 * hi; int r0 = kv0 - myq, r1 = r0 + 32;
            r0 = r0 < -128 ? -128 : r0; r1 = r1 < -128 ? -128 : r1;
            p0[g] += tab[r0 + 128]; p1[g] += tab[r1 + 128]; }
    }
    float mx = p0[0];
#pragma unroll
    for (int g = 1; g < 16; ++g) mx = fmaxf(mx, p0[g]);
#pragma unroll
    for (int g = 0; g < 16; ++g) mx = fmaxf(mx, p1[g]);
    mx = fmaxf(mx, __shfl_xor(mx, 32));
    if (j == 0 || __any(mx > 0.f)) {
        const float dl = (j == 0) ? mx : fmaxf(mx, 0.f);
        m_run += dl;
        const float al = __builtin_amdgcn_exp2f(-dl); l_run *= al;
#pragma unroll
        for (int g = 0; g < 16; ++g) { p0[g] -= dl; p1[g] -= dl; o0[g] *= al; o1[g] *= al; negmb[g] = bias_far - m_run; }
        asm volatile("" : "+v"(negmb));
    }
    const int sw0 = (int)(cw0 >> (4 * hi)), sw1 = (int)(cw1 >> (4 * hi));
    float ls = 0.f;
#pragma unroll
    for (int g = 0; g < 16; ++g) { const int bit = (g & 3) + 8 * (g >> 2);
        const float e0 = __builtin_amdgcn_exp2f(p0[g]), e1 = __builtin_amdgcn_exp2f(p1[g]);
        int m0_, m1_;
        asm("v_bfe_i32 %0, %1, %2, 1" : "=v"(m0_) : "v"(sw0), "n"(bit)); asm("v_bfe_i32 %0, %1, %2, 1" : "=v"(m1_) : "v"(sw1), "n"(bit));
        p0[g] = __builtin_bit_cast(float, __builtin_bit_cast(int, e0) & m0_); p1[g] = __builtin_bit_cast(float, __builtin_bit_cast(int, e1) & m1_); ls += p0[g] + p1[g]; }
    l_run += ls;
    bf16x8 pb[4];
#pragma unroll
    for (int s = 0; s < 2; ++s) {
        u32x4 w; w.x = pk2(p0[8 * s], p0[8 * s + 1]); w.y = pk2(p0[8 * s + 2], p0[8 * s + 3]); w.z = pk2(p0[8 * s + 4], p0[8 * s + 5]); w.w = pk2(p0[8 * s + 6], p0[8 * s + 7]); pb[s] = __builtin_bit_cast(bf16x8, w);
        u32x4 x; x.x = pk2(p1[8 * s], p1[8 * s + 1]); x.y = pk2(p1[8 * s + 2], p1[8 * s + 3]); x.z = pk2(p1[8 * s + 4], p1[8 * s + 5]); x.w = pk2(p1[8 * s + 6], p1[8 * s + 7]); pb[2 + s] = __builtin_bit_cast(bf16x8, x); }
#pragma unroll
    for (int s = 0; s < 4; ++s) {
        o0 = __builtin_amdgcn_mfma_f32_32x32x16_bf16(__builtin_bit_cast(bf16x8, va0[s]), pb[s], o0, 0, 0, 0);
        o1 = __builtin_amdgcn_mfma_f32_32x32x16_bf16(__builtin_bit_cast(bf16x8, va1[s]), pb[s], o1, 0, 0, 0); }
}
DI void attn_unit(Ctx& C, int b, int h, int qb) {
    const int tid = C.tid, lane = C.lane, wave = C.wave, r32 = lane & 31, hi = lane >> 5;
    const bf16_t* proj = (const bf16_t*)(C.ws + WS_PROJ);
    const unsigned* bm = (const unsigned*)(C.ws + WS_BM);
    LAS unsigned char* Kl = C.lds; LAS unsigned char* Vl = C.lds + 16384; LAS float* tab = (LAS float*)(C.lds + 33792);
    const size_t rowbase = (size_t)b * SEQ; const int q0 = qb * 256, qw = q0 + 32 * wave, myq = qw + r32;
    const int NT = 4 * qb + 4, mylast = qw >> 6;
    constexpr float LOG2E = 1.4426950408889634f;
    __syncthreads();
    if (tid < 192) { const int rel = tid - 128; const int n = rel < 0 ? -rel : rel; int bk = rel > 0 ? 16 : 0;
        if (n < 8) bk += n; else bk += 8 + (n >= 12) + (n >= 16) + (n >= 23) + (n >= 32) + (n >= 46) + (n >= 64) + (n >= 91);
        tab[tid] = (C.in(17)[bk * 8 + h] - C.in(17)[15 * 8 + h]) * LOG2E; }
    const float bias_far = C.in(17)[15 * 8 + h] * LOG2E;
    bf16x8 qr[4];
    { const bf16_t* qp = proj + (rowbase + myq) * PLD + PC_Q + h * 64 + 8 * hi;
#pragma unroll
        for (int s = 0; s < 4; ++s) { const u32x4 raw = *(const u32x4*)(qp + 16 * s); u32x4 sc_;
#pragma unroll
            for (int e = 0; e < 4; ++e) sc_[e] = pk2(bflo(raw[e]) * (0.125f * LOG2E), bfhi(raw[e]) * (0.125f * LOG2E));
            qr[s] = __builtin_bit_cast(bf16x8, sc_); } }
    const unsigned* bmrow = bm + (rowbase + myq) * 128;
    const int skv = tid >> 3, sch = tid & 7;
    const bf16_t* ksrc = proj + (rowbase + skv) * PLD + PC_K + h * 64 + 8 * sch;
    const bf16_t* vsrc = proj + (rowbase + skv) * PLD + PC_V + h * 64 + 8 * sch;
    const int kdst = skv * 128 + ((sch ^ ((skv >> 1) & 7)) << 4);
    const u32x4 m4i = *(const u32x4*)bmrow;
    u32x4 kregA = *(const u32x4*)ksrc, vregA = *(const u32x4*)vsrc; unsigned mA0 = m4i.x, mA1 = m4i.y;
    u32x4 kregB = kregA, vregB = vregA; unsigned mB0 = m4i.z, mB1 = m4i.w;
    if (NT > 1) { kregB = *(const u32x4*)(ksrc + (size_t)64 * PLD); vregB = *(const u32x4*)(vsrc + (size_t)64 * PLD); }
    const bool vodd = (skv & 1) != 0; const int vdst = ((8 * sch + (vodd ? 4 : 0)) * 68 + (skv & ~1)) * 2;
#define ATT_WRITE(buf, kreg, vreg) do { *(LAS u32x4*)(Kl + (buf) * 8192 + kdst) = kreg; LAS unsigned char* vt_ = Vl + (buf) * 8704 + vdst; \
        const unsigned r0_ = (unsigned)__builtin_amdgcn_ds_swizzle((int)(vodd ? vreg.x : vreg.z), 0x201F), r1_ = (unsigned)__builtin_amdgcn_ds_swizzle((int)(vodd ? vreg.y : vreg.w), 0x201F); \
        const unsigned lo0_ = vodd ? r0_ : vreg.x, hi0_ = vodd ? vreg.z : r0_, lo1_ = vodd ? r1_ : vreg.y, hi1_ = vodd ? vreg.w : r1_; \
        *(LAS unsigned*)(vt_ + 0 * 136) = (lo0_ & 0xffffu) | (hi0_ << 16); *(LAS unsigned*)(vt_ + 1 * 136) = (lo0_ >> 16) | (hi0_ & 0xffff0000u); \
        *(LAS unsigned*)(vt_ + 2 * 136) = (lo1_ & 0xffffu) | (hi1_ << 16); *(LAS unsigned*)(vt_ + 3 * 136) = (lo1_ >> 16) | (hi1_ & 0xffff0000u); } while (0)
    ATT_WRITE(0, kregA, vregA);
    __syncthreads();
    float m_run = 0.f, l_run = 0.f; f32x16 o0 = {}, o1 = {}, negmb;
#pragma unroll
    for (int g = 0; g < 16; ++g) negmb[g] = bias_far;
    asm volatile("" : "+v"(negmb));
#define ATT_STEP(J, CW0, CW1, KN, VN, KF, VF, MLOAD) do { const int js_ = (J); const int buf = js_ & 1; \
        if (js_ + 2 < NT) { KF = *(const u32x4*)(ksrc + (size_t)(js_ + 2) * 64 * PLD); VF = *(const u32x4*)(vsrc + (size_t)(js_ + 2) * 64 * PLD); MLOAD; } \
        if (js_ <= mylast) { attn_tile(Kl + buf * 8192, Vl + buf * 8704, tab, qr, (CW0), (CW1), js_, qw, myq, r32, hi, bias_far, m_run, l_run, o0, o1, negmb); } \
        if (js_ + 1 < NT) ATT_WRITE(buf ^ 1, KN, VN); \
        __syncthreads(); } while (0)
    {
        unsigned cA0 = mA0, cA1 = mA1;
        for (int j = 0; j < NT; j += 2) {
            u32x4 m4 = {0u, 0u, 0u, 0u};
            { const unsigned c0 = cA0, c1 = cA1; u32x4 kf = kregA, vf = vregA;
              ATT_STEP(j, c0, c1, kregB, vregB, kf, vf, m4 = *(const u32x4*)(bmrow + 2 * js_ + 4)); kregA = kf; vregA = vf; cA0 = m4.x; cA1 = m4.y; }
            if (j + 1 < NT) {
                const unsigned c0 = mB0, c1 = mB1; u32x4 kf = kregB, vf = vregB;
                ATT_STEP(j + 1, c0, c1, kregA, vregA, kf, vf, (void)0); kregB = kf; vregB = vf; mB0 = m4.z; mB1 = m4.w; }
        }
    }
#undef ATT_STEP
#undef ATT_WRITE
    const float lt = l_run + __shfl_xor(l_run, 32); const float inv = 1.f / lt;
    bf16_t* orow = C.mixcat + (rowbase + myq) * D + h * 64;
#pragma unroll
    for (int i = 0; i < 4; ++i) { const int d = 8 * i + 4 * hi;
        u32x2 w0; w0.x = pk2(o0[4 * i] * inv, o0[4 * i + 1] * inv); w0.y = pk2(o0[4 * i + 2] * inv, o0[4 * i + 3] * inv); *(u32x2*)(orow + d) = w0;
        u32x2 w1; w1.x = pk2(o1[4 * i] * inv, o1[4 * i + 1] * inv); w1.y = pk2(o1[4 * i + 2] * inv, o1[4 * i + 3] * inv); *(u32x2*)(orow + 32 + d) = w1; }
}

constexpr size_t WS_PHI = 38 * MiB, WS_PSI = 54 * MiB, WS_GT = 70 * MiB, WS_Y0T = 86 * MiB, WS_GGT = 102 * MiB, WS_RHO = 118 * MiB;
constexpr size_t WS_S0 = 1 * MiB;
constexpr size_t WS_LORA = 250 * MiB;
DI int crow(int g, int hi) { return (g & 3) + 8 * (g >> 2) + 4 * hi; }
DI f32x16 mfma32(bf16x8 a, bf16x8 b, f32x16 c) { return __builtin_amdgcn_mfma_f32_32x32x16_bf16(a, b, c, 0, 0, 0); }
struct FA { float v[16]; DI float& operator[](int i) { return v[i]; } DI const float& operator[](int i) const { return v[i]; } };
struct F8 { float v[8]; DI float& operator[](int i) { return v[i]; } DI const float& operator[](int i) const { return v[i]; } };
DI bf16x8 pack8(const F8& a) { u32x4 w; w.x = pk2(a[0], a[1]); w.y = pk2(a[2], a[3]); w.z = pk2(a[4], a[5]); w.w = pk2(a[6], a[7]); return __builtin_bit_cast(bf16x8, w); }
DI void pin(FA& a) { asm volatile("" : "+v"(a.v[0]), "+v"(a.v[1]), "+v"(a.v[2]), "+v"(a.v[3]), "+v"(a.v[4]), "+v"(a.v[5]), "+v"(a.v[6]), "+v"(a.v[7]), "+v"(a.v[8]), "+v"(a.v[9]), "+v"(a.v[10]), "+v"(a.v[11]), "+v"(a.v[12]), "+v"(a.v[13]), "+v"(a.v[14]), "+v"(a.v[15])); }
DI void pinf(bf16x8& a) { asm volatile("" : "+v"(a)); }
DI FA toFA(const f32x16& a) { FA r; _Pragma("unroll") for (int i = 0; i < 16; ++i) r.v[i] = a[i]; return r; }
DI f32x16 toV(const FA& a) { f32x16 r; _Pragma("unroll") for (int i = 0; i < 16; ++i) r[i] = a.v[i]; return r; }
DI bf16x8 packfrag(const FA& a, int s) { u32x4 w; w.x = pk2(a[8 * s], a[8 * s + 1]); w.y = pk2(a[8 * s + 2], a[8 * s + 3]); w.z = pk2(a[8 * s + 4], a[8 * s + 5]); w.w = pk2(a[8 * s + 6], a[8 * s + 7]); return __builtin_bit_cast(bf16x8, w); }
DI bf16x8 packfrag(const f32x16& a, int s) { u32x4 w; w.x = pk2(a[8 * s], a[8 * s + 1]); w.y = pk2(a[8 * s + 2], a[8 * s + 3]); w.z = pk2(a[8 * s + 4], a[8 * s + 5]); w.w = pk2(a[8 * s + 6], a[8 * s + 7]); return __builtin_bit_cast(bf16x8, w); }
DI unsigned opq(unsigned v) { asm volatile("" : "+v"(v)); return v; }
DI void st_frag(unsigned char* buf, int f, int lane, bf16x8 v) { *(bf16x8*)(buf + f * 1024 + opq(lane * 16)) = v; }
DI bf16x8 ld_frag(const unsigned char* buf, int f, int lane) { return *(const bf16x8*)(buf + f * 1024 + opq(lane * 16)); }
template <class TT> DI void st_tile_bf16(unsigned char* buf, int q, int lane, const TT& a) { const unsigned o = opq(lane * 32); *(bf16x8*)(buf + q * 2048 + o) = packfrag(a, 0); *(bf16x8*)(buf + q * 2048 + o + 16) = packfrag(a, 1); }
DI FA ld_tile_bf16(const unsigned char* buf, int q, int lane) { const unsigned o = opq(lane * 32); const u32x4 a = *(const u32x4*)(buf + q * 2048 + o), b = *(const u32x4*)(buf + q * 2048 + o + 16); FA r;
    r[0] = bflo(a.x); r[1] = bfhi(a.x); r[2] = bflo(a.y); r[3] = bfhi(a.y); r[4] = bflo(a.z); r[5] = bfhi(a.z); r[6] = bflo(a.w); r[7] = bfhi(a.w);
    r[8] = bflo(b.x); r[9] = bfhi(b.x); r[10] = bflo(b.y); r[11] = bfhi(b.y); r[12] = bflo(b.z); r[13] = bfhi(b.z); r[14] = bflo(b.w); r[15] = bfhi(b.w); return r; }
DI float fexp(float x) { return __builtin_amdgcn_exp2f(x * 1.4426950408889634f); }
DI float flog(float x) { return __builtin_amdgcn_logf(x) * 0.6931471805599453f; }
DI float ftanh(float x) { return 1.f - 2.f * __builtin_amdgcn_rcpf(1.f + fexp(2.f * x)); }
DI float fsigm(float x) { return __builtin_amdgcn_rcpf(1.f + fexp(-x)); }
DI float fsoftplus(float z) { return fmaxf(z, 0.f) + flog(1.f + fexp(-fabsf(z))); }
template <int ACT> DI bf16x8 act_frag(const bf16_t* proj, size_t row, bool first, int c0, const float* mu8) {
    const bf16_t* rp = proj + opq((unsigned)(row * PLD)); const u32x4 cu = *(const u32x4*)(rp + c0); u32x4 pv = {0u, 0u, 0u, 0u}; if (!first) pv = *(const u32x4*)(rp - PLD + c0);
    const float* mq = mu8 + opq(0u); const f32x4 m0 = *(const f32x4*)(mq), m1 = *(const f32x4*)(mq + 4);
    float x[8];
#pragma unroll
    for (int q = 0; q < 4; ++q) { const float c_lo = bflo(cu[q]), c_hi = bfhi(cu[q]), p_lo = bflo(pv[q]), p_hi = bfhi(pv[q]); const float ma = (q < 2) ? m0[2 * q] : m1[2 * q - 4], mb = (q < 2) ? m0[2 * q + 1] : m1[2 * q - 3];
        x[2 * q] = c_lo + (p_lo - c_lo) * ma; x[2 * q + 1] = c_hi + (p_hi - c_hi) * mb; }
#pragma unroll
    for (int e = 0; e < 8; ++e) { if (ACT == 1) x[e] = ftanh(x[e]); else if (ACT == 2) x[e] = fsigm(x[e]); }
    u32x4 w; w.x = pk2(x[0], x[1]); w.y = pk2(x[2], x[3]); w.z = pk2(x[4], x[5]); w.w = pk2(x[6], x[7]); return __builtin_bit_cast(bf16x8, w);
}
DI f32x4 shift4(const bf16_t* proj, size_t row, bool first, int c4, const float* mu4) {
    const bf16_t* rp = proj + opq((unsigned)(row * PLD)); const u32x2 cu = *(const u32x2*)(rp + c4); u32x2 pv = {0u, 0u}; if (!first) pv = *(const u32x2*)(rp - PLD + c4);
    const f32x4 m = *(const f32x4*)(mu4 + opq(0u)); const f32x4 c = {bflo(cu.x), bfhi(cu.x), bflo(cu.y), bfhi(cu.y)}, p = {bflo(pv.x), bfhi(pv.x), bflo(pv.y), bfhi(pv.y)};
    return c + (p - c) * m;
}
DI f32x4 shiftT4(const bf16_t* proj, size_t row, bool firstseq, int c1, float mu1) {
    const bf16_t* rp = proj + opq((unsigned)(row * PLD + c1));
    const float c0 = bf2f(rp[0]), c1_ = bf2f(rp[PLD]), c2 = bf2f(rp[2 * PLD]), c3 = bf2f(rp[3 * PLD]);
    const float pm = firstseq ? 0.f : bf2f(*(rp - PLD));
    f32x4 r; r.x = c0 + (pm - c0) * mu1; r.y = c1_ + (c0 - c1_) * mu1; r.z = c2 + (c1_ - c2) * mu1; r.w = c3 + (c2 - c3) * mu1; return r;
}
DI float scan32_incl(float x, int tl) {
#pragma unroll
    for (int d = 1; d < 32; d <<= 1) { const float y = __shfl_up(x, d, 32); if (tl >= d) x += y; }
    return x;
}

constexpr int RL_ACT = 0;
constexpr int RL_MAB = 0, RL_W1C = 17408, RL_W2C = 26624;
constexpr int RL_ELL = 35840;
constexpr int RL_AV = RL_ELL + 16640, RL_MAK = RL_ELL, RL_NRB = RL_ELL + 9216, RL_NRK = RL_ELL + 18432;
constexpr int RL_RT = 69120, RL_AT = RL_RT + 9216, RL_BT = RL_RT + 18432, RL_KT = RL_RT + 27648;
constexpr int RL_X2 = RL_AT;
constexpr int RL_BHC = 105984, RL_KHC = RL_BHC + 9216, RL_VC = RL_BHC + 18432;
constexpr int RL_X = 133632;
constexpr int RL_SM = 150272;
constexpr int RL_END = RL_SM + 512;
template <int KS> DI f32x16 mm_ll(const LAS bf16_t* a, int pa, const LAS bf16_t* b, int pb, int lane, f32x16 acc) {
    const LAS bf16_t* ap = a + (lane & 31) * pa + 8 * (lane >> 5); const LAS bf16_t* bp = b + (lane & 31) * pb + 8 * (lane >> 5);
#pragma unroll
    for (int s = 0; s < KS; ++s) acc = mfma32(*(const LAS bf16x8*)(ap + 16 * s), *(const LAS bf16x8*)(bp + 16 * s), acc);
    return acc;
}
DI void rwkv_chunk_acts(Ctx& C, int bc, int l, bf16x8 (&actv)[4]) {
    const int chunk = bc & 63, b = bc >> 6, t = C.tid >> 3, cg = C.tid & 7; const size_t row = (size_t)b * SEQ + chunk * 64 + t; const bool first = (chunk == 0 && t == 0);
    const bf16_t* proj = (const bf16_t*)(C.ws + WS_PROJ); const float* mu = C.in(6) + (size_t)l * 1792;
#pragma unroll
    for (int q = 0; q < 4; ++q) { const int c8 = cg * 32 + 8 * q;
        if (c8 < 64) actv[q] = act_frag<1>(proj, row, first, PC_WD + c8, mu + 1536 + c8); else if (c8 < 128) actv[q] = act_frag<0>(proj, row, first, PC_WD + c8, mu + 1536 + c8); else actv[q] = act_frag<2>(proj, row, first, PC_WD + c8, mu + 1536 + c8); }
}
#define LBAR() asm volatile("s_waitcnt lgkmcnt(0)\n\ts_barrier" ::: "memory")
DI void rwkv_head_item(Ctx& C, int item, int l, const bf16x8 (&actv)[4]) {
    const int h = item & 7, chunk = (item >> 3) & 63, b = item >> 9, tid = C.tid, lane = C.lane, wave = C.wave, tl = lane & 31, hi = lane >> 5;
    const size_t tok0 = (size_t)b * SEQ + chunk * 64;
    const bf16_t* proj = (const bf16_t*)(C.ws + WS_PROJ);
    const size_t chid = ((size_t)(b * 8 + h) * 64 + chunk) * 8192;
    unsigned char* PHI = C.ws + WS_PHI + chid; unsigned char* PSI = C.ws + WS_PSI + chid; unsigned char* GT = C.ws + WS_GT + chid; unsigned char* Y0T = C.ws + WS_Y0T + chid; unsigned char* GGT = C.ws + WS_GGT + chid;
    const bf16_t* WDT = (const bf16_t*)(C.ws + WS_LORA); const bf16_t* WAT = WDT + 512 * 64; const bf16_t* WGT = WAT + 512 * 64;
    const float* mu = C.in(6) + (size_t)l * 1792;
    const float* w0p = C.in(7) + l * 512 + 64 * h; const float* a0p = C.in(9) + l * 512 + 64 * h;
    const float* kkp = C.in(12) + l * 512 + 64 * h; const float* kap = C.in(13) + l * 512 + 64 * h; const float* rkp = C.in(14) + l * 512 + 64 * h;
    LAS bf16_t* ACT = (LAS bf16_t*)(C.lds + RL_ACT); LAS float* MAB = (LAS float*)(C.lds + RL_MAB); LAS bf16_t* W1C = (LAS bf16_t*)(C.lds + RL_W1C); LAS bf16_t* W2C = (LAS bf16_t*)(C.lds + RL_W2C);
    LAS float* ELL = (LAS float*)(C.lds + RL_ELL); LAS float* AV = (LAS float*)(C.lds + RL_AV);
    LAS bf16_t* MAK = (LAS bf16_t*)(C.lds + RL_MAK); LAS bf16_t* NRB = (LAS bf16_t*)(C.lds + RL_NRB); LAS bf16_t* NRK = (LAS bf16_t*)(C.lds + RL_NRK);
    LAS bf16_t* AT = (LAS bf16_t*)(C.lds + RL_AT); LAS bf16_t* RT = (LAS bf16_t*)(C.lds + RL_RT); LAS bf16_t* BT = (LAS bf16_t*)(C.lds + RL_BT); LAS bf16_t* KT = (LAS bf16_t*)(C.lds + RL_KT);
    LAS bf16_t* BHC = (LAS bf16_t*)(C.lds + RL_BHC); LAS bf16_t* KHC = (LAS bf16_t*)(C.lds + RL_KHC); LAS bf16_t* VC = (LAS bf16_t*)(C.lds + RL_VC);
    LAS float* X = (LAS float*)(C.lds + RL_X); LAS float* X2 = (LAS float*)(C.lds + RL_X2); LAS float* INV = (LAS float*)(C.lds + RL_SM); LAS float* LCv = INV + 64;
    LBAR();
#ifndef RWR12
#define RWR12 1
#define RWR4 1
#define RWR5 1
#define RWR11 1
#endif
    for (int rr_ = 0; rr_ < RWR12; ++rr_) {
    const int jp = (wave >> 1) & 1, jq = wave & 1;
    bf16x8 wfr[8];
    if (wave < 4) { const bf16_t* W = WGT + (size_t)(64 * h + 32 * jp + tl) * 128 + 8 * hi;
#pragma unroll
        for (int s = 0; s < 8; ++s) wfr[s] = *(const bf16x8*)(W + 16 * s);
    } else { const bf16_t* W0 = WDT + (size_t)(64 * h + 32 * jq + tl) * 64 + 8 * hi; const bf16_t* W1 = WAT + (size_t)(64 * h + 32 * jq + tl) * 64 + 8 * hi;
#pragma unroll
        for (int s = 0; s < 4; ++s) { wfr[s] = *(const bf16x8*)(W0 + 16 * s); wfr[4 + s] = *(const bf16x8*)(W1 + 16 * s); } }
    { const int t = tid >> 3, cg = tid & 7;
#pragma unroll
        for (int q = 0; q < 4; ++q) *(LAS bf16x8*)(ACT + t * 264 + cg * 32 + 8 * q) = actv[q]; }
    LBAR();
    if (wave < 4) {
        const LAS bf16_t* bp = ACT + (32 * jq + tl) * 264 + 128 + 8 * hi; f32x16 acc = {};
#pragma unroll
        for (int s = 0; s < 8; ++s) acc = mfma32(wfr[s], *(const LAS bf16x8*)(bp + 16 * s), acc);
        st_tile_bf16(GGT, jp * 2 + jq, lane, acc);
    } else {
        const LAS bf16_t* ap = ACT + (32 * jp + tl) * 264 + 8 * hi; f32x16 a0 = {}, a1 = {};
#pragma unroll
        for (int s = 0; s < 4; ++s) { a0 = mfma32(*(const LAS bf16x8*)(ap + 16 * s), wfr[s], a0); a1 = mfma32(*(const LAS bf16x8*)(ap + 64 + 16 * s), wfr[4 + s], a1); }
        const int ch = 32 * jq + tl; const float w0c = w0p[ch], a0c = a0p[ch];
#pragma unroll
        for (int g = 0; g < 16; ++g) { const int t = 32 * jp + crow(g, hi); ELL[t * 65 + ch] = -fexp(-fsoftplus(-(w0c + a0[g])) - 0.5f); AV[t * 65 + ch] = fsigm(a0c + a1[g]); }
    }
    LBAR();
    }
    { const int ch = tid & 63, seg = tid >> 6; float p[8]; float run = 0.f;
#pragma unroll
        for (int e = 0; e < 8; ++e) { run += ELL[(8 * seg + e) * 65 + ch]; p[e] = run; }
        X[seg * 65 + ch] = run;
        LBAR();
        float off = 0.f;
#pragma unroll
        for (int s2 = 0; s2 < 7; ++s2) off += (s2 < seg) ? X[s2 * 65 + ch] : 0.f;
#pragma unroll
        for (int e = 0; e < 8; ++e) ELL[(8 * seg + e) * 65 + ch] = off + p[e];
        if (seg == 7) LCv[ch] = off + p[7]; }
    LBAR();
    for (int rr_ = 0; rr_ < RWR4; ++rr_) {
    { const int t = tid >> 3, c0 = (tid & 7) * 8; const size_t row = tok0 + t; const bool first = (chunk == 0 && t == 0); float rho = 0.f, n2 = 0.f;
        f32x4 r4[2], k4[2], v4[2];
#pragma unroll
        for (int q = 0; q < 2; ++q) { const int c = c0 + 4 * q;
            r4[q] = shift4(proj, row, first, PC_R + 64 * h + c, mu + 64 * h + c); k4[q] = shift4(proj, row, first, PC_BK + 64 * h + c, mu + 512 + 64 * h + c); v4[q] = shift4(proj, row, first, PC_BV + 64 * h + c, mu + 1024 + 64 * h + c);
            const f32x4 kr = k4[q] * *(const f32x4*)(kkp + c); n2 += (kr.x * kr.x + kr.y * kr.y) + (kr.z * kr.z + kr.w * kr.w); }
        n2 += __shfl_xor(n2, 1); n2 += __shfl_xor(n2, 2); n2 += __shfl_xor(n2, 4);
        const float inv = 1.f / fmaxf(sqrtf(n2), 1e-12f);
        F8 vA, vR, vB, vK;
#pragma unroll
        for (int q = 0; q < 2; ++q) { const int c = c0 + 4 * q;
            const f32x4 kk4 = *(const f32x4*)(kkp + c), ka4 = *(const f32x4*)(kap + c), rk4 = *(const f32x4*)(rkp + c);
#pragma unroll
            for (int jj = 0; jj < 4; ++jj) { const int ch = c + jj; const float a = AV[t * 65 + ch], L = ELL[t * 65 + ch], Lp = t ? ELL[(t - 1) * 65 + ch] : 0.f, LC = LCv[ch];
                const float kk = k4[q][jj] * kk4[jj] * inv, kp = k4[q][jj] * (1.f + (a - 1.f) * ka4[jj]), bb = kk * a;
                const float eL = fexp(L), eN = fexp(-L), eP = fexp(Lp), eD = fexp(LC - L);
                rho += r4[q][jj] * kp * rk4[jj];
                const float xa = -kk * eP; vA[4 * q + jj] = xa; vR[4 * q + jj] = r4[q][jj] * eL; vB[4 * q + jj] = bb * eN; vK[4 * q + jj] = kp * eN;
                X[t * 65 + ch] = xa; BHC[ch * 72 + t] = (bf16_t)f2bf(bb * eD); KHC[ch * 72 + t] = (bf16_t)f2bf(kp * eD); VC[ch * 72 + t] = (bf16_t)f2bf(v4[q][jj]); } }
        *(LAS bf16x8*)(AT + t * 72 + c0) = pack8(vA); *(LAS bf16x8*)(RT + t * 72 + c0) = pack8(vR); *(LAS bf16x8*)(BT + t * 72 + c0) = pack8(vB); *(LAS bf16x8*)(KT + t * 72 + c0) = pack8(vK);
        rho += __shfl_xor(rho, 1); rho += __shfl_xor(rho, 2); rho += __shfl_xor(rho, 4);
        if ((tid & 7) == 0) ((float*)(C.ws + WS_RHO))[row * 8 + h] = rho; }
    LBAR();
    }
    for (int rr_ = 0; rr_ < RWR5; ++rr_) {
    for (int job = wave; job < 16; job += 8) {
        const int kind = job >> 2, ti = (job >> 1) & 1, tj = job & 1;
        const LAS bf16_t* a = (kind < 2 ? AT : RT) + 32 * ti * 72; const LAS bf16_t* bm = ((kind & 1) ? KT : BT) + 32 * tj * 72;
        f32x16 acc = {};
        if (!(ti == 0 && tj == 1)) acc = mm_ll<4>(a, 72, bm, 72, lane, acc);
#pragma unroll
        for (int g = 0; g < 16; ++g) { const int i = 32 * ti + crow(g, hi), j = 32 * tj + tl; const bool keep = (kind < 2) ? (j < i) : (j <= i); const float v = keep ? acc[g] : 0.f;
            if (kind == 0) MAB[i * 68 + j] = v; else (kind == 1 ? MAK : kind == 2 ? NRB : NRK)[i * 72 + j] = (bf16_t)f2bf(v); }
    }
    LBAR();
    }
    if (wave < 4) { const int ti = wave >> 1, tv = wave & 1; f32x16 acc = {}; acc = mm_ll<4>(MAK + 32 * ti * 72, 72, VC + 32 * tv * 72, 72, lane, acc);
#pragma unroll
        for (int g = 0; g < 16; ++g) X2[(32 * ti + crow(g, hi)) * 65 + 32 * tv + tl] = acc[g]; }
    LBAR();
    for (int bk = 0; bk < 4; ++bk) {
        const int r0 = 16 * bk;
        if (wave < 2) {
            LAS float* XX = wave ? X2 : X; float x[16];
#pragma unroll
            for (int i = 0; i < 16; ++i) x[i] = XX[(r0 + i) * 65 + lane];
#pragma unroll
            for (int i = 1; i < 16; ++i) { const LAS float* mr = MAB + (r0 + i) * 68 + r0; float a_ = x[i];
#pragma unroll
                for (int q = 0; q < (i + 3) / 4; ++q) { const f32x4 m4 = *(const LAS f32x4*)(mr + 4 * q);
#pragma unroll
                    for (int e = 0; e < 4; ++e) if (4 * q + e < i) a_ += m4[e] * x[4 * q + e]; }
                x[i] = a_; }
#pragma unroll
            for (int i = 1; i < 16; ++i) XX[(r0 + i) * 65 + lane] = x[i];
        }
        LBAR();
        if (bk < 3) {
            const int mat = wave >> 2, rt = (wave >> 1) & 1, ctl = wave & 1;
            if (32 * rt + 31 >= r0 + 16) {
                LAS float* XX = mat ? X2 : X;
                F8 av8, bv8;
#pragma unroll
                for (int e = 0; e < 8; ++e) { av8[e] = MAB[(32 * rt + tl) * 68 + r0 + 8 * hi + e]; bv8[e] = XX[(r0 + 8 * hi + e) * 65 + 32 * ctl + tl]; }
                f32x16 acc;
#pragma unroll
                for (int g = 0; g < 16; ++g) acc[g] = XX[(32 * rt + crow(g, hi)) * 65 + 32 * ctl + tl];
                acc = mfma32(pack8(av8), pack8(bv8), acc);
#pragma unroll
                for (int g = 0; g < 16; ++g) { const int i = 32 * rt + crow(g, hi); if (i >= r0 + 16) XX[i * 65 + 32 * ctl + tl] = acc[g]; }
            }
            LBAR();
        }
    }
    { const int k = tid >> 3, i0 = (tid & 7) * 8; F8 v, w;
#pragma unroll
        for (int e = 0; e < 8; ++e) { v[e] = X[(i0 + e) * 65 + k]; w[e] = X2[(i0 + e) * 65 + k]; }
        *(LAS bf16x8*)(W1C + k * 72 + i0) = pack8(v); *(LAS bf16x8*)(W2C + k * 72 + i0) = pack8(w); }
    LBAR();
    for (int rr_ = 0; rr_ < RWR11; ++rr_) {
    for (int job = wave; job < 16; job += 8) {
        const int kind = job >> 2, p = (job >> 1) & 1, q = job & 1; f32x16 acc = {};
        if (kind == 0) {
            acc = mm_ll<4>(W1C + 32 * p * 72, 72, NRB + 32 * q * 72, 72, lane, acc);
            FA fa;
#pragma unroll
            for (int g = 0; g < 16; ++g) fa[g] = acc[g] + bf2f(RT[(32 * q + tl) * 72 + 32 * p + crow(g, hi)]);
            st_frag(GT, (p * 2 + q) * 2 + 0, lane, packfrag(fa, 0)); st_frag(GT, (p * 2 + q) * 2 + 1, lane, packfrag(fa, 1));
        } else if (kind == 1) {
            acc = mm_ll<4>(W2C + 32 * p * 72, 72, NRB + 32 * q * 72, 72, lane, acc); acc = mm_ll<4>(VC + 32 * p * 72, 72, NRK + 32 * q * 72, 72, lane, acc);
            st_tile_bf16(Y0T, p * 2 + q, lane, acc);
        } else if (kind == 2) {
            acc = mm_ll<4>(W1C + 32 * p * 72, 72, BHC + 32 * q * 72, 72, lane, acc);
            FA fa = toFA(acc);
            if (p == q) { const float pc = fexp(LCv[32 * q + tl]);
#pragma unroll
                for (int g = 0; g < 16; ++g) if (crow(g, hi) == tl) fa[g] += pc; }
            st_frag(PHI, (p * 2 + q) * 2 + 0, lane, packfrag(fa, 0)); st_frag(PHI, (p * 2 + q) * 2 + 1, lane, packfrag(fa, 1));
        } else {
            acc = mm_ll<4>(BHC + 32 * p * 72, 72, W2C + 32 * q * 72, 72, lane, acc); acc = mm_ll<4>(KHC + 32 * p * 72, 72, VC + 32 * q * 72, 72, lane, acc);
            st_tile_bf16(PSI, p * 2 + q, lane, acc);
        }
    }
    LBAR();
    }
}

#undef LBAR
DI void rwkv_scan_wave(Ctx& C, int id) {
    const int vt = id & 1, bh = id >> 1, lane = C.lane;
    f32x16 S[2] = {{}, {}};
    for (int chunk = 0; chunk < 64; ++chunk) {
        const size_t chid = ((size_t)bh * 64 + chunk) * 8192;
        const unsigned char* PHI = C.ws + WS_PHI + chid; const unsigned char* PSI = C.ws + WS_PSI + chid; unsigned char* S0B = C.ws + WS_S0 + chid;
        bf16x8 sh[2][2], sl[2][2];
        f32x16 N[2];
#pragma unroll
        for (int ct = 0; ct < 2; ++ct) N[ct] = toV(ld_tile_bf16(PSI, ct * 2 + vt, lane));
        asm volatile("" ::: "memory");
#pragma unroll
        for (int cp = 0; cp < 2; ++cp)
#pragma unroll
            for (int s = 0; s < 2; ++s) { sh[cp][s] = packfrag(S[cp], s); st_frag(S0B, (cp * 2 + vt) * 2 + s, lane, sh[cp][s]);
                const u32x4 hw = __builtin_bit_cast(u32x4, sh[cp][s]); u32x4 lw;
#pragma unroll
                for (int q = 0; q < 4; ++q) lw[q] = pk2(S[cp][8 * s + 2 * q] - bflo(hw[q]), S[cp][8 * s + 2 * q + 1] - bfhi(hw[q]));
                sl[cp][s] = __builtin_bit_cast(bf16x8, lw); }
#pragma unroll
        for (int ct = 0; ct < 2; ++ct) {
#pragma unroll
            for (int cp = 0; cp < 2; ++cp)
#pragma unroll
                for (int s = 0; s < 2; ++s) { const bf16x8 ph = ld_frag(PHI, (cp * 2 + ct) * 2 + s, lane); N[ct] = mfma32(ph, sh[cp][s], N[ct]); N[ct] = mfma32(ph, sl[cp][s], N[ct]); } }
        S[0] = N[0]; S[1] = N[1];
    }
}

DI void rwkv_out_wave(Ctx& C, int id, int l) {
    const int chunk = id & 63, bh = id >> 6, b = bh >> 3, h = bh & 7, lane = C.lane, tl = lane & 31, hi = lane >> 5;
    const size_t chid = (size_t)id * 8192; const size_t tok0 = (size_t)b * SEQ + chunk * 64;
    const unsigned char* GT = C.ws + WS_GT + chid; const unsigned char* Y0T = C.ws + WS_Y0T + chid; const unsigned char* GGT = C.ws + WS_GGT + chid; const unsigned char* S0B = C.ws + WS_S0 + chid;
    const bf16_t* proj = (const bf16_t*)(C.ws + WS_PROJ);
    const float* mu = C.in(6) + (size_t)l * 1792; const float* gng = C.in(15) + l * 512 + 64 * h; const float* gnb = C.in(16) + l * 512 + 64 * h;
    const float* RHO = (const float*)(C.ws + WS_RHO);
    LAS unsigned char* stg = C.lds + C.wave * 9216;
    FA Y[2][2];
#pragma unroll
    for (int vt = 0; vt < 2; ++vt)
#pragma unroll
        for (int tt = 0; tt < 2; ++tt) { f32x16 acc = toV(ld_tile_bf16(Y0T, vt * 2 + tt, lane));
#pragma unroll
            for (int cp = 0; cp < 2; ++cp)
#pragma unroll
                for (int s = 0; s < 2; ++s) acc = mfma32(ld_frag(S0B, (cp * 2 + vt) * 2 + s, lane), ld_frag(GT, (cp * 2 + tt) * 2 + s, lane), acc);
            Y[vt][tt] = toFA(acc); }
#pragma unroll
    for (int tt = 0; tt < 2; ++tt) {
        float s1 = 0.f;
#pragma unroll
        for (int vt = 0; vt < 2; ++vt)
#pragma unroll
            for (int g = 0; g < 16; ++g) s1 += Y[vt][tt][g];
        s1 += __shfl_xor(s1, 32); const float mean = s1 * (1.f / 64.f);
        float s2 = 0.f;
#pragma unroll
        for (int vt = 0; vt < 2; ++vt)
#pragma unroll
            for (int g = 0; g < 16; ++g) { const float d = Y[vt][tt][g] - mean; s2 += d * d; }
        s2 += __shfl_xor(s2, 32); const float rstd = 1.f / sqrtf(s2 * (1.f / 64.f) + GN_EPS);
        const size_t row = tok0 + 32 * tt + tl; const bool first = (chunk == 0 && tt == 0 && tl == 0);
        const float rho = RHO[row * 8 + h];
#pragma unroll
        for (int vt = 0; vt < 2; ++vt) { const FA gt = ld_tile_bf16(GGT, vt * 2 + tt, lane);
#pragma unroll
            for (int i = 0; i < 4; ++i) { const int c = 32 * vt + 8 * i + 4 * hi;
                const f32x4 v4 = shift4(proj, row, first, PC_BV + 64 * h + c, mu + 1024 + 64 * h + c); const f32x4 gg = *(const f32x4*)(gng + c), gb = *(const f32x4*)(gnb + c);
                float o[4];
#pragma unroll
                for (int jj = 0; jj < 4; ++jj) { const int g = 4 * i + jj; o[jj] = ((Y[vt][tt][g] - mean) * rstd * gg[jj] + gb[jj] + rho * v4[jj]) * gt[g]; }
                u32x2 w; w.x = pk2(o[0], o[1]); w.y = pk2(o[2], o[3]); *(LAS u32x2*)(stg + (32 * tt + tl) * 144 + c * 2) = w; } }
    }
    asm volatile("s_waitcnt lgkmcnt(0)" ::: "memory");
#pragma unroll
    for (int k = 0; k < 8; ++k) { const int t = (lane >> 3) + 8 * k, cch = lane & 7; const u32x4 w = *(const LAS u32x4*)(stg + t * 144 + cch * 16);
        *(u32x4*)(C.mixcat + (tok0 + t) * D + 512 + 64 * h + cch * 8) = w; }
    asm volatile("s_waitcnt lgkmcnt(0)" ::: "memory");
}

constexpr int GB_OFF = 163840 - 256;
DI void gbar(LAS unsigned* cnt, unsigned& target, int lane) {
    asm volatile("s_waitcnt lgkmcnt(0)" ::: "memory");
    target += 4u;
    if (lane == 0) __hip_atomic_fetch_add(cnt, 1u, __ATOMIC_RELAXED, __HIP_MEMORY_SCOPE_WORKGROUP);
    while (__hip_atomic_load(cnt, __ATOMIC_RELAXED, __HIP_MEMORY_SCOPE_WORKGROUP) < target) __builtin_amdgcn_s_sleep(1);
    asm volatile("" ::: "memory");
}
DI void rwkv_chunk_acts4(Ctx& C, int bc, int l, bf16x8 (&actv)[8]) {
    const int chunk = bc & 63, b = bc >> 6, t = C.tid >> 2, cg = C.tid & 3; const size_t row = (size_t)b * SEQ + chunk * 64 + t; const bool first = (chunk == 0 && t == 0);
    const bf16_t* proj = (const bf16_t*)(C.ws + WS_PROJ); const float* mu = C.in(6) + (size_t)l * 1792;
#pragma unroll
    for (int q = 0; q < 8; ++q) { const int c8 = cg * 64 + 8 * q;
        if (c8 < 64) actv[q] = act_frag<1>(proj, row, first, PC_WD + c8, mu + 1536 + c8); else if (c8 < 128) actv[q] = act_frag<0>(proj, row, first, PC_WD + c8, mu + 1536 + c8); else actv[q] = act_frag<2>(proj, row, first, PC_WD + c8, mu + 1536 + c8); }
}
#ifndef RW4_12
#define RW4_12 1
#endif
#ifndef RW4_4
#define RW4_4 1
#endif
#ifndef RW4_5
#define RW4_5 1
#endif
#ifndef RW4_11
#define RW4_11 1
#endif
#define GBA() gbar(gcnt, gtarget, lane)
DI void rwkv_head_item4(Ctx& C, int item, int l, const bf16x8 (&actv)[8], LAS unsigned* gcnt, unsigned& gtarget) {
    const int h = item & 7, chunk = (item >> 3) & 63, b = item >> 9, tid = C.tid, lane = C.lane, wave = C.wave, tl = lane & 31, hi = lane >> 5;
    const size_t tok0 = (size_t)b * SEQ + chunk * 64;
    const bf16_t* proj = (const bf16_t*)(C.ws + WS_PROJ);
    const size_t chid = ((size_t)(b * 8 + h) * 64 + chunk) * 8192;
    unsigned char* PHI = C.ws + WS_PHI + chid; unsigned char* PSI = C.ws + WS_PSI + chid; unsigned char* GT = C.ws + WS_GT + chid; unsigned char* Y0T = C.ws + WS_Y0T + chid; unsigned char* GGT = C.ws + WS_GGT + chid;
    const bf16_t* WDT = (const bf16_t*)(C.ws + WS_LORA); const bf16_t* WAT = WDT + 512 * 64; const bf16_t* WGT = WAT + 512 * 64;
    const float* mu = C.in(6) + (size_t)l * 1792;
    const float* w0p = C.in(7) + l * 512 + 64 * h; const float* a0p = C.in(9) + l * 512 + 64 * h;
    const float* kkp = C.in(12) + l * 512 + 64 * h; const float* kap = C.in(13) + l * 512 + 64 * h; const float* rkp = C.in(14) + l * 512 + 64 * h;
    LAS bf16_t* ACT = (LAS bf16_t*)(C.lds + RL_ACT); LAS float* MAB = (LAS float*)(C.lds + RL_MAB); LAS bf16_t* W1C = (LAS bf16_t*)(C.lds + RL_W1C); LAS bf16_t* W2C = (LAS bf16_t*)(C.lds + RL_W2C);
    LAS float* ELL = (LAS float*)(C.lds + RL_ELL); LAS float* AV = (LAS float*)(C.lds + RL_AV);
    LAS bf16_t* MAK = (LAS bf16_t*)(C.lds + RL_MAK); LAS bf16_t* NRB = (LAS bf16_t*)(C.lds + RL_NRB); LAS bf16_t* NRK = (LAS bf16_t*)(C.lds + RL_NRK);
    LAS bf16_t* AT = (LAS bf16_t*)(C.lds + RL_AT); LAS bf16_t* RT = (LAS bf16_t*)(C.lds + RL_RT); LAS bf16_t* BT = (LAS bf16_t*)(C.lds + RL_BT); LAS bf16_t* KT = (LAS bf16_t*)(C.lds + RL_KT);
    LAS bf16_t* BHC = (LAS bf16_t*)(C.lds + RL_BHC); LAS bf16_t* KHC = (LAS bf16_t*)(C.lds + RL_KHC); LAS bf16_t* VC = (LAS bf16_t*)(C.lds + RL_VC);
    LAS float* X = (LAS float*)(C.lds + RL_X); LAS float* X2 = (LAS float*)(C.lds + RL_X2); LAS float* LCv = (LAS float*)(C.lds + RL_SM) + 64;
    GBA();
    for (int r_RW4_12 = 0; r_RW4_12 < RW4_12; ++r_RW4_12) { asm volatile("" ::: "memory");
    const int jp = (wave >> 1) & 1, jq = wave & 1;
    bf16x8 wg[8], wd[8];
    { const bf16_t* W = WGT + (size_t)(64 * h + 32 * jp + tl) * 128 + 8 * hi; const bf16_t* W0 = WDT + (size_t)(64 * h + 32 * jq + tl) * 64 + 8 * hi; const bf16_t* W1 = WAT + (size_t)(64 * h + 32 * jq + tl) * 64 + 8 * hi;
#pragma unroll
        for (int s = 0; s < 8; ++s) wg[s] = *(const bf16x8*)(W + 16 * s);
#pragma unroll
        for (int s = 0; s < 4; ++s) { wd[s] = *(const bf16x8*)(W0 + 16 * s); wd[4 + s] = *(const bf16x8*)(W1 + 16 * s); } }
    { const int t = tid >> 2, cg = tid & 3;
#pragma unroll
        for (int q = 0; q < 8; ++q) *(LAS bf16x8*)(ACT + t * 264 + cg * 64 + 8 * q) = actv[q]; }
    GBA();
    {
        const LAS bf16_t* bp = ACT + (32 * jq + tl) * 264 + 128 + 8 * hi; f32x16 acc = {};
#pragma unroll
        for (int s = 0; s < 8; ++s) acc = mfma32(wg[s], *(const LAS bf16x8*)(bp + 16 * s), acc);
        st_tile_bf16(GGT, jp * 2 + jq, lane, acc);
        const LAS bf16_t* ap = ACT + (32 * jp + tl) * 264 + 8 * hi; f32x16 a0 = {}, a1 = {};
#pragma unroll
        for (int s = 0; s < 4; ++s) { a0 = mfma32(*(const LAS bf16x8*)(ap + 16 * s), wd[s], a0); a1 = mfma32(*(const LAS bf16x8*)(ap + 64 + 16 * s), wd[4 + s], a1); }
        const int ch = 32 * jq + tl; const float w0c = w0p[ch], a0c = a0p[ch];
#pragma unroll
        for (int g = 0; g < 16; ++g) { const int t = 32 * jp + crow(g, hi); ELL[t * 65 + ch] = -fexp(-fsoftplus(-(w0c + a0[g])) - 0.5f); AV[t * 65 + ch] = fsigm(a0c + a1[g]); }
    }
    GBA();
    }
    { const int ch = tid & 63, seg = tid >> 6; float p[16]; float run = 0.f;
#pragma unroll
        for (int e = 0; e < 16; ++e) { run += ELL[(16 * seg + e) * 65 + ch]; p[e] = run; }
        X[seg * 65 + ch] = run;
        GBA();
        float off = 0.f;
#pragma unroll
        for (int s2 = 0; s2 < 3; ++s2) off += (s2 < seg) ? X[s2 * 65 + ch] : 0.f;
#pragma unroll
        for (int e = 0; e < 16; ++e) ELL[(16 * seg + e) * 65 + ch] = off + p[e];
        if (seg == 3) LCv[ch] = off + p[15]; }
    GBA();
    for (int r_RW4_4 = 0; r_RW4_4 < RW4_4; ++r_RW4_4) { asm volatile("" ::: "memory");
#pragma unroll 1
    for (int pass = 0; pass < 2; ++pass) { const int e_ = tid + 256 * pass; const int t = e_ >> 3, c0 = (e_ & 7) * 8; const size_t row = tok0 + t; const bool first = (chunk == 0 && t == 0); float rho = 0.f, n2 = 0.f;
        f32x4 r4[2], k4[2], v4[2];
#pragma unroll
        for (int q = 0; q < 2; ++q) { const int c = c0 + 4 * q;
            r4[q] = shift4(proj, row, first, PC_R + 64 * h + c, mu + 64 * h + c); k4[q] = shift4(proj, row, first, PC_BK + 64 * h + c, mu + 512 + 64 * h + c); v4[q] = shift4(proj, row, first, PC_BV + 64 * h + c, mu + 1024 + 64 * h + c);
            const f32x4 kr = k4[q] * *(const f32x4*)(kkp + c); n2 += (kr.x * kr.x + kr.y * kr.y) + (kr.z * kr.z + kr.w * kr.w); }
        n2 += __shfl_xor(n2, 1); n2 += __shfl_xor(n2, 2); n2 += __shfl_xor(n2, 4);
        const float inv = 1.f / fmaxf(sqrtf(n2), 1e-12f);
        F8 vA, vR, vB, vK;
#pragma unroll
        for (int q = 0; q < 2; ++q) { const int c = c0 + 4 * q;
            const f32x4 kk4 = *(const f32x4*)(kkp + c), ka4 = *(const f32x4*)(kap + c), rk4 = *(const f32x4*)(rkp + c);
#pragma unroll
            for (int jj = 0; jj < 4; ++jj) { const int ch = c + jj; const float a = AV[t * 65 + ch], L = ELL[t * 65 + ch], Lp = t ? ELL[(t - 1) * 65 + ch] : 0.f, LC = LCv[ch];
                const float kk = k4[q][jj] * kk4[jj] * inv, kp = k4[q][jj] * (1.f + (a - 1.f) * ka4[jj]), bb = kk * a;
                const float eL = fexp(L), eN = fexp(-L), eP = fexp(Lp), eD = fexp(LC - L);
                rho += r4[q][jj] * kp * rk4[jj];
                const float xa = -kk * eP; vA[4 * q + jj] = xa; vR[4 * q + jj] = r4[q][jj] * eL; vB[4 * q + jj] = bb * eN; vK[4 * q + jj] = kp * eN;
                X[t * 65 + ch] = xa; BHC[ch * 72 + t] = (bf16_t)f2bf(bb * eD); KHC[ch * 72 + t] = (bf16_t)f2bf(kp * eD); VC[ch * 72 + t] = (bf16_t)f2bf(v4[q][jj]); } }
        *(LAS bf16x8*)(AT + t * 72 + c0) = pack8(vA); *(LAS bf16x8*)(RT + t * 72 + c0) = pack8(vR); *(LAS bf16x8*)(BT + t * 72 + c0) = pack8(vB); *(LAS bf16x8*)(KT + t * 72 + c0) = pack8(vK);
        rho += __shfl_xor(rho, 1); rho += __shfl_xor(rho, 2); rho += __shfl_xor(rho, 4);
        if ((tid & 7) == 0) ((float*)(C.ws + WS_RHO))[row * 8 + h] = rho; }
    GBA();
    }
    for (int r_RW4_5 = 0; r_RW4_5 < RW4_5; ++r_RW4_5) { asm volatile("" ::: "memory");
    for (int job = wave; job < 16; job += 4) {
        const int kind = job >> 2, ti = (job >> 1) & 1, tj = job & 1;
        const LAS bf16_t* a = (kind < 2 ? AT : RT) + 32 * ti * 72; const LAS bf16_t* bm = ((kind & 1) ? KT : BT) + 32 * tj * 72;
        f32x16 acc = {};
        if (!(ti == 0 && tj == 1)) acc = mm_ll<4>(a, 72, bm, 72, lane, acc);
#pragma unroll
        for (int g = 0; g < 16; ++g) { const int i = 32 * ti + crow(g, hi), j = 32 * tj + tl; const bool keep = (kind < 2) ? (j < i) : (j <= i); const float v = keep ? acc[g] : 0.f;
            if (kind == 0) MAB[i * 68 + j] = v; else (kind == 1 ? MAK : kind == 2 ? NRB : NRK)[i * 72 + j] = (bf16_t)f2bf(v); }
    }
    GBA();
    }
    { const int ti = wave >> 1, tv = wave & 1; f32x16 acc = {}; acc = mm_ll<4>(MAK + 32 * ti * 72, 72, VC + 32 * tv * 72, 72, lane, acc);
#pragma unroll
        for (int g = 0; g < 16; ++g) X2[(32 * ti + crow(g, hi)) * 65 + 32 * tv + tl] = acc[g]; }
    GBA();
    for (int bk = 0; bk < 4; ++bk) {
        const int r0 = 16 * bk;
        if (wave < 2) {
            LAS float* XX = wave ? X2 : X; float x[16];
#pragma unroll
            for (int i = 0; i < 16; ++i) x[i] = XX[(r0 + i) * 65 + lane];
#pragma unroll
            for (int i = 1; i < 16; ++i) { const LAS float* mr = MAB + (r0 + i) * 68 + r0; float a_ = x[i];
#pragma unroll
                for (int q = 0; q < (i + 3) / 4; ++q) { const f32x4 m4 = *(const LAS f32x4*)(mr + 4 * q);
#pragma unroll
                    for (int e = 0; e < 4; ++e) if (4 * q + e < i) a_ += m4[e] * x[4 * q + e]; }
                x[i] = a_; }
#pragma unroll
            for (int i = 1; i < 16; ++i) XX[(r0 + i) * 65 + lane] = x[i];
        }
        GBA();
        if (bk < 3) {
            for (int tq = wave; tq < 8; tq += 4) { const int mat = tq >> 2, rt = (tq >> 1) & 1, ctl = tq & 1;
                if (32 * rt + 31 >= r0 + 16) {
                    LAS float* XX = mat ? X2 : X;
                    F8 av8, bv8;
#pragma unroll
                    for (int e = 0; e < 8; ++e) { av8[e] = MAB[(32 * rt + tl) * 68 + r0 + 8 * hi + e]; bv8[e] = XX[(r0 + 8 * hi + e) * 65 + 32 * ctl + tl]; }
                    f32x16 acc;
#pragma unroll
                    for (int g = 0; g < 16; ++g) acc[g] = XX[(32 * rt + crow(g, hi)) * 65 + 32 * ctl + tl];
                    acc = mfma32(pack8(av8), pack8(bv8), acc);
#pragma unroll
                    for (int g = 0; g < 16; ++g) { const int i = 32 * rt + crow(g, hi); if (i >= r0 + 16) XX[i * 65 + 32 * ctl + tl] = acc[g]; }
                } }
            GBA();
        }
    }
#pragma unroll 1
    for (int pass = 0; pass < 2; ++pass) { const int e_ = tid + 256 * pass; const int k = e_ >> 3, i0 = (e_ & 7) * 8; F8 v, w;
#pragma unroll
        for (int e = 0; e < 8; ++e) { v[e] = X[(i0 + e) * 65 + k]; w[e] = X2[(i0 + e) * 65 + k]; }
        *(LAS bf16x8*)(W1C + k * 72 + i0) = pack8(v); *(LAS bf16x8*)(W2C + k * 72 + i0) = pack8(w); }
    GBA();
    for (int r_11 = 0; r_11 < RW4_11; ++r_11) { asm volatile("" ::: "memory");
    for (int job = wave; job < 16; job += 4) {
        const int kind = job >> 2, p = (job >> 1) & 1, q = job & 1; f32x16 acc = {};
        if (kind == 0) {
            acc = mm_ll<4>(W1C + 32 * p * 72, 72, NRB + 32 * q * 72, 72, lane, acc);
            FA fa;
#pragma unroll
            for (int g = 0; g < 16; ++g) fa[g] = acc[g] + bf2f(RT[(32 * q + tl) * 72 + 32 * p + crow(g, hi)]);
            st_frag(GT, (p * 2 + q) * 2 + 0, lane, packfrag(fa, 0)); st_frag(GT, (p * 2 + q) * 2 + 1, lane, packfrag(fa, 1));
        } else if (kind == 1) {
            acc = mm_ll<4>(W2C + 32 * p * 72, 72, NRB + 32 * q * 72, 72, lane, acc); acc = mm_ll<4>(VC + 32 * p * 72, 72, NRK + 32 * q * 72, 72, lane, acc);
            st_tile_bf16(Y0T, p * 2 + q, lane, acc);
        } else if (kind == 2) {
            acc = mm_ll<4>(W1C + 32 * p * 72, 72, BHC + 32 * q * 72, 72, lane, acc);
            FA fa = toFA(acc);
            if (p == q) { const float pc = fexp(LCv[32 * q + tl]);
#pragma unroll
                for (int g = 0; g < 16; ++g) if (crow(g, hi) == tl) fa[g] += pc; }
            st_frag(PHI, (p * 2 + q) * 2 + 0, lane, packfrag(fa, 0)); st_frag(PHI, (p * 2 + q) * 2 + 1, lane, packfrag(fa, 1));
        } else {
            acc = mm_ll<4>(BHC + 32 * p * 72, 72, W2C + 32 * q * 72, 72, lane, acc); acc = mm_ll<4>(KHC + 32 * p * 72, 72, VC + 32 * q * 72, 72, lane, acc);
            st_tile_bf16(PSI, p * 2 + q, lane, acc);
        }
    }
    }
}
#undef GBA

typedef float f32x2 __attribute__((ext_vector_type(2)));
constexpr int IX4 = RL_END, IX4_CAP = 256;
#ifndef IX_PF
#define IX_PF 2
#endif
#ifndef IXR_SEL
#define IXR_SEL 1
#endif
#define GBB() gbar(gcnt, gtarget, lane)
DI void ld_ktile(const _Float16* kbase, int kt, int ktmax, f16x8 (&d)[4]) {
    const _Float16* p = kbase + (size_t)(32 * min(kt, ktmax)) * PLD;
#pragma unroll
    for (int s = 0; s < 4; ++s) d[s] = *(const f16x8*)(p + 16 * s);
}
DI void idx_item4(Ctx& C, int item, int l, const int ixb, LAS unsigned* gcnt, unsigned& gtarget) {
    const int b = item & 3, qt = 1023 - (item >> 2);
    const int t0 = qt * 4, chunk = t0 >> 6, NT32 = 2 * (chunk + 1);
    const size_t tok0 = (size_t)b * SEQ + t0;
    unsigned* bm = (unsigned*)(C.ws + WS_BM);
    int lane = C.lane, wave = C.wave & 3, tid = C.tid & 255;
    asm volatile("" : "+v"(lane), "+v"(tid), "+s"(wave));
    if (chunk < 4) {
        if (tid < 4 * NT32) { const int q = tid / NT32, kt = tid % NT32; bm[(tok0 + q) * 128 + kt] = 0xffffffffu; }
        return;
    }
    const _Float16* ph = (const _Float16*)(C.ws + WS_PROJ);
    LAS unsigned* hist = (LAS unsigned*)(C.lds + ixb);
    LAS float* cand = (LAS float*)(C.lds + ixb + 4096);
    LAS float* redmn = (LAS float*)(C.lds + ixb + 4096 + 8 * IX4_CAP * 4);
    LAS float* redmx = redmn + 16;
    LAS unsigned* ccount = (LAS unsigned*)(redmx + 16);
    LAS float* thrS = (LAS float*)(ccount + 4);
    LAS int* thrI = (LAS int*)(thrS + 4);
    LAS unsigned* ovf = (LAS unsigned*)(thrI + 4);
    LAS unsigned* fbT = ovf + 4;
    LAS unsigned* fbCnt = fbT + 4;
    LAS unsigned* fbNeed = fbCnt + 4;
    const int r = lane & 31, hh = lane >> 5;
    float sc[32][2];
    {
        f16x8 afr[4]; float wq[2][8];
        {
            const int gq = (r >> 2) & 1, i = r >> 3, jj = r & 3, query = 2 * gq + (i >> 1), head = 4 * (i & 1) + jj;
            const _Float16* qp = ph + (tok0 + query) * PLD + PC_QI + head * 64 + 8 * hh;
#pragma unroll
            for (int s = 0; s < 4; ++s) afr[s] = *(const f16x8*)(qp + 16 * s);
#pragma unroll
            for (int qq = 0; qq < 2; ++qq) { const int q2 = 2 * hh + qq; const f16x8 wv = *(const f16x8*)(ph + (tok0 + q2) * PLD + PC_WI);
#pragma unroll
                for (int e = 0; e < 8; ++e) wq[qq][e] = (float)wv[e] * 0.044194173824159216f; }
        }
        const _Float16* kbase = ph + ((size_t)b * SEQ + r) * PLD + PC_KI + 8 * hh;
        f16x8 bq[IX_PF][4];
#pragma unroll
        for (int d = 0; d < IX_PF - 1; ++d) ld_ktile(kbase, wave + 4 * d, NT32 - 1, bq[d]);
#pragma unroll
        for (int it = 0; it < 32; ++it) {
            const int kt = wave + 4 * it;
            if (kt < NT32) {
                if (kt + 4 * (IX_PF - 1) < NT32) ld_ktile(kbase, kt + 4 * (IX_PF - 1), NT32 - 1, bq[(it + IX_PF - 1) % IX_PF]);
                f32x16 c = {};
#pragma unroll
                for (int s = 0; s < 4; ++s) c = __builtin_amdgcn_mfma_f32_32x32x16_f16(afr[s], bq[it % IX_PF][s], c, 0, 0, 0);
#pragma unroll
                for (int qq = 0; qq < 2; ++qq) { float a = 0.f;
#pragma unroll
                    for (int e = 0; e < 8; ++e) a += wq[qq][e] * fmaxf(c[8 * qq + e], 0.f);
                    sc[it][qq] = a; }
            } else { sc[it][0] = -3.0e38f; sc[it][1] = -3.0e38f; }
        }
    }
    for (int rl_ = 0; rl_ < IXR_SEL; ++rl_) { asm volatile("" ::: "memory");
    float mn[2], mx[2];
#pragma unroll
    for (int qq = 0; qq < 2; ++qq) { float me = -3.0e38f, mo = -3.0e38f;
#pragma unroll
        for (int it = 0; it < 32; it += 2) { me = fmaxf(me, sc[it][qq]); mo = fmaxf(mo, sc[it + 1][qq]); }
        float a = fminf(me, mo), z = fmaxf(me, mo);
#pragma unroll
        for (int o = 1; o < 32; o <<= 1) { a = fminf(a, __shfl_xor(a, o)); z = fmaxf(z, __shfl_xor(z, o)); }
        mn[qq] = a; mx[qq] = z; }
    if (r == 0) {
#pragma unroll
        for (int qq = 0; qq < 2; ++qq) { const int qid = 2 * hh + qq; redmn[wave * 4 + qid] = mn[qq]; redmx[wave * 4 + qid] = mx[qq]; }
    }
    { u32x4 z4 = {0u, 0u, 0u, 0u}; *(LAS u32x4*)(hist + 4 * tid) = z4; }
    if (tid < 4) { ccount[tid] = 0u; ovf[tid] = 0u; }
    GBB();
    unsigned pk[2][8];
#pragma unroll
    for (int qq = 0; qq < 2; ++qq) { const int qid = 2 * hh + qq; float a = 3.0e38f, z = -3.0e38f;
#pragma unroll
        for (int w = 0; w < 4; ++w) { a = fminf(a, redmn[w * 4 + qid]); z = fmaxf(z, redmx[w * 4 + qid]); }
        const float scl = (z > a) ? fminf(253.f / (z - a), 1.0e30f) : 1.f; const float nlo = 1.5f - a * scl;
#pragma unroll
        for (int g8 = 0; g8 < 8; ++g8) { unsigned p = 0u;
            if (wave + 16 * g8 < NT32) {
#pragma unroll
                for (int e = 0; e < 4; ++e) p = __builtin_amdgcn_cvt_pk_u8_f32(__builtin_amdgcn_fmed3f(__builtin_fmaf(sc[4 * g8 + e][qq], scl, nlo), 0.f, 255.f), e, p);
#pragma unroll
                for (int e = 0; e < 4; ++e) { const unsigned pb = (p >> (8 * e)) & 255u; if (pb) __hip_atomic_fetch_add(hist + qid * 256 + pb, 1u, __ATOMIC_RELAXED, __HIP_MEMORY_SCOPE_WORKGROUP); }
            }
            pk[qq][g8] = p; } }
    GBB();
    int B[2]; unsigned above[2];
#pragma unroll
    for (int qq = 0; qq < 2; ++qq) { const int qid = 2 * hh + qq;
        const u32x4 h0 = *(const LAS u32x4*)(hist + qid * 256 + 8 * r), h1 = *(const LAS u32x4*)(hist + qid * 256 + 8 * r + 4);
        const unsigned tot = (h0.x + h0.y) + (h0.z + h0.w) + (h1.x + h1.y) + (h1.z + h1.w); unsigned incl = tot;
#pragma unroll
        for (int o = 1; o < 32; o <<= 1) { const unsigned v = __shfl_down(incl, o, 32); if (r + o < 32) incl += v; }
        unsigned run = incl - tot; int Bf = -1; unsigned ab = 0; const unsigned hv8[8] = {h0.x, h0.y, h0.z, h0.w, h1.x, h1.y, h1.z, h1.w};
#pragma unroll
        for (int j = 7; j >= 0; --j) { const unsigned hv = hv8[j]; if (run < 256u && run + hv >= 256u) { Bf = 8 * r + j; ab = run; } run += hv; }
        const unsigned long long mk = __ballot(Bf >= 0);
        const unsigned mh = hh ? (unsigned)(mk >> 32) : (unsigned)mk;
        const int src = 32 * hh + (mh ? __builtin_ctz(mh) : 0);
        B[qq] = __shfl(Bf, src); above[qq] = (unsigned)__shfl((int)ab, src); }
#define IX_PB(it, qq) ((int)((pk[qq][(it) >> 2] >> (8 * ((it) & 3))) & 255u))
#define IX_LAUNDER() do { _Pragma("unroll") for (int it_ = 0; it_ < 32; ++it_) { asm volatile("" : "+v"(sc[it_][0]), "+v"(sc[it_][1])); } asm volatile("" : "+v"(B[0]), "+v"(B[1])); } while (0)
#pragma unroll
    for (int qq = 0; qq < 2; ++qq) { const int qid = 2 * hh + qq;
#pragma unroll
        for (int g8 = 0; g8 < 8; ++g8) if (wave + 16 * g8 < NT32) {
#pragma unroll
            for (int e = 0; e < 4; ++e) { const int it = 4 * g8 + e; const bool hit = (IX_PB(it, qq) == B[qq]);
                if (__any(hit)) { if (hit) { const unsigned pos = __hip_atomic_fetch_add(ccount + qid, 1u, __ATOMIC_RELAXED, __HIP_MEMORY_SCOPE_WORKGROUP);
                    if (pos < (unsigned)IX4_CAP) { f32x2 cv; cv.x = sc[it][qq]; cv.y = __builtin_bit_cast(float, 32 * (wave + 4 * it) + r); *(LAS f32x2*)(cand + (qid * IX4_CAP + pos) * 2) = cv; } } } } } }
    GBB();
    {
        const int c = (int)ccount[wave];
        const unsigned abq = (wave & 1) ? above[1] : above[0];
        const int need = 256 - (int)__shfl((int)abq, 32 * (wave >> 1));
        if (c <= IX4_CAP) {
            LAS float* cw = cand + wave * IX4_CAP * 2;
            if ((c & 1) && lane == 0) { f32x2 cv; cv.x = -3.0e38f; cv.y = __builtin_bit_cast(float, 0x7fffffff); *(LAS f32x2*)(cw + 2 * c) = cv; }
            asm volatile("" ::: "memory");
            for (int i = lane; i < c; i += 64) { const f32x2 ci = *(const LAS f32x2*)(cw + 2 * i); const float si = ci.x; const int ii = __float_as_int(ci.y); int rank = 0;
                for (int j = 0; j < c; j += 2) { const f32x4 cj = *(const LAS f32x4*)(cw + 2 * j);
                    rank += ((cj.x > si) || (cj.x == si && __float_as_int(cj.y) < ii)) ? 1 : 0; rank += ((cj.z > si) || (cj.z == si && __float_as_int(cj.w) < ii)) ? 1 : 0; }
                if (rank == need - 1) { thrS[wave] = si; thrI[wave] = ii; } }
        } else if (lane == 0) { ovf[wave] = 1u; fbNeed[wave] = (unsigned)need; fbT[wave] = 0u; }
    }
    GBB();
    unsigned anyovf = 0u;
#pragma unroll
    for (int q = 0; q < 4; ++q) anyovf |= ovf[q];
#ifndef IX_NOFB
#define IX_NOFB 0
#endif
    if (anyovf && !IX_NOFB) {
        for (int bit = 31; bit >= 0; --bit) {
            if (tid < 4) fbCnt[tid] = 0u;
            GBB();
            IX_LAUNDER();
#pragma unroll
            for (int qq = 0; qq < 2; ++qq) { const int qid = 2 * hh + qq; if (ovf[qid]) { const unsigned cd = fbT[qid] | (1u << bit); unsigned cnt = 0;
#pragma unroll
                for (int it = 0; it < 32; ++it) cnt += (IX_PB(it, qq) == B[qq] && ordkey(sc[it][qq]) >= cd) ? 1u : 0u;
                if (cnt) __hip_atomic_fetch_add(fbCnt + qid, cnt, __ATOMIC_RELAXED, __HIP_MEMORY_SCOPE_WORKGROUP); } }
            GBB();
            if (tid < 4 && ovf[tid] && fbCnt[tid] >= fbNeed[tid]) fbT[tid] |= (1u << bit);
            GBB();
        }
        if (tid < 4) fbCnt[tid] = 0u;
        GBB();
        IX_LAUNDER();
#pragma unroll
        for (int qq = 0; qq < 2; ++qq) { const int qid = 2 * hh + qq; if (ovf[qid]) { const unsigned Tk = fbT[qid]; unsigned cnt = 0;
#pragma unroll
            for (int it = 0; it < 32; ++it) cnt += (IX_PB(it, qq) == B[qq] && ordkey(sc[it][qq]) > Tk) ? 1u : 0u;
            if (cnt) __hip_atomic_fetch_add(fbCnt + qid, cnt, __ATOMIC_RELAXED, __HIP_MEMORY_SCOPE_WORKGROUP); } }
        GBB();
        if (tid < 4 && ovf[tid]) { fbNeed[tid] -= fbCnt[tid]; thrS[tid] = unordkey(fbT[tid]); thrI[tid] = 0; }
        GBB();
        for (int bit = 11; bit >= 0; --bit) {
            if (tid < 4) fbCnt[tid] = 0u;
            GBB();
            IX_LAUNDER();
#pragma unroll
            for (int qq = 0; qq < 2; ++qq) { const int qid = 2 * hh + qq; if (ovf[qid]) { const unsigned Tk = fbT[qid]; const int cd = thrI[qid] | (1 << bit); unsigned cnt = 0;
#pragma unroll
                for (int it = 0; it < 32; ++it) cnt += (IX_PB(it, qq) == B[qq] && ordkey(sc[it][qq]) == Tk && (32 * (wave + 4 * it) + r) < cd) ? 1u : 0u;
                if (cnt) __hip_atomic_fetch_add(fbCnt + qid, cnt, __ATOMIC_RELAXED, __HIP_MEMORY_SCOPE_WORKGROUP); } }
            GBB();
            if (tid < 4 && ovf[tid] && fbCnt[tid] < fbNeed[tid]) thrI[tid] |= (1 << bit);
            GBB();
        }
    }
#pragma unroll
    for (int qq = 0; qq < 2; ++qq) { const int qid = 2 * hh + qq; const float ts = thrS[qid]; const int ti = thrI[qid] - 32 * wave - r;
        unsigned myw = 0u;
#pragma unroll
        for (int g8 = 0; g8 < 8; ++g8) if (wave + 16 * g8 < NT32) {
#pragma unroll
            for (int e = 0; e < 4; ++e) { const int it = 4 * g8 + e; const float s = sc[it][qq];
                const bool sel = (s > ts) | ((s == ts) & (128 * it <= ti));
                const unsigned long long mk = __builtin_amdgcn_ballot_w64(sel);
                const unsigned wv = hh ? (unsigned)(mk >> 32) : (unsigned)mk;
                if (r == it) myw = wv; } }
        if (wave + 4 * r < NT32) bm[(tok0 + qid) * 128 + wave + 4 * r] = myw; }
    }
#undef IX_PB
#undef IX_LAUNDER
}
#undef GBB

constexpr int NCV_GU = 4096, NCV_DN = 2048, NCV_PG = 512, NCV_PL = 128, NCV = NCV_GU + NCV_DN + NCV_PG + NCV_PL;
DI void conv_flat_item(Ctx& C, int l, int w, LAS float* scr) {
    if (w < NCV_GU) { ColGateUp c{C.in(20) + (size_t)l * NEXP * D * DEXP, C.in(21) + (size_t)l * NEXP * D * DEXP}; transpose_item(c, DEXP, D, (bf16_t*)(C.ws + WS_WEXP), 32 * (w & 255), 64 * (w >> 8), scr, C.lane); return; }
    w -= NCV_GU;
    if (w < NCV_DN) { const int e = w >> 7, r = w & 127; ColDown c{C.in(22) + ((size_t)l * NEXP + e) * DEXP * D}; transpose_item(c, D, DEXP, (bf16_t*)(C.ws + WS_WDOWN) + (size_t)e * D * DEXP, 32 * (r & 31), 64 * (r >> 5), scr, C.lane); return; }
    w -= NCV_DN;
    if (w < NCV_PG) { ColPlain c{C.in(24) + (size_t)l * D * D}; transpose_item(c, D, D, (bf16_t*)(C.ws + WS_WPG), 32 * (w & 31), 64 * (w >> 5), scr, C.lane); return; }
    w -= NCV_PG;
    { ColPlain c{C.in(23) + (size_t)l * PLE * D}; transpose_item(c, D, PLE, (bf16_t*)(C.ws + WS_WPLE), 32 * (w & 31), 64 * (w >> 5), scr, C.lane); }
}
DI void phase_ln_router(Ctx& C, int l) {
    const bf16_t* V = (const bf16_t*)(C.ws + WS_V);
    const float* g = C.in(25) + (size_t)l * D; const float* bta = C.in(26) + (size_t)l * D;
    const float* wr = C.in(18); const float* br = C.in(19);
    LAS unsigned* lcnt = (LAS unsigned*)C.lds; LAS unsigned* base = lcnt + 16; LAS int* rec = (LAS int*)(C.lds + 128);
    TokInfo* tok = (TokInfo*)(C.ws + WS_TOK); RowInfo* rowi = (RowInfo*)(C.ws + WS_ROW);
    unsigned* gcnt = C.ctl + CW_GCNT + 64 * l;
    for (int i = C.blk * NTHR + C.tid; i < MAXROWS; i += C.G * NTHR) { RowInfo ri; ri.token = -1; ri.slot = 0; ri.gate = 0.f; ri.pad = 0; rowi[i] = ri; }
    LAS float* wT = (LAS float*)(C.lds + 4096);
    __syncthreads();
    for (int i = C.tid; i < D * 16; i += NTHR) { const int d = i >> 4, e = i & 15; wT[e * D + d] = wr[i]; }
    const int cgw = C.blk * NWAVES + C.wave, cNGW = C.G * NWAVES; LAS float* cscr = (LAS float*)(C.lds + 70656 + C.wave * 8448);
    for (int rb = C.blk; rb < T / 64; rb += C.G) {
        __syncthreads();
        if (C.tid < 16) lcnt[C.tid] = 0u;
        __syncthreads();
#pragma unroll 1
        for (int i4 = 0; i4 < 8; i4 += 2) {
          const int cw_ = cgw + (i4 >> 1) * cNGW; const bool cdo_ = (rb == C.blk) && cw_ < NCV;
          if (cdo_ && C.wave >= 4) conv_flat_item(C, l, cw_, cscr);
          f32x4 vv[8]; float lgg[32];
          { u32x2 raw[8];
#pragma unroll
            for (int r = 0; r < 2; ++r)
#pragma unroll
                for (int j = 0; j < 4; ++j) raw[4 * r + j] = *(const u32x2*)(V + ((size_t)rb * 64 + C.wave * 8 + i4 + r) * D + 256 * j + 4 * C.lane);
#pragma unroll
            for (int r = 0; r < 2; ++r) { f32x4 t[4];
#pragma unroll
                for (int j = 0; j < 4; ++j) { const u32x2 o = raw[4 * r + j]; t[j] = (f32x4){bflo(o.x), bfhi(o.x), bflo(o.y), bfhi(o.y)}; }
                ln16(t, g, bta, C.lane);
                store_row_bf16(C.xcur + ((size_t)rb * 64 + C.wave * 8 + i4 + r) * D, t, C.lane);
#pragma unroll
                for (int j = 0; j < 4; ++j) vv[4 * r + j] = t[j]; } }
#pragma unroll
          for (int k = 0; k < 32; ++k) lgg[k] = 0.f;
#pragma unroll
          for (int e = 0; e < 16; ++e)
#pragma unroll
              for (int j = 0; j < 4; ++j) { const f32x4 w4 = *(const LAS f32x4*)(wT + e * D + 256 * j + 4 * C.lane);
#pragma unroll
                  for (int r = 0; r < 2; ++r) { const f32x4 x = vv[4 * r + j]; lgg[16 * r + e] += (x.x * w4.x + x.y * w4.y) + (x.z * w4.z + x.w * w4.w); } }
#pragma unroll
          for (int k = 0; k < 32; ++k) lgg[k] = wave_sum(lgg[k]);
#pragma unroll
          for (int r = 0; r < 2; ++r) {
            const int lr = C.wave * 8 + i4 + r;
            float sc[16], sl[16];
#pragma unroll
            for (int e = 0; e < 16; ++e) { const float t = lgg[16 * r + e]; sc[e] = 1.f / (1.f + expf(-t)); sl[e] = sc[e] + br[e]; }
            int best = 0; float bestv = -3.0e38f;
#pragma unroll
            for (int gq = 0; gq < 4; ++gq) { const float a = sl[4 * gq], b2 = sl[4 * gq + 1], c2 = sl[4 * gq + 2], d2 = sl[4 * gq + 3];
                const float mx1 = fmaxf(fmaxf(a, b2), fmaxf(c2, d2)); const float tot = a + b2 + c2 + d2; const float mn1 = fminf(fminf(a, b2), fminf(c2, d2));
                const float lo1 = fminf(a, b2), hi1 = fmaxf(a, b2), lo2 = fminf(c2, d2), hi2 = fmaxf(c2, d2);
                const float second = fmaxf(fminf(hi1, hi2), fmaxf(lo1, lo2));
                (void)tot; (void)mn1;
                const float gs = mx1 + second; if (gs > bestv) { bestv = gs; best = gq; } }
            int i0 = 0, i1 = 0; float v0 = -3.0e38f, v1 = -3.0e38f, s0 = 0.f, s1 = 0.f;
#pragma unroll
            for (int gq = 0; gq < 4; ++gq) if (gq == best) {
#pragma unroll
                for (int k = 0; k < 4; ++k) { const float x = sl[4 * gq + k]; if (x > v0) { v1 = v0; i1 = i0; s1 = s0; v0 = x; i0 = 4 * gq + k; s0 = sc[4 * gq + k]; } else if (x > v1) { v1 = x; i1 = 4 * gq + k; s1 = sc[4 * gq + k]; } } }
            const float den = s0 + s1; const float g0 = s0 / den, g1 = s1 / den;
            if (C.lane == 0) {
                const unsigned r0 = __hip_atomic_fetch_add(lcnt + i0, 1u, __ATOMIC_RELAXED, __HIP_MEMORY_SCOPE_WORKGROUP);
                const unsigned r1 = __hip_atomic_fetch_add(lcnt + i1, 1u, __ATOMIC_RELAXED, __HIP_MEMORY_SCOPE_WORKGROUP);
                rec[lr * 8 + 0] = i0; rec[lr * 8 + 1] = i1; rec[lr * 8 + 2] = (int)r0; rec[lr * 8 + 3] = (int)r1;
                rec[lr * 8 + 4] = __builtin_bit_cast(int, g0); rec[lr * 8 + 5] = __builtin_bit_cast(int, g1); }
          }
          if (cdo_ && C.wave < 4) conv_flat_item(C, l, cw_, cscr);
        }
        __syncthreads();
        if (C.tid < 16) base[C.tid] = __hip_atomic_fetch_add(gcnt + C.tid, lcnt[C.tid], __ATOMIC_RELAXED, __HIP_MEMORY_SCOPE_AGENT);
        __syncthreads();
        if (C.tid < 64) { TokInfo ti; ti.e0 = rec[C.tid * 8]; ti.e1 = rec[C.tid * 8 + 1]; ti.p0 = rec[C.tid * 8 + 2] + (int)base[ti.e0]; ti.p1 = rec[C.tid * 8 + 3] + (int)base[ti.e1];
            ti.g0 = __builtin_bit_cast(float, rec[C.tid * 8 + 4]); ti.g1 = __builtin_bit_cast(float, rec[C.tid * 8 + 5]); ti.pad0 = 0; ti.pad1 = 0; tok[(size_t)rb * 64 + C.tid] = ti; }
    }
    for (int w = cgw + 4 * cNGW; w < NCV; w += cNGW) conv_flat_item(C, l, w, cscr);
}
DI int build_tile_table(Ctx& C, int l, LAS int* toff, LAS int* texp) {
    const unsigned* gcnt = C.ctl + CW_GCNT + 64 * l;
    __syncthreads();
    if (C.tid < 64) {
        int c = 0; if (C.lane < 16) c = (int)__hip_atomic_load(gcnt + C.lane, __ATOMIC_RELAXED, __HIP_MEMORY_SCOPE_AGENT);
        const int nt = (c + 255) >> 8; int incl = nt;
#pragma unroll
        for (int o = 1; o < 16; o <<= 1) { const int v = __shfl_up(incl, o); if (C.lane >= o) incl += v; }
        const int start = incl - nt;
        if (C.lane < 16) { toff[C.lane] = start << 8; for (int t = 0; t < nt; ++t) texp[start + t] = C.lane; }
        if (C.lane == 15) toff[16] = incl << 8; }
    __syncthreads();
    return toff[16] >> 8;
}
DI void phase_gather(Ctx& C, int l) {
    LAS int* toff = (LAS int*)(C.lds + 1024); LAS int* texp = (LAS int*)(C.lds + 2048);
    (void)build_tile_table(C, l, toff, texp);
    const TokInfo* tok = (const TokInfo*)(C.ws + WS_TOK); RowInfo* rowi = (RowInfo*)(C.ws + WS_ROW); bf16_t* AG = (bf16_t*)(C.ws + WS_AG);
    for (int m = C.blk * NTHR + C.tid; m < T; m += C.G * NTHR) {
        const TokInfo ti = tok[m];
        const int r0 = toff[ti.e0] + ti.p0, r1 = toff[ti.e1] + ti.p1;
        { RowInfo x; x.token = m; x.slot = 0; x.gate = ti.g0; x.pad = 0; rowi[r0] = x; x.slot = 1; x.gate = ti.g1; rowi[r1] = x; }
    }
}
DI void phase_ln_ffn(Ctx& C, int l) {
    const bf16_t* Y = (const bf16_t*)(C.ws + WS_Y);
    const float* g = C.in(27) + (size_t)l * D; const float* bta = C.in(28) + (size_t)l * D;
    const int gw = C.blk * NWAVES + C.wave, NGW = C.G * NWAVES;
    for (int m = gw; m < T; m += NGW) {
        f32x4 x[4], y0[4], y1[4];
        load_row_bf16(C.xcur + (size_t)m * D, x, C.lane); load_row_bf16(Y + (size_t)m * D, y0, C.lane); load_row_bf16(Y + ((size_t)T + m) * D, y1, C.lane);
#pragma unroll
        for (int j = 0; j < 4; ++j) x[j] = x[j] * ALPHA + (y0[j] + y1[j]);
        ln16(x, g, bta, C.lane);
        store_row_bf16(C.xcur + (size_t)m * D, x, C.lane);
    }
}
DI void phase_ln_ple(Ctx& C, int l, bool last) {
    const bf16_t* V = (const bf16_t*)(C.ws + WS_V3);
    const float* g = C.in(29) + (size_t)l * D; const float* bta = C.in(30) + (size_t)l * D;
    const int gw = C.blk * NWAVES + C.wave, NGW = C.G * NWAVES;
    for (int m = gw; m < T; m += NGW) {
        f32x4 v[4];
        load_row_bf16(V + (size_t)m * D, v, C.lane);
        ln16(v, g, bta, C.lane);
        if (last) {
#ifdef PROBE_PHASE
            { const unsigned long long* pt = (const unsigned long long*)(C.ws + WS_CTL + 32768); const float sc = 1.f + (float)(pt[1] - pt[0]) * (float)(PROBE_SCALE);
#pragma unroll
              for (int j = 0; j < 4; ++j) v[j] = v[j] * sc; }
#endif
#pragma unroll
            for (int j = 0; j < 4; ++j) *(f32x4*)(C.out + (size_t)m * D + 256 * j + 4 * C.lane) = v[j];
        } else store_row_bf16(C.xcur + (size_t)m * D, v, C.lane);
    }
}

constexpr int LDS_BYTES = 163840;
constexpr int PH_PER_LAYER = 13, NPHASE = 1 + DEPTH * PH_PER_LAYER;

constexpr int CW_AQ = 2048;
DI void convert_mixer_weights(Ctx& C, int l) {
    int first = 0;
    { ColPlain c{C.in(5) + (size_t)l * D * D}; convert_matrix(C, c, D, D, D, (bf16_t*)(C.ws + WS_WOUT), first); }
    { ColPlain c{C.in(8) + (size_t)l * 64 * 512}; convert_matrix(C, c, 512, 64, 512, (bf16_t*)(C.ws + WS_LORA), first); }
    { ColPlain c{C.in(10) + (size_t)l * 64 * 512}; convert_matrix(C, c, 512, 64, 512, (bf16_t*)(C.ws + WS_LORA) + 512 * 64, first); }
    { ColPlain c{C.in(11) + (size_t)l * 128 * 512}; convert_matrix(C, c, 512, 128, 512, (bf16_t*)(C.ws + WS_LORA) + 2 * 512 * 64, first); }
}
DI void convert_ffn_weights(Ctx& C, int l) {
    const float* p = C.in(1) + (size_t)l * T * PLE; bf16_t* pb = (bf16_t*)(C.ws + WS_PBF);
    const size_t pstr = (size_t)C.G * NTHR * 8;
    for (size_t i0 = ((size_t)C.blk * NTHR + C.tid) * 8; i0 < (size_t)T * PLE; i0 += 4 * pstr) {
        f32x4 a[4], b[4];
#pragma unroll
        for (int k = 0; k < 4; ++k) { const size_t i = i0 + k * pstr; if (i < (size_t)T * PLE) { a[k] = *(const f32x4*)(p + i); b[k] = *(const f32x4*)(p + i + 4); } }
#pragma unroll
        for (int k = 0; k < 4; ++k) { const size_t i = i0 + k * pstr; if (i < (size_t)T * PLE) { u32x4 o; o.x = pk2(a[k].x, a[k].y); o.y = pk2(a[k].z, a[k].w); o.z = pk2(b[k].x, b[k].y); o.w = pk2(b[k].z, b[k].w); *(u32x4*)(pb + i) = o; } } }
}
#ifndef RWREP
#define RWREP 1
#endif
#ifndef IQREP
#define IQREP 1
#endif
#ifndef REP_SUB
#define REP_SUB 0
#endif
#ifndef REP_SP
#define REP_SP -1
#define REP_N 1
#endif
template <int SP> DI void run_sp_(Ctx& C, const int l, const int rep);
template <int SP> DI void run_sp(Ctx& C, const int l) { run_sp_<SP>(C, l, 0); }
template <int SP> DI void run_sp_(Ctx& C, const int l, const int rep) {
    if constexpr (SP == 0) {
        pg8::Gemm g{C.xcur, (const bf16_t*)(C.ws + WS_WEXP), T, NPROJ_PAD, opaque_i(D)}; pg8::StaticOrder S; S.init(T, NPROJ_PAD, C.G, C.blk);
        EpiProj E{(bf16_t*)(C.ws + WS_PROJ)};
        pg8::gemm_phase<EpiProj, pg8::StaticOrder, true, true>(C.lds, g, S, E);
    } else if constexpr (SP == 1) {
    } else if constexpr (SP == 2) {
        LAS unsigned* gb = (LAS unsigned*)(C.lds + GB_OFF);
        if (C.tid < 8) gb[C.tid] = 0u;
        __syncthreads();
        const int half = C.wave >> 2, ltid = C.tid & 255;
        LAS unsigned* gcnt = gb + half; unsigned gtarget = 0u;
        LAS int* slot = (LAS int*)(gb + 2 + 2 * half);
        unsigned* iq = C.ctl + CW_AQ + 32 + 64 * l + 256 * rep;
        int nxt = 0, par = 0;
        if (half == 0) {
            for (int rw_ = 0; rw_ < RWREP; ++rw_)
            for (int bc = C.blk; bc < 256; bc += C.G) { bf16x8 actv[8]; rwkv_chunk_acts4(C, bc, l, actv); for (int h = 0; h < 8; ++h) rwkv_head_item4(C, bc * 8 + h, l, actv, gcnt, gtarget); }
        }
        const int ixb = half ? IX4 : 0;
        if (ltid == 0) nxt = (int)__hip_atomic_fetch_add(iq, 1u, __ATOMIC_RELAXED, __HIP_MEMORY_SCOPE_AGENT);
        for (;;) {
            if (ltid == 0) slot[par] = nxt;
            gbar(gcnt, gtarget, C.lane);
            const int u = __builtin_amdgcn_readfirstlane(slot[par]); par ^= 1;
            if (u >= 4096) break;
            if (ltid == 0) nxt = (int)__hip_atomic_fetch_add(iq, 1u, __ATOMIC_RELAXED, __HIP_MEMORY_SCOPE_AGENT);
            idx_item4(C, u, l, ixb, gcnt, gtarget);
        }
    } else if constexpr (SP == 3) {
        if (C.blk < 8 && (rep == 0 || REP_SUB != 2)) rwkv_scan_wave(C, C.blk * 8 + C.wave);
        LAS int* qs = (LAS int*)(C.lds + LDS_BYTES - 128);
        if (rep == 0 || REP_SUB != 1)
        for (;;) {
            __syncthreads();
            if (C.tid == 0) qs[0] = (int)__hip_atomic_fetch_add(C.ctl + CW_AQ + 64 * l + 256 * rep, 1u, __ATOMIC_RELAXED, __HIP_MEMORY_SCOPE_AGENT);
            __syncthreads();
            const int u = __builtin_amdgcn_readfirstlane(qs[0]);
            if (u >= 512) break;
            const int qb = 15 - (u >> 5), bh = u & 31; attn_unit(C, bh >> 3, bh & 7, qb);
        }
    } else if constexpr (SP == 4) {
        const int gw = C.blk * NWAVES + C.wave, NGW = C.G * NWAVES;
        for (int id = gw; id < 2048; id += NGW) rwkv_out_wave(C, id, l);
    } else if constexpr (SP == 5) {
        pg8::Gemm g{C.mixcat, (const bf16_t*)(C.ws + WS_WOUT), T, D, opaque_i(D)}; pg8::StaticOrder S; S.init(T, D, C.G, C.blk);
        EpiResF32 E{C.xcur, (bf16_t*)(C.ws + WS_V)};
        pg8::gemm_phase<EpiResF32, pg8::StaticOrder, true, true>(C.lds, g, S, E);
    } else if constexpr (SP == 6) { phase_ln_router(C, l); convert_ffn_weights(C, l);
    } else if constexpr (SP == 7) { phase_gather(C, l);
    } else if constexpr (SP == 8) {
        LAS int* toff = (LAS int*)(C.lds + 135168); LAS int* texp = (LAS int*)(C.lds + 136192);
        const int nt = build_tile_table(C, l, toff, texp);
        pg8::Gemm g{C.xcur, (const bf16_t*)(C.ws + WS_WEXP), MAXROWS, NEXP * 512, opaque_i(D)};
        GroupedOrder<2> S{texp, nt, C.G, C.blk};
        EpiSwiGLU E{(bf16_t*)(C.ws + WS_H), (const RowInfo*)(C.ws + WS_ROW)};
        pg8::gemm_phase_gather<EpiSwiGLU, GroupedOrder<2>, true>(C.lds, g, S, E, (const int*)(C.ws + WS_ROW));
        {
            const int extra = (2 * nt > C.G) ? (2 * nt - C.G) : 0; const int nb = C.G - extra;
            if (C.blk >= extra && nb > 0) { pg8::Gemm g2{(const bf16_t*)(C.ws + WS_PBF), (const bf16_t*)(C.ws + WS_WPLE), T, D, opaque_i(PLE)}; pg8::StaticOrder S2; S2.init(T, D, nb, C.blk - extra);
                EpiBf16Plain E2{(bf16_t*)(C.ws + WS_PE), D};
                pg8::gemm_phase<EpiBf16Plain, pg8::StaticOrder, true, true>(C.lds, g2, S2, E2); } }
    } else if constexpr (SP == 9) {
        LAS int* toff = (LAS int*)(C.lds + 135168); LAS int* texp = (LAS int*)(C.lds + 136192);
        const int nt = build_tile_table(C, l, toff, texp);
        { pg8::Gemm g{(const bf16_t*)(C.ws + WS_H), (const bf16_t*)(C.ws + WS_WDOWN), MAXROWS, NEXP * D, opaque_i(DEXP)};
          GroupedOrder<4> S{texp, nt, C.G, C.blk};
          EpiDown E{(bf16_t*)(C.ws + WS_Y), (const RowInfo*)(C.ws + WS_ROW)};
          pg8::gemm_phase<EpiDown, GroupedOrder<4>, true, true>(C.lds, g, S, E); }
    } else if constexpr (SP == 10) { phase_ln_ffn(C, l);
    } else if constexpr (SP == 11) {
        pg8::Gemm g{C.xcur, (const bf16_t*)(C.ws + WS_WPG), T, D, opaque_i(D)}; pg8::StaticOrder S; S.init(T, D, C.G, C.blk);
        EpiPle E{C.xcur, (const bf16_t*)(C.ws + WS_PE), (bf16_t*)(C.ws + WS_V3)};
        pg8::gemm_phase<EpiPle, pg8::StaticOrder, true, true>(C.lds, g, S, E);
    } else { phase_ln_ple(C, l, l == DEPTH - 1); if (l + 1 < DEPTH) { convert_win(C, l + 1); convert_mixer_weights(C, l + 1); } }
}
#define XB_TMO      128
#define XB_XCNT(j)  (256  + 64 * (j))
#define XB_XSUB(j)  (1280 + 64 * (j))
#define XB_XGEN(j)  (2304 + 64 * (j))
#define XB_TOP      3328
#define XB_TOPGEN   3392
#define XCD_BAR_WORDS 3456
#define XB_SPIN_CAP (1u << 18)

__device__ __forceinline__ unsigned xb_ld(unsigned* p)              { return __hip_atomic_load(p, __ATOMIC_RELAXED, __HIP_MEMORY_SCOPE_AGENT); }
__device__ __forceinline__ unsigned xb_add(unsigned* p, unsigned v) { return __hip_atomic_fetch_add(p, v, __ATOMIC_RELAXED, __HIP_MEMORY_SCOPE_AGENT); }
__device__ __forceinline__ unsigned xb_xcc_id() { return (unsigned)__builtin_amdgcn_s_getreg((3 << 11) | 20) & 0xFu; }
#define XB_SPIN(cond, bar) do { unsigned _sp = 0; while (cond) { __builtin_amdgcn_s_sleep(1); \
    if ((++_sp & 255u) == 0u) { if (xb_ld(&(bar)[XB_TMO])) break; if (_sp > XB_SPIN_CAP) { atomicAdd(&(bar)[XB_TMO], 1u); break; } } } } while (0)

struct XcdBarrier {
    unsigned* bar; unsigned x;
    volatile __attribute__((address_space(3))) unsigned* st;
};

__device__ __forceinline__ XcdBarrier xcd_barrier_post(unsigned* bar, volatile __attribute__((address_space(3))) unsigned* st) {
    XcdBarrier b; b.bar = bar; b.x = xb_xcc_id(); b.st = st;
    if (threadIdx.x == 0) (void)xb_add(&bar[XB_XCNT(b.x)], 1u);
    return b;
}
__device__ __forceinline__ void xcd_barrier_complete(unsigned* bar, unsigned x, unsigned& nloc, unsigned& nx) {
    const unsigned G = gridDim.x * gridDim.y * gridDim.z;
    unsigned sum, cnt, mine, sp = 0u;
    for (;;) {
        sum = 0u; cnt = 0u; mine = 0u;
#pragma unroll
        for (unsigned j = 0; j < 16; ++j) { const unsigned c = xb_ld(&bar[XB_XCNT(j)]); sum += c; cnt += (c > 0u) ? 1u : 0u; mine = (j == x) ? c : mine; }
        if (sum == G) break;
        __builtin_amdgcn_s_sleep(1);
        if ((++sp & 255u) == 0u) { if (xb_ld(&bar[XB_TMO])) break; if (sp > XB_SPIN_CAP) { atomicAdd(&bar[XB_TMO], 1u); break; } }
    }
    nloc = mine > 0u ? mine : 1u; nx = cnt > 0u ? cnt : 1u;
}

__device__ __forceinline__ void xcd_barrier(const XcdBarrier& b) {
    asm volatile("s_waitcnt vmcnt(0)" ::: "memory");
    __syncthreads();
    if (threadIdx.x == 0) {
        unsigned* bar = b.bar;
        __builtin_amdgcn_s_waitcnt(0);
        unsigned nloc = b.st[0], nx = b.st[1];
        if (nloc == 0u) { xcd_barrier_complete(bar, b.x, nloc, nx); b.st[0] = nloc; b.st[1] = nx; }
        const unsigned old = xb_add(&bar[XB_XSUB(b.x)], 1u);
        const unsigned gen = old / nloc;
        if (old + 1u == (gen + 1u) * nloc) {
            __builtin_amdgcn_fence(__ATOMIC_RELEASE, "agent");
            asm volatile("s_waitcnt vmcnt(0)" ::: "memory");
            const unsigned og = xb_add(&bar[XB_TOP], 1u);
            const unsigned tg = og / nx;
            if (og + 1u == (tg + 1u) * nx) xb_add(&bar[XB_TOPGEN], 1u);
            else XB_SPIN(xb_ld(&bar[XB_TOPGEN]) == tg, bar);
            __builtin_amdgcn_fence(__ATOMIC_ACQUIRE, "agent");
            xb_add(&bar[XB_XGEN(b.x)], 1u);
            asm volatile("s_waitcnt vmcnt(0)" ::: "memory");
        } else {
            XB_SPIN(xb_ld(&bar[XB_XGEN(b.x)]) == gen, bar);
            __builtin_amdgcn_fence(__ATOMIC_ACQUIRE, "agent");
            asm volatile("s_waitcnt vmcnt(0)" ::: "memory");
        }
    }
    __syncthreads();
}

constexpr int CW_XBAR = 65536;
typedef const __attribute__((address_space(4))) Args* KArgP;
DI void ctx_setup(Ctx& C) {
    int t_ = threadIdx.x; asm volatile("" : "+v"(t_)); C.tid = t_; C.lane = t_ & 63; C.wave = __builtin_amdgcn_readfirstlane(t_ >> 6);
    int b_ = blockIdx.x, g_ = gridDim.x; asm volatile("" : "+s"(b_), "+s"(g_)); C.blk = b_; C.G = g_;
    KArgP ap = (KArgP)__builtin_amdgcn_kernarg_segment_ptr(); asm volatile("" : "+s"(ap));
    C.ap = ap; C.out = ap->out; C.ws = ap->ws; C.ctl = (unsigned*)(ap->ws + WS_CTL); C.xcur = (bf16_t*)ap->out; C.mixcat = (bf16_t*)ap->out + (size_t)T * D;
}
__global__ void __launch_bounds__(NTHR, 2) mega_fwd(Args args) {
    extern __shared__ __attribute__((aligned(16))) unsigned char lds_raw[];
    Ctx C;
    C.lds = (LAS unsigned char*)lds_raw;
    cg::grid_group grid = cg::this_grid();
    volatile LAS unsigned* xbst = (volatile LAS unsigned*)(C.lds + LDS_BYTES - 32);
    if (threadIdx.x < 4) xbst[threadIdx.x] = 0u;
    __syncthreads();
    XcdBarrier xbar = xcd_barrier_post((unsigned*)(((KArgP)__builtin_amdgcn_kernarg_segment_ptr())->ws + WS_CTL) + CW_XBAR, xbst);
    const int lo = ((KArgP)__builtin_amdgcn_kernarg_segment_ptr())->ph_lo, hi = ((KArgP)__builtin_amdgcn_kernarg_segment_ptr())->ph_hi;
#ifdef PROBE_PHASE
#define PROBE_HOOK(k) do { if (blockIdx.x == 0 && threadIdx.x == 0) { unsigned long long* pt = (unsigned long long*)(C.ws + WS_CTL + 32768); if ((k) == PROBE_PHASE) pt[0] = __builtin_amdgcn_s_memrealtime(); if ((k) == PROBE_PHASE_END) pt[1] = __builtin_amdgcn_s_memrealtime(); } } while (0)
#else
#define PROBE_HOOK(k) do { } while (0)
#endif
#define GRID_BAR(k) do { if ((k) == lo + 1) grid.sync(); else xcd_barrier(xbar); } while (0)
#define PHASE(k, body) do { if (lo <= (k) && (k) < hi) { if ((k) > lo) GRID_BAR(k); ctx_setup(C); PROBE_HOOK(k); body; } } while (0)
    PHASE(0, { phase_ln_in(C); convert_win(C, 0); convert_mixer_weights(C, 0); });
#define LAYER(l) PHASE(1 + 13 * (l) + 0, run_sp<0>(C, l)); PHASE(1 + 13 * (l) + 2, run_sp<2>(C, l)); PHASE(1 + 13 * (l) + 3, run_sp<3>(C, l)); \
    PHASE(1 + 13 * (l) + 4, run_sp<4>(C, l)); PHASE(1 + 13 * (l) + 5, run_sp<5>(C, l)); PHASE(1 + 13 * (l) + 6, run_sp<6>(C, l)); PHASE(1 + 13 * (l) + 7, run_sp<7>(C, l)); \
    PHASE(1 + 13 * (l) + 8, run_sp<8>(C, l)); PHASE(1 + 13 * (l) + 9, run_sp<9>(C, l)); PHASE(1 + 13 * (l) + 10, run_sp<10>(C, l)); PHASE(1 + 13 * (l) + 11, run_sp<11>(C, l)); \
    PHASE(1 + 13 * (l) + 12, run_sp<12>(C, l))
#define PH0(sp) PHASE(1 + (sp), run_sp<sp>(C, 0)); if (REP_SP == (sp)) { if (REP_N > 1) { xcd_barrier(xbar); ctx_setup(C); run_sp_<sp>(C, 0, 1); } if (REP_N > 2) { xcd_barrier(xbar); ctx_setup(C); run_sp_<sp>(C, 0, 2); } }
    PH0(0); PH0(2); PH0(3); PH0(4); PH0(5); PH0(6); PH0(7); PH0(8); PH0(9); PH0(10); PH0(11); PH0(12);
#undef PH0
    LAYER(1);
#undef LAYER
#undef PHASE
}

#ifndef N_LAUNCH_MODE
#define N_LAUNCH_MODE 1
#endif
extern "C" void kernel_launch(void* const* d_in, const int* in_sizes, int n_in, void* d_out, int out_size, void* d_ws, size_t ws_size, hipStream_t stream) {
    static int grid = 0;
    if (grid == 0) {
        if (n_in != 31 || out_size != T * D) { fprintf(stderr, "kernel_launch: unexpected problem (n_in %d out %d)\n", n_in, out_size); grid = -1; return; }
        int dev = 0, cus = 0, per_cu = 0;
        hipGetDevice(&dev); hipDeviceGetAttribute(&cus, hipDeviceAttributeMultiprocessorCount, dev);
        if (hipFuncSetAttribute((const void*)mega_fwd, hipFuncAttributeMaxDynamicSharedMemorySize, LDS_BYTES) != hipSuccess) { fprintf(stderr, "kernel_launch: hipFuncSetAttribute failed\n"); grid = -1; return; }
        if (hipOccupancyMaxActiveBlocksPerMultiprocessor(&per_cu, (const void*)mega_fwd, NTHR, LDS_BYTES) != hipSuccess || per_cu < 1) { fprintf(stderr, "kernel_launch: occupancy query says %d\n", per_cu); per_cu = 1; }
        (void)hipGetLastError();
        grid = cus * 1;
        fprintf(stderr, "kernel_launch: grid %d (occupancy %d per CU)\n", grid, per_cu);
    }
    if (grid < 0) return;
    hipMemsetAsync((char*)d_ws + WS_CTL, 0, CTL_BYTES, stream);
    Args a{};
    for (int i = 0; i < 31; ++i) a.in[i] = (const float*)d_in[i];
    a.out = (float*)d_out; a.ws = (unsigned char*)d_ws;
#if N_LAUNCH_MODE == 0
    for (int ph = 0; ph < NPHASE; ++ph) { a.ph_lo = ph; a.ph_hi = ph + 1; hipLaunchKernelGGL(mega_fwd, dim3(grid), dim3(NTHR), LDS_BYTES, stream, a); }
#else
    a.ph_lo = 0; a.ph_hi = NPHASE;
    void* kargs[] = {&a};
    hipError_t e = hipLaunchCooperativeKernel((const void*)mega_fwd, dim3(grid), dim3(NTHR), kargs, LDS_BYTES, stream);
    if (e != hipSuccess) fprintf(stderr, "cooperative launch failed: %s (grid %d)\n", hipGetErrorString(e), grid);
#endif
}
```

```cpp
#include <hip/hip_runtime.h>
#include <hip/hip_cooperative_groups.h>
#include <cstdio>
#include <cstdint>
namespace cg = cooperative_groups;
namespace pg8 {
#define PG8_LAS __attribute__((address_space(3)))
typedef unsigned short bf16_t;
typedef short bf16x8 __attribute__((ext_vector_type(8)));
typedef float f32x4 __attribute__((ext_vector_type(4)));
typedef unsigned u32x4 __attribute__((ext_vector_type(4)));
constexpr int BM = 256, BK = 64, HALF = 128, HTB = HALF * BK * 2  , STAGE_BYTES = 8 * HTB, NXCD = 8, WGM = 8;

__host__ __device__ __forceinline__ int lds_byte(int r, int c) { const int st = (r >> 4) * 2 + (c >> 5), rr = r & 15, cc = c & 31, ob = rr * 64 + cc * 2; return st * 1024 + (ob ^ (((ob >> 9) & 1) << 5)); }
__host__ __device__ __forceinline__ void stage_rc(int b, int& R, int& C) { const int st = b / 1024, sb = b % 1024, swz = sb ^ (((sb >> 9) & 1) << 5); R = (st >> 1) * 16 + swz / 64; C = (st & 1) * 32 + (swz % 64) / 2; }
__host__ __device__ __forceinline__ int perm32(int rho) { const int n = rho >> 4, i = rho & 15; return 8 * (i >> 2) + 4 * n + (i & 3); }

struct Unit { int pm, pn; };
struct Gemm { const bf16_t* A; const bf16_t* Bt; int M, N, K; };

struct StaticOrder {
    int nM, nN, nwg, G, c;
    __host__ __device__ void init(int M, int N, int G_, int c_) { nM = M / BM; nN = N / BM; nwg = nM * nN; G = G_; c = c_; }
    __host__ __device__ bool next(int i, Unit& u) const {
        const long L = (long)i * G + c; if (L >= nwg) return false;
        int wgid = (int)L; { const int q = nwg / NXCD, r = nwg % NXCD, xcd = wgid % NXCD, off = wgid / NXCD; wgid = (xcd < r ? xcd * (q + 1) : r * (q + 1) + (xcd - r) * q) + off; }
        const int nig = WGM * nN, gid = wgid / nig, fm = gid * WGM, gsz = (nM - fm) < WGM ? (nM - fm) : WGM;
        u.pm = fm + ((wgid % nig) % gsz); u.pn = (wgid % nig) / gsz; return true;
    }
    __device__ __forceinline__ void a_ready(const Unit&) const {}
    __device__ __forceinline__ void done(const Unit&) const {}
};

__device__ __forceinline__ unsigned cvt_pk_bf16(float lo, float hi) { typedef float f2_t __attribute__((ext_vector_type(2))); typedef __bf16 b2_t __attribute__((ext_vector_type(2))); f2_t v = {lo, hi}; b2_t b = __builtin_convertvector(v, b2_t); return __builtin_bit_cast(unsigned, b); }
template <class Epi, class Sched, bool ALIGN_EPI = false, bool SP2 = false>
__device__ __forceinline__ void gemm_phase(PG8_LAS unsigned char* lds, const Gemm g, const Sched& S, const Epi& E) {
    int tid_ = threadIdx.x; asm volatile("" : "+v"(tid_));
    const int tid = tid_, wid = __builtin_amdgcn_readfirstlane(tid >> 6), lane = tid & 63, wr = wid >> 2, wc = wid & 3, fr = lane & 15, fq = lane >> 4;
    const int K = g.K, nt = K / BK;
    unsigned voffA[2], voffB[2];
#pragma unroll
    for (int i = 0; i < 2; ++i) { int R, C; stage_rc(tid * 16 + i * 8192, R, C); const int Rb = Epi::PERM ? ((R & ~31) + perm32(R & 31)) : R;
        voffA[i] = (unsigned)(R * K + C) * 2u; voffB[i] = (unsigned)(Rb * K + C) * 2u; }
    const size_t kstep = (size_t)(BK * 2);
    const size_t hstep = (size_t)HALF * K * 2;
    const size_t tstep = 2 * hstep;
    const unsigned ldsw = (unsigned)wid * 1024u;
    const int aoff = lds_byte(wr * 64 + fr, fq * 8), boff = lds_byte(wc * 32 + fr, fq * 8);
#define PG8_SA(b, h) (((b) * 2 + (h)) * HTB)
#define PG8_SB(b, h) ((4 + (b) * 2 + (h)) * HTB)
#define PG8_STAGE(bufoff, gbase, voff) do { _Pragma("unroll") for (int _i = 0; _i < 2; ++_i) \
        __builtin_amdgcn_global_load_lds((const unsigned*)((const char*)(gbase) + (voff)[_i]), (PG8_LAS unsigned*)(lds + (bufoff) + ldsw + _i * 8192), 16, 0, 0); } while (0)
#define PG8_LDA(dst, b, h) do { _Pragma("unroll") for (int m = 0; m < 4; ++m) _Pragma("unroll") for (int k = 0; k < 2; ++k) dst[m][k] = *(const PG8_LAS bf16x8*)(lds + PG8_SA(b, h) + aoff + m * 2048 + k * 1024); } while (0)
#define PG8_LDB(dst, b, h) do { _Pragma("unroll") for (int n = 0; n < 2; ++n) _Pragma("unroll") for (int k = 0; k < 2; ++k) dst[n][k] = *(const PG8_LAS bf16x8*)(lds + PG8_SB(b, h) + boff + n * 2048 + k * 1024); } while (0)
#define PG8_MMA(ai, bj, At, Bt) do { __builtin_amdgcn_s_setprio(1); _Pragma("unroll") for (int m = 0; m < 4; ++m) _Pragma("unroll") for (int n = 0; n < 2; ++n) _Pragma("unroll") for (int k = 0; k < 2; ++k) \
        acc[ai][bj][m][n] = __builtin_amdgcn_mfma_f32_16x16x32_bf16(Bt[n][k], At[m][k], acc[ai][bj][m][n], 0, 0, 0); __builtin_amdgcn_s_setprio(0); } while (0)
#define PG8_WAIT_V(n) asm volatile("s_waitcnt vmcnt(" #n ")" ::: "memory")
#define PG8_WAIT_L(n) asm volatile("s_waitcnt lgkmcnt(" #n ")" ::: "memory")
#define PG8_BAR __builtin_amdgcn_s_barrier()
#define PG8_SCHED __builtin_amdgcn_sched_barrier(0)
    Unit cur, nxt; int ui = 0;
    if (!S.next(0, cur)) return;
    f32x4 acc[2][2][4][2];
#pragma unroll
    for (int a = 0; a < 2; ++a)
#pragma unroll
        for (int b = 0; b < 2; ++b)
#pragma unroll
            for (int m = 0; m < 4; ++m)
#pragma unroll
                for (int n = 0; n < 2; ++n) acc[a][b][m][n] = (f32x4){0.f, 0.f, 0.f, 0.f};
    bf16x8 At[4][2], B0[2][2], B1[2][2];
    const char* cA = (const char*)g.A + (size_t)cur.pm * tstep; const char* cB = (const char*)g.Bt + (size_t)cur.pn * tstep;
    S.a_ready(cur);
    if constexpr (SP2) {
        PG8_STAGE(PG8_SB(0, 0), cB, voffB); PG8_STAGE(PG8_SB(0, 1), cB + hstep, voffB); PG8_STAGE(PG8_SA(0, 0), cA, voffA); PG8_STAGE(PG8_SA(0, 1), cA + hstep, voffA);
        if (wr == 1) PG8_BAR;
        PG8_WAIT_V(2); PG8_BAR;
        PG8_STAGE(PG8_SB(1, 0), cB + kstep, voffB); PG8_STAGE(PG8_SA(1, 0), cA + kstep, voffA); PG8_STAGE(PG8_SB(1, 1), cB + hstep + kstep, voffB);
        PG8_WAIT_V(6); PG8_BAR;
    } else {
        PG8_STAGE(PG8_SB(0, 0), cB, voffB); PG8_STAGE(PG8_SA(0, 0), cA, voffA); PG8_STAGE(PG8_SB(0, 1), cB + hstep, voffB); PG8_STAGE(PG8_SA(0, 1), cA + hstep, voffA);
        if (wr == 1) PG8_BAR;
        PG8_WAIT_V(4); PG8_BAR;
        PG8_STAGE(PG8_SB(1, 0), cB + kstep, voffB); PG8_STAGE(PG8_SA(1, 0), cA + kstep, voffA); PG8_STAGE(PG8_SB(1, 1), cB + hstep + kstep, voffB);
        PG8_WAIT_V(6); PG8_BAR;
    }
    for (;;) {
        const bool has_next = S.next(ui + 1, nxt);
        const char* nA = has_next ? (const char*)g.A + (size_t)nxt.pm * tstep : cA; const char* nB = has_next ? (const char*)g.Bt + (size_t)nxt.pn * tstep : cB;
        for (int t = 0; t < nt; t += 2) {
            const bool last = (t == nt - 2);
            const char* a1 = cA + (size_t)(t + 1) * kstep;
            const char* a2 = last ? nA : cA + (size_t)(t + 2) * kstep; const char* b2 = last ? nB : cB + (size_t)(t + 2) * kstep;
            const char* a3 = a2 + kstep; const char* b3 = b2 + kstep;
            if (last && has_next) S.a_ready(nxt);
            if constexpr (SP2) {
            PG8_LDB(B0, 0, 0); PG8_LDB(B1, 0, 1); PG8_SCHED; PG8_LDA(At, 0, 0); PG8_STAGE(PG8_SA(1, 1), a1 + hstep, voffA);
            PG8_WAIT_V(8); PG8_WAIT_L(0); PG8_BAR; PG8_MMA(0, 0, At, B0); PG8_MMA(0, 1, At, B1); PG8_BAR; PG8_SCHED;
            PG8_LDA(At, 0, 1); PG8_STAGE(PG8_SB(0, 0), b2, voffB); PG8_STAGE(PG8_SB(0, 1), b2 + hstep, voffB); PG8_STAGE(PG8_SA(0, 0), a2, voffA);
            PG8_WAIT_V(8); PG8_WAIT_L(0); PG8_BAR; PG8_MMA(1, 0, At, B0); PG8_MMA(1, 1, At, B1); PG8_BAR; PG8_SCHED;
            PG8_LDB(B0, 1, 0); PG8_LDB(B1, 1, 1); PG8_SCHED; PG8_LDA(At, 1, 0); PG8_STAGE(PG8_SA(0, 1), a2 + hstep, voffA);
            PG8_WAIT_V(8); PG8_WAIT_L(0); PG8_BAR; PG8_MMA(0, 0, At, B0); PG8_MMA(0, 1, At, B1); PG8_BAR; PG8_SCHED;
            PG8_LDA(At, 1, 1); PG8_STAGE(PG8_SB(1, 0), b3, voffB); PG8_STAGE(PG8_SB(1, 1), b3 + hstep, voffB); PG8_STAGE(PG8_SA(1, 0), a3, voffA);
            PG8_WAIT_V(8); PG8_WAIT_L(0); PG8_BAR; PG8_MMA(1, 0, At, B0); PG8_MMA(1, 1, At, B1); PG8_BAR; PG8_SCHED;
            } else {
            PG8_LDB(B0, 0, 0); PG8_SCHED; PG8_LDA(At, 0, 0); PG8_STAGE(PG8_SA(1, 1), a1 + hstep, voffA);
            PG8_WAIT_L(8); PG8_BAR; PG8_WAIT_L(0); PG8_MMA(0, 0, At, B0); PG8_BAR; PG8_SCHED;
            PG8_LDB(B1, 0, 1); PG8_STAGE(PG8_SB(0, 0), b2, voffB);
            PG8_BAR; PG8_WAIT_L(0); PG8_MMA(0, 1, At, B1); PG8_BAR;
            PG8_LDA(At, 0, 1); PG8_STAGE(PG8_SA(0, 0), a2, voffA);
            PG8_BAR; PG8_WAIT_L(0); PG8_MMA(1, 0, At, B0); PG8_BAR; PG8_SCHED;
            PG8_STAGE(PG8_SB(0, 1), b2 + hstep, voffB);
            PG8_WAIT_V(6); PG8_BAR; PG8_MMA(1, 1, At, B1); PG8_BAR;
            PG8_LDB(B0, 1, 0); PG8_SCHED; PG8_LDA(At, 1, 0); PG8_STAGE(PG8_SA(0, 1), a2 + hstep, voffA);
            PG8_WAIT_L(8); PG8_BAR; PG8_WAIT_L(0); PG8_MMA(0, 0, At, B0); PG8_BAR; PG8_SCHED;
            PG8_LDB(B1, 1, 1); PG8_STAGE(PG8_SB(1, 0), b3, voffB);
            PG8_BAR; PG8_WAIT_L(0); PG8_MMA(0, 1, At, B1); PG8_BAR;
            PG8_LDA(At, 1, 1); PG8_STAGE(PG8_SA(1, 0), a3, voffA);
            PG8_BAR; PG8_WAIT_L(0); PG8_MMA(1, 0, At, B0); PG8_BAR; PG8_SCHED;
            PG8_STAGE(PG8_SB(1, 1), b3 + hstep, voffB);
            PG8_WAIT_V(6); PG8_BAR; PG8_MMA(1, 1, At, B1); PG8_BAR;
            }
        }
        if constexpr (ALIGN_EPI) { if (wr == 0) PG8_BAR; }
        if constexpr (!Epi::AFTER_DRAIN) { E(acc, cur, wr, wc, fr, fq); S.done(cur); }
        if (!has_next) break;
#pragma unroll
        for (int a = 0; a < 2; ++a)
#pragma unroll
            for (int b = 0; b < 2; ++b)
#pragma unroll
                for (int m = 0; m < 4; ++m)
#pragma unroll
                    for (int n = 0; n < 2; ++n) acc[a][b][m][n] = (f32x4){0.f, 0.f, 0.f, 0.f};
        cur = nxt; cA = nA; cB = nB; ++ui;
        if constexpr (ALIGN_EPI) { if (wr == 1) PG8_BAR; }
    }
    PG8_WAIT_V(0);
    if constexpr (!ALIGN_EPI) { if (wr == 0) PG8_BAR; }
    PG8_BAR;
    if constexpr (Epi::AFTER_DRAIN) { E.fused(acc, cur, wr, wc, fr, fq, lds, wid, lane); S.done(cur); }
#undef PG8_SA
#undef PG8_SB
#undef PG8_STAGE
#undef PG8_LDA
#undef PG8_LDB
#undef PG8_MMA
#undef PG8_WAIT_V
#undef PG8_WAIT_L
#undef PG8_BAR
#undef PG8_SCHED
}

template <class Epi, class Sched, bool ALIGN_EPI = false>
__device__ __forceinline__ void gemm_phase_gather(PG8_LAS unsigned char* lds, const Gemm g, const Sched& S, const Epi& E, const int* rowtok) {
    constexpr bool SP2 = true;
    int tid_ = threadIdx.x; asm volatile("" : "+v"(tid_));
    const int tid = tid_, wid = __builtin_amdgcn_readfirstlane(tid >> 6), lane = tid & 63, wr = wid >> 2, wc = wid & 3, fr = lane & 15, fq = lane >> 4;
    const int K = g.K, nt = K / BK;
    unsigned voffB[2]; unsigned vcur[2][2], vnxt[2][2]; int RA[2], CA[2]; const unsigned voffA[2] = {0u, 0u};
#pragma unroll
    for (int i = 0; i < 2; ++i) { int R, C; stage_rc(tid * 16 + i * 8192, R, C); const int Rb = Epi::PERM ? ((R & ~31) + perm32(R & 31)) : R;
        RA[i] = R; CA[i] = C; voffB[i] = (unsigned)(Rb * K + C) * 2u; }
#define PG8_GMAP(dst, pm_) do { _Pragma("unroll") for (int h_ = 0; h_ < 2; ++h_) _Pragma("unroll") for (int i_ = 0; i_ < 2; ++i_) { int tk_ = rowtok[4 * ((pm_) * BM + h_ * HALF + RA[i_])]; tk_ = tk_ < 0 ? 0 : tk_; dst[h_][i_] = (unsigned)(tk_ * K + CA[i_]) * 2u; } } while (0)
    const size_t kstep = (size_t)(BK * 2);
    const size_t hstep = (size_t)HALF * K * 2;
    const size_t tstep = 2 * hstep;
    const unsigned ldsw = (unsigned)wid * 1024u;
    const int aoff = lds_byte(wr * 64 + fr, fq * 8), boff = lds_byte(wc * 32 + fr, fq * 8);
#define PG8_SA(b, h) (((b) * 2 + (h)) * HTB)
#define PG8_SB(b, h) ((4 + (b) * 2 + (h)) * HTB)
#define PG8_STAGE(bufoff, gbase, voff) do { _Pragma("unroll") for (int _i = 0; _i < 2; ++_i) \
        __builtin_amdgcn_global_load_lds((const unsigned*)((const char*)(gbase) + (voff)[_i]), (PG8_LAS unsigned*)(lds + (bufoff) + ldsw + _i * 8192), 16, 0, 0); } while (0)
#define PG8_LDA(dst, b, h) do { _Pragma("unroll") for (int m = 0; m < 4; ++m) _Pragma("unroll") for (int k = 0; k < 2; ++k) dst[m][k] = *(const PG8_LAS bf16x8*)(lds + PG8_SA(b, h) + aoff + m * 2048 + k * 1024); } while (0)
#define PG8_LDB(dst, b, h) do { _Pragma("unroll") for (int n = 0; n < 2; ++n) _Pragma("unroll") for (int k = 0; k < 2; ++k) dst[n][k] = *(const PG8_LAS bf16x8*)(lds + PG8_SB(b, h) + boff + n * 2048 + k * 1024); } while (0)
#define PG8_MMA(ai, bj, At, Bt) do { __builtin_amdgcn_s_setprio(1); _Pragma("unroll") for (int m = 0; m < 4; ++m) _Pragma("unroll") for (int n = 0; n < 2; ++n) _Pragma("unroll") for (int k = 0; k < 2; ++k) \
        acc[ai][bj][m][n] = __builtin_amdgcn_mfma_f32_16x16x32_bf16(Bt[n][k], At[m][k], acc[ai][bj][m][n], 0, 0, 0); __builtin_amdgcn_s_setprio(0); } while (0)
#define PG8_WAIT_V(n) asm volatile("s_waitcnt vmcnt(" #n ")" ::: "memory")
#define PG8_WAIT_L(n) asm volatile("s_waitcnt lgkmcnt(" #n ")" ::: "memory")
#define PG8_BAR __builtin_amdgcn_s_barrier()
#define PG8_SCHED __builtin_amdgcn_sched_barrier(0)
    Unit cur, nxt; int ui = 0;
    if (!S.next(0, cur)) return;
    f32x4 acc[2][2][4][2];
#pragma unroll
    for (int a = 0; a < 2; ++a)
#pragma unroll
        for (int b = 0; b < 2; ++b)
#pragma unroll
            for (int m = 0; m < 4; ++m)
#pragma unroll
                for (int n = 0; n < 2; ++n) acc[a][b][m][n] = (f32x4){0.f, 0.f, 0.f, 0.f};
    bf16x8 At[4][2], B0[2][2], B1[2][2];
    const char* cA = (const char*)g.A; const char* cB = (const char*)g.Bt + (size_t)cur.pn * tstep;
    PG8_GMAP(vcur, cur.pm);
    S.a_ready(cur);
    if constexpr (SP2) {
        PG8_STAGE(PG8_SB(0, 0), cB, voffB); PG8_STAGE(PG8_SB(0, 1), cB + hstep, voffB); PG8_STAGE(PG8_SA(0, 0), cA, vcur[0]); PG8_STAGE(PG8_SA(0, 1), cA, vcur[1]);
        if (wr == 1) PG8_BAR;
        PG8_WAIT_V(2); PG8_BAR;
        PG8_STAGE(PG8_SB(1, 0), cB + kstep, voffB); PG8_STAGE(PG8_SA(1, 0), cA + kstep, vcur[0]); PG8_STAGE(PG8_SB(1, 1), cB + hstep + kstep, voffB);
        PG8_WAIT_V(6); PG8_BAR;
    } else {
        PG8_STAGE(PG8_SB(0, 0), cB, voffB); PG8_STAGE(PG8_SA(0, 0), cA, voffA); PG8_STAGE(PG8_SB(0, 1), cB + hstep, voffB); PG8_STAGE(PG8_SA(0, 1), cA + hstep, voffA);
        if (wr == 1) PG8_BAR;
        PG8_WAIT_V(4); PG8_BAR;
        PG8_STAGE(PG8_SB(1, 0), cB + kstep, voffB); PG8_STAGE(PG8_SA(1, 0), cA + kstep, voffA); PG8_STAGE(PG8_SB(1, 1), cB + hstep + kstep, voffB);
        PG8_WAIT_V(6); PG8_BAR;
    }
    for (;;) {
        const bool has_next = S.next(ui + 1, nxt);
        const char* nA = cA; const char* nB = has_next ? (const char*)g.Bt + (size_t)nxt.pn * tstep : cB;
        if (has_next) PG8_GMAP(vnxt, nxt.pm); else { vnxt[0][0] = vcur[0][0]; vnxt[0][1] = vcur[0][1]; vnxt[1][0] = vcur[1][0]; vnxt[1][1] = vcur[1][1]; }
        for (int t = 0; t < nt; t += 2) {
            const bool last = (t == nt - 2);
            const char* a1 = cA + (size_t)(t + 1) * kstep;
            const char* a2 = last ? nA : cA + (size_t)(t + 2) * kstep; unsigned v2[2][2]; v2[0][0] = last ? vnxt[0][0] : vcur[0][0]; v2[0][1] = last ? vnxt[0][1] : vcur[0][1]; v2[1][0] = last ? vnxt[1][0] : vcur[1][0]; v2[1][1] = last ? vnxt[1][1] : vcur[1][1]; const char* b2 = last ? nB : cB + (size_t)(t + 2) * kstep;
            const char* a3 = a2 + kstep; const char* b3 = b2 + kstep;
            if (last && has_next) S.a_ready(nxt);
            if constexpr (SP2) {
            PG8_LDB(B0, 0, 0); PG8_LDB(B1, 0, 1); PG8_SCHED; PG8_LDA(At, 0, 0); PG8_STAGE(PG8_SA(1, 1), a1, vcur[1]);
            PG8_WAIT_V(8); PG8_WAIT_L(0); PG8_BAR; PG8_MMA(0, 0, At, B0); PG8_MMA(0, 1, At, B1); PG8_BAR; PG8_SCHED;
            PG8_LDA(At, 0, 1); PG8_STAGE(PG8_SB(0, 0), b2, voffB); PG8_STAGE(PG8_SB(0, 1), b2 + hstep, voffB); PG8_STAGE(PG8_SA(0, 0), a2, v2[0]);
            PG8_WAIT_V(8); PG8_WAIT_L(0); PG8_BAR; PG8_MMA(1, 0, At, B0); PG8_MMA(1, 1, At, B1); PG8_BAR; PG8_SCHED;
            PG8_LDB(B0, 1, 0); PG8_LDB(B1, 1, 1); PG8_SCHED; PG8_LDA(At, 1, 0); PG8_STAGE(PG8_SA(0, 1), a2, v2[1]);
            PG8_WAIT_V(8); PG8_WAIT_L(0); PG8_BAR; PG8_MMA(0, 0, At, B0); PG8_MMA(0, 1, At, B1); PG8_BAR; PG8_SCHED;
            PG8_LDA(At, 1, 1); PG8_STAGE(PG8_SB(1, 0), b3, voffB); PG8_STAGE(PG8_SB(1, 1), b3 + hstep, voffB); PG8_STAGE(PG8_SA(1, 0), a3, v2[0]);
            PG8_WAIT_V(8); PG8_WAIT_L(0); PG8_BAR; PG8_MMA(1, 0, At, B0); PG8_MMA(1, 1, At, B1); PG8_BAR; PG8_SCHED;
            } else {
            PG8_LDB(B0, 0, 0); PG8_SCHED; PG8_LDA(At, 0, 0); PG8_STAGE(PG8_SA(1, 1), a1 + hstep, voffA);
            PG8_WAIT_L(8); PG8_BAR; PG8_WAIT_L(0); PG8_MMA(0, 0, At, B0); PG8_BAR; PG8_SCHED;
            PG8_LDB(B1, 0, 1); PG8_STAGE(PG8_SB(0, 0), b2, voffB);
            PG8_BAR; PG8_WAIT_L(0); PG8_MMA(0, 1, At, B1); PG8_BAR;
            PG8_LDA(At, 0, 1); PG8_STAGE(PG8_SA(0, 0), a2, voffA);
            PG8_BAR; PG8_WAIT_L(0); PG8_MMA(1, 0, At, B0); PG8_BAR; PG8_SCHED;
            PG8_STAGE(PG8_SB(0, 1), b2 + hstep, voffB);
            PG8_WAIT_V(6); PG8_BAR; PG8_MMA(1, 1, At, B1); PG8_BAR;
            PG8_LDB(B0, 1, 0); PG8_SCHED; PG8_LDA(At, 1, 0); PG8_STAGE(PG8_SA(0, 1), a2 + hstep, voffA);
            PG8_WAIT_L(8); PG8_BAR; PG8_WAIT_L(0); PG8_MMA(0, 0, At, B0); PG8_BAR; PG8_SCHED;
            PG8_LDB(B1, 1, 1); PG8_STAGE(PG8_SB(1, 0), b3, voffB);
            PG8_BAR; PG8_WAIT_L(0); PG8_MMA(0, 1, At, B1); PG8_BAR;
            PG8_LDA(At, 1, 1); PG8_STAGE(PG8_SA(1, 0), a3, voffA);
            PG8_BAR; PG8_WAIT_L(0); PG8_MMA(1, 0, At, B0); PG8_BAR; PG8_SCHED;
            PG8_STAGE(PG8_SB(1, 1), b3 + hstep, voffB);
            PG8_WAIT_V(6); PG8_BAR; PG8_MMA(1, 1, At, B1); PG8_BAR;
            }
        }
        if constexpr (ALIGN_EPI) { if (wr == 0) PG8_BAR; }
        if constexpr (!Epi::AFTER_DRAIN) { E(acc, cur, wr, wc, fr, fq); S.done(cur); }
        if (!has_next) break;
#pragma unroll
        for (int a = 0; a < 2; ++a)
#pragma unroll
            for (int b = 0; b < 2; ++b)
#pragma unroll
                for (int m = 0; m < 4; ++m)
#pragma unroll
                    for (int n = 0; n < 2; ++n) acc[a][b][m][n] = (f32x4){0.f, 0.f, 0.f, 0.f};
        cur = nxt; cA = nA; cB = nB; ++ui; vcur[0][0] = vnxt[0][0]; vcur[0][1] = vnxt[0][1]; vcur[1][0] = vnxt[1][0]; vcur[1][1] = vnxt[1][1];
        if constexpr (ALIGN_EPI) { if (wr == 1) PG8_BAR; }
    }
    PG8_WAIT_V(0);
    if constexpr (!ALIGN_EPI) { if (wr == 0) PG8_BAR; }
    PG8_BAR;
    if constexpr (Epi::AFTER_DRAIN) { E.fused(acc, cur, wr, wc, fr, fq, lds, wid, lane); S.done(cur); }
#undef PG8_GMAP
#undef PG8_SA
#undef PG8_SB
#undef PG8_STAGE
#undef PG8_LDA
#undef PG8_LDB
#undef PG8_MMA
#undef PG8_WAIT_V
#undef PG8_WAIT_L
#undef PG8_BAR
#undef PG8_SCHED
}

}

#define DI __device__ __forceinline__
#define LAS __attribute__((address_space(3)))
typedef unsigned short bf16_t;
typedef short bf16x8 __attribute__((ext_vector_type(8)));
typedef _Float16 f16x8 __attribute__((ext_vector_type(8)));
typedef float f32x4 __attribute__((ext_vector_type(4)));
typedef float f32x16 __attribute__((ext_vector_type(16)));
typedef unsigned u32x4 __attribute__((ext_vector_type(4)));
typedef unsigned u32x2 __attribute__((ext_vector_type(2)));

constexpr int NB = 4, SEQ = 4096, T = NB * SEQ, D = 1024, DEPTH = 2;
constexpr int PLD = 3912;
constexpr int PC_Q = 0, PC_K = 512, PC_V = 1024, PC_QI = 1536, PC_KI = 2048, PC_WI = 2112;
constexpr int PC_R = 2120, PC_BK = 2632, PC_BV = 3144, PC_WD = 3656;
constexpr int NPROJ_PAD = 4096;
constexpr int NEXP = 16, DEXP = 256, PLE = 256;
constexpr float ALPHA = 1.4142135623730951f;
constexpr float LN_EPS = 1e-5f, GN_EPS = 64e-5f;
constexpr int MAXROWS = 2 * T + NEXP * 256;
constexpr int NWAVES = 8, NTHR = 512;

constexpr size_t MiB = 1u << 20;
constexpr size_t WS_CTL = 0, CTL_BYTES = 1 * MiB;
constexpr size_t WS_WEXP = 1 * MiB;
constexpr size_t WS_WDOWN = 17 * MiB;
constexpr size_t WS_WOUT = 25 * MiB, WS_WPG = 27 * MiB, WS_WPLE = 29 * MiB;
constexpr size_t WS_BM = 30 * MiB;
constexpr size_t WS_ELL = 38 * MiB, WS_AA = 70 * MiB, WS_GG = 102 * MiB;
constexpr size_t WS_PROJ = 119 * MiB;
constexpr size_t WS_PBF = 242 * MiB;
constexpr size_t WS_V = 119 * MiB;
constexpr size_t WS_AG = 38 * MiB;
constexpr size_t WS_H = 183 * MiB;
constexpr size_t WS_Y = 119 * MiB;
constexpr size_t WS_PE = 201 * MiB;
constexpr size_t WS_V3 = 38 * MiB;
constexpr size_t WS_TOK = 233 * MiB;
constexpr size_t WS_ROW = 234 * MiB;
constexpr int CW_GCNT = 1024;

struct TokInfo { int e0, e1, p0, p1; float g0, g1; int pad0, pad1; };
struct RowInfo { int token, slot; float gate; int pad; };

#define LDS_WAIT() asm volatile("s_waitcnt lgkmcnt(0)" ::: "memory")
#define VM_WAIT() asm volatile("s_waitcnt vmcnt(0)" ::: "memory")
DI unsigned f2bf(float f) { unsigned u = __builtin_bit_cast(unsigned, f); return (u + 0x7fffu + ((u >> 16) & 1u)) >> 16; }
DI unsigned pk2(float lo, float hi) { return pg8::cvt_pk_bf16(lo, hi); }
DI float bf2f(unsigned short b) { return __builtin_bit_cast(float, (unsigned)b << 16); }
DI float bflo(unsigned w) { return __builtin_bit_cast(float, w << 16); }
DI float bfhi(unsigned w) { return __builtin_bit_cast(float, w & 0xffff0000u); }
DI unsigned pk2h(float lo, float hi) { typedef _Float16 h2_t __attribute__((ext_vector_type(2))); h2_t v = {(_Float16)lo, (_Float16)hi}; return __builtin_bit_cast(unsigned, v); }
DI float wave_sum(float v) {
#pragma unroll
    for (int o = 1; o < 64; o <<= 1) v += __shfl_xor(v, o);
    return v;
}
DI int opaque_i(int v) { asm volatile("" : "+s"(v)); return v; }
DI float sigmoidf_(float x) { return 1.f / (1.f + __expf(-x)); }

struct Args { const float* in[31]; float* out; unsigned char* ws; int ph_lo, ph_hi; };
struct Ctx {
    LAS unsigned char* lds;
    int tid, lane, wave, G, blk;
    const __attribute__((address_space(4))) Args* ap;
    float* out; unsigned char* ws;
    unsigned* ctl;
    bf16_t* xcur; bf16_t* mixcat;
    DI const float* in(int i) const { return ap->in[i]; }
};

DI void ln16(f32x4 (&v)[4], const float* g, const float* b, int lane) {
    float s = 0.f;
#pragma unroll
    for (int j = 0; j < 4; ++j) s += (v[j].x + v[j].y) + (v[j].z + v[j].w);
    const float mean = wave_sum(s) * (1.f / D);
    float s2 = 0.f;
#pragma unroll
    for (int j = 0; j < 4; ++j) { v[j] = v[j] - mean; s2 += (v[j].x * v[j].x + v[j].y * v[j].y) + (v[j].z * v[j].z + v[j].w * v[j].w); }
    const float rstd = 1.f / sqrtf(wave_sum(s2) * (1.f / D) + LN_EPS);
#pragma unroll
    for (int j = 0; j < 4; ++j) { const f32x4 gg = *(const f32x4*)(g + 256 * j + 4 * lane), bb = *(const f32x4*)(b + 256 * j + 4 * lane); v[j] = v[j] * rstd * gg + bb; }
}
DI void store_row_bf16(bf16_t* row, const f32x4 (&v)[4], int lane) {
#pragma unroll
    for (int j = 0; j < 4; ++j) { u32x2 o; o.x = pk2(v[j].x, v[j].y); o.y = pk2(v[j].z, v[j].w); *(u32x2*)(row + 256 * j + 4 * lane) = o; }
}
DI void load_row_bf16(const bf16_t* row, f32x4 (&v)[4], int lane) {
#pragma unroll
    for (int j = 0; j < 4; ++j) { const u32x2 o = *(const u32x2*)(row + 256 * j + 4 * lane); v[j] = (f32x4){bflo(o.x), bfhi(o.x), bflo(o.y), bfhi(o.y)}; }
}

template <class ColPtr>
DI void transpose_item(const ColPtr colptr, int ld, int K, bf16_t* WT, int n0, int k0, LAS float* scr, int lane) {
    const float* sp = colptr(n0 + (lane & 31));
    float tv[32];
#pragma unroll
    for (int i = 0; i < 32; ++i) { const int kk = 2 * i + (lane >> 5); tv[i] = sp ? sp[(size_t)(k0 + kk) * ld] : 0.f; }
#pragma unroll
    for (int i = 0; i < 32; ++i) { const int kk = 2 * i + (lane >> 5); scr[kk * 33 + (lane & 31)] = tv[i]; }
    LDS_WAIT(); asm volatile("" ::: "memory");
    const int c = lane & 7;
#pragma unroll
    for (int j = 0; j < 4; ++j) { const int n = (lane >> 3) + 8 * j; const LAS float* s = scr + (8 * c) * 33 + n;
        u32x4 o; o.x = pk2(s[0 * 33], s[1 * 33]); o.y = pk2(s[2 * 33], s[3 * 33]); o.z = pk2(s[4 * 33], s[5 * 33]); o.w = pk2(s[6 * 33], s[7 * 33]);
        *(u32x4*)(WT + (size_t)(n0 + n) * K + k0 + 8 * c) = o; }
    LDS_WAIT(); asm volatile("" ::: "memory");
}
template <class ColPtr>
DI void convert_matrix(Ctx& C, const ColPtr colptr, int ld, int K, int N, bf16_t* WT, int& first) {
    LAS float* scr = (LAS float*)(C.lds + C.wave * 16384);
    const int gw = C.blk * NWAVES + C.wave, NGW = C.G * NWAVES;
    const int nblk = N / 32, nitems = (K / 64) * nblk;
    int it = gw - (first % NGW); if (it < 0) it += NGW;
    for (; it < nitems; it += NGW) transpose_item(colptr, ld, K, WT, 32 * (it % nblk), 64 * (it / nblk), scr, C.lane);
    first += nitems;
}

struct ColWin { const float* w; DI const float* operator()(int j) const { if (j < 2120) return w + j; if (j >= 2176 && j < 3968) return w + (j - 56); return nullptr; } };
struct ColPlain { const float* w; DI const float* operator()(int j) const { return w + j; } };
struct ColGateUp { const float* wg; const float* wu; DI const float* operator()(int j) const {
        const int e = j >> 9, pn = (j >> 8) & 1, jj = j & 255; const int col = pn * 128 + (jj & 127); const uintptr_t pg = (uintptr_t)wg, pu = (uintptr_t)wu; const uintptr_t sel = pg + ((jj >= 128) ? (pu - pg) : (uintptr_t)0); return (const float*)sel + (size_t)e * D * DEXP + col; } };
struct ColDown { const float* wd; DI const float* operator()(int j) const { return wd + j; } };

DI void phase_ln_in(Ctx& C) {
    const int gw = C.blk * NWAVES + C.wave, NGW = C.G * NWAVES;
    for (int m = gw; m < T; m += NGW) {
        f32x4 v[4]; const float* xr = C.in(0) + (size_t)m * D;
#pragma unroll
        for (int j = 0; j < 4; ++j) v[j] = *(const f32x4*)(xr + 256 * j + 4 * C.lane);
        ln16(v, C.in(2), C.in(3), C.lane);
        store_row_bf16(C.xcur + (size_t)m * D, v, C.lane);
    }
}
DI void convert_win(Ctx& C, int l) { int first = 0; ColWin cw{C.in(4) + (size_t)l * D * 3912}; convert_matrix(C, cw, 3912, D, NPROJ_PAD, (bf16_t*)(C.ws + WS_WEXP), first); }
DI void convert_layer_weights(Ctx& C, int l) {
    int first = 0;
    { ColPlain c{C.in(5) + (size_t)l * D * D}; convert_matrix(C, c, D, D, D, (bf16_t*)(C.ws + WS_WOUT), first); }
    { ColGateUp c{C.in(20) + (size_t)l * NEXP * D * DEXP, C.in(21) + (size_t)l * NEXP * D * DEXP}; convert_matrix(C, c, DEXP, D, NEXP * 512, (bf16_t*)(C.ws + WS_WEXP), first); }
    for (int e = 0; e < NEXP; ++e) { ColDown c{C.in(22) + ((size_t)l * NEXP + e) * DEXP * D}; convert_matrix(C, c, D, DEXP, D, (bf16_t*)(C.ws + WS_WDOWN) + (size_t)e * D * DEXP, first); }
    { ColPlain c{C.in(24) + (size_t)l * D * D}; convert_matrix(C, c, D, D, D, (bf16_t*)(C.ws + WS_WPG), first); }
    { ColPlain c{C.in(23) + (size_t)l * PLE * D}; convert_matrix(C, c, D, PLE, D, (bf16_t*)(C.ws + WS_WPLE), first); }
    const float* p = C.in(1) + (size_t)l * T * PLE; bf16_t* pb = (bf16_t*)(C.ws + WS_PBF);
    for (size_t i = ((size_t)C.blk * NTHR + C.tid) * 8; i < (size_t)T * PLE; i += (size_t)C.G * NTHR * 8) {
        const f32x4 a = *(const f32x4*)(p + i), b = *(const f32x4*)(p + i + 4);
        u32x4 o; o.x = pk2(a.x, a.y); o.y = pk2(a.z, a.w); o.z = pk2(b.x, b.y); o.w = pk2(b.z, b.w); *(u32x4*)(pb + i) = o; }
}

struct EpiProj {
    static constexpr bool PERM = true, AFTER_DRAIN = false;
    bf16_t* P;
    DI void operator()(const f32x4 (&acc)[2][2][4][2], const pg8::Unit& u, int wr, int wc, int fr, int fq) const {
        const int row0 = u.pm * 256 + wr * 64 + fr;
#pragma unroll
        for (int bj = 0; bj < 2; ++bj) {
            const int j0 = u.pn * 256 + bj * 128 + wc * 32 + 8 * fq;
            int dst; bool half = false;
            if (j0 < 2120) { dst = j0; half = (j0 >= 1536); } else if (j0 >= 2176 && j0 < 3968) dst = j0 - 56; else dst = -1;
            if (dst >= 0) {
#pragma unroll
                for (int ai = 0; ai < 2; ++ai)
#pragma unroll
                    for (int m = 0; m < 4; ++m) {
                        const f32x4 v0 = acc[ai][bj][m][0], v1 = acc[ai][bj][m][1]; u32x4 w;
                        if (half) { w.x = pk2h(v0[0], v0[1]); w.y = pk2h(v0[2], v0[3]); w.z = pk2h(v1[0], v1[1]); w.w = pk2h(v1[2], v1[3]); }
                        else { w.x = pk2(v0[0], v0[1]); w.y = pk2(v0[2], v0[3]); w.z = pk2(v1[0], v1[1]); w.w = pk2(v1[2], v1[3]); }
                        *(u32x4*)(P + (size_t)(row0 + ai * 128 + m * 16) * PLD + dst) = w; }
            }
        }
    }
};
struct EpiBf16Plain {
    static constexpr bool PERM = true, AFTER_DRAIN = false;
    bf16_t* O; int ldc;
    DI void operator()(const f32x4 (&acc)[2][2][4][2], const pg8::Unit& u, int wr, int wc, int fr, int fq) const {
        const int row0 = u.pm * 256 + wr * 64 + fr, col0 = u.pn * 256 + wc * 32 + 8 * fq;
#pragma unroll
        for (int ai = 0; ai < 2; ++ai)
#pragma unroll
            for (int m = 0; m < 4; ++m)
#pragma unroll
                for (int bj = 0; bj < 2; ++bj) { const f32x4 v0 = acc[ai][bj][m][0], v1 = acc[ai][bj][m][1]; u32x4 w; w.x = pk2(v0[0], v0[1]); w.y = pk2(v0[2], v0[3]); w.z = pk2(v1[0], v1[1]); w.w = pk2(v1[2], v1[3]);
                    *(u32x4*)(O + (size_t)(row0 + ai * 128 + m * 16) * ldc + col0 + bj * 128) = w; }
    }
};
struct EpiResF32 {
    static constexpr bool PERM = false, AFTER_DRAIN = false;
    const bf16_t* X; bf16_t* V;
    DI void operator()(const f32x4 (&acc)[2][2][4][2], const pg8::Unit& u, int wr, int wc, int fr, int fq) const {
        const int row0 = u.pm * 256 + wr * 64 + fr, col0 = u.pn * 256 + wc * 32 + 4 * fq;
#pragma unroll
        for (int ai = 0; ai < 2; ++ai)
#pragma unroll
            for (int m = 0; m < 4; ++m)
#pragma unroll
                for (int bj = 0; bj < 2; ++bj)
#pragma unroll
                    for (int n = 0; n < 2; ++n) { const size_t off = (size_t)(row0 + ai * 128 + m * 16) * D + col0 + bj * 128 + n * 16;
                        const u32x2 xb = *(const u32x2*)(X + off); const f32x4 xv = {bflo(xb.x), bfhi(xb.x), bflo(xb.y), bfhi(xb.y)};
                        const f32x4 o = xv * ALPHA + acc[ai][bj][m][n]; u32x2 ob; ob.x = pk2(o.x, o.y); ob.y = pk2(o.z, o.w); *(u32x2*)(V + off) = ob; }
    }
};
struct EpiPle {
    static constexpr bool PERM = false, AFTER_DRAIN = false;
    const bf16_t* X; const bf16_t* PE; bf16_t* V;
    DI void operator()(const f32x4 (&acc)[2][2][4][2], const pg8::Unit& u, int wr, int wc, int fr, int fq) const {
        const int row0 = u.pm * 256 + wr * 64 + fr, col0 = u.pn * 256 + wc * 32 + 4 * fq;
#pragma unroll
        for (int ai = 0; ai < 2; ++ai)
#pragma unroll
            for (int m = 0; m < 4; ++m)
#pragma unroll
                for (int bj = 0; bj < 2; ++bj)
#pragma unroll
                    for (int n = 0; n < 2; ++n) { const size_t off = (size_t)(row0 + ai * 128 + m * 16) * D + col0 + bj * 128 + n * 16;
                        const u32x2 xb = *(const u32x2*)(X + off); const f32x4 xv = {bflo(xb.x), bfhi(xb.x), bflo(xb.y), bfhi(xb.y)};
                        const u32x2 pb = *(const u32x2*)(PE + off); const f32x4 pv = {bflo(pb.x), bfhi(pb.x), bflo(pb.y), bfhi(pb.y)};
                        const f32x4 a = acc[ai][bj][m][n]; f32x4 s; s.x = sigmoidf_(a.x); s.y = sigmoidf_(a.y); s.z = sigmoidf_(a.z); s.w = sigmoidf_(a.w);
                        const f32x4 o = xv * ALPHA + s * pv; u32x2 ob; ob.x = pk2(o.x, o.y); ob.y = pk2(o.z, o.w); *(u32x2*)(V + off) = ob; }
    }
};
struct EpiSwiGLU {
    static constexpr bool PERM = true, AFTER_DRAIN = false;
    bf16_t* H; const RowInfo* R;
    DI void operator()(const f32x4 (&acc)[2][2][4][2], const pg8::Unit& u, int wr, int wc, int fr, int fq) const {
        const int row0 = u.pm * 256 + wr * 64 + fr, col0 = (u.pn & 1) * 128 + wc * 32 + 8 * fq;
#pragma unroll
        for (int ai = 0; ai < 2; ++ai)
#pragma unroll
            for (int m = 0; m < 4; ++m) { const int row = row0 + ai * 128 + m * 16; const float gw = R[row].gate;
                float h[8];
#pragma unroll
                for (int n = 0; n < 2; ++n)
#pragma unroll
                    for (int i = 0; i < 4; ++i) { const float g = acc[ai][0][m][n][i], up = acc[ai][1][m][n][i]; h[4 * n + i] = g * sigmoidf_(g) * up * gw; }
                u32x4 w; w.x = pk2(h[0], h[1]); w.y = pk2(h[2], h[3]); w.z = pk2(h[4], h[5]); w.w = pk2(h[6], h[7]);
                *(u32x4*)(H + (size_t)row * DEXP + col0) = w; }
    }
};
struct EpiDown {
    static constexpr bool PERM = true, AFTER_DRAIN = false;
    bf16_t* Y; const RowInfo* R;
    DI void operator()(const f32x4 (&acc)[2][2][4][2], const pg8::Unit& u, int wr, int wc, int fr, int fq) const {
        const int row0 = u.pm * 256 + wr * 64 + fr, col0 = (u.pn & 3) * 256 + wc * 32 + 8 * fq;
#pragma unroll
        for (int ai = 0; ai < 2; ++ai)
#pragma unroll
            for (int m = 0; m < 4; ++m) { const int row = row0 + ai * 128 + m * 16; const RowInfo ri = R[row];
                if (ri.token >= 0) { bf16_t* dst = Y + ((size_t)ri.slot * T + ri.token) * D + col0;
#pragma unroll
                    for (int bj = 0; bj < 2; ++bj) { const f32x4 v0 = acc[ai][bj][m][0], v1 = acc[ai][bj][m][1]; u32x4 w; w.x = pk2(v0[0], v0[1]); w.y = pk2(v0[2], v0[3]); w.z = pk2(v1[0], v1[1]); w.w = pk2(v1[2], v1[3]);
                        *(u32x4*)(dst + bj * 128) = w; } } }
    }
};
template <int NPN> struct GroupedOrder {
    const LAS int* texp; int ntiles, G, c;
    DI bool next(int i, pg8::Unit& u) const { const int L = i * G + c; if (L >= ntiles * NPN) return false; u.pm = L / NPN; u.pn = texp[u.pm] * NPN + (L % NPN); return true; }
    DI void a_ready(const pg8::Unit&) const {}
    DI void done(const pg8::Unit&) const {}
};

constexpr int IDX_CAP = 512;
DI unsigned ordkey(float s) { const unsigned b = __builtin_bit_cast(unsigned, s); return (b & 0x80000000u) ? ~b : (b | 0x80000000u); }
DI float unordkey(unsigned k) { const unsigned b = (k & 0x80000000u) ? (k & 0x7fffffffu) : ~k; return __builtin_bit_cast(float, b); }

DI void idx_item(Ctx& C, int item, int l) {
    const int b = item & 3, qt = 511 - (item >> 2);
    const int t0 = qt * 8, chunk = t0 >> 6, NT32 = 2 * (chunk + 1);
    const size_t tok0 = (size_t)b * SEQ + t0;
    unsigned* bm = (unsigned*)(C.ws + WS_BM);
    const int lane = C.lane, wave = C.wave, tid = C.tid;
    if (chunk < 4) {
        if (tid < 8 * NT32) { const int q = tid / NT32, kt = tid % NT32; bm[(tok0 + q) * 128 + kt] = 0xffffffffu; }
        return;
    }
    const _Float16* ph = (const _Float16*)(C.ws + WS_PROJ);
    LAS unsigned* hist = (LAS unsigned*)(C.lds);
    LAS float* candS = (LAS float*)(C.lds + 8192);
    LAS int* candI = (LAS int*)(C.lds + 24576);
    LAS float* redmn = (LAS float*)(C.lds + 40960);
    LAS float* redmx = redmn + 64;
    LAS int* selB = (LAS int*)(C.lds + 41472);
    LAS unsigned* selAbove = (LAS unsigned*)(selB + 8);
    LAS unsigned* ccount = selAbove + 8;
    LAS float* thrS = (LAS float*)(ccount + 8);
    LAS int* thrI = (LAS int*)(thrS + 8);
    LAS unsigned* ovf = (LAS unsigned*)(thrI + 8);
    LAS unsigned* fbT = ovf + 8;
    LAS unsigned* fbCnt = fbT + 8;
    LAS unsigned* fbNeed = fbCnt + 8;
    const int r = lane & 31, hh = lane >> 5;
    float sc[2][16][2];
    f16x8 afr[2][4]; float wq[2][2][8];
#pragma unroll
    for (int m = 0; m < 2; ++m) {
        const int gq = (r >> 2) & 1, i = r >> 3, jj = r & 3, query = 4 * m + 2 * gq + (i >> 1), head = 4 * (i & 1) + jj;
        const _Float16* qp = ph + (tok0 + query) * PLD + PC_QI + head * 64 + 8 * hh;
#pragma unroll
        for (int s = 0; s < 4; ++s) afr[m][s] = *(const f16x8*)(qp + 16 * s);
#pragma unroll
        for (int qq = 0; qq < 2; ++qq) { const int q2 = 4 * m + 2 * hh + qq; const f16x8 wv = *(const f16x8*)(ph + (tok0 + q2) * PLD + PC_WI);
#pragma unroll
            for (int e = 0; e < 8; ++e) wq[m][qq][e] = (float)wv[e] * 0.044194173824159216f; }
    }
    const _Float16* kbase = ph + ((size_t)b * SEQ + r) * PLD + PC_KI + 8 * hh;
    f16x8 bnx[4];
#pragma unroll
    for (int s = 0; s < 4; ++s) bnx[s] = *(const f16x8*)(kbase + (size_t)(32 * wave) * PLD + 16 * s);
#pragma unroll
    for (int it = 0; it < 16; ++it) {
        const int kt = wave + 8 * it;
        if (kt < NT32) {
            f16x8 bfr[4];
#pragma unroll
            for (int s = 0; s < 4; ++s) bfr[s] = bnx[s];
            if (kt + 8 < NT32) {
#pragma unroll
                for (int s = 0; s < 4; ++s) bnx[s] = *(const f16x8*)(kbase + (size_t)(32 * (kt + 8)) * PLD + 16 * s); }
#pragma unroll
            for (int m = 0; m < 2; ++m) {
                f32x16 c = {};
#pragma unroll
                for (int s = 0; s < 4; ++s) c = __builtin_amdgcn_mfma_f32_32x32x16_f16(afr[m][s], bfr[s], c, 0, 0, 0);
#pragma unroll
                for (int qq = 0; qq < 2; ++qq) { float a = 0.f;
#pragma unroll
                    for (int e = 0; e < 8; ++e) a += wq[m][qq][e] * fmaxf(c[8 * qq + e], 0.f);
                    sc[m][it][qq] = a; }
            }
        } else { sc[0][it][0] = 0.f; sc[0][it][1] = 0.f; sc[1][it][0] = 0.f; sc[1][it][1] = 0.f; }
    }
    float mn[2][2], mx[2][2];
#pragma unroll
    for (int m = 0; m < 2; ++m)
#pragma unroll
        for (int qq = 0; qq < 2; ++qq) { float a = 3.0e38f, z = -3.0e38f;
#pragma unroll
            for (int it = 0; it < 16; ++it) if (wave + 8 * it < NT32) z = fmaxf(z, sc[m][it][qq]);
            a = z;
#pragma unroll
            for (int o = 1; o < 32; o <<= 1) { a = fminf(a, __shfl_xor(a, o)); z = fmaxf(z, __shfl_xor(z, o)); }
            mn[m][qq] = a; mx[m][qq] = z; }
    asm volatile("s_waitcnt lgkmcnt(0)\n\ts_barrier" ::: "memory");
    if (r == 0) {
#pragma unroll
        for (int m = 0; m < 2; ++m)
#pragma unroll
            for (int qq = 0; qq < 2; ++qq) { const int qid = 4 * m + 2 * hh + qq; redmn[wave * 8 + qid] = mn[m][qq]; redmx[wave * 8 + qid] = mx[m][qq]; }
    }
    for (int i = tid; i < 2048; i += NTHR) hist[i] = 0u;
    if (tid < 8) { ccount[tid] = 0u; ovf[tid] = 0u; }
    asm volatile("s_waitcnt lgkmcnt(0)\n\ts_barrier" ::: "memory");
    float lo[2][2], scl[2][2];
#pragma unroll
    for (int m = 0; m < 2; ++m)
#pragma unroll
        for (int qq = 0; qq < 2; ++qq) { const int qid = 4 * m + 2 * hh + qq; float a = 3.0e38f, z = -3.0e38f;
#pragma unroll
            for (int w = 0; w < 8; ++w) { a = fminf(a, redmn[w * 8 + qid]); z = fmaxf(z, redmx[w * 8 + qid]); }
            lo[m][qq] = a; scl[m][qq] = (z > a) ? 256.f / (z - a) : 0.f; }
#define IDX_BIN(m, it, qq) ((sc[m][it][qq] >= lo[m][qq]) ? min(255, (int)((sc[m][it][qq] - lo[m][qq]) * scl[m][qq])) : -1)
#define IDX_LAUNDER() do { _Pragma("unroll") for (int m_ = 0; m_ < 2; ++m_) _Pragma("unroll") for (int q_ = 0; q_ < 2; ++q_) { asm volatile("" : "+v"(lo[m_][q_]), "+v"(scl[m_][q_])); } } while (0)
#pragma unroll
    for (int m = 0; m < 2; ++m)
#pragma unroll
        for (int qq = 0; qq < 2; ++qq) { const int qid = 4 * m + 2 * hh + qq;
#pragma unroll
            for (int it = 0; it < 16; ++it) if (wave + 8 * it < NT32) { const int bin_ = IDX_BIN(m, it, qq); if (bin_ >= 0) __hip_atomic_fetch_add(hist + qid * 256 + bin_, 1u, __ATOMIC_RELAXED, __HIP_MEMORY_SCOPE_WORKGROUP); } }
    asm volatile("s_waitcnt lgkmcnt(0)\n\ts_barrier" ::: "memory");
    {
        const u32x4 h4 = *(const LAS u32x4*)(hist + wave * 256 + 4 * lane);
        const unsigned tot = h4.x + h4.y + h4.z + h4.w; unsigned incl = tot;
#pragma unroll
        for (int o = 1; o < 64; o <<= 1) { const unsigned v = __shfl_down(incl, o); if (lane + o < 64) incl += v; }
        unsigned run = incl - tot; int Bf = -1; unsigned ab = 0;
#pragma unroll
        for (int j = 3; j >= 0; --j) { const unsigned h = h4[j]; if (run < 256u && run + h >= 256u) { Bf = 4 * lane + j; ab = run; } run += h; }
        if (Bf >= 0) { selB[wave] = Bf; selAbove[wave] = ab; }
    }
    asm volatile("s_waitcnt lgkmcnt(0)\n\ts_barrier" ::: "memory");
    IDX_LAUNDER();
#pragma unroll
    for (int m = 0; m < 2; ++m)
#pragma unroll
        for (int qq = 0; qq < 2; ++qq) { const int qid = 4 * m + 2 * hh + qq; const int B = selB[qid];
#pragma unroll
            for (int it = 0; it < 16; ++it) if (wave + 8 * it < NT32) { const bool hit = (IDX_BIN(m, it, qq) == B); if (__any(hit)) { if (hit) { const unsigned pos = __hip_atomic_fetch_add(ccount + qid, 1u, __ATOMIC_RELAXED, __HIP_MEMORY_SCOPE_WORKGROUP);
                if (pos < (unsigned)IDX_CAP) { candS[qid * IDX_CAP + pos] = sc[m][it][qq]; candI[qid * IDX_CAP + pos] = 32 * (wave + 8 * it) + r; } } } } }
    asm volatile("s_waitcnt lgkmcnt(0)\n\ts_barrier" ::: "memory");
    {
        const int c = (int)ccount[wave]; const int need = 256 - (int)selAbove[wave];
        if (c <= IDX_CAP) {
            for (int i = lane; i < c; i += 64) { const float si = candS[wave * IDX_CAP + i]; const int ii = candI[wave * IDX_CAP + i]; int rank = 0;
                for (int j = 0; j < c; ++j) { const float sj = candS[wave * IDX_CAP + j]; const int ij = candI[wave * IDX_CAP + j]; rank += ((sj > si) || (sj == si && ij < ii)) ? 1 : 0; }
                if (rank == need - 1) { thrS[wave] = si; thrI[wave] = ii; } }
        } else if (lane == 0) { ovf[wave] = 1u; fbNeed[wave] = (unsigned)need; fbT[wave] = 0u; }
    }
    asm volatile("s_waitcnt lgkmcnt(0)\n\ts_barrier" ::: "memory");
    unsigned anyovf = 0u;
#pragma unroll
    for (int q = 0; q < 8; ++q) anyovf |= ovf[q];
    if (anyovf) {
        for (int bit = 31; bit >= 0; --bit) {
            if (tid < 8) fbCnt[tid] = 0u;
            asm volatile("s_waitcnt lgkmcnt(0)\n\ts_barrier" ::: "memory");
            IDX_LAUNDER();
#pragma unroll
            for (int m = 0; m < 2; ++m)
#pragma unroll
                for (int qq = 0; qq < 2; ++qq) { const int qid = 4 * m + 2 * hh + qq; if (ovf[qid]) { const unsigned cand = fbT[qid] | (1u << bit); const int B = selB[qid]; unsigned cnt = 0;
#pragma unroll
                    for (int it = 0; it < 16; ++it) if (wave + 8 * it < NT32) cnt += (IDX_BIN(m, it, qq) == B && ordkey(sc[m][it][qq]) >= cand) ? 1u : 0u;
                    if (cnt) __hip_atomic_fetch_add(fbCnt + qid, cnt, __ATOMIC_RELAXED, __HIP_MEMORY_SCOPE_WORKGROUP); } }
            asm volatile("s_waitcnt lgkmcnt(0)\n\ts_barrier" ::: "memory");
            if (tid < 8 && ovf[tid] && fbCnt[tid] >= fbNeed[tid]) fbT[tid] |= (1u << bit);
            asm volatile("s_waitcnt lgkmcnt(0)\n\ts_barrier" ::: "memory");
        }
        if (tid < 8) fbCnt[tid] = 0u;
        asm volatile("s_waitcnt lgkmcnt(0)\n\ts_barrier" ::: "memory");
        IDX_LAUNDER();
#pragma unroll
        for (int m = 0; m < 2; ++m)
#pragma unroll
            for (int qq = 0; qq < 2; ++qq) { const int qid = 4 * m + 2 * hh + qq; if (ovf[qid]) { const unsigned Tk = fbT[qid]; const int B = selB[qid]; unsigned cnt = 0;
#pragma unroll
                for (int it = 0; it < 16; ++it) if (wave + 8 * it < NT32) cnt += (IDX_BIN(m, it, qq) == B && ordkey(sc[m][it][qq]) > Tk) ? 1u : 0u;
                if (cnt) __hip_atomic_fetch_add(fbCnt + qid, cnt, __ATOMIC_RELAXED, __HIP_MEMORY_SCOPE_WORKGROUP); } }
        asm volatile("s_waitcnt lgkmcnt(0)\n\ts_barrier" ::: "memory");
        if (tid < 8 && ovf[tid]) { fbNeed[tid] -= fbCnt[tid]; thrS[tid] = unordkey(fbT[tid]); thrI[tid] = 0; }
        asm volatile("s_waitcnt lgkmcnt(0)\n\ts_barrier" ::: "memory");
        for (int bit = 11; bit >= 0; --bit) {
            if (tid < 8) fbCnt[tid] = 0u;
            asm volatile("s_waitcnt lgkmcnt(0)\n\ts_barrier" ::: "memory");
            IDX_LAUNDER();
#pragma unroll
            for (int m = 0; m < 2; ++m)
#pragma unroll
                for (int qq = 0; qq < 2; ++qq) { const int qid = 4 * m + 2 * hh + qq; if (ovf[qid]) { const unsigned Tk = fbT[qid]; const int B = selB[qid]; const int cand = thrI[qid] | (1 << bit); unsigned cnt = 0;
#pragma unroll
                    for (int it = 0; it < 16; ++it) if (wave + 8 * it < NT32) cnt += (IDX_BIN(m, it, qq) == B && ordkey(sc[m][it][qq]) == Tk && (32 * (wave + 8 * it) + r) < cand) ? 1u : 0u;
                    if (cnt) __hip_atomic_fetch_add(fbCnt + qid, cnt, __ATOMIC_RELAXED, __HIP_MEMORY_SCOPE_WORKGROUP); } }
            asm volatile("s_waitcnt lgkmcnt(0)\n\ts_barrier" ::: "memory");
            if (tid < 8 && ovf[tid] && fbCnt[tid] < fbNeed[tid]) thrI[tid] |= (1 << bit);
            asm volatile("s_waitcnt lgkmcnt(0)\n\ts_barrier" ::: "memory");
        }
    }
    IDX_LAUNDER();
#pragma unroll
    for (int m = 0; m < 2; ++m)
#pragma unroll
        for (int qq = 0; qq < 2; ++qq) { const int qid = 4 * m + 2 * hh + qq; const int B = selB[qid]; const float ts = thrS[qid]; const int ti = thrI[qid];
            unsigned myw = 0u;
#pragma unroll
            for (int it = 0; it < 16; ++it) { const int kt = wave + 8 * it;
                if (kt < NT32) { const int bin = IDX_BIN(m, it, qq); const float s = sc[m][it][qq]; const int idx = 32 * kt + r;
                    const bool sel = (bin > B) || (bin == B && (s > ts || (s == ts && idx <= ti)));
                    const unsigned long long mk = __ballot(sel);
                    const unsigned wv = hh ? (unsigned)(mk >> 32) : (unsigned)mk;
                    if (r == it) myw = wv; } }
            if (r < 16 && wave + 8 * r < NT32) bm[(tok0 + qid) * 128 + wave + 8 * r] = myw; }
#undef IDX_BIN
#undef IDX_LAUNDER
}

DI float softplusf_(float z) { return fmaxf(z, 0.f) + log1pf(expf(-fabsf(z))); }
DI void attn_tile(const LAS unsigned char* kb, const LAS unsigned char* vb, const LAS float* tab, const bf16x8 (&qr)[4], unsigned cw0, unsigned cw1, int j, int qw, int myq, int r32, int hi, float bias_far,
                  float& m_run, float& l_run, f32x16& o0, f32x16& o1, f32x16& negmb) {
    bf16x8 ka[8];
#pragma unroll
    for (int s = 0; s < 4; ++s) { const int ch = 2 * s + hi;
        ka[2 * s] = *(const LAS bf16x8*)(kb + r32 * 128 + ((ch ^ ((r32 >> 1) & 7)) << 4));
        ka[2 * s + 1] = *(const LAS bf16x8*)(kb + (32 + r32) * 128 + ((ch ^ (((32 + r32) >> 1) & 7)) << 4)); }
    f32x16 p0 = negmb, p1 = negmb;
#pragma unroll
    for (int s = 0; s < 4; ++s) { p0 = __builtin_amdgcn_mfma_f32_32x32x16_bf16(ka[2 * s], qr[s], p0, 0, 0, 0); p1 = __builtin_amdgcn_mfma_f32_32x32x16_bf16(ka[2 * s + 1], qr[s], p1, 0, 0, 0); }
    u32x4 va0[4], va1[4];
#pragma unroll
    for (int s = 0; s < 4; ++s) {
        const u32x2 a0l = *(const LAS u32x2*)(vb + (r32) * 136 + (16 * s + 4 * hi) * 2), a0h = *(const LAS u32x2*)(vb + (r32) * 136 + (16 * s + 8 + 4 * hi) * 2);
        const u32x2 a1l = *(const LAS u32x2*)(vb + (32 + r32) * 136 + (16 * s + 4 * hi) * 2), a1h = *(const LAS u32x2*)(vb + (32 + r32) * 136 + (16 * s + 8 + 4 * hi) * 2);
        va0[s] = (u32x4){a0l.x, a0l.y, a0h.x, a0h.y}; va1[s] = (u32x4){a1l.x, a1l.y, a1h.x, a1h.y}; }
    const bool far = (64 * j + 63 - qw) <= -128;
    if (!far) {
#pragma unroll
        for (int g = 0; g < 16; ++g) { const int kv0 = 64 * j + (g & 3) + 8 * (g >> 2) + 4 * hi; int r0 = kv0 - myq, r1 = r0 + 32;
            r0 = r0 < -128 ? -128 : r0; r1 = r1 < -128 ? -128 : r1;
            p0[g] += tab[r0 + 128]; p1[g] += tab[r1 + 128]; }
    }
    float mx = p0[0];
#pragma unroll
    for (int g = 1; g < 16; ++g) mx = fmaxf(mx, p0[g]);
#pragma unroll
    for (int g = 0; g < 16; ++g) mx = fmaxf(mx, p1[g]);
    mx = fmaxf(mx, __shfl_xor(mx, 32));
    if (j == 0 || __any(mx > 0.f)) {
        const float dl = (j == 0) ? mx : fmaxf(mx, 0.f);
        m_run += dl;
        const float al = __builtin_amdgcn_exp2f(-dl); l_run *= al;
#pragma unroll
        for (int g = 0; g < 16; ++g) { p0[g] -= dl; p1[g] -= dl; o0[g] *= al; o1[g] *= al; negmb[g] = bias_far - m_run; }
        asm volatile("" : "+v"(negmb));
    }
    const int sw0 = (int)(cw0 >> (4 * hi)), sw1 = (int)(cw1 >> (4 * hi));
    float ls = 0.f;
#pragma unroll
    for (int g = 0; g < 16; ++g) { const int bit = (g & 3) + 8 * (g >> 2);
        const float e0 = __builtin_amdgcn_exp2f(p0[g]), e1 = __builtin_amdgcn_exp2f(p1[g]);
        int m0_, m1_;
        asm("v_bfe_i32 %0, %1, %2, 1" : "=v"(m0_) : "v"(sw0), "n"(bit)); asm("v_bfe_i32 %0, %1, %2, 1" : "=v"(m1_) : "v"(sw1), "n"(bit));
        p0[g] = __builtin_bit_cast(float, __builtin_bit_cast(int, e0) & m0_); p1[g] = __builtin_bit_cast(float, __builtin_bit_cast(int, e1) & m1_); ls += p0[g] + p1[g]; }
    l_run += ls;
    bf16x8 pb[4];
#pragma unroll
    for (int s = 0; s < 2; ++s) {
        u32x4 w; w.x = pk2(p0[8 * s], p0[8 * s + 1]); w.y = pk2(p0[8 * s + 2], p0[8 * s + 3]); w.z = pk2(p0[8 * s + 4], p0[8 * s + 5]); w.w = pk2(p0[8 * s + 6], p0[8 * s + 7]); pb[s] = __builtin_bit_cast(bf16x8, w);
        u32x4 x; x.x = pk2(p1[8 * s], p1[8 * s + 1]); x.y = pk2(p1[8 * s + 2], p1[8 * s + 3]); x.z = pk2(p1[8 * s + 4], p1[8 * s + 5]); x.w = pk2(p1[8 * s + 6], p1[8 * s + 7]); pb[2 + s] = __builtin_bit_cast(bf16x8, x); }
#pragma unroll
    for (int s = 0; s < 4; ++s) {
        o0 = __builtin_amdgcn_mfma_f32_32x32x16_bf16(__builtin_bit_cast(bf16x8, va0[s]), pb[s], o0, 0, 0, 0);
        o1 = __builtin_amdgcn_mfma_f32_32x32x16_bf16(__builtin_bit_cast(bf16x8, va1[s]), pb[s], o1, 0, 0, 0); }
}
DI void attn_unit(Ctx& C, int b, int h, int qb) {
    const int tid = C.tid, lane = C.lane, wave = C.wave, r32 = lane & 31, hi = lane >> 5;
    const bf16_t* proj = (const bf16_t*)(C.ws + WS_PROJ);
    const unsigned* bm = (const unsigned*)(C.ws + WS_BM);
    LAS unsigned char* Kl = C.lds; LAS unsigned char* Vl = C.lds + 16384; LAS float* tab = (LAS float*)(C.lds + 33792);
    const size_t rowbase = (size_t)b * SEQ; const int q0 = qb * 256, qw = q0 + 32 * wave, myq = qw + r32;
    const int NT = 4 * qb + 4, mylast = qw >> 6;
    constexpr float LOG2E = 1.4426950408889634f;
    __syncthreads();
    if (tid < 192) { const int rel = tid - 128; const int n = rel < 0 ? -rel : rel; int bk = rel > 0 ? 16 : 0;
        if (n < 8) bk += n; else bk += 8 + (n >= 12) + (n >= 16) + (n >= 23) + (n >= 32) + (n >= 46) + (n >= 64) + (n >= 91);
        tab[tid] = (C.in(17)[bk * 8 + h] - C.in(17)[15 * 8 + h]) * LOG2E; }
    const float bias_far = C.in(17)[15 * 8 + h] * LOG2E;
    bf16x8 qr[4];
    { const bf16_t* qp = proj + (rowbase + myq) * PLD + PC_Q + h * 64 + 8 * hi;
#pragma unroll
        for (int s = 0; s < 4; ++s) { const u32x4 raw = *(const u32x4*)(qp + 16 * s); u32x4 sc_;
#pragma unroll
            for (int e = 0; e < 4; ++e) sc_[e] = pk2(bflo(raw[e]) * (0.125f * LOG2E), bfhi(raw[e]) * (0.125f * LOG2E));
            qr[s] = __builtin_bit_cast(bf16x8, sc_); } }
    const unsigned* bmrow = bm + (rowbase + myq) * 128;
    const int skv = tid >> 3, sch = tid & 7;
    const bf16_t* ksrc = proj + (rowbase + skv) * PLD + PC_K + h * 64 + 8 * sch;
    const bf16_t* vsrc = proj + (rowbase + skv) * PLD + PC_V + h * 64 + 8 * sch;
    const int kdst = skv * 128 + ((sch ^ ((skv >> 1) & 7)) << 4);
    const u32x4 m4i = *(const u32x4*)bmrow;
    u32x4 kregA = *(const u32x4*)ksrc, vregA = *(const u32x4*)vsrc; unsigned mA0 = m4i.x, mA1 = m4i.y;
    u32x4 kregB = kregA, vregB = vregA; unsigned mB0 = m4i.z, mB1 = m4i.w;
    if (NT > 1) { kregB = *(const u32x4*)(ksrc + (size_t)64 * PLD); vregB = *(const u32x4*)(vsrc + (size_t)64 * PLD); }
    const bool vodd = (skv & 1) != 0; const int vdst = ((8 * sch + (vodd ? 4 : 0)) * 68 + (skv & ~1)) * 2;
#define ATT_WRITE(buf, kreg, vreg) do { *(LAS u32x4*)(Kl + (buf) * 8192 + kdst) = kreg; LAS unsigned char* vt_ = Vl + (buf) * 8704 + vdst; \
        const unsigned r0_ = (unsigned)__builtin_amdgcn_ds_swizzle((int)(vodd ? vreg.x : vreg.z), 0x201F), r1_ = (unsigned)__builtin_amdgcn_ds_swizzle((int)(vodd ? vreg.y : vreg.w), 0x201F); \
        const unsigned lo0_ = vodd ? r0_ : vreg.x, hi0_ = vodd ? vreg.z : r0_, lo1_ = vodd ? r1_ : vreg.y, hi1_ = vodd ? vreg.w : r1_; \
        *(LAS unsigned*)(vt_ + 0 * 136) = (lo0_ & 0xffffu) | (hi0_ << 16); *(LAS unsigned*)(vt_ + 1 * 136) = (lo0_ >> 16) | (hi0_ & 0xffff0000u); \
        *(LAS unsigned*)(vt_ + 2 * 136) = (lo1_ & 0xffffu) | (hi1_ << 16); *(LAS unsigned*)(vt_ + 3 * 136) = (lo1_ >> 16) | (hi1_ & 0xffff0000u); } while (0)
    ATT_WRITE(0, kregA, vregA);
    __syncthreads();
    float m_run = 0.f, l_run = 0.f; f32x16 o0 = {}, o1 = {}, negmb;
#pragma unroll
    for (int g = 0; g < 16; ++g) negmb[g] = bias_far;
    asm volatile("" : "+v"(negmb));
#define ATT_STEP(J, CW0, CW1, KN, VN, KF, VF, MLOAD) do { const int js_ = (J); const int buf = js_ & 1; \
        if (js_ + 2 < NT) { KF = *(const u32x4*)(ksrc + (size_t)(js_ + 2) * 64 * PLD); VF = *(const u32x4*)(vsrc + (size_t)(js_ + 2) * 64 * PLD); MLOAD; } \
        if (js_ <= mylast) { attn_tile(Kl + buf * 8192, Vl + buf * 8704, tab, qr, (CW0), (CW1), js_, qw, myq, r32, hi, bias_far, m_run, l_run, o0, o1, negmb); } \
        if (js_ + 1 < NT) ATT_WRITE(buf ^ 1, KN, VN); \
        __syncthreads(); } while (0)
    {
        unsigned cA0 = mA0, cA1 = mA1;
        for (int j = 0; j < NT; j += 2) {
            u32x4 m4 = {0u, 0u, 0u, 0u};
            { const unsigned c0 = cA0, c1 = cA1; u32x4 kf = kregA, vf = vregA;
              ATT_STEP(j, c0, c1, kregB, vregB, kf, vf, m4 = *(const u32x4*)(bmrow + 2 * js_ + 4)); kregA = kf; vregA = vf; cA0 = m4.x; cA1 = m4.y; }
            if (j + 1 < NT) {
                const unsigned c0 = mB0, c1 = mB1; u32x4 kf = kregB, vf = vregB;
                ATT_STEP(j + 1, c0, c1, kregA, vregA, kf, vf, (void)0); kregB = kf; vregB = vf; mB0 = m4.z; mB1 = m4.w; }
        }
    }
#undef ATT_STEP
#undef ATT_WRITE
    const float lt = l_run + __shfl_xor(l_run, 32); const float inv = 1.f / lt;
    bf16_t* orow = C.mixcat + (rowbase + myq) * D + h * 64;
#pragma unroll
    for (int i = 0; i < 4; ++i) { const int d = 8 * i + 4 * hi;
        u32x2 w0; w0.x = pk2(o0[4 * i] * inv, o0[4 * i + 1] * inv); w0.y = pk2(o0[4 * i + 2] * inv, o0[4 * i + 3] * inv); *(u32x2*)(orow + d) = w0;
        u32x2 w1; w1.x = pk2(o1[4 * i] * inv, o1[4 * i + 1] * inv); w1.y = pk2(o1[4 * i + 2] * inv, o1[4 * i + 3] * inv); *(u32x2*)(orow + 32 + d) = w1; }
}

constexpr size_t WS_PHI = 38 * MiB, WS_PSI = 54 * MiB, WS_GT = 70 * MiB, WS_Y0T = 86 * MiB, WS_GGT = 102 * MiB, WS_RHO = 118 * MiB;
constexpr size_t WS_S0 = 1 * MiB;
constexpr size_t WS_LORA = 250 * MiB;
DI int crow(int g, int hi) { return (g & 3) + 8 * (g >> 2) + 4 * hi; }
DI f32x16 mfma32(bf16x8 a, bf16x8 b, f32x16 c) { return __builtin_amdgcn_mfma_f32_32x32x16_bf16(a, b, c, 0, 0, 0); }
struct FA { float v[16]; DI float& operator[](int i) { return v[i]; } DI const float& operator[](int i) const { return v[i]; } };
struct F8 { float v[8]; DI float& operator[](int i) { return v[i]; } DI const float& operator[](int i) const { return v[i]; } };
DI bf16x8 pack8(const F8& a) { u32x4 w; w.x = pk2(a[0], a[1]); w.y = pk2(a[2], a[3]); w.z = pk2(a[4], a[5]); w.w = pk2(a[6], a[7]); return __builtin_bit_cast(bf16x8, w); }
DI void pin(FA& a) { asm volatile("" : "+v"(a.v[0]), "+v"(a.v[1]), "+v"(a.v[2]), "+v"(a.v[3]), "+v"(a.v[4]), "+v"(a.v[5]), "+v"(a.v[6]), "+v"(a.v[7]), "+v"(a.v[8]), "+v"(a.v[9]), "+v"(a.v[10]), "+v"(a.v[11]), "+v"(a.v[12]), "+v"(a.v[13]), "+v"(a.v[14]), "+v"(a.v[15])); }
DI void pinf(bf16x8& a) { asm volatile("" : "+v"(a)); }
DI FA toFA(const f32x16& a) { FA r; _Pragma("unroll") for (int i = 0; i < 16; ++i) r.v[i] = a[i]; return r; }
DI f32x16 toV(const FA& a) { f32x16 r; _Pragma("unroll") for (int i = 0; i < 16; ++i) r[i] = a.v[i]; return r; }
DI bf16x8 packfrag(const FA& a, int s) { u32x4 w; w.x = pk2(a[8 * s], a[8 * s + 1]); w.y = pk2(a[8 * s + 2], a[8 * s + 3]); w.z = pk2(a[8 * s + 4], a[8 * s + 5]); w.w = pk2(a[8 * s + 6], a[8 * s + 7]); return __builtin_bit_cast(bf16x8, w); }
DI bf16x8 packfrag(const f32x16& a, int s) { u32x4 w; w.x = pk2(a[8 * s], a[8 * s + 1]); w.y = pk2(a[8 * s + 2], a[8 * s + 3]); w.z = pk2(a[8 * s + 4], a[8 * s + 5]); w.w = pk2(a[8 * s + 6], a[8 * s + 7]); return __builtin_bit_cast(bf16x8, w); }
DI unsigned opq(unsigned v) { asm volatile("" : "+v"(v)); return v; }
DI void st_frag(unsigned char* buf, int f, int lane, bf16x8 v) { *(bf16x8*)(buf + f * 1024 + opq(lane * 16)) = v; }
DI bf16x8 ld_frag(const unsigned char* buf, int f, int lane) { return *(const bf16x8*)(buf + f * 1024 + opq(lane * 16)); }
template <class TT> DI void st_tile_bf16(unsigned char* buf, int q, int lane, const TT& a) { const unsigned o = opq(lane * 32); *(bf16x8*)(buf + q * 2048 + o) = packfrag(a, 0); *(bf16x8*)(buf + q * 2048 + o + 16) = packfrag(a, 1); }
DI FA ld_tile_bf16(const unsigned char* buf, int q, int lane) { const unsigned o = opq(lane * 32); const u32x4 a = *(const u32x4*)(buf + q * 2048 + o), b = *(const u32x4*)(buf + q * 2048 + o + 16); FA r;
    r[0] = bflo(a.x); r[1] = bfhi(a.x); r[2] = bflo(a.y); r[3] = bfhi(a.y); r[4] = bflo(a.z); r[5] = bfhi(a.z); r[6] = bflo(a.w); r[7] = bfhi(a.w);
    r[8] = bflo(b.x); r[9] = bfhi(b.x); r[10] = bflo(b.y); r[11] = bfhi(b.y); r[12] = bflo(b.z); r[13] = bfhi(b.z); r[14] = bflo(b.w); r[15] = bfhi(b.w); return r; }
DI float fexp(float x) { return __builtin_amdgcn_exp2f(x * 1.4426950408889634f); }
DI float flog(float x) { return __builtin_amdgcn_logf(x) * 0.6931471805599453f; }
DI float ftanh(float x) { return 1.f - 2.f * __builtin_amdgcn_rcpf(1.f + fexp(2.f * x)); }
DI float fsigm(float x) { return __builtin_amdgcn_rcpf(1.f + fexp(-x)); }
DI float fsoftplus(float z) { return fmaxf(z, 0.f) + flog(1.f + fexp(-fabsf(z))); }
template <int ACT> DI bf16x8 act_frag(const bf16_t* proj, size_t row, bool first, int c0, const float* mu8) {
    const bf16_t* rp = proj + opq((unsigned)(row * PLD)); const u32x4 cu = *(const u32x4*)(rp + c0); u32x4 pv = {0u, 0u, 0u, 0u}; if (!first) pv = *(const u32x4*)(rp - PLD + c0);
    const float* mq = mu8 + opq(0u); const f32x4 m0 = *(const f32x4*)(mq), m1 = *(const f32x4*)(mq + 4);
    float x[8];
#pragma unroll
    for (int q = 0; q < 4; ++q) { const float c_lo = bflo(cu[q]), c_hi = bfhi(cu[q]), p_lo = bflo(pv[q]), p_hi = bfhi(pv[q]); const float ma = (q < 2) ? m0[2 * q] : m1[2 * q - 4], mb = (q < 2) ? m0[2 * q + 1] : m1[2 * q - 3];
        x[2 * q] = c_lo + (p_lo - c_lo) * ma; x[2 * q + 1] = c_hi + (p_hi - c_hi) * mb; }
#pragma unroll
    for (int e = 0; e < 8; ++e) { if (ACT == 1) x[e] = ftanh(x[e]); else if (ACT == 2) x[e] = fsigm(x[e]); }
    u32x4 w; w.x = pk2(x[0], x[1]); w.y = pk2(x[2], x[3]); w.z = pk2(x[4], x[5]); w.w = pk2(x[6], x[7]); return __builtin_bit_cast(bf16x8, w);
}
DI f32x4 shift4(const bf16_t* proj, size_t row, bool first, int c4, const float* mu4) {
    const bf16_t* rp = proj + opq((unsigned)(row * PLD)); const u32x2 cu = *(const u32x2*)(rp + c4); u32x2 pv = {0u, 0u}; if (!first) pv = *(const u32x2*)(rp - PLD + c4);
    const f32x4 m = *(const f32x4*)(mu4 + opq(0u)); const f32x4 c = {bflo(cu.x), bfhi(cu.x), bflo(cu.y), bfhi(cu.y)}, p = {bflo(pv.x), bfhi(pv.x), bflo(pv.y), bfhi(pv.y)};
    return c + (p - c) * m;
}
DI f32x4 shiftT4(const bf16_t* proj, size_t row, bool firstseq, int c1, float mu1) {
    const bf16_t* rp = proj + opq((unsigned)(row * PLD + c1));
    const float c0 = bf2f(rp[0]), c1_ = bf2f(rp[PLD]), c2 = bf2f(rp[2 * PLD]), c3 = bf2f(rp[3 * PLD]);
    const float pm = firstseq ? 0.f : bf2f(*(rp - PLD));
    f32x4 r; r.x = c0 + (pm - c0) * mu1; r.y = c1_ + (c0 - c1_) * mu1; r.z = c2 + (c1_ - c2) * mu1; r.w = c3 + (c2 - c3) * mu1; return r;
}
DI float scan32_incl(float x, int tl) {
#pragma unroll
    for (int d = 1; d < 32; d <<= 1) { const float y = __shfl_up(x, d, 32); if (tl >= d) x += y; }
    return x;
}

constexpr int RL_ACT = 0;
constexpr int RL_MAB = 0, RL_W1C = 17408, RL_W2C = 26624;
constexpr int RL_ELL = 35840;
constexpr int RL_AV = RL_ELL + 16640, RL_MAK = RL_ELL, RL_NRB = RL_ELL + 9216, RL_NRK = RL_ELL + 18432;
constexpr int RL_RT = 69120, RL_AT = RL_RT + 9216, RL_BT = RL_RT + 18432, RL_KT = RL_RT + 27648;
constexpr int RL_X2 = RL_AT;
constexpr int RL_BHC = 105984, RL_KHC = RL_BHC + 9216, RL_VC = RL_BHC + 18432;
constexpr int RL_X = 133632;
constexpr int RL_SM = 150272;
constexpr int RL_END = RL_SM + 512;
template <int KS> DI f32x16 mm_ll(const LAS bf16_t* a, int pa, const LAS bf16_t* b, int pb, int lane, f32x16 acc) {
    const LAS bf16_t* ap = a + (lane & 31) * pa + 8 * (lane >> 5); const LAS bf16_t* bp = b + (lane & 31) * pb + 8 * (lane >> 5);
#pragma unroll
    for (int s = 0; s < KS; ++s) acc = mfma32(*(const LAS bf16x8*)(ap + 16 * s), *(const LAS bf16x8*)(bp + 16 * s), acc);
    return acc;
}
DI void rwkv_chunk_acts(Ctx& C, int bc, int l, bf16x8 (&actv)[4]) {
    const int chunk = bc & 63, b = bc >> 6, t = C.tid >> 3, cg = C.tid & 7; const size_t row = (size_t)b * SEQ + chunk * 64 + t; const bool first = (chunk == 0 && t == 0);
    const bf16_t* proj = (const bf16_t*)(C.ws + WS_PROJ); const float* mu = C.in(6) + (size_t)l * 1792;
#pragma unroll
    for (int q = 0; q < 4; ++q) { const int c8 = cg * 32 + 8 * q;
        if (c8 < 64) actv[q] = act_frag<1>(proj, row, first, PC_WD + c8, mu + 1536 + c8); else if (c8 < 128) actv[q] = act_frag<0>(proj, row, first, PC_WD + c8, mu + 1536 + c8); else actv[q] = act_frag<2>(proj, row, first, PC_WD + c8, mu + 1536 + c8); }
}
#define LBAR() asm volatile("s_waitcnt lgkmcnt(0)\n\ts_barrier" ::: "memory")
DI void rwkv_head_item(Ctx& C, int item, int l, const bf16x8 (&actv)[4]) {
    const int h = item & 7, chunk = (item >> 3) & 63, b = item >> 9, tid = C.tid, lane = C.lane, wave = C.wave, tl = lane & 31, hi = lane >> 5;
    const size_t tok0 = (size_t)b * SEQ + chunk * 64;
    const bf16_t* proj = (const bf16_t*)(C.ws + WS_PROJ);
    const size_t chid = ((size_t)(b * 8 + h) * 64 + chunk) * 8192;
    unsigned char* PHI = C.ws + WS_PHI + chid; unsigned char* PSI = C.ws + WS_PSI + chid; unsigned char* GT = C.ws + WS_GT + chid; unsigned char* Y0T = C.ws + WS_Y0T + chid; unsigned char* GGT = C.ws + WS_GGT + chid;
    const bf16_t* WDT = (const bf16_t*)(C.ws + WS_LORA); const bf16_t* WAT = WDT + 512 * 64; const bf16_t* WGT = WAT + 512 * 64;
    const float* mu = C.in(6) + (size_t)l * 1792;
    const float* w0p = C.in(7) + l * 512 + 64 * h; const float* a0p = C.in(9) + l * 512 + 64 * h;
    const float* kkp = C.in(12) + l * 512 + 64 * h; const float* kap = C.in(13) + l * 512 + 64 * h; const float* rkp = C.in(14) + l * 512 + 64 * h;
    LAS bf16_t* ACT = (LAS bf16_t*)(C.lds + RL_ACT); LAS float* MAB = (LAS float*)(C.lds + RL_MAB); LAS bf16_t* W1C = (LAS bf16_t*)(C.lds + RL_W1C); LAS bf16_t* W2C = (LAS bf16_t*)(C.lds + RL_W2C);
    LAS float* ELL = (LAS float*)(C.lds + RL_ELL); LAS float* AV = (LAS float*)(C.lds + RL_AV);
    LAS bf16_t* MAK = (LAS bf16_t*)(C.lds + RL_MAK); LAS bf16_t* NRB = (LAS bf16_t*)(C.lds + RL_NRB); LAS bf16_t* NRK = (LAS bf16_t*)(C.lds + RL_NRK);
    LAS bf16_t* AT = (LAS bf16_t*)(C.lds + RL_AT); LAS bf16_t* RT = (LAS bf16_t*)(C.lds + RL_RT); LAS bf16_t* BT = (LAS bf16_t*)(C.lds + RL_BT); LAS bf16_t* KT = (LAS bf16_t*)(C.lds + RL_KT);
    LAS bf16_t* BHC = (LAS bf16_t*)(C.lds + RL_BHC); LAS bf16_t* KHC = (LAS bf16_t*)(C.lds + RL_KHC); LAS bf16_t* VC = (LAS bf16_t*)(C.lds + RL_VC);
    LAS float* X = (LAS float*)(C.lds + RL_X); LAS float* X2 = (LAS float*)(C.lds + RL_X2); LAS float* INV = (LAS float*)(C.lds + RL_SM); LAS float* LCv = INV + 64;
    LBAR();
#ifndef RWR12
#define RWR12 1
#define RWR4 1
#define RWR5 1
#define RWR11 1
#endif
    for (int rr_ = 0; rr_ < RWR12; ++rr_) {
    const int jp = (wave >> 1) & 1, jq = wave & 1;
    bf16x8 wfr[8];
    if (wave < 4) { const bf16_t* W = WGT + (size_t)(64 * h + 32 * jp + tl) * 128 + 8 * hi;
#pragma unroll
        for (int s = 0; s < 8; ++s) wfr[s] = *(const bf16x8*)(W + 16 * s);
    } else { const bf16_t* W0 = WDT + (size_t)(64 * h + 32 * jq + tl) * 64 + 8 * hi; const bf16_t* W1 = WAT + (size_t)(64 * h + 32 * jq + tl) * 64 + 8 * hi;
#pragma unroll
        for (int s = 0; s < 4; ++s) { wfr[s] = *(const bf16x8*)(W0 + 16 * s); wfr[4 + s] = *(const bf16x8*)(W1 + 16 * s); } }
    { const int t = tid >> 3, cg = tid & 7;
#pragma unroll
        for (int q = 0; q < 4; ++q) *(LAS bf16x8*)(ACT + t * 264 + cg * 32 + 8 * q) = actv[q]; }
    LBAR();
    if (wave < 4) {
        const LAS bf16_t* bp = ACT + (32 * jq + tl) * 264 + 128 + 8 * hi; f32x16 acc = {};
#pragma unroll
        for (int s = 0; s < 8; ++s) acc = mfma32(wfr[s], *(const LAS bf16x8*)(bp + 16 * s), acc);
        st_tile_bf16(GGT, jp * 2 + jq, lane, acc);
    } else {
        const LAS bf16_t* ap = ACT + (32 * jp + tl) * 264 + 8 * hi; f32x16 a0 = {}, a1 = {};
#pragma unroll
        for (int s = 0; s < 4; ++s) { a0 = mfma32(*(const LAS bf16x8*)(ap + 16 * s), wfr[s], a0); a1 = mfma32(*(const LAS bf16x8*)(ap + 64 + 16 * s), wfr[4 + s], a1); }
        const int ch = 32 * jq + tl; const float w0c = w0p[ch], a0c = a0p[ch];
#pragma unroll
        for (int g = 0; g < 16; ++g) { const int t = 32 * jp + crow(g, hi); ELL[t * 65 + ch] = -fexp(-fsoftplus(-(w0c + a0[g])) - 0.5f); AV[t * 65 + ch] = fsigm(a0c + a1[g]); }
    }
    LBAR();
    }
    { const int ch = tid & 63, seg = tid >> 6; float p[8]; float run = 0.f;
#pragma unroll
        for (int e = 0; e < 8; ++e) { run += ELL[(8 * seg + e) * 65 + ch]; p[e] = run; }
        X[seg * 65 + ch] = run;
        LBAR();
        float off = 0.f;
#pragma unroll
        for (int s2 = 0; s2 < 7; ++s2) off += (s2 < seg) ? X[s2 * 65 + ch] : 0.f;
#pragma unroll
        for (int e = 0; e < 8; ++e) ELL[(8 * seg + e) * 65 + ch] = off + p[e];
        if (seg == 7) LCv[ch] = off + p[7]; }
    LBAR();
    for (int rr_ = 0; rr_ < RWR4; ++rr_) {
    { const int t = tid >> 3, c0 = (tid & 7) * 8; const size_t row = tok0 + t; const bool first = (chunk == 0 && t == 0); float rho = 0.f, n2 = 0.f;
        f32x4 r4[2], k4[2], v4[2];
#pragma unroll
        for (int q = 0; q < 2; ++q) { const int c = c0 + 4 * q;
            r4[q] = shift4(proj, row, first, PC_R + 64 * h + c, mu + 64 * h + c); k4[q] = shift4(proj, row, first, PC_BK + 64 * h + c, mu + 512 + 64 * h + c); v4[q] = shift4(proj, row, first, PC_BV + 64 * h + c, mu + 1024 + 64 * h + c);
            const f32x4 kr = k4[q] * *(const f32x4*)(kkp + c); n2 += (kr.x * kr.x + kr.y * kr.y) + (kr.z * kr.z + kr.w * kr.w); }
        n2 += __shfl_xor(n2, 1); n2 += __shfl_xor(n2, 2); n2 += __shfl_xor(n2, 4);
        const float inv = 1.f / fmaxf(sqrtf(n2), 1e-12f);
        F8 vA, vR, vB, vK;
#pragma unroll
        for (int q = 0; q < 2; ++q) { const int c = c0 + 4 * q;
            const f32x4 kk4 = *(const f32x4*)(kkp + c), ka4 = *(const f32x4*)(kap + c), rk4 = *(const f32x4*)(rkp + c);
#pragma unroll
            for (int jj = 0; jj < 4; ++jj) { const int ch = c + jj; const float a = AV[t * 65 + ch], L = ELL[t * 65 + ch], Lp = t ? ELL[(t - 1) * 65 + ch] : 0.f, LC = LCv[ch];
                const float kk = k4[q][jj] * kk4[jj] * inv, kp = k4[q][jj] * (1.f + (a - 1.f) * ka4[jj]), bb = kk * a;
                const float eL = fexp(L), eN = fexp(-L), eP = fexp(Lp), eD = fexp(LC - L);
                rho += r4[q][jj] * kp * rk4[jj];
                const float xa = -kk * eP; vA[4 * q + jj] = xa; vR[4 * q + jj] = r4[q][jj] * eL; vB[4 * q + jj] = bb * eN; vK[4 * q + jj] = kp * eN;
                X[t * 65 + ch] = xa; BHC[ch * 72 + t] = (bf16_t)f2bf(bb * eD); KHC[ch * 72 + t] = (bf16_t)f2bf(kp * eD); VC[ch * 72 + t] = (bf16_t)f2bf(v4[q][jj]); } }
        *(LAS bf16x8*)(AT + t * 72 + c0) = pack8(vA); *(LAS bf16x8*)(RT + t * 72 + c0) = pack8(vR); *(LAS bf16x8*)(BT + t * 72 + c0) = pack8(vB); *(LAS bf16x8*)(KT + t * 72 + c0) = pack8(vK);
        rho += __shfl_xor(rho, 1); rho += __shfl_xor(rho, 2); rho += __shfl_xor(rho, 4);
        if ((tid & 7) == 0) ((float*)(C.ws + WS_RHO))[row * 8 + h] = rho; }
    LBAR();
    }
    for (int rr_ = 0; rr_ < RWR5; ++rr_) {
    for (int job = wave; job < 16; job += 8) {
        const int kind = job >> 2, ti = (job >> 1) & 1, tj = job & 1;
        const LAS bf16_t* a = (kind < 2 ? AT : RT) + 32 * ti * 72; const LAS bf16_t* bm = ((kind & 1) ? KT : BT) + 32 * tj * 72;
        f32x16 acc = {};
        if (!(ti == 0 && tj == 1)) acc = mm_ll<4>(a, 72, bm, 72, lane, acc);
#pragma unroll
        for (int g = 0; g < 16; ++g) { const int i = 32 * ti + crow(g, hi), j = 32 * tj + tl; const bool keep = (kind < 2) ? (j < i) : (j <= i); const float v = keep ? acc[g] : 0.f;
            if (kind == 0) MAB[i * 68 + j] = v; else (kind == 1 ? MAK : kind == 2 ? NRB : NRK)[i * 72 + j] = (bf16_t)f2bf(v); }
    }
    LBAR();
    }
    if (wave < 4) { const int ti = wave >> 1, tv = wave & 1; f32x16 acc = {}; acc = mm_ll<4>(MAK + 32 * ti * 72, 72, VC + 32 * tv * 72, 72, lane, acc);
#pragma unroll
        for (int g = 0; g < 16; ++g) X2[(32 * ti + crow(g, hi)) * 65 + 32 * tv + tl] = acc[g]; }
    LBAR();
    for (int bk = 0; bk < 4; ++bk) {
        const int r0 = 16 * bk;
        if (wave < 2) {
            LAS float* XX = wave ? X2 : X; float x[16];
#pragma unroll
            for (int i = 0; i < 16; ++i) x[i] = XX[(r0 + i) * 65 + lane];
#pragma unroll
            for (int i = 1; i < 16; ++i) { const LAS float* mr = MAB + (r0 + i) * 68 + r0; float a_ = x[i];
#pragma unroll
                for (int q = 0; q < (i + 3) / 4; ++q) { const f32x4 m4 = *(const LAS f32x4*)(mr + 4 * q);
#pragma unroll
                    for (int e = 0; e < 4; ++e) if (4 * q + e < i) a_ += m4[e] * x[4 * q + e]; }
                x[i] = a_; }
#pragma unroll
            for (int i = 1; i < 16; ++i) XX[(r0 + i) * 65 + lane] = x[i];
        }
        LBAR();
        if (bk < 3) {
            const int mat = wave >> 2, rt = (wave >> 1) & 1, ctl = wave & 1;
            if (32 * rt + 31 >= r0 + 16) {
                LAS float* XX = mat ? X2 : X;
                F8 av8, bv8;
#pragma unroll
                for (int e = 0; e < 8; ++e) { av8[e] = MAB[(32 * rt + tl) * 68 + r0 + 8 * hi + e]; bv8[e] = XX[(r0 + 8 * hi + e) * 65 + 32 * ctl + tl]; }
                f32x16 acc;
#pragma unroll
                for (int g = 0; g < 16; ++g) acc[g] = XX[(32 * rt + crow(g, hi)) * 65 + 32 * ctl + tl];
                acc = mfma32(pack8(av8), pack8(bv8), acc);
#pragma unroll
                for (int g = 0; g < 16; ++g) { const int i = 32 * rt + crow(g, hi); if (i >= r0 + 16) XX[i * 65 + 32 * ctl + tl] = acc[g]; }
            }
            LBAR();
        }
    }
    { const int k = tid >> 3, i0 = (tid & 7) * 8; F8 v, w;
#pragma unroll
        for (int e = 0; e < 8; ++e) { v[e] = X[(i0 + e) * 65 + k]; w[e] = X2[(i0 + e) * 65 + k]; }
        *(LAS bf16x8*)(W1C + k * 72 + i0) = pack8(v); *(LAS bf16x8*)(W2C + k * 72 + i0) = pack8(w); }
    LBAR();
    for (int rr_ = 0; rr_ < RWR11; ++rr_) {
    for (int job = wave; job < 16; job += 8) {
        const int kind = job >> 2, p = (job >> 1) & 1, q = job & 1; f32x16 acc = {};
        if (kind == 0) {
            acc = mm_ll<4>(W1C + 32 * p * 72, 72, NRB + 32 * q * 72, 72, lane, acc);
            FA fa;
#pragma unroll
            for (int g = 0; g < 16; ++g) fa[g] = acc[g] + bf2f(RT[(32 * q + tl) * 72 + 32 * p + crow(g, hi)]);
            st_frag(GT, (p * 2 + q) * 2 + 0, lane, packfrag(fa, 0)); st_frag(GT, (p * 2 + q) * 2 + 1, lane, packfrag(fa, 1));
        } else if (kind == 1) {
            acc = mm_ll<4>(W2C + 32 * p * 72, 72, NRB + 32 * q * 72, 72, lane, acc); acc = mm_ll<4>(VC + 32 * p * 72, 72, NRK + 32 * q * 72, 72, lane, acc);
            st_tile_bf16(Y0T, p * 2 + q, lane, acc);
        } else if (kind == 2) {
            acc = mm_ll<4>(W1C + 32 * p * 72, 72, BHC + 32 * q * 72, 72, lane, acc);
            FA fa = toFA(acc);
            if (p == q) { const float pc = fexp(LCv[32 * q + tl]);
#pragma unroll
                for (int g = 0; g < 16; ++g) if (crow(g, hi) == tl) fa[g] += pc; }
            st_frag(PHI, (p * 2 + q) * 2 + 0, lane, packfrag(fa, 0)); st_frag(PHI, (p * 2 + q) * 2 + 1, lane, packfrag(fa, 1));
        } else {
            acc = mm_ll<4>(BHC + 32 * p * 72, 72, W2C + 32 * q * 72, 72, lane, acc); acc = mm_ll<4>(KHC + 32 * p * 72, 72, VC + 32 * q * 72, 72, lane, acc);
            st_tile_bf16(PSI, p * 2 + q, lane, acc);
        }
    }
    LBAR();
    }
}

#undef LBAR
DI void rwkv_scan_wave(Ctx& C, int id) {
    const int vt = id & 1, bh = id >> 1, lane = C.lane;
    f32x16 S[2] = {{}, {}};
    for (int chunk = 0; chunk < 64; ++chunk) {
        const size_t chid = ((size_t)bh * 64 + chunk) * 8192;
        const unsigned char* PHI = C.ws + WS_PHI + chid; const unsigned char* PSI = C.ws + WS_PSI + chid; unsigned char* S0B = C.ws + WS_S0 + chid;
        bf16x8 sh[2][2], sl[2][2];
        f32x16 N[2];
#pragma unroll
        for (int ct = 0; ct < 2; ++ct) N[ct] = toV(ld_tile_bf16(PSI, ct * 2 + vt, lane));
        asm volatile("" ::: "memory");
#pragma unroll
        for (int cp = 0; cp < 2; ++cp)
#pragma unroll
            for (int s = 0; s < 2; ++s) { sh[cp][s] = packfrag(S[cp], s); st_frag(S0B, (cp * 2 + vt) * 2 + s, lane, sh[cp][s]);
                const u32x4 hw = __builtin_bit_cast(u32x4, sh[cp][s]); u32x4 lw;
#pragma unroll
                for (int q = 0; q < 4; ++q) lw[q] = pk2(S[cp][8 * s + 2 * q] - bflo(hw[q]), S[cp][8 * s + 2 * q + 1] - bfhi(hw[q]));
                sl[cp][s] = __builtin_bit_cast(bf16x8, lw); }
#pragma unroll
        for (int ct = 0; ct < 2; ++ct) {
#pragma unroll
            for (int cp = 0; cp < 2; ++cp)
#pragma unroll
                for (int s = 0; s < 2; ++s) { const bf16x8 ph = ld_frag(PHI, (cp * 2 + ct) * 2 + s, lane); N[ct] = mfma32(ph, sh[cp][s], N[ct]); N[ct] = mfma32(ph, sl[cp][s], N[ct]); } }
        S[0] = N[0]; S[1] = N[1];
    }
}

DI void rwkv_out_wave(Ctx& C, int id, int l) {
    const int chunk = id & 63, bh = id >> 6, b = bh >> 3, h = bh & 7, lane = C.lane, tl = lane & 31, hi = lane >> 5;
    const size_t chid = (size_t)id * 8192; const size_t tok0 = (size_t)b * SEQ + chunk * 64;
    const unsigned char* GT = C.ws + WS_GT + chid; const unsigned char* Y0T = C.ws + WS_Y0T + chid; const unsigned char* GGT = C.ws + WS_GGT + chid; const unsigned char* S0B = C.ws + WS_S0 + chid;
    const bf16_t* proj = (const bf16_t*)(C.ws + WS_PROJ);
    const float* mu = C.in(6) + (size_t)l * 1792; const float* gng = C.in(15) + l * 512 + 64 * h; const float* gnb = C.in(16) + l * 512 + 64 * h;
    const float* RHO = (const float*)(C.ws + WS_RHO);
    LAS unsigned char* stg = C.lds + C.wave * 9216;
    FA Y[2][2];
#pragma unroll
    for (int vt = 0; vt < 2; ++vt)
#pragma unroll
        for (int tt = 0; tt < 2; ++tt) { f32x16 acc = toV(ld_tile_bf16(Y0T, vt * 2 + tt, lane));
#pragma unroll
            for (int cp = 0; cp < 2; ++cp)
#pragma unroll
                for (int s = 0; s < 2; ++s) acc = mfma32(ld_frag(S0B, (cp * 2 + vt) * 2 + s, lane), ld_frag(GT, (cp * 2 + tt) * 2 + s, lane), acc);
            Y[vt][tt] = toFA(acc); }
#pragma unroll
    for (int tt = 0; tt < 2; ++tt) {
        float s1 = 0.f;
#pragma unroll
        for (int vt = 0; vt < 2; ++vt)
#pragma unroll
            for (int g = 0; g < 16; ++g) s1 += Y[vt][tt][g];
        s1 += __shfl_xor(s1, 32); const float mean = s1 * (1.f / 64.f);
        float s2 = 0.f;
#pragma unroll
        for (int vt = 0; vt < 2; ++vt)
#pragma unroll
            for (int g = 0; g < 16; ++g) { const float d = Y[vt][tt][g] - mean; s2 += d * d; }
        s2 += __shfl_xor(s2, 32); const float rstd = 1.f / sqrtf(s2 * (1.f / 64.f) + GN_EPS);
        const size_t row = tok0 + 32 * tt + tl; const bool first = (chunk == 0 && tt == 0 && tl == 0);
        const float rho = RHO[row * 8 + h];
#pragma unroll
        for (int vt = 0; vt < 2; ++vt) { const FA gt = ld_tile_bf16(GGT, vt * 2 + tt, lane);
#pragma unroll
            for (int i = 0; i < 4; ++i) { const int c = 32 * vt + 8 * i + 4 * hi;
                const f32x4 v4 = shift4(proj, row, first, PC_BV + 64 * h + c, mu + 1024 + 64 * h + c); const f32x4 gg = *(const f32x4*)(gng + c), gb = *(const f32x4*)(gnb + c);
                float o[4];
#pragma unroll
                for (int jj = 0; jj < 4; ++jj) { const int g = 4 * i + jj; o[jj] = ((Y[vt][tt][g] - mean) * rstd * gg[jj] + gb[jj] + rho * v4[jj]) * gt[g]; }
                u32x2 w; w.x = pk2(o[0], o[1]); w.y = pk2(o[2], o[3]); *(LAS u32x2*)(stg + (32 * tt + tl) * 144 + c * 2) = w; } }
    }
    asm volatile("s_waitcnt lgkmcnt(0)" ::: "memory");
#pragma unroll
    for (int k = 0; k < 8; ++k) { const int t = (lane >> 3) + 8 * k, cch = lane & 7; const u32x4 w = *(const LAS u32x4*)(stg + t * 144 + cch * 16);
        *(u32x4*)(C.mixcat + (tok0 + t) * D + 512 + 64 * h + cch * 8) = w; }
    asm volatile("s_waitcnt lgkmcnt(0)" ::: "memory");
}

constexpr int GB_OFF = 163840 - 256;
DI void gbar(LAS unsigned* cnt, unsigned& target, int lane) {
    asm volatile("s_waitcnt lgkmcnt(0)" ::: "memory");
    target += 4u;
    if (lane == 0) __hip_atomic_fetch_add(cnt, 1u, __ATOMIC_RELAXED, __HIP_MEMORY_SCOPE_WORKGROUP);
    while (__hip_atomic_load(cnt, __ATOMIC_RELAXED, __HIP_MEMORY_SCOPE_WORKGROUP) < target) __builtin_amdgcn_s_sleep(1);
    asm volatile("" ::: "memory");
}
DI void rwkv_chunk_acts4(Ctx& C, int bc, int l, bf16x8 (&actv)[8]) {
    const int chunk = bc & 63, b = bc >> 6, t = C.tid >> 2, cg = C.tid & 3; const size_t row = (size_t)b * SEQ + chunk * 64 + t; const bool first = (chunk == 0 && t == 0);
    const bf16_t* proj = (const bf16_t*)(C.ws + WS_PROJ); const float* mu = C.in(6) + (size_t)l * 1792;
#pragma unroll
    for (int q = 0; q < 8; ++q) { const int c8 = cg * 64 + 8 * q;
        if (c8 < 64) actv[q] = act_frag<1>(proj, row, first, PC_WD + c8, mu + 1536 + c8); else if (c8 < 128) actv[q] = act_frag<0>(proj, row, first, PC_WD + c8, mu + 1536 + c8); else actv[q] = act_frag<2>(proj, row, first, PC_WD + c8, mu + 1536 + c8); }
}
#ifndef RW4_12
#define RW4_12 1
#endif
#ifndef RW4_4
#define RW4_4 1
#endif
#ifndef RW4_5
#define RW4_5 1
#endif
#ifndef RW4_11
#define RW4_11 1
#endif
#define GBA() gbar(gcnt, gtarget, lane)
DI void rwkv_head_item4(Ctx& C, int item, int l, const bf16x8 (&actv)[8], LAS unsigned* gcnt, unsigned& gtarget) {
    const int h = item & 7, chunk = (item >> 3) & 63, b = item >> 9, tid = C.tid, lane = C.lane, wave = C.wave, tl = lane & 31, hi = lane >> 5;
    const size_t tok0 = (size_t)b * SEQ + chunk * 64;
    const bf16_t* proj = (const bf16_t*)(C.ws + WS_PROJ);
    const size_t chid = ((size_t)(b * 8 + h) * 64 + chunk) * 8192;
    unsigned char* PHI = C.ws + WS_PHI + chid; unsigned char* PSI = C.ws + WS_PSI + chid; unsigned char* GT = C.ws + WS_GT + chid; unsigned char* Y0T = C.ws + WS_Y0T + chid; unsigned char* GGT = C.ws + WS_GGT + chid;
    const bf16_t* WDT = (const bf16_t*)(C.ws + WS_LORA); const bf16_t* WAT = WDT + 512 * 64; const bf16_t* WGT = WAT + 512 * 64;
    const float* mu = C.in(6) + (size_t)l * 1792;
    const float* w0p = C.in(7) + l * 512 + 64 * h; const float* a0p = C.in(9) + l * 512 + 64 * h;
    const float* kkp = C.in(12) + l * 512 + 64 * h; const float* kap = C.in(13) + l * 512 + 64 * h; const float* rkp = C.in(14) + l * 512 + 64 * h;
    LAS bf16_t* ACT = (LAS bf16_t*)(C.lds + RL_ACT); LAS float* MAB = (LAS float*)(C.lds + RL_MAB); LAS bf16_t* W1C = (LAS bf16_t*)(C.lds + RL_W1C); LAS bf16_t* W2C = (LAS bf16_t*)(C.lds + RL_W2C);
    LAS float* ELL = (LAS float*)(C.lds + RL_ELL); LAS float* AV = (LAS float*)(C.lds + RL_AV);
    LAS bf16_t* MAK = (LAS bf16_t*)(C.lds + RL_MAK); LAS bf16_t* NRB = (LAS bf16_t*)(C.lds + RL_NRB); LAS bf16_t* NRK = (LAS bf16_t*)(C.lds + RL_NRK);
    LAS bf16_t* AT = (LAS bf16_t*)(C.lds + RL_AT); LAS bf16_t* RT = (LAS bf16_t*)(C.lds + RL_RT); LAS bf16_t* BT = (LAS bf16_t*)(C.lds + RL_BT); LAS bf16_t* KT = (LAS bf16_t*)(C.lds + RL_KT);
    LAS bf16_t* BHC = (LAS bf16_t*)(C.lds + RL_BHC); LAS bf16_t* KHC = (LAS bf16_t*)(C.lds + RL_KHC); LAS bf16_t* VC = (LAS bf16_t*)(C.lds + RL_VC);
    LAS float* X = (LAS float*)(C.lds + RL_X); LAS float* X2 = (LAS float*)(C.lds + RL_X2); LAS float* LCv = (LAS float*)(C.lds + RL_SM) + 64;
    GBA();
    for (int r_RW4_12 = 0; r_RW4_12 < RW4_12; ++r_RW4_12) { asm volatile("" ::: "memory");
    const int jp = (wave >> 1) & 1, jq = wave & 1;
    bf16x8 wg[8], wd[8];
    { const bf16_t* W = WGT + (size_t)(64 * h + 32 * jp + tl) * 128 + 8 * hi; const bf16_t* W0 = WDT + (size_t)(64 * h + 32 * jq + tl) * 64 + 8 * hi; const bf16_t* W1 = WAT + (size_t)(64 * h + 32 * jq + tl) * 64 + 8 * hi;
#pragma unroll
        for (int s = 0; s < 8; ++s) wg[s] = *(const bf16x8*)(W + 16 * s);
#pragma unroll
        for (int s = 0; s < 4; ++s) { wd[s] = *(const bf16x8*)(W0 + 16 * s); wd[4 + s] = *(const bf16x8*)(W1 + 16 * s); } }
    { const int t = tid >> 2, cg = tid & 3;
#pragma unroll
        for (int q = 0; q < 8; ++q) *(LAS bf16x8*)(ACT + t * 264 + cg * 64 + 8 * q) = actv[q]; }
    GBA();
    {
        const LAS bf16_t* bp = ACT + (32 * jq + tl) * 264 + 128 + 8 * hi; f32x16 acc = {};
#pragma unroll
        for (int s = 0; s < 8; ++s) acc = mfma32(wg[s], *(const LAS bf16x8*)(bp + 16 * s), acc);
        st_tile_bf16(GGT, jp * 2 + jq, lane, acc);
        const LAS bf16_t* ap = ACT + (32 * jp + tl) * 264 + 8 * hi; f32x16 a0 = {}, a1 = {};
#pragma unroll
        for (int s = 0; s < 4; ++s) { a0 = mfma32(*(const LAS bf16x8*)(ap + 16 * s), wd[s], a0); a1 = mfma32(*(const LAS bf16x8*)(ap + 64 + 16 * s), wd[4 + s], a1); }
        const int ch = 32 * jq + tl; const float w0c = w0p[ch], a0c = a0p[ch];
#pragma unroll
        for (int g = 0; g < 16; ++g) { const int t = 32 * jp + crow(g, hi); ELL[t * 65 + ch] = -fexp(-fsoftplus(-(w0c + a0[g])) - 0.5f); AV[t * 65 + ch] = fsigm(a0c + a1[g]); }
    }
    GBA();
    }
    { const int ch = tid & 63, seg = tid >> 6; float p[16]; float run = 0.f;
#pragma unroll
        for (int e = 0; e < 16; ++e) { run += ELL[(16 * seg + e) * 65 + ch]; p[e] = run; }
        X[seg * 65 + ch] = run;
        GBA();
        float off = 0.f;
#pragma unroll
        for (int s2 = 0; s2 < 3; ++s2) off += (s2 < seg) ? X[s2 * 65 + ch] : 0.f;
#pragma unroll
        for (int e = 0; e < 16; ++e) ELL[(16 * seg + e) * 65 + ch] = off + p[e];
        if (seg == 3) LCv[ch] = off + p[15]; }
    GBA();
    for (int r_RW4_4 = 0; r_RW4_4 < RW4_4; ++r_RW4_4) { asm volatile("" ::: "memory");
#pragma unroll 1
    for (int pass = 0; pass < 2; ++pass) { const int e_ = tid + 256 * pass; const int t = e_ >> 3, c0 = (e_ & 7) * 8; const size_t row = tok0 + t; const bool first = (chunk == 0 && t == 0); float rho = 0.f, n2 = 0.f;
        f32x4 r4[2], k4[2], v4[2];
#pragma unroll
        for (int q = 0; q < 2; ++q) { const int c = c0 + 4 * q;
            r4[q] = shift4(proj, row, first, PC_R + 64 * h + c, mu + 64 * h + c); k4[q] = shift4(proj, row, first, PC_BK + 64 * h + c, mu + 512 + 64 * h + c); v4[q] = shift4(proj, row, first, PC_BV + 64 * h + c, mu + 1024 + 64 * h + c);
            const f32x4 kr = k4[q] * *(const f32x4*)(kkp + c); n2 += (kr.x * kr.x + kr.y * kr.y) + (kr.z * kr.z + kr.w * kr.w); }
        n2 += __shfl_xor(n2, 1); n2 += __shfl_xor(n2, 2); n2 += __shfl_xor(n2, 4);
        const float inv = 1.f / fmaxf(sqrtf(n2), 1e-12f);
        F8 vA, vR, vB, vK;
#pragma unroll
        for (int q = 0; q < 2; ++q) { const int c = c0 + 4 * q;
            const f32x4 kk4 = *(const f32x4*)(kkp + c), ka4 = *(const f32x4*)(kap + c), rk4 = *(const f32x4*)(rkp + c);
#pragma unroll
            for (int jj = 0; jj < 4; ++jj) { const int ch = c + jj; const float a = AV[t * 65 + ch], L = ELL[t * 65 + ch], Lp = t ? ELL[(t - 1) * 65 + ch] : 0.f, LC = LCv[ch];
                const float kk = k4[q][jj] * kk4[jj] * inv, kp = k4[q][jj] * (1.f + (a - 1.f) * ka4[jj]), bb = kk * a;
                const float eL = fexp(L), eN = fexp(-L), eP = fexp(Lp), eD = fexp(LC - L);
                rho += r4[q][jj] * kp * rk4[jj];
                const float xa = -kk * eP; vA[4 * q + jj] = xa; vR[4 * q + jj] = r4[q][jj] * eL; vB[4 * q + jj] = bb * eN; vK[4 * q + jj] = kp * eN;
                X[t * 65 + ch] = xa; BHC[ch * 72 + t] = (bf16_t)f2bf(bb * eD); KHC[ch * 72 + t] = (bf16_t)f2bf(kp * eD); VC[ch * 72 + t] = (bf16_t)f2bf(v4[q][jj]); } }
        *(LAS bf16x8*)(AT + t * 72 + c0) = pack8(vA); *(LAS bf16x8*)(RT + t * 72 + c0) = pack8(vR); *(LAS bf16x8*)(BT + t * 72 + c0) = pack8(vB); *(LAS bf16x8*)(KT + t * 72 + c0) = pack8(vK);
        rho += __shfl_xor(rho, 1); rho += __shfl_xor(rho, 2); rho += __shfl_xor(rho, 4);
        if ((tid & 7) == 0) ((float*)(C.ws + WS_RHO))[row * 8 + h] = rho; }
    GBA();
    }
    for (int r_RW4_5 = 0; r_RW4_5 < RW4_5; ++r_RW4_5) { asm volatile("" ::: "memory");
#pragma unroll
    for (int kind = 0; kind < 4; ++kind) {
        const int ti = (wave >> 1) & 1, tj = wave & 1;
        const LAS bf16_t* a = (kind < 2 ? AT : RT) + 32 * ti * 72; const LAS bf16_t* bm = ((kind & 1) ? KT : BT) + 32 * tj * 72;
        f32x16 acc = {};
        if (!(ti == 0 && tj == 1)) acc = mm_ll<4>(a, 72, bm, 72, lane, acc);
#pragma unroll
        for (int g = 0; g < 16; ++g) { const int i = 32 * ti + crow(g, hi), j = 32 * tj + tl; const bool keep = (kind < 2) ? (j < i) : (j <= i); const float v = keep ? acc[g] : 0.f;
            if (kind == 0) MAB[i * 68 + j] = v; else (kind == 1 ? MAK : kind == 2 ? NRB : NRK)[i * 72 + j] = (bf16_t)f2bf(v); }
    }
    GBA();
    }
    { const int ti = wave >> 1, tv = wave & 1; f32x16 acc = {}; acc = mm_ll<4>(MAK + 32 * ti * 72, 72, VC + 32 * tv * 72, 72, lane, acc);
#pragma unroll
        for (int g = 0; g < 16; ++g) X2[(32 * ti + crow(g, hi)) * 65 + 32 * tv + tl] = acc[g]; }
    GBA();
    for (int bk = 0; bk < 4; ++bk) {
        const int r0 = 16 * bk;
        if (wave < 2) {
            LAS float* XX = wave ? X2 : X; float x[16];
#pragma unroll
            for (int i = 0; i < 16; ++i) x[i] = XX[(r0 + i) * 65 + lane];
#pragma unroll
            for (int i = 1; i < 16; ++i) { const LAS float* mr = MAB + (r0 + i) * 68 + r0; float a_ = x[i];
#pragma unroll
                for (int q = 0; q < (i + 3) / 4; ++q) { const f32x4 m4 = *(const LAS f32x4*)(mr + 4 * q);
#pragma unroll
                    for (int e = 0; e < 4; ++e) if (4 * q + e < i) a_ += m4[e] * x[4 * q + e]; }
                x[i] = a_; }
#pragma unroll
            for (int i = 1; i < 16; ++i) XX[(r0 + i) * 65 + lane] = x[i];
        }
        GBA();
        if (bk < 3) {
            for (int tq = wave; tq < 8; tq += 4) { const int mat = tq >> 2, rt = (tq >> 1) & 1, ctl = tq & 1;
                if (32 * rt + 31 >= r0 + 16) {
                    LAS float* XX = mat ? X2 : X;
                    F8 av8, bv8;
#pragma unroll
                    for (int e = 0; e < 8; ++e) { av8[e] = MAB[(32 * rt + tl) * 68 + r0 + 8 * hi + e]; bv8[e] = XX[(r0 + 8 * hi + e) * 65 + 32 * ctl + tl]; }
                    f32x16 acc;
#pragma unroll
                    for (int g = 0; g < 16; ++g) acc[g] = XX[(32 * rt + crow(g, hi)) * 65 + 32 * ctl + tl];
                    acc = mfma32(pack8(av8), pack8(bv8), acc);
#pragma unroll
                    for (int g = 0; g < 16; ++g) { const int i = 32 * rt + crow(g, hi); if (i >= r0 + 16) XX[i * 65 + 32 * ctl + tl] = acc[g]; }
                } }
            GBA();
        }
    }
#pragma unroll 1
    for (int pass = 0; pass < 2; ++pass) { const int e_ = tid + 256 * pass; const int k = e_ >> 3, i0 = (e_ & 7) * 8; F8 v, w;
#pragma unroll
        for (int e = 0; e < 8; ++e) { v[e] = X[(i0 + e) * 65 + k]; w[e] = X2[(i0 + e) * 65 + k]; }
        *(LAS bf16x8*)(W1C + k * 72 + i0) = pack8(v); *(LAS bf16x8*)(W2C + k * 72 + i0) = pack8(w); }
    GBA();
    for (int r_11 = 0; r_11 < RW4_11; ++r_11) { asm volatile("" ::: "memory");
#pragma unroll
    for (int kind = 0; kind < 4; ++kind) {
        const int p = (wave >> 1) & 1, q = wave & 1; f32x16 acc = {};
        if (kind == 0) {
            acc = mm_ll<4>(W1C + 32 * p * 72, 72, NRB + 32 * q * 72, 72, lane, acc);
            FA fa;
#pragma unroll
            for (int g = 0; g < 16; ++g) fa[g] = acc[g] + bf2f(RT[(32 * q + tl) * 72 + 32 * p + crow(g, hi)]);
            st_frag(GT, (p * 2 + q) * 2 + 0, lane, packfrag(fa, 0)); st_frag(GT, (p * 2 + q) * 2 + 1, lane, packfrag(fa, 1));
        } else if (kind == 1) {
            acc = mm_ll<4>(W2C + 32 * p * 72, 72, NRB + 32 * q * 72, 72, lane, acc); acc = mm_ll<4>(VC + 32 * p * 72, 72, NRK + 32 * q * 72, 72, lane, acc);
            st_tile_bf16(Y0T, p * 2 + q, lane, acc);
        } else if (kind == 2) {
            acc = mm_ll<4>(W1C + 32 * p * 72, 72, BHC + 32 * q * 72, 72, lane, acc);
            FA fa = toFA(acc);
            if (p == q) { const float pc = fexp(LCv[32 * q + tl]);
#pragma unroll
                for (int g = 0; g < 16; ++g) if (crow(g, hi) == tl) fa[g] += pc; }
            st_frag(PHI, (p * 2 + q) * 2 + 0, lane, packfrag(fa, 0)); st_frag(PHI, (p * 2 + q) * 2 + 1, lane, packfrag(fa, 1));
        } else {
            acc = mm_ll<4>(BHC + 32 * p * 72, 72, W2C + 32 * q * 72, 72, lane, acc); acc = mm_ll<4>(KHC + 32 * p * 72, 72, VC + 32 * q * 72, 72, lane, acc);
            st_tile_bf16(PSI, p * 2 + q, lane, acc);
        }
    }
    }
}
#undef GBA

typedef float f32x2 __attribute__((ext_vector_type(2)));
constexpr int IX4 = RL_END, IX4_CAP = 256;
#ifndef IX_PF
#define IX_PF 2
#endif
#ifndef IXR_SEL
#define IXR_SEL 1
#endif
#define GBB() gbar(gcnt, gtarget, lane)
DI void ld_ktile(const _Float16* kbase, int kt, int ktmax, f16x8 (&d)[4]) {
    const _Float16* p = kbase + (size_t)(32 * min(kt, ktmax)) * PLD;
#pragma unroll
    for (int s = 0; s < 4; ++s) d[s] = *(const f16x8*)(p + 16 * s);
}
DI void idx_item4(Ctx& C, int item, int l, const int ixb, LAS unsigned* gcnt, unsigned& gtarget) {
    const int b = item & 3, qt = 1023 - (item >> 2);
    const int t0 = qt * 4, chunk = t0 >> 6, NT32 = 2 * (chunk + 1);
    const size_t tok0 = (size_t)b * SEQ + t0;
    unsigned* bm = (unsigned*)(C.ws + WS_BM);
    int lane = C.lane, wave = C.wave & 3, tid = C.tid & 255;
    asm volatile("" : "+v"(lane), "+v"(tid), "+s"(wave));
    if (chunk < 4) {
        if (tid < 4 * NT32) { const int q = tid / NT32, kt = tid % NT32; bm[(tok0 + q) * 128 + kt] = 0xffffffffu; }
        return;
    }
    const _Float16* ph = (const _Float16*)(C.ws + WS_PROJ);
    LAS unsigned* hist = (LAS unsigned*)(C.lds + ixb);
    LAS float* cand = (LAS float*)(C.lds + ixb + 4096);
    LAS float* redmn = (LAS float*)(C.lds + ixb + 4096 + 8 * IX4_CAP * 4);
    LAS float* redmx = redmn + 16;
    LAS unsigned* ccount = (LAS unsigned*)(redmx + 16);
    LAS float* thrS = (LAS float*)(ccount + 4);
    LAS int* thrI = (LAS int*)(thrS + 4);
    LAS unsigned* ovf = (LAS unsigned*)(thrI + 4);
    LAS unsigned* fbT = ovf + 4;
    LAS unsigned* fbCnt = fbT + 4;
    LAS unsigned* fbNeed = fbCnt + 4;
    const int r = lane & 31, hh = lane >> 5;
    float sc[32][2];
    {
        f16x8 afr[4]; float wq[2][8];
        {
            const int gq = (r >> 2) & 1, i = r >> 3, jj = r & 3, query = 2 * gq + (i >> 1), head = 4 * (i & 1) + jj;
            const _Float16* qp = ph + (tok0 + query) * PLD + PC_QI + head * 64 + 8 * hh;
#pragma unroll
            for (int s = 0; s < 4; ++s) afr[s] = *(const f16x8*)(qp + 16 * s);
#pragma unroll
            for (int qq = 0; qq < 2; ++qq) { const int q2 = 2 * hh + qq; const f16x8 wv = *(const f16x8*)(ph + (tok0 + q2) * PLD + PC_WI);
#pragma unroll
                for (int e = 0; e < 8; ++e) wq[qq][e] = (float)wv[e] * 0.044194173824159216f; }
        }
        const _Float16* kbase = ph + ((size_t)b * SEQ + r) * PLD + PC_KI + 8 * hh;
        f16x8 bq[IX_PF][4];
#pragma unroll
        for (int d = 0; d < IX_PF - 1; ++d) ld_ktile(kbase, wave + 4 * d, NT32 - 1, bq[d]);
#pragma unroll
        for (int it = 0; it < 32; ++it) {
            const int kt = wave + 4 * it;
            if (kt < NT32) {
                if (kt + 4 * (IX_PF - 1) < NT32) ld_ktile(kbase, kt + 4 * (IX_PF - 1), NT32 - 1, bq[(it + IX_PF - 1) % IX_PF]);
                f32x16 c = {};
#pragma unroll
                for (int s = 0; s < 4; ++s) c = __builtin_amdgcn_mfma_f32_32x32x16_f16(afr[s], bq[it % IX_PF][s], c, 0, 0, 0);
#pragma unroll
                for (int qq = 0; qq < 2; ++qq) { float a = 0.f;
#pragma unroll
                    for (int e = 0; e < 8; ++e) a += wq[qq][e] * fmaxf(c[8 * qq + e], 0.f);
                    sc[it][qq] = a; }
            } else { sc[it][0] = -3.0e38f; sc[it][1] = -3.0e38f; }
        }
    }
    for (int rl_ = 0; rl_ < IXR_SEL; ++rl_) { asm volatile("" ::: "memory");
    float mn[2], mx[2];
#pragma unroll
    for (int qq = 0; qq < 2; ++qq) { float me = -3.0e38f, mo = -3.0e38f;
#pragma unroll
        for (int it = 0; it < 32; it += 2) { me = fmaxf(me, sc[it][qq]); mo = fmaxf(mo, sc[it + 1][qq]); }
        float a = fminf(me, mo), z = fmaxf(me, mo);
#pragma unroll
        for (int o = 1; o < 32; o <<= 1) { a = fminf(a, __shfl_xor(a, o)); z = fmaxf(z, __shfl_xor(z, o)); }
        mn[qq] = a; mx[qq] = z; }
    if (r == 0) {
#pragma unroll
        for (int qq = 0; qq < 2; ++qq) { const int qid = 2 * hh + qq; redmn[wave * 4 + qid] = mn[qq]; redmx[wave * 4 + qid] = mx[qq]; }
    }
    { u32x4 z4 = {0u, 0u, 0u, 0u}; *(LAS u32x4*)(hist + 4 * tid) = z4; }
    if (tid < 4) { ccount[tid] = 0u; ovf[tid] = 0u; }
    GBB();
    unsigned pk[2][8];
#pragma unroll
    for (int qq = 0; qq < 2; ++qq) { const int qid = 2 * hh + qq; float a = 3.0e38f, z = -3.0e38f;
#pragma unroll
        for (int w = 0; w < 4; ++w) { a = fminf(a, redmn[w * 4 + qid]); z = fmaxf(z, redmx[w * 4 + qid]); }
        const float scl = (z > a) ? fminf(253.f / (z - a), 1.0e30f) : 1.f; const float nlo = 1.5f - a * scl;
#pragma unroll
        for (int g8 = 0; g8 < 8; ++g8) { unsigned p = 0u;
            if (wave + 16 * g8 < NT32) {
#pragma unroll
                for (int e = 0; e < 4; ++e) p = __builtin_amdgcn_cvt_pk_u8_f32(__builtin_amdgcn_fmed3f(__builtin_fmaf(sc[4 * g8 + e][qq], scl, nlo), 0.f, 255.f), e, p);
#pragma unroll
                for (int e = 0; e < 4; ++e) { const unsigned pb = (p >> (8 * e)) & 255u; if (pb) __hip_atomic_fetch_add(hist + qid * 256 + pb, 1u, __ATOMIC_RELAXED, __HIP_MEMORY_SCOPE_WORKGROUP); }
            }
            pk[qq][g8] = p; } }
    GBB();
    int B[2]; unsigned above[2];
#pragma unroll
    for (int qq = 0; qq < 2; ++qq) { const int qid = 2 * hh + qq;
        const u32x4 h0 = *(const LAS u32x4*)(hist + qid * 256 + 8 * r), h1 = *(const LAS u32x4*)(hist + qid * 256 + 8 * r + 4);
        const unsigned tot = (h0.x + h0.y) + (h0.z + h0.w) + (h1.x + h1.y) + (h1.z + h1.w); unsigned incl = tot;
#pragma unroll
        for (int o = 1; o < 32; o <<= 1) { const unsigned v = __shfl_down(incl, o, 32); if (r + o < 32) incl += v; }
        unsigned run = incl - tot; int Bf = -1; unsigned ab = 0; const unsigned hv8[8] = {h0.x, h0.y, h0.z, h0.w, h1.x, h1.y, h1.z, h1.w};
#pragma unroll
        for (int j = 7; j >= 0; --j) { const unsigned hv = hv8[j]; if (run < 256u && run + hv >= 256u) { Bf = 8 * r + j; ab = run; } run += hv; }
        const unsigned long long mk = __ballot(Bf >= 0);
        const unsigned mh = hh ? (unsigned)(mk >> 32) : (unsigned)mk;
        const int src = 32 * hh + (mh ? __builtin_ctz(mh) : 0);
        B[qq] = __shfl(Bf, src); above[qq] = (unsigned)__shfl((int)ab, src); }
#define IX_PB(it, qq) ((int)((pk[qq][(it) >> 2] >> (8 * ((it) & 3))) & 255u))
#define IX_LAUNDER() do { _Pragma("unroll") for (int it_ = 0; it_ < 32; ++it_) { asm volatile("" : "+v"(sc[it_][0]), "+v"(sc[it_][1])); } asm volatile("" : "+v"(B[0]), "+v"(B[1])); } while (0)
#pragma unroll
    for (int qq = 0; qq < 2; ++qq) { const int qid = 2 * hh + qq;
#pragma unroll
        for (int g8 = 0; g8 < 8; ++g8) if (wave + 16 * g8 < NT32) {
#pragma unroll
            for (int e = 0; e < 4; ++e) { const int it = 4 * g8 + e; const bool hit = (IX_PB(it, qq) == B[qq]);
                if (__any(hit)) { if (hit) { const unsigned pos = __hip_atomic_fetch_add(ccount + qid, 1u, __ATOMIC_RELAXED, __HIP_MEMORY_SCOPE_WORKGROUP);
                    if (pos < (unsigned)IX4_CAP) { f32x2 cv; cv.x = sc[it][qq]; cv.y = __builtin_bit_cast(float, 32 * (wave + 4 * it) + r); *(LAS f32x2*)(cand + (qid * IX4_CAP + pos) * 2) = cv; } } } } } }
    GBB();
    {
        const int c = (int)ccount[wave];
        const unsigned abq = (wave & 1) ? above[1] : above[0];
        const int need = 256 - (int)__shfl((int)abq, 32 * (wave >> 1));
        if (c <= IX4_CAP) {
            LAS float* cw = cand + wave * IX4_CAP * 2;
            if ((c & 1) && lane == 0) { f32x2 cv; cv.x = -3.0e38f; cv.y = __builtin_bit_cast(float, 0x7fffffff); *(LAS f32x2*)(cw + 2 * c) = cv; }
            asm volatile("" ::: "memory");
            for (int i = lane; i < c; i += 64) { const f32x2 ci = *(const LAS f32x2*)(cw + 2 * i); const float si = ci.x; const int ii = __float_as_int(ci.y); int rank = 0;
                for (int j = 0; j < c; j += 2) { const f32x4 cj = *(const LAS f32x4*)(cw + 2 * j);
                    rank += ((cj.x > si) || (cj.x == si && __float_as_int(cj.y) < ii)) ? 1 : 0; rank += ((cj.z > si) || (cj.z == si && __float_as_int(cj.w) < ii)) ? 1 : 0; }
                if (rank == need - 1) { thrS[wave] = si; thrI[wave] = ii; } }
        } else if (lane == 0) { ovf[wave] = 1u; fbNeed[wave] = (unsigned)need; fbT[wave] = 0u; }
    }
    GBB();
    unsigned anyovf = 0u;
#pragma unroll
    for (int q = 0; q < 4; ++q) anyovf |= ovf[q];
#ifndef IX_NOFB
#define IX_NOFB 0
#endif
    if (anyovf && !IX_NOFB) {
        for (int bit = 31; bit >= 0; --bit) {
            if (tid < 4) fbCnt[tid] = 0u;
            GBB();
            IX_LAUNDER();
#pragma unroll
            for (int qq = 0; qq < 2; ++qq) { const int qid = 2 * hh + qq; if (ovf[qid]) { const unsigned cd = fbT[qid] | (1u << bit); unsigned cnt = 0;
#pragma unroll
                for (int it = 0; it < 32; ++it) cnt += (IX_PB(it, qq) == B[qq] && ordkey(sc[it][qq]) >= cd) ? 1u : 0u;
                if (cnt) __hip_atomic_fetch_add(fbCnt + qid, cnt, __ATOMIC_RELAXED, __HIP_MEMORY_SCOPE_WORKGROUP); } }
            GBB();
            if (tid < 4 && ovf[tid] && fbCnt[tid] >= fbNeed[tid]) fbT[tid] |= (1u << bit);
            GBB();
        }
        if (tid < 4) fbCnt[tid] = 0u;
        GBB();
        IX_LAUNDER();
#pragma unroll
        for (int qq = 0; qq < 2; ++qq) { const int qid = 2 * hh + qq; if (ovf[qid]) { const unsigned Tk = fbT[qid]; unsigned cnt = 0;
#pragma unroll
            for (int it = 0; it < 32; ++it) cnt += (IX_PB(it, qq) == B[qq] && ordkey(sc[it][qq]) > Tk) ? 1u : 0u;
            if (cnt) __hip_atomic_fetch_add(fbCnt + qid, cnt, __ATOMIC_RELAXED, __HIP_MEMORY_SCOPE_WORKGROUP); } }
        GBB();
        if (tid < 4 && ovf[tid]) { fbNeed[tid] -= fbCnt[tid]; thrS[tid] = unordkey(fbT[tid]); thrI[tid] = 0; }
        GBB();
        for (int bit = 11; bit >= 0; --bit) {
            if (tid < 4) fbCnt[tid] = 0u;
            GBB();
            IX_LAUNDER();
#pragma unroll
            for (int qq = 0; qq < 2; ++qq) { const int qid = 2 * hh + qq; if (ovf[qid]) { const unsigned Tk = fbT[qid]; const int cd = thrI[qid] | (1 << bit); unsigned cnt = 0;
#pragma unroll
                for (int it = 0; it < 32; ++it) cnt += (IX_PB(it, qq) == B[qq] && ordkey(sc[it][qq]) == Tk && (32 * (wave + 4 * it) + r) < cd) ? 1u : 0u;
                if (cnt) __hip_atomic_fetch_add(fbCnt + qid, cnt, __ATOMIC_RELAXED, __HIP_MEMORY_SCOPE_WORKGROUP); } }
            GBB();
            if (tid < 4 && ovf[tid] && fbCnt[tid] < fbNeed[tid]) thrI[tid] |= (1 << bit);
            GBB();
        }
    }
#pragma unroll
    for (int qq = 0; qq < 2; ++qq) { const int qid = 2 * hh + qq; const float ts = thrS[qid]; const int ti = thrI[qid] - 32 * wave - r;
        unsigned myw = 0u;
#pragma unroll
        for (int g8 = 0; g8 < 8; ++g8) if (wave + 16 * g8 < NT32) {
#pragma unroll
            for (int e = 0; e < 4; ++e) { const int it = 4 * g8 + e; const float s = sc[it][qq];
                const bool sel = (s > ts) | ((s == ts) & (128 * it <= ti));
                const unsigned long long mk = __builtin_amdgcn_ballot_w64(sel);
                const unsigned wv = hh ? (unsigned)(mk >> 32) : (unsigned)mk;
                if (r == it) myw = wv; } }
        if (wave + 4 * r < NT32) bm[(tok0 + qid) * 128 + wave + 4 * r] = myw; }
    }
#undef IX_PB
#undef IX_LAUNDER
}
#undef GBB

constexpr int NCV_GU = 4096, NCV_DN = 2048, NCV_PG = 512, NCV_PL = 128, NCV = NCV_GU + NCV_DN + NCV_PG + NCV_PL;
DI void conv_flat_item(Ctx& C, int l, int w, LAS float* scr) {
    if (w < NCV_GU) { ColGateUp c{C.in(20) + (size_t)l * NEXP * D * DEXP, C.in(21) + (size_t)l * NEXP * D * DEXP}; transpose_item(c, DEXP, D, (bf16_t*)(C.ws + WS_WEXP), 32 * (w & 255), 64 * (w >> 8), scr, C.lane); return; }
    w -= NCV_GU;
    if (w < NCV_DN) { const int e = w >> 7, r = w & 127; ColDown c{C.in(22) + ((size_t)l * NEXP + e) * DEXP * D}; transpose_item(c, D, DEXP, (bf16_t*)(C.ws + WS_WDOWN) + (size_t)e * D * DEXP, 32 * (r & 31), 64 * (r >> 5), scr, C.lane); return; }
    w -= NCV_DN;
    if (w < NCV_PG) { ColPlain c{C.in(24) + (size_t)l * D * D}; transpose_item(c, D, D, (bf16_t*)(C.ws + WS_WPG), 32 * (w & 31), 64 * (w >> 5), scr, C.lane); return; }
    w -= NCV_PG;
    { ColPlain c{C.in(23) + (size_t)l * PLE * D}; transpose_item(c, D, PLE, (bf16_t*)(C.ws + WS_WPLE), 32 * (w & 31), 64 * (w >> 5), scr, C.lane); }
}
DI void phase_ln_router(Ctx& C, int l) {
    const bf16_t* V = (const bf16_t*)(C.ws + WS_V);
    const float* g = C.in(25) + (size_t)l * D; const float* bta = C.in(26) + (size_t)l * D;
    const float* wr = C.in(18); const float* br = C.in(19);
    LAS unsigned* lcnt = (LAS unsigned*)C.lds; LAS unsigned* base = lcnt + 16; LAS int* rec = (LAS int*)(C.lds + 128);
    TokInfo* tok = (TokInfo*)(C.ws + WS_TOK); RowInfo* rowi = (RowInfo*)(C.ws + WS_ROW);
    unsigned* gcnt = C.ctl + CW_GCNT + 64 * l;
    for (int i = C.blk * NTHR + C.tid; i < MAXROWS; i += C.G * NTHR) { RowInfo ri; ri.token = -1; ri.slot = 0; ri.gate = 0.f; ri.pad = 0; rowi[i] = ri; }
    LAS float* wT = (LAS float*)(C.lds + 4096);
    __syncthreads();
    for (int i = C.tid; i < D * 16; i += NTHR) { const int d = i >> 4, e = i & 15; wT[e * D + d] = wr[i]; }
    const int cgw = C.blk * NWAVES + C.wave, cNGW = C.G * NWAVES; LAS float* cscr = (LAS float*)(C.lds + 70656 + C.wave * 8448);
    for (int rb = C.blk; rb < T / 64; rb += C.G) {
        __syncthreads();
        if (C.tid < 16) lcnt[C.tid] = 0u;
        __syncthreads();
#pragma unroll 1
        for (int i4 = 0; i4 < 8; i4 += 2) {
          const int cw_ = cgw + (i4 >> 1) * cNGW; const bool cdo_ = (rb == C.blk) && cw_ < NCV;
          if (cdo_ && C.wave >= 4) conv_flat_item(C, l, cw_, cscr);
          f32x4 vv[8]; float lgg[32];
          { u32x2 raw[8];
#pragma unroll
            for (int r = 0; r < 2; ++r)
#pragma unroll
                for (int j = 0; j < 4; ++j) raw[4 * r + j] = *(const u32x2*)(V + ((size_t)rb * 64 + C.wave * 8 + i4 + r) * D + 256 * j + 4 * C.lane);
#pragma unroll
            for (int r = 0; r < 2; ++r) { f32x4 t[4];
#pragma unroll
                for (int j = 0; j < 4; ++j) { const u32x2 o = raw[4 * r + j]; t[j] = (f32x4){bflo(o.x), bfhi(o.x), bflo(o.y), bfhi(o.y)}; }
                ln16(t, g, bta, C.lane);
                store_row_bf16(C.xcur + ((size_t)rb * 64 + C.wave * 8 + i4 + r) * D, t, C.lane);
#pragma unroll
                for (int j = 0; j < 4; ++j) vv[4 * r + j] = t[j]; } }
#pragma unroll
          for (int k = 0; k < 32; ++k) lgg[k] = 0.f;
#pragma unroll
          for (int e = 0; e < 16; ++e)
#pragma unroll
              for (int j = 0; j < 4; ++j) { const f32x4 w4 = *(const LAS f32x4*)(wT + e * D + 256 * j + 4 * C.lane);
#pragma unroll
                  for (int r = 0; r < 2; ++r) { const f32x4 x = vv[4 * r + j]; lgg[16 * r + e] += (x.x * w4.x + x.y * w4.y) + (x.z * w4.z + x.w * w4.w); } }
#pragma unroll
          for (int k = 0; k < 32; ++k) lgg[k] = wave_sum(lgg[k]);
#pragma unroll
          for (int r = 0; r < 2; ++r) {
            const int lr = C.wave * 8 + i4 + r;
            float sc[16], sl[16];
#pragma unroll
            for (int e = 0; e < 16; ++e) { const float t = lgg[16 * r + e]; sc[e] = 1.f / (1.f + expf(-t)); sl[e] = sc[e] + br[e]; }
            int best = 0; float bestv = -3.0e38f;
#pragma unroll
            for (int gq = 0; gq < 4; ++gq) { const float a = sl[4 * gq], b2 = sl[4 * gq + 1], c2 = sl[4 * gq + 2], d2 = sl[4 * gq + 3];
                const float mx1 = fmaxf(fmaxf(a, b2), fmaxf(c2, d2)); const float tot = a + b2 + c2 + d2; const float mn1 = fminf(fminf(a, b2), fminf(c2, d2));
                const float lo1 = fminf(a, b2), hi1 = fmaxf(a, b2), lo2 = fminf(c2, d2), hi2 = fmaxf(c2, d2);
                const float second = fmaxf(fminf(hi1, hi2), fmaxf(lo1, lo2));
                (void)tot; (void)mn1;
                const float gs = mx1 + second; if (gs > bestv) { bestv = gs; best = gq; } }
            int i0 = 0, i1 = 0; float v0 = -3.0e38f, v1 = -3.0e38f, s0 = 0.f, s1 = 0.f;
#pragma unroll
            for (int gq = 0; gq < 4; ++gq) if (gq == best) {
#pragma unroll
                for (int k = 0; k < 4; ++k) { const float x = sl[4 * gq + k]; if (x > v0) { v1 = v0; i1 = i0; s1 = s0; v0 = x; i0 = 4 * gq + k; s0 = sc[4 * gq + k]; } else if (x > v1) { v1 = x; i1 = 4 * gq + k; s1 = sc[4 * gq + k]; } } }
            const float den = s0 + s1; const float g0 = s0 / den, g1 = s1 / den;
            if (C.lane == 0) {
                const unsigned r0 = __hip_atomic_fetch_add(lcnt + i0, 1u, __ATOMIC_RELAXED, __HIP_MEMORY_SCOPE_WORKGROUP);
                const unsigned r1 = __hip_atomic_fetch_add(lcnt + i1, 1u, __ATOMIC_RELAXED, __HIP_MEMORY_SCOPE_WORKGROUP);
                rec[lr * 8 + 0] = i0; rec[lr * 8 + 1] = i1; rec[lr * 8 + 2] = (int)r0; rec[lr * 8 + 3] = (int)r1;
                rec[lr * 8 + 4] = __builtin_bit_cast(int, g0); rec[lr * 8 + 5] = __builtin_bit_cast(int, g1); }
          }
          if (cdo_ && C.wave < 4) conv_flat_item(C, l, cw_, cscr);
        }
        __syncthreads();
        if (C.tid < 16) base[C.tid] = __hip_atomic_fetch_add(gcnt + C.tid, lcnt[C.tid], __ATOMIC_RELAXED, __HIP_MEMORY_SCOPE_AGENT);
        __syncthreads();
        if (C.tid < 64) { TokInfo ti; ti.e0 = rec[C.tid * 8]; ti.e1 = rec[C.tid * 8 + 1]; ti.p0 = rec[C.tid * 8 + 2] + (int)base[ti.e0]; ti.p1 = rec[C.tid * 8 + 3] + (int)base[ti.e1];
            ti.g0 = __builtin_bit_cast(float, rec[C.tid * 8 + 4]); ti.g1 = __builtin_bit_cast(float, rec[C.tid * 8 + 5]); ti.pad0 = 0; ti.pad1 = 0; tok[(size_t)rb * 64 + C.tid] = ti; }
    }
    for (int w = cgw + 4 * cNGW; w < NCV; w += cNGW) conv_flat_item(C, l, w, cscr);
}
DI int build_tile_table(Ctx& C, int l, LAS int* toff, LAS int* texp) {
    const unsigned* gcnt = C.ctl + CW_GCNT + 64 * l;
    __syncthreads();
    if (C.tid < 64) {
        int c = 0; if (C.lane < 16) c = (int)__hip_atomic_load(gcnt + C.lane, __ATOMIC_RELAXED, __HIP_MEMORY_SCOPE_AGENT);
        const int nt = (c + 255) >> 8; int incl = nt;
#pragma unroll
        for (int o = 1; o < 16; o <<= 1) { const int v = __shfl_up(incl, o); if (C.lane >= o) incl += v; }
        const int start = incl - nt;
        if (C.lane < 16) { toff[C.lane] = start << 8; for (int t = 0; t < nt; ++t) texp[start + t] = C.lane; }
        if (C.lane == 15) toff[16] = incl << 8; }
    __syncthreads();
    return toff[16] >> 8;
}
DI void phase_gather(Ctx& C, int l) {
    LAS int* toff = (LAS int*)(C.lds + 1024); LAS int* texp = (LAS int*)(C.lds + 2048);
    (void)build_tile_table(C, l, toff, texp);
    const TokInfo* tok = (const TokInfo*)(C.ws + WS_TOK); RowInfo* rowi = (RowInfo*)(C.ws + WS_ROW); bf16_t* AG = (bf16_t*)(C.ws + WS_AG);
    for (int m = C.blk * NTHR + C.tid; m < T; m += C.G * NTHR) {
        const TokInfo ti = tok[m];
        const int r0 = toff[ti.e0] + ti.p0, r1 = toff[ti.e1] + ti.p1;
        { RowInfo x; x.token = m; x.slot = 0; x.gate = ti.g0; x.pad = 0; rowi[r0] = x; x.slot = 1; x.gate = ti.g1; rowi[r1] = x; }
    }
}
DI void phase_ln_ffn(Ctx& C, int l) {
    const bf16_t* Y = (const bf16_t*)(C.ws + WS_Y);
    const float* g = C.in(27) + (size_t)l * D; const float* bta = C.in(28) + (size_t)l * D;
    const int gw = C.blk * NWAVES + C.wave, NGW = C.G * NWAVES;
    for (int m = gw; m < T; m += NGW) {
        f32x4 x[4], y0[4], y1[4];
        load_row_bf16(C.xcur + (size_t)m * D, x, C.lane); load_row_bf16(Y + (size_t)m * D, y0, C.lane); load_row_bf16(Y + ((size_t)T + m) * D, y1, C.lane);
#pragma unroll
        for (int j = 0; j < 4; ++j) x[j] = x[j] * ALPHA + (y0[j] + y1[j]);
        ln16(x, g, bta, C.lane);
        store_row_bf16(C.xcur + (size_t)m * D, x, C.lane);
    }
}
DI void phase_ln_ple(Ctx& C, int l, bool last) {
    const bf16_t* V = (const bf16_t*)(C.ws + WS_V3);
    const float* g = C.in(29) + (size_t)l * D; const float* bta = C.in(30) + (size_t)l * D;
    const int gw = C.blk * NWAVES + C.wave, NGW = C.G * NWAVES;
    for (int m = gw; m < T; m += NGW) {
        f32x4 v[4];
        load_row_bf16(V + (size_t)m * D, v, C.lane);
        ln16(v, g, bta, C.lane);
        if (last) {
#ifdef PROBE_PHASE
            { const unsigned long long* pt = (const unsigned long long*)(C.ws + WS_CTL + 32768); const float sc = 1.f + (float)(pt[1] - pt[0]) * (float)(PROBE_SCALE);
#pragma unroll
              for (int j = 0; j < 4; ++j) v[j] = v[j] * sc; }
#endif
#pragma unroll
            for (int j = 0; j < 4; ++j) *(f32x4*)(C.out + (size_t)m * D + 256 * j + 4 * C.lane) = v[j];
        } else store_row_bf16(C.xcur + (size_t)m * D, v, C.lane);
    }
}

constexpr int LDS_BYTES = 163840;
constexpr int PH_PER_LAYER = 13, NPHASE = 1 + DEPTH * PH_PER_LAYER;

constexpr int CW_AQ = 2048;
DI void convert_mixer_weights(Ctx& C, int l) {
    int first = 0;
    { ColPlain c{C.in(5) + (size_t)l * D * D}; convert_matrix(C, c, D, D, D, (bf16_t*)(C.ws + WS_WOUT), first); }
    { ColPlain c{C.in(8) + (size_t)l * 64 * 512}; convert_matrix(C, c, 512, 64, 512, (bf16_t*)(C.ws + WS_LORA), first); }
    { ColPlain c{C.in(10) + (size_t)l * 64 * 512}; convert_matrix(C, c, 512, 64, 512, (bf16_t*)(C.ws + WS_LORA) + 512 * 64, first); }
    { ColPlain c{C.in(11) + (size_t)l * 128 * 512}; convert_matrix(C, c, 512, 128, 512, (bf16_t*)(C.ws + WS_LORA) + 2 * 512 * 64, first); }
}
DI void convert_ffn_weights(Ctx& C, int l) {
    const float* p = C.in(1) + (size_t)l * T * PLE; bf16_t* pb = (bf16_t*)(C.ws + WS_PBF);
    const size_t pstr = (size_t)C.G * NTHR * 8;
    for (size_t i0 = ((size_t)C.blk * NTHR + C.tid) * 8; i0 < (size_t)T * PLE; i0 += 4 * pstr) {
        f32x4 a[4], b[4];
#pragma unroll
        for (int k = 0; k < 4; ++k) { const size_t i = i0 + k * pstr; if (i < (size_t)T * PLE) { a[k] = *(const f32x4*)(p + i); b[k] = *(const f32x4*)(p + i + 4); } }
#pragma unroll
        for (int k = 0; k < 4; ++k) { const size_t i = i0 + k * pstr; if (i < (size_t)T * PLE) { u32x4 o; o.x = pk2(a[k].x, a[k].y); o.y = pk2(a[k].z, a[k].w); o.z = pk2(b[k].x, b[k].y); o.w = pk2(b[k].z, b[k].w); *(u32x4*)(pb + i) = o; } } }
}
#ifndef RWREP
#define RWREP 1
#endif
#ifndef IQREP
#define IQREP 1
#endif
#ifndef REP_SUB
#define REP_SUB 0
#endif
#ifndef REP_SP
#define REP_SP -1
#define REP_N 1
#endif
template <int SP> DI void run_sp_(Ctx& C, const int l, const int rep);
template <int SP> DI void run_sp(Ctx& C, const int l) { run_sp_<SP>(C, l, 0); }
template <int SP> DI void run_sp_(Ctx& C, const int l, const int rep) {
    if constexpr (SP == 0) {
        pg8::Gemm g{C.xcur, (const bf16_t*)(C.ws + WS_WEXP), T, NPROJ_PAD, opaque_i(D)}; pg8::StaticOrder S; S.init(T, NPROJ_PAD, C.G, C.blk);
        EpiProj E{(bf16_t*)(C.ws + WS_PROJ)};
        pg8::gemm_phase<EpiProj, pg8::StaticOrder, true, true>(C.lds, g, S, E);
    } else if constexpr (SP == 1) {
    } else if constexpr (SP == 2) {
        LAS unsigned* gb = (LAS unsigned*)(C.lds + GB_OFF);
        if (C.tid < 8) gb[C.tid] = 0u;
        __syncthreads();
        const int half = C.wave >> 2, ltid = C.tid & 255;
        LAS unsigned* gcnt = gb + half; unsigned gtarget = 0u;
        LAS int* slot = (LAS int*)(gb + 2 + 2 * half);
        unsigned* iq = C.ctl + CW_AQ + 32 + 64 * l + 256 * rep;
        int nxt = 0, par = 0;
        if (half == 0) {
            for (int rw_ = 0; rw_ < RWREP; ++rw_)
            for (int bc = C.blk; bc < 256; bc += C.G) { bf16x8 actv[8]; rwkv_chunk_acts4(C, bc, l, actv); for (int h = 0; h < 8; ++h) rwkv_head_item4(C, bc * 8 + h, l, actv, gcnt, gtarget); }
        }
        const int ixb = half ? IX4 : 0;
        if (ltid == 0) nxt = (int)__hip_atomic_fetch_add(iq, 1u, __ATOMIC_RELAXED, __HIP_MEMORY_SCOPE_AGENT);
        for (;;) {
            if (ltid == 0) slot[par] = nxt;
            gbar(gcnt, gtarget, C.lane);
            const int u = __builtin_amdgcn_readfirstlane(slot[par]); par ^= 1;
            if (u >= 4096) break;
            if (ltid == 0) nxt = (int)__hip_atomic_fetch_add(iq, 1u, __ATOMIC_RELAXED, __HIP_MEMORY_SCOPE_AGENT);
            idx_item4(C, u, l, ixb, gcnt, gtarget);
        }
    } else if constexpr (SP == 3) {
        if (C.blk < 8 && (rep == 0 || REP_SUB != 2)) rwkv_scan_wave(C, C.blk * 8 + C.wave);
        LAS int* qs = (LAS int*)(C.lds + LDS_BYTES - 128);
        if (rep == 0 || REP_SUB != 1)
        for (;;) {
            __syncthreads();
            if (C.tid == 0) qs[0] = (int)__hip_atomic_fetch_add(C.ctl + CW_AQ + 64 * l + 256 * rep, 1u, __ATOMIC_RELAXED, __HIP_MEMORY_SCOPE_AGENT);
            __syncthreads();
            const int u = __builtin_amdgcn_readfirstlane(qs[0]);
            if (u >= 512) break;
            const int qb = 15 - (u >> 5), bh = u & 31; attn_unit(C, bh >> 3, bh & 7, qb);
        }
    } else if constexpr (SP == 4) {
        const int gw = C.blk * NWAVES + C.wave, NGW = C.G * NWAVES;
        for (int id = gw; id < 2048; id += NGW) rwkv_out_wave(C, id, l);
    } else if constexpr (SP == 5) {
        pg8::Gemm g{C.mixcat, (const bf16_t*)(C.ws + WS_WOUT), T, D, opaque_i(D)}; pg8::StaticOrder S; S.init(T, D, C.G, C.blk);
        EpiResF32 E{C.xcur, (bf16_t*)(C.ws + WS_V)};
        pg8::gemm_phase<EpiResF32, pg8::StaticOrder, true, true>(C.lds, g, S, E);
    } else if constexpr (SP == 6) { phase_ln_router(C, l); convert_ffn_weights(C, l);
    } else if constexpr (SP == 7) { phase_gather(C, l);
    } else if constexpr (SP == 8) {
        LAS int* toff = (LAS int*)(C.lds + 135168); LAS int* texp = (LAS int*)(C.lds + 136192);
        const int nt = build_tile_table(C, l, toff, texp);
        pg8::Gemm g{C.xcur, (const bf16_t*)(C.ws + WS_WEXP), MAXROWS, NEXP * 512, opaque_i(D)};
        GroupedOrder<2> S{texp, nt, C.G, C.blk};
        EpiSwiGLU E{(bf16_t*)(C.ws + WS_H), (const RowInfo*)(C.ws + WS_ROW)};
        pg8::gemm_phase_gather<EpiSwiGLU, GroupedOrder<2>, true>(C.lds, g, S, E, (const int*)(C.ws + WS_ROW));
        {
            const int extra = (2 * nt > C.G) ? (2 * nt - C.G) : 0; const int nb = C.G - extra;
            if (C.blk >= extra && nb > 0) { pg8::Gemm g2{(const bf16_t*)(C.ws + WS_PBF), (const bf16_t*)(C.ws + WS_WPLE), T, D, opaque_i(PLE)}; pg8::StaticOrder S2; S2.init(T, D, nb, C.blk - extra);
                EpiBf16Plain E2{(bf16_t*)(C.ws + WS_PE), D};
                pg8::gemm_phase<EpiBf16Plain, pg8::StaticOrder, true, true>(C.lds, g2, S2, E2); } }
    } else if constexpr (SP == 9) {
        LAS int* toff = (LAS int*)(C.lds + 135168); LAS int* texp = (LAS int*)(C.lds + 136192);
        const int nt = build_tile_table(C, l, toff, texp);
        { pg8::Gemm g{(const bf16_t*)(C.ws + WS_H), (const bf16_t*)(C.ws + WS_WDOWN), MAXROWS, NEXP * D, opaque_i(DEXP)};
          GroupedOrder<4> S{texp, nt, C.G, C.blk};
          EpiDown E{(bf16_t*)(C.ws + WS_Y), (const RowInfo*)(C.ws + WS_ROW)};
          pg8::gemm_phase<EpiDown, GroupedOrder<4>, true, true>(C.lds, g, S, E); }
    } else if constexpr (SP == 10) { phase_ln_ffn(C, l);
    } else if constexpr (SP == 11) {
        pg8::Gemm g{C.xcur, (const bf16_t*)(C.ws + WS_WPG), T, D, opaque_i(D)}; pg8::StaticOrder S; S.init(T, D, C.G, C.blk);
        EpiPle E{C.xcur, (const bf16_t*)(C.ws + WS_PE), (bf16_t*)(C.ws + WS_V3)};
        pg8::gemm_phase<EpiPle, pg8::StaticOrder, true, true>(C.lds, g, S, E);
    } else { phase_ln_ple(C, l, l == DEPTH - 1); if (l + 1 < DEPTH) { convert_win(C, l + 1); convert_mixer_weights(C, l + 1); } }
}
#define XB_TMO      128
#define XB_XCNT(j)  (256  + 64 * (j))
#define XB_XSUB(j)  (1280 + 64 * (j))
#define XB_XGEN(j)  (2304 + 64 * (j))
#define XB_TOP      3328
#define XB_TOPGEN   3392
#define XCD_BAR_WORDS 3456
#define XB_SPIN_CAP (1u << 18)

__device__ __forceinline__ unsigned xb_ld(unsigned* p)              { return __hip_atomic_load(p, __ATOMIC_RELAXED, __HIP_MEMORY_SCOPE_AGENT); }
__device__ __forceinline__ unsigned xb_add(unsigned* p, unsigned v) { return __hip_atomic_fetch_add(p, v, __ATOMIC_RELAXED, __HIP_MEMORY_SCOPE_AGENT); }
__device__ __forceinline__ unsigned xb_xcc_id() { return (unsigned)__builtin_amdgcn_s_getreg((3 << 11) | 20) & 0xFu; }
#define XB_SPIN(cond, bar) do { unsigned _sp = 0; while (cond) { __builtin_amdgcn_s_sleep(1); \
    if ((++_sp & 255u) == 0u) { if (xb_ld(&(bar)[XB_TMO])) break; if (_sp > XB_SPIN_CAP) { atomicAdd(&(bar)[XB_TMO], 1u); break; } } } } while (0)

struct XcdBarrier {
    unsigned* bar; unsigned x;
    volatile __attribute__((address_space(3))) unsigned* st;
};

__device__ __forceinline__ XcdBarrier xcd_barrier_post(unsigned* bar, volatile __attribute__((address_space(3))) unsigned* st) {
    XcdBarrier b; b.bar = bar; b.x = xb_xcc_id(); b.st = st;
    if (threadIdx.x == 0) (void)xb_add(&bar[XB_XCNT(b.x)], 1u);
    return b;
}
__device__ __forceinline__ void xcd_barrier_complete(unsigned* bar, unsigned x, unsigned& nloc, unsigned& nx) {
    const unsigned G = gridDim.x * gridDim.y * gridDim.z;
    unsigned sum, cnt, mine, sp = 0u;
    for (;;) {
        sum = 0u; cnt = 0u; mine = 0u;
#pragma unroll
        for (unsigned j = 0; j < 16; ++j) { const unsigned c = xb_ld(&bar[XB_XCNT(j)]); sum += c; cnt += (c > 0u) ? 1u : 0u; mine = (j == x) ? c : mine; }
        if (sum == G) break;
        __builtin_amdgcn_s_sleep(1);
        if ((++sp & 255u) == 0u) { if (xb_ld(&bar[XB_TMO])) break; if (sp > XB_SPIN_CAP) { atomicAdd(&bar[XB_TMO], 1u); break; } }
    }
    nloc = mine > 0u ? mine : 1u; nx = cnt > 0u ? cnt : 1u;
}

__device__ __forceinline__ void xcd_barrier(const XcdBarrier& b) {
    asm volatile("s_waitcnt vmcnt(0)" ::: "memory");
    __syncthreads();
    if (threadIdx.x == 0) {
        unsigned* bar = b.bar;
        __builtin_amdgcn_s_waitcnt(0);
        unsigned nloc = b.st[0], nx = b.st[1];
        if (nloc == 0u) { xcd_barrier_complete(bar, b.x, nloc, nx); b.st[0] = nloc; b.st[1] = nx; }
        const unsigned old = xb_add(&bar[XB_XSUB(b.x)], 1u);
        const unsigned gen = old / nloc;
        if (old + 1u == (gen + 1u) * nloc) {
            __builtin_amdgcn_fence(__ATOMIC_RELEASE, "agent");
            asm volatile("s_waitcnt vmcnt(0)" ::: "memory");
            const unsigned og = xb_add(&bar[XB_TOP], 1u);
            const unsigned tg = og / nx;
            if (og + 1u == (tg + 1u) * nx) xb_add(&bar[XB_TOPGEN], 1u);
            else XB_SPIN(xb_ld(&bar[XB_TOPGEN]) == tg, bar);
            __builtin_amdgcn_fence(__ATOMIC_ACQUIRE, "agent");
            xb_add(&bar[XB_XGEN(b.x)], 1u);
            asm volatile("s_waitcnt vmcnt(0)" ::: "memory");
        } else {
            XB_SPIN(xb_ld(&bar[XB_XGEN(b.x)]) == gen, bar);
            __builtin_amdgcn_fence(__ATOMIC_ACQUIRE, "agent");
            asm volatile("s_waitcnt vmcnt(0)" ::: "memory");
        }
    }
    __syncthreads();
}

constexpr int CW_XBAR = 65536;
typedef const __attribute__((address_space(4))) Args* KArgP;
DI void ctx_setup(Ctx& C) {
    int t_ = threadIdx.x; asm volatile("" : "+v"(t_)); C.tid = t_; C.lane = t_ & 63; C.wave = __builtin_amdgcn_readfirstlane(t_ >> 6);
    int b_ = blockIdx.x, g_ = gridDim.x; asm volatile("" : "+s"(b_), "+s"(g_)); C.blk = b_; C.G = g_;
    KArgP ap = (KArgP)__builtin_amdgcn_kernarg_segment_ptr(); asm volatile("" : "+s"(ap));
    C.ap = ap; C.out = ap->out; C.ws = ap->ws; C.ctl = (unsigned*)(ap->ws + WS_CTL); C.xcur = (bf16_t*)ap->out; C.mixcat = (bf16_t*)ap->out + (size_t)T * D;
}
__global__ void __launch_bounds__(NTHR, 2) mega_fwd(Args args) {
    extern __shared__ __attribute__((aligned(16))) unsigned char lds_raw[];
    Ctx C;
    C.lds = (LAS unsigned char*)lds_raw;
    cg::grid_group grid = cg::this_grid();
    volatile LAS unsigned* xbst = (volatile LAS unsigned*)(C.lds + LDS_BYTES - 32);
    if (threadIdx.x < 4) xbst[threadIdx.x] = 0u;
    __syncthreads();
    XcdBarrier xbar = xcd_barrier_post((unsigned*)(((KArgP)__builtin_amdgcn_kernarg_segment_ptr())->ws + WS_CTL) + CW_XBAR, xbst);
    const int lo = ((KArgP)__builtin_amdgcn_kernarg_segment_ptr())->ph_lo, hi = ((KArgP)__builtin_amdgcn_kernarg_segment_ptr())->ph_hi;
#ifdef PROBE_PHASE
#define PROBE_HOOK(k) do { if (blockIdx.x == 0 && threadIdx.x == 0) { unsigned long long* pt = (unsigned long long*)(C.ws + WS_CTL + 32768); if ((k) == PROBE_PHASE) pt[0] = __builtin_amdgcn_s_memrealtime(); if ((k) == PROBE_PHASE_END) pt[1] = __builtin_amdgcn_s_memrealtime(); } } while (0)
#else
#define PROBE_HOOK(k) do { } while (0)
#endif
#define GRID_BAR(k) do { if ((k) == lo + 1) grid.sync(); else xcd_barrier(xbar); } while (0)
#define PHASE(k, body) do { if (lo <= (k) && (k) < hi) { if ((k) > lo) GRID_BAR(k); ctx_setup(C); PROBE_HOOK(k); body; } } while (0)
    PHASE(0, { phase_ln_in(C); convert_win(C, 0); convert_mixer_weights(C, 0); });
#define LAYER(l) PHASE(1 + 13 * (l) + 0, run_sp<0>(C, l)); PHASE(1 + 13 * (l) + 2, run_sp<2>(C, l)); PHASE(1 + 13 * (l) + 3, run_sp<3>(C, l)); \
    PHASE(1 + 13 * (l) + 4, run_sp<4>(C, l)); PHASE(1 + 13 * (l) + 5, run_sp<5>(C, l)); PHASE(1 + 13 * (l) + 6, run_sp<6>(C, l)); PHASE(1 + 13 * (l) + 7, run_sp<7>(C, l)); \
    PHASE(1 + 13 * (l) + 8, run_sp<8>(C, l)); PHASE(1 + 13 * (l) + 9, run_sp<9>(C, l)); PHASE(1 + 13 * (l) + 10, run_sp<10>(C, l)); PHASE(1 + 13 * (l) + 11, run_sp<11>(C, l)); \
    PHASE(1 + 13 * (l) + 12, run_sp<12>(C, l))
#define PH0(sp) PHASE(1 + (sp), run_sp<sp>(C, 0)); if (REP_SP == (sp)) { if (REP_N > 1) { xcd_barrier(xbar); ctx_setup(C); run_sp_<sp>(C, 0, 1); } if (REP_N > 2) { xcd_barrier(xbar); ctx_setup(C); run_sp_<sp>(C, 0, 2); } }
    PH0(0); PH0(2); PH0(3); PH0(4); PH0(5); PH0(6); PH0(7); PH0(8); PH0(9); PH0(10); PH0(11); PH0(12);
#undef PH0
    LAYER(1);
#undef LAYER
#undef PHASE
}

#ifndef N_LAUNCH_MODE
#define N_LAUNCH_MODE 1
#endif
extern "C" void kernel_launch(void* const* d_in, const int* in_sizes, int n_in, void* d_out, int out_size, void* d_ws, size_t ws_size, hipStream_t stream) {
    static int grid = 0;
    if (grid == 0) {
        if (n_in != 31 || out_size != T * D) { fprintf(stderr, "kernel_launch: unexpected problem (n_in %d out %d)\n", n_in, out_size); grid = -1; return; }
        int dev = 0, cus = 0, per_cu = 0;
        hipGetDevice(&dev); hipDeviceGetAttribute(&cus, hipDeviceAttributeMultiprocessorCount, dev);
        if (hipFuncSetAttribute((const void*)mega_fwd, hipFuncAttributeMaxDynamicSharedMemorySize, LDS_BYTES) != hipSuccess) { fprintf(stderr, "kernel_launch: hipFuncSetAttribute failed\n"); grid = -1; return; }
        if (hipOccupancyMaxActiveBlocksPerMultiprocessor(&per_cu, (const void*)mega_fwd, NTHR, LDS_BYTES) != hipSuccess || per_cu < 1) { fprintf(stderr, "kernel_launch: occupancy query says %d\n", per_cu); per_cu = 1; }
        (void)hipGetLastError();
        grid = cus * 1;
        fprintf(stderr, "kernel_launch: grid %d (occupancy %d per CU)\n", grid, per_cu);
    }
    if (grid < 0) return;
    hipMemsetAsync((char*)d_ws + WS_CTL, 0, CTL_BYTES, stream);
    Args a{};
    for (int i = 0; i < 31; ++i) a.in[i] = (const float*)d_in[i];
    a.out = (float*)d_out; a.ws = (unsigned char*)d_ws;
#if N_LAUNCH_MODE == 0
    for (int ph = 0; ph < NPHASE; ++ph) { a.ph_lo = ph; a.ph_hi = ph + 1; hipLaunchKernelGGL(mega_fwd, dim3(grid), dim3(NTHR), LDS_BYTES, stream, a); }
#else
    a.ph_lo = 0; a.ph_hi = NPHASE;
    void* kargs[] = {&a};
    hipError_t e = hipLaunchCooperativeKernel((const void*)mega_fwd, dim3(grid), dim3(NTHR), kargs, LDS_BYTES, stream);
    if (e != hipSuccess) fprintf(stderr, "cooperative launch failed: %s (grid %d)\n", hipGetErrorString(e), grid);
#endif
}
```

```cpp
#include <hip/hip_runtime.h>
#include <hip/hip_cooperative_groups.h>
#include <cstdio>
#include <cstdint>
namespace cg = cooperative_groups;
namespace pg8 {
#define PG8_LAS __attribute__((address_space(3)))
typedef unsigned short bf16_t;
typedef short bf16x8 __attribute__((ext_vector_type(8)));
typedef float f32x4 __attribute__((ext_vector_type(4)));
typedef unsigned u32x4 __attribute__((ext_vector_type(4)));
constexpr int BM = 256, BK = 64, HALF = 128, HTB = HALF * BK * 2  , STAGE_BYTES = 8 * HTB, NXCD = 8, WGM = 8;

__host__ __device__ __forceinline__ int lds_byte(int r, int c) { const int st = (r >> 4) * 2 + (c >> 5), rr = r & 15, cc = c & 31, ob = rr * 64 + cc * 2; return st * 1024 + (ob ^ (((ob >> 9) & 1) << 5)); }
__host__ __device__ __forceinline__ void stage_rc(int b, int& R, int& C) { const int st = b / 1024, sb = b % 1024, swz = sb ^ (((sb >> 9) & 1) << 5); R = (st >> 1) * 16 + swz / 64; C = (st & 1) * 32 + (swz % 64) / 2; }
__host__ __device__ __forceinline__ int perm32(int rho) { const int n = rho >> 4, i = rho & 15; return 8 * (i >> 2) + 4 * n + (i & 3); }

struct Unit { int pm, pn; };
struct Gemm { const bf16_t* A; const bf16_t* Bt; int M, N, K; };

struct StaticOrder {
    int nM, nN, nwg, G, c;
    __host__ __device__ void init(int M, int N, int G_, int c_) { nM = M / BM; nN = N / BM; nwg = nM * nN; G = G_; c = c_; }
    __host__ __device__ bool next(int i, Unit& u) const {
        const long L = (long)i * G + c; if (L >= nwg) return false;
        int wgid = (int)L; { const int q = nwg / NXCD, r = nwg % NXCD, xcd = wgid % NXCD, off = wgid / NXCD; wgid = (xcd < r ? xcd * (q + 1) : r * (q + 1) + (xcd - r) * q) + off; }
        const int nig = WGM * nN, gid = wgid / nig, fm = gid * WGM, gsz = (nM - fm) < WGM ? (nM - fm) : WGM;
        u.pm = fm + ((wgid % nig) % gsz); u.pn = (wgid % nig) / gsz; return true;
    }
    __device__ __forceinline__ void a_ready(const Unit&) const {}
    __device__ __forceinline__ void done(const Unit&) const {}
};

__device__ __forceinline__ unsigned cvt_pk_bf16(float lo, float hi) { typedef float f2_t __attribute__((ext_vector_type(2))); typedef __bf16 b2_t __attribute__((ext_vector_type(2))); f2_t v = {lo, hi}; b2_t b = __builtin_convertvector(v, b2_t); return __builtin_bit_cast(unsigned, b); }
template <class Epi, class Sched, bool ALIGN_EPI = false, bool SP2 = false>
__device__ __forceinline__ void gemm_phase(PG8_LAS unsigned char* lds, const Gemm g, const Sched& S, const Epi& E) {
    int tid_ = threadIdx.x; asm volatile("" : "+v"(tid_));
    const int tid = tid_, wid = __builtin_amdgcn_readfirstlane(tid >> 6), lane = tid & 63, wr = wid >> 2, wc = wid & 3, fr = lane & 15, fq = lane >> 4;
    const int K = g.K, nt = K / BK;
    unsigned voffA[2], voffB[2];
#pragma unroll
    for (int i = 0; i < 2; ++i) { int R, C; stage_rc(tid * 16 + i * 8192, R, C); const int Rb = Epi::PERM ? ((R & ~31) + perm32(R & 31)) : R;
        voffA[i] = (unsigned)(R * K + C) * 2u; voffB[i] = (unsigned)(Rb * K + C) * 2u; }
    const size_t kstep = (size_t)(BK * 2);
    const size_t hstep = (size_t)HALF * K * 2;
    const size_t tstep = 2 * hstep;
    const unsigned ldsw = (unsigned)wid * 1024u;
    const int aoff = lds_byte(wr * 64 + fr, fq * 8), boff = lds_byte(wc * 32 + fr, fq * 8);
#define PG8_SA(b, h) (((b) * 2 + (h)) * HTB)
#define PG8_SB(b, h) ((4 + (b) * 2 + (h)) * HTB)
#define PG8_STAGE(bufoff, gbase, voff) do { _Pragma("unroll") for (int _i = 0; _i < 2; ++_i) \
        __builtin_amdgcn_global_load_lds((const unsigned*)((const char*)(gbase) + (voff)[_i]), (PG8_LAS unsigned*)(lds + (bufoff) + ldsw + _i * 8192), 16, 0, 0); } while (0)
#define PG8_LDA(dst, b, h) do { _Pragma("unroll") for (int m = 0; m < 4; ++m) _Pragma("unroll") for (int k = 0; k < 2; ++k) dst[m][k] = *(const PG8_LAS bf16x8*)(lds + PG8_SA(b, h) + aoff + m * 2048 + k * 1024); } while (0)
#define PG8_LDB(dst, b, h) do { _Pragma("unroll") for (int n = 0; n < 2; ++n) _Pragma("unroll") for (int k = 0; k < 2; ++k) dst[n][k] = *(const PG8_LAS bf16x8*)(lds + PG8_SB(b, h) + boff + n * 2048 + k * 1024); } while (0)
#define PG8_MMA(ai, bj, At, Bt) do { __builtin_amdgcn_s_setprio(1); _Pragma("unroll") for (int m = 0; m < 4; ++m) _Pragma("unroll") for (int n = 0; n < 2; ++n) _Pragma("unroll") for (int k = 0; k < 2; ++k) \
        acc[ai][bj][m][n] = __builtin_amdgcn_mfma_f32_16x16x32_bf16(Bt[n][k], At[m][k], acc[ai][bj][m][n], 0, 0, 0); __builtin_amdgcn_s_setprio(0); } while (0)
#define PG8_WAIT_V(n) asm volatile("s_waitcnt vmcnt(" #n ")" ::: "memory")
#define PG8_WAIT_L(n) asm volatile("s_waitcnt lgkmcnt(" #n ")" ::: "memory")
#define PG8_BAR __builtin_amdgcn_s_barrier()
#define PG8_SCHED __builtin_amdgcn_sched_barrier(0)
    Unit cur, nxt; int ui = 0;
    if (!S.next(0, cur)) return;
    f32x4 acc[2][2][4][2];
#pragma unroll
    for (int a = 0; a < 2; ++a)
#pragma unroll
        for (int b = 0; b < 2; ++b)
#pragma unroll
            for (int m = 0; m < 4; ++m)
#pragma unroll
                for (int n = 0; n < 2; ++n) acc[a][b][m][n] = (f32x4){0.f, 0.f, 0.f, 0.f};
    bf16x8 At[4][2], B0[2][2], B1[2][2];
    const char* cA = (const char*)g.A + (size_t)cur.pm * tstep; const char* cB = (const char*)g.Bt + (size_t)cur.pn * tstep;
    S.a_ready(cur);
    if constexpr (SP2) {
        PG8_STAGE(PG8_SB(0, 0), cB, voffB); PG8_STAGE(PG8_SB(0, 1), cB + hstep, voffB); PG8_STAGE(PG8_SA(0, 0), cA, voffA); PG8_STAGE(PG8_SA(0, 1), cA + hstep, voffA);
        if (wr == 1) PG8_BAR;
        PG8_WAIT_V(2); PG8_BAR;
        PG8_STAGE(PG8_SB(1, 0), cB + kstep, voffB); PG8_STAGE(PG8_SA(1, 0), cA + kstep, voffA); PG8_STAGE(PG8_SB(1, 1), cB + hstep + kstep, voffB);
        PG8_WAIT_V(6); PG8_BAR;
    } else {
        PG8_STAGE(PG8_SB(0, 0), cB, voffB); PG8_STAGE(PG8_SA(0, 0), cA, voffA); PG8_STAGE(PG8_SB(0, 1), cB + hstep, voffB); PG8_STAGE(PG8_SA(0, 1), cA + hstep, voffA);
        if (wr == 1) PG8_BAR;
        PG8_WAIT_V(4); PG8_BAR;
        PG8_STAGE(PG8_SB(1, 0), cB + kstep, voffB); PG8_STAGE(PG8_SA(1, 0), cA + kstep, voffA); PG8_STAGE(PG8_SB(1, 1), cB + hstep + kstep, voffB);
        PG8_WAIT_V(6); PG8_BAR;
    }
    for (;;) {
        const bool has_next = S.next(ui + 1, nxt);
        const char* nA = has_next ? (const char*)g.A + (size_t)nxt.pm * tstep : cA; const char* nB = has_next ? (const char*)g.Bt + (size_t)nxt.pn * tstep : cB;
        for (int t = 0; t < nt; t += 2) {
            const bool last = (t == nt - 2);
            const char* a1 = cA + (size_t)(t + 1) * kstep;
            const char* a2 = last ? nA : cA + (size_t)(t + 2) * kstep; const char* b2 = last ? nB : cB + (size_t)(t + 2) * kstep;
            const char* a3 = a2 + kstep; const char* b3 = b2 + kstep;
            if (last && has_next) S.a_ready(nxt);
            if constexpr (SP2) {
            PG8_LDB(B0, 0, 0); PG8_LDB(B1, 0, 1); PG8_SCHED; PG8_LDA(At, 0, 0); PG8_STAGE(PG8_SA(1, 1), a1 + hstep, voffA);
            PG8_WAIT_V(8); PG8_WAIT_L(0); PG8_BAR; PG8_MMA(0, 0, At, B0); PG8_MMA(0, 1, At, B1); PG8_BAR; PG8_SCHED;
            PG8_LDA(At, 0, 1); PG8_STAGE(PG8_SB(0, 0), b2, voffB); PG8_STAGE(PG8_SB(0, 1), b2 + hstep, voffB); PG8_STAGE(PG8_SA(0, 0), a2, voffA);
            PG8_WAIT_V(8); PG8_WAIT_L(0); PG8_BAR; PG8_MMA(1, 0, At, B0); PG8_MMA(1, 1, At, B1); PG8_BAR; PG8_SCHED;
            PG8_LDB(B0, 1, 0); PG8_LDB(B1, 1, 1); PG8_SCHED; PG8_LDA(At, 1, 0); PG8_STAGE(PG8_SA(0, 1), a2 + hstep, voffA);
            PG8_WAIT_V(8); PG8_WAIT_L(0); PG8_BAR; PG8_MMA(0, 0, At, B0); PG8_MMA(0, 1, At, B1); PG8_BAR; PG8_SCHED;
            PG8_LDA(At, 1, 1); PG8_STAGE(PG8_SB(1, 0), b3, voffB); PG8_STAGE(PG8_SB(1, 1), b3 + hstep, voffB); PG8_STAGE(PG8_SA(1, 0), a3, voffA);
            PG8_WAIT_V(8); PG8_WAIT_L(0); PG8_BAR; PG8_MMA(1, 0, At, B0); PG8_MMA(1, 1, At, B1); PG8_BAR; PG8_SCHED;
            } else {
            PG8_LDB(B0, 0, 0); PG8_SCHED; PG8_LDA(At, 0, 0); PG8_STAGE(PG8_SA(1, 1), a1 + hstep, voffA);
            PG8_WAIT_L(8); PG8_BAR; PG8_WAIT_L(0); PG8_MMA(0, 0, At, B0); PG8_BAR; PG8_SCHED;
            PG8_LDB(B1, 0, 1); PG8_STAGE(PG8_SB(0, 0), b2, voffB);
            PG8_BAR; PG8_WAIT_L(0); PG8_MMA(0, 1, At, B1); PG8_BAR;
            PG8_LDA(At, 0, 1); PG8_STAGE(PG8_SA(0, 0), a2, voffA);
            PG8_BAR; PG8_WAIT_L(0); PG8_MMA(1, 0, At, B0); PG8_BAR; PG8_SCHED;
            PG8_STAGE(PG8_SB(0, 1), b2 + hstep, voffB);
            PG8_WAIT_V(6); PG8_BAR; PG8_MMA(1, 1, At, B1); PG8_BAR;
            PG8_LDB(B0, 1, 0); PG8_SCHED; PG8_LDA(At, 1, 0); PG8_STAGE(PG8_SA(0, 1), a2 + hstep, voffA);
            PG8_WAIT_L(8); PG8_BAR; PG8_WAIT_L(0); PG8_MMA(0, 0, At, B0); PG8_BAR; PG8_SCHED;
            PG8_LDB(B1, 1, 1); PG8_STAGE(PG8_SB(1, 0), b3, voffB);
            PG8_BAR; PG8_WAIT_L(0); PG8_MMA(0, 1, At, B1); PG8_BAR;
            PG8_LDA(At, 1, 1); PG8_STAGE(PG8_SA(1, 0), a3, voffA);
            PG8_BAR; PG8_WAIT_L(0); PG8_MMA(1, 0, At, B0); PG8_BAR; PG8_SCHED;
            PG8_STAGE(PG8_SB(1, 1), b3 + hstep, voffB);
            PG8_WAIT_V(6); PG8_BAR; PG8_MMA(1, 1, At, B1); PG8_BAR;
            }
        }
        if constexpr (ALIGN_EPI) { if (wr == 0) PG8_BAR; }
        if constexpr (!Epi::AFTER_DRAIN) { E(acc, cur, wr, wc, fr, fq); S.done(cur); }
        if (!has_next) break;
#pragma unroll
        for (int a = 0; a < 2; ++a)
#pragma unroll
            for (int b = 0; b < 2; ++b)
#pragma unroll
                for (int m = 0; m < 4; ++m)
#pragma unroll
                    for (int n = 0; n < 2; ++n) acc[a][b][m][n] = (f32x4){0.f, 0.f, 0.f, 0.f};
        cur = nxt; cA = nA; cB = nB; ++ui;
        if constexpr (ALIGN_EPI) { if (wr == 1) PG8_BAR; }
    }
    PG8_WAIT_V(0);
    if constexpr (!ALIGN_EPI) { if (wr == 0) PG8_BAR; }
    PG8_BAR;
    if constexpr (Epi::AFTER_DRAIN) { E.fused(acc, cur, wr, wc, fr, fq, lds, wid, lane); S.done(cur); }
#undef PG8_SA
#undef PG8_SB
#undef PG8_STAGE
#undef PG8_LDA
#undef PG8_LDB
#undef PG8_MMA
#undef PG8_WAIT_V
#undef PG8_WAIT_L
#undef PG8_BAR
#undef PG8_SCHED
}

template <class Epi, class Sched, bool ALIGN_EPI = false>
__device__ __forceinline__ void gemm_phase_gather(PG8_LAS unsigned char* lds, const Gemm g, const Sched& S, const Epi& E, const int* rowtok) {
    constexpr bool SP2 = true;
    int tid_ = threadIdx.x; asm volatile("" : "+v"(tid_));
    const int tid = tid_, wid = __builtin_amdgcn_readfirstlane(tid >> 6), lane = tid & 63, wr = wid >> 2, wc = wid & 3, fr = lane & 15, fq = lane >> 4;
    const int K = g.K, nt = K / BK;
    unsigned voffB[2]; unsigned vcur[2][2], vnxt[2][2]; int RA[2], CA[2]; const unsigned voffA[2] = {0u, 0u};
#pragma unroll
    for (int i = 0; i < 2; ++i) { int R, C; stage_rc(tid * 16 + i * 8192, R, C); const int Rb = Epi::PERM ? ((R & ~31) + perm32(R & 31)) : R;
        RA[i] = R; CA[i] = C; voffB[i] = (unsigned)(Rb * K + C) * 2u; }
#define PG8_GMAP(dst, pm_) do { _Pragma("unroll") for (int h_ = 0; h_ < 2; ++h_) _Pragma("unroll") for (int i_ = 0; i_ < 2; ++i_) { int tk_ = rowtok[4 * ((pm_) * BM + h_ * HALF + RA[i_])]; tk_ = tk_ < 0 ? 0 : tk_; dst[h_][i_] = (unsigned)(tk_ * K + CA[i_]) * 2u; } } while (0)
    const size_t kstep = (size_t)(BK * 2);
    const size_t hstep = (size_t)HALF * K * 2;
    const size_t tstep = 2 * hstep;
    const unsigned ldsw = (unsigned)wid * 1024u;
    const int aoff = lds_byte(wr * 64 + fr, fq * 8), boff = lds_byte(wc * 32 + fr, fq * 8);
#define PG8_SA(b, h) (((b) * 2 + (h)) * HTB)
#define PG8_SB(b, h) ((4 + (b) * 2 + (h)) * HTB)
#define PG8_STAGE(bufoff, gbase, voff) do { _Pragma("unroll") for (int _i = 0; _i < 2; ++_i) \
        __builtin_amdgcn_global_load_lds((const unsigned*)((const char*)(gbase) + (voff)[_i]), (PG8_LAS unsigned*)(lds + (bufoff) + ldsw + _i * 8192), 16, 0, 0); } while (0)
#define PG8_LDA(dst, b, h) do { _Pragma("unroll") for (int m = 0; m < 4; ++m) _Pragma("unroll") for (int k = 0; k < 2; ++k) dst[m][k] = *(const PG8_LAS bf16x8*)(lds + PG8_SA(b, h) + aoff + m * 2048 + k * 1024); } while (0)
#define PG8_LDB(dst, b, h) do { _Pragma("unroll") for (int n = 0; n < 2; ++n) _Pragma("unroll") for (int k = 0; k < 2; ++k) dst[n][k] = *(const PG8_LAS bf16x8*)(lds + PG8_SB(b, h) + boff + n * 2048 + k * 1024); } while (0)
#define PG8_MMA(ai, bj, At, Bt) do { __builtin_amdgcn_s_setprio(1); _Pragma("unroll") for (int m = 0; m < 4; ++m) _Pragma("unroll") for (int n = 0; n < 2; ++n) _Pragma("unroll") for (int k = 0; k < 2; ++k) \
        acc[ai][bj][m][n] = __builtin_amdgcn_mfma_f32_16x16x32_bf16(Bt[n][k], At[m][k], acc[ai][bj][m][n], 0, 0, 0); __builtin_amdgcn_s_setprio(0); } while (0)
#define PG8_WAIT_V(n) asm volatile("s_waitcnt vmcnt(" #n ")" ::: "memory")
#define PG8_WAIT_L(n) asm volatile("s_waitcnt lgkmcnt(" #n ")" ::: "memory")
#define PG8_BAR __builtin_amdgcn_s_barrier()
#define PG8_SCHED __builtin_amdgcn_sched_barrier(0)
    Unit cur, nxt; int ui = 0;
    if (!S.next(0, cur)) return;
    f32x4 acc[2][2][4][2];
#pragma unroll
    for (int a = 0; a < 2; ++a)
#pragma unroll
        for (int b = 0; b < 2; ++b)
#pragma unroll
            for (int m = 0; m < 4; ++m)
#pragma unroll
                for (int n = 0; n < 2; ++n) acc[a][b][m][n] = (f32x4){0.f, 0.f, 0.f, 0.f};
    bf16x8 At[4][2], B0[2][2], B1[2][2];
    const char* cA = (const char*)g.A; const char* cB = (const char*)g.Bt + (size_t)cur.pn * tstep;
    PG8_GMAP(vcur, cur.pm);
    S.a_ready(cur);
    if constexpr (SP2) {
        PG8_STAGE(PG8_SB(0, 0), cB, voffB); PG8_STAGE(PG8_SB(0, 1), cB + hstep, voffB); PG8_STAGE(PG8_SA(0, 0), cA, vcur[0]); PG8_STAGE(PG8_SA(0, 1), cA, vcur[1]);
        if (wr == 1) PG8_BAR;
        PG8_WAIT_V(2); PG8_BAR;
        PG8_STAGE(PG8_SB(1, 0), cB + kstep, voffB); PG8_STAGE(PG8_SA(1, 0), cA + kstep, vcur[0]); PG8_STAGE(PG8_SB(1, 1), cB + hstep + kstep, voffB);
        PG8_WAIT_V(6); PG8_BAR;
    } else {
        PG8_STAGE(PG8_SB(0, 0), cB, voffB); PG8_STAGE(PG8_SA(0, 0), cA, voffA); PG8_STAGE(PG8_SB(0, 1), cB + hstep, voffB); PG8_STAGE(PG8_SA(0, 1), cA + hstep, voffA);
        if (wr == 1) PG8_BAR;
        PG8_WAIT_V(4); PG8_BAR;
        PG8_STAGE(PG8_SB(1, 0), cB + kstep, voffB); PG8_STAGE(PG8_SA(1, 0), cA + kstep, voffA); PG8_STAGE(PG8_SB(1, 1), cB + hstep + kstep, voffB);
        PG8_WAIT_V(6); PG8_BAR;
    }
    for (;;) {
        const bool has_next = S.next(ui + 1, nxt);
        const char* nA = cA; const char* nB = has_next ? (const char*)g.Bt + (size_t)nxt.pn * tstep : cB;
        if (has_next) PG8_GMAP(vnxt, nxt.pm); else { vnxt[0][0] = vcur[0][0]; vnxt[0][1] = vcur[0][1]; vnxt[1][0] = vcur[1][0]; vnxt[1][1] = vcur[1][1]; }
        for (int t = 0; t < nt; t += 2) {
            const bool last = (t == nt - 2);
            const char* a1 = cA + (size_t)(t + 1) * kstep;
            const char* a2 = last ? nA : cA + (size_t)(t + 2) * kstep; unsigned v2[2][2]; v2[0][0] = last ? vnxt[0][0] : vcur[0][0]; v2[0][1] = last ? vnxt[0][1] : vcur[0][1]; v2[1][0] = last ? vnxt[1][0] : vcur[1][0]; v2[1][1] = last ? vnxt[1][1] : vcur[1][1]; const char* b2 = last ? nB : cB + (size_t)(t + 2) * kstep;
            const char* a3 = a2 + kstep; const char* b3 = b2 + kstep;
            if (last && has_next) S.a_ready(nxt);
            if constexpr (SP2) {
            PG8_LDB(B0, 0, 0); PG8_LDB(B1, 0, 1); PG8_SCHED; PG8_LDA(At, 0, 0); PG8_STAGE(PG8_SA(1, 1), a1, vcur[1]);
            PG8_WAIT_V(8); PG8_WAIT_L(0); PG8_BAR; PG8_MMA(0, 0, At, B0); PG8_MMA(0, 1, At, B1); PG8_BAR; PG8_SCHED;
            PG8_LDA(At, 0, 1); PG8_STAGE(PG8_SB(0, 0), b2, voffB); PG8_STAGE(PG8_SB(0, 1), b2 + hstep, voffB); PG8_STAGE(PG8_SA(0, 0), a2, v2[0]);
            PG8_WAIT_V(8); PG8_WAIT_L(0); PG8_BAR; PG8_MMA(1, 0, At, B0); PG8_MMA(1, 1, At, B1); PG8_BAR; PG8_SCHED;
            PG8_LDB(B0, 1, 0); PG8_LDB(B1, 1, 1); PG8_SCHED; PG8_LDA(At, 1, 0); PG8_STAGE(PG8_SA(0, 1), a2, v2[1]);
            PG8_WAIT_V(8); PG8_WAIT_L(0); PG8_BAR; PG8_MMA(0, 0, At, B0); PG8_MMA(0, 1, At, B1); PG8_BAR; PG8_SCHED;
            PG8_LDA(At, 1, 1); PG8_STAGE(PG8_SB(1, 0), b3, voffB); PG8_STAGE(PG8_SB(1, 1), b3 + hstep, voffB); PG8_STAGE(PG8_SA(1, 0), a3, v2[0]);
            PG8_WAIT_V(8); PG8_WAIT_L(0); PG8_BAR; PG8_MMA(1, 0, At, B0); PG8_MMA(1, 1, At, B1); PG8_BAR; PG8_SCHED;
            } else {
            PG8_LDB(B0, 0, 0); PG8_SCHED; PG8_LDA(At, 0, 0); PG8_STAGE(PG8_SA(1, 1), a1 + hstep, voffA);
            PG8_WAIT_L(8); PG8_BAR; PG8_WAIT_L(0); PG8_MMA(0, 0, At, B0); PG8_BAR; PG8_SCHED;
            PG8_LDB(B1, 0, 1); PG8_STAGE(PG8_SB(0, 0), b2, voffB);
            PG8_BAR; PG8_WAIT_L(0); PG8_MMA(0, 1, At, B1); PG8_BAR;
            PG8_LDA(At, 0, 1); PG8_STAGE(PG8_SA(0, 0), a2, voffA);
            PG8_BAR; PG8_WAIT_L(0); PG8_MMA(1, 0, At, B0); PG8_BAR; PG8_SCHED;
            PG8_STAGE(PG8_SB(0, 1), b2 + hstep, voffB);
            PG8_WAIT_V(6); PG8_BAR; PG8_MMA(1, 1, At, B1); PG8_BAR;
            PG8_LDB(B0, 1, 0); PG8_SCHED; PG8_LDA(At, 1, 0); PG8_STAGE(PG8_SA(0, 1), a2 + hstep, voffA);
            PG8_WAIT_L(8); PG8_BAR; PG8_WAIT_L(0); PG8_MMA(0, 0, At, B0); PG8_BAR; PG8_SCHED;
            PG8_LDB(B1, 1, 1); PG8_STAGE(PG8_SB(1, 0), b3, voffB);
            PG8_BAR; PG8_WAIT_L(0); PG8_MMA(0, 1, At, B1); PG8_BAR;
            PG8_LDA(At, 1, 1); PG8_STAGE(PG8_SA(1, 0), a3, voffA);
            PG8_BAR; PG8_WAIT_L(0); PG8_MMA(1, 0, At, B0); PG8_BAR; PG8_SCHED;
            PG8_STAGE(PG8_SB(1, 1), b3 + hstep, voffB);
            PG8_WAIT_V(6); PG8_BAR; PG8_MMA(1, 1, At, B1); PG8_BAR;
            }
        }
        if constexpr (ALIGN_EPI) { if (wr == 0) PG8_BAR; }
        if constexpr (!Epi::AFTER_DRAIN) { E(acc, cur, wr, wc, fr, fq); S.done(cur); }
        if (!has_next) break;
#pragma unroll
        for (int a = 0; a < 2; ++a)
#pragma unroll
            for (int b = 0; b < 2; ++b)
#pragma unroll
                for (int m = 0; m < 4; ++m)
#pragma unroll
                    for (int n = 0; n < 2; ++n) acc[a][b][m][n] = (f32x4){0.f, 0.f, 0.f, 0.f};
        cur = nxt; cA = nA; cB = nB; ++ui; vcur[0][0] = vnxt[0][0]; vcur[0][1] = vnxt[0][1]; vcur[1][0] = vnxt[1][0]; vcur[1][1] = vnxt[1][1];
        if constexpr (ALIGN_EPI) { if (wr == 1) PG8_BAR; }
    }
    PG8_WAIT_V(0);
    if constexpr (!ALIGN_EPI) { if (wr == 0) PG8_BAR; }
    PG8_BAR;
    if constexpr (Epi::AFTER_DRAIN) { E.fused(acc, cur, wr, wc, fr, fq, lds, wid, lane); S.done(cur); }
#undef PG8_GMAP
#undef PG8_SA
#undef PG8_SB
#undef PG8_STAGE
#undef PG8_LDA
#undef PG8_LDB
#undef PG8_MMA
#undef PG8_WAIT_V
#undef PG8_WAIT_L
#undef PG8_BAR
#undef PG8_SCHED
}

}

#define DI __device__ __forceinline__
#define LAS __attribute__((address_space(3)))
typedef unsigned short bf16_t;
typedef short bf16x8 __attribute__((ext_vector_type(8)));
typedef _Float16 f16x8 __attribute__((ext_vector_type(8)));
typedef float f32x4 __attribute__((ext_vector_type(4)));
typedef float f32x16 __attribute__((ext_vector_type(16)));
typedef unsigned u32x4 __attribute__((ext_vector_type(4)));
typedef unsigned u32x2 __attribute__((ext_vector_type(2)));

constexpr int NB = 4, SEQ = 4096, T = NB * SEQ, D = 1024, DEPTH = 2;
constexpr int PLD = 3912;
constexpr int PC_Q = 0, PC_K = 512, PC_V = 1024, PC_QI = 1536, PC_KI = 2048, PC_WI = 2112;
constexpr int PC_R = 2120, PC_BK = 2632, PC_BV = 3144, PC_WD = 3656;
constexpr int NPROJ_PAD = 4096;
constexpr int NEXP = 16, DEXP = 256, PLE = 256;
constexpr float ALPHA = 1.4142135623730951f;
constexpr float LN_EPS = 1e-5f, GN_EPS = 64e-5f;
constexpr int MAXROWS = 2 * T + NEXP * 256;
constexpr int NWAVES = 8, NTHR = 512;

constexpr size_t MiB = 1u << 20;
constexpr size_t WS_CTL = 0, CTL_BYTES = 1 * MiB;
constexpr size_t WS_WEXP = 1 * MiB;
constexpr size_t WS_WDOWN = 17 * MiB;
constexpr size_t WS_WOUT = 25 * MiB, WS_WPG = 27 * MiB, WS_WPLE = 29 * MiB;
constexpr size_t WS_BM = 30 * MiB;
constexpr size_t WS_ELL = 38 * MiB, WS_AA = 70 * MiB, WS_GG = 102 * MiB;
constexpr size_t WS_PROJ = 119 * MiB;
constexpr size_t WS_PBF = 242 * MiB;
constexpr size_t WS_V = 119 * MiB;
constexpr size_t WS_AG = 38 * MiB;
constexpr size_t WS_H = 183 * MiB;
constexpr size_t WS_Y = 119 * MiB;
constexpr size_t WS_PE = 201 * MiB;
constexpr size_t WS_V3 = 38 * MiB;
constexpr size_t WS_TOK = 233 * MiB;
constexpr size_t WS_ROW = 234 * MiB;
constexpr int CW_GCNT = 1024;

struct TokInfo { int e0, e1, p0, p1; float g0, g1; int pad0, pad1; };
struct RowInfo { int token, slot; float gate; int pad; };

#define LDS_WAIT() asm volatile("s_waitcnt lgkmcnt(0)" ::: "memory")
#define VM_WAIT() asm volatile("s_waitcnt vmcnt(0)" ::: "memory")
DI unsigned f2bf(float f) { unsigned u = __builtin_bit_cast(unsigned, f); return (u + 0x7fffu + ((u >> 16) & 1u)) >> 16; }
DI unsigned pk2(float lo, float hi) { return pg8::cvt_pk_bf16(lo, hi); }
DI float bf2f(unsigned short b) { return __builtin_bit_cast(float, (unsigned)b << 16); }
DI float bflo(unsigned w) { return __builtin_bit_cast(float, w << 16); }
DI float bfhi(unsigned w) { return __builtin_bit_cast(float, w & 0xffff0000u); }
DI unsigned pk2h(float lo, float hi) { typedef _Float16 h2_t __attribute__((ext_vector_type(2))); h2_t v = {(_Float16)lo, (_Float16)hi}; return __builtin_bit_cast(unsigned, v); }
DI float wave_sum(float v) {
#pragma unroll
    for (int o = 1; o < 64; o <<= 1) v += __shfl_xor(v, o);
    return v;
}
DI int opaque_i(int v) { asm volatile("" : "+s"(v)); return v; }
DI float sigmoidf_(float x) { return 1.f / (1.f + __expf(-x)); }

struct Args { const float* in[31]; float* out; unsigned char* ws; int ph_lo, ph_hi; };
struct Ctx {
    LAS unsigned char* lds;
    int tid, lane, wave, G, blk;
    const __attribute__((address_space(4))) Args* ap;
    float* out; unsigned char* ws;
    unsigned* ctl;
    bf16_t* xcur; bf16_t* mixcat;
    DI const float* in(int i) const { return ap->in[i]; }
};

DI void ln16(f32x4 (&v)[4], const float* g, const float* b, int lane) {
    float s = 0.f;
#pragma unroll
    for (int j = 0; j < 4; ++j) s += (v[j].x + v[j].y) + (v[j].z + v[j].w);
    const float mean = wave_sum(s) * (1.f / D);
    float s2 = 0.f;
#pragma unroll
    for (int j = 0; j < 4; ++j) { v[j] = v[j] - mean; s2 += (v[j].x * v[j].x + v[j].y * v[j].y) + (v[j].z * v[j].z + v[j].w * v[j].w); }
    const float rstd = 1.f / sqrtf(wave_sum(s2) * (1.f / D) + LN_EPS);
#pragma unroll
    for (int j = 0; j < 4; ++j) { const f32x4 gg = *(const f32x4*)(g + 256 * j + 4 * lane), bb = *(const f32x4*)(b + 256 * j + 4 * lane); v[j] = v[j] * rstd * gg + bb; }
}
DI void store_row_bf16(bf16_t* row, const f32x4 (&v)[4], int lane) {
#pragma unroll
    for (int j = 0; j < 4; ++j) { u32x2 o; o.x = pk2(v[j].x, v[j].y); o.y = pk2(v[j].z, v[j].w); *(u32x2*)(row + 256 * j + 4 * lane) = o; }
}
DI void load_row_bf16(const bf16_t* row, f32x4 (&v)[4], int lane) {
#pragma unroll
    for (int j = 0; j < 4; ++j) { const u32x2 o = *(const u32x2*)(row + 256 * j + 4 * lane); v[j] = (f32x4){bflo(o.x), bfhi(o.x), bflo(o.y), bfhi(o.y)}; }
}

template <class ColPtr>
DI void transpose_item(const ColPtr colptr, int ld, int K, bf16_t* WT, int n0, int k0, LAS float* scr, int lane) {
    const float* sp = colptr(n0 + (lane & 31));
    float tv[32];
#pragma unroll
    for (int i = 0; i < 32; ++i) { const int kk = 2 * i + (lane >> 5); tv[i] = sp ? sp[(size_t)(k0 + kk) * ld] : 0.f; }
#pragma unroll
    for (int i = 0; i < 32; ++i) { const int kk = 2 * i + (lane >> 5); scr[kk * 33 + (lane & 31)] = tv[i]; }
    LDS_WAIT(); asm volatile("" ::: "memory");
    const int c = lane & 7;
#pragma unroll
    for (int j = 0; j < 4; ++j) { const int n = (lane >> 3) + 8 * j; const LAS float* s = scr + (8 * c) * 33 + n;
        u32x4 o; o.x = pk2(s[0 * 33], s[1 * 33]); o.y = pk2(s[2 * 33], s[3 * 33]); o.z = pk2(s[4 * 33], s[5 * 33]); o.w = pk2(s[6 * 33], s[7 * 33]);
        *(u32x4*)(WT + (size_t)(n0 + n) * K + k0 + 8 * c) = o; }
    LDS_WAIT(); asm volatile("" ::: "memory");
}
template <class ColPtr>
DI void convert_matrix(Ctx& C, const ColPtr colptr, int ld, int K, int N, bf16_t* WT, int& first) {
    LAS float* scr = (LAS float*)(C.lds + C.wave * 16384);
    const int gw = C.blk * NWAVES + C.wave, NGW = C.G * NWAVES;
    const int nblk = N / 32, nitems = (K / 64) * nblk;
    int it = gw - (first % NGW); if (it < 0) it += NGW;
    for (; it < nitems; it += NGW) transpose_item(colptr, ld, K, WT, 32 * (it % nblk), 64 * (it / nblk), scr, C.lane);
    first += nitems;
}

struct ColWin { const float* w; DI const float* operator()(int j) const { if (j < 2120) return w + j; if (j >= 2176 && j < 3968) return w + (j - 56); return nullptr; } };
struct ColPlain { const float* w; DI const float* operator()(int j) const { return w + j; } };
struct ColGateUp { const float* wg; const float* wu; DI const float* operator()(int j) const {
        const int e = j >> 9, pn = (j >> 8) & 1, jj = j & 255; const int col = pn * 128 + (jj & 127); const uintptr_t pg = (uintptr_t)wg, pu = (uintptr_t)wu; const uintptr_t sel = pg + ((jj >= 128) ? (pu - pg) : (uintptr_t)0); return (const float*)sel + (size_t)e * D * DEXP + col; } };
struct ColDown { const float* wd; DI const float* operator()(int j) const { return wd + j; } };

DI void phase_ln_in(Ctx& C) {
    const int gw = C.blk * NWAVES + C.wave, NGW = C.G * NWAVES;
    for (int m = gw; m < T; m += NGW) {
        f32x4 v[4]; const float* xr = C.in(0) + (size_t)m * D;
#pragma unroll
        for (int j = 0; j < 4; ++j) v[j] = *(const f32x4*)(xr + 256 * j + 4 * C.lane);
        ln16(v, C.in(2), C.in(3), C.lane);
        store_row_bf16(C.xcur + (size_t)m * D, v, C.lane);
    }
}
DI void convert_win(Ctx& C, int l) { int first = 0; ColWin cw{C.in(4) + (size_t)l * D * 3912}; convert_matrix(C, cw, 3912, D, NPROJ_PAD, (bf16_t*)(C.ws + WS_WEXP), first); }
DI void convert_layer_weights(Ctx& C, int l) {
    int first = 0;
    { ColPlain c{C.in(5) + (size_t)l * D * D}; convert_matrix(C, c, D, D, D, (bf16_t*)(C.ws + WS_WOUT), first); }
    { ColGateUp c{C.in(20) + (size_t)l * NEXP * D * DEXP, C.in(21) + (size_t)l * NEXP * D * DEXP}; convert_matrix(C, c, DEXP, D, NEXP * 512, (bf16_t*)(C.ws + WS_WEXP), first); }
    for (int e = 0; e < NEXP; ++e) { ColDown c{C.in(22) + ((size_t)l * NEXP + e) * DEXP * D}; convert_matrix(C, c, D, DEXP, D, (bf16_t*)(C.ws + WS_WDOWN) + (size_t)e * D * DEXP, first); }
    { ColPlain c{C.in(24) + (size_t)l * D * D}; convert_matrix(C, c, D, D, D, (bf16_t*)(C.ws + WS_WPG), first); }
    { ColPlain c{C.in(23) + (size_t)l * PLE * D}; convert_matrix(C, c, D, PLE, D, (bf16_t*)(C.ws + WS_WPLE), first); }
    const float* p = C.in(1) + (size_t)l * T * PLE; bf16_t* pb = (bf16_t*)(C.ws + WS_PBF);
    for (size_t i = ((size_t)C.blk * NTHR + C.tid) * 8; i < (size_t)T * PLE; i += (size_t)C.G * NTHR * 8) {
        const f32x4 a = *(const f32x4*)(p + i), b = *(const f32x4*)(p + i + 4);
        u32x4 o; o.x = pk2(a.x, a.y); o.y = pk2(a.z, a.w); o.z = pk2(b.x, b.y); o.w = pk2(b.z, b.w); *(u32x4*)(pb + i) = o; }
}

struct EpiProj {
    static constexpr bool PERM = true, AFTER_DRAIN = false;
    bf16_t* P;
    DI void operator()(const f32x4 (&acc)[2][2][4][2], const pg8::Unit& u, int wr, int wc, int fr, int fq) const {
        const int row0 = u.pm * 256 + wr * 64 + fr;
#pragma unroll
        for (int bj = 0; bj < 2; ++bj) {
            const int j0 = u.pn * 256 + bj * 128 + wc * 32 + 8 * fq;
            int dst; bool half = false;
            if (j0 < 2120) { dst = j0; half = (j0 >= 1536); } else if (j0 >= 2176 && j0 < 3968) dst = j0 - 56; else dst = -1;
            if (dst >= 0) {
#pragma unroll
                for (int ai = 0; ai < 2; ++ai)
#pragma unroll
                    for (int m = 0; m < 4; ++m) {
                        const f32x4 v0 = acc[ai][bj][m][0], v1 = acc[ai][bj][m][1]; u32x4 w;
                        if (half) { w.x = pk2h(v0[0], v0[1]); w.y = pk2h(v0[2], v0[3]); w.z = pk2h(v1[0], v1[1]); w.w = pk2h(v1[2], v1[3]); }
                        else { w.x = pk2(v0[0], v0[1]); w.y = pk2(v0[2], v0[3]); w.z = pk2(v1[0], v1[1]); w.w = pk2(v1[2], v1[3]); }
                        *(u32x4*)(P + (size_t)(row0 + ai * 128 + m * 16) * PLD + dst) = w; }
            }
        }
    }
};
struct EpiBf16Plain {
    static constexpr bool PERM = true, AFTER_DRAIN = false;
    bf16_t* O; int ldc;
    DI void operator()(const f32x4 (&acc)[2][2][4][2], const pg8::Unit& u, int wr, int wc, int fr, int fq) const {
        const int row0 = u.pm * 256 + wr * 64 + fr, col0 = u.pn * 256 + wc * 32 + 8 * fq;
#pragma unroll
        for (int ai = 0; ai < 2; ++ai)
#pragma unroll
            for (int m = 0; m < 4; ++m)
#pragma unroll
                for (int bj = 0; bj < 2; ++bj) { const f32x4 v0 = acc[ai][bj][m][0], v1 = acc[ai][bj][m][1]; u32x4 w; w.x = pk2(v0[0], v0[1]); w.y = pk2(v0[2], v0[3]); w.z = pk2(v1[0], v1[1]); w.w = pk2(v1[2], v1[3]);
                    *(u32x4*)(O + (size_t)(row0 + ai * 128 + m * 16) * ldc + col0 + bj * 128) = w; }
    }
};
struct EpiResF32 {
    static constexpr bool PERM = false, AFTER_DRAIN = false;
    const bf16_t* X; bf16_t* V;
    DI void operator()(const f32x4 (&acc)[2][2][4][2], const pg8::Unit& u, int wr, int wc, int fr, int fq) const {
        const int row0 = u.pm * 256 + wr * 64 + fr, col0 = u.pn * 256 + wc * 32 + 4 * fq;
#pragma unroll
        for (int ai = 0; ai < 2; ++ai) {
            u32x2 xr[16];
#pragma unroll
            for (int k = 0; k < 16; ++k) xr[k] = *(const u32x2*)(X + (size_t)(row0 + ai * 128 + (k >> 2) * 16) * D + col0 + ((k >> 1) & 1) * 128 + (k & 1) * 16);
#pragma unroll
            for (int m = 0; m < 4; ++m)
#pragma unroll
                for (int bj = 0; bj < 2; ++bj)
#pragma unroll
                    for (int n = 0; n < 2; ++n) { const size_t off = (size_t)(row0 + ai * 128 + m * 16) * D + col0 + bj * 128 + n * 16;
                        const u32x2 xb = xr[(m * 2 + bj) * 2 + n]; const f32x4 xv = {bflo(xb.x), bfhi(xb.x), bflo(xb.y), bfhi(xb.y)};
                        const f32x4 o = xv * ALPHA + acc[ai][bj][m][n]; u32x2 ob; ob.x = pk2(o.x, o.y); ob.y = pk2(o.z, o.w); *(u32x2*)(V + off) = ob; } }
    }
};
struct EpiPle {
    static constexpr bool PERM = false, AFTER_DRAIN = false;
    const bf16_t* X; const bf16_t* PE; bf16_t* V;
    DI void operator()(const f32x4 (&acc)[2][2][4][2], const pg8::Unit& u, int wr, int wc, int fr, int fq) const {
        const int row0 = u.pm * 256 + wr * 64 + fr, col0 = u.pn * 256 + wc * 32 + 4 * fq;
#pragma unroll
        for (int ai = 0; ai < 2; ++ai) {
            u32x2 xr[16], pr[16];
#pragma unroll
            for (int k = 0; k < 16; ++k) { const size_t o2 = (size_t)(row0 + ai * 128 + (k >> 2) * 16) * D + col0 + ((k >> 1) & 1) * 128 + (k & 1) * 16; xr[k] = *(const u32x2*)(X + o2); pr[k] = *(const u32x2*)(PE + o2); }
#pragma unroll
            for (int m = 0; m < 4; ++m)
#pragma unroll
                for (int bj = 0; bj < 2; ++bj)
#pragma unroll
                    for (int n = 0; n < 2; ++n) { const size_t off = (size_t)(row0 + ai * 128 + m * 16) * D + col0 + bj * 128 + n * 16;
                        const u32x2 xb = xr[(m * 2 + bj) * 2 + n]; const f32x4 xv = {bflo(xb.x), bfhi(xb.x), bflo(xb.y), bfhi(xb.y)};
                        const u32x2 pb = pr[(m * 2 + bj) * 2 + n]; const f32x4 pv = {bflo(pb.x), bfhi(pb.x), bflo(pb.y), bfhi(pb.y)};
                        const f32x4 a = acc[ai][bj][m][n]; f32x4 s; s.x = sigmoidf_(a.x); s.y = sigmoidf_(a.y); s.z = sigmoidf_(a.z); s.w = sigmoidf_(a.w);
                        const f32x4 o = xv * ALPHA + s * pv; u32x2 ob; ob.x = pk2(o.x, o.y); ob.y = pk2(o.z, o.w); *(u32x2*)(V + off) = ob; } }
    }
};
struct EpiSwiGLU {
    static constexpr bool PERM = true, AFTER_DRAIN = false;
    bf16_t* H; const RowInfo* R;
    DI void operator()(const f32x4 (&acc)[2][2][4][2], const pg8::Unit& u, int wr, int wc, int fr, int fq) const {
        const int row0 = u.pm * 256 + wr * 64 + fr, col0 = (u.pn & 1) * 128 + wc * 32 + 8 * fq;
        float gwv[8];
#pragma unroll
        for (int k = 0; k < 8; ++k) gwv[k] = R[row0 + (k >> 2) * 128 + (k & 3) * 16].gate;
#pragma unroll
        for (int ai = 0; ai < 2; ++ai)
#pragma unroll
            for (int m = 0; m < 4; ++m) { const int row = row0 + ai * 128 + m * 16; const float gw = gwv[ai * 4 + m];
                float h[8];
#pragma unroll
                for (int n = 0; n < 2; ++n)
#pragma unroll
                    for (int i = 0; i < 4; ++i) { const float g = acc[ai][0][m][n][i], up = acc[ai][1][m][n][i]; h[4 * n + i] = g * sigmoidf_(g) * up * gw; }
                u32x4 w; w.x = pk2(h[0], h[1]); w.y = pk2(h[2], h[3]); w.z = pk2(h[4], h[5]); w.w = pk2(h[6], h[7]);
                *(u32x4*)(H + (size_t)row * DEXP + col0) = w; }
    }
};
struct EpiDown {
    static constexpr bool PERM = true, AFTER_DRAIN = false;
    bf16_t* Y; const RowInfo* R;
    DI void operator()(const f32x4 (&acc)[2][2][4][2], const pg8::Unit& u, int wr, int wc, int fr, int fq) const {
        const int row0 = u.pm * 256 + wr * 64 + fr, col0 = (u.pn & 3) * 256 + wc * 32 + 8 * fq;
        int tkv[8], slv[8];
#pragma unroll
        for (int k = 0; k < 8; ++k) { const u32x2 q = *(const u32x2*)(R + row0 + (k >> 2) * 128 + (k & 3) * 16); tkv[k] = (int)q.x; slv[k] = (int)q.y; }
#pragma unroll
        for (int ai = 0; ai < 2; ++ai)
#pragma unroll
            for (int m = 0; m < 4; ++m) { RowInfo ri; ri.token = tkv[ai * 4 + m]; ri.slot = slv[ai * 4 + m];
                if (ri.token >= 0) { bf16_t* dst = Y + ((size_t)ri.slot * T + ri.token) * D + col0;
#pragma unroll
                    for (int bj = 0; bj < 2; ++bj) { const f32x4 v0 = acc[ai][bj][m][0], v1 = acc[ai][bj][m][1]; u32x4 w; w.x = pk2(v0[0], v0[1]); w.y = pk2(v0[2], v0[3]); w.z = pk2(v1[0], v1[1]); w.w = pk2(v1[2], v1[3]);
                        *(u32x4*)(dst + bj * 128) = w; } } }
    }
};
template <int NPN> struct GroupedOrder {
    const LAS int* texp; int ntiles, G, c;
    DI bool next(int i, pg8::Unit& u) const { const int L = i * G + c; if (L >= ntiles * NPN) return false; u.pm = L / NPN; u.pn = texp[u.pm] * NPN + (L % NPN); return true; }
    DI void a_ready(const pg8::Unit&) const {}
    DI void done(const pg8::Unit&) const {}
};

constexpr int IDX_CAP = 512;
DI unsigned ordkey(float s) { const unsigned b = __builtin_bit_cast(unsigned, s); return (b & 0x80000000u) ? ~b : (b | 0x80000000u); }
DI float unordkey(unsigned k) { const unsigned b = (k & 0x80000000u) ? (k & 0x7fffffffu) : ~k; return __builtin_bit_cast(float, b); }

DI void idx_item(Ctx& C, int item, int l) {
    const int b = item & 3, qt = 511 - (item >> 2);
    const int t0 = qt * 8, chunk = t0 >> 6, NT32 = 2 * (chunk + 1);
    const size_t tok0 = (size_t)b * SEQ + t0;
    unsigned* bm = (unsigned*)(C.ws + WS_BM);
    const int lane = C.lane, wave = C.wave, tid = C.tid;
    if (chunk < 4) {
        if (tid < 8 * NT32) { const int q = tid / NT32, kt = tid % NT32; bm[(tok0 + q) * 128 + kt] = 0xffffffffu; }
        return;
    }
    const _Float16* ph = (const _Float16*)(C.ws + WS_PROJ);
    LAS unsigned* hist = (LAS unsigned*)(C.lds);
    LAS float* candS = (LAS float*)(C.lds + 8192);
    LAS int* candI = (LAS int*)(C.lds + 24576);
    LAS float* redmn = (LAS float*)(C.lds + 40960);
    LAS float* redmx = redmn + 64;
    LAS int* selB = (LAS int*)(C.lds + 41472);
    LAS unsigned* selAbove = (LAS unsigned*)(selB + 8);
    LAS unsigned* ccount = selAbove + 8;
    LAS float* thrS = (LAS float*)(ccount + 8);
    LAS int* thrI = (LAS int*)(thrS + 8);
    LAS unsigned* ovf = (LAS unsigned*)(thrI + 8);
    LAS unsigned* fbT = ovf + 8;
    LAS unsigned* fbCnt = fbT + 8;
    LAS unsigned* fbNeed = fbCnt + 8;
    const int r = lane & 31, hh = lane >> 5;
    float sc[2][16][2];
    f16x8 afr[2][4]; float wq[2][2][8];
#pragma unroll
    for (int m = 0; m < 2; ++m) {
        const int gq = (r >> 2) & 1, i = r >> 3, jj = r & 3, query = 4 * m + 2 * gq + (i >> 1), head = 4 * (i & 1) + jj;
        const _Float16* qp = ph + (tok0 + query) * PLD + PC_QI + head * 64 + 8 * hh;
#pragma unroll
        for (int s = 0; s < 4; ++s) afr[m][s] = *(const f16x8*)(qp + 16 * s);
#pragma unroll
        for (int qq = 0; qq < 2; ++qq) { const int q2 = 4 * m + 2 * hh + qq; const f16x8 wv = *(const f16x8*)(ph + (tok0 + q2) * PLD + PC_WI);
#pragma unroll
            for (int e = 0; e < 8; ++e) wq[m][qq][e] = (float)wv[e] * 0.044194173824159216f; }
    }
    const _Float16* kbase = ph + ((size_t)b * SEQ + r) * PLD + PC_KI + 8 * hh;
    f16x8 bnx[4];
#pragma unroll
    for (int s = 0; s < 4; ++s) bnx[s] = *(const f16x8*)(kbase + (size_t)(32 * wave) * PLD + 16 * s);
#pragma unroll
    for (int it = 0; it < 16; ++it) {
        const int kt = wave + 8 * it;
        if (kt < NT32) {
            f16x8 bfr[4];
#pragma unroll
            for (int s = 0; s < 4; ++s) bfr[s] = bnx[s];
            if (kt + 8 < NT32) {
#pragma unroll
                for (int s = 0; s < 4; ++s) bnx[s] = *(const f16x8*)(kbase + (size_t)(32 * (kt + 8)) * PLD + 16 * s); }
#pragma unroll
            for (int m = 0; m < 2; ++m) {
                f32x16 c = {};
#pragma unroll
                for (int s = 0; s < 4; ++s) c = __builtin_amdgcn_mfma_f32_32x32x16_f16(afr[m][s], bfr[s], c, 0, 0, 0);
#pragma unroll
                for (int qq = 0; qq < 2; ++qq) { float a = 0.f;
#pragma unroll
                    for (int e = 0; e < 8; ++e) a += wq[m][qq][e] * fmaxf(c[8 * qq + e], 0.f);
                    sc[m][it][qq] = a; }
            }
        } else { sc[0][it][0] = 0.f; sc[0][it][1] = 0.f; sc[1][it][0] = 0.f; sc[1][it][1] = 0.f; }
    }
    float mn[2][2], mx[2][2];
#pragma unroll
    for (int m = 0; m < 2; ++m)
#pragma unroll
        for (int qq = 0; qq < 2; ++qq) { float a = 3.0e38f, z = -3.0e38f;
#pragma unroll
            for (int it = 0; it < 16; ++it) if (wave + 8 * it < NT32) z = fmaxf(z, sc[m][it][qq]);
            a = z;
#pragma unroll
            for (int o = 1; o < 32; o <<= 1) { a = fminf(a, __shfl_xor(a, o)); z = fmaxf(z, __shfl_xor(z, o)); }
            mn[m][qq] = a; mx[m][qq] = z; }
    asm volatile("s_waitcnt lgkmcnt(0)\n\ts_barrier" ::: "memory");
    if (r == 0) {
#pragma unroll
        for (int m = 0; m < 2; ++m)
#pragma unroll
            for (int qq = 0; qq < 2; ++qq) { const int qid = 4 * m + 2 * hh + qq; redmn[wave * 8 + qid] = mn[m][qq]; redmx[wave * 8 + qid] = mx[m][qq]; }
    }
    for (int i = tid; i < 2048; i += NTHR) hist[i] = 0u;
    if (tid < 8) { ccount[tid] = 0u; ovf[tid] = 0u; }
    asm volatile("s_waitcnt lgkmcnt(0)\n\ts_barrier" ::: "memory");
    float lo[2][2], scl[2][2];
#pragma unroll
    for (int m = 0; m < 2; ++m)
#pragma unroll
        for (int qq = 0; qq < 2; ++qq) { const int qid = 4 * m + 2 * hh + qq; float a = 3.0e38f, z = -3.0e38f;
#pragma unroll
            for (int w = 0; w < 8; ++w) { a = fminf(a, redmn[w * 8 + qid]); z = fmaxf(z, redmx[w * 8 + qid]); }
            lo[m][qq] = a; scl[m][qq] = (z > a) ? 256.f / (z - a) : 0.f; }
#define IDX_BIN(m, it, qq) ((sc[m][it][qq] >= lo[m][qq]) ? min(255, (int)((sc[m][it][qq] - lo[m][qq]) * scl[m][qq])) : -1)
#define IDX_LAUNDER() do { _Pragma("unroll") for (int m_ = 0; m_ < 2; ++m_) _Pragma("unroll") for (int q_ = 0; q_ < 2; ++q_) { asm volatile("" : "+v"(lo[m_][q_]), "+v"(scl[m_][q_])); } } while (0)
#pragma unroll
    for (int m = 0; m < 2; ++m)
#pragma unroll
        for (int qq = 0; qq < 2; ++qq) { const int qid = 4 * m + 2 * hh + qq;
#pragma unroll
            for (int it = 0; it < 16; ++it) if (wave + 8 * it < NT32) { const int bin_ = IDX_BIN(m, it, qq); if (bin_ >= 0) __hip_atomic_fetch_add(hist + qid * 256 + bin_, 1u, __ATOMIC_RELAXED, __HIP_MEMORY_SCOPE_WORKGROUP); } }
    asm volatile("s_waitcnt lgkmcnt(0)\n\ts_barrier" ::: "memory");
    {
        const u32x4 h4 = *(const LAS u32x4*)(hist + wave * 256 + 4 * lane);
        const unsigned tot = h4.x + h4.y + h4.z + h4.w; unsigned incl = tot;
#pragma unroll
        for (int o = 1; o < 64; o <<= 1) { const unsigned v = __shfl_down(incl, o); if (lane + o < 64) incl += v; }
        unsigned run = incl - tot; int Bf = -1; unsigned ab = 0;
#pragma unroll
        for (int j = 3; j >= 0; --j) { const unsigned h = h4[j]; if (run < 256u && run + h >= 256u) { Bf = 4 * lane + j; ab = run; } run += h; }
        if (Bf >= 0) { selB[wave] = Bf; selAbove[wave] = ab; }
    }
    asm volatile("s_waitcnt lgkmcnt(0)\n\ts_barrier" ::: "memory");
    IDX_LAUNDER();
#pragma unroll
    for (int m = 0; m < 2; ++m)
#pragma unroll
        for (int qq = 0; qq < 2; ++qq) { const int qid = 4 * m + 2 * hh + qq; const int B = selB[qid];
#pragma unroll
            for (int it = 0; it < 16; ++it) if (wave + 8 * it < NT32) { const bool hit = (IDX_BIN(m, it, qq) == B); if (__any(hit)) { if (hit) { const unsigned pos = __hip_atomic_fetch_add(ccount + qid, 1u, __ATOMIC_RELAXED, __HIP_MEMORY_SCOPE_WORKGROUP);
                if (pos < (unsigned)IDX_CAP) { candS[qid * IDX_CAP + pos] = sc[m][it][qq]; candI[qid * IDX_CAP + pos] = 32 * (wave + 8 * it) + r; } } } } }
    asm volatile("s_waitcnt lgkmcnt(0)\n\ts_barrier" ::: "memory");
    {
        const int c = (int)ccount[wave]; const int need = 256 - (int)selAbove[wave];
        if (c <= IDX_CAP) {
            for (int i = lane; i < c; i += 64) { const float si = candS[wave * IDX_CAP + i]; const int ii = candI[wave * IDX_CAP + i]; int rank = 0;
                for (int j = 0; j < c; ++j) { const float sj = candS[wave * IDX_CAP + j]; const int ij = candI[wave * IDX_CAP + j]; rank += ((sj > si) || (sj == si && ij < ii)) ? 1 : 0; }
                if (rank == need - 1) { thrS[wave] = si; thrI[wave] = ii; } }
        } else if (lane == 0) { ovf[wave] = 1u; fbNeed[wave] = (unsigned)need; fbT[wave] = 0u; }
    }
    asm volatile("s_waitcnt lgkmcnt(0)\n\ts_barrier" ::: "memory");
    unsigned anyovf = 0u;
#pragma unroll
    for (int q = 0; q < 8; ++q) anyovf |= ovf[q];
    if (anyovf) {
        for (int bit = 31; bit >= 0; --bit) {
            if (tid < 8) fbCnt[tid] = 0u;
            asm volatile("s_waitcnt lgkmcnt(0)\n\ts_barrier" ::: "memory");
            IDX_LAUNDER();
#pragma unroll
            for (int m = 0; m < 2; ++m)
#pragma unroll
                for (int qq = 0; qq < 2; ++qq) { const int qid = 4 * m + 2 * hh + qq; if (ovf[qid]) { const unsigned cand = fbT[qid] | (1u << bit); const int B = selB[qid]; unsigned cnt = 0;
#pragma unroll
                    for (int it = 0; it < 16; ++it) if (wave + 8 * it < NT32) cnt += (IDX_BIN(m, it, qq) == B && ordkey(sc[m][it][qq]) >= cand) ? 1u : 0u;
                    if (cnt) __hip_atomic_fetch_add(fbCnt + qid, cnt, __ATOMIC_RELAXED, __HIP_MEMORY_SCOPE_WORKGROUP); } }
            asm volatile("s_waitcnt lgkmcnt(0)\n\ts_barrier" ::: "memory");
            if (tid < 8 && ovf[tid] && fbCnt[tid] >= fbNeed[tid]) fbT[tid] |= (1u << bit);
            asm volatile("s_waitcnt lgkmcnt(0)\n\ts_barrier" ::: "memory");
        }
        if (tid < 8) fbCnt[tid] = 0u;
        asm volatile("s_waitcnt lgkmcnt(0)\n\ts_barrier" ::: "memory");
        IDX_LAUNDER();
#pragma unroll
        for (int m = 0; m < 2; ++m)
#pragma unroll
            for (int qq = 0; qq < 2; ++qq) { const int qid = 4 * m + 2 * hh + qq; if (ovf[qid]) { const unsigned Tk = fbT[qid]; const int B = selB[qid]; unsigned cnt = 0;
#pragma unroll
                for (int it = 0; it < 16; ++it) if (wave + 8 * it < NT32) cnt += (IDX_BIN(m, it, qq) == B && ordkey(sc[m][it][qq]) > Tk) ? 1u : 0u;
                if (cnt) __hip_atomic_fetch_add(fbCnt + qid, cnt, __ATOMIC_RELAXED, __HIP_MEMORY_SCOPE_WORKGROUP); } }
        asm volatile("s_waitcnt lgkmcnt(0)\n\ts_barrier" ::: "memory");
        if (tid < 8 && ovf[tid]) { fbNeed[tid] -= fbCnt[tid]; thrS[tid] = unordkey(fbT[tid]); thrI[tid] = 0; }
        asm volatile("s_waitcnt lgkmcnt(0)\n\ts_barrier" ::: "memory");
        for (int bit = 11; bit >= 0; --bit) {
            if (tid < 8) fbCnt[tid] = 0u;
            asm volatile("s_waitcnt lgkmcnt(0)\n\ts_barrier" ::: "memory");
            IDX_LAUNDER();
#pragma unroll
            for (int m = 0; m < 2; ++m)
#pragma unroll
                for (int qq = 0; qq < 2; ++qq) { const int qid = 4 * m + 2 * hh + qq; if (ovf[qid]) { const unsigned Tk = fbT[qid]; const int B = selB[qid]; const int cand = thrI[qid] | (1 << bit); unsigned cnt = 0;
#pragma unroll
                    for (int it = 0; it < 16; ++it) if (wave + 8 * it < NT32) cnt += (IDX_BIN(m, it, qq) == B && ordkey(sc[m][it][qq]) == Tk && (32 * (wave + 8 * it) + r) < cand) ? 1u : 0u;
                    if (cnt) __hip_atomic_fetch_add(fbCnt + qid, cnt, __ATOMIC_RELAXED, __HIP_MEMORY_SCOPE_WORKGROUP); } }
            asm volatile("s_waitcnt lgkmcnt(0)\n\ts_barrier" ::: "memory");
            if (tid < 8 && ovf[tid] && fbCnt[tid] < fbNeed[tid]) thrI[tid] |= (1 << bit);
            asm volatile("s_waitcnt lgkmcnt(0)\n\ts_barrier" ::: "memory");
        }
    }
    IDX_LAUNDER();
#pragma unroll
    for (int m = 0; m < 2; ++m)
#pragma unroll
        for (int qq = 0; qq < 2; ++qq) { const int qid = 4 * m + 2 * hh + qq; const int B = selB[qid]; const float ts = thrS[qid]; const int ti = thrI[qid];
            unsigned myw = 0u;
#pragma unroll
            for (int it = 0; it < 16; ++it) { const int kt = wave + 8 * it;
                if (kt < NT32) { const int bin = IDX_BIN(m, it, qq); const float s = sc[m][it][qq]; const int idx = 32 * kt + r;
                    const bool sel = (bin > B) || (bin == B && (s > ts || (s == ts && idx <= ti)));
                    const unsigned long long mk = __ballot(sel);
                    const unsigned wv = hh ? (unsigned)(mk >> 32) : (unsigned)mk;
                    if (r == it) myw = wv; } }
            if (r < 16 && wave + 8 * r < NT32) bm[(tok0 + qid) * 128 + wave + 8 * r] = myw; }
#undef IDX_BIN
#undef IDX_LAUNDER
}

DI float softplusf_(float z) { return fmaxf(z, 0.f) + log1pf(expf(-fabsf(z))); }
DI void attn_tile(const LAS unsigned char* kb, const LAS unsigned char* vb, const LAS float* tab, const bf16x8 (&qr)[4], unsigned cw0, unsigned cw1, int j, int qw, int myq, int r32, int hi, float bias_far,
                  float& m_run, float& l_run, f32x16& o0, f32x16& o1, f32x16& negmb) {
    bf16x8 ka[8];
#pragma unroll
    for (int s = 0; s < 4; ++s) { const int ch = 2 * s + hi;
        ka[2 * s] = *(const LAS bf16x8*)(kb + r32 * 128 + ((ch ^ ((r32 >> 1) & 7)) << 4));
        ka[2 * s + 1] = *(const LAS bf16x8*)(kb + (32 + r32) * 128 + ((ch ^ (((32 + r32) >> 1) & 7)) << 4)); }
    f32x16 p0 = negmb, p1 = negmb;
#pragma unroll
    for (int s = 0; s < 4; ++s) { p0 = __builtin_amdgcn_mfma_f32_32x32x16_bf16(ka[2 * s], qr[s], p0, 0, 0, 0); p1 = __builtin_amdgcn_mfma_f32_32x32x16_bf16(ka[2 * s + 1], qr[s], p1, 0, 0, 0); }
    u32x4 va0[4], va1[4];
#pragma unroll
    for (int s = 0; s < 4; ++s) {
        const u32x2 a0l = *(const LAS u32x2*)(vb + (r32) * 136 + (16 * s + 4 * hi) * 2), a0h = *(const LAS u32x2*)(vb + (r32) * 136 + (16 * s + 8 + 4 * hi) * 2);
        const u32x2 a1l = *(const LAS u32x2*)(vb + (32 + r32) * 136 + (16 * s + 4 * hi) * 2), a1h = *(const LAS u32x2*)(vb + (32 + r32) * 136 + (16 * s + 8 + 4 * hi) * 2);
        va0[s] = (u32x4){a0l.x, a0l.y, a0h.x, a0h.y}; va1[s] = (u32x4){a1l.x, a1l.y, a1h.x, a1h.y}; }
    const bool far = (64 * j + 63 - qw) <= -128;
    if (!far) {
#pragma unroll
        for (int g = 0; g < 16; ++g) { const int kv0 = 64 * j + (g & 3) + 8 * (g >> 2) + 4 * hi; int r0 = kv0 - myq, r1 = r0 + 32;
            r0 = r0 < -128 ? -128 : r0; r1 = r1 < -128 ? -128 : r1;
            p0[g] += tab[r0 + 128]; p1[g] += tab[r1 + 128]; }
    }
    float mx = p0[0];
#pragma unroll
    for (int g = 1; g < 16; ++g) mx = fmaxf(mx, p0[g]);
#pragma unroll
    for (int g = 0; g < 16; ++g) mx = fmaxf(mx, p1[g]);
    mx = fmaxf(mx, __shfl_xor(mx, 32));
    if (j == 0 || __any(mx > 0.f)) {
        const float dl = (j == 0) ? mx : fmaxf(mx, 0.f);
        m_run += dl;
        const float al = __builtin_amdgcn_exp2f(-dl); l_run *= al;
#pragma unroll
        for (int g = 0; g < 16; ++g) { p0[g] -= dl; p1[g] -= dl; o0[g] *= al; o1[g] *= al; negmb[g] = bias_far - m_run; }
        asm volatile("" : "+v"(negmb));
    }
    const int sw0 = (int)(cw0 >> (4 * hi)), sw1 = (int)(cw1 >> (4 * hi));
    float ls = 0.f;
#pragma unroll
    for (int g = 0; g < 16; ++g) { const int bit = (g & 3) + 8 * (g >> 2);
        const float e0 = __builtin_amdgcn_exp2f(p0[g]), e1 = __builtin_amdgcn_exp2f(p1[g]);
        int m0_, m1_;
        asm("v_bfe_i32 %0, %1, %2, 1" : "=v"(m0_) : "v"(sw0), "n"(bit)); asm("v_bfe_i32 %0, %1, %2, 1" : "=v"(m1_) : "v"(sw1), "n"(bit));
        p0[g] = __builtin_bit_cast(float, __builtin_bit_cast(int, e0) & m0_); p1[g] = __builtin_bit_cast(float, __builtin_bit_cast(int, e1) & m1_); ls += p0[g] + p1[g]; }
    l_run += ls;
    bf16x8 pb[4];
#pragma unroll
    for (int s = 0; s < 2; ++s) {
        u32x4 w; w.x = pk2(p0[8 * s], p0[8 * s + 1]); w.y = pk2(p0[8 * s + 2], p0[8 * s + 3]); w.z = pk2(p0[8 * s + 4], p0[8 * s + 5]); w.w = pk2(p0[8 * s + 6], p0[8 * s + 7]); pb[s] = __builtin_bit_cast(bf16x8, w);
        u32x4 x; x.x = pk2(p1[8 * s], p1[8 * s + 1]); x.y = pk2(p1[8 * s + 2], p1[8 * s + 3]); x.z = pk2(p1[8 * s + 4], p1[8 * s + 5]); x.w = pk2(p1[8 * s + 6], p1[8 * s + 7]); pb[2 + s] = __builtin_bit_cast(bf16x8, x); }
#pragma unroll
    for (int s = 0; s < 4; ++s) {
        o0 = __builtin_amdgcn_mfma_f32_32x32x16_bf16(__builtin_bit_cast(bf16x8, va0[s]), pb[s], o0, 0, 0, 0);
        o1 = __builtin_amdgcn_mfma_f32_32x32x16_bf16(__builtin_bit_cast(bf16x8, va1[s]), pb[s], o1, 0, 0, 0); }
}
DI void attn_unit(Ctx& C, int b, int h, int qb) {
    const int tid = C.tid, lane = C.lane, wave = C.wave, r32 = lane & 31, hi = lane >> 5;
    const bf16_t* proj = (const bf16_t*)(C.ws + WS_PROJ);
    const unsigned* bm = (const unsigned*)(C.ws + WS_BM);
    LAS unsigned char* Kl = C.lds; LAS unsigned char* Vl = C.lds + 16384; LAS float* tab = (LAS float*)(C.lds + 33792);
    const size_t rowbase = (size_t)b * SEQ; const int q0 = qb * 256, qw = q0 + 32 * wave, myq = qw + r32;
    const int NT = 4 * qb + 4, mylast = qw >> 6;
    constexpr float LOG2E = 1.4426950408889634f;
    __syncthreads();
    if (tid < 192) { const int rel = tid - 128; const int n = rel < 0 ? -rel : rel; int bk = rel > 0 ? 16 : 0;
        if (n < 8) bk += n; else bk += 8 + (n >= 12) + (n >= 16) + (n >= 23) + (n >= 32) + (n >= 46) + (n >= 64) + (n >= 91);
        tab[tid] = (C.in(17)[bk * 8 + h] - C.in(17)[15 * 8 + h]) * LOG2E; }
    const float bias_far = C.in(17)[15 * 8 + h] * LOG2E;
    bf16x8 qr[4];
    { const bf16_t* qp = proj + (rowbase + myq) * PLD + PC_Q + h * 64 + 8 * hi;
#pragma unroll
        for (int s = 0; s < 4; ++s) { const u32x4 raw = *(const u32x4*)(qp + 16 * s); u32x4 sc_;
#pragma unroll
            for (int e = 0; e < 4; ++e) sc_[e] = pk2(bflo(raw[e]) * (0.125f * LOG2E), bfhi(raw[e]) * (0.125f * LOG2E));
            qr[s] = __builtin_bit_cast(bf16x8, sc_); } }
    const unsigned* bmrow = bm + (rowbase + myq) * 128;
    const int skv = tid >> 3, sch = tid & 7;
    const bf16_t* ksrc = proj + (rowbase + skv) * PLD + PC_K + h * 64 + 8 * sch;
    const bf16_t* vsrc = proj + (rowbase + skv) * PLD + PC_V + h * 64 + 8 * sch;
    const int kdst = skv * 128 + ((sch ^ ((skv >> 1) & 7)) << 4);
    const u32x4 m4i = *(const u32x4*)bmrow;
    u32x4 kregA = *(const u32x4*)ksrc, vregA = *(const u32x4*)vsrc; unsigned mA0 = m4i.x, mA1 = m4i.y;
    u32x4 kregB = kregA, vregB = vregA; unsigned mB0 = m4i.z, mB1 = m4i.w;
    if (NT > 1) { kregB = *(const u32x4*)(ksrc + (size_t)64 * PLD); vregB = *(const u32x4*)(vsrc + (size_t)64 * PLD); }
    const bool vodd = (skv & 1) != 0; const int vdst = ((8 * sch + (vodd ? 4 : 0)) * 68 + (skv & ~1)) * 2;
#define ATT_WRITE(buf, kreg, vreg) do { *(LAS u32x4*)(Kl + (buf) * 8192 + kdst) = kreg; LAS unsigned char* vt_ = Vl + (buf) * 8704 + vdst; \
        const unsigned r0_ = (unsigned)__builtin_amdgcn_ds_swizzle((int)(vodd ? vreg.x : vreg.z), 0x201F), r1_ = (unsigned)__builtin_amdgcn_ds_swizzle((int)(vodd ? vreg.y : vreg.w), 0x201F); \
        const unsigned lo0_ = vodd ? r0_ : vreg.x, hi0_ = vodd ? vreg.z : r0_, lo1_ = vodd ? r1_ : vreg.y, hi1_ = vodd ? vreg.w : r1_; \
        *(LAS unsigned*)(vt_ + 0 * 136) = (lo0_ & 0xffffu) | (hi0_ << 16); *(LAS unsigned*)(vt_ + 1 * 136) = (lo0_ >> 16) | (hi0_ & 0xffff0000u); \
        *(LAS unsigned*)(vt_ + 2 * 136) = (lo1_ & 0xffffu) | (hi1_ << 16); *(LAS unsigned*)(vt_ + 3 * 136) = (lo1_ >> 16) | (hi1_ & 0xffff0000u); } while (0)
    ATT_WRITE(0, kregA, vregA);
    __syncthreads();
    float m_run = 0.f, l_run = 0.f; f32x16 o0 = {}, o1 = {}, negmb;
#pragma unroll
    for (int g = 0; g < 16; ++g) negmb[g] = bias_far;
    asm volatile("" : "+v"(negmb));
#define ATT_STEP(J, CW0, CW1, KN, VN, KF, VF, MLOAD) do { const int js_ = (J); const int buf = js_ & 1; \
        if (js_ + 2 < NT) { KF = *(const u32x4*)(ksrc + (size_t)(js_ + 2) * 64 * PLD); VF = *(const u32x4*)(vsrc + (size_t)(js_ + 2) * 64 * PLD); MLOAD; } \
        if (js_ <= mylast) { attn_tile(Kl + buf * 8192, Vl + buf * 8704, tab, qr, (CW0), (CW1), js_, qw, myq, r32, hi, bias_far, m_run, l_run, o0, o1, negmb); } \
        if (js_ + 1 < NT) ATT_WRITE(buf ^ 1, KN, VN); \
        __syncthreads(); } while (0)
    {
        unsigned cA0 = mA0, cA1 = mA1;
        for (int j = 0; j < NT; j += 2) {
            u32x4 m4 = {0u, 0u, 0u, 0u};
            { const unsigned c0 = cA0, c1 = cA1; u32x4 kf = kregA, vf = vregA;
              ATT_STEP(j, c0, c1, kregB, vregB, kf, vf, m4 = *(const u32x4*)(bmrow + 2 * js_ + 4)); kregA = kf; vregA = vf; cA0 = m4.x; cA1 = m4.y; }
            if (j + 1 < NT) {
                const unsigned c0 = mB0, c1 = mB1; u32x4 kf = kregB, vf = vregB;
                ATT_STEP(j + 1, c0, c1, kregA, vregA, kf, vf, (void)0); kregB = kf; vregB = vf; mB0 = m4.z; mB1 = m4.w; }
        }
    }
#undef ATT_STEP
#undef ATT_WRITE
    const float lt = l_run + __shfl_xor(l_run, 32); const float inv = 1.f / lt;
    bf16_t* orow = C.mixcat + (rowbase + myq) * D + h * 64;
#pragma unroll
    for (int i = 0; i < 4; ++i) { const int d = 8 * i + 4 * hi;
        u32x2 w0; w0.x = pk2(o0[4 * i] * inv, o0[4 * i + 1] * inv); w0.y = pk2(o0[4 * i + 2] * inv, o0[4 * i + 3] * inv); *(u32x2*)(orow + d) = w0;
        u32x2 w1; w1.x = pk2(o1[4 * i] * inv, o1[4 * i + 1] * inv); w1.y = pk2(o1[4 * i + 2] * inv, o1[4 * i + 3] * inv); *(u32x2*)(orow + 32 + d) = w1; }
}

constexpr size_t WS_PHI = 38 * MiB, WS_PSI = 54 * MiB, WS_GT = 70 * MiB, WS_Y0T = 86 * MiB, WS_GGT = 102 * MiB, WS_RHO = 118 * MiB;
constexpr size_t WS_S0 = 1 * MiB;
constexpr size_t WS_LORA = 250 * MiB;
DI int crow(int g, int hi) { return (g & 3) + 8 * (g >> 2) + 4 * hi; }
DI f32x16 mfma32(bf16x8 a, bf16x8 b, f32x16 c) { return __builtin_amdgcn_mfma_f32_32x32x16_bf16(a, b, c, 0, 0, 0); }
struct FA { float v[16]; DI float& operator[](int i) { return v[i]; } DI const float& operator[](int i) const { return v[i]; } };
struct F8 { float v[8]; DI float& operator[](int i) { return v[i]; } DI const float& operator[](int i) const { return v[i]; } };
DI bf16x8 pack8(const F8& a) { u32x4 w; w.x = pk2(a[0], a[1]); w.y = pk2(a[2], a[3]); w.z = pk2(a[4], a[5]); w.w = pk2(a[6], a[7]); return __builtin_bit_cast(bf16x8, w); }
DI void pin(FA& a) { asm volatile("" : "+v"(a.v[0]), "+v"(a.v[1]), "+v"(a.v[2]), "+v"(a.v[3]), "+v"(a.v[4]), "+v"(a.v[5]), "+v"(a.v[6]), "+v"(a.v[7]), "+v"(a.v[8]), "+v"(a.v[9]), "+v"(a.v[10]), "+v"(a.v[11]), "+v"(a.v[12]), "+v"(a.v[13]), "+v"(a.v[14]), "+v"(a.v[15])); }
DI void pinf(bf16x8& a) { asm volatile("" : "+v"(a)); }
DI FA toFA(const f32x16& a) { FA r; _Pragma("unroll") for (int i = 0; i < 16; ++i) r.v[i] = a[i]; return r; }
DI f32x16 toV(const FA& a) { f32x16 r; _Pragma("unroll") for (int i = 0; i < 16; ++i) r[i] = a.v[i]; return r; }
DI bf16x8 packfrag(const FA& a, int s) { u32x4 w; w.x = pk2(a[8 * s], a[8 * s + 1]); w.y = pk2(a[8 * s + 2], a[8 * s + 3]); w.z = pk2(a[8 * s + 4], a[8 * s + 5]); w.w = pk2(a[8 * s + 6], a[8 * s + 7]); return __builtin_bit_cast(bf16x8, w); }
DI bf16x8 packfrag(const f32x16& a, int s) { u32x4 w; w.x = pk2(a[8 * s], a[8 * s + 1]); w.y = pk2(a[8 * s + 2], a[8 * s + 3]); w.z = pk2(a[8 * s + 4], a[8 * s + 5]); w.w = pk2(a[8 * s + 6], a[8 * s + 7]); return __builtin_bit_cast(bf16x8, w); }
DI unsigned opq(unsigned v) { asm volatile("" : "+v"(v)); return v; }
DI void st_frag(unsigned char* buf, int f, int lane, bf16x8 v) { *(bf16x8*)(buf + f * 1024 + opq(lane * 16)) = v; }
DI bf16x8 ld_frag(const unsigned char* buf, int f, int lane) { return *(const bf16x8*)(buf + f * 1024 + opq(lane * 16)); }
template <class TT> DI void st_tile_bf16(unsigned char* buf, int q, int lane, const TT& a) { const unsigned o = opq(lane * 32); *(bf16x8*)(buf + q * 2048 + o) = packfrag(a, 0); *(bf16x8*)(buf + q * 2048 + o + 16) = packfrag(a, 1); }
DI FA ld_tile_bf16(const unsigned char* buf, int q, int lane) { const unsigned o = opq(lane * 32); const u32x4 a = *(const u32x4*)(buf + q * 2048 + o), b = *(const u32x4*)(buf + q * 2048 + o + 16); FA r;
    r[0] = bflo(a.x); r[1] = bfhi(a.x); r[2] = bflo(a.y); r[3] = bfhi(a.y); r[4] = bflo(a.z); r[5] = bfhi(a.z); r[6] = bflo(a.w); r[7] = bfhi(a.w);
    r[8] = bflo(b.x); r[9] = bfhi(b.x); r[10] = bflo(b.y); r[11] = bfhi(b.y); r[12] = bflo(b.z); r[13] = bfhi(b.z); r[14] = bflo(b.w); r[15] = bfhi(b.w); return r; }
DI float fexp(float x) { return __builtin_amdgcn_exp2f(x * 1.4426950408889634f); }
DI float flog(float x) { return __builtin_amdgcn_logf(x) * 0.6931471805599453f; }
DI float ftanh(float x) { return 1.f - 2.f * __builtin_amdgcn_rcpf(1.f + fexp(2.f * x)); }
DI float fsigm(float x) { return __builtin_amdgcn_rcpf(1.f + fexp(-x)); }
DI float fsoftplus(float z) { return fmaxf(z, 0.f) + flog(1.f + fexp(-fabsf(z))); }
template <int ACT> DI bf16x8 act_frag(const bf16_t* proj, size_t row, bool first, int c0, const float* mu8) {
    const bf16_t* rp = proj + opq((unsigned)(row * PLD)); const u32x4 cu = *(const u32x4*)(rp + c0); u32x4 pv = {0u, 0u, 0u, 0u}; if (!first) pv = *(const u32x4*)(rp - PLD + c0);
    const float* mq = mu8 + opq(0u); const f32x4 m0 = *(const f32x4*)(mq), m1 = *(const f32x4*)(mq + 4);
    float x[8];
#pragma unroll
    for (int q = 0; q < 4; ++q) { const float c_lo = bflo(cu[q]), c_hi = bfhi(cu[q]), p_lo = bflo(pv[q]), p_hi = bfhi(pv[q]); const float ma = (q < 2) ? m0[2 * q] : m1[2 * q - 4], mb = (q < 2) ? m0[2 * q + 1] : m1[2 * q - 3];
        x[2 * q] = c_lo + (p_lo - c_lo) * ma; x[2 * q + 1] = c_hi + (p_hi - c_hi) * mb; }
#pragma unroll
    for (int e = 0; e < 8; ++e) { if (ACT == 1) x[e] = ftanh(x[e]); else if (ACT == 2) x[e] = fsigm(x[e]); }
    u32x4 w; w.x = pk2(x[0], x[1]); w.y = pk2(x[2], x[3]); w.z = pk2(x[4], x[5]); w.w = pk2(x[6], x[7]); return __builtin_bit_cast(bf16x8, w);
}
DI f32x4 shift4(const bf16_t* proj, size_t row, bool first, int c4, const float* mu4) {
    const bf16_t* rp = proj + opq((unsigned)(row * PLD)); const u32x2 cu = *(const u32x2*)(rp + c4); u32x2 pv = {0u, 0u}; if (!first) pv = *(const u32x2*)(rp - PLD + c4);
    const f32x4 m = *(const f32x4*)(mu4 + opq(0u)); const f32x4 c = {bflo(cu.x), bfhi(cu.x), bflo(cu.y), bfhi(cu.y)}, p = {bflo(pv.x), bfhi(pv.x), bflo(pv.y), bfhi(pv.y)};
    return c + (p - c) * m;
}
DI f32x4 shiftT4(const bf16_t* proj, size_t row, bool firstseq, int c1, float mu1) {
    const bf16_t* rp = proj + opq((unsigned)(row * PLD + c1));
    const float c0 = bf2f(rp[0]), c1_ = bf2f(rp[PLD]), c2 = bf2f(rp[2 * PLD]), c3 = bf2f(rp[3 * PLD]);
    const float pm = firstseq ? 0.f : bf2f(*(rp - PLD));
    f32x4 r; r.x = c0 + (pm - c0) * mu1; r.y = c1_ + (c0 - c1_) * mu1; r.z = c2 + (c1_ - c2) * mu1; r.w = c3 + (c2 - c3) * mu1; return r;
}
DI float scan32_incl(float x, int tl) {
#pragma unroll
    for (int d = 1; d < 32; d <<= 1) { const float y = __shfl_up(x, d, 32); if (tl >= d) x += y; }
    return x;
}

constexpr int RL_ACT = 0;
constexpr int RL_MAB = 0, RL_W1C = 17408, RL_W2C = 26624;
constexpr int RL_ELL = 35840;
constexpr int RL_AV = RL_ELL + 16640, RL_MAK = RL_ELL, RL_NRB = RL_ELL + 9216, RL_NRK = RL_ELL + 18432;
constexpr int RL_RT = 69120, RL_AT = RL_RT + 9216, RL_BT = RL_RT + 18432, RL_KT = RL_RT + 27648;
constexpr int RL_X2 = RL_AT;
constexpr int RL_BHC = 105984, RL_KHC = RL_BHC + 9216, RL_VC = RL_BHC + 18432;
constexpr int RL_X = 133632;
constexpr int RL_SM = 150272;
constexpr int RL_END = RL_SM + 512;
template <int KS> DI f32x16 mm_ll(const LAS bf16_t* a, int pa, const LAS bf16_t* b, int pb, int lane, f32x16 acc) {
    const LAS bf16_t* ap = a + (lane & 31) * pa + 8 * (lane >> 5); const LAS bf16_t* bp = b + (lane & 31) * pb + 8 * (lane >> 5);
#pragma unroll
    for (int s = 0; s < KS; ++s) acc = mfma32(*(const LAS bf16x8*)(ap + 16 * s), *(const LAS bf16x8*)(bp + 16 * s), acc);
    return acc;
}
DI void rwkv_chunk_acts(Ctx& C, int bc, int l, bf16x8 (&actv)[4]) {
    const int chunk = bc & 63, b = bc >> 6, t = C.tid >> 3, cg = C.tid & 7; const size_t row = (size_t)b * SEQ + chunk * 64 + t; const bool first = (chunk == 0 && t == 0);
    const bf16_t* proj = (const bf16_t*)(C.ws + WS_PROJ); const float* mu = C.in(6) + (size_t)l * 1792;
#pragma unroll
    for (int q = 0; q < 4; ++q) { const int c8 = cg * 32 + 8 * q;
        if (c8 < 64) actv[q] = act_frag<1>(proj, row, first, PC_WD + c8, mu + 1536 + c8); else if (c8 < 128) actv[q] = act_frag<0>(proj, row, first, PC_WD + c8, mu + 1536 + c8); else actv[q] = act_frag<2>(proj, row, first, PC_WD + c8, mu + 1536 + c8); }
}
#define LBAR() asm volatile("s_waitcnt lgkmcnt(0)\n\ts_barrier" ::: "memory")
DI void rwkv_head_item(Ctx& C, int item, int l, const bf16x8 (&actv)[4]) {
    const int h = item & 7, chunk = (item >> 3) & 63, b = item >> 9, tid = C.tid, lane = C.lane, wave = C.wave, tl = lane & 31, hi = lane >> 5;
    const size_t tok0 = (size_t)b * SEQ + chunk * 64;
    const bf16_t* proj = (const bf16_t*)(C.ws + WS_PROJ);
    const size_t chid = ((size_t)(b * 8 + h) * 64 + chunk) * 8192;
    unsigned char* PHI = C.ws + WS_PHI + chid; unsigned char* PSI = C.ws + WS_PSI + chid; unsigned char* GT = C.ws + WS_GT + chid; unsigned char* Y0T = C.ws + WS_Y0T + chid; unsigned char* GGT = C.ws + WS_GGT + chid;
    const bf16_t* WDT = (const bf16_t*)(C.ws + WS_LORA); const bf16_t* WAT = WDT + 512 * 64; const bf16_t* WGT = WAT + 512 * 64;
    const float* mu = C.in(6) + (size_t)l * 1792;
    const float* w0p = C.in(7) + l * 512 + 64 * h; const float* a0p = C.in(9) + l * 512 + 64 * h;
    const float* kkp = C.in(12) + l * 512 + 64 * h; const float* kap = C.in(13) + l * 512 + 64 * h; const float* rkp = C.in(14) + l * 512 + 64 * h;
    LAS bf16_t* ACT = (LAS bf16_t*)(C.lds + RL_ACT); LAS float* MAB = (LAS float*)(C.lds + RL_MAB); LAS bf16_t* W1C = (LAS bf16_t*)(C.lds + RL_W1C); LAS bf16_t* W2C = (LAS bf16_t*)(C.lds + RL_W2C);
    LAS float* ELL = (LAS float*)(C.lds + RL_ELL); LAS float* AV = (LAS float*)(C.lds + RL_AV);
    LAS bf16_t* MAK = (LAS bf16_t*)(C.lds + RL_MAK); LAS bf16_t* NRB = (LAS bf16_t*)(C.lds + RL_NRB); LAS bf16_t* NRK = (LAS bf16_t*)(C.lds + RL_NRK);
    LAS bf16_t* AT = (LAS bf16_t*)(C.lds + RL_AT); LAS bf16_t* RT = (LAS bf16_t*)(C.lds + RL_RT); LAS bf16_t* BT = (LAS bf16_t*)(C.lds + RL_BT); LAS bf16_t* KT = (LAS bf16_t*)(C.lds + RL_KT);
    LAS bf16_t* BHC = (LAS bf16_t*)(C.lds + RL_BHC); LAS bf16_t* KHC = (LAS bf16_t*)(C.lds + RL_KHC); LAS bf16_t* VC = (LAS bf16_t*)(C.lds + RL_VC);
    LAS float* X = (LAS float*)(C.lds + RL_X); LAS float* X2 = (LAS float*)(C.lds + RL_X2); LAS float* INV = (LAS float*)(C.lds + RL_SM); LAS float* LCv = INV + 64;
    LBAR();
#ifndef RWR12
#define RWR12 1
#define RWR4 1
#define RWR5 1
#define RWR11 1
#endif
    for (int rr_ = 0; rr_ < RWR12; ++rr_) {
    const int jp = (wave >> 1) & 1, jq = wave & 1;
    bf16x8 wfr[8];
    if (wave < 4) { const bf16_t* W = WGT + (size_t)(64 * h + 32 * jp + tl) * 128 + 8 * hi;
#pragma unroll
        for (int s = 0; s < 8; ++s) wfr[s] = *(const bf16x8*)(W + 16 * s);
    } else { const bf16_t* W0 = WDT + (size_t)(64 * h + 32 * jq + tl) * 64 + 8 * hi; const bf16_t* W1 = WAT + (size_t)(64 * h + 32 * jq + tl) * 64 + 8 * hi;
#pragma unroll
        for (int s = 0; s < 4; ++s) { wfr[s] = *(const bf16x8*)(W0 + 16 * s); wfr[4 + s] = *(const bf16x8*)(W1 + 16 * s); } }
    { const int t = tid >> 3, cg = tid & 7;
#pragma unroll
        for (int q = 0; q < 4; ++q) *(LAS bf16x8*)(ACT + t * 264 + cg * 32 + 8 * q) = actv[q]; }
    LBAR();
    if (wave < 4) {
        const LAS bf16_t* bp = ACT + (32 * jq + tl) * 264 + 128 + 8 * hi; f32x16 acc = {};
#pragma unroll
        for (int s = 0; s < 8; ++s) acc = mfma32(wfr[s], *(const LAS bf16x8*)(bp + 16 * s), acc);
        st_tile_bf16(GGT, jp * 2 + jq, lane, acc);
    } else {
        const LAS bf16_t* ap = ACT + (32 * jp + tl) * 264 + 8 * hi; f32x16 a0 = {}, a1 = {};
#pragma unroll
        for (int s = 0; s < 4; ++s) { a0 = mfma32(*(const LAS bf16x8*)(ap + 16 * s), wfr[s], a0); a1 = mfma32(*(const LAS bf16x8*)(ap + 64 + 16 * s), wfr[4 + s], a1); }
        const int ch = 32 * jq + tl; const float w0c = w0p[ch], a0c = a0p[ch];
#pragma unroll
        for (int g = 0; g < 16; ++g) { const int t = 32 * jp + crow(g, hi); ELL[t * 65 + ch] = -fexp(-fsoftplus(-(w0c + a0[g])) - 0.5f); AV[t * 65 + ch] = fsigm(a0c + a1[g]); }
    }
    LBAR();
    }
    { const int ch = tid & 63, seg = tid >> 6; float p[8]; float run = 0.f;
#pragma unroll
        for (int e = 0; e < 8; ++e) { run += ELL[(8 * seg + e) * 65 + ch]; p[e] = run; }
        X[seg * 65 + ch] = run;
        LBAR();
        float off = 0.f;
#pragma unroll
        for (int s2 = 0; s2 < 7; ++s2) off += (s2 < seg) ? X[s2 * 65 + ch] : 0.f;
#pragma unroll
        for (int e = 0; e < 8; ++e) ELL[(8 * seg + e) * 65 + ch] = off + p[e];
        if (seg == 7) LCv[ch] = off + p[7]; }
    LBAR();
    for (int rr_ = 0; rr_ < RWR4; ++rr_) {
    { const int t = tid >> 3, c0 = (tid & 7) * 8; const size_t row = tok0 + t; const bool first = (chunk == 0 && t == 0); float rho = 0.f, n2 = 0.f;
        f32x4 r4[2], k4[2], v4[2];
#pragma unroll
        for (int q = 0; q < 2; ++q) { const int c = c0 + 4 * q;
            r4[q] = shift4(proj, row, first, PC_R + 64 * h + c, mu + 64 * h + c); k4[q] = shift4(proj, row, first, PC_BK + 64 * h + c, mu + 512 + 64 * h + c); v4[q] = shift4(proj, row, first, PC_BV + 64 * h + c, mu + 1024 + 64 * h + c);
            const f32x4 kr = k4[q] * *(const f32x4*)(kkp + c); n2 += (kr.x * kr.x + kr.y * kr.y) + (kr.z * kr.z + kr.w * kr.w); }
        n2 += __shfl_xor(n2, 1); n2 += __shfl_xor(n2, 2); n2 += __shfl_xor(n2, 4);
        const float inv = 1.f / fmaxf(sqrtf(n2), 1e-12f);
        F8 vA, vR, vB, vK;
#pragma unroll
        for (int q = 0; q < 2; ++q) { const int c = c0 + 4 * q;
            const f32x4 kk4 = *(const f32x4*)(kkp + c), ka4 = *(const f32x4*)(kap + c), rk4 = *(const f32x4*)(rkp + c);
#pragma unroll
            for (int jj = 0; jj < 4; ++jj) { const int ch = c + jj; const float a = AV[t * 65 + ch], L = ELL[t * 65 + ch], Lp = t ? ELL[(t - 1) * 65 + ch] : 0.f, LC = LCv[ch];
                const float kk = k4[q][jj] * kk4[jj] * inv, kp = k4[q][jj] * (1.f + (a - 1.f) * ka4[jj]), bb = kk * a;
                const float eL = fexp(L), eN = fexp(-L), eP = fexp(Lp), eD = fexp(LC - L);
                rho += r4[q][jj] * kp * rk4[jj];
                const float xa = -kk * eP; vA[4 * q + jj] = xa; vR[4 * q + jj] = r4[q][jj] * eL; vB[4 * q + jj] = bb * eN; vK[4 * q + jj] = kp * eN;
                X[t * 65 + ch] = xa; BHC[ch * 72 + t] = (bf16_t)f2bf(bb * eD); KHC[ch * 72 + t] = (bf16_t)f2bf(kp * eD); VC[ch * 72 + t] = (bf16_t)f2bf(v4[q][jj]); } }
        *(LAS bf16x8*)(AT + t * 72 + c0) = pack8(vA); *(LAS bf16x8*)(RT + t * 72 + c0) = pack8(vR); *(LAS bf16x8*)(BT + t * 72 + c0) = pack8(vB); *(LAS bf16x8*)(KT + t * 72 + c0) = pack8(vK);
        rho += __shfl_xor(rho, 1); rho += __shfl_xor(rho, 2); rho += __shfl_xor(rho, 4);
        if ((tid & 7) == 0) ((float*)(C.ws + WS_RHO))[row * 8 + h] = rho; }
    LBAR();
    }
    for (int rr_ = 0; rr_ < RWR5; ++rr_) {
    for (int job = wave; job < 16; job += 8) {
        const int kind = job >> 2, ti = (job >> 1) & 1, tj = job & 1;
        const LAS bf16_t* a = (kind < 2 ? AT : RT) + 32 * ti * 72; const LAS bf16_t* bm = ((kind & 1) ? KT : BT) + 32 * tj * 72;
        f32x16 acc = {};
        if (!(ti == 0 && tj == 1)) acc = mm_ll<4>(a, 72, bm, 72, lane, acc);
#pragma unroll
        for (int g = 0; g < 16; ++g) { const int i = 32 * ti + crow(g, hi), j = 32 * tj + tl; const bool keep = (kind < 2) ? (j < i) : (j <= i); const float v = keep ? acc[g] : 0.f;
            if (kind == 0) MAB[i * 68 + j] = v; else (kind == 1 ? MAK : kind == 2 ? NRB : NRK)[i * 72 + j] = (bf16_t)f2bf(v); }
    }
    LBAR();
    }
    if (wave < 4) { const int ti = wave >> 1, tv = wave & 1; f32x16 acc = {}; acc = mm_ll<4>(MAK + 32 * ti * 72, 72, VC + 32 * tv * 72, 72, lane, acc);
#pragma unroll
        for (int g = 0; g < 16; ++g) X2[(32 * ti + crow(g, hi)) * 65 + 32 * tv + tl] = acc[g]; }
    LBAR();
    for (int bk = 0; bk < 4; ++bk) {
        const int r0 = 16 * bk;
        if (wave < 2) {
            LAS float* XX = wave ? X2 : X; float x[16];
#pragma unroll
            for (int i = 0; i < 16; ++i) x[i] = XX[(r0 + i) * 65 + lane];
#pragma unroll
            for (int i = 1; i < 16; ++i) { const LAS float* mr = MAB + (r0 + i) * 68 + r0; float a_ = x[i];
#pragma unroll
                for (int q = 0; q < (i + 3) / 4; ++q) { const f32x4 m4 = *(const LAS f32x4*)(mr + 4 * q);
#pragma unroll
                    for (int e = 0; e < 4; ++e) if (4 * q + e < i) a_ += m4[e] * x[4 * q + e]; }
                x[i] = a_; }
#pragma unroll
            for (int i = 1; i < 16; ++i) XX[(r0 + i) * 65 + lane] = x[i];
        }
        LBAR();
        if (bk < 3) {
            const int mat = wave >> 2, rt = (wave >> 1) & 1, ctl = wave & 1;
            if (32 * rt + 31 >= r0 + 16) {
                LAS float* XX = mat ? X2 : X;
                F8 av8, bv8;
#pragma unroll
                for (int e = 0; e < 8; ++e) { av8[e] = MAB[(32 * rt + tl) * 68 + r0 + 8 * hi + e]; bv8[e] = XX[(r0 + 8 * hi + e) * 65 + 32 * ctl + tl]; }
                f32x16 acc;
#pragma unroll
                for (int g = 0; g < 16; ++g) acc[g] = XX[(32 * rt + crow(g, hi)) * 65 + 32 * ctl + tl];
                acc = mfma32(pack8(av8), pack8(bv8), acc);
#pragma unroll
                for (int g = 0; g < 16; ++g) { const int i = 32 * rt + crow(g, hi); if (i >= r0 + 16) XX[i * 65 + 32 * ctl + tl] = acc[g]; }
            }
            LBAR();
        }
    }
    { const int k = tid >> 3, i0 = (tid & 7) * 8; F8 v, w;
#pragma unroll
        for (int e = 0; e < 8; ++e) { v[e] = X[(i0 + e) * 65 + k]; w[e] = X2[(i0 + e) * 65 + k]; }
        *(LAS bf16x8*)(W1C + k * 72 + i0) = pack8(v); *(LAS bf16x8*)(W2C + k * 72 + i0) = pack8(w); }
    LBAR();
    for (int rr_ = 0; rr_ < RWR11; ++rr_) {
    for (int job = wave; job < 16; job += 8) {
        const int kind = job >> 2, p = (job >> 1) & 1, q = job & 1; f32x16 acc = {};
        if (kind == 0) {
            acc = mm_ll<4>(W1C + 32 * p * 72, 72, NRB + 32 * q * 72, 72, lane, acc);
            FA fa;
#pragma unroll
            for (int g = 0; g < 16; ++g) fa[g] = acc[g] + bf2f(RT[(32 * q + tl) * 72 + 32 * p + crow(g, hi)]);
            st_frag(GT, (p * 2 + q) * 2 + 0, lane, packfrag(fa, 0)); st_frag(GT, (p * 2 + q) * 2 + 1, lane, packfrag(fa, 1));
        } else if (kind == 1) {
            acc = mm_ll<4>(W2C + 32 * p * 72, 72, NRB + 32 * q * 72, 72, lane, acc); acc = mm_ll<4>(VC + 32 * p * 72, 72, NRK + 32 * q * 72, 72, lane, acc);
            st_tile_bf16(Y0T, p * 2 + q, lane, acc);
        } else if (kind == 2) {
            acc = mm_ll<4>(W1C + 32 * p * 72, 72, BHC + 32 * q * 72, 72, lane, acc);
            FA fa = toFA(acc);
            if (p == q) { const float pc = fexp(LCv[32 * q + tl]);
#pragma unroll
                for (int g = 0; g < 16; ++g) if (crow(g, hi) == tl) fa[g] += pc; }
            st_frag(PHI, (p * 2 + q) * 2 + 0, lane, packfrag(fa, 0)); st_frag(PHI, (p * 2 + q) * 2 + 1, lane, packfrag(fa, 1));
        } else {
            acc = mm_ll<4>(BHC + 32 * p * 72, 72, W2C + 32 * q * 72, 72, lane, acc); acc = mm_ll<4>(KHC + 32 * p * 72, 72, VC + 32 * q * 72, 72, lane, acc);
            st_tile_bf16(PSI, p * 2 + q, lane, acc);
        }
    }
    LBAR();
    }
}

#undef LBAR
DI void scan_ld(const unsigned char* ws, int bh, int chunk, int vt, int lane, u32x4 (&nr)[4], bf16x8 (&ph)[8]) {
    const size_t chid = ((size_t)bh * 64 + chunk) * 8192;
    const unsigned char* PHI = ws + WS_PHI + chid; const unsigned char* PSI = ws + WS_PSI + chid; const unsigned o = opq(lane * 32);
#pragma unroll
    for (int ct = 0; ct < 2; ++ct) { nr[2 * ct] = *(const u32x4*)(PSI + (ct * 2 + vt) * 2048 + o); nr[2 * ct + 1] = *(const u32x4*)(PSI + (ct * 2 + vt) * 2048 + o + 16); }
#pragma unroll
    for (int ct = 0; ct < 2; ++ct)
#pragma unroll
        for (int cp = 0; cp < 2; ++cp)
#pragma unroll
            for (int s = 0; s < 2; ++s) ph[(ct * 2 + cp) * 2 + s] = ld_frag(PHI, (cp * 2 + ct) * 2 + s, lane);
}
DI f32x16 scan_cv(const u32x4& a, const u32x4& b) { f32x16 r;
    r[0] = bflo(a.x); r[1] = bfhi(a.x); r[2] = bflo(a.y); r[3] = bfhi(a.y); r[4] = bflo(a.z); r[5] = bfhi(a.z); r[6] = bflo(a.w); r[7] = bfhi(a.w);
    r[8] = bflo(b.x); r[9] = bfhi(b.x); r[10] = bflo(b.y); r[11] = bfhi(b.y); r[12] = bflo(b.z); r[13] = bfhi(b.z); r[14] = bflo(b.w); r[15] = bfhi(b.w); return r; }
DI void rwkv_scan_wave(Ctx& C, int id) {
    const int vt = id & 1, bh = id >> 1, lane = C.lane;
    f32x16 S[2] = {{}, {}};
    u32x4 nr[4]; bf16x8 pf[8];
    scan_ld(C.ws, bh, 0, vt, lane, nr, pf);
    for (int chunk = 0; chunk < 64; ++chunk) {
        const size_t chid = ((size_t)bh * 64 + chunk) * 8192;
        unsigned char* S0B = C.ws + WS_S0 + chid;
        bf16x8 sh[2][2], sl[2][2];
        f32x16 N[2] = {scan_cv(nr[0], nr[1]), scan_cv(nr[2], nr[3])};
        bf16x8 pc[8];
#pragma unroll
        for (int i = 0; i < 8; ++i) pc[i] = pf[i];
        scan_ld(C.ws, bh, min(chunk + 1, 63), vt, lane, nr, pf);
        asm volatile("" ::: "memory");
#pragma unroll
        for (int cp = 0; cp < 2; ++cp)
#pragma unroll
            for (int s = 0; s < 2; ++s) { sh[cp][s] = packfrag(S[cp], s); st_frag(S0B, (cp * 2 + vt) * 2 + s, lane, sh[cp][s]);
                const u32x4 hw = __builtin_bit_cast(u32x4, sh[cp][s]); u32x4 lw;
#pragma unroll
                for (int q = 0; q < 4; ++q) lw[q] = pk2(S[cp][8 * s + 2 * q] - bflo(hw[q]), S[cp][8 * s + 2 * q + 1] - bfhi(hw[q]));
                sl[cp][s] = __builtin_bit_cast(bf16x8, lw); }
#pragma unroll
        for (int ct = 0; ct < 2; ++ct) {
#pragma unroll
            for (int cp = 0; cp < 2; ++cp)
#pragma unroll
                for (int s = 0; s < 2; ++s) { const bf16x8 ph = pc[(ct * 2 + cp) * 2 + s]; N[ct] = mfma32(ph, sh[cp][s], N[ct]); N[ct] = mfma32(ph, sl[cp][s], N[ct]); } }
        S[0] = N[0]; S[1] = N[1];
    }
}

DI void rwkv_out_wave(Ctx& C, int id, int l) {
    const int chunk = id & 63, bh = id >> 6, b = bh >> 3, h = bh & 7, lane = C.lane, tl = lane & 31, hi = lane >> 5;
    const size_t chid = (size_t)id * 8192; const size_t tok0 = (size_t)b * SEQ + chunk * 64;
    const unsigned char* GT = C.ws + WS_GT + chid; const unsigned char* Y0T = C.ws + WS_Y0T + chid; const unsigned char* GGT = C.ws + WS_GGT + chid; const unsigned char* S0B = C.ws + WS_S0 + chid;
    const bf16_t* proj = (const bf16_t*)(C.ws + WS_PROJ);
    const float* mu = C.in(6) + (size_t)l * 1792; const float* gng = C.in(15) + l * 512 + 64 * h; const float* gnb = C.in(16) + l * 512 + 64 * h;
    const float* RHO = (const float*)(C.ws + WS_RHO);
    LAS unsigned char* stg = C.lds + C.wave * 9216;
    FA Y[2][2];
#pragma unroll
    for (int vt = 0; vt < 2; ++vt)
#pragma unroll
        for (int tt = 0; tt < 2; ++tt) { f32x16 acc = toV(ld_tile_bf16(Y0T, vt * 2 + tt, lane));
#pragma unroll
            for (int cp = 0; cp < 2; ++cp)
#pragma unroll
                for (int s = 0; s < 2; ++s) acc = mfma32(ld_frag(S0B, (cp * 2 + vt) * 2 + s, lane), ld_frag(GT, (cp * 2 + tt) * 2 + s, lane), acc);
            Y[vt][tt] = toFA(acc); }
#pragma unroll
    for (int tt = 0; tt < 2; ++tt) {
        float s1 = 0.f;
#pragma unroll
        for (int vt = 0; vt < 2; ++vt)
#pragma unroll
            for (int g = 0; g < 16; ++g) s1 += Y[vt][tt][g];
        s1 += __shfl_xor(s1, 32); const float mean = s1 * (1.f / 64.f);
        float s2 = 0.f;
#pragma unroll
        for (int vt = 0; vt < 2; ++vt)
#pragma unroll
            for (int g = 0; g < 16; ++g) { const float d = Y[vt][tt][g] - mean; s2 += d * d; }
        s2 += __shfl_xor(s2, 32); const float rstd = 1.f / sqrtf(s2 * (1.f / 64.f) + GN_EPS);
        const size_t row = tok0 + 32 * tt + tl; const bool first = (chunk == 0 && tt == 0 && tl == 0);
        const float rho = RHO[row * 8 + h];
#pragma unroll
        for (int vt = 0; vt < 2; ++vt) { const FA gt = ld_tile_bf16(GGT, vt * 2 + tt, lane);
#pragma unroll
            for (int i = 0; i < 4; ++i) { const int c = 32 * vt + 8 * i + 4 * hi;
                const f32x4 v4 = shift4(proj, row, first, PC_BV + 64 * h + c, mu + 1024 + 64 * h + c); const f32x4 gg = *(const f32x4*)(gng + c), gb = *(const f32x4*)(gnb + c);
                float o[4];
#pragma unroll
                for (int jj = 0; jj < 4; ++jj) { const int g = 4 * i + jj; o[jj] = ((Y[vt][tt][g] - mean) * rstd * gg[jj] + gb[jj] + rho * v4[jj]) * gt[g]; }
                u32x2 w; w.x = pk2(o[0], o[1]); w.y = pk2(o[2], o[3]); *(LAS u32x2*)(stg + (32 * tt + tl) * 144 + c * 2) = w; } }
    }
    asm volatile("s_waitcnt lgkmcnt(0)" ::: "memory");
#pragma unroll
    for (int k = 0; k < 8; ++k) { const int t = (lane >> 3) + 8 * k, cch = lane & 7; const u32x4 w = *(const LAS u32x4*)(stg + t * 144 + cch * 16);
        *(u32x4*)(C.mixcat + (tok0 + t) * D + 512 + 64 * h + cch * 8) = w; }
    asm volatile("s_waitcnt lgkmcnt(0)" ::: "memory");
}

constexpr int GB_OFF = 163840 - 256;
DI void gbar(LAS unsigned* cnt, unsigned& target, int lane) {
    asm volatile("s_waitcnt lgkmcnt(0)" ::: "memory");
    target += 4u;
    if (lane == 0) __hip_atomic_fetch_add(cnt, 1u, __ATOMIC_RELAXED, __HIP_MEMORY_SCOPE_WORKGROUP);
    while (__hip_atomic_load(cnt, __ATOMIC_RELAXED, __HIP_MEMORY_SCOPE_WORKGROUP) < target) __builtin_amdgcn_s_sleep(1);
    asm volatile("" ::: "memory");
}
DI void rwkv_chunk_acts4(Ctx& C, int bc, int l, bf16x8 (&actv)[8]) {
    const int chunk = bc & 63, b = bc >> 6, t = C.tid & 63, cg = C.wave & 3; const size_t row = (size_t)b * SEQ + chunk * 64 + t; const bool first = (chunk == 0 && t == 0);
    const bf16_t* proj = (const bf16_t*)(C.ws + WS_PROJ); const float* mu = C.in(6) + (size_t)l * 1792;
#pragma unroll
    for (int q = 0; q < 8; ++q) { const int c8 = cg * 64 + 8 * q;
        if (c8 < 64) actv[q] = act_frag<1>(proj, row, first, PC_WD + c8, mu + 1536 + c8); else if (c8 < 128) actv[q] = act_frag<0>(proj, row, first, PC_WD + c8, mu + 1536 + c8); else actv[q] = act_frag<2>(proj, row, first, PC_WD + c8, mu + 1536 + c8); }
}
#ifndef RW4_12
#define RW4_12 1
#endif
#ifndef RW4_4
#define RW4_4 1
#endif
#ifndef RW4_5
#define RW4_5 1
#endif
#ifndef RW4_11
#define RW4_11 1
#endif
#define GBA() gbar(gcnt, gtarget, lane)
DI void rwkv_head_item4(Ctx& C, int item, int l, const bf16x8 (&actv)[8], LAS unsigned* gcnt, unsigned& gtarget) {
    const int h = item & 7, chunk = (item >> 3) & 63, b = item >> 9, tid = C.tid, lane = C.lane, wave = C.wave, tl = lane & 31, hi = lane >> 5;
    const size_t tok0 = (size_t)b * SEQ + chunk * 64;
    const bf16_t* proj = (const bf16_t*)(C.ws + WS_PROJ);
    const size_t chid = ((size_t)(b * 8 + h) * 64 + chunk) * 8192;
    unsigned char* PHI = C.ws + WS_PHI + chid; unsigned char* PSI = C.ws + WS_PSI + chid; unsigned char* GT = C.ws + WS_GT + chid; unsigned char* Y0T = C.ws + WS_Y0T + chid; unsigned char* GGT = C.ws + WS_GGT + chid;
    const bf16_t* WDT = (const bf16_t*)(C.ws + WS_LORA); const bf16_t* WAT = WDT + 512 * 64; const bf16_t* WGT = WAT + 512 * 64;
    const float* mu = C.in(6) + (size_t)l * 1792;
    const float* w0p = C.in(7) + l * 512 + 64 * h; const float* a0p = C.in(9) + l * 512 + 64 * h;
    const float* kkp = C.in(12) + l * 512 + 64 * h; const float* kap = C.in(13) + l * 512 + 64 * h; const float* rkp = C.in(14) + l * 512 + 64 * h;
    LAS bf16_t* ACT = (LAS bf16_t*)(C.lds + RL_ACT); LAS float* MAB = (LAS float*)(C.lds + RL_MAB); LAS bf16_t* W1C = (LAS bf16_t*)(C.lds + RL_W1C); LAS bf16_t* W2C = (LAS bf16_t*)(C.lds + RL_W2C);
    LAS float* ELL = (LAS float*)(C.lds + RL_ELL); LAS float* AV = (LAS float*)(C.lds + RL_AV);
    LAS bf16_t* MAK = (LAS bf16_t*)(C.lds + RL_MAK); LAS bf16_t* NRB = (LAS bf16_t*)(C.lds + RL_NRB); LAS bf16_t* NRK = (LAS bf16_t*)(C.lds + RL_NRK);
    LAS bf16_t* AT = (LAS bf16_t*)(C.lds + RL_AT); LAS bf16_t* RT = (LAS bf16_t*)(C.lds + RL_RT); LAS bf16_t* BT = (LAS bf16_t*)(C.lds + RL_BT); LAS bf16_t* KT = (LAS bf16_t*)(C.lds + RL_KT);
    LAS bf16_t* BHC = (LAS bf16_t*)(C.lds + RL_BHC); LAS bf16_t* KHC = (LAS bf16_t*)(C.lds + RL_KHC); LAS bf16_t* VC = (LAS bf16_t*)(C.lds + RL_VC);
    LAS float* X = (LAS float*)(C.lds + RL_X); LAS float* X2 = (LAS float*)(C.lds + RL_X2); LAS float* LCv = (LAS float*)(C.lds + RL_SM) + 64;
    GBA();
    for (int r_RW4_12 = 0; r_RW4_12 < RW4_12; ++r_RW4_12) { asm volatile("" ::: "memory");
    const int jp = (wave >> 1) & 1, jq = wave & 1;
    bf16x8 wg[8], wd[8];
    { const bf16_t* W = WGT + (size_t)(64 * h + 32 * jp + tl) * 128 + 8 * hi; const bf16_t* W0 = WDT + (size_t)(64 * h + 32 * jq + tl) * 64 + 8 * hi; const bf16_t* W1 = WAT + (size_t)(64 * h + 32 * jq + tl) * 64 + 8 * hi;
#pragma unroll
        for (int s = 0; s < 8; ++s) wg[s] = *(const bf16x8*)(W + 16 * s);
#pragma unroll
        for (int s = 0; s < 4; ++s) { wd[s] = *(const bf16x8*)(W0 + 16 * s); wd[4 + s] = *(const bf16x8*)(W1 + 16 * s); } }
    { const int t = tid & 63, cg = wave;
#pragma unroll
        for (int q = 0; q < 8; ++q) *(LAS bf16x8*)(ACT + t * 264 + cg * 64 + 8 * q) = actv[q]; }
    GBA();
    {
        const LAS bf16_t* bp = ACT + (32 * jq + tl) * 264 + 128 + 8 * hi; f32x16 acc = {};
#pragma unroll
        for (int s = 0; s < 8; ++s) acc = mfma32(wg[s], *(const LAS bf16x8*)(bp + 16 * s), acc);
        st_tile_bf16(GGT, jp * 2 + jq, lane, acc);
        const LAS bf16_t* ap = ACT + (32 * jp + tl) * 264 + 8 * hi; f32x16 a0 = {}, a1 = {};
#pragma unroll
        for (int s = 0; s < 4; ++s) { a0 = mfma32(*(const LAS bf16x8*)(ap + 16 * s), wd[s], a0); a1 = mfma32(*(const LAS bf16x8*)(ap + 64 + 16 * s), wd[4 + s], a1); }
        const int ch = 32 * jq + tl; const float w0c = w0p[ch], a0c = a0p[ch];
#pragma unroll
        for (int g = 0; g < 16; ++g) { const int t = 32 * jp + crow(g, hi); ELL[t * 65 + ch] = -0.6065306597126334f * fsigm(w0c + a0[g]);     AV[t * 65 + ch] = fsigm(a0c + a1[g]); }
    }
    GBA();
    }
    { const int seg = lane >> 4, ch = 16 * wave + (lane & 15); float p[16]; float run = 0.f;
#pragma unroll
        for (int e = 0; e < 16; ++e) { run += ELL[(16 * seg + e) * 65 + ch]; p[e] = run; }
        const float r0_ = __shfl(run, lane & 15), r1_ = __shfl(run, 16 + (lane & 15)), r2_ = __shfl(run, 32 + (lane & 15));
        const float off = (seg > 0 ? r0_ : 0.f) + (seg > 1 ? r1_ : 0.f) + (seg > 2 ? r2_ : 0.f);
#pragma unroll
        for (int e = 0; e < 16; ++e) ELL[(16 * seg + e) * 65 + ch] = off + p[e];
        if (seg == 3) LCv[ch] = off + p[15]; }
    GBA();
    for (int r_RW4_4 = 0; r_RW4_4 < RW4_4; ++r_RW4_4) { asm volatile("" ::: "memory");
    float eLC[8];
#pragma unroll
    for (int e = 0; e < 8; ++e) eLC[e] = fexp(LCv[(tid & 7) * 8 + e]);
#pragma unroll 1
    for (int pass = 0; pass < 2; ++pass) { const int e_ = tid + 256 * pass; const int t = e_ >> 3, c0 = (e_ & 7) * 8; const size_t row = tok0 + t; const bool first = (chunk == 0 && t == 0); float rho = 0.f, n2 = 0.f;
        f32x4 r4[2], k4[2], v4[2];
#pragma unroll
        for (int q = 0; q < 2; ++q) { const int c = c0 + 4 * q;
            r4[q] = shift4(proj, row, first, PC_R + 64 * h + c, mu + 64 * h + c); k4[q] = shift4(proj, row, first, PC_BK + 64 * h + c, mu + 512 + 64 * h + c); v4[q] = shift4(proj, row, first, PC_BV + 64 * h + c, mu + 1024 + 64 * h + c);
            const f32x4 kr = k4[q] * *(const f32x4*)(kkp + c); n2 += (kr.x * kr.x + kr.y * kr.y) + (kr.z * kr.z + kr.w * kr.w); }
        n2 += __shfl_xor(n2, 1); n2 += __shfl_xor(n2, 2); n2 += __shfl_xor(n2, 4);
        const float inv = 1.f / fmaxf(sqrtf(n2), 1e-12f);
        F8 vA, vR, vB, vK;
#pragma unroll
        for (int q = 0; q < 2; ++q) { const int c = c0 + 4 * q;
            const f32x4 kk4 = *(const f32x4*)(kkp + c), ka4 = *(const f32x4*)(kap + c), rk4 = *(const f32x4*)(rkp + c);
#pragma unroll
            for (int jj = 0; jj < 4; ++jj) { const int ch = c + jj; const float a = AV[t * 65 + ch], L = ELL[t * 65 + ch], Lp = t ? ELL[(t - 1) * 65 + ch] : 0.f;
                const float kk = k4[q][jj] * kk4[jj] * inv, kp = k4[q][jj] * (1.f + (a - 1.f) * ka4[jj]), bb = kk * a;
                const float eL = fexp(L), eN = fexp(-L), eP = fexp(Lp), eD = eLC[4 * q + jj] * eN;
                rho += r4[q][jj] * kp * rk4[jj];
                const float xa = -kk * eP; vA[4 * q + jj] = xa; vR[4 * q + jj] = r4[q][jj] * eL; vB[4 * q + jj] = bb * eN; vK[4 * q + jj] = kp * eN;
                X[t * 65 + ch] = xa; BHC[ch * 72 + t] = (bf16_t)f2bf(bb * eD); KHC[ch * 72 + t] = (bf16_t)f2bf(kp * eD); VC[ch * 72 + t] = (bf16_t)f2bf(v4[q][jj]); } }
        *(LAS bf16x8*)(AT + t * 72 + c0) = pack8(vA); *(LAS bf16x8*)(RT + t * 72 + c0) = pack8(vR); *(LAS bf16x8*)(BT + t * 72 + c0) = pack8(vB); *(LAS bf16x8*)(KT + t * 72 + c0) = pack8(vK);
        rho += __shfl_xor(rho, 1); rho += __shfl_xor(rho, 2); rho += __shfl_xor(rho, 4);
        if ((tid & 7) == 0) ((float*)(C.ws + WS_RHO))[row * 8 + h] = rho; }
    GBA();
    }
    for (int r_RW4_5 = 0; r_RW4_5 < RW4_5; ++r_RW4_5) { asm volatile("" ::: "memory");
#pragma unroll
    for (int kind = 0; kind < 4; ++kind) {
        const int ti = (wave >> 1) & 1, tj = wave & 1;
        const LAS bf16_t* a = (kind < 2 ? AT : RT) + 32 * ti * 72; const LAS bf16_t* bm = ((kind & 1) ? KT : BT) + 32 * tj * 72;
        f32x16 acc = {};
        if (!(ti == 0 && tj == 1)) acc = mm_ll<4>(bm, 72, a, 72, lane, acc);
        const int i = 32 * ti + tl;
#pragma unroll
        for (int q = 0; q < 4; ++q) { const int j0 = 32 * tj + 8 * q + 4 * hi; float v[4];
#pragma unroll
            for (int e = 0; e < 4; ++e) { const bool keep = (kind < 2) ? (j0 + e < i) : (j0 + e <= i); v[e] = keep ? acc[4 * q + e] : 0.f; }
            if (kind == 0) { f32x4 w = {v[0], v[1], v[2], v[3]}; *(LAS f32x4*)(MAB + i * 68 + j0) = w; }
            else { u32x2 w; w.x = pk2(v[0], v[1]); w.y = pk2(v[2], v[3]); *(LAS u32x2*)((kind == 1 ? MAK : kind == 2 ? NRB : NRK) + i * 72 + j0) = w; } }
    }
    GBA();
    }
    { const int ti = wave >> 1, tv = wave & 1; f32x16 acc = {}; acc = mm_ll<4>(MAK + 32 * ti * 72, 72, VC + 32 * tv * 72, 72, lane, acc);
#pragma unroll
        for (int g = 0; g < 16; ++g) X2[(32 * ti + crow(g, hi)) * 65 + 32 * tv + tl] = acc[g]; }
    GBA();
    { const int mat = wave >> 1, ctl = wave & 1; LAS float* XX = mat ? X2 : X; const int cb = 32 * ctl + tl;
      for (int bk = 0; bk < 4; ++bk) {
        const int r0 = 16 * bk;
        { float x[16];
#pragma unroll
          for (int i = 0; i < 16; ++i) x[i] = XX[(r0 + i) * 65 + cb];
#pragma unroll
          for (int i = 1; i < 16; ++i) { const LAS float* mr = MAB + (r0 + i) * 68 + r0; float a_ = x[i];
#pragma unroll
              for (int q = 0; q < (i + 3) / 4; ++q) { const f32x4 m4 = *(const LAS f32x4*)(mr + 4 * q);
#pragma unroll
                  for (int e = 0; e < 4; ++e) if (4 * q + e < i) a_ += m4[e] * x[4 * q + e]; }
              x[i] = a_; }
          if (hi == 0) {
#pragma unroll
              for (int i = 1; i < 16; ++i) XX[(r0 + i) * 65 + cb] = x[i];
              F8 lo8, hi8;
#pragma unroll
              for (int e = 0; e < 8; ++e) { lo8[e] = x[e]; hi8[e] = x[8 + e]; }
              LAS bf16_t* WW = mat ? W2C : W1C; *(LAS bf16x8*)(WW + cb * 72 + r0) = pack8(lo8); *(LAS bf16x8*)(WW + cb * 72 + r0 + 8) = pack8(hi8); } }
        if (bk < 3) {
#pragma unroll
            for (int rt = 0; rt < 2; ++rt) {
                if (32 * rt + 31 >= r0 + 16) {
                    F8 av8, bv8;
#pragma unroll
                    for (int e = 0; e < 8; ++e) bv8[e] = XX[(r0 + 8 * hi + e) * 65 + cb];
                    { const f32x4 m0 = *(const LAS f32x4*)(MAB + (32 * rt + tl) * 68 + r0 + 8 * hi), m1 = *(const LAS f32x4*)(MAB + (32 * rt + tl) * 68 + r0 + 8 * hi + 4);
                      av8[0] = m0.x; av8[1] = m0.y; av8[2] = m0.z; av8[3] = m0.w; av8[4] = m1.x; av8[5] = m1.y; av8[6] = m1.z; av8[7] = m1.w; }
                    f32x16 acc;
#pragma unroll
                    for (int g = 0; g < 16; ++g) acc[g] = XX[(32 * rt + crow(g, hi)) * 65 + cb];
                    acc = mfma32(pack8(av8), pack8(bv8), acc);
#pragma unroll
                    for (int g = 0; g < 16; ++g) { const int i = 32 * rt + crow(g, hi); if (i >= r0 + 16) XX[i * 65 + cb] = acc[g]; }
                } }
        }
      } }
    GBA();
    for (int r_11 = 0; r_11 < RW4_11; ++r_11) { asm volatile("" ::: "memory");
#pragma unroll
    for (int kind = 0; kind < 4; ++kind) {
        const int p = (wave >> 1) & 1, q = wave & 1; f32x16 acc = {};
        if (kind == 0) {
            acc = mm_ll<4>(W1C + 32 * p * 72, 72, NRB + 32 * q * 72, 72, lane, acc);
            FA fa;
#pragma unroll
            for (int g4 = 0; g4 < 4; ++g4) { const u32x2 rr = *(const LAS u32x2*)(RT + (32 * q + tl) * 72 + 32 * p + 8 * g4 + 4 * hi);
                fa[4 * g4] = acc[4 * g4] + bflo(rr.x); fa[4 * g4 + 1] = acc[4 * g4 + 1] + bfhi(rr.x); fa[4 * g4 + 2] = acc[4 * g4 + 2] + bflo(rr.y); fa[4 * g4 + 3] = acc[4 * g4 + 3] + bfhi(rr.y); }
            st_frag(GT, (p * 2 + q) * 2 + 0, lane, packfrag(fa, 0)); st_frag(GT, (p * 2 + q) * 2 + 1, lane, packfrag(fa, 1));
        } else if (kind == 1) {
            acc = mm_ll<4>(W2C + 32 * p * 72, 72, NRB + 32 * q * 72, 72, lane, acc); acc = mm_ll<4>(VC + 32 * p * 72, 72, NRK + 32 * q * 72, 72, lane, acc);
            st_tile_bf16(Y0T, p * 2 + q, lane, acc);
        } else if (kind == 2) {
            acc = mm_ll<4>(W1C + 32 * p * 72, 72, BHC + 32 * q * 72, 72, lane, acc);
            FA fa = toFA(acc);
            if (p == q) { const float pc = fexp(LCv[32 * q + tl]);
#pragma unroll
                for (int g = 0; g < 16; ++g) if (crow(g, hi) == tl) fa[g] += pc; }
            st_frag(PHI, (p * 2 + q) * 2 + 0, lane, packfrag(fa, 0)); st_frag(PHI, (p * 2 + q) * 2 + 1, lane, packfrag(fa, 1));
        } else {
            acc = mm_ll<4>(BHC + 32 * p * 72, 72, W2C + 32 * q * 72, 72, lane, acc); acc = mm_ll<4>(KHC + 32 * p * 72, 72, VC + 32 * q * 72, 72, lane, acc);
            st_tile_bf16(PSI, p * 2 + q, lane, acc);
        }
    }
    }
}
#undef GBA

typedef float f32x2 __attribute__((ext_vector_type(2)));
constexpr int IX4 = RL_END, IX4_CAP = 256;
#ifndef IX_PF
#define IX_PF 2
#endif
#ifndef IXR_SEL
#define IXR_SEL 1
#endif
#define GBB() gbar(gcnt, gtarget, lane)
DI void ld_ktile(const _Float16* kbase, int kt, int ktmax, f16x8 (&d)[4]) {
    const _Float16* p = kbase + (size_t)(32 * min(kt, ktmax)) * PLD;
#pragma unroll
    for (int s = 0; s < 4; ++s) d[s] = *(const f16x8*)(p + 16 * s);
}
DI void idx_item4(Ctx& C, int item, int l, const int ixb, LAS unsigned* gcnt, unsigned& gtarget) {
    const int b = item & 3, qt = 1023 - (item >> 2);
    const int t0 = qt * 4, chunk = t0 >> 6, NT32 = 2 * (chunk + 1);
    const size_t tok0 = (size_t)b * SEQ + t0;
    unsigned* bm = (unsigned*)(C.ws + WS_BM);
    int lane = C.lane, wave = C.wave & 3, tid = C.tid & 255;
    asm volatile("" : "+v"(lane), "+v"(tid), "+s"(wave));
    if (chunk < 4) {
        if (tid < 4 * NT32) { const int q = tid / NT32, kt = tid % NT32; bm[(tok0 + q) * 128 + kt] = 0xffffffffu; }
        return;
    }
    const _Float16* ph = (const _Float16*)(C.ws + WS_PROJ);
    LAS unsigned* hist = (LAS unsigned*)(C.lds + ixb);
    LAS float* cand = (LAS float*)(C.lds + ixb + 4096);
    LAS float* redmn = (LAS float*)(C.lds + ixb + 4096 + 8 * IX4_CAP * 4);
    LAS float* redmx = redmn + 16;
    LAS unsigned* ccount = (LAS unsigned*)(redmx + 16);
    LAS float* thrS = (LAS float*)(ccount + 4);
    LAS int* thrI = (LAS int*)(thrS + 4);
    LAS unsigned* ovf = (LAS unsigned*)(thrI + 4);
    LAS unsigned* fbT = ovf + 4;
    LAS unsigned* fbCnt = fbT + 4;
    LAS unsigned* fbNeed = fbCnt + 4;
    const int r = lane & 31, hh = lane >> 5;
    float sc[32][2];
    {
        f16x8 afr[4]; float wq[2][8];
        {
            const int gq = (r >> 2) & 1, i = r >> 3, jj = r & 3, query = 2 * gq + (i >> 1), head = 4 * (i & 1) + jj;
            const _Float16* qp = ph + (tok0 + query) * PLD + PC_QI + head * 64 + 8 * hh;
#pragma unroll
            for (int s = 0; s < 4; ++s) afr[s] = *(const f16x8*)(qp + 16 * s);
#pragma unroll
            for (int qq = 0; qq < 2; ++qq) { const int q2 = 2 * hh + qq; const f16x8 wv = *(const f16x8*)(ph + (tok0 + q2) * PLD + PC_WI);
#pragma unroll
                for (int e = 0; e < 8; ++e) wq[qq][e] = (float)wv[e] * 0.044194173824159216f; }
        }
        const _Float16* kbase = ph + ((size_t)b * SEQ + r) * PLD + PC_KI + 8 * hh;
        f16x8 bq[IX_PF][4];
#pragma unroll
        for (int d = 0; d < IX_PF - 1; ++d) ld_ktile(kbase, wave + 4 * d, NT32 - 1, bq[d]);
#pragma unroll
        for (int it = 0; it < 32; ++it) {
            const int kt = wave + 4 * it;
            if (kt < NT32) {
                if (kt + 4 * (IX_PF - 1) < NT32) ld_ktile(kbase, kt + 4 * (IX_PF - 1), NT32 - 1, bq[(it + IX_PF - 1) % IX_PF]);
                f32x16 c = {};
#pragma unroll
                for (int s = 0; s < 4; ++s) c = __builtin_amdgcn_mfma_f32_32x32x16_f16(afr[s], bq[it % IX_PF][s], c, 0, 0, 0);
#pragma unroll
                for (int qq = 0; qq < 2; ++qq) { float a = 0.f;
#pragma unroll
                    for (int e = 0; e < 8; ++e) a += wq[qq][e] * fmaxf(c[8 * qq + e], 0.f);
                    sc[it][qq] = a; }
            } else { sc[it][0] = -3.0e38f; sc[it][1] = -3.0e38f; }
        }
    }
    for (int rl_ = 0; rl_ < IXR_SEL; ++rl_) { asm volatile("" ::: "memory");
    float mn[2], mx[2];
#pragma unroll
    for (int qq = 0; qq < 2; ++qq) { float me = -3.0e38f, mo = -3.0e38f;
#pragma unroll
        for (int it = 0; it < 32; it += 2) { me = fmaxf(me, sc[it][qq]); mo = fmaxf(mo, sc[it + 1][qq]); }
        float a = fminf(me, mo), z = fmaxf(me, mo);
#pragma unroll
        for (int o = 1; o < 32; o <<= 1) { a = fminf(a, __shfl_xor(a, o)); z = fmaxf(z, __shfl_xor(z, o)); }
        mn[qq] = a; mx[qq] = z; }
    if (r == 0) {
#pragma unroll
        for (int qq = 0; qq < 2; ++qq) { const int qid = 2 * hh + qq; redmn[wave * 4 + qid] = mn[qq]; redmx[wave * 4 + qid] = mx[qq]; }
    }
    { u32x4 z4 = {0u, 0u, 0u, 0u}; *(LAS u32x4*)(hist + 4 * tid) = z4; }
    if (tid < 4) { ccount[tid] = 0u; ovf[tid] = 0u; }
    GBB();
    unsigned pk[2][8];
#pragma unroll
    for (int qq = 0; qq < 2; ++qq) { const int qid = 2 * hh + qq; float a = 3.0e38f, z = -3.0e38f;
#pragma unroll
        for (int w = 0; w < 4; ++w) { a = fminf(a, redmn[w * 4 + qid]); z = fmaxf(z, redmx[w * 4 + qid]); }
        const float scl = (z > a) ? fminf(253.f / (z - a), 1.0e30f) : 1.f; const float nlo = 1.5f - a * scl;
#pragma unroll
        for (int g8 = 0; g8 < 8; ++g8) { unsigned p = 0u;
            if (wave + 16 * g8 < NT32) {
#pragma unroll
                for (int e = 0; e < 4; ++e) p = __builtin_amdgcn_cvt_pk_u8_f32(__builtin_amdgcn_fmed3f(__builtin_fmaf(sc[4 * g8 + e][qq], scl, nlo), 0.f, 255.f), e, p);
#pragma unroll
                for (int e = 0; e < 4; ++e) { const unsigned pb = (p >> (8 * e)) & 255u; if (pb) __hip_atomic_fetch_add(hist + qid * 256 + pb, 1u, __ATOMIC_RELAXED, __HIP_MEMORY_SCOPE_WORKGROUP); }
            }
            pk[qq][g8] = p; } }
    GBB();
    int B[2]; unsigned above[2];
#pragma unroll
    for (int qq = 0; qq < 2; ++qq) { const int qid = 2 * hh + qq;
        const u32x4 h0 = *(const LAS u32x4*)(hist + qid * 256 + 8 * r), h1 = *(const LAS u32x4*)(hist + qid * 256 + 8 * r + 4);
        const unsigned tot = (h0.x + h0.y) + (h0.z + h0.w) + (h1.x + h1.y) + (h1.z + h1.w); unsigned incl = tot;
#pragma unroll
        for (int o = 1; o < 32; o <<= 1) { const unsigned v = __shfl_down(incl, o, 32); if (r + o < 32) incl += v; }
        unsigned run = incl - tot; int Bf = -1; unsigned ab = 0; const unsigned hv8[8] = {h0.x, h0.y, h0.z, h0.w, h1.x, h1.y, h1.z, h1.w};
#pragma unroll
        for (int j = 7; j >= 0; --j) { const unsigned hv = hv8[j]; if (run < 256u && run + hv >= 256u) { Bf = 8 * r + j; ab = run; } run += hv; }
        const unsigned long long mk = __ballot(Bf >= 0);
        const unsigned mh = hh ? (unsigned)(mk >> 32) : (unsigned)mk;
        const int src = 32 * hh + (mh ? __builtin_ctz(mh) : 0);
        B[qq] = __shfl(Bf, src); above[qq] = (unsigned)__shfl((int)ab, src); }
#define IX_PB(it, qq) ((int)((pk[qq][(it) >> 2] >> (8 * ((it) & 3))) & 255u))
#define IX_LAUNDER() do { _Pragma("unroll") for (int it_ = 0; it_ < 32; ++it_) { asm volatile("" : "+v"(sc[it_][0]), "+v"(sc[it_][1])); } asm volatile("" : "+v"(B[0]), "+v"(B[1])); } while (0)
#pragma unroll
    for (int qq = 0; qq < 2; ++qq) { const int qid = 2 * hh + qq;
#pragma unroll
        for (int g8 = 0; g8 < 8; ++g8) if (wave + 16 * g8 < NT32) {
#pragma unroll
            for (int e = 0; e < 4; ++e) { const int it = 4 * g8 + e; const bool hit = (IX_PB(it, qq) == B[qq]);
                if (__any(hit)) { if (hit) { const unsigned pos = __hip_atomic_fetch_add(ccount + qid, 1u, __ATOMIC_RELAXED, __HIP_MEMORY_SCOPE_WORKGROUP);
                    if (pos < (unsigned)IX4_CAP) { f32x2 cv; cv.x = sc[it][qq]; cv.y = __builtin_bit_cast(float, 32 * (wave + 4 * it) + r); *(LAS f32x2*)(cand + (qid * IX4_CAP + pos) * 2) = cv; } } } } } }
    GBB();
    {
        const int c = (int)ccount[wave];
        const unsigned abq = (wave & 1) ? above[1] : above[0];
        const int need = 256 - (int)__shfl((int)abq, 32 * (wave >> 1));
        if (c <= IX4_CAP) {
            LAS float* cw = cand + wave * IX4_CAP * 2;
            if ((c & 1) && lane == 0) { f32x2 cv; cv.x = -3.0e38f; cv.y = __builtin_bit_cast(float, 0x7fffffff); *(LAS f32x2*)(cw + 2 * c) = cv; }
            asm volatile("" ::: "memory");
            for (int i = lane; i < c; i += 64) { const f32x2 ci = *(const LAS f32x2*)(cw + 2 * i); const float si = ci.x; const int ii = __float_as_int(ci.y); int rank = 0;
                for (int j = 0; j < c; j += 2) { const f32x4 cj = *(const LAS f32x4*)(cw + 2 * j);
                    rank += ((cj.x > si) || (cj.x == si && __float_as_int(cj.y) < ii)) ? 1 : 0; rank += ((cj.z > si) || (cj.z == si && __float_as_int(cj.w) < ii)) ? 1 : 0; }
                if (rank == need - 1) { thrS[wave] = si; thrI[wave] = ii; } }
        } else if (lane == 0) { ovf[wave] = 1u; fbNeed[wave] = (unsigned)need; fbT[wave] = 0u; }
    }
    GBB();
    unsigned anyovf = 0u;
#pragma unroll
    for (int q = 0; q < 4; ++q) anyovf |= ovf[q];
#ifndef IX_NOFB
#define IX_NOFB 0
#endif
    if (anyovf && !IX_NOFB) {
        for (int bit = 31; bit >= 0; --bit) {
            if (tid < 4) fbCnt[tid] = 0u;
            GBB();
            IX_LAUNDER();
#pragma unroll
            for (int qq = 0; qq < 2; ++qq) { const int qid = 2 * hh + qq; if (ovf[qid]) { const unsigned cd = fbT[qid] | (1u << bit); unsigned cnt = 0;
#pragma unroll
                for (int it = 0; it < 32; ++it) cnt += (IX_PB(it, qq) == B[qq] && ordkey(sc[it][qq]) >= cd) ? 1u : 0u;
                if (cnt) __hip_atomic_fetch_add(fbCnt + qid, cnt, __ATOMIC_RELAXED, __HIP_MEMORY_SCOPE_WORKGROUP); } }
            GBB();
            if (tid < 4 && ovf[tid] && fbCnt[tid] >= fbNeed[tid]) fbT[tid] |= (1u << bit);
            GBB();
        }
        if (tid < 4) fbCnt[tid] = 0u;
        GBB();
        IX_LAUNDER();
#pragma unroll
        for (int qq = 0; qq < 2; ++qq) { const int qid = 2 * hh + qq; if (ovf[qid]) { const unsigned Tk = fbT[qid]; unsigned cnt = 0;
#pragma unroll
            for (int it = 0; it < 32; ++it) cnt += (IX_PB(it, qq) == B[qq] && ordkey(sc[it][qq]) > Tk) ? 1u : 0u;
            if (cnt) __hip_atomic_fetch_add(fbCnt + qid, cnt, __ATOMIC_RELAXED, __HIP_MEMORY_SCOPE_WORKGROUP); } }
        GBB();
        if (tid < 4 && ovf[tid]) { fbNeed[tid] -= fbCnt[tid]; thrS[tid] = unordkey(fbT[tid]); thrI[tid] = 0; }
        GBB();
        for (int bit = 11; bit >= 0; --bit) {
            if (tid < 4) fbCnt[tid] = 0u;
            GBB();
            IX_LAUNDER();
#pragma unroll
            for (int qq = 0; qq < 2; ++qq) { const int qid = 2 * hh + qq; if (ovf[qid]) { const unsigned Tk = fbT[qid]; const int cd = thrI[qid] | (1 << bit); unsigned cnt = 0;
#pragma unroll
                for (int it = 0; it < 32; ++it) cnt += (IX_PB(it, qq) == B[qq] && ordkey(sc[it][qq]) == Tk && (32 * (wave + 4 * it) + r) < cd) ? 1u : 0u;
                if (cnt) __hip_atomic_fetch_add(fbCnt + qid, cnt, __ATOMIC_RELAXED, __HIP_MEMORY_SCOPE_WORKGROUP); } }
            GBB();
            if (tid < 4 && ovf[tid] && fbCnt[tid] < fbNeed[tid]) thrI[tid] |= (1 << bit);
            GBB();
        }
    }
#pragma unroll
    for (int qq = 0; qq < 2; ++qq) { const int qid = 2 * hh + qq; const float ts = thrS[qid]; const int ti = thrI[qid] - 32 * wave - r;
        unsigned myw = 0u;
#pragma unroll
        for (int g8 = 0; g8 < 8; ++g8) if (wave + 16 * g8 < NT32) {
#pragma unroll
            for (int e = 0; e < 4; ++e) { const int it = 4 * g8 + e; const float s = sc[it][qq];
                const bool sel = (s > ts) | ((s == ts) & (128 * it <= ti));
                const unsigned long long mk = __builtin_amdgcn_ballot_w64(sel);
                const unsigned wv = hh ? (unsigned)(mk >> 32) : (unsigned)mk;
                if (r == it) myw = wv; } }
        if (wave + 4 * r < NT32) bm[(tok0 + qid) * 128 + wave + 4 * r] = myw; }
    }
#undef IX_PB
#undef IX_LAUNDER
}
#undef GBB

constexpr int NCV_GU = 4096, NCV_DN = 2048, NCV_PG = 512, NCV_PL = 128, NCV = NCV_GU + NCV_DN + NCV_PG + NCV_PL;
DI void conv_flat_item(Ctx& C, int l, int w, LAS float* scr) {
    if (w < NCV_GU) { ColGateUp c{C.in(20) + (size_t)l * NEXP * D * DEXP, C.in(21) + (size_t)l * NEXP * D * DEXP}; transpose_item(c, DEXP, D, (bf16_t*)(C.ws + WS_WEXP), 32 * (w & 255), 64 * (w >> 8), scr, C.lane); return; }
    w -= NCV_GU;
    if (w < NCV_DN) { const int e = w >> 7, r = w & 127; ColDown c{C.in(22) + ((size_t)l * NEXP + e) * DEXP * D}; transpose_item(c, D, DEXP, (bf16_t*)(C.ws + WS_WDOWN) + (size_t)e * D * DEXP, 32 * (r & 31), 64 * (r >> 5), scr, C.lane); return; }
    w -= NCV_DN;
    if (w < NCV_PG) { ColPlain c{C.in(24) + (size_t)l * D * D}; transpose_item(c, D, D, (bf16_t*)(C.ws + WS_WPG), 32 * (w & 31), 64 * (w >> 5), scr, C.lane); return; }
    w -= NCV_PG;
    { ColPlain c{C.in(23) + (size_t)l * PLE * D}; transpose_item(c, D, PLE, (bf16_t*)(C.ws + WS_WPLE), 32 * (w & 31), 64 * (w >> 5), scr, C.lane); }
}
DI void phase_ln_router(Ctx& C, int l) {
    const bf16_t* V = (const bf16_t*)(C.ws + WS_V);
    const float* g = C.in(25) + (size_t)l * D; const float* bta = C.in(26) + (size_t)l * D;
    const float* wr = C.in(18); const float* br = C.in(19);
    LAS unsigned* lcnt = (LAS unsigned*)C.lds; LAS unsigned* base = lcnt + 16; LAS int* rec = (LAS int*)(C.lds + 128);
    TokInfo* tok = (TokInfo*)(C.ws + WS_TOK); RowInfo* rowi = (RowInfo*)(C.ws + WS_ROW);
    unsigned* gcnt = C.ctl + CW_GCNT + 64 * l;
    for (int i = C.blk * NTHR + C.tid; i < MAXROWS; i += C.G * NTHR) { RowInfo ri; ri.token = -1; ri.slot = 0; ri.gate = 0.f; ri.pad = 0; rowi[i] = ri; }
    LAS float* wT = (LAS float*)(C.lds + 4096);
    __syncthreads();
    for (int i = C.tid; i < D * 16; i += NTHR) { const int d = i >> 4, e = i & 15; wT[e * D + d] = wr[i]; }
    const int cgw = C.blk * NWAVES + C.wave, cNGW = C.G * NWAVES; LAS float* cscr = (LAS float*)(C.lds + 70656 + C.wave * 8448);
    for (int rb = C.blk; rb < T / 64; rb += C.G) {
        __syncthreads();
        if (C.tid < 16) lcnt[C.tid] = 0u;
        __syncthreads();
#pragma unroll 1
        for (int i4 = 0; i4 < 8; i4 += 2) {
          const int cw_ = cgw + (i4 >> 1) * cNGW; const bool cdo_ = (rb == C.blk) && cw_ < NCV;
          if (cdo_ && C.wave >= 4) conv_flat_item(C, l, cw_, cscr);
          f32x4 vv[8]; float lgg[32];
          { u32x2 raw[8];
#pragma unroll
            for (int r = 0; r < 2; ++r)
#pragma unroll
                for (int j = 0; j < 4; ++j) raw[4 * r + j] = *(const u32x2*)(V + ((size_t)rb * 64 + C.wave * 8 + i4 + r) * D + 256 * j + 4 * C.lane);
#pragma unroll
            for (int r = 0; r < 2; ++r) { f32x4 t[4];
#pragma unroll
                for (int j = 0; j < 4; ++j) { const u32x2 o = raw[4 * r + j]; t[j] = (f32x4){bflo(o.x), bfhi(o.x), bflo(o.y), bfhi(o.y)}; }
                ln16(t, g, bta, C.lane);
                store_row_bf16(C.xcur + ((size_t)rb * 64 + C.wave * 8 + i4 + r) * D, t, C.lane);
#pragma unroll
                for (int j = 0; j < 4; ++j) vv[4 * r + j] = t[j]; } }
#pragma unroll
          for (int k = 0; k < 32; ++k) lgg[k] = 0.f;
#pragma unroll
          for (int e = 0; e < 16; ++e)
#pragma unroll
              for (int j = 0; j < 4; ++j) { const f32x4 w4 = *(const LAS f32x4*)(wT + e * D + 256 * j + 4 * C.lane);
#pragma unroll
                  for (int r = 0; r < 2; ++r) { const f32x4 x = vv[4 * r + j]; lgg[16 * r + e] += (x.x * w4.x + x.y * w4.y) + (x.z * w4.z + x.w * w4.w); } }
#pragma unroll
          for (int k = 0; k < 32; ++k) lgg[k] = wave_sum(lgg[k]);
#pragma unroll
          for (int r = 0; r < 2; ++r) {
            const int lr = C.wave * 8 + i4 + r;
            float sc[16], sl[16];
#pragma unroll
            for (int e = 0; e < 16; ++e) { const float t = lgg[16 * r + e]; sc[e] = 1.f / (1.f + expf(-t)); sl[e] = sc[e] + br[e]; }
            int best = 0; float bestv = -3.0e38f;
#pragma unroll
            for (int gq = 0; gq < 4; ++gq) { const float a = sl[4 * gq], b2 = sl[4 * gq + 1], c2 = sl[4 * gq + 2], d2 = sl[4 * gq + 3];
                const float mx1 = fmaxf(fmaxf(a, b2), fmaxf(c2, d2)); const float tot = a + b2 + c2 + d2; const float mn1 = fminf(fminf(a, b2), fminf(c2, d2));
                const float lo1 = fminf(a, b2), hi1 = fmaxf(a, b2), lo2 = fminf(c2, d2), hi2 = fmaxf(c2, d2);
                const float second = fmaxf(fminf(hi1, hi2), fmaxf(lo1, lo2));
                (void)tot; (void)mn1;
                const float gs = mx1 + second; if (gs > bestv) { bestv = gs; best = gq; } }
            int i0 = 0, i1 = 0; float v0 = -3.0e38f, v1 = -3.0e38f, s0 = 0.f, s1 = 0.f;
#pragma unroll
            for (int gq = 0; gq < 4; ++gq) if (gq == best) {
#pragma unroll
                for (int k = 0; k < 4; ++k) { const float x = sl[4 * gq + k]; if (x > v0) { v1 = v0; i1 = i0; s1 = s0; v0 = x; i0 = 4 * gq + k; s0 = sc[4 * gq + k]; } else if (x > v1) { v1 = x; i1 = 4 * gq + k; s1 = sc[4 * gq + k]; } } }
            const float den = s0 + s1; const float g0 = s0 / den, g1 = s1 / den;
            if (C.lane == 0) {
                const unsigned r0 = __hip_atomic_fetch_add(lcnt + i0, 1u, __ATOMIC_RELAXED, __HIP_MEMORY_SCOPE_WORKGROUP);
                const unsigned r1 = __hip_atomic_fetch_add(lcnt + i1, 1u, __ATOMIC_RELAXED, __HIP_MEMORY_SCOPE_WORKGROUP);
                rec[lr * 8 + 0] = i0; rec[lr * 8 + 1] = i1; rec[lr * 8 + 2] = (int)r0; rec[lr * 8 + 3] = (int)r1;
                rec[lr * 8 + 4] = __builtin_bit_cast(int, g0); rec[lr * 8 + 5] = __builtin_bit_cast(int, g1); }
          }
          if (cdo_ && C.wave < 4) conv_flat_item(C, l, cw_, cscr);
        }
        __syncthreads();
        if (C.tid < 16) base[C.tid] = __hip_atomic_fetch_add(gcnt + C.tid, lcnt[C.tid], __ATOMIC_RELAXED, __HIP_MEMORY_SCOPE_AGENT);
        __syncthreads();
        if (C.tid < 64) { TokInfo ti; ti.e0 = rec[C.tid * 8]; ti.e1 = rec[C.tid * 8 + 1]; ti.p0 = rec[C.tid * 8 + 2] + (int)base[ti.e0]; ti.p1 = rec[C.tid * 8 + 3] + (int)base[ti.e1];
            ti.g0 = __builtin_bit_cast(float, rec[C.tid * 8 + 4]); ti.g1 = __builtin_bit_cast(float, rec[C.tid * 8 + 5]); ti.pad0 = 0; ti.pad1 = 0; tok[(size_t)rb * 64 + C.tid] = ti; }
    }
    for (int w = cgw + 4 * cNGW; w < NCV; w += cNGW) conv_flat_item(C, l, w, cscr);
}
DI int build_tile_table(Ctx& C, int l, LAS int* toff, LAS int* texp) {
    const unsigned* gcnt = C.ctl + CW_GCNT + 64 * l;
    __syncthreads();
    if (C.tid < 64) {
        int c = 0; if (C.lane < 16) c = (int)__hip_atomic_load(gcnt + C.lane, __ATOMIC_RELAXED, __HIP_MEMORY_SCOPE_AGENT);
        const int nt = (c + 255) >> 8; int incl = nt;
#pragma unroll
        for (int o = 1; o < 16; o <<= 1) { const int v = __shfl_up(incl, o); if (C.lane >= o) incl += v; }
        const int start = incl - nt;
        if (C.lane < 16) { toff[C.lane] = start << 8; for (int t = 0; t < nt; ++t) texp[start + t] = C.lane; }
        if (C.lane == 15) toff[16] = incl << 8; }
    __syncthreads();
    return toff[16] >> 8;
}
DI void phase_gather(Ctx& C, int l) {
    LAS int* toff = (LAS int*)(C.lds + 1024); LAS int* texp = (LAS int*)(C.lds + 2048);
    (void)build_tile_table(C, l, toff, texp);
    const TokInfo* tok = (const TokInfo*)(C.ws + WS_TOK); RowInfo* rowi = (RowInfo*)(C.ws + WS_ROW); bf16_t* AG = (bf16_t*)(C.ws + WS_AG);
    for (int m = C.blk * NTHR + C.tid; m < T; m += C.G * NTHR) {
        const TokInfo ti = tok[m];
        const int r0 = toff[ti.e0] + ti.p0, r1 = toff[ti.e1] + ti.p1;
        { RowInfo x; x.token = m; x.slot = 0; x.gate = ti.g0; x.pad = 0; rowi[r0] = x; x.slot = 1; x.gate = ti.g1; rowi[r1] = x; }
    }
}
DI void phase_ln_ffn(Ctx& C, int l) {
    const bf16_t* Y = (const bf16_t*)(C.ws + WS_Y);
    const float* g = C.in(27) + (size_t)l * D; const float* bta = C.in(28) + (size_t)l * D;
    const int gw = C.blk * NWAVES + C.wave, NGW = C.G * NWAVES;
    for (int m = gw; m < T; m += 2 * NGW) {
        const int m2 = m + NGW, m2c = min(m2, T - 1);
        f32x4 x[4], y0[4], y1[4], xb[4], y0b[4], y1b[4];
        load_row_bf16(C.xcur + (size_t)m * D, x, C.lane); load_row_bf16(Y + (size_t)m * D, y0, C.lane); load_row_bf16(Y + ((size_t)T + m) * D, y1, C.lane);
        load_row_bf16(C.xcur + (size_t)m2c * D, xb, C.lane); load_row_bf16(Y + (size_t)m2c * D, y0b, C.lane); load_row_bf16(Y + ((size_t)T + m2c) * D, y1b, C.lane);
        asm volatile("" ::: "memory");
#pragma unroll
        for (int j = 0; j < 4; ++j) { x[j] = x[j] * ALPHA + (y0[j] + y1[j]); xb[j] = xb[j] * ALPHA + (y0b[j] + y1b[j]); }
        ln16(x, g, bta, C.lane); ln16(xb, g, bta, C.lane);
        store_row_bf16(C.xcur + (size_t)m * D, x, C.lane);
        if (m2 < T) store_row_bf16(C.xcur + (size_t)m2 * D, xb, C.lane);
    }
}
DI void ln_ple_out(Ctx& C, int m, f32x4 (&v)[4], bool last) {
    if (m >= T) return;
    if (last) {
#pragma unroll
        for (int j = 0; j < 4; ++j) *(f32x4*)(C.out + (size_t)m * D + 256 * j + 4 * C.lane) = v[j];
    } else store_row_bf16(C.xcur + (size_t)m * D, v, C.lane);
}
DI void phase_ln_ple(Ctx& C, int l, bool last) {
    const bf16_t* V = (const bf16_t*)(C.ws + WS_V3);
    const float* g = C.in(29) + (size_t)l * D; const float* bta = C.in(30) + (size_t)l * D;
    const int gw = C.blk * NWAVES + C.wave, NGW = C.G * NWAVES;
    for (int m = gw; m < T; m += 4 * NGW) {
        f32x4 va[4], vb[4], vc[4], vd[4];
        load_row_bf16(V + (size_t)m * D, va, C.lane); load_row_bf16(V + (size_t)min(m + NGW, T - 1) * D, vb, C.lane);
        load_row_bf16(V + (size_t)min(m + 2 * NGW, T - 1) * D, vc, C.lane); load_row_bf16(V + (size_t)min(m + 3 * NGW, T - 1) * D, vd, C.lane);
        asm volatile("" ::: "memory");
        ln16(va, g, bta, C.lane); ln16(vb, g, bta, C.lane); ln16(vc, g, bta, C.lane); ln16(vd, g, bta, C.lane);
        ln_ple_out(C, m, va, last); ln_ple_out(C, m + NGW, vb, last); ln_ple_out(C, m + 2 * NGW, vc, last); ln_ple_out(C, m + 3 * NGW, vd, last);
    }
}

constexpr int LDS_BYTES = 163840;
constexpr int PH_PER_LAYER = 13, NPHASE = 1 + DEPTH * PH_PER_LAYER;

constexpr int CW_AQ = 2048;
DI void convert_mixer_weights(Ctx& C, int l) {
    int first = 0;
    { ColPlain c{C.in(5) + (size_t)l * D * D}; convert_matrix(C, c, D, D, D, (bf16_t*)(C.ws + WS_WOUT), first); }
    { ColPlain c{C.in(8) + (size_t)l * 64 * 512}; convert_matrix(C, c, 512, 64, 512, (bf16_t*)(C.ws + WS_LORA), first); }
    { ColPlain c{C.in(10) + (size_t)l * 64 * 512}; convert_matrix(C, c, 512, 64, 512, (bf16_t*)(C.ws + WS_LORA) + 512 * 64, first); }
    { ColPlain c{C.in(11) + (size_t)l * 128 * 512}; convert_matrix(C, c, 512, 128, 512, (bf16_t*)(C.ws + WS_LORA) + 2 * 512 * 64, first); }
}
DI void convert_ffn_weights(Ctx& C, int l) {
    const float* p = C.in(1) + (size_t)l * T * PLE; bf16_t* pb = (bf16_t*)(C.ws + WS_PBF);
    const size_t pstr = (size_t)C.G * NTHR * 8;
    for (size_t i0 = ((size_t)C.blk * NTHR + C.tid) * 8; i0 < (size_t)T * PLE; i0 += 4 * pstr) {
        f32x4 a[4], b[4];
#pragma unroll
        for (int k = 0; k < 4; ++k) { const size_t i = i0 + k * pstr; if (i < (size_t)T * PLE) { a[k] = *(const f32x4*)(p + i); b[k] = *(const f32x4*)(p + i + 4); } }
#pragma unroll
        for (int k = 0; k < 4; ++k) { const size_t i = i0 + k * pstr; if (i < (size_t)T * PLE) { u32x4 o; o.x = pk2(a[k].x, a[k].y); o.y = pk2(a[k].z, a[k].w); o.z = pk2(b[k].x, b[k].y); o.w = pk2(b[k].z, b[k].w); *(u32x4*)(pb + i) = o; } } }
}
#ifndef RWREP
#define RWREP 1
#endif
#ifndef IQREP
#define IQREP 1
#endif
#ifndef REP_SUB
#define REP_SUB 0
#endif
#ifndef REP_SP
#define REP_SP -1
#define REP_N 1
#endif
template <int SP> DI void run_sp_(Ctx& C, const int l, const int rep);
template <int SP> DI void run_sp(Ctx& C, const int l) { run_sp_<SP>(C, l, 0); }
template <int SP> DI void run_sp_(Ctx& C, const int l, const int rep) {
    if constexpr (SP == 0) {
        pg8::Gemm g{C.xcur, (const bf16_t*)(C.ws + WS_WEXP), T, NPROJ_PAD, opaque_i(D)}; pg8::StaticOrder S; S.init(T, NPROJ_PAD, C.G, C.blk);
        EpiProj E{(bf16_t*)(C.ws + WS_PROJ)};
        pg8::gemm_phase<EpiProj, pg8::StaticOrder, true, true>(C.lds, g, S, E);
    } else if constexpr (SP == 1) {
    } else if constexpr (SP == 2) {
        LAS unsigned* gb = (LAS unsigned*)(C.lds + GB_OFF);
        if (C.tid < 8) gb[C.tid] = 0u;
        __syncthreads();
        const int half = C.wave >> 2, ltid = C.tid & 255;
        LAS unsigned* gcnt = gb + half; unsigned gtarget = 0u;
        LAS int* slot = (LAS int*)(gb + 2 + 2 * half);
        unsigned* iq = C.ctl + CW_AQ + 32 + 64 * l + 256 * rep;
        int nxt = 0, par = 0;
        if (half == 0) {
            for (int rw_ = 0; rw_ < RWREP; ++rw_)
            for (int bc = C.blk; bc < 256; bc += C.G) { bf16x8 actv[8]; rwkv_chunk_acts4(C, bc, l, actv); for (int h = 0; h < 8; ++h) rwkv_head_item4(C, bc * 8 + h, l, actv, gcnt, gtarget); }
        }
        const int ixb = half ? IX4 : 0;
        if (ltid == 0) nxt = (int)__hip_atomic_fetch_add(iq, 1u, __ATOMIC_RELAXED, __HIP_MEMORY_SCOPE_AGENT);
        for (;;) {
            if (ltid == 0) slot[par] = nxt;
            gbar(gcnt, gtarget, C.lane);
            const int u = __builtin_amdgcn_readfirstlane(slot[par]); par ^= 1;
            if (u >= 4096) break;
            if (ltid == 0) nxt = (int)__hip_atomic_fetch_add(iq, 1u, __ATOMIC_RELAXED, __HIP_MEMORY_SCOPE_AGENT);
            idx_item4(C, u, l, ixb, gcnt, gtarget);
        }
    } else if constexpr (SP == 3) {
        if (C.blk < 8 && (rep == 0 || REP_SUB != 2)) rwkv_scan_wave(C, C.blk * 8 + C.wave);
        LAS int* qs = (LAS int*)(C.lds + LDS_BYTES - 128);
        if (rep == 0 || REP_SUB != 1)
        for (;;) {
            __syncthreads();
            if (C.tid == 0) qs[0] = (int)__hip_atomic_fetch_add(C.ctl + CW_AQ + 64 * l + 256 * rep, 1u, __ATOMIC_RELAXED, __HIP_MEMORY_SCOPE_AGENT);
            __syncthreads();
            const int u = __builtin_amdgcn_readfirstlane(qs[0]);
            if (u >= 512) break;
            const int qb = 15 - (u >> 5), bh = u & 31; attn_unit(C, bh >> 3, bh & 7, qb);
        }
    } else if constexpr (SP == 4) {
        const int gw = C.blk * NWAVES + C.wave, NGW = C.G * NWAVES;
        for (int id = gw; id < 2048; id += NGW) rwkv_out_wave(C, id, l);
    } else if constexpr (SP == 5) {
        pg8::Gemm g{C.mixcat, (const bf16_t*)(C.ws + WS_WOUT), T, D, opaque_i(D)}; pg8::StaticOrder S; S.init(T, D, C.G, C.blk);
        EpiResF32 E{C.xcur, (bf16_t*)(C.ws + WS_V)};
        pg8::gemm_phase<EpiResF32, pg8::StaticOrder, true, true>(C.lds, g, S, E);
    } else if constexpr (SP == 6) { phase_ln_router(C, l); convert_ffn_weights(C, l);
    } else if constexpr (SP == 7) { phase_gather(C, l);
    } else if constexpr (SP == 8) {
        LAS int* toff = (LAS int*)(C.lds + 135168); LAS int* texp = (LAS int*)(C.lds + 136192);
        const int nt = build_tile_table(C, l, toff, texp);
        pg8::Gemm g{C.xcur, (const bf16_t*)(C.ws + WS_WEXP), MAXROWS, NEXP * 512, opaque_i(D)};
        GroupedOrder<2> S{texp, nt, C.G, C.blk};
        EpiSwiGLU E{(bf16_t*)(C.ws + WS_H), (const RowInfo*)(C.ws + WS_ROW)};
        pg8::gemm_phase_gather<EpiSwiGLU, GroupedOrder<2>, true>(C.lds, g, S, E, (const int*)(C.ws + WS_ROW));
        {
            const int extra = (2 * nt > C.G) ? (2 * nt - C.G) : 0; const int nb = C.G - extra;
            if (C.blk >= extra && nb > 0) { pg8::Gemm g2{(const bf16_t*)(C.ws + WS_PBF), (const bf16_t*)(C.ws + WS_WPLE), T, D, opaque_i(PLE)}; pg8::StaticOrder S2; S2.init(T, D, nb, C.blk - extra);
                EpiBf16Plain E2{(bf16_t*)(C.ws + WS_PE), D};
                pg8::gemm_phase<EpiBf16Plain, pg8::StaticOrder, true, true>(C.lds, g2, S2, E2); } }
    } else if constexpr (SP == 9) {
        LAS int* toff = (LAS int*)(C.lds + 135168); LAS int* texp = (LAS int*)(C.lds + 136192);
        const int nt = build_tile_table(C, l, toff, texp);
        { pg8::Gemm g{(const bf16_t*)(C.ws + WS_H), (const bf16_t*)(C.ws + WS_WDOWN), MAXROWS, NEXP * D, opaque_i(DEXP)};
          GroupedOrder<4> S{texp, nt, C.G, C.blk};
          EpiDown E{(bf16_t*)(C.ws + WS_Y), (const RowInfo*)(C.ws + WS_ROW)};
          pg8::gemm_phase<EpiDown, GroupedOrder<4>, true, true>(C.lds, g, S, E); }
    } else if constexpr (SP == 10) { phase_ln_ffn(C, l);
    } else if constexpr (SP == 11) {
        pg8::Gemm g{C.xcur, (const bf16_t*)(C.ws + WS_WPG), T, D, opaque_i(D)}; pg8::StaticOrder S; S.init(T, D, C.G, C.blk);
        EpiPle E{C.xcur, (const bf16_t*)(C.ws + WS_PE), (bf16_t*)(C.ws + WS_V3)};
        pg8::gemm_phase<EpiPle, pg8::StaticOrder, true, true>(C.lds, g, S, E);
    } else { phase_ln_ple(C, l, l == DEPTH - 1); if (l + 1 < DEPTH) { convert_win(C, l + 1); convert_mixer_weights(C, l + 1); } }
}
#define XB_TMO      128
#define XB_XCNT(j)  (256  + 64 * (j))
#define XB_XSUB(j)  (1280 + 64 * (j))
#define XB_XGEN(j)  (2304 + 64 * (j))
#define XB_TOP      3328
#define XB_TOPGEN   3392
#define XCD_BAR_WORDS 3456
#define XB_SPIN_CAP (1u << 18)

__device__ __forceinline__ unsigned xb_ld(unsigned* p)              { return __hip_atomic_load(p, __ATOMIC_RELAXED, __HIP_MEMORY_SCOPE_AGENT); }
__device__ __forceinline__ unsigned xb_add(unsigned* p, unsigned v) { return __hip_atomic_fetch_add(p, v, __ATOMIC_RELAXED, __HIP_MEMORY_SCOPE_AGENT); }
__device__ __forceinline__ unsigned xb_xcc_id() { return (unsigned)__builtin_amdgcn_s_getreg((3 << 11) | 20) & 0xFu; }
#define XB_SPIN(cond, bar) do { unsigned _sp = 0; while (cond) { __builtin_amdgcn_s_sleep(1); \
    if ((++_sp & 255u) == 0u) { if (xb_ld(&(bar)[XB_TMO])) break; if (_sp > XB_SPIN_CAP) { atomicAdd(&(bar)[XB_TMO], 1u); break; } } } } while (0)

struct XcdBarrier {
    unsigned* bar; unsigned x;
    volatile __attribute__((address_space(3))) unsigned* st;
};

__device__ __forceinline__ XcdBarrier xcd_barrier_post(unsigned* bar, volatile __attribute__((address_space(3))) unsigned* st) {
    XcdBarrier b; b.bar = bar; b.x = xb_xcc_id(); b.st = st;
    if (threadIdx.x == 0) (void)xb_add(&bar[XB_XCNT(b.x)], 1u);
    return b;
}
__device__ __forceinline__ void xcd_barrier_complete(unsigned* bar, unsigned x, unsigned& nloc, unsigned& nx) {
    const unsigned G = gridDim.x * gridDim.y * gridDim.z;
    unsigned sum, cnt, mine, sp = 0u;
    for (;;) {
        sum = 0u; cnt = 0u; mine = 0u;
#pragma unroll
        for (unsigned j = 0; j < 16; ++j) { const unsigned c = xb_ld(&bar[XB_XCNT(j)]); sum += c; cnt += (c > 0u) ? 1u : 0u; mine = (j == x) ? c : mine; }
        if (sum == G) break;
        __builtin_amdgcn_s_sleep(1);
        if ((++sp & 255u) == 0u) { if (xb_ld(&bar[XB_TMO])) break; if (sp > XB_SPIN_CAP) { atomicAdd(&bar[XB_TMO], 1u); break; } }
    }
    nloc = mine > 0u ? mine : 1u; nx = cnt > 0u ? cnt : 1u;
}

__device__ __forceinline__ void xcd_barrier(const XcdBarrier& b) {
    asm volatile("s_waitcnt vmcnt(0)" ::: "memory");
    __syncthreads();
    if (threadIdx.x == 0) {
        unsigned* bar = b.bar;
        __builtin_amdgcn_s_waitcnt(0);
        unsigned nloc = b.st[0], nx = b.st[1];
        if (nloc == 0u) { xcd_barrier_complete(bar, b.x, nloc, nx); b.st[0] = nloc; b.st[1] = nx; }
        const unsigned old = xb_add(&bar[XB_XSUB(b.x)], 1u);
        const unsigned gen = old / nloc;
        if (old + 1u == (gen + 1u) * nloc) {
            __builtin_amdgcn_fence(__ATOMIC_RELEASE, "agent");
            asm volatile("s_waitcnt vmcnt(0)" ::: "memory");
            const unsigned og = xb_add(&bar[XB_TOP], 1u);
            const unsigned tg = og / nx;
            if (og + 1u == (tg + 1u) * nx) xb_add(&bar[XB_TOPGEN], 1u);
            else XB_SPIN(xb_ld(&bar[XB_TOPGEN]) == tg, bar);
            __builtin_amdgcn_fence(__ATOMIC_ACQUIRE, "agent");
            xb_add(&bar[XB_XGEN(b.x)], 1u);
            asm volatile("s_waitcnt vmcnt(0)" ::: "memory");
        } else {
            XB_SPIN(xb_ld(&bar[XB_XGEN(b.x)]) == gen, bar);
            __builtin_amdgcn_fence(__ATOMIC_ACQUIRE, "agent");
            asm volatile("s_waitcnt vmcnt(0)" ::: "memory");
        }
    }
    __syncthreads();
}

constexpr int CW_XBAR = 65536;
typedef const __attribute__((address_space(4))) Args* KArgP;
DI void ctx_setup(Ctx& C) {
    int t_ = threadIdx.x; asm volatile("" : "+v"(t_)); C.tid = t_; C.lane = t_ & 63; C.wave = __builtin_amdgcn_readfirstlane(t_ >> 6);
    int b_ = blockIdx.x, g_ = gridDim.x; asm volatile("" : "+s"(b_), "+s"(g_)); C.blk = b_; C.G = g_;
    KArgP ap = (KArgP)__builtin_amdgcn_kernarg_segment_ptr(); asm volatile("" : "+s"(ap));
    C.ap = ap; C.out = ap->out; C.ws = ap->ws; C.ctl = (unsigned*)(ap->ws + WS_CTL); C.xcur = (bf16_t*)ap->out; C.mixcat = (bf16_t*)ap->out + (size_t)T * D;
}
__global__ void __launch_bounds__(NTHR, 2) mega_fwd(Args args) {
    extern __shared__ __attribute__((aligned(16))) unsigned char lds_raw[];
    Ctx C;
    C.lds = (LAS unsigned char*)lds_raw;
    cg::grid_group grid = cg::this_grid();
    volatile LAS unsigned* xbst = (volatile LAS unsigned*)(C.lds + LDS_BYTES - 32);
    if (threadIdx.x < 4) xbst[threadIdx.x] = 0u;
    __syncthreads();
    XcdBarrier xbar = xcd_barrier_post((unsigned*)(((KArgP)__builtin_amdgcn_kernarg_segment_ptr())->ws + WS_CTL) + CW_XBAR, xbst);
    const int lo = ((KArgP)__builtin_amdgcn_kernarg_segment_ptr())->ph_lo, hi = ((KArgP)__builtin_amdgcn_kernarg_segment_ptr())->ph_hi;
#ifdef PROBE_PHASE
#define PROBE_HOOK(k) do { if (blockIdx.x == 0 && threadIdx.x == 0) { unsigned long long* pt = (unsigned long long*)(C.ws + WS_CTL + 32768); if ((k) == PROBE_PHASE) pt[0] = __builtin_amdgcn_s_memrealtime(); if ((k) == PROBE_PHASE_END) pt[1] = __builtin_amdgcn_s_memrealtime(); } } while (0)
#else
#define PROBE_HOOK(k) do { } while (0)
#endif
#define GRID_BAR(k) do { if ((k) == lo + 1) grid.sync(); else xcd_barrier(xbar); } while (0)
#define PHASE(k, body) do { if (lo <= (k) && (k) < hi) { if ((k) > lo) GRID_BAR(k); ctx_setup(C); PROBE_HOOK(k); body; } } while (0)
    PHASE(0, { phase_ln_in(C); convert_win(C, 0); convert_mixer_weights(C, 0); });
#define LAYER(l) PHASE(1 + 13 * (l) + 0, run_sp<0>(C, l)); PHASE(1 + 13 * (l) + 2, run_sp<2>(C, l)); PHASE(1 + 13 * (l) + 3, run_sp<3>(C, l)); \
    PHASE(1 + 13 * (l) + 4, run_sp<4>(C, l)); PHASE(1 + 13 * (l) + 5, run_sp<5>(C, l)); PHASE(1 + 13 * (l) + 6, run_sp<6>(C, l)); PHASE(1 + 13 * (l) + 7, run_sp<7>(C, l)); \
    PHASE(1 + 13 * (l) + 8, run_sp<8>(C, l)); PHASE(1 + 13 * (l) + 9, run_sp<9>(C, l)); PHASE(1 + 13 * (l) + 10, run_sp<10>(C, l)); PHASE(1 + 13 * (l) + 11, run_sp<11>(C, l)); \
    PHASE(1 + 13 * (l) + 12, run_sp<12>(C, l))
#define PH0(sp) PHASE(1 + (sp), run_sp<sp>(C, 0)); if (REP_SP == (sp)) { if (REP_N > 1) { xcd_barrier(xbar); ctx_setup(C); run_sp_<sp>(C, 0, 1); } if (REP_N > 2) { xcd_barrier(xbar); ctx_setup(C); run_sp_<sp>(C, 0, 2); } }
    PH0(0); PH0(2); PH0(3); PH0(4); PH0(5); PH0(6); PH0(7); PH0(8); PH0(9); PH0(10); PH0(11); PH0(12);
#undef PH0
    LAYER(1);
#undef LAYER
#undef PHASE
}

#ifndef N_LAUNCH_MODE
#define N_LAUNCH_MODE 1
#endif
extern "C" void kernel_launch(void* const* d_in, const int* in_sizes, int n_in, void* d_out, int out_size, void* d_ws, size_t ws_size, hipStream_t stream) {
    static int grid = 0;
    if (grid == 0) {
        if (n_in != 31 || out_size != T * D) { fprintf(stderr, "kernel_launch: unexpected problem (n_in %d out %d)\n", n_in, out_size); grid = -1; return; }
        int dev = 0, cus = 0, per_cu = 0;
        hipGetDevice(&dev); hipDeviceGetAttribute(&cus, hipDeviceAttributeMultiprocessorCount, dev);
        if (hipFuncSetAttribute((const void*)mega_fwd, hipFuncAttributeMaxDynamicSharedMemorySize, LDS_BYTES) != hipSuccess) { fprintf(stderr, "kernel_launch: hipFuncSetAttribute failed\n"); grid = -1; return; }
        if (hipOccupancyMaxActiveBlocksPerMultiprocessor(&per_cu, (const void*)mega_fwd, NTHR, LDS_BYTES) != hipSuccess || per_cu < 1) { fprintf(stderr, "kernel_launch: occupancy query says %d\n", per_cu); per_cu = 1; }
        (void)hipGetLastError();
        grid = cus * 1;
        fprintf(stderr, "kernel_launch: grid %d (occupancy %d per CU)\n", grid, per_cu);
    }
    if (grid < 0) return;
    hipMemsetAsync((char*)d_ws + WS_CTL, 0, CTL_BYTES, stream);
    Args a{};
    for (int i = 0; i < 31; ++i) a.in[i] = (const float*)d_in[i];
    a.out = (float*)d_out; a.ws = (unsigned char*)d_ws;
#if N_LAUNCH_MODE == 0
    for (int ph = 0; ph < NPHASE; ++ph) { a.ph_lo = ph; a.ph_hi = ph + 1; hipLaunchKernelGGL(mega_fwd, dim3(grid), dim3(NTHR), LDS_BYTES, stream, a); }
#else
    a.ph_lo = 0; a.ph_hi = NPHASE;
    void* kargs[] = {&a};
    hipError_t e = hipLaunchCooperativeKernel((const void*)mega_fwd, dim3(grid), dim3(NTHR), kargs, LDS_BYTES, stream);
    if (e != hipSuccess) fprintf(stderr, "cooperative launch failed: %s (grid %d)\n", hipGetErrorString(e), grid);
#endif
}
```
